# Optimizing an MI355X kernel written in HIP

```python
import jax, jax.numpy as jnp
from jax import lax
import numpy as np

D_MODEL = 1024
BATCH = 16
SEQ = 4096
DEPTH = 2

N_META = 16
A_HEADS = 4
A_QK_DIM = 128
A_V_DIM = 256
A_CHUNK = 64
GATE_PAD = -1e30
B_HEADS = 8
B_HEAD_DIM = 128
B_BLOCK = 128
D_FF_DENSE = 2816
N_EXPERTS = 8
TOP_K = 2
D_FF_EXPERT = 3584
MOE_BLOCK = 256
N_A_LAYERS = DEPTH // 2
N_B_LAYERS = DEPTH - N_A_LAYERS
N_DENSE_LAYERS = (DEPTH + 1) // 2
N_MOE_LAYERS = DEPTH // 2
DEEPNORM_ALPHA = (2 * DEPTH) ** 0.25
DEEPNORM_BETA = (8 * DEPTH) ** -0.25
LN_EPS = 1e-5

kernel_name = "yoco_mlstm_stickbreak_moe_deepnorm"


def _layernorm(x, g, b):
    xf = x.astype(jnp.float32)
    mu = xf.mean(-1, keepdims=True)
    var = jnp.mean(jnp.square(xf - mu), -1, keepdims=True)
    return ((xf - mu) * lax.rsqrt(var + LN_EPS) * g.astype(jnp.float32) + b.astype(jnp.float32)).astype(x.dtype)


def _mlstm_chunk(carry, xs):
    c_mat, n_vec, m = carry
    q, k, v, li, lf = xs
    b = jnp.cumsum(lf, axis=-1)
    causal = jnp.tril(jnp.ones((A_CHUNK, A_CHUNK), dtype=bool))
    d_log = jnp.where(causal, b[..., :, None] - b[..., None, :] + li[..., None, :], -jnp.inf)
    inter = b + m[..., None]
    m_t = jnp.maximum(inter, d_log.max(-1))
    w_intra = jnp.exp(d_log - m_t[..., None])
    w_inter = jnp.exp(inter - m_t)
    s = jnp.einsum('bhtd,bhsd->bhts', q, k) * w_intra
    num = w_inter[..., None] * jnp.einsum('bhtd,bhde->bhte', q, c_mat) + jnp.einsum('bhts,bhse->bhte', s, v)
    den = w_inter * jnp.einsum('bhtd,bhd->bht', q, n_vec) + s.sum(-1)
    h = num / jnp.maximum(jnp.abs(den), jnp.exp(-m_t))[..., None]
    b_last = b[..., -1]
    g = b_last[..., None] - b + li
    m_new = jnp.maximum(b_last + m, g.max(-1))
    decay = jnp.exp(b_last + m - m_new)
    wk = jnp.exp(g - m_new[..., None])[..., None] * k
    c_new = decay[..., None, None] * c_mat + jnp.einsum('bhsd,bhse->bhde', wk, v)
    n_new = decay[..., None] * n_vec + wk.sum(2)
    return (c_new, n_new, m_new), h


def _mlstm_mixer(h, w_in, b_gate, norm_g, w_out):
    bsz, length, _ = h.shape
    hk, hv = A_HEADS * A_QK_DIM, A_HEADS * A_V_DIM
    proj = h @ w_in
    q = proj[..., :hk]
    k = proj[..., hk:2 * hk]
    v = proj[..., 2 * hk:2 * hk + hv]
    o = proj[..., 2 * hk + hv:2 * hk + 2 * hv]
    gates = (proj[..., 2 * hk + 2 * hv:] + b_gate).astype(jnp.float32)
    li = gates[..., :A_HEADS].transpose(0, 2, 1)
    lf = jax.nn.log_sigmoid(gates[..., A_HEADS:]).transpose(0, 2, 1)

    def heads(t, dh):
        return t.reshape(bsz, length, A_HEADS, dh).transpose(0, 2, 1, 3).astype(jnp.float32)

    qh = heads(q, A_QK_DIM)
    kh = heads(k, A_QK_DIM) * (A_QK_DIM ** -0.5)
    vh = heads(v, A_V_DIM)
    pad = A_CHUNK - N_META

    def padseq(t, val):
        return jnp.pad(t, [(0, 0), (0, 0), (pad, 0)] + [(0, 0)] * (t.ndim - 3), constant_values=val)

    n_chunks = (length + pad) // A_CHUNK

    def chunks(t):
        return jnp.moveaxis(t.reshape((bsz, A_HEADS, n_chunks, A_CHUNK) + t.shape[3:]), 2, 0)

    xs = (chunks(padseq(qh, 0.0)), chunks(padseq(kh, 0.0)), chunks(padseq(vh, 0.0)),
          chunks(padseq(li, GATE_PAD)), chunks(padseq(lf, 0.0)))
    init = (jnp.zeros((bsz, A_HEADS, A_QK_DIM, A_V_DIM), jnp.float32),
            jnp.zeros((bsz, A_HEADS, A_QK_DIM), jnp.float32),
            jnp.zeros((bsz, A_HEADS), jnp.float32))
    _, hs = lax.scan(_mlstm_chunk, init, xs)
    hs = jnp.moveaxis(hs, 0, 2).reshape(bsz, A_HEADS, n_chunks * A_CHUNK, A_V_DIM)[:, :, pad:]
    hs = hs.transpose(0, 2, 1, 3)
    mu = hs.mean(-1, keepdims=True)
    var = jnp.mean(jnp.square(hs - mu), -1, keepdims=True)
    hn = (hs - mu) * lax.rsqrt(var + LN_EPS) * norm_g.astype(jnp.float32).reshape(A_HEADS, A_V_DIM)
    out = jax.nn.sigmoid(o.astype(jnp.float32)) * hn.reshape(bsz, length, hv)
    return out.astype(h.dtype) @ w_out


def _shared_kv(h, w_kv):
    bsz, length, _ = h.shape
    kv = (h @ w_kv).reshape(bsz, length, 2, B_HEADS, B_HEAD_DIM).transpose(2, 0, 3, 1, 4).astype(jnp.float32)
    kv = jnp.pad(kv, [(0, 0), (0, 0), (0, 0), (B_BLOCK - N_META, 0), (0, 0)])
    return kv[0], kv[1]


def _stick_breaking_mixer(h, w_q, k_sh, v_sh, w_o):
    bsz, length, _ = h.shape
    pad = B_BLOCK - N_META
    q = (h @ w_q).reshape(bsz, length, B_HEADS, B_HEAD_DIM).transpose(0, 2, 1, 3).astype(jnp.float32)
    q = jnp.pad(q, [(0, 0), (0, 0), (pad, 0), (0, 0)]) * (B_HEAD_DIM ** -0.5)
    total = length + pad
    n_blk = total // B_BLOCK
    qb = jnp.moveaxis(q.reshape(bsz, B_HEADS, n_blk, B_BLOCK, B_HEAD_DIM), 2, 0)
    kpos = jnp.arange(total)

    def block(args):
        q_blk, blk = args
        qpos = blk * B_BLOCK + jnp.arange(B_BLOCK)
        z = jnp.einsum('bhqd,bhkd->bhqk', q_blk, k_sh)
        valid = (kpos[None, :] < qpos[:, None]) & (kpos[None, :] >= pad)
        sp = jnp.where(valid, jax.nn.softplus(z), 0.0)
        suffix = lax.cumsum(sp, axis=3, reverse=True) - sp
        a = jnp.where(valid, jnp.exp(jax.nn.log_sigmoid(z) - suffix), 0.0)
        return jnp.einsum('bhqk,bhkd->bhqd', a, v_sh)

    ob = lax.map(block, (qb, jnp.arange(n_blk)))
    o = jnp.moveaxis(ob, 0, 2).reshape(bsz, B_HEADS, total, B_HEAD_DIM)[:, :, pad:]
    o = o.transpose(0, 2, 1, 3).reshape(bsz, length, B_HEADS * B_HEAD_DIM).astype(h.dtype)
    return o @ w_o


def _swiglu(x, w_gate, w_up, w_down):
    return (jax.nn.silu(x @ w_gate) * (x @ w_up)) @ w_down


def _moe_swiglu(x2, w_router, w_gate, w_up, w_down):
    n = x2.shape[0]
    logits = x2.astype(jnp.float32) @ w_router.astype(jnp.float32)
    top_val, top_idx = lax.top_k(logits, TOP_K)
    gates = jax.nn.softmax(top_val, axis=-1)
    flat_e = top_idx.reshape(-1)
    flat_tok = jnp.repeat(jnp.arange(n, dtype=jnp.int32), TOP_K)
    flat_g = gates.reshape(-1)
    order = jnp.argsort(flat_e)
    se, stok, sg = flat_e[order], flat_tok[order], flat_g[order]
    counts = jnp.bincount(flat_e, length=N_EXPERTS)
    start = jnp.cumsum(counts) - counts
    pcounts = (counts + MOE_BLOCK - 1) // MOE_BLOCK * MOE_BLOCK
    pend = jnp.cumsum(pcounts)
    pstart = pend - pcounts
    dest = pstart[se] + (jnp.arange(n * TOP_K) - start[se])
    n_blk = -(-(n * TOP_K + N_EXPERTS * (MOE_BLOCK - 1)) // MOE_BLOCK)
    rows = n_blk * MOE_BLOCK
    tok_buf = jnp.full((rows,), n, dtype=jnp.int32).at[dest].set(stok)
    x_pad = jnp.concatenate([x2, jnp.zeros((1, x2.shape[1]), x2.dtype)], axis=0)
    xb = x_pad[tok_buf].reshape(n_blk, MOE_BLOCK, x2.shape[1])
    blk_e = jnp.minimum(jnp.searchsorted(pend, jnp.arange(n_blk) * MOE_BLOCK, side='right'), N_EXPERTS - 1)

    def expert_block(args):
        x_blk, e = args
        return _swiglu(x_blk, w_gate[e], w_up[e], w_down[e])

    yb = lax.map(expert_block, (xb, blk_e)).reshape(rows, x2.shape[1])
    y = yb[dest] * sg[:, None].astype(yb.dtype)
    return jnp.zeros_like(x2).at[stok].add(y)


def setup_inputs(seed: int = 0) -> dict:
    key = jax.random.key(seed)
    ks = jax.random.split(key, 20)
    f32 = jnp.float32
    hk, hv = A_HEADS * A_QK_DIM, A_HEADS * A_V_DIM
    a_in = 2 * hk + 2 * hv + 2 * A_HEADS
    bw = B_HEADS * B_HEAD_DIM

    def nrm(k, shape, fan_in, scale=1.0):
        return jax.random.normal(k, shape, f32) * (fan_in ** -0.5) * scale

    f_bias = jnp.linspace(3.0, 6.0, A_HEADS, dtype=f32)
    b_gate = jnp.concatenate([jnp.zeros((N_A_LAYERS, A_HEADS), f32),
                              jnp.broadcast_to(f_bias, (N_A_LAYERS, A_HEADS))], axis=-1)
    b_gate = b_gate + 0.1 * jax.random.normal(ks[3], (N_A_LAYERS, 2 * A_HEADS), f32)
    return {
        "x": jax.random.normal(ks[0], (BATCH, SEQ, D_MODEL), f32),
        "meta": jax.random.normal(ks[1], (N_META, D_MODEL), f32),
        "w_in_a": nrm(ks[2], (N_A_LAYERS, D_MODEL, a_in), D_MODEL),
        "b_gate_a": b_gate,
        "norm_a": 1.0 + 0.02 * jax.random.normal(ks[4], (N_A_LAYERS, hv), f32),
        "w_out_a": nrm(ks[5], (N_A_LAYERS, hv, D_MODEL), hv, DEEPNORM_BETA),
        "w_kv": nrm(ks[6], (D_MODEL, 2 * bw), D_MODEL),
        "w_q_b": nrm(ks[7], (N_B_LAYERS, D_MODEL, bw), D_MODEL),
        "w_o_b": nrm(ks[8], (N_B_LAYERS, bw, D_MODEL), bw, DEEPNORM_BETA),
        "w_gate_d": nrm(ks[9], (N_DENSE_LAYERS, D_MODEL, D_FF_DENSE), D_MODEL),
        "w_up_d": nrm(ks[10], (N_DENSE_LAYERS, D_MODEL, D_FF_DENSE), D_MODEL),
        "w_down_d": nrm(ks[11], (N_DENSE_LAYERS, D_FF_DENSE, D_MODEL), D_FF_DENSE, DEEPNORM_BETA),
        "w_router": nrm(ks[12], (N_MOE_LAYERS, D_MODEL, N_EXPERTS), D_MODEL),
        "w_gate_e": nrm(ks[13], (N_MOE_LAYERS, N_EXPERTS, D_MODEL, D_FF_EXPERT), D_MODEL),
        "w_up_e": nrm(ks[14], (N_MOE_LAYERS, N_EXPERTS, D_MODEL, D_FF_EXPERT), D_MODEL),
        "w_down_e": nrm(ks[15], (N_MOE_LAYERS, N_EXPERTS, D_FF_EXPERT, D_MODEL), D_FF_EXPERT, DEEPNORM_BETA),
        "ln_g": 1.0 + 0.02 * jax.random.normal(ks[16], (DEPTH, 2, D_MODEL), f32),
        "ln_b": 0.02 * jax.random.normal(ks[17], (DEPTH, 2, D_MODEL), f32),
    }


def reference(x, meta, w_in_a, b_gate_a, norm_a, w_out_a, w_kv, w_q_b, w_o_b,
              w_gate_d, w_up_d, w_down_d, w_router, w_gate_e, w_up_e, w_down_e, ln_g, ln_b):
    bsz = x.shape[0]
    h = jnp.concatenate([jnp.broadcast_to(meta[None].astype(x.dtype), (bsz, N_META, D_MODEL)), x], axis=1)
    k_sh = None
    v_sh = None
    for layer in range(DEPTH):
        if layer < N_A_LAYERS:
            mix = _mlstm_mixer(h, w_in_a[layer], b_gate_a[layer], norm_a[layer], w_out_a[layer])
        else:
            j = layer - N_A_LAYERS
            mix = _stick_breaking_mixer(h, w_q_b[j], k_sh, v_sh, w_o_b[j])
        h = _layernorm(DEEPNORM_ALPHA * h + mix, ln_g[layer, 0], ln_b[layer, 0])
        if layer % 2 == 0:
            i = layer // 2
            ffn = _swiglu(h, w_gate_d[i], w_up_d[i], w_down_d[i])
        else:
            i = layer // 2
            ffn = _moe_swiglu(h.reshape(-1, D_MODEL), w_router[i], w_gate_e[i], w_up_e[i], w_down_e[i]).reshape(h.shape)
        h = _layernorm(DEEPNORM_ALPHA * h + ffn, ln_g[layer, 1], ln_b[layer, 1])
        if layer == N_A_LAYERS - 1:
            k_sh, v_sh = _shared_kv(h, w_kv)
    return h[:, N_META:]
```

```cpp
#include <hip/hip_runtime.h>
#include <cstdio>
#include <cstdint>

#ifndef N_LAUNCH_MODE
#define N_LAUNCH_MODE 0
#endif
#ifndef DBG_CHECK
#define DBG_CHECK 0
#endif

#define LAS __attribute__((address_space(3)))
typedef unsigned short bf16_t;
typedef short bf16x8 __attribute__((ext_vector_type(8)));
typedef float f32x2 __attribute__((ext_vector_type(2)));
typedef float f32x4 __attribute__((ext_vector_type(4)));
typedef float f32x16 __attribute__((ext_vector_type(16)));
typedef unsigned u32x2 __attribute__((ext_vector_type(2)));
typedef unsigned u32x4 __attribute__((ext_vector_type(4)));
typedef __bf16 bf16x2_t __attribute__((ext_vector_type(2)));

constexpr int D = 1024, NB = 16, SEQ = 4096, NMETA = 16;
constexpr int NR = NB * SEQ;
constexpr int NROWS = NR + NB * NMETA;
constexpr int NPAN = NROWS / 256;
constexpr int NPROJ = 3072;
constexpr int FFD = 2816, NE = 8, FFE = 3584;
constexpr float ALPHA = 1.41421356237f, LN_EPS = 1e-5f;
constexpr int NTHREADS = 512;
constexpr int MOE_ROWS = 2 * NR + NE * 256;
constexpr int MOE_CHUNK_PAN = 128;
constexpr int MOE_NCHUNK = 5;

constexpr size_t al256(size_t x) { return (x + 255) & ~(size_t)255; }
constexpr size_t WS_CTL = 0;
constexpr size_t CTL_BYTES = 65536;
constexpr size_t WS_WIN = WS_CTL + CTL_BYTES;
constexpr size_t WS_WOUT = WS_WIN + (size_t)NPROJ * D * 2;
constexpr size_t WS_WGU = WS_WOUT + (size_t)D * D * 2;
constexpr size_t WS_WDN = WS_WGU + (size_t)2 * FFD * D * 2;
constexpr size_t WS_WKVQ = WS_WDN + (size_t)D * FFD * 2;
constexpr size_t WS_WO = WS_WKVQ + (size_t)NPROJ * D * 2;
constexpr size_t WS_WEGU = WS_WO + (size_t)D * D * 2;
constexpr size_t WS_WEDN = WS_WEGU + (size_t)NE * 2 * FFE * D * 2;
constexpr size_t WS_VEC = WS_WEDN + (size_t)NE * D * FFE * 2;
constexpr int VEC_GU_CS = 0, VEC_GU_BW = 2 * FFD, VEC_KVQ_CS = 4 * FFD, VEC_KVQ_BW = VEC_KVQ_CS + NPROJ, VEC_EGU_CS = VEC_KVQ_BW + NPROJ, VEC_EGU_BW = VEC_EGU_CS + NE * 2 * FFE, VEC_END = VEC_EGU_BW + NE * 2 * FFE;
constexpr size_t WS_GATES = al256(WS_VEC + (size_t)VEC_END * 4);
constexpr size_t WS_ST1 = al256(WS_GATES + (size_t)NROWS * 8 * 4);
constexpr size_t WS_ST2 = WS_ST1 + (size_t)NROWS * 16 * 8;
constexpr size_t WS_ST3 = WS_ST2 + (size_t)NROWS * 16 * 8;
constexpr size_t WS_ROUTE = WS_ST3 + (size_t)NROWS * 16 * 8;
constexpr size_t WS_CNT = WS_ROUTE + (size_t)NR * 16;
constexpr size_t WS_HDR = WS_CNT + 256 * 8 * 4;
constexpr size_t WS_TOK = WS_HDR + 256;
constexpr size_t WS_GATEB = al256(WS_TOK + (size_t)MOE_ROWS * 4);
constexpr size_t WS_DIAG = al256(WS_GATEB + (size_t)MOE_ROWS * 4);
constexpr size_t WS_RA = al256(WS_DIAG + 4096);
constexpr size_t RA_BYTES = (size_t)NROWS * NPROJ * 2;
constexpr size_t WS_RB = al256(WS_RA + RA_BYTES);
constexpr size_t RX_BYTES = (size_t)NROWS * D * 2;
constexpr size_t WS_RC = al256(WS_RB + RX_BYTES);
constexpr size_t WS_RD = al256(WS_RC + RX_BYTES);
constexpr size_t WS_END = al256(WS_RD + RX_BYTES);

__device__ __forceinline__ float bf2f(bf16_t v) { return __uint_as_float(((unsigned)v) << 16); }
__device__ __forceinline__ float bflo(unsigned u) { return __uint_as_float(u << 16); }
__device__ __forceinline__ float bfhi(unsigned u) { return __uint_as_float(u & 0xffff0000u); }
__device__ __forceinline__ unsigned pk2(float lo, float hi) { f32x2 v = {lo, hi}; bf16x2_t b = __builtin_convertvector(v, bf16x2_t); return __builtin_bit_cast(unsigned, b); }
__device__ __forceinline__ bf16_t f2bf(float f) { return (bf16_t)(pk2(f, 0.f) & 0xffffu); }
__device__ __forceinline__ float rbf(float f) { return bflo(pk2(f, 0.f)); }
__device__ __forceinline__ float wave_sum(float v) {
#pragma unroll
    for (int o = 32; o >= 1; o >>= 1) v += __shfl_xor(v, o);
    return v;
}
__device__ __forceinline__ float sigmoidf_(float x) { return 1.0f / (1.0f + __expf(-x)); }

#define XB_TMO      128
#define XB_XCNT(j)  (256  + 64 * (j))
#define XB_XSUB(j)  (1280 + 64 * (j))
#define XB_XGEN(j)  (2304 + 64 * (j))
#define XB_TOP      3328
#define XB_TOPGEN   3392
#define XCD_BAR_WORDS 3456
#define XB_SPIN_CAP (1u << 20)
__device__ __forceinline__ unsigned xb_ld(unsigned* p)              { return __hip_atomic_load(p, __ATOMIC_RELAXED, __HIP_MEMORY_SCOPE_AGENT); }
__device__ __forceinline__ unsigned xb_add(unsigned* p, unsigned v) { return __hip_atomic_fetch_add(p, v, __ATOMIC_RELAXED, __HIP_MEMORY_SCOPE_AGENT); }
__device__ __forceinline__ unsigned xb_xcc_id() { return (unsigned)__builtin_amdgcn_s_getreg((3 << 11) | 20) & 0xFu; }
#define XB_SPIN(cond, bar) do { unsigned _sp = 0; while (cond) { __builtin_amdgcn_s_sleep(1); \
    if ((++_sp & 255u) == 0u) { if (xb_ld(&(bar)[XB_TMO])) break; if (_sp > XB_SPIN_CAP) { atomicAdd(&(bar)[XB_TMO], 1u); break; } } } } while (0)
struct XcdBarrier { unsigned* bar; unsigned x; volatile LAS unsigned* st; };
__device__ __forceinline__ XcdBarrier xcd_barrier_post(unsigned* bar, volatile LAS unsigned* st) {
    XcdBarrier b; b.bar = bar; b.x = xb_xcc_id(); b.st = st;
    if (threadIdx.x == 0) (void)xb_add(&bar[XB_XCNT(b.x)], 1u);
    return b;
}
__device__ __forceinline__ void xcd_barrier_complete(unsigned* bar, unsigned x, unsigned& nloc, unsigned& nx) {
    const unsigned G = gridDim.x * gridDim.y * gridDim.z;
    unsigned sum, cnt, mine, sp = 0u;
    for (;;) {
        sum = 0u; cnt = 0u; mine = 0u;
#pragma unroll
        for (unsigned j = 0; j < 16; ++j) { const unsigned c = xb_ld(&bar[XB_XCNT(j)]); sum += c; cnt += (c > 0u) ? 1u : 0u; mine = (j == x) ? c : mine; }
        if (sum == G) break;
        __builtin_amdgcn_s_sleep(1);
        if ((++sp & 255u) == 0u) { if (xb_ld(&bar[XB_TMO])) break; if (sp > XB_SPIN_CAP) { atomicAdd(&bar[XB_TMO], 1u); break; } }
    }
    nloc = mine > 0u ? mine : 1u; nx = cnt > 0u ? cnt : 1u;
}
__device__ __forceinline__ void xcd_barrier(const XcdBarrier& b) {
    asm volatile("s_waitcnt vmcnt(0)" ::: "memory");
    __syncthreads();
    if (threadIdx.x == 0) {
        unsigned* bar = b.bar;
        __builtin_amdgcn_s_waitcnt(0);
        unsigned nloc = b.st[0], nx = b.st[1];
        if (nloc == 0u) { xcd_barrier_complete(bar, b.x, nloc, nx); b.st[0] = nloc; b.st[1] = nx; }
        const unsigned old = xb_add(&bar[XB_XSUB(b.x)], 1u);
        const unsigned gen = old / nloc;
        if (old + 1u == (gen + 1u) * nloc) {
            __builtin_amdgcn_fence(__ATOMIC_RELEASE, "agent");
            asm volatile("s_waitcnt vmcnt(0)" ::: "memory");
            const unsigned og = xb_add(&bar[XB_TOP], 1u);
            const unsigned tg = og / nx;
            if (og + 1u == (tg + 1u) * nx) xb_add(&bar[XB_TOPGEN], 1u);
            else XB_SPIN(xb_ld(&bar[XB_TOPGEN]) == tg, bar);
            __builtin_amdgcn_fence(__ATOMIC_ACQUIRE, "agent");
            xb_add(&bar[XB_XGEN(b.x)], 1u);
            asm volatile("s_waitcnt vmcnt(0)" ::: "memory");
        } else {
            XB_SPIN(xb_ld(&bar[XB_XGEN(b.x)]) == gen, bar);
            __builtin_amdgcn_fence(__ATOMIC_ACQUIRE, "agent");
            asm volatile("s_waitcnt vmcnt(0)" ::: "memory");
        }
    }
    __syncthreads();
}

namespace g8 {
constexpr int BM = 256, BK = 64, HALF = 128, HTB = HALF * BK * 2, STAGE_BYTES = 8 * HTB, NXCD = 8, WGM = 8;
__host__ __device__ __forceinline__ int lds_byte(int r, int c) { const int st = (r >> 4) * 2 + (c >> 5), rr = r & 15, cc = c & 31, ob = rr * 64 + cc * 2; return st * 1024 + (ob ^ (((ob >> 9) & 1) << 5)); }
__host__ __device__ __forceinline__ void stage_rc(int b, int& R, int& C) { const int st = b / 1024, sb = b % 1024, swz = sb ^ (((sb >> 9) & 1) << 5); R = (st >> 1) * 16 + swz / 64; C = (st & 1) * 32 + (swz % 64) / 2; }
__host__ __device__ __forceinline__ int perm32(int rho) { const int n = rho >> 4, i = rho & 15; return 8 * (i >> 2) + 4 * n + (i & 3); }

struct Unit { int pm, pn, gp; unsigned boff; };
struct Gemm { const bf16_t* A; const bf16_t* Bt; int K; const int* rowtab; };

struct DenseOrder {
    int nM, nN, nwg, G, c, K;
    __device__ void init(int nM_, int nN_, int K_, int G_, int c_) { nM = nM_; nN = nN_; nwg = nM * nN; G = G_; c = c_; K = K_; }
    __device__ bool next(int i, Unit& u) const {
        const long L = (long)i * G + c; if (L >= nwg) return false;
        int wgid = (int)L; { const int q = nwg / NXCD, r = nwg % NXCD, xcd = wgid % NXCD, off = wgid / NXCD; wgid = (xcd < r ? xcd * (q + 1) : r * (q + 1) + (xcd - r) * q) + off; }
        const int nig = WGM * nN, gid = wgid / nig, fm = gid * WGM, gsz = (nM - fm) < WGM ? (nM - fm) : WGM;
        u.pm = fm + ((wgid % nig) % gsz); u.pn = (wgid % nig) / gsz; u.gp = u.pm; u.boff = (unsigned)u.pn * (unsigned)(256 * K * 2); return true;
    }
};
struct MoeOrder {
    int p0, np, nN, G, c, K; unsigned estride; int pend[NE];
    __device__ bool next(int i, Unit& u) const {
        const long L = (long)i * G + c; if (L >= (long)np * nN) return false;
        const int pn = (int)(L / np), pml = (int)(L % np), gp = p0 + pml;
        int e = 0;
#pragma unroll
        for (int j = 0; j < NE - 1; ++j) e += (gp >= pend[j]) ? 1 : 0;
        u.pm = pml; u.pn = pn; u.gp = gp; u.boff = (unsigned)e * estride + (unsigned)pn * (unsigned)(256 * K * 2); return true;
    }
};

template <class Epi, class Sched, bool GATHER>
__device__ __forceinline__ void gemm_phase(LAS unsigned char* lds, const Gemm g, const Sched& S, const Epi& E) {
    const int tid = threadIdx.x, wid = __builtin_amdgcn_readfirstlane(tid >> 6), lane = tid & 63, wr = wid >> 2, wc = wid & 3, fr = lane & 15, fq = lane >> 4;
    const int K = g.K, nt = K / BK;
    int Rr[2], Cc[2]; unsigned voffA[2], voffB[2];
#pragma unroll
    for (int i = 0; i < 2; ++i) { stage_rc(tid * 16 + i * 8192, Rr[i], Cc[i]); const int Rb = (Rr[i] & ~31) + perm32(Rr[i] & 31);
        voffA[i] = (unsigned)(Rr[i] * K + Cc[i]) * 2u; voffB[i] = (unsigned)(Rb * K + Cc[i]) * 2u; }
    const size_t kstep = (size_t)(BK * 2);
    const size_t hstep = (size_t)HALF * K * 2;
    const size_t tstep = 2 * hstep;
    const unsigned ldsw = (unsigned)wid * 1024u;
    const int aoff = lds_byte(wr * 64 + fr, fq * 8), boff = lds_byte(wc * 32 + fr, fq * 8);
#define G8_SA(b, h) (((b) * 2 + (h)) * HTB)
#define G8_SB(b, h) ((4 + (b) * 2 + (h)) * HTB)
#define G8_STAGE(bufoff, gbase, voff) do { _Pragma("unroll") for (int _i = 0; _i < 2; ++_i) \
        __builtin_amdgcn_global_load_lds((const unsigned*)((const char*)(gbase) + (voff)[_i]), (LAS unsigned*)(lds + (bufoff) + ldsw + _i * 8192), 16, 0, 0); } while (0)
#define G8_STA(bufoff, ptr, offs, h) do { if constexpr (GATHER) { G8_STAGE(bufoff, (const char*)g.A, (offs)[h]); } else { G8_STAGE(bufoff, (ptr) + (h) * hstep, voffA); } } while (0)
#define G8_LDA(dst, b, h) do { _Pragma("unroll") for (int m = 0; m < 4; ++m) _Pragma("unroll") for (int k = 0; k < 2; ++k) dst[m][k] = *(const LAS bf16x8*)(lds + G8_SA(b, h) + aoff + m * 2048 + k * 1024); } while (0)
#define G8_LDB(dst, b, h) do { _Pragma("unroll") for (int n = 0; n < 2; ++n) _Pragma("unroll") for (int k = 0; k < 2; ++k) dst[n][k] = *(const LAS bf16x8*)(lds + G8_SB(b, h) + boff + n * 2048 + k * 1024); } while (0)
#define G8_MMA(ai, bj, At, Bt) do { __builtin_amdgcn_s_setprio(1); _Pragma("unroll") for (int m = 0; m < 4; ++m) _Pragma("unroll") for (int n = 0; n < 2; ++n) _Pragma("unroll") for (int k = 0; k < 2; ++k) \
        acc[ai][bj][m][n] = __builtin_amdgcn_mfma_f32_16x16x32_bf16(Bt[n][k], At[m][k], acc[ai][bj][m][n], 0, 0, 0); __builtin_amdgcn_s_setprio(0); } while (0)
#define G8_WAIT_V(n) asm volatile("s_waitcnt vmcnt(" #n ")" ::: "memory")
#define G8_WAIT_L(n) asm volatile("s_waitcnt lgkmcnt(" #n ")" ::: "memory")
#define G8_BAR __builtin_amdgcn_s_barrier()
#define G8_SCHED __builtin_amdgcn_sched_barrier(0)
#define G8_ROWOFFS(dst, U) do { _Pragma("unroll") for (int _h = 0; _h < 2; ++_h) _Pragma("unroll") for (int _i = 0; _i < 2; ++_i) { \
        const int _id = g.rowtab[(U).gp * 256 + _h * 128 + Rr[_i]]; const int _tk = _id < 0 ? 0 : (_id >> 1); dst[_h][_i] = (unsigned)(_tk * K + Cc[_i]) * 2u; } } while (0)
    Unit cur, nxt; int ui = 0;
    if (!S.next(0, cur)) return;
    f32x4 acc[2][2][4][2];
#pragma unroll
    for (int a = 0; a < 2; ++a)
#pragma unroll
        for (int b = 0; b < 2; ++b)
#pragma unroll
            for (int m = 0; m < 4; ++m)
#pragma unroll
                for (int n = 0; n < 2; ++n) acc[a][b][m][n] = (f32x4){0.f, 0.f, 0.f, 0.f};
    bf16x8 At[4][2], B0[2][2], B1[2][2];
    const char* cA = (const char*)g.A + (size_t)cur.pm * tstep; const char* cB = (const char*)g.Bt + cur.boff;
    unsigned oc[2][2], on[2][2], o1[2][2], o2[2][2], o3[2][2];
    if constexpr (GATHER) { G8_ROWOFFS(oc, cur);
#pragma unroll
        for (int h = 0; h < 2; ++h)
#pragma unroll
            for (int i = 0; i < 2; ++i) { o1[h][i] = oc[h][i] + 128u; on[h][i] = oc[h][i]; o2[h][i] = 0; o3[h][i] = 0; } }
    G8_STAGE(G8_SB(0, 0), cB, voffB); G8_STAGE(G8_SB(0, 1), cB + hstep, voffB); G8_STA(G8_SA(0, 0), cA, oc, 0); G8_STA(G8_SA(0, 1), cA, oc, 1);
    if (wr == 1) G8_BAR;
    G8_WAIT_V(2); G8_BAR;
    G8_STAGE(G8_SB(1, 0), cB + kstep, voffB); G8_STA(G8_SA(1, 0), cA + kstep, o1, 0); G8_STAGE(G8_SB(1, 1), cB + hstep + kstep, voffB);
    G8_WAIT_V(6); G8_BAR;
    for (;;) {
        const bool has_next = S.next(ui + 1, nxt);
        const char* nA = has_next ? (const char*)g.A + (size_t)nxt.pm * tstep : cA; const char* nB = has_next ? (const char*)g.Bt + nxt.boff : cB;
        if constexpr (GATHER) { if (has_next) { G8_ROWOFFS(on, nxt); } else {
#pragma unroll
            for (int h = 0; h < 2; ++h)
#pragma unroll
                for (int i = 0; i < 2; ++i) on[h][i] = oc[h][i]; } }
        for (int t = 0; t < nt; t += 2) {
            const bool last = (t == nt - 2);
            const char* a1 = cA + (size_t)(t + 1) * kstep;
            const char* a2 = last ? nA : cA + (size_t)(t + 2) * kstep; const char* b2 = last ? nB : cB + (size_t)(t + 2) * kstep;
            const char* a3 = a2 + kstep; const char* b3 = b2 + kstep;
            if constexpr (GATHER) {
#pragma unroll
                for (int h = 0; h < 2; ++h)
#pragma unroll
                    for (int i = 0; i < 2; ++i) { o1[h][i] = oc[h][i] + (unsigned)(t + 1) * 128u; o2[h][i] = last ? on[h][i] : oc[h][i] + (unsigned)(t + 2) * 128u; o3[h][i] = o2[h][i] + 128u; } }
            G8_LDB(B0, 0, 0); G8_LDB(B1, 0, 1); G8_SCHED; G8_LDA(At, 0, 0); G8_STA(G8_SA(1, 1), a1, o1, 1);
            G8_WAIT_V(8); G8_WAIT_L(0); G8_BAR; G8_MMA(0, 0, At, B0); G8_MMA(0, 1, At, B1); G8_BAR; G8_SCHED;
            G8_LDA(At, 0, 1); G8_STAGE(G8_SB(0, 0), b2, voffB); G8_STAGE(G8_SB(0, 1), b2 + hstep, voffB); G8_STA(G8_SA(0, 0), a2, o2, 0);
            G8_WAIT_V(8); G8_WAIT_L(0); G8_BAR; G8_MMA(1, 0, At, B0); G8_MMA(1, 1, At, B1); G8_BAR; G8_SCHED;
            G8_LDB(B0, 1, 0); G8_LDB(B1, 1, 1); G8_SCHED; G8_LDA(At, 1, 0); G8_STA(G8_SA(0, 1), a2, o2, 1);
            G8_WAIT_V(8); G8_WAIT_L(0); G8_BAR; G8_MMA(0, 0, At, B0); G8_MMA(0, 1, At, B1); G8_BAR; G8_SCHED;
            G8_LDA(At, 1, 1); G8_STAGE(G8_SB(1, 0), b3, voffB); G8_STAGE(G8_SB(1, 1), b3 + hstep, voffB); G8_STA(G8_SA(1, 0), a3, o3, 0);
            G8_WAIT_V(8); G8_WAIT_L(0); G8_BAR; G8_MMA(1, 0, At, B0); G8_MMA(1, 1, At, B1); G8_BAR; G8_SCHED;
        }
        if (wr == 0) G8_BAR;
        E(acc, cur, wr, wc, fr, fq);
        if (!has_next) break;
#pragma unroll
        for (int a = 0; a < 2; ++a)
#pragma unroll
            for (int b = 0; b < 2; ++b)
#pragma unroll
                for (int m = 0; m < 4; ++m)
#pragma unroll
                    for (int n = 0; n < 2; ++n) acc[a][b][m][n] = (f32x4){0.f, 0.f, 0.f, 0.f};
        cur = nxt; cA = nA; cB = nB; ++ui;
        if constexpr (GATHER) {
#pragma unroll
            for (int h = 0; h < 2; ++h)
#pragma unroll
                for (int i = 0; i < 2; ++i) oc[h][i] = on[h][i]; }
        if (wr == 1) G8_BAR;
    }
    G8_WAIT_V(0);
    G8_BAR;
#undef G8_SA
#undef G8_SB
#undef G8_STAGE
#undef G8_STA
#undef G8_LDA
#undef G8_LDB
#undef G8_MMA
#undef G8_WAIT_V
#undef G8_WAIT_L
#undef G8_BAR
#undef G8_SCHED
#undef G8_ROWOFFS
}

typedef f32x4 Acc[2][2][4][2];
__device__ __forceinline__ u32x4 pack8(const f32x4 a, const f32x4 b) { u32x4 w; w.x = pk2(a[0], a[1]); w.y = pk2(a[2], a[3]); w.z = pk2(b[0], b[1]); w.w = pk2(b[2], b[3]); return w; }
__device__ __forceinline__ void unpack8(const u32x4 w, float (&f)[8]) { f[0] = bflo(w.x); f[1] = bfhi(w.x); f[2] = bflo(w.y); f[3] = bfhi(w.y); f[4] = bflo(w.z); f[5] = bfhi(w.z); f[6] = bflo(w.w); f[7] = bfhi(w.w); }
__device__ __forceinline__ void row_stats(const float* st, int row, int fq, float& mu, float& rstd) {
    const f32x4* p = (const f32x4*)(st + (size_t)row * 32 + fq * 8);
    const f32x4 a = p[0], b = p[1];
    float s1 = (a[0] + a[2]) + (b[0] + b[2]), s2 = (a[1] + a[3]) + (b[1] + b[3]);
    s1 += __shfl_xor(s1, 16); s1 += __shfl_xor(s1, 32); s2 += __shfl_xor(s2, 16); s2 += __shfl_xor(s2, 32);
    mu = s1 * (1.0f / 1024.0f); const float var = fmaxf(s2 * (1.0f / 1024.0f) - mu * mu, 0.f); rstd = rsqrtf(var + LN_EPS);
}
__device__ __forceinline__ void put_stats(float* st, int row, int slot, int fq, float s1, float s2) {
    s1 += __shfl_xor(s1, 16); s1 += __shfl_xor(s1, 32); s2 += __shfl_xor(s2, 16); s2 += __shfl_xor(s2, 32);
    if (fq == 0) *(f32x2*)(st + (size_t)row * 32 + slot * 2) = (f32x2){s1, s2};
}

struct EpiPlain {
    bf16_t* O; int ldc;
    __device__ __forceinline__ void operator()(const Acc& acc, const Unit& u, int wr, int wc, int fr, int fq) const {
        const int row0 = u.pm * 256 + wr * 64 + fr, col0 = u.pn * 256 + wc * 32 + 8 * fq;
#pragma unroll
        for (int ai = 0; ai < 2; ++ai)
#pragma unroll
            for (int m = 0; m < 4; ++m) { bf16_t* rowp = O + (size_t)(row0 + ai * 128 + m * 16) * ldc + col0;
#pragma unroll
                for (int bj = 0; bj < 2; ++bj) *(u32x4*)(rowp + bj * 128) = pack8(acc[ai][bj][m][0], acc[ai][bj][m][1]); }
    }
};
template <int MODE> struct EpiRes {
    bf16_t* Z; const bf16_t* Rsrc; float* st_out; const float* st_in; const float* g; const float* b;
    __device__ __forceinline__ void operator()(const Acc& acc, const Unit& u, int wr, int wc, int fr, int fq) const {
        const int row0 = u.pm * 256 + wr * 64 + fr, col0 = u.pn * 256 + wc * 32 + 8 * fq;
        f32x4 gv[2][2], bv[2][2];
        if (MODE == 1) {
#pragma unroll
            for (int bj = 0; bj < 2; ++bj)
#pragma unroll
                for (int n = 0; n < 2; ++n) { gv[bj][n] = *(const f32x4*)(g + col0 + bj * 128 + 4 * n); bv[bj][n] = *(const f32x4*)(b + col0 + bj * 128 + 4 * n); }
        }
#pragma unroll
        for (int ai = 0; ai < 2; ++ai)
#pragma unroll
            for (int m = 0; m < 4; ++m) {
                const int row = row0 + ai * 128 + m * 16;
                float mu = 0.f, rstd = 1.f;
                if (MODE == 1) row_stats(st_in, row, fq, mu, rstd);
                float s1 = 0.f, s2 = 0.f;
#pragma unroll
                for (int bj = 0; bj < 2; ++bj) {
                    const u32x4 rw = *(const u32x4*)(Rsrc + (size_t)row * D + col0 + bj * 128);
                    float r[8]; unpack8(rw, r);
                    f32x4 v0, v1;
#pragma unroll
                    for (int j = 0; j < 4; ++j) {
                        float h0 = r[j], h1 = r[4 + j];
                        if (MODE == 1) { h0 = (h0 - mu) * rstd * gv[bj][0][j] + bv[bj][0][j]; h1 = (h1 - mu) * rstd * gv[bj][1][j] + bv[bj][1][j]; }
                        v0[j] = ALPHA * h0 + acc[ai][bj][m][0][j]; v1[j] = ALPHA * h1 + acc[ai][bj][m][1][j];
                    }
                    const u32x4 w = pack8(v0, v1);
                    *(u32x4*)(Z + (size_t)row * D + col0 + bj * 128) = w;
                    float q[8]; unpack8(w, q);
#pragma unroll
                    for (int j = 0; j < 8; ++j) { s1 += q[j]; s2 += q[j] * q[j]; }
                }
                put_stats(st_out, row, u.pn * 4 + wc, fq, s1, s2);
            }
    }
};
struct EpiFold {
    bf16_t* O; int ldc; const float* st_in; const float* cs; const float* bw;
    __device__ __forceinline__ void operator()(const Acc& acc, const Unit& u, int wr, int wc, int fr, int fq) const {
        const int row0 = u.pm * 256 + wr * 64 + fr, col0 = u.pn * 256 + wc * 32 + 8 * fq;
        f32x4 cv[2][2], bv[2][2];
#pragma unroll
        for (int bj = 0; bj < 2; ++bj)
#pragma unroll
            for (int n = 0; n < 2; ++n) { cv[bj][n] = *(const f32x4*)(cs + col0 + bj * 128 + 4 * n); bv[bj][n] = *(const f32x4*)(bw + col0 + bj * 128 + 4 * n); }
#pragma unroll
        for (int ai = 0; ai < 2; ++ai)
#pragma unroll
            for (int m = 0; m < 4; ++m) {
                const int row = row0 + ai * 128 + m * 16;
                float mu, rstd; row_stats(st_in, row, fq, mu, rstd);
#pragma unroll
                for (int bj = 0; bj < 2; ++bj) {
                    const f32x4 v0 = (acc[ai][bj][m][0] - mu * cv[bj][0]) * rstd + bv[bj][0], v1 = (acc[ai][bj][m][1] - mu * cv[bj][1]) * rstd + bv[bj][1];
                    *(u32x4*)(O + (size_t)row * ldc + col0 + bj * 128) = pack8(v0, v1);
                }
            }
    }
};
template <bool MOE> struct EpiGlu {
    bf16_t* O; int ldc; const float* st_in; const float* cs; const float* bw; const int* rowtab; int ncs;
    __device__ __forceinline__ void operator()(const Acc& acc, const Unit& u, int wr, int wc, int fr, int fq) const {
        const int row0 = u.pm * 256 + wr * 64 + fr, colo = u.pn * 128 + wc * 32 + 8 * fq;
        int vb = u.pn * 256 + wc * 32 + 8 * fq;
        if (MOE) vb += (int)(u.boff / (unsigned)(256 * D * 2)) * 256 - u.pn * 256;
        f32x4 cv[2][2], bv[2][2];
#pragma unroll
        for (int bj = 0; bj < 2; ++bj)
#pragma unroll
            for (int n = 0; n < 2; ++n) { cv[bj][n] = *(const f32x4*)(cs + vb + bj * 128 + 4 * n); bv[bj][n] = *(const f32x4*)(bw + vb + bj * 128 + 4 * n); }
#pragma unroll
        for (int ai = 0; ai < 2; ++ai)
#pragma unroll
            for (int m = 0; m < 4; ++m) {
                const int row = row0 + ai * 128 + m * 16;
                int srow = row;
                if (MOE) { const int id = rowtab[u.gp * 256 + (row - u.pm * 256)]; srow = id < 0 ? 0 : (id >> 1); }
                float mu, rstd; row_stats(st_in, srow, fq, mu, rstd);
                f32x4 o0, o1;
#pragma unroll
                for (int j = 0; j < 4; ++j) {
                    const float g0 = (acc[ai][0][m][0][j] - mu * cv[0][0][j]) * rstd + bv[0][0][j], g1 = (acc[ai][0][m][1][j] - mu * cv[0][1][j]) * rstd + bv[0][1][j];
                    const float u0 = (acc[ai][1][m][0][j] - mu * cv[1][0][j]) * rstd + bv[1][0][j], u1 = (acc[ai][1][m][1][j] - mu * cv[1][1][j]) * rstd + bv[1][1][j];
                    o0[j] = g0 * sigmoidf_(g0) * u0; o1[j] = g1 * sigmoidf_(g1) * u1;
                }
                *(u32x4*)(O + (size_t)row * ldc + colo) = pack8(o0, o1);
            }
    }
};
struct EpiMoeDown {
    bf16_t* Y0; bf16_t* Y1; const int* rowtab; const float* gateb;
    __device__ __forceinline__ void operator()(const Acc& acc, const Unit& u, int wr, int wc, int fr, int fq) const {
        const int r0 = wr * 64 + fr, col0 = u.pn * 256 + wc * 32 + 8 * fq;
#pragma unroll
        for (int ai = 0; ai < 2; ++ai)
#pragma unroll
            for (int m = 0; m < 4; ++m) {
                const int slot = u.gp * 256 + r0 + ai * 128 + m * 16;
                const int id = rowtab[slot]; const float gt = gateb[slot];
                if (id >= 0) { bf16_t* rowp = Y0 + (size_t)(id & 1) * (size_t)(Y1 - Y0) + (size_t)(id >> 1) * D + col0;
#pragma unroll
                    for (int bj = 0; bj < 2; ++bj) *(u32x4*)(rowp + bj * 128) = pack8(acc[ai][bj][m][0] * gt, acc[ai][bj][m][1] * gt); }
            }
    }
};
}

struct Args { const float* in[18]; float* out; unsigned char* ws; int ph_lo, ph_hi; };
constexpr int LDS_MAIN = 131072, LDS_BYTES = LDS_MAIN + 256;
enum { PH_PRO = 0, PH_PROJ, PH_MLSTM, PH_WOUT, PH_GU, PH_DN, PH_KVQ, PH_ATT, PH_WO, PH_RT1, PH_RT2, PH_MOE0, PH_FINAL = PH_MOE0 + 2 * MOE_NCHUNK, PH_COUNT };

__device__ __forceinline__ void conv_block(LAS unsigned char* lds, const float* src, int ldw, int K, bf16_t* dst, const float* g, const float* bb, float* cs, float* bw) {
    const int tid = threadIdx.x;
    const int n4 = (tid & 15) * 4, k4 = (tid >> 4) * 4;
    const int rn = tid >> 3, rs = tid & 7;
    float csp[4] = {0.f, 0.f, 0.f, 0.f}, bwp[4] = {0.f, 0.f, 0.f, 0.f};
    const int nch = K / 128;
    for (int ch = 0; ch < nch; ++ch) {
        LAS unsigned char* T = lds + (ch & 1) * (64 * 264);
        f32x4 v[4];
#pragma unroll
        for (int kk = 0; kk < 4; ++kk) v[kk] = *(const f32x4*)(src + (size_t)(ch * 128 + k4 + kk) * ldw + n4);
        float gk[4] = {1.f, 1.f, 1.f, 1.f}, bk[4] = {0.f, 0.f, 0.f, 0.f};
        if (g) {
#pragma unroll
            for (int kk = 0; kk < 4; ++kk) { gk[kk] = g[ch * 128 + k4 + kk]; bk[kk] = bb[ch * 128 + k4 + kk]; } }
#pragma unroll
        for (int j = 0; j < 4; ++j) {
            const unsigned lo = pk2(v[0][j] * gk[0], v[1][j] * gk[1]), hi = pk2(v[2][j] * gk[2], v[3][j] * gk[3]);
            *(LAS u32x2*)(T + (n4 + j) * 264 + k4 * 2) = (u32x2){lo, hi};
            csp[j] += (bflo(lo) + bfhi(lo)) + (bflo(hi) + bfhi(hi));
            bwp[j] += (v[0][j] * bk[0] + v[1][j] * bk[1]) + (v[2][j] * bk[2] + v[3][j] * bk[3]);
        }
        __syncthreads();
        u32x2 q[4];
#pragma unroll
        for (int i = 0; i < 4; ++i) q[i] = *(const LAS u32x2*)(T + rn * 264 + rs * 32 + i * 8);
        bf16_t* dp = dst + (size_t)rn * K + ch * 128 + rs * 16;
        *(u32x4*)dp = (u32x4){q[0].x, q[0].y, q[1].x, q[1].y};
        *(u32x4*)(dp + 8) = (u32x4){q[2].x, q[2].y, q[3].x, q[3].y};
    }
    __syncthreads();
    if (cs) {
        LAS float* red = (LAS float*)(lds + 2 * 64 * 264);
#pragma unroll
        for (int j = 0; j < 4; ++j) { red[(tid >> 4) * 64 + n4 + j] = csp[j]; red[2048 + (tid >> 4) * 64 + n4 + j] = bwp[j]; }
        __syncthreads();
        if (tid < 128) { const int n = tid & 63, w = tid >> 6; float s = 0.f;
            for (int i = 0; i < 32; ++i) s += red[w * 2048 + i * 64 + n];
            (w ? bw : cs)[n] = s; }
        __syncthreads();
    }
}
__device__ __forceinline__ void prologue_phase(LAS unsigned char* lds, const Args& a) {
    unsigned char* ws = a.ws;
    const float* ln_g = a.in[16]; const float* ln_b = a.in[17];
    float* vec = (float*)(ws + WS_VEC);
    const int G = gridDim.x;
    for (int blk = blockIdx.x; blk < 1256; blk += G) {
        int j = blk;
        if (j < 128) { const int e = j >> 4, jj = j & 15;
            conv_block(lds, a.in[15] + (size_t)e * FFE * D + 64 * jj, D, FFE, (bf16_t*)(ws + WS_WEDN) + ((size_t)e * D + 64 * jj) * FFE, nullptr, nullptr, nullptr, nullptr); continue; }
        j -= 128;
        if (j < 16) { conv_block(lds, a.in[11] + 64 * j, D, FFD, (bf16_t*)(ws + WS_WDN) + (size_t)(64 * j) * FFD, nullptr, nullptr, nullptr, nullptr); continue; }
        j -= 16;
        if (j < 48) { conv_block(lds, a.in[2] + 64 * j, 3080, D, (bf16_t*)(ws + WS_WIN) + (size_t)(64 * j) * D, nullptr, nullptr, nullptr, nullptr); continue; }
        j -= 48;
        if (j < 16) { conv_block(lds, a.in[5] + 64 * j, D, D, (bf16_t*)(ws + WS_WOUT) + (size_t)(64 * j) * D, nullptr, nullptr, nullptr, nullptr); continue; }
        j -= 16;
        if (j < 88) { const int t = j >> 2, q = j & 3;
            conv_block(lds, (q < 2 ? a.in[9] : a.in[10]) + 128 * t + 64 * (q & 1), FFD, D, (bf16_t*)(ws + WS_WGU) + (size_t)(64 * j) * D, ln_g, ln_b, vec + VEC_GU_CS + 64 * j, vec + VEC_GU_BW + 64 * j); continue; }
        j -= 88;
        if (j < 48) { const float* src = j < 32 ? a.in[6] + 64 * j : a.in[7] + 64 * (j - 32);
            conv_block(lds, src, j < 32 ? 2048 : 1024, D, (bf16_t*)(ws + WS_WKVQ) + (size_t)(64 * j) * D, ln_g + 1024, ln_b + 1024, vec + VEC_KVQ_CS + 64 * j, vec + VEC_KVQ_BW + 64 * j); continue; }
        j -= 48;
        if (j < 16) { conv_block(lds, a.in[8] + 64 * j, D, D, (bf16_t*)(ws + WS_WO) + (size_t)(64 * j) * D, nullptr, nullptr, nullptr, nullptr); continue; }
        j -= 16;
        { const int e = j / 112, jj = j % 112, t = jj >> 2, q = jj & 3;
            conv_block(lds, (q < 2 ? a.in[13] : a.in[14]) + (size_t)e * D * FFE + 128 * t + 64 * (q & 1), FFE, D, (bf16_t*)(ws + WS_WEGU) + ((size_t)e * 2 * FFE + 64 * jj) * D,
                       ln_g + 2048, ln_b + 2048, vec + VEC_EGU_CS + e * 2 * FFE + 64 * jj, vec + VEC_EGU_BW + e * 2 * FFE + 64 * jj); }
    }
    {
        const int tid = threadIdx.x, lane = tid & 63, wid = tid >> 6;
        LAS float* wg = (LAS float*)lds;
        __syncthreads();
        const float* w_in = a.in[2];
        for (int i = tid; i < 8192; i += NTHREADS) { const int k = i >> 3, e = i & 7; wg[e * 1024 + k] = w_in[(size_t)k * 3080 + 3072 + e]; }
        __syncthreads();
        bf16_t* H0 = (bf16_t*)(ws + WS_RB); float* gates = (float*)(ws + WS_GATES);
        const float bg = a.in[3][lane & 7];
        for (int row = blockIdx.x * 8 + wid; row < NROWS; row += G * 8) {
            const float* src = row < NR ? a.in[0] + (size_t)row * D : a.in[1] + (size_t)((row - NR) & 15) * D;
            float acc[8] = {0.f, 0.f, 0.f, 0.f, 0.f, 0.f, 0.f, 0.f};
#pragma unroll
            for (int i = 0; i < 4; ++i) {
                const int k = i * 256 + lane * 4;
                const f32x4 v = *(const f32x4*)(src + k);
                *(u32x2*)(H0 + (size_t)row * D + k) = (u32x2){pk2(v[0], v[1]), pk2(v[2], v[3])};
#pragma unroll
                for (int e = 0; e < 8; ++e) { const f32x4 w = *(const LAS f32x4*)(wg + e * 1024 + k); acc[e] += (v[0] * w[0] + v[1] * w[1]) + (v[2] * w[2] + v[3] * w[3]); }
            }
#pragma unroll
            for (int e = 0; e < 8; ++e) acc[e] = wave_sum(acc[e]);
            float mine = acc[0];
#pragma unroll
            for (int e = 1; e < 8; ++e) mine = ((lane & 7) == e) ? acc[e] : mine;
            if (lane < 8) gates[(size_t)row * 8 + lane] = mine + bg;
        }
        __syncthreads();
    }
}

__device__ __forceinline__ float logsigmoid_(float x) { return fminf(x, 0.f) - log1pf(expf(-fabsf(x))); }
__device__ __forceinline__ bf16x8 pack_frag(const f32x16& x, int s) {
    u32x4 p; p.x = pk2(x[8 * s], x[8 * s + 1]); p.y = pk2(x[8 * s + 2], x[8 * s + 3]); p.z = pk2(x[8 * s + 4], x[8 * s + 5]); p.w = pk2(x[8 * s + 6], x[8 * s + 7]);
    return __builtin_bit_cast(bf16x8, p);
}
__device__ __forceinline__ bf16x8 ld2x64(const LAS unsigned char* p0, const LAS unsigned char* p1) {
    const u32x2 a = *(const LAS u32x2*)p0, b = *(const LAS u32x2*)p1; u32x4 r = {a.x, a.y, b.x, b.y}; return __builtin_bit_cast(bf16x8, r);
}
__device__ __forceinline__ void tr4x4(const u32x2 (&r)[4], u32x2 (&c)[4]) {
    c[0] = (u32x2){(r[0].x & 0xffffu) | (r[1].x << 16), (r[2].x & 0xffffu) | (r[3].x << 16)};
    c[1] = (u32x2){(r[0].x >> 16) | (r[1].x & 0xffff0000u), (r[2].x >> 16) | (r[3].x & 0xffff0000u)};
    c[2] = (u32x2){(r[0].y & 0xffffu) | (r[1].y << 16), (r[2].y & 0xffffu) | (r[3].y << 16)};
    c[3] = (u32x2){(r[0].y >> 16) | (r[1].y & 0xffff0000u), (r[2].y >> 16) | (r[3].y & 0xffff0000u)};
}
constexpr int ML_QS = 0, ML_KS = 17408, ML_PS = 34816, ML_VT = 44032, ML_KT = 78848, ML_SC = 96256;
__device__ __forceinline__ void mlstm_phase(LAS unsigned char* lds, const bf16_t* qkvo, const float* gates, const float* normg, bf16_t* hn, int unit) {
    const int tid = threadIdx.x, lane = tid & 63, wid = __builtin_amdgcn_readfirstlane(tid >> 6);
    const int b = unit >> 2, h = unit & 3;
    const int r32 = lane & 31, hh = lane >> 5, l15 = lane & 15, l4 = lane >> 4;
    LAS float* sc = (LAS float*)(lds + ML_SC);
    LAS float* Hs = (LAS float*)lds;
    const int q_row = tid >> 4, q_col = (tid & 15) * 8;
    const int k_dk = (16 * (wid & 1) + l15) * 4, k_s = (4 * (wid >> 1) + l4) * 4;
    const int v_dv = (16 * (wid & 3) + l15) * 4, v_s0 = (4 * (wid >> 2) + l4) * 4;
    f32x16 Cacc[4];
#pragma unroll
    for (int i = 0; i < 4; ++i)
#pragma unroll
        for (int j = 0; j < 16; ++j) Cacc[i][j] = 0.f;
    if (tid < 128) sc[192 + tid] = 0.f;
    float m_run = 0.f;
    u32x4 qreg[2]; u32x2 kreg[4], vreg[2][4]; float g_li = 0.f, g_lf = 0.f;
#define rowof(c, t) ((c) == 0 ? (NR + b * 16 + ((t) - 48)) : (b * SEQ + 64 * ((c) - 1) + (t)))
#define ML_PREFETCH(c) do { \
        _Pragma("unroll") for (int p = 0; p < 2; ++p) { const int t = q_row + 32 * p; const bool pad = ((c) == 0 && t < 48); \
            qreg[p] = pad ? (u32x4){0u, 0u, 0u, 0u} : *(const u32x4*)(qkvo + (size_t)rowof((c), t) * NPROJ + h * 128 + q_col); } \
        _Pragma("unroll") for (int kk = 0; kk < 4; ++kk) { const int t = k_s + kk; const bool pad = ((c) == 0 && t < 48); \
            kreg[kk] = pad ? (u32x2){0u, 0u} : *(const u32x2*)(qkvo + (size_t)rowof((c), t) * NPROJ + 512 + h * 128 + k_dk); } \
        _Pragma("unroll") for (int p = 0; p < 2; ++p) _Pragma("unroll") for (int kk = 0; kk < 4; ++kk) { const int t = v_s0 + 32 * p + kk; const bool pad = ((c) == 0 && t < 48); \
            vreg[p][kk] = pad ? (u32x2){0u, 0u} : *(const u32x2*)(qkvo + (size_t)rowof((c), t) * NPROJ + 1024 + h * 256 + v_dv); } \
        { const bool pad = ((c) == 0 && lane < 48); g_li = pad ? -1e30f : gates[(size_t)rowof((c), lane) * 8 + h]; g_lf = pad ? 1e30f : gates[(size_t)rowof((c), lane) * 8 + 4 + h]; } } while (0)
    ML_PREFETCH(0);
    for (int c = 0; c < 65; ++c) {
        const float li = g_li;
        const float lf = (g_lf > 1e29f) ? 0.f : logsigmoid_(g_lf);
        float bc = lf;
#pragma unroll
        for (int o = 1; o < 64; o <<= 1) { const float y = __shfl_up(bc, o); if (lane >= o) bc += y; }
        const float av = li - bc;
        float um = av;
#pragma unroll
        for (int o = 1; o < 64; o <<= 1) { const float y = __shfl_up(um, o); if (lane >= o) um = fmaxf(um, y); }
        const float Mt = fmaxf(m_run, um);
        const float winter = __expf(m_run - Mt), bmt = bc + Mt;
        const float M63 = __shfl(Mt, 63), b63 = __shfl(bc, 63);
        const float wlast = __expf(av - M63), decay = __expf(m_run - M63);
#pragma unroll
        for (int p = 0; p < 2; ++p) *(LAS u32x4*)(lds + ML_QS + (q_row + 32 * p) * 272 + q_col * 2) = qreg[p];
        {
            u32x2 kw[4];
#pragma unroll
            for (int kk = 0; kk < 4; ++kk) {
                *(LAS u32x2*)(lds + ML_KS + (k_s + kk) * 272 + k_dk * 2) = kreg[kk];
                const float w = __shfl(wlast, k_s + kk) * 0.08838834764831845f;
                kw[kk] = (u32x2){pk2(bflo(kreg[kk].x) * w, bfhi(kreg[kk].x) * w), pk2(bflo(kreg[kk].y) * w, bfhi(kreg[kk].y) * w)};
            }
            u32x2 kc[4]; tr4x4(kw, kc);
#pragma unroll
            for (int j = 0; j < 4; ++j) *(LAS u32x2*)(lds + ML_KT + (k_dk + j) * 136 + k_s * 2) = kc[j];
        }
#pragma unroll
        for (int p = 0; p < 2; ++p) { u32x2 vc[4]; tr4x4(vreg[p], vc);
#pragma unroll
            for (int j = 0; j < 4; ++j) *(LAS u32x2*)(lds + ML_VT + (v_dv + j) * 136 + (v_s0 + 32 * p) * 2) = vc[j]; }
        if (wid == 0) { sc[lane] = winter; sc[128 + lane] = bmt; }
        __syncthreads();
        if (c + 1 < 65) ML_PREFETCH(c + 1);
        {
            const int ti = wid >> 1;
#pragma unroll
            for (int q = 0; q < 2; ++q) {
                const int si = 2 * (wid & 1) + q;
                f32x4 sa = {0.f, 0.f, 0.f, 0.f};
                if (si <= ti) {
#pragma unroll
                    for (int ks = 0; ks < 4; ++ks) {
                        const bf16x8 af = *(const LAS bf16x8*)(lds + ML_QS + (16 * ti + l15) * 272 + (32 * ks + 8 * l4) * 2);
                        const bf16x8 bfr = *(const LAS bf16x8*)(lds + ML_KS + (16 * si + l15) * 272 + (32 * ks + 8 * l4) * 2);
                        sa = __builtin_amdgcn_mfma_f32_16x16x32_bf16(af, bfr, sa, 0, 0, 0);
                    }
                }
                const int s = 16 * si + l15;
                const float a_s = __shfl(av, s);
#pragma unroll
                for (int r = 0; r < 4; ++r) {
                    const int t = 16 * ti + 4 * l4 + r;
                    const float Mtt = __shfl(Mt, t);
                    const float w = (s <= t) ? __expf(a_s - Mtt) : 0.f;
                    *(LAS bf16_t*)(lds + ML_PS + t * 144 + s * 2) = f2bf(sa[r] * 0.08838834764831845f * w);
                }
            }
        }
        bf16x8 vf[4];
#pragma unroll
        for (int ks = 0; ks < 4; ++ks) { const LAS unsigned char* p = lds + ML_VT + (32 * wid + r32) * 136 + (16 * ks + 8 * hh) * 2; vf[ks] = ld2x64(p, p + 8); }
        __syncthreads();
        {
            const int t = tid >> 3, part = tid & 7;
            float qn = 0.f, ps = 0.f;
            const u32x4 q0 = *(const LAS u32x4*)(lds + ML_QS + t * 272 + part * 32), q1 = *(const LAS u32x4*)(lds + ML_QS + t * 272 + part * 32 + 16);
            float qv[16]; { float t8[8]; g8::unpack8(q0, t8);
#pragma unroll
                for (int j = 0; j < 8; ++j) qv[j] = t8[j]; g8::unpack8(q1, t8);
#pragma unroll
                for (int j = 0; j < 8; ++j) qv[8 + j] = t8[j]; }
#pragma unroll
            for (int j = 0; j < 16; ++j) qn += qv[j] * sc[192 + part * 16 + j];
            const u32x4 pw = *(const LAS u32x4*)(lds + ML_PS + t * 144 + part * 16);
            float pv[8]; g8::unpack8(pw, pv);
#pragma unroll
            for (int j = 0; j < 8; ++j) ps += pv[j];
            qn += __shfl_xor(qn, 1); qn += __shfl_xor(qn, 2); qn += __shfl_xor(qn, 4);
            ps += __shfl_xor(ps, 1); ps += __shfl_xor(ps, 2); ps += __shfl_xor(ps, 4);
            if (part == 0) { const float den = sc[t] * qn + ps; sc[64 + t] = 1.0f / fmaxf(fabsf(den), __expf(-sc[128 + t])); }
        }
        f32x16 num[2];
#pragma unroll
        for (int tt = 0; tt < 2; ++tt) {
#pragma unroll
            for (int j = 0; j < 16; ++j) num[tt][j] = 0.f;
#pragma unroll
            for (int dkt = 0; dkt < 4; ++dkt)
#pragma unroll
                for (int s2 = 0; s2 < 2; ++s2) {
                    const LAS unsigned char* p = lds + ML_QS + (32 * tt + r32) * 272 + (32 * dkt + 16 * s2 + 4 * hh) * 2;
                    const bf16x8 af = ld2x64(p, p + 16);
                    num[tt] = __builtin_amdgcn_mfma_f32_32x32x16_bf16(af, pack_frag(Cacc[dkt], s2), num[tt], 0, 0, 0);
                }
#pragma unroll
            for (int gq = 0; gq < 4; ++gq) { const f32x4 wv = *(const LAS f32x4*)(sc + 32 * tt + 8 * gq + 4 * hh);
#pragma unroll
                for (int r = 0; r < 4; ++r) num[tt][4 * gq + r] *= wv[r]; }
#pragma unroll
            for (int ks = 0; ks < 4; ++ks) {
                if (tt == 0 && ks >= 2) continue;
                const bf16x8 pf = *(const LAS bf16x8*)(lds + ML_PS + (32 * tt + r32) * 144 + (16 * ks + 8 * hh) * 2);
                num[tt] = __builtin_amdgcn_mfma_f32_32x32x16_bf16(pf, vf[ks], num[tt], 0, 0, 0);
            }
        }
        __syncthreads();
#pragma unroll
        for (int tt = 0; tt < 2; ++tt)
#pragma unroll
            for (int gq = 0; gq < 4; ++gq) { const f32x4 iv = *(const LAS f32x4*)(sc + 64 + 32 * tt + 8 * gq + 4 * hh);
#pragma unroll
                for (int r = 0; r < 4; ++r) Hs[(32 * tt + 8 * gq + 4 * hh + r) * 260 + 32 * wid + r32] = num[tt][4 * gq + r] * iv[r]; }
        __syncthreads();
        {
            const int t = tid >> 3, part = tid & 7;
            f32x4 x[8]; float s1 = 0.f;
#pragma unroll
            for (int i = 0; i < 8; ++i) { x[i] = *(const LAS f32x4*)(Hs + t * 260 + 32 * i + 4 * part); s1 += (x[i][0] + x[i][1]) + (x[i][2] + x[i][3]); }
            s1 += __shfl_xor(s1, 1); s1 += __shfl_xor(s1, 2); s1 += __shfl_xor(s1, 4);
            const float mean = s1 * (1.0f / 256.0f); float s2 = 0.f;
#pragma unroll
            for (int i = 0; i < 8; ++i) { const f32x4 d = x[i] - mean; s2 += (d[0] * d[0] + d[1] * d[1]) + (d[2] * d[2] + d[3] * d[3]); }
            s2 += __shfl_xor(s2, 1); s2 += __shfl_xor(s2, 2); s2 += __shfl_xor(s2, 4);
            const float rstd = rsqrtf(s2 * (1.0f / 256.0f) + LN_EPS);
            if (!(c == 0 && t < 48)) {
                const size_t row = (size_t)rowof(c, t);
#pragma unroll
                for (int i = 0; i < 8; ++i) {
                    const int dv = 32 * i + 4 * part;
                    const u32x2 ow = *(const u32x2*)(qkvo + row * NPROJ + 2048 + h * 256 + dv);
                    const f32x4 ng = *(const f32x4*)(normg + h * 256 + dv);
                    const float o0 = sigmoidf_(bflo(ow.x)), o1 = sigmoidf_(bfhi(ow.x)), o2 = sigmoidf_(bflo(ow.y)), o3 = sigmoidf_(bfhi(ow.y));
                    const f32x4 y = (x[i] - mean) * rstd * ng;
                    *(u32x2*)(hn + row * D + h * 256 + dv) = (u32x2){pk2(y[0] * o0, y[1] * o1), pk2(y[2] * o2, y[3] * o3)};
                }
            }
        }
#pragma unroll
        for (int dkt = 0; dkt < 4; ++dkt) {
#pragma unroll
            for (int j = 0; j < 16; ++j) Cacc[dkt][j] *= decay;
#pragma unroll
            for (int ks = 0; ks < 4; ++ks) { const LAS unsigned char* p = lds + ML_KT + (32 * dkt + r32) * 136 + (16 * ks + 8 * hh) * 2;
                Cacc[dkt] = __builtin_amdgcn_mfma_f32_32x32x16_bf16(ld2x64(p, p + 8), vf[ks], Cacc[dkt], 0, 0, 0); }
        }
        {
            const int dk = tid >> 2, part = tid & 3;
            const u32x2 k0 = *(const LAS u32x2*)(lds + ML_KT + dk * 136 + part * 32), k1 = *(const LAS u32x2*)(lds + ML_KT + dk * 136 + part * 32 + 8),
                        k2 = *(const LAS u32x2*)(lds + ML_KT + dk * 136 + part * 32 + 16), k3 = *(const LAS u32x2*)(lds + ML_KT + dk * 136 + part * 32 + 24);
            float s = ((bflo(k0.x) + bfhi(k0.x)) + (bflo(k0.y) + bfhi(k0.y))) + ((bflo(k1.x) + bfhi(k1.x)) + (bflo(k1.y) + bfhi(k1.y)))
                    + ((bflo(k2.x) + bfhi(k2.x)) + (bflo(k2.y) + bfhi(k2.y))) + ((bflo(k3.x) + bfhi(k3.x)) + (bflo(k3.y) + bfhi(k3.y)));
            s += __shfl_xor(s, 1); s += __shfl_xor(s, 2);
            if (part == 0) sc[192 + dk] = decay * sc[192 + dk] + s;
        }
        m_run = b63 + M63;
        __syncthreads();
    }
#undef ML_PREFETCH
#undef rowof
}

constexpr int AT_K0 = 0, AT_V0 = 17408, AT_BUF = 34816, AT_FLAGS = 2 * AT_BUF;
__device__ __forceinline__ void attn_phase(LAS unsigned char* lds, const bf16_t* kvq, bf16_t* ao) {
    const int tid = threadIdx.x, lane = tid & 63, wid = __builtin_amdgcn_readfirstlane(tid >> 6);
    const int r32 = lane & 31, hh = lane >> 5, l15 = lane & 15, l4 = lane >> 4;
    LAS unsigned* flags = (LAS unsigned*)(lds + AT_FLAGS);
    const int k_row = tid >> 4, k_col = (tid & 15) * 8;
    const int v_d = (16 * (wid & 1) + l15) * 4, v_s = (4 * (wid >> 1) + l4) * 4;
    for (int unit = blockIdx.x; unit < NB * 8 * 16; unit += gridDim.x) {
        const int qt = unit & 15, head = (unit >> 4) & 7, b = unit >> 7;
        const int q0 = 128 + 256 * qt, tmin = q0 + 32 * wid;
#define rowofp(p) ((p) >= 128 ? b * SEQ + (p) - 128 : ((p) >= 112 ? NR + b * 16 + (p) - 112 : NR + b * 16))
        bf16x8 qf[8];
        { const bf16_t* qp = kvq + (size_t)(b * SEQ + tmin - 128 + r32) * NPROJ + 2048 + head * 128 + 8 * hh;
#pragma unroll
            for (int ks = 0; ks < 8; ++ks) qf[ks] = *(const bf16x8*)(qp + 16 * ks); }
        f32x16 O[4];
#pragma unroll
        for (int i = 0; i < 4; ++i)
#pragma unroll
            for (int j = 0; j < 16; ++j) O[i][j] = 0.f;
        float P = 1.0f;
        const int kt_hi = (q0 >> 6) + 3;
        u32x4 kreg[2]; u32x2 vreg[4];
#define AT_LOAD(kt) do { \
        _Pragma("unroll") for (int p = 0; p < 2; ++p) kreg[p] = *(const u32x4*)(kvq + (size_t)rowofp(64 * (kt) + k_row + 32 * p) * NPROJ + head * 128 + k_col); \
        _Pragma("unroll") for (int kk = 0; kk < 4; ++kk) vreg[kk] = *(const u32x2*)(kvq + (size_t)rowofp(64 * (kt) + v_s + kk) * NPROJ + 1024 + head * 128 + v_d); } while (0)
#define AT_STORE(buf) do { LAS unsigned char* base = lds + (buf) * AT_BUF; \
        _Pragma("unroll") for (int p = 0; p < 2; ++p) *(LAS u32x4*)(base + AT_K0 + (k_row + 32 * p) * 272 + k_col * 2) = kreg[p]; \
        u32x2 vc[4]; tr4x4(vreg, vc); \
        _Pragma("unroll") for (int j = 0; j < 4; ++j) *(LAS u32x2*)(base + AT_V0 + (v_d + j) * 136 + v_s * 2) = vc[j]; } while (0)
        if (tid < 80) flags[tid] = 0u;
        AT_LOAD(kt_hi);
        AT_STORE(0);
        for (int it = 0; ; ++it) {
            const int kt = kt_hi - it;
            __syncthreads();
            if (it > 0 && flags[it - 1] == 0u) break;
            const bool more = (kt > 1);
            if (more) AT_LOAD(kt - 1);
            const int k0 = 64 * kt;
            if (k0 < tmin + 31) {
                const LAS unsigned char* Kb = lds + (it & 1) * AT_BUF + AT_K0; const LAS unsigned char* Vb = lds + (it & 1) * AT_BUF + AT_V0;
                f32x16 S[2];
#pragma unroll
                for (int u = 0; u < 2; ++u) {
#pragma unroll
                    for (int j = 0; j < 16; ++j) S[u][j] = 0.f;
#pragma unroll
                    for (int ks = 0; ks < 8; ++ks) {
                        const bf16x8 kf = *(const LAS bf16x8*)(Kb + (32 * u + r32) * 272 + (16 * ks + 8 * hh) * 2);
                        S[u] = __builtin_amdgcn_mfma_f32_32x32x16_bf16(kf, qf[ks], S[u], 0, 0, 0);
                    }
                }
                const bool full = (k0 + 63 < tmin) && (k0 >= 128);
                const int tq = tmin + r32;
                float xs[2][16], T[2][4];
#pragma unroll
                for (int u = 0; u < 2; ++u)
#pragma unroll
                    for (int gq = 0; gq < 4; ++gq) {
                        float x4[4];
#pragma unroll
                        for (int r = 0; r < 4; ++r) {
                            const float zz = fminf(S[u][4 * gq + r] * (0.08838834764831845f * 1.4426950408889634f), 110.f);
                            const float e = __builtin_amdgcn_exp2f(zz);
                            const float rc = __builtin_amdgcn_rcpf(1.0f + e);
                            float beta = e * rc, x = rc;
                            if (!full) { const int sp = k0 + 32 * u + 8 * gq + 4 * hh + r; const bool valid = (sp < tq) && (sp >= 112); beta = valid ? beta : 0.f; x = valid ? x : 1.f; }
                            S[u][4 * gq + r] = beta; x4[r] = x;
                        }
                        const float e2 = x4[3], e1 = e2 * x4[2], e0 = e1 * x4[1];
                        xs[u][4 * gq + 3] = 1.f; xs[u][4 * gq + 2] = e2; xs[u][4 * gq + 1] = e1; xs[u][4 * gq + 0] = e0;
                        T[u][gq] = e0 * x4[0];
                    }
                float acc = P;
#pragma unroll
                for (int u = 1; u >= 0; --u)
#pragma unroll
                    for (int gq = 3; gq >= 0; --gq) {
                        const float Tp = __shfl_xor(T[u][gq], 32);
                        const float t1 = hh ? T[u][gq] : Tp, t0 = hh ? Tp : T[u][gq];
                        const float Rr = hh ? acc : acc * t1;
                        acc = (acc * t1) * t0;
#pragma unroll
                        for (int r = 0; r < 4; ++r) S[u][4 * gq + r] = S[u][4 * gq + r] * (xs[u][4 * gq + r] * Rr);
                    }
                P = acc;
#pragma unroll
                for (int u = 0; u < 2; ++u)
#pragma unroll
                    for (int s2 = 0; s2 < 2; ++s2) {
                        const bf16x8 af = pack_frag(S[u], s2);
#pragma unroll
                        for (int dt = 0; dt < 4; ++dt) {
                            const LAS unsigned char* p = Vb + (32 * dt + r32) * 136 + (32 * u + 16 * s2 + 4 * hh) * 2;
                            O[dt] = __builtin_amdgcn_mfma_f32_32x32x16_bf16(af, ld2x64(p, p + 16), O[dt], 0, 0, 0);
                        }
                    }
            }
            if (__ballot(P >= 1e-30f) != 0ull && lane == 0) flags[it] = 1u;
            if (!more) break;
            AT_STORE((it + 1) & 1);
        }
#pragma unroll
        for (int dt = 0; dt < 4; ++dt)
#pragma unroll
            for (int j = 0; j < 16; ++j) {
                const int t = tmin + (j & 3) + 8 * (j >> 2) + 4 * hh;
                ao[(size_t)(b * SEQ + t - 128) * D + head * 128 + 32 * dt + r32] = f2bf(O[dt][j]);
            }
        __syncthreads();
    }
#undef AT_LOAD
#undef AT_STORE
#undef rowofp
}

__device__ __forceinline__ void ln_row_stats_wave(const float* st, int row, int lane, float& mu, float& rstd) {
    const f32x2 p = *(const f32x2*)(st + (size_t)row * 32 + (lane & 15) * 2);
    float s1 = p[0], s2 = p[1];
#pragma unroll
    for (int o = 1; o < 16; o <<= 1) { s1 += __shfl_xor(s1, o); s2 += __shfl_xor(s2, o); }
    mu = s1 * (1.0f / 1024.0f); const float var = fmaxf(s2 * (1.0f / 1024.0f) - mu * mu, 0.f); rstd = rsqrtf(var + LN_EPS);
}
__device__ __forceinline__ void router1_phase(LAS unsigned char* lds, const Args& a) {
    const int tid = threadIdx.x, lane = tid & 63, wid = tid >> 6;
    unsigned char* ws = a.ws;
    const float* g3 = a.in[16] + 2048; const float* b3 = a.in[17] + 2048; const float* wr = a.in[12];
    LAS float* gw = (LAS float*)lds;
    LAS float* cc = (LAS float*)(lds + 32768);
    LAS int* cnt = (LAS int*)(lds + 32768 + 64);
    __syncthreads();
    for (int i = tid; i < 8192; i += NTHREADS) { const int k = i >> 3, e = i & 7; gw[e * 1024 + k] = g3[k] * wr[i]; }
    if (tid < 8) cnt[tid] = 0;
    __syncthreads();
    { float s1 = 0.f, s2 = 0.f;
        for (int k = lane; k < 1024; k += 64) { s1 += gw[wid * 1024 + k]; s2 += b3[k] * wr[k * 8 + wid]; }
        s1 = wave_sum(s1); s2 = wave_sum(s2);
        if (lane == 0) { cc[wid] = s1; cc[8 + wid] = s2; } }
    __syncthreads();
    const bf16_t* z3 = (const bf16_t*)(ws + WS_RC); const float* st3 = (const float*)(ws + WS_ST3);
    f32x4* route = (f32x4*)(ws + WS_ROUTE);
    const int tok0 = (int)(((long)NR * blockIdx.x) / gridDim.x), tok1 = (int)(((long)NR * (blockIdx.x + 1)) / gridDim.x);
    for (int tok = tok0 + wid; tok < tok1; tok += 8) {
        float mu, rstd; ln_row_stats_wave(st3, tok, lane, mu, rstd);
        float acc[8] = {0.f, 0.f, 0.f, 0.f, 0.f, 0.f, 0.f, 0.f};
#pragma unroll
        for (int hf = 0; hf < 2; ++hf) {
            const int k = hf * 512 + lane * 8;
            float z[8]; g8::unpack8(*(const u32x4*)(z3 + (size_t)tok * D + k), z);
#pragma unroll
            for (int e = 0; e < 8; ++e) { const f32x4 w0 = *(const LAS f32x4*)(gw + e * 1024 + k), w1 = *(const LAS f32x4*)(gw + e * 1024 + k + 4);
                acc[e] += ((z[0] * w0[0] + z[1] * w0[1]) + (z[2] * w0[2] + z[3] * w0[3])) + ((z[4] * w1[0] + z[5] * w1[1]) + (z[6] * w1[2] + z[7] * w1[3])); }
        }
        float lg[8];
#pragma unroll
        for (int e = 0; e < 8; ++e) lg[e] = rstd * (wave_sum(acc[e]) - mu * cc[e]) + cc[8 + e];
        int e1 = 0; float v1 = lg[0];
#pragma unroll
        for (int e = 1; e < 8; ++e) if (lg[e] > v1) { v1 = lg[e]; e1 = e; }
        int e2 = -1; float v2 = -3.0e38f;
#pragma unroll
        for (int e = 0; e < 8; ++e) if (e != e1 && lg[e] > v2) { v2 = lg[e]; e2 = e; }
        const float g1 = 1.0f / (1.0f + expf(v2 - v1));
        if (lane == 0) { route[tok] = (f32x4){__int_as_float(e1 | (e2 << 8)), g1, 1.0f - g1, 0.f}; __hip_atomic_fetch_add(&cnt[e1], 1, __ATOMIC_RELAXED, __HIP_MEMORY_SCOPE_WORKGROUP); __hip_atomic_fetch_add(&cnt[e2], 1, __ATOMIC_RELAXED, __HIP_MEMORY_SCOPE_WORKGROUP); }
    }
    __syncthreads();
    if (tid < 8) ((int*)(ws + WS_CNT))[blockIdx.x * 8 + tid] = cnt[tid];
}
__device__ __forceinline__ void router2_phase(LAS unsigned char* lds, const Args& a) {
    const int tid = threadIdx.x, lane = tid & 63, wid = tid >> 6;
    unsigned char* ws = a.ws;
    const int G = gridDim.x, wg = blockIdx.x;
    LAS int* cn = (LAS int*)lds;
    LAS int* tot = (LAS int*)(lds + 16384);
    __syncthreads();
    const int* cnts = (const int*)(ws + WS_CNT);
    for (int i = tid; i < G * 8; i += NTHREADS) cn[i] = cnts[i];
    __syncthreads();
    { int t = 0, p = 0;
        for (int w = lane; w < G; w += 64) { const int v = cn[w * 8 + wid]; t += v; p += (w < wg) ? v : 0; }
#pragma unroll
        for (int o = 32; o >= 1; o >>= 1) { t += __shfl_xor(t, o); p += __shfl_xor(p, o); }
        if (lane == 0) { tot[wid] = t; tot[8 + wid] = p; } }
    __syncthreads();
    if (tid == 0) { int ps = 0;
        for (int e = 0; e < 8; ++e) { tot[24 + e] = ps; tot[16 + e] = ps + tot[8 + e]; ps += ((tot[e] + 255) >> 8) << 8; }
        if (wg == 0) { int* hdr = (int*)(ws + WS_HDR); int pp = 0; for (int e = 0; e < 8; ++e) { pp += (tot[e] + 255) >> 8; hdr[e] = pp; } hdr[8] = pp; } }
    __syncthreads();
    int* tokb = (int*)(ws + WS_TOK); float* gateb = (float*)(ws + WS_GATEB);
    const f32x4* route = (const f32x4*)(ws + WS_ROUTE);
    const int tok0 = (int)(((long)NR * wg) / G), tok1 = (int)(((long)NR * (wg + 1)) / G);
    { const int e = wid; int run = tot[16 + e];
        for (int q0 = 2 * tok0; q0 < 2 * tok1; q0 += 64) {
            const int q = q0 + lane; bool match = false; float gt = 0.f;
            if (q < 2 * tok1) { const f32x4 r = route[q >> 1]; const int ee = __float_as_int(r[0]); const int ex = (q & 1) ? ((ee >> 8) & 0xff) : (ee & 0xff); match = (ex == e); gt = (q & 1) ? r[2] : r[1]; }
            const unsigned long long mask = __ballot(match);
            const int pos = __popcll(mask & ((1ull << lane) - 1ull));
            if (match) { tokb[run + pos] = q; gateb[run + pos] = gt; }
            run += __popcll(mask);
        }
        if (wg == 0) { const int s0 = tot[24 + e] + tot[e], s1 = tot[24 + e] + (((tot[e] + 255) >> 8) << 8);
            for (int s = s0 + lane; s < s1; s += 64) { tokb[s] = -1; gateb[s] = 0.f; } }
    }
}

__device__ __forceinline__ void final_phase(const Args& a) {
    const int tid = threadIdx.x, lane = tid & 63, wid = tid >> 6;
    unsigned char* ws = a.ws;
    const bf16_t* z3 = (const bf16_t*)(ws + WS_RC); const float* st3 = (const float*)(ws + WS_ST3);
    const bf16_t* Y0 = (const bf16_t*)(ws + WS_RB); const bf16_t* Y1 = (const bf16_t*)(ws + WS_RD);
    const float* g3 = a.in[16] + 2048; const float* b3 = a.in[17] + 2048; const float* g4 = a.in[16] + 3072; const float* b4 = a.in[17] + 3072;
    for (int tok = blockIdx.x * 8 + wid; tok < NR; tok += gridDim.x * 8) {
        float mu, rstd; ln_row_stats_wave(st3, tok, lane, mu, rstd);
        float v[16]; float s1 = 0.f;
#pragma unroll
        for (int hf = 0; hf < 2; ++hf) {
            const int k = hf * 512 + lane * 8;
            float z[8], y0[8], y1[8];
            g8::unpack8(*(const u32x4*)(z3 + (size_t)tok * D + k), z); g8::unpack8(*(const u32x4*)(Y0 + (size_t)tok * D + k), y0); g8::unpack8(*(const u32x4*)(Y1 + (size_t)tok * D + k), y1);
            const f32x4 ga = *(const f32x4*)(g3 + k), gb = *(const f32x4*)(g3 + k + 4), ba = *(const f32x4*)(b3 + k), bb = *(const f32x4*)(b3 + k + 4);
#pragma unroll
            for (int j = 0; j < 8; ++j) { const float gg = j < 4 ? ga[j] : gb[j - 4], bq = j < 4 ? ba[j] : bb[j - 4];
                const float x = ALPHA * ((z[j] - mu) * rstd * gg + bq) + (y0[j] + y1[j]); v[hf * 8 + j] = x; s1 += x; }
        }
        s1 = wave_sum(s1); const float mean = s1 * (1.0f / 1024.0f); float s2 = 0.f;
#pragma unroll
        for (int j = 0; j < 16; ++j) { const float d = v[j] - mean; s2 += d * d; }
        s2 = wave_sum(s2); const float rs = rsqrtf(s2 * (1.0f / 1024.0f) + LN_EPS);
#pragma unroll
        for (int hf = 0; hf < 2; ++hf) {
            const int k = hf * 512 + lane * 8;
            const f32x4 ga = *(const f32x4*)(g4 + k), gb = *(const f32x4*)(g4 + k + 4), ba = *(const f32x4*)(b4 + k), bb = *(const f32x4*)(b4 + k + 4);
            f32x4 o0, o1;
#pragma unroll
            for (int j = 0; j < 4; ++j) { o0[j] = (v[hf * 8 + j] - mean) * rs * ga[j] + ba[j]; o1[j] = (v[hf * 8 + 4 + j] - mean) * rs * gb[j] + bb[j]; }
            *(f32x4*)(a.out + (size_t)tok * D + k) = o0; *(f32x4*)(a.out + (size_t)tok * D + k + 4) = o1;
        }
    }
}

__global__ void __launch_bounds__(NTHREADS, 2) yoco_fwd(Args args) {
    extern __shared__ __attribute__((aligned(16))) unsigned char lds_raw[];
    LAS unsigned char* lds = (LAS unsigned char*)lds_raw;
    unsigned char* ws = args.ws;
    const int G = gridDim.x;
    const int lo = args.ph_lo, hi = args.ph_hi;
    volatile LAS unsigned* misc = (volatile LAS unsigned*)(lds + LDS_MAIN);
    if (threadIdx.x < 4) misc[threadIdx.x] = 0u;
    __syncthreads();
    XcdBarrier bar; bar.bar = (unsigned*)(ws + WS_CTL); bar.x = 0; bar.st = misc;
    if (hi - lo > 1) bar = xcd_barrier_post((unsigned*)(ws + WS_CTL), misc);
#ifndef PHASE_MASK
#define PHASE_MASK 0xFFFFFFFFu
#endif
#define IN(k) (((PHASE_MASK >> (k)) & 1u) && lo <= (k) && (k) < hi)
#define SEAM(k) do { if (IN(k) && IN((k) + 1)) xcd_barrier(bar); } while (0)
    bf16_t* RA = (bf16_t*)(ws + WS_RA); bf16_t* RB = (bf16_t*)(ws + WS_RB); bf16_t* RC = (bf16_t*)(ws + WS_RC); bf16_t* RD = (bf16_t*)(ws + WS_RD);
    float* vec = (float*)(ws + WS_VEC);
    float* st1 = (float*)(ws + WS_ST1); float* st2 = (float*)(ws + WS_ST2); float* st3 = (float*)(ws + WS_ST3);
    const float* ln_g = args.in[16]; const float* ln_b = args.in[17];

    if (IN(PH_PRO)) { prologue_phase(lds, args); } SEAM(PH_PRO);
    if (IN(PH_PROJ)) {
        g8::Gemm g{RB, (const bf16_t*)(ws + WS_WIN), D, nullptr}; g8::DenseOrder S; S.init(NPAN, NPROJ / 256, D, G, (int)blockIdx.x);
        g8::EpiPlain E{RA, NPROJ};
        g8::gemm_phase<g8::EpiPlain, g8::DenseOrder, false>(lds, g, S, E);
    } SEAM(PH_PROJ);
    if (IN(PH_MLSTM)) { if ((int)blockIdx.x < 64) mlstm_phase(lds, RA, (const float*)(ws + WS_GATES), args.in[4], RD, (int)blockIdx.x); } SEAM(PH_MLSTM);
    if (IN(PH_WOUT)) {
        g8::Gemm g{RD, (const bf16_t*)(ws + WS_WOUT), D, nullptr}; g8::DenseOrder S; S.init(NPAN, 4, D, G, (int)blockIdx.x);
        g8::EpiRes<0> E{RC, RB, st1, nullptr, nullptr, nullptr};
        g8::gemm_phase<g8::EpiRes<0>, g8::DenseOrder, false>(lds, g, S, E);
    } SEAM(PH_WOUT);
    if (IN(PH_GU)) {
        g8::Gemm g{RC, (const bf16_t*)(ws + WS_WGU), D, nullptr}; g8::DenseOrder S; S.init(NPAN, 2 * FFD / 256, D, G, (int)blockIdx.x);
        g8::EpiGlu<false> E{RA, FFD, st1, vec + VEC_GU_CS, vec + VEC_GU_BW, nullptr, 0};
        g8::gemm_phase<g8::EpiGlu<false>, g8::DenseOrder, false>(lds, g, S, E);
    } SEAM(PH_GU);
    if (IN(PH_DN)) {
        g8::Gemm g{RA, (const bf16_t*)(ws + WS_WDN), FFD, nullptr}; g8::DenseOrder S; S.init(NPAN, 4, FFD, G, (int)blockIdx.x);
        g8::EpiRes<1> E{RB, RC, st2, st1, ln_g, ln_b};
        g8::gemm_phase<g8::EpiRes<1>, g8::DenseOrder, false>(lds, g, S, E);
    } SEAM(PH_DN);
    if (IN(PH_KVQ)) {
        g8::Gemm g{RB, (const bf16_t*)(ws + WS_WKVQ), D, nullptr}; g8::DenseOrder S; S.init(NPAN, NPROJ / 256, D, G, (int)blockIdx.x);
        g8::EpiFold E{RA, NPROJ, st2, vec + VEC_KVQ_CS, vec + VEC_KVQ_BW};
        g8::gemm_phase<g8::EpiFold, g8::DenseOrder, false>(lds, g, S, E);
    } SEAM(PH_KVQ);
    if (IN(PH_ATT)) { attn_phase(lds, RA, RD); } SEAM(PH_ATT);
    if (IN(PH_WO)) {
        g8::Gemm g{RD, (const bf16_t*)(ws + WS_WO), D, nullptr}; g8::DenseOrder S; S.init(NR / 256, 4, D, G, (int)blockIdx.x);
        g8::EpiRes<1> E{RC, RB, st3, st2, ln_g + 1024, ln_b + 1024};
        g8::gemm_phase<g8::EpiRes<1>, g8::DenseOrder, false>(lds, g, S, E);
    } SEAM(PH_WO);
    if (IN(PH_RT1)) { router1_phase(lds, args); } SEAM(PH_RT1);
    if (IN(PH_RT2)) { router2_phase(lds, args); } SEAM(PH_RT2);
#define MOE_CHUNK(cidx) \
    if (IN(PH_MOE0 + 2 * (cidx))) { const int* hdr = (const int*)(ws + WS_HDR); const int npan = hdr[8]; const int p0 = (cidx) * MOE_CHUNK_PAN; \
        if (p0 < npan) { g8::MoeOrder S; S.p0 = p0; S.np = (npan - p0) < MOE_CHUNK_PAN ? (npan - p0) : MOE_CHUNK_PAN; S.nN = 2 * FFE / 256; S.G = G; S.c = (int)blockIdx.x; S.K = D; S.estride = (unsigned)(2 * FFE * D * 2); \
            _Pragma("unroll") for (int e = 0; e < NE; ++e) S.pend[e] = hdr[e]; \
            g8::Gemm g{RC, (const bf16_t*)(ws + WS_WEGU), D, (const int*)(ws + WS_TOK)}; \
            g8::EpiGlu<true> E{RA, FFE, st3, vec + VEC_EGU_CS, vec + VEC_EGU_BW, (const int*)(ws + WS_TOK), 2 * FFE}; \
            g8::gemm_phase<g8::EpiGlu<true>, g8::MoeOrder, true>(lds, g, S, E); } } \
    SEAM(PH_MOE0 + 2 * (cidx)); \
    if (IN(PH_MOE0 + 2 * (cidx) + 1)) { const int* hdr = (const int*)(ws + WS_HDR); const int npan = hdr[8]; const int p0 = (cidx) * MOE_CHUNK_PAN; \
        if (p0 < npan) { g8::MoeOrder S; S.p0 = p0; S.np = (npan - p0) < MOE_CHUNK_PAN ? (npan - p0) : MOE_CHUNK_PAN; S.nN = 4; S.G = G; S.c = (int)blockIdx.x; S.K = FFE; S.estride = (unsigned)(D * FFE * 2); \
            _Pragma("unroll") for (int e = 0; e < NE; ++e) S.pend[e] = hdr[e]; \
            g8::Gemm g{RA, (const bf16_t*)(ws + WS_WEDN), FFE, nullptr}; \
            g8::EpiMoeDown E{RB, RD, (const int*)(ws + WS_TOK), (const float*)(ws + WS_GATEB)}; \
            g8::gemm_phase<g8::EpiMoeDown, g8::MoeOrder, false>(lds, g, S, E); } } \
    SEAM(PH_MOE0 + 2 * (cidx) + 1);
    MOE_CHUNK(0) MOE_CHUNK(1) MOE_CHUNK(2) MOE_CHUNK(3) MOE_CHUNK(4)
    if (IN(PH_FINAL)) { final_phase(args); }
#undef IN
#undef SEAM
}

extern "C" void kernel_launch(void* const* d_in, const int* in_sizes, int n_in, void* d_out, int out_size, void* d_ws, size_t ws_size, hipStream_t stream) {
    static int grid = 0;
    if (grid == 0) {
        if (n_in != 18 || out_size != NR * D || ws_size < WS_END) { fprintf(stderr, "kernel_launch: unexpected problem (n_in %d out %d ws %zu need %zu)\n", n_in, out_size, ws_size, (size_t)WS_END); grid = -1; return; }
        int dev = 0, cus = 0, per_cu = 0;
        if (hipGetDevice(&dev) != hipSuccess || hipDeviceGetAttribute(&cus, hipDeviceAttributeMultiprocessorCount, dev) != hipSuccess) { grid = -1; return; }
        if (hipFuncSetAttribute((const void*)yoco_fwd, hipFuncAttributeMaxDynamicSharedMemorySize, LDS_BYTES) != hipSuccess) { fprintf(stderr, "kernel_launch: hipFuncSetAttribute failed\n"); grid = -1; return; }
        if (hipOccupancyMaxActiveBlocksPerMultiprocessor(&per_cu, (const void*)yoco_fwd, NTHREADS, LDS_BYTES) != hipSuccess || per_cu < 1) { fprintf(stderr, "kernel_launch: occupancy query says %d\n", per_cu); }
        (void)hipGetLastError();
        grid = cus;
    }
    if (grid < 0) return;
    (void)hipMemsetAsync((char*)d_ws + WS_CTL, 0, CTL_BYTES, stream);
    Args a{};
    for (int i = 0; i < 18; ++i) a.in[i] = (const float*)d_in[i];
    a.out = (float*)d_out; a.ws = (unsigned char*)d_ws;
#if N_LAUNCH_MODE == 1
    for (int p = 0; p < PH_COUNT; ++p) { a.ph_lo = p; a.ph_hi = p + 1; hipLaunchKernelGGL(yoco_fwd, dim3(grid), dim3(NTHREADS), LDS_BYTES, stream, a); }
#else
    a.ph_lo = 0; a.ph_hi = PH_COUNT;
    hipLaunchKernelGGL(yoco_fwd, dim3(grid), dim3(NTHREADS), LDS_BYTES, stream, a);
#endif
}
```

```cpp
#include <hip/hip_runtime.h>
#include <cstdio>
#include <cstdint>

#ifndef N_LAUNCH_MODE
#define N_LAUNCH_MODE 0
#endif
#ifndef PROBE_CLK
#define PROBE_CLK 0
#endif
#ifndef REPMASK
#define REPMASK 0u
#endif

#define LAS __attribute__((address_space(3)))
typedef unsigned short bf16_t;
typedef short bf16x8 __attribute__((ext_vector_type(8)));
typedef float f32x2 __attribute__((ext_vector_type(2)));
typedef float f32x4 __attribute__((ext_vector_type(4)));
typedef float f32x16 __attribute__((ext_vector_type(16)));
typedef unsigned u32x2 __attribute__((ext_vector_type(2)));
typedef unsigned u32x4 __attribute__((ext_vector_type(4)));
typedef __bf16 bf16x2_t __attribute__((ext_vector_type(2)));

constexpr int D = 1024, NB = 16, SEQ = 4096, NMETA = 16;
constexpr int NR = NB * SEQ;
constexpr int NROWS = NR + NB * NMETA;
constexpr int NPAN = NROWS / 256;
constexpr int NPROJ = 3072;
constexpr int FFD = 2816, NE = 8, FFE = 3584;
constexpr float ALPHA = 1.41421356237f, LN_EPS = 1e-5f;
constexpr int NTHREADS = 512;
constexpr int MOE_ROWS = 2 * NR + NE * 256;
constexpr int MOE_CHUNK_PAN = 128;
constexpr int MOE_NCHUNK = 4;
constexpr int MOE_KSPLIT = 7;
constexpr size_t RA_POFF = (size_t)256 << 20;

constexpr size_t al256(size_t x) { return (x + 255) & ~(size_t)255; }
constexpr size_t WS_CTL = 0;
constexpr size_t CTL_BYTES = 65536;
constexpr size_t WS_WIN = WS_CTL + CTL_BYTES;
constexpr size_t WS_WOUT = WS_WIN + (size_t)NPROJ * D * 2;
constexpr size_t WS_WGU = WS_WOUT + (size_t)D * D * 2;
constexpr size_t WS_WDN = WS_WGU + (size_t)2 * FFD * D * 2;
constexpr size_t WS_WKVQ = WS_WDN + (size_t)D * FFD * 2;
constexpr size_t WS_WO = WS_WKVQ + (size_t)NPROJ * D * 2;
constexpr size_t WS_WEGU = WS_WO + (size_t)D * D * 2;
constexpr size_t WS_WEDN = WS_WEGU + (size_t)NE * 2 * FFE * D * 2;
constexpr size_t WS_VEC = WS_WEDN + (size_t)NE * D * FFE * 2;
constexpr int VEC_GU_CS = 0, VEC_GU_BW = 2 * FFD, VEC_KVQ_CS = 4 * FFD, VEC_KVQ_BW = VEC_KVQ_CS + NPROJ, VEC_EGU_CS = VEC_KVQ_BW + NPROJ, VEC_EGU_BW = VEC_EGU_CS + NE * 2 * FFE, VEC_END = VEC_EGU_BW + NE * 2 * FFE;
constexpr size_t WS_GATES = al256(WS_VEC + (size_t)VEC_END * 4);
constexpr size_t WS_ST1 = al256(WS_GATES + (size_t)NROWS * 8 * 4);
constexpr size_t WS_ST2 = WS_ST1 + (size_t)NROWS * 16 * 8;
constexpr size_t WS_ST3 = WS_ST2 + (size_t)NROWS * 16 * 8;
constexpr size_t WS_ROUTE = WS_ST3 + (size_t)NROWS * 16 * 8;
constexpr size_t WS_CNT = WS_ROUTE + (size_t)NR * 16;
constexpr size_t WS_HDR = WS_CNT + 256 * 8 * 4;
constexpr size_t WS_TOK = WS_HDR + 256;
constexpr size_t WS_GATEB = al256(WS_TOK + (size_t)MOE_ROWS * 8);
constexpr size_t WS_TOKST = al256(WS_GATEB + (size_t)MOE_ROWS * 8);
constexpr size_t WS_RS1 = al256(WS_TOKST + (size_t)NR * 8);
constexpr size_t WS_RS2 = al256(WS_RS1 + (size_t)NROWS * 8);
constexpr size_t WS_DIAG = al256(WS_RS2 + (size_t)NROWS * 8);
constexpr size_t WS_RA = al256(WS_DIAG + 4096);
constexpr size_t RA_BYTES = (size_t)NROWS * NPROJ * 2;
constexpr size_t WS_RB = al256(WS_RA + RA_BYTES);
constexpr size_t RX_BYTES = (size_t)NROWS * D * 2;
constexpr size_t WS_RC = al256(WS_RB + RX_BYTES);
constexpr size_t WS_RD = al256(WS_RC + RX_BYTES);
constexpr size_t WS_END = al256(WS_RD + RX_BYTES);

constexpr int LDS_MAIN = 131072, LDS_META = LDS_MAIN + 256  , LDS_BYTES = LDS_META + 8192;
__device__ __forceinline__ float bf2f(bf16_t v) { return __uint_as_float(((unsigned)v) << 16); }
__device__ __forceinline__ float bflo(unsigned u) { return __uint_as_float(u << 16); }
__device__ __forceinline__ float bfhi(unsigned u) { return __uint_as_float(u & 0xffff0000u); }
__device__ __forceinline__ unsigned pk2(float lo, float hi) { f32x2 v = {lo, hi}; bf16x2_t b = __builtin_convertvector(v, bf16x2_t); return __builtin_bit_cast(unsigned, b); }
__device__ __forceinline__ bf16_t f2bf(float f) { return (bf16_t)(pk2(f, 0.f) & 0xffffu); }
__device__ __forceinline__ float rbf(float f) { return bflo(pk2(f, 0.f)); }
__device__ __forceinline__ float wave_sum(float v) {
#pragma unroll
    for (int o = 32; o >= 1; o >>= 1) v += __shfl_xor(v, o);
    return v;
}
__device__ __forceinline__ float swap32_hi(float x, float& lo) {
    const u32x2 r = __builtin_amdgcn_permlane32_swap(__float_as_uint(x), __float_as_uint(x), false, false); lo = __uint_as_float(r.x); return __uint_as_float(r.y); }
__device__ __forceinline__ float fq_sum(float x) {
    const u32x2 a = __builtin_amdgcn_permlane16_swap(__float_as_uint(x), __float_as_uint(x), false, false); const float y = __uint_as_float(a.x) + __uint_as_float(a.y);
    const u32x2 b = __builtin_amdgcn_permlane32_swap(__float_as_uint(y), __float_as_uint(y), false, false); return __uint_as_float(b.x) + __uint_as_float(b.y); }
__device__ __forceinline__ float sigmoidf_(float x) { return __builtin_amdgcn_rcpf(1.0f + __builtin_amdgcn_exp2f(x * -1.4426950408889634f)); }

#define XB_TMO      128
#define XB_XCNT(j)  (256  + 64 * (j))
#define XB_XSUB(j)  (1280 + 64 * (j))
#define XB_XGEN(j)  (2304 + 64 * (j))
#define XB_TOP      3328
#define XB_TOPGEN   3392
#define XCD_BAR_WORDS 3456
#define XB_SPIN_CAP (1u << 20)
__device__ __forceinline__ unsigned xb_ld(unsigned* p)              { return __hip_atomic_load(p, __ATOMIC_RELAXED, __HIP_MEMORY_SCOPE_AGENT); }
__device__ __forceinline__ unsigned xb_add(unsigned* p, unsigned v) { return __hip_atomic_fetch_add(p, v, __ATOMIC_RELAXED, __HIP_MEMORY_SCOPE_AGENT); }
__device__ __forceinline__ unsigned xb_xcc_id() { return (unsigned)__builtin_amdgcn_s_getreg((3 << 11) | 20) & 0xFu; }
#define XB_SPIN(cond, bar) do { unsigned _sp = 0; while (cond) { __builtin_amdgcn_s_sleep(1); \
    if ((++_sp & 255u) == 0u) { if (xb_ld(&(bar)[XB_TMO])) break; if (_sp > XB_SPIN_CAP) { atomicAdd(&(bar)[XB_TMO], 1u); break; } } } } while (0)
struct XcdBarrier { unsigned* bar; unsigned x; volatile LAS unsigned* st; };
__device__ __forceinline__ XcdBarrier xcd_barrier_post(unsigned* bar, volatile LAS unsigned* st) {
    XcdBarrier b; b.bar = bar; b.x = xb_xcc_id(); b.st = st;
    if (threadIdx.x == 0) (void)xb_add(&bar[XB_XCNT(b.x)], 1u);
    return b;
}
__device__ __forceinline__ void xcd_barrier_complete(unsigned* bar, unsigned x, unsigned& nloc, unsigned& nx) {
    const unsigned G = gridDim.x * gridDim.y * gridDim.z;
    unsigned sum, cnt, mine, sp = 0u;
    for (;;) {
        sum = 0u; cnt = 0u; mine = 0u;
#pragma unroll
        for (unsigned j = 0; j < 16; ++j) { const unsigned c = xb_ld(&bar[XB_XCNT(j)]); sum += c; cnt += (c > 0u) ? 1u : 0u; mine = (j == x) ? c : mine; }
        if (sum == G) break;
        __builtin_amdgcn_s_sleep(1);
        if ((++sp & 255u) == 0u) { if (xb_ld(&bar[XB_TMO])) break; if (sp > XB_SPIN_CAP) { atomicAdd(&bar[XB_TMO], 1u); break; } }
    }
    nloc = mine > 0u ? mine : 1u; nx = cnt > 0u ? cnt : 1u;
}
__device__ __forceinline__ void xcd_barrier(const XcdBarrier& b) {
    asm volatile("s_waitcnt vmcnt(0)" ::: "memory");
    __syncthreads();
    if (threadIdx.x == 0) {
        unsigned* bar = b.bar;
        __builtin_amdgcn_s_waitcnt(0);
        unsigned nloc = b.st[0], nx = b.st[1];
        if (nloc == 0u) { xcd_barrier_complete(bar, b.x, nloc, nx); b.st[0] = nloc; b.st[1] = nx; }
        const unsigned old = xb_add(&bar[XB_XSUB(b.x)], 1u);
        const unsigned gen = old / nloc;
        if (old + 1u == (gen + 1u) * nloc) {
            __builtin_amdgcn_fence(__ATOMIC_RELEASE, "agent");
            asm volatile("s_waitcnt vmcnt(0)" ::: "memory");
            const unsigned og = xb_add(&bar[XB_TOP], 1u);
            const unsigned tg = og / nx;
            if (og + 1u == (tg + 1u) * nx) xb_add(&bar[XB_TOPGEN], 1u);
            else XB_SPIN(xb_ld(&bar[XB_TOPGEN]) == tg, bar);
            __builtin_amdgcn_fence(__ATOMIC_ACQUIRE, "agent");
            xb_add(&bar[XB_XGEN(b.x)], 1u);
            asm volatile("s_waitcnt vmcnt(0)" ::: "memory");
        } else {
            XB_SPIN(xb_ld(&bar[XB_XGEN(b.x)]) == gen, bar);
            __builtin_amdgcn_fence(__ATOMIC_ACQUIRE, "agent");
            asm volatile("s_waitcnt vmcnt(0)" ::: "memory");
        }
    }
    __syncthreads();
}

namespace g8 {
constexpr int BM = 256, BK = 64, HALF = 128, HTB = HALF * BK * 2, STAGE_BYTES = 8 * HTB, NXCD = 8, WGM = 8;
__host__ __device__ __forceinline__ int lds_byte(int r, int c) { const int st = (r >> 4) * 2 + (c >> 5), rr = r & 15, cc = c & 31, ob = rr * 64 + cc * 2; return st * 1024 + (ob ^ (((ob >> 9) & 1) << 5)); }
__host__ __device__ __forceinline__ void stage_rc(int b, int& R, int& C) { const int st = b / 1024, sb = b % 1024, swz = sb ^ (((sb >> 9) & 1) << 5); R = (st >> 1) * 16 + swz / 64; C = (st & 1) * 32 + (swz % 64) / 2; }
__host__ __device__ __forceinline__ int perm32(int rho) { const int n = rho >> 4, i = rho & 15; return 8 * (i >> 2) + 4 * n + (i & 3); }

struct Unit { int pm, pn, gp; unsigned boff; int aux; int kt; unsigned koff; int ks; };
struct Gemm { const bf16_t* A; const bf16_t* Bt; int K; const int* rowtab; const unsigned char* smeta; const unsigned char* sstat; };

struct DenseOrder {
    int nM, nN, nwg, G, c, K;
    __device__ void init(int nM_, int nN_, int K_, int G_, int c_) { nM = nM_; nN = nN_; nwg = nM * nN; G = G_; c = c_; K = K_; }
    __device__ bool next(int i, Unit& u) const {
        const long L = (long)i * G + c; if (L >= nwg) return false;
        int wgid = (int)L; { const int q = nwg / NXCD, r = nwg % NXCD, xcd = wgid % NXCD, off = wgid / NXCD; wgid = (xcd < r ? xcd * (q + 1) : r * (q + 1) + (xcd - r) * q) + off; }
        const int nig = WGM * nN, gid = wgid / nig, fm = gid * WGM, gsz = (nM - fm) < WGM ? (nM - fm) : WGM;
        u.pm = fm + ((wgid % nig) % gsz); u.pn = (wgid % nig) / gsz; u.gp = u.pm; u.boff = (unsigned)u.pn * (unsigned)(256 * K * 2); u.kt = K / BK; u.koff = 0u; u.ks = -1; return true;
    }
};
struct MoeOrder {
    int p0, np, nN, G, c, K; unsigned estride; int pend[NE]; int nfull, nsplit;
    __device__ bool next(int i, Unit& u) const {
        const long L = (long)i * G + c; const long nmain = (long)nfull * nN;
        int pn, pml, ks = -1;
        if (L < nmain) { pn = (int)(L / nfull); pml = (int)(L % nfull); }
        else { const long r = L - nmain; if (r >= (long)(np - nfull) * nN * nsplit) return false;
            ks = (int)(r % nsplit); const int q = (int)(r / nsplit); pn = q % nN; pml = nfull + q / nN; if (nsplit == 1) ks = -1; }
        const int gp = p0 + pml;
        int e = 0;
#pragma unroll
        for (int j = 0; j < NE - 1; ++j) e += (gp >= pend[j]) ? 1 : 0;
        const int ktall = K / BK;
        u.pm = pml; u.pn = pn; u.gp = gp; u.ks = ks; u.kt = ks < 0 ? ktall : ktall / nsplit; u.koff = ks < 0 ? 0u : (unsigned)(ks * (K / nsplit) * 2);
        u.boff = (unsigned)e * estride + (unsigned)pn * (unsigned)(256 * K * 2) + u.koff; return true;
    }
};

template <class Epi, class Sched, bool GATHER, int META = 0>
__device__ __forceinline__ void gemm_phase(LAS unsigned char* lds, const Gemm g, const Sched& S, const Epi& E) {
    const int tid = threadIdx.x, wid = __builtin_amdgcn_readfirstlane(tid >> 6), lane = tid & 63, wr = wid >> 2, wc = wid & 3, fr = lane & 15, fq = lane >> 4;
    const int K = g.K;
    int Rr[2], Cc[2]; unsigned voffA[2], voffB[2];
#pragma unroll
    for (int i = 0; i < 2; ++i) { stage_rc(tid * 16 + i * 8192, Rr[i], Cc[i]); const int Rb = (Rr[i] & ~31) + perm32(Rr[i] & 31);
        voffA[i] = (unsigned)(Rr[i] * K + Cc[i]) * 2u; voffB[i] = (unsigned)(Rb * K + Cc[i]) * 2u; }
    const size_t kstep = (size_t)(BK * 2);
    const size_t hstep = (size_t)HALF * K * 2;
    const size_t tstep = 2 * hstep;
    const unsigned ldsw = (unsigned)wid * 1024u;
    const int aoff = lds_byte(wr * 64 + fr, fq * 8), boff = lds_byte(wc * 32 + fr, fq * 8);
#define G8_SA(b, h) (((b) * 2 + (h)) * HTB)
#define G8_SB(b, h) ((4 + (b) * 2 + (h)) * HTB)
#define G8_STAGE(bufoff, gbase, voff) do { _Pragma("unroll") for (int _i = 0; _i < 2; ++_i) \
        __builtin_amdgcn_global_load_lds((const unsigned*)((const char*)(gbase) + (voff)[_i]), (LAS unsigned*)(lds + (bufoff) + ldsw + _i * 8192), 16, 0, 0); } while (0)
#define G8_STA(bufoff, ptr, offs, h) do { if constexpr (GATHER) { G8_STAGE(bufoff, (const char*)g.A, (offs)[h]); } else { G8_STAGE(bufoff, (ptr) + (h) * hstep, voffA); } } while (0)
#define G8_LDA(dst, b, h) do { _Pragma("unroll") for (int m = 0; m < 4; ++m) _Pragma("unroll") for (int k = 0; k < 2; ++k) dst[m][k] = *(const LAS bf16x8*)(lds + G8_SA(b, h) + aoff + m * 2048 + k * 1024); } while (0)
#define G8_LDB(dst, b, h) do { _Pragma("unroll") for (int n = 0; n < 2; ++n) _Pragma("unroll") for (int k = 0; k < 2; ++k) dst[n][k] = *(const LAS bf16x8*)(lds + G8_SB(b, h) + boff + n * 2048 + k * 1024); } while (0)
#define G8_MMA(ai, bj, At, Bt) do { __builtin_amdgcn_s_setprio(1); _Pragma("unroll") for (int m = 0; m < 4; ++m) _Pragma("unroll") for (int n = 0; n < 2; ++n) _Pragma("unroll") for (int k = 0; k < 2; ++k) \
        acc[ai][bj][m][n] = __builtin_amdgcn_mfma_f32_16x16x32_bf16(Bt[n][k], At[m][k], acc[ai][bj][m][n], 0, 0, 0); __builtin_amdgcn_s_setprio(0); } while (0)
#define G8_WAIT_V(n) asm volatile("s_waitcnt vmcnt(" #n ")" ::: "memory")
#define G8_WAIT_L(n) asm volatile("s_waitcnt lgkmcnt(" #n ")" ::: "memory")
#define G8_BAR __builtin_amdgcn_s_barrier()
#define G8_SCHED __builtin_amdgcn_sched_barrier(0)
#define G8_ROWOFFS(dst, U) do { _Pragma("unroll") for (int _h = 0; _h < 2; ++_h) _Pragma("unroll") for (int _i = 0; _i < 2; ++_i) { \
        const int _id = g.rowtab[2 * ((U).gp * 256 + _h * 128 + Rr[_i])]; const int _tk = _id < 0 ? 0 : (_id >> 1); dst[_h][_i] = (unsigned)(_tk * K + Cc[_i]) * 2u; } } while (0)
#define G8_META_DMA(gsrc, panel, bufidx) __builtin_amdgcn_global_load_lds((const unsigned*)((gsrc) + (size_t)(panel) * 2048 + wid * 256 + lane * 4), (LAS unsigned*)(lds + LDS_META + (bufidx) * 2048 + wid * 256), 4, 0, 0)
    Unit cur, nxt; int ui = 0;
    if (!S.next(0, cur)) return;
    f32x4 acc[2][2][4][2];
#pragma unroll
    for (int a = 0; a < 2; ++a)
#pragma unroll
        for (int b = 0; b < 2; ++b)
#pragma unroll
            for (int m = 0; m < 4; ++m)
#pragma unroll
                for (int n = 0; n < 2; ++n) acc[a][b][m][n] = (f32x4){0.f, 0.f, 0.f, 0.f};
    bf16x8 At[4][2], B0[2][2], B1[2][2];
    const char* cA = (const char*)g.A + (size_t)cur.pm * tstep + cur.koff; const char* cB = (const char*)g.Bt + cur.boff;
    unsigned oc[2][2], on[2][2], o1[2][2], o2[2][2], o3[2][2];
    if constexpr (GATHER) { G8_ROWOFFS(oc, cur);
#pragma unroll
        for (int h = 0; h < 2; ++h)
#pragma unroll
            for (int i = 0; i < 2; ++i) { o1[h][i] = oc[h][i] + 128u; on[h][i] = oc[h][i]; o2[h][i] = 0; o3[h][i] = 0; } }
    G8_STAGE(G8_SB(0, 0), cB, voffB); G8_STAGE(G8_SB(0, 1), cB + hstep, voffB); G8_STA(G8_SA(0, 0), cA, oc, 0); G8_STA(G8_SA(0, 1), cA, oc, 1);
    if (wr == 1) G8_BAR;
    G8_WAIT_V(2); G8_BAR;
    G8_STAGE(G8_SB(1, 0), cB + kstep, voffB); G8_STA(G8_SA(1, 0), cA + kstep, o1, 0); G8_STAGE(G8_SB(1, 1), cB + hstep + kstep, voffB);
    G8_WAIT_V(6); G8_BAR;
    for (;;) {
        const bool has_next = S.next(ui + 1, nxt);
        const char* nA = has_next ? (const char*)g.A + (size_t)nxt.pm * tstep + nxt.koff : cA; const char* nB = has_next ? (const char*)g.Bt + nxt.boff : cB;
        const int nt = cur.kt;
        if constexpr (META == 1) { if (has_next) G8_META_DMA(g.smeta, nxt.gp, (ui + 1) & 1); G8_META_DMA(g.sstat, cur.gp, 2 + (ui & 1)); }
        if constexpr (META == 2) { G8_META_DMA(g.smeta, cur.gp, ui & 1); }
        if constexpr (META == 3) { G8_META_DMA(g.sstat, cur.pm, 2 + (ui & 1)); }
        for (int t = 0; t < nt; t += 2) {
            const bool last = (t == nt - 2);
            const char* a1 = cA + (size_t)(t + 1) * kstep;
            const char* a2 = last ? nA : cA + (size_t)(t + 2) * kstep; const char* b2 = last ? nB : cB + (size_t)(t + 2) * kstep;
            const char* a3 = a2 + kstep; const char* b3 = b2 + kstep;
            if constexpr (GATHER) {
                if (last) {
#pragma unroll
                    for (int h = 0; h < 2; ++h)
#pragma unroll
                        for (int i = 0; i < 2; ++i) { int id = -1; if (has_next) id = *(const LAS int*)(lds + LDS_META + ((ui + 1) & 1) * 2048 + (h * 128 + Rr[i]) * 8);
                            const int tk = id < 0 ? 0 : (id >> 1); on[h][i] = has_next ? (unsigned)(tk * K + Cc[i]) * 2u : oc[h][i]; } }
#pragma unroll
                for (int h = 0; h < 2; ++h)
#pragma unroll
                    for (int i = 0; i < 2; ++i) { o1[h][i] = oc[h][i] + (unsigned)(t + 1) * 128u; o2[h][i] = last ? on[h][i] : oc[h][i] + (unsigned)(t + 2) * 128u; o3[h][i] = o2[h][i] + 128u; } }
            G8_LDB(B0, 0, 0); G8_LDB(B1, 0, 1); G8_SCHED; G8_LDA(At, 0, 0); G8_STA(G8_SA(1, 1), a1, o1, 1);
            G8_WAIT_V(8); G8_WAIT_L(0); G8_BAR; G8_MMA(0, 0, At, B0); G8_MMA(0, 1, At, B1); G8_BAR; G8_SCHED;
            G8_LDA(At, 0, 1); G8_STAGE(G8_SB(0, 0), b2, voffB); G8_STAGE(G8_SB(0, 1), b2 + hstep, voffB); G8_STA(G8_SA(0, 0), a2, o2, 0);
            G8_WAIT_V(8); G8_WAIT_L(0); G8_BAR; G8_MMA(1, 0, At, B0); G8_MMA(1, 1, At, B1); G8_BAR; G8_SCHED;
            G8_LDB(B0, 1, 0); G8_LDB(B1, 1, 1); G8_SCHED; G8_LDA(At, 1, 0); G8_STA(G8_SA(0, 1), a2, o2, 1);
            G8_WAIT_V(8); G8_WAIT_L(0); G8_BAR; G8_MMA(0, 0, At, B0); G8_MMA(0, 1, At, B1); G8_BAR; G8_SCHED;
            G8_LDA(At, 1, 1); G8_STAGE(G8_SB(1, 0), b3, voffB); G8_STAGE(G8_SB(1, 1), b3 + hstep, voffB); G8_STA(G8_SA(1, 0), a3, o3, 0);
            G8_WAIT_V(8); G8_WAIT_L(0); G8_BAR; G8_MMA(1, 0, At, B0); G8_MMA(1, 1, At, B1); G8_BAR; G8_SCHED;
        }
        if (wr == 0) G8_BAR;
        cur.aux = ui & 1;
        E(acc, cur, wr, wc, fr, fq);
        if (!has_next) break;
#pragma unroll
        for (int a = 0; a < 2; ++a)
#pragma unroll
            for (int b = 0; b < 2; ++b)
#pragma unroll
                for (int m = 0; m < 4; ++m)
#pragma unroll
                    for (int n = 0; n < 2; ++n) acc[a][b][m][n] = (f32x4){0.f, 0.f, 0.f, 0.f};
        cur = nxt; cA = nA; cB = nB; ++ui;
        if constexpr (GATHER) {
#pragma unroll
            for (int h = 0; h < 2; ++h)
#pragma unroll
                for (int i = 0; i < 2; ++i) oc[h][i] = on[h][i]; }
        if (wr == 1) G8_BAR;
    }
    G8_WAIT_V(0);
    G8_BAR;
#undef G8_SA
#undef G8_SB
#undef G8_STAGE
#undef G8_STA
#undef G8_LDA
#undef G8_LDB
#undef G8_MMA
#undef G8_WAIT_V
#undef G8_WAIT_L
#undef G8_BAR
#undef G8_SCHED
#undef G8_ROWOFFS
#undef G8_META_DMA
}

typedef f32x4 Acc[2][2][4][2];
__device__ __forceinline__ u32x4 pack8(const f32x4 a, const f32x4 b) { u32x4 w; w.x = pk2(a[0], a[1]); w.y = pk2(a[2], a[3]); w.z = pk2(b[0], b[1]); w.w = pk2(b[2], b[3]); return w; }
__device__ __forceinline__ void unpack8(const u32x4 w, float (&f)[8]) { f[0] = bflo(w.x); f[1] = bfhi(w.x); f[2] = bflo(w.y); f[3] = bfhi(w.y); f[4] = bflo(w.z); f[5] = bfhi(w.z); f[6] = bflo(w.w); f[7] = bfhi(w.w); }
__device__ __forceinline__ void row_stats(const float* st, int row, int fq, float& mu, float& rstd) {
    const f32x4* p = (const f32x4*)(st + (size_t)row * 32 + fq * 8);
    const f32x4 a = p[0], b = p[1];
    float s1 = (a[0] + a[2]) + (b[0] + b[2]), s2 = (a[1] + a[3]) + (b[1] + b[3]);
    s1 += __shfl_xor(s1, 16); s1 += __shfl_xor(s1, 32); s2 += __shfl_xor(s2, 16); s2 += __shfl_xor(s2, 32);
    mu = s1 * (1.0f / 1024.0f); const float var = fmaxf(s2 * (1.0f / 1024.0f) - mu * mu, 0.f); rstd = rsqrtf(var + LN_EPS);
}
__device__ __forceinline__ void put_stats(float* st, int row, int slot, int fq, float s1, float s2) {
    s1 = fq_sum(s1); s2 = fq_sum(s2);
    if (fq == 0) *(f32x2*)(st + (size_t)row * 32 + slot * 2) = (f32x2){s1, s2};
}

struct EpiPlain {
    bf16_t* O; int ldc;
    __device__ __forceinline__ void operator()(const Acc& acc, const Unit& u, int wr, int wc, int fr, int fq) const {
        const int row0 = u.pm * 256 + wr * 64 + fr, col0 = u.pn * 256 + wc * 32 + 8 * fq;
#pragma unroll
        for (int ai = 0; ai < 2; ++ai)
#pragma unroll
            for (int m = 0; m < 4; ++m) { bf16_t* rowp = O + (size_t)(row0 + ai * 128 + m * 16) * ldc + col0;
#pragma unroll
                for (int bj = 0; bj < 2; ++bj) *(u32x4*)(rowp + bj * 128) = pack8(acc[ai][bj][m][0], acc[ai][bj][m][1]); }
    }
};
template <int MODE> struct EpiRes {
    bf16_t* Z; const bf16_t* Rsrc; float* st_out; LAS unsigned char* ldsm; const float* g; const float* b;
    __device__ __forceinline__ void operator()(const Acc& acc, const Unit& u, int wr, int wc, int fr, int fq) const {
        const int r0 = wr * 64 + fr, col0 = u.pn * 256 + wc * 32 + 8 * fq;
        f32x4 gv[2][2], bv[2][2];
        if (MODE == 1) {
#pragma unroll
            for (int bj = 0; bj < 2; ++bj)
#pragma unroll
                for (int n = 0; n < 2; ++n) { gv[bj][n] = *(const f32x4*)(g + col0 + bj * 128 + 4 * n); bv[bj][n] = *(const f32x4*)(b + col0 + bj * 128 + 4 * n); }
        }
        u32x4 rwa[4][4][2];
#define EPR_LOAD(am_) do { _Pragma("unroll") for (int m = 2 * ((am_) & 1); m < 2 * ((am_) & 1) + 2; ++m) _Pragma("unroll") for (int bj = 0; bj < 2; ++bj) \
            rwa[am_][m][bj] = *(const u32x4*)(Rsrc + ((size_t)u.pm * 256 + r0 + ((am_) >> 1) * 128 + m * 16) * D + col0 + bj * 128); } while (0)
        EPR_LOAD(0);
#pragma unroll
        for (int am = 0; am < 4; ++am) { const int ai = am >> 1;
            if (am + 1 < 4) EPR_LOAD(am + 1);
            u32x4 (&rw)[4][2] = rwa[am];
#pragma unroll
            for (int m = 2 * (am & 1); m < 2 * (am & 1) + 2; ++m) {
                const int rl = r0 + ai * 128 + m * 16; const size_t row = (size_t)u.pm * 256 + rl;
                float mu = 0.f, rstd = 1.f;
                if (MODE == 1) { const f32x2 ms = *(const LAS f32x2*)(ldsm + (2 + u.aux) * 2048 + rl * 8); mu = ms[0]; rstd = ms[1]; }
                float s1 = 0.f, s2 = 0.f;
#pragma unroll
                for (int bj = 0; bj < 2; ++bj) {
                    float r[8]; unpack8(rw[m][bj], r);
                    f32x4 v0, v1;
#pragma unroll
                    for (int j = 0; j < 4; ++j) {
                        float h0 = r[j], h1 = r[4 + j];
                        if (MODE == 1) { h0 = (h0 - mu) * rstd * gv[bj][0][j] + bv[bj][0][j]; h1 = (h1 - mu) * rstd * gv[bj][1][j] + bv[bj][1][j]; }
                        v0[j] = ALPHA * h0 + acc[ai][bj][m][0][j]; v1[j] = ALPHA * h1 + acc[ai][bj][m][1][j];
                    }
                    const u32x4 w = pack8(v0, v1);
                    *(u32x4*)(Z + row * D + col0 + bj * 128) = w;
                    float q[8]; unpack8(w, q);
#pragma unroll
                    for (int j = 0; j < 8; ++j) { s1 += q[j]; s2 += q[j] * q[j]; }
                }
                put_stats(st_out, (int)row, u.pn * 4 + wc, fq, s1, s2);
            }
        }
    }
};
struct EpiFold {
    bf16_t* O; int ldc; LAS unsigned char* ldsm; const float* cs; const float* bw;
    __device__ __forceinline__ void operator()(const Acc& acc, const Unit& u, int wr, int wc, int fr, int fq) const {
        const int r0 = wr * 64 + fr, col0 = u.pn * 256 + wc * 32 + 8 * fq;
        f32x4 cv[2][2], bv[2][2];
#pragma unroll
        for (int bj = 0; bj < 2; ++bj)
#pragma unroll
            for (int n = 0; n < 2; ++n) { cv[bj][n] = *(const f32x4*)(cs + col0 + bj * 128 + 4 * n); bv[bj][n] = *(const f32x4*)(bw + col0 + bj * 128 + 4 * n); }
#pragma unroll
        for (int ai = 0; ai < 2; ++ai)
#pragma unroll
            for (int m = 0; m < 4; ++m) {
                const int rl = r0 + ai * 128 + m * 16; const size_t row = (size_t)u.pm * 256 + rl;
                const f32x2 ms = *(const LAS f32x2*)(ldsm + (2 + u.aux) * 2048 + rl * 8); const float mu = ms[0], rstd = ms[1];
#pragma unroll
                for (int bj = 0; bj < 2; ++bj) {
                    const f32x4 v0 = (acc[ai][bj][m][0] - mu * cv[bj][0]) * rstd + bv[bj][0], v1 = (acc[ai][bj][m][1] - mu * cv[bj][1]) * rstd + bv[bj][1];
                    *(u32x4*)(O + row * ldc + col0 + bj * 128) = pack8(v0, v1);
                }
            }
    }
};
template <bool MOE> struct EpiGlu {
    bf16_t* O; int ldc; const float* st_in; const float* cs; const float* bw; LAS unsigned char* ldsm; int ncs;
    __device__ __forceinline__ void operator()(const Acc& acc, const Unit& u, int wr, int wc, int fr, int fq) const {
        const int row0 = u.pm * 256 + wr * 64 + fr, colo = u.pn * 128 + wc * 32 + 8 * fq;
        int vb = u.pn * 256 + wc * 32 + 8 * fq;
        if (MOE) vb += (int)(u.boff / (unsigned)(256 * D * 2)) * 256 - u.pn * 256;
        f32x4 cv[2][2], bv[2][2];
#pragma unroll
        for (int bj = 0; bj < 2; ++bj)
#pragma unroll
            for (int n = 0; n < 2; ++n) { cv[bj][n] = *(const f32x4*)(cs + vb + bj * 128 + 4 * n); bv[bj][n] = *(const f32x4*)(bw + vb + bj * 128 + 4 * n); }
#pragma unroll
        for (int ai = 0; ai < 2; ++ai)
#pragma unroll
            for (int m = 0; m < 4; ++m) {
                const int row = row0 + ai * 128 + m * 16;
                const f32x2 ms = *(const LAS f32x2*)(ldsm + (2 + u.aux) * 2048 + (row - u.pm * 256) * 8); const float mu = ms[0], rstd = ms[1];
                f32x4 o0, o1;
#pragma unroll
                for (int j = 0; j < 4; ++j) {
                    const float g0 = (acc[ai][0][m][0][j] - mu * cv[0][0][j]) * rstd + bv[0][0][j], g1 = (acc[ai][0][m][1][j] - mu * cv[0][1][j]) * rstd + bv[0][1][j];
                    const float u0 = (acc[ai][1][m][0][j] - mu * cv[1][0][j]) * rstd + bv[1][0][j], u1 = (acc[ai][1][m][1][j] - mu * cv[1][1][j]) * rstd + bv[1][1][j];
                    o0[j] = g0 * sigmoidf_(g0) * u0; o1[j] = g1 * sigmoidf_(g1) * u1;
                }
                *(u32x4*)(O + (size_t)row * ldc + colo) = pack8(o0, o1);
            }
    }
};
struct EpiMoeDown {
    bf16_t* Y0; bf16_t* Y1; LAS unsigned char* ldsm; float* P; int nfull;
    __device__ __forceinline__ void operator()(const Acc& acc, const Unit& u, int wr, int wc, int fr, int fq) const {
        const int r0 = wr * 64 + fr, col0 = u.pn * 256 + wc * 32 + 8 * fq;
        if (u.ks >= 0) {
#pragma unroll
            for (int ai = 0; ai < 2; ++ai)
#pragma unroll
                for (int m = 0; m < 4; ++m) { float* rowp = P + ((size_t)u.ks * 2048 + (size_t)(u.pm - nfull) * 256 + r0 + ai * 128 + m * 16) * D + col0;
#pragma unroll
                    for (int bj = 0; bj < 2; ++bj) { *(f32x4*)(rowp + bj * 128) = acc[ai][bj][m][0]; *(f32x4*)(rowp + bj * 128 + 4) = acc[ai][bj][m][1]; } }
            return;
        }
#pragma unroll
        for (int ai = 0; ai < 2; ++ai)
#pragma unroll
            for (int m = 0; m < 4; ++m) {
                const u32x2 mg = *(const LAS u32x2*)(ldsm + u.aux * 2048 + (r0 + ai * 128 + m * 16) * 8);
                const int id = (int)mg.x; const float gt = __uint_as_float(mg.y);
                if (id >= 0) { bf16_t* rowp = Y0 + (size_t)(id & 1) * (size_t)(Y1 - Y0) + (size_t)(id >> 1) * D + col0;
#pragma unroll
                    for (int bj = 0; bj < 2; ++bj) *(u32x4*)(rowp + bj * 128) = pack8(acc[ai][bj][m][0] * gt, acc[ai][bj][m][1] * gt); }
            }
    }
};
}

struct Args { const float* in[18]; float* out; unsigned char* ws; int ph_lo, ph_hi; };
enum { PH_PRO = 0, PH_PROJ, PH_MLSTM, PH_WOUT, PH_FIN1, PH_GU, PH_DN, PH_FIN2, PH_KVQ, PH_ATT, PH_WO, PH_RT1, PH_RT2, PH_MOE0, PH_FIX = PH_MOE0 + 2 * MOE_NCHUNK, PH_FINAL, PH_COUNT };

__device__ __forceinline__ float logsigmoid_(float x) { return fminf(x, 0.f) - log1pf(expf(-fabsf(x))); }
__device__ __forceinline__ void conv_block(LAS unsigned char* lds, const float* src, int ldw, int K, bf16_t* dst, const float* g, const float* bb, float* cs, float* bw) {
    const int tid = threadIdx.x;
    const int n4 = (tid & 15) * 4, k4 = (tid >> 4) * 4;
    const int rn = tid >> 3, rs = tid & 7;
    float csp[4] = {0.f, 0.f, 0.f, 0.f}, bwp[4] = {0.f, 0.f, 0.f, 0.f};
    const int nch = K / 128;
    LAS float* gs = (LAS float*)(lds + 2 * 64 * 264 + 16384);
    if (g) { for (int i = tid; i < K; i += NTHREADS) { gs[i] = g[i]; gs[K + i] = bb[i]; } __syncthreads(); }
    f32x4 v[4], vn[4];
#pragma unroll
    for (int kk = 0; kk < 4; ++kk) v[kk] = *(const f32x4*)(src + (size_t)(k4 + kk) * ldw + n4);
    for (int ch = 0; ch < nch; ++ch) {
        LAS unsigned char* T = lds + (ch & 1) * (64 * 264);
        if (ch + 1 < nch) {
#pragma unroll
            for (int kk = 0; kk < 4; ++kk) vn[kk] = *(const f32x4*)(src + (size_t)((ch + 1) * 128 + k4 + kk) * ldw + n4); }
        float gk[4] = {1.f, 1.f, 1.f, 1.f}, bk[4] = {0.f, 0.f, 0.f, 0.f};
        if (g) {
#pragma unroll
            for (int kk = 0; kk < 4; ++kk) { gk[kk] = gs[ch * 128 + k4 + kk]; bk[kk] = gs[K + ch * 128 + k4 + kk]; } }
#pragma unroll
        for (int j = 0; j < 4; ++j) {
            const unsigned lo = pk2(v[0][j] * gk[0], v[1][j] * gk[1]), hi = pk2(v[2][j] * gk[2], v[3][j] * gk[3]);
            *(LAS u32x2*)(T + (n4 + j) * 264 + k4 * 2) = (u32x2){lo, hi};
            csp[j] += (bflo(lo) + bfhi(lo)) + (bflo(hi) + bfhi(hi));
            bwp[j] += (v[0][j] * bk[0] + v[1][j] * bk[1]) + (v[2][j] * bk[2] + v[3][j] * bk[3]);
        }
        __syncthreads();
        u32x2 q[4];
#pragma unroll
        for (int i = 0; i < 4; ++i) q[i] = *(const LAS u32x2*)(T + rn * 264 + rs * 32 + i * 8);
        bf16_t* dp = dst + (size_t)rn * K + ch * 128 + rs * 16;
        *(u32x4*)dp = (u32x4){q[0].x, q[0].y, q[1].x, q[1].y};
        *(u32x4*)(dp + 8) = (u32x4){q[2].x, q[2].y, q[3].x, q[3].y};
#pragma unroll
        for (int kk = 0; kk < 4; ++kk) v[kk] = vn[kk];
    }
    __syncthreads();
    if (cs) {
        LAS float* red = (LAS float*)(lds + 2 * 64 * 264);
#pragma unroll
        for (int j = 0; j < 4; ++j) { red[(tid >> 4) * 64 + n4 + j] = csp[j]; red[2048 + (tid >> 4) * 64 + n4 + j] = bwp[j]; }
        __syncthreads();
        if (tid < 128) { const int n = tid & 63, w = tid >> 6; float s = 0.f;
            for (int i = 0; i < 32; ++i) s += red[w * 2048 + i * 64 + n];
            (w ? bw : cs)[n] = s; }
        __syncthreads();
    }
}
__device__ __forceinline__ void conv_job(LAS unsigned char* lds, const Args& a, int blk) {
    unsigned char* ws = a.ws;
    const float* ln_g = a.in[16]; const float* ln_b = a.in[17];
    float* vec = (float*)(ws + WS_VEC);
    const float* src; int ldw, K; bf16_t* dst; const float* g = nullptr; const float* bb = nullptr; float* cs = nullptr; float* bw = nullptr;
    int j = blk;
    if (j < 128) { const int e = j >> 4, jj = j & 15; src = a.in[15] + (size_t)e * FFE * D + 64 * jj; ldw = D; K = FFE; dst = (bf16_t*)(ws + WS_WEDN) + ((size_t)e * D + 64 * jj) * FFE; }
    else if (j < 144) { j -= 128; src = a.in[11] + 64 * j; ldw = D; K = FFD; dst = (bf16_t*)(ws + WS_WDN) + (size_t)(64 * j) * FFD; }
    else if (j < 192) { j -= 144; src = a.in[2] + 64 * j; ldw = 3080; K = D; dst = (bf16_t*)(ws + WS_WIN) + (size_t)(64 * j) * D; }
    else if (j < 208) { j -= 192; src = a.in[5] + 64 * j; ldw = D; K = D; dst = (bf16_t*)(ws + WS_WOUT) + (size_t)(64 * j) * D; }
    else if (j < 296) { j -= 208; const int t = j >> 2, q = j & 3; src = (q < 2 ? a.in[9] : a.in[10]) + 128 * t + 64 * (q & 1); ldw = FFD; K = D; dst = (bf16_t*)(ws + WS_WGU) + (size_t)(64 * j) * D;
        g = ln_g; bb = ln_b; cs = vec + VEC_GU_CS + 64 * j; bw = vec + VEC_GU_BW + 64 * j; }
    else if (j < 344) { j -= 296; src = j < 32 ? a.in[6] + 64 * j : a.in[7] + 64 * (j - 32); ldw = j < 32 ? 2048 : 1024; K = D; dst = (bf16_t*)(ws + WS_WKVQ) + (size_t)(64 * j) * D;
        g = ln_g + 1024; bb = ln_b + 1024; cs = vec + VEC_KVQ_CS + 64 * j; bw = vec + VEC_KVQ_BW + 64 * j; }
    else if (j < 360) { j -= 344; src = a.in[8] + 64 * j; ldw = D; K = D; dst = (bf16_t*)(ws + WS_WO) + (size_t)(64 * j) * D; }
    else { j -= 360; const int e = j / 112, jj = j % 112, t = jj >> 2, q = jj & 3; src = (q < 2 ? a.in[13] : a.in[14]) + (size_t)e * D * FFE + 128 * t + 64 * (q & 1); ldw = FFE; K = D;
        dst = (bf16_t*)(ws + WS_WEGU) + ((size_t)e * 2 * FFE + 64 * jj) * D; g = ln_g + 2048; bb = ln_b + 2048; cs = vec + VEC_EGU_CS + e * 2 * FFE + 64 * jj; bw = vec + VEC_EGU_BW + e * 2 * FFE + 64 * jj; }
    conv_block(lds, src, ldw, K, dst, g, bb, cs, bw);
}
constexpr int EGU0 = 360;
__device__ __forceinline__ void tail_jobs(LAS unsigned char* lds, const Args& a, int phase) {
    const int c = (int)blockIdx.x;
    int j0 = -1, j1 = -1;
    if (phase == PH_PROJ) { const int q = c - 12; if (q >= 0) j0 = EGU0 + q; }
    else if (phase == PH_WOUT) { const int q = c - 4; if (q >= 0) j0 = EGU0 + 244 + q; }
    else if (phase == PH_GU) { const int q = c - 22; if (q >= 0) j0 = EGU0 + 496 + q; }
    else { const int q = c - 4;
        if (q >= 0 && q < 128) j0 = q;
        else if (q >= 128) { const int r = q - 128; if (730 + r < 896) j0 = EGU0 + 730 + r; if (730 + 124 + r < 896) j1 = EGU0 + 730 + 124 + r; } }
    for (int k = 0; k < 2; ++k) { const int j = k ? j1 : j0; if (j >= 0) conv_job(lds, a, j); }
}
__device__ __forceinline__ void prologue_phase(LAS unsigned char* lds, const Args& a) {
    unsigned char* ws = a.ws;
    const int G = gridDim.x;
    for (int blk = 128 + blockIdx.x; blk < EGU0; blk += G) conv_job(lds, a, blk);
    {
        const int tid = threadIdx.x, lane = tid & 63, wid = tid >> 6;
        LAS float* wg = (LAS float*)lds;
        __syncthreads();
        const float* w_in = a.in[2];
        for (int i = tid; i < 8192; i += NTHREADS) { const int k = i >> 3, e = i & 7; wg[e * 1024 + k] = w_in[(size_t)k * 3080 + 3072 + e]; }
        __syncthreads();
        bf16_t* H0 = (bf16_t*)(ws + WS_RB); float* gates = (float*)(ws + WS_GATES);
        const float bg = a.in[3][lane & 7];
        f32x4 xv[4], xn[4];
        { const int row = blockIdx.x * 8 + wid; const float* src = row < NR ? a.in[0] + (size_t)row * D : a.in[1] + (size_t)((row - NR) & 15) * D;
#pragma unroll
            for (int i = 0; i < 4; ++i) xv[i] = *(const f32x4*)(src + i * 256 + lane * 4); }
        for (int row = blockIdx.x * 8 + wid; row < NROWS; row += G * 8) {
            { const int rn = row + G * 8;
                if (rn < NROWS) { const float* srcn = rn < NR ? a.in[0] + (size_t)rn * D : a.in[1] + (size_t)((rn - NR) & 15) * D;
#pragma unroll
                    for (int i = 0; i < 4; ++i) xn[i] = *(const f32x4*)(srcn + i * 256 + lane * 4); } }
            float acc[8] = {0.f, 0.f, 0.f, 0.f, 0.f, 0.f, 0.f, 0.f};
#pragma unroll
            for (int i = 0; i < 4; ++i) {
                const int k = i * 256 + lane * 4;
                const f32x4 v = xv[i];
                *(u32x2*)(H0 + (size_t)row * D + k) = (u32x2){pk2(v[0], v[1]), pk2(v[2], v[3])};
#pragma unroll
                for (int e = 0; e < 8; ++e) { const f32x4 w = *(const LAS f32x4*)(wg + e * 1024 + k); acc[e] += (v[0] * w[0] + v[1] * w[1]) + (v[2] * w[2] + v[3] * w[3]); }
            }
#pragma unroll
            for (int i = 0; i < 4; ++i) xv[i] = xn[i];
#pragma unroll
            for (int e = 0; e < 8; ++e) acc[e] = wave_sum(acc[e]);
            float mine = acc[0];
#pragma unroll
            for (int e = 1; e < 8; ++e) mine = ((lane & 7) == e) ? acc[e] : mine;
            if (lane < 8) gates[(size_t)row * 8 + lane] = lane < 4 ? mine + bg : logsigmoid_(mine + bg);
        }
        __syncthreads();
    }
}

__device__ __forceinline__ bf16x8 pack_frag(const f32x16& x, int s) {
    u32x4 p; p.x = pk2(x[8 * s], x[8 * s + 1]); p.y = pk2(x[8 * s + 2], x[8 * s + 3]); p.z = pk2(x[8 * s + 4], x[8 * s + 5]); p.w = pk2(x[8 * s + 6], x[8 * s + 7]);
    return __builtin_bit_cast(bf16x8, p);
}
__device__ __forceinline__ bf16x8 ld2x64(const LAS unsigned char* p0, const LAS unsigned char* p1) {
    const u32x2 a = *(const LAS u32x2*)p0, b = *(const LAS u32x2*)p1; u32x4 r = {a.x, a.y, b.x, b.y}; return __builtin_bit_cast(bf16x8, r);
}
__device__ __forceinline__ void tr4x4(const u32x2 (&r)[4], u32x2 (&c)[4]) {
    c[0] = (u32x2){(r[0].x & 0xffffu) | (r[1].x << 16), (r[2].x & 0xffffu) | (r[3].x << 16)};
    c[1] = (u32x2){(r[0].x >> 16) | (r[1].x & 0xffff0000u), (r[2].x >> 16) | (r[3].x & 0xffff0000u)};
    c[2] = (u32x2){(r[0].y & 0xffffu) | (r[1].y << 16), (r[2].y & 0xffffu) | (r[3].y << 16)};
    c[3] = (u32x2){(r[0].y >> 16) | (r[1].y & 0xffff0000u), (r[2].y >> 16) | (r[3].y & 0xffff0000u)};
}

#define DPP_STEP_ADD(x, ctrl, rmask) x += __builtin_bit_cast(float, __builtin_amdgcn_update_dpp(0, __builtin_bit_cast(int, x), ctrl, rmask, 0xf, false))
#define DPP_STEP_MAX(x, ctrl, rmask) x = fmaxf(x, __builtin_bit_cast(float, __builtin_amdgcn_update_dpp((int)0xff800000, __builtin_bit_cast(int, x), ctrl, rmask, 0xf, false)))
__device__ __forceinline__ float scan_add64(float x) { DPP_STEP_ADD(x, 0x111, 0xf); DPP_STEP_ADD(x, 0x112, 0xf); DPP_STEP_ADD(x, 0x114, 0xf); DPP_STEP_ADD(x, 0x118, 0xf); DPP_STEP_ADD(x, 0x142, 0xa); DPP_STEP_ADD(x, 0x143, 0xc); return x; }
__device__ __forceinline__ float scan_max64(float x) { DPP_STEP_MAX(x, 0x111, 0xf); DPP_STEP_MAX(x, 0x112, 0xf); DPP_STEP_MAX(x, 0x114, 0xf); DPP_STEP_MAX(x, 0x118, 0xf); DPP_STEP_MAX(x, 0x142, 0xa); DPP_STEP_MAX(x, 0x143, 0xc); return x; }
__device__ __forceinline__ float wave_total(float x);
__device__ __forceinline__ float lane63(float x) { return __builtin_bit_cast(float, __builtin_amdgcn_readlane(__builtin_bit_cast(int, x), 63)); }
__device__ __forceinline__ float wave_total(float x) { return lane63(scan_add64(x)); }
constexpr int ML_QS = 0, ML_KS = 17408, ML_PS = 34816, ML_VT = 44032, ML_KT = 78848, ML_SC = 96256;
#ifndef ML_N0
#define ML_N0 23
#define ML_N1 18
#define ML_N2 14
#endif
__device__ __forceinline__ void mlstm_phase(LAS unsigned char* lds, const bf16_t* qkvo, const float* gates, const float* normg, bf16_t* hn, int unit_) {
    const int unit = unit_ >> 2, part_ = unit_ & 3;
    const int c_begin = part_ == 0 ? 0 : (part_ == 1 ? ML_N0 : (part_ == 2 ? ML_N0 + ML_N1 : ML_N0 + ML_N1 + ML_N2));
    const int c_end = part_ == 0 ? ML_N0 : (part_ == 1 ? ML_N0 + ML_N1 : (part_ == 2 ? ML_N0 + ML_N1 + ML_N2 : 65));
    const int tid = threadIdx.x, lane = tid & 63, wid = __builtin_amdgcn_readfirstlane(tid >> 6);
    const int b = unit >> 2, h = unit & 3;
    const int r32 = lane & 31, hh = lane >> 5, l15 = lane & 15, l4 = lane >> 4;
    LAS float* sc = (LAS float*)(lds + ML_SC);
    LAS float* Hs = (LAS float*)lds;
    const int q_row = tid >> 4, q_col = (tid & 15) * 8;
    const int k_dk = (16 * (wid & 1) + l15) * 4, k_s = (4 * (wid >> 1) + l4) * 4;
    const int v_dv = (16 * (wid & 3) + l15) * 4, v_s0 = (4 * (wid >> 2) + l4) * 4;
    f32x16 Cacc[4];
#pragma unroll
    for (int i = 0; i < 4; ++i)
#pragma unroll
        for (int j = 0; j < 16; ++j) Cacc[i][j] = 0.f;
    if (tid < 128) sc[192 + tid] = 0.f;
    float m_run = 0.f;
    u32x4 qreg[2]; u32x2 kreg[4], vreg[2][4]; float g_li = 0.f, g_lf = 0.f;
#define rowof(c, t) ((c) == 0 ? (NR + b * 16 + ((t) - 48)) : (b * SEQ + 64 * ((c) - 1) + (t)))
#define ML_PREFETCH(c) do { \
        if ((c) >= c_begin) _Pragma("unroll") for (int p = 0; p < 2; ++p) { const int t = q_row + 32 * p; const bool pad = ((c) == 0 && t < 48); \
            qreg[p] = pad ? (u32x4){0u, 0u, 0u, 0u} : *(const u32x4*)(qkvo + (size_t)rowof((c), t) * NPROJ + h * 128 + q_col); } \
        _Pragma("unroll") for (int kk = 0; kk < 4; ++kk) { const int t = k_s + kk; const bool pad = ((c) == 0 && t < 48); \
            kreg[kk] = pad ? (u32x2){0u, 0u} : *(const u32x2*)(qkvo + (size_t)rowof((c), t) * NPROJ + 512 + h * 128 + k_dk); } \
        _Pragma("unroll") for (int p = 0; p < 2; ++p) _Pragma("unroll") for (int kk = 0; kk < 4; ++kk) { const int t = v_s0 + 32 * p + kk; const bool pad = ((c) == 0 && t < 48); \
            vreg[p][kk] = pad ? (u32x2){0u, 0u} : *(const u32x2*)(qkvo + (size_t)rowof((c), t) * NPROJ + 1024 + h * 256 + v_dv); } \
        { const bool pad = ((c) == 0 && lane < 48); g_li = pad ? -1e30f : gates[(size_t)rowof((c), lane) * 8 + h]; g_lf = pad ? 0.f : gates[(size_t)rowof((c), lane) * 8 + 4 + h]; } } while (0)
    ML_PREFETCH(0);
    for (int c = 0; c < c_end; ++c) {
        const bool full = (c >= c_begin);
        const float li = g_li;
        const float lf = g_lf;
        const float bc = scan_add64(lf);
        const float av = li - bc;
        const float um = scan_max64(av);
        const float Mt = fmaxf(m_run, um);
        const float winter = __expf(m_run - Mt), bmt = bc + Mt;
        const float M63 = lane63(Mt), b63 = lane63(bc);
        const float wlast = __expf(av - M63), decay = __expf(m_run - M63);
        if (full) {
#pragma unroll
        for (int p = 0; p < 2; ++p) *(LAS u32x4*)(lds + ML_QS + (q_row + 32 * p) * 272 + q_col * 2) = qreg[p]; }
        {
            u32x2 kw[4];
#pragma unroll
            for (int kk = 0; kk < 4; ++kk) {
                if (full) *(LAS u32x2*)(lds + ML_KS + (k_s + kk) * 272 + k_dk * 2) = kreg[kk];
                const float w = __shfl(wlast, k_s + kk) * 0.08838834764831845f;
                kw[kk] = (u32x2){pk2(bflo(kreg[kk].x) * w, bfhi(kreg[kk].x) * w), pk2(bflo(kreg[kk].y) * w, bfhi(kreg[kk].y) * w)};
            }
            u32x2 kc[4]; tr4x4(kw, kc);
#pragma unroll
            for (int j = 0; j < 4; ++j) *(LAS u32x2*)(lds + ML_KT + (k_dk + j) * 136 + k_s * 2) = kc[j];
        }
#pragma unroll
        for (int p = 0; p < 2; ++p) { u32x2 vc[4]; tr4x4(vreg[p], vc);
#pragma unroll
            for (int j = 0; j < 4; ++j) *(LAS u32x2*)(lds + ML_VT + (v_dv + j) * 136 + (v_s0 + 32 * p) * 2) = vc[j]; }
        if (wid == 0) { sc[lane] = winter; sc[128 + lane] = bmt; }
        __syncthreads();
        if (c + 1 < c_end) ML_PREFETCH(c + 1);
        if (full) {
            const int ti = wid >> 1;
#pragma unroll
            for (int q = 0; q < 2; ++q) {
                const int si = 2 * (wid & 1) + q;
                f32x4 sa = {0.f, 0.f, 0.f, 0.f};
                if (si <= ti) {
#pragma unroll
                    for (int ks = 0; ks < 4; ++ks) {
                        const bf16x8 af = *(const LAS bf16x8*)(lds + ML_QS + (16 * ti + l15) * 272 + (32 * ks + 8 * l4) * 2);
                        const bf16x8 bfr = *(const LAS bf16x8*)(lds + ML_KS + (16 * si + l15) * 272 + (32 * ks + 8 * l4) * 2);
                        sa = __builtin_amdgcn_mfma_f32_16x16x32_bf16(af, bfr, sa, 0, 0, 0);
                    }
                }
                const int s = 16 * si + l15;
                const float a_s = __shfl(av, s);
#pragma unroll
                for (int r = 0; r < 4; ++r) {
                    const int t = 16 * ti + 4 * l4 + r;
                    const float Mtt = __shfl(Mt, t);
                    const float w = (s <= t) ? __expf(a_s - Mtt) : 0.f;
                    *(LAS bf16_t*)(lds + ML_PS + t * 144 + s * 2) = f2bf(sa[r] * 0.08838834764831845f * w);
                }
            }
        }
        bf16x8 vf[4];
#pragma unroll
        for (int ks = 0; ks < 4; ++ks) { const LAS unsigned char* p = lds + ML_VT + (32 * wid + r32) * 136 + (16 * ks + 8 * hh) * 2; vf[ks] = ld2x64(p, p + 8); }
        if (full) {
        __syncthreads();
        {
            const int t = tid >> 3, part = tid & 7;
            float qn = 0.f, ps = 0.f;
            const u32x4 q0 = *(const LAS u32x4*)(lds + ML_QS + t * 272 + part * 32), q1 = *(const LAS u32x4*)(lds + ML_QS + t * 272 + part * 32 + 16);
            float qv[16]; { float t8[8]; g8::unpack8(q0, t8);
#pragma unroll
                for (int j = 0; j < 8; ++j) qv[j] = t8[j]; g8::unpack8(q1, t8);
#pragma unroll
                for (int j = 0; j < 8; ++j) qv[8 + j] = t8[j]; }
#pragma unroll
            for (int j = 0; j < 16; ++j) qn += qv[j] * sc[192 + part * 16 + j];
            const u32x4 pw = *(const LAS u32x4*)(lds + ML_PS + t * 144 + part * 16);
            float pv[8]; g8::unpack8(pw, pv);
#pragma unroll
            for (int j = 0; j < 8; ++j) ps += pv[j];
            qn += __shfl_xor(qn, 1); qn += __shfl_xor(qn, 2); qn += __shfl_xor(qn, 4);
            ps += __shfl_xor(ps, 1); ps += __shfl_xor(ps, 2); ps += __shfl_xor(ps, 4);
            if (part == 0) { const float den = sc[t] * qn + ps; sc[64 + t] = __builtin_amdgcn_rcpf(fmaxf(fabsf(den), __expf(-sc[128 + t]))); }
        }
        f32x16 num[2];
#pragma unroll
        for (int tt = 0; tt < 2; ++tt) {
#pragma unroll
            for (int j = 0; j < 16; ++j) num[tt][j] = 0.f;
#pragma unroll
            for (int dkt = 0; dkt < 4; ++dkt)
#pragma unroll
                for (int s2 = 0; s2 < 2; ++s2) {
                    const LAS unsigned char* p = lds + ML_QS + (32 * tt + r32) * 272 + (32 * dkt + 16 * s2 + 4 * hh) * 2;
                    const bf16x8 af = ld2x64(p, p + 16);
                    num[tt] = __builtin_amdgcn_mfma_f32_32x32x16_bf16(af, pack_frag(Cacc[dkt], s2), num[tt], 0, 0, 0);
                }
#pragma unroll
            for (int gq = 0; gq < 4; ++gq) { const f32x4 wv = *(const LAS f32x4*)(sc + 32 * tt + 8 * gq + 4 * hh);
#pragma unroll
                for (int r = 0; r < 4; ++r) num[tt][4 * gq + r] *= wv[r]; }
#pragma unroll
            for (int ks = 0; ks < 4; ++ks) {
                if (tt == 0 && ks >= 2) continue;
                const bf16x8 pf = *(const LAS bf16x8*)(lds + ML_PS + (32 * tt + r32) * 144 + (16 * ks + 8 * hh) * 2);
                num[tt] = __builtin_amdgcn_mfma_f32_32x32x16_bf16(pf, vf[ks], num[tt], 0, 0, 0);
            }
        }
        __syncthreads();
        u32x2 oreg[8];
        { const int t = tid >> 3, part = tid & 7; const bool pad = (c == 0 && t < 48); const size_t row = pad ? 0 : (size_t)rowof(c, t);
#pragma unroll
            for (int i = 0; i < 8; ++i) oreg[i] = *(const u32x2*)(qkvo + row * NPROJ + 2048 + h * 256 + 32 * i + 4 * part); }
#pragma unroll
        for (int tt = 0; tt < 2; ++tt)
#pragma unroll
            for (int gq = 0; gq < 4; ++gq) { const f32x4 iv = *(const LAS f32x4*)(sc + 64 + 32 * tt + 8 * gq + 4 * hh);
#pragma unroll
                for (int r = 0; r < 4; ++r) Hs[(32 * tt + 8 * gq + 4 * hh + r) * 260 + 32 * wid + r32] = num[tt][4 * gq + r] * iv[r]; }
        __syncthreads();
        {
            const int t = tid >> 3, part = tid & 7;
            f32x4 x[8]; float s1 = 0.f;
#pragma unroll
            for (int i = 0; i < 8; ++i) { x[i] = *(const LAS f32x4*)(Hs + t * 260 + 32 * i + 4 * part); s1 += (x[i][0] + x[i][1]) + (x[i][2] + x[i][3]); }
            s1 += __shfl_xor(s1, 1); s1 += __shfl_xor(s1, 2); s1 += __shfl_xor(s1, 4);
            const float mean = s1 * (1.0f / 256.0f); float s2 = 0.f;
#pragma unroll
            for (int i = 0; i < 8; ++i) { const f32x4 d = x[i] - mean; s2 += (d[0] * d[0] + d[1] * d[1]) + (d[2] * d[2] + d[3] * d[3]); }
            s2 += __shfl_xor(s2, 1); s2 += __shfl_xor(s2, 2); s2 += __shfl_xor(s2, 4);
            const float rstd = rsqrtf(s2 * (1.0f / 256.0f) + LN_EPS);
            if (!(c == 0 && t < 48)) {
                const size_t row = (size_t)rowof(c, t);
#pragma unroll
                for (int i = 0; i < 8; ++i) {
                    const int dv = 32 * i + 4 * part;
                    const u32x2 ow = oreg[i];
                    const f32x4 ng = *(const f32x4*)(normg + h * 256 + dv);
                    const float o0 = sigmoidf_(bflo(ow.x)), o1 = sigmoidf_(bfhi(ow.x)), o2 = sigmoidf_(bflo(ow.y)), o3 = sigmoidf_(bfhi(ow.y));
                    const f32x4 y = (x[i] - mean) * rstd * ng;
                    *(u32x2*)(hn + row * D + h * 256 + dv) = (u32x2){pk2(y[0] * o0, y[1] * o1), pk2(y[2] * o2, y[3] * o3)};
                }
            }
        }
        }
#pragma unroll
        for (int dkt = 0; dkt < 4; ++dkt) {
#pragma unroll
            for (int j = 0; j < 16; ++j) Cacc[dkt][j] *= decay;
#pragma unroll
            for (int ks = 0; ks < 4; ++ks) { const LAS unsigned char* p = lds + ML_KT + (32 * dkt + r32) * 136 + (16 * ks + 8 * hh) * 2;
                Cacc[dkt] = __builtin_amdgcn_mfma_f32_32x32x16_bf16(ld2x64(p, p + 8), vf[ks], Cacc[dkt], 0, 0, 0); }
        }
        {
            const int dk = tid >> 2, part = tid & 3;
            const u32x2 k0 = *(const LAS u32x2*)(lds + ML_KT + dk * 136 + part * 32), k1 = *(const LAS u32x2*)(lds + ML_KT + dk * 136 + part * 32 + 8),
                        k2 = *(const LAS u32x2*)(lds + ML_KT + dk * 136 + part * 32 + 16), k3 = *(const LAS u32x2*)(lds + ML_KT + dk * 136 + part * 32 + 24);
            float s = ((bflo(k0.x) + bfhi(k0.x)) + (bflo(k0.y) + bfhi(k0.y))) + ((bflo(k1.x) + bfhi(k1.x)) + (bflo(k1.y) + bfhi(k1.y)))
                    + ((bflo(k2.x) + bfhi(k2.x)) + (bflo(k2.y) + bfhi(k2.y))) + ((bflo(k3.x) + bfhi(k3.x)) + (bflo(k3.y) + bfhi(k3.y)));
            s += __shfl_xor(s, 1); s += __shfl_xor(s, 2);
            if (part == 0) sc[192 + dk] = decay * sc[192 + dk] + s;
        }
        m_run = b63 + M63;
        __syncthreads();
    }
#undef ML_PREFETCH
#undef rowof
}

constexpr int AT_K0 = 0, AT_V0 = 17408, AT_BUF = 34816, AT_FLAGS = 2 * AT_BUF;
__device__ __forceinline__ void at_tile(const LAS unsigned char* Kb, const LAS unsigned char* Vb, int k0, int tmin, int r32, int hh, const bf16x8 (&qf)[8], f32x16 (&O)[4], float& P) {
    f32x16 S[2];
#pragma unroll
    for (int u = 0; u < 2; ++u) {
#pragma unroll
        for (int j = 0; j < 16; ++j) S[u][j] = 0.f;
#pragma unroll
        for (int ks = 0; ks < 8; ++ks) {
            const bf16x8 kf = *(const LAS bf16x8*)(Kb + (32 * u + r32) * 272 + (16 * ks + 8 * hh) * 2);
            S[u] = __builtin_amdgcn_mfma_f32_32x32x16_bf16(kf, qf[ks], S[u], 0, 0, 0);
        }
    }
    const bool full = (k0 + 63 < tmin) && (k0 >= 128);
    const int lim = tmin + r32 - k0 - 4 * hh;
    const int lo = 112 - k0 - 4 * hh;
    float Tt[2][4];
#define AT_ELEM(MASKED) \
    _Pragma("unroll") for (int u = 0; u < 2; ++u) _Pragma("unroll") for (int gq = 0; gq < 4; ++gq) { \
        float x4[4]; \
        _Pragma("unroll") for (int r = 0; r < 4; ++r) { \
            float zz = S[u][4 * gq + r] * (0.08838834764831845f * 1.4426950408889634f); \
            if (MASKED) { const int o = 32 * u + 8 * gq + r; zz = (o < lim && o >= lo) ? zz : -1.0e4f; } \
            const float rc = __builtin_amdgcn_rcpf(1.0f + __builtin_amdgcn_exp2f(zz)); \
            S[u][4 * gq + r] = 1.0f - rc; x4[r] = rc; } \
        const float e2 = x4[3], e1 = e2 * x4[2], e0 = e1 * x4[1]; \
        Tt[u][gq] = e0 * x4[0]; \
        S[u][4 * gq + 2] *= e2; S[u][4 * gq + 1] *= e1; S[u][4 * gq + 0] *= e0; }
    if (full) { AT_ELEM(false) } else { AT_ELEM(true) }
#undef AT_ELEM
    float acc = P;
#pragma unroll
    for (int u = 1; u >= 0; --u)
#pragma unroll
        for (int gq = 3; gq >= 0; --gq) {
            float t0; const float t1 = swap32_hi(Tt[u][gq], t0);
            const float Rr = hh ? acc : acc * t1;
            acc = (acc * t1) * t0;
#pragma unroll
            for (int r = 0; r < 4; ++r) S[u][4 * gq + r] *= Rr;
        }
    P = acc;
#pragma unroll
    for (int u = 0; u < 2; ++u)
#pragma unroll
        for (int s2 = 0; s2 < 2; ++s2) {
            const bf16x8 af = pack_frag(S[u], s2);
#pragma unroll
            for (int dt = 0; dt < 4; ++dt) {
                const LAS unsigned char* p = Vb + (32 * dt + r32) * 136 + (32 * u + 16 * s2 + 4 * hh) * 2;
                O[dt] = __builtin_amdgcn_mfma_f32_32x32x16_bf16(af, ld2x64(p, p + 16), O[dt], 0, 0, 0);
            }
        }
}
__device__ __forceinline__ void attn_phase(LAS unsigned char* lds, const bf16_t* kvq, bf16_t* ao) {
    const int tid = threadIdx.x, lane = tid & 63, wid = __builtin_amdgcn_readfirstlane(tid >> 6);
    const int r32 = lane & 31, hh = lane >> 5, l15 = lane & 15, l4 = lane >> 4;
    LAS unsigned* flags = (LAS unsigned*)(lds + AT_FLAGS);
    const int k_row = tid >> 4, k_col = (tid & 15) * 8;
    const int v_d = (16 * (wid & 1) + l15) * 4, v_s = (4 * (wid >> 1) + l4) * 4;
    for (int unit = blockIdx.x; unit < NB * 8 * 16; unit += gridDim.x) {
        const int qt = unit & 15, head = (unit >> 4) & 7, b = unit >> 7;
        const int q0 = 128 + 256 * qt, tmin = q0 + 32 * wid;
#define rowofp(p) ((p) >= 128 ? b * SEQ + (p) - 128 : ((p) >= 112 ? NR + b * 16 + (p) - 112 : NR + b * 16))
        bf16x8 qf[8];
        { const bf16_t* qp = kvq + (size_t)(b * SEQ + tmin - 128 + r32) * NPROJ + 2048 + head * 128 + 8 * hh;
#pragma unroll
            for (int ks = 0; ks < 8; ++ks) qf[ks] = *(const bf16x8*)(qp + 16 * ks); }
        f32x16 O[4];
#pragma unroll
        for (int i = 0; i < 4; ++i)
#pragma unroll
            for (int j = 0; j < 16; ++j) O[i][j] = 0.f;
        float P = 1.0f;
        const int kt_hi = (q0 >> 6) + 3;
        u32x4 kregA[2], kregB[2]; u32x2 vregA[4], vregB[4];
#define AT_LOAD(kreg, vreg, kt) do { \
        _Pragma("unroll") for (int p = 0; p < 2; ++p) kreg[p] = *(const u32x4*)(kvq + (size_t)rowofp(64 * (kt) + k_row + 32 * p) * NPROJ + head * 128 + k_col); \
        _Pragma("unroll") for (int kk = 0; kk < 4; ++kk) vreg[kk] = *(const u32x2*)(kvq + (size_t)rowofp(64 * (kt) + v_s + kk) * NPROJ + 1024 + head * 128 + v_d); } while (0)
#define AT_STORE(kreg, vreg, buf) do { LAS unsigned char* base = lds + (buf) * AT_BUF; \
        _Pragma("unroll") for (int p = 0; p < 2; ++p) *(LAS u32x4*)(base + AT_K0 + (k_row + 32 * p) * 272 + k_col * 2) = kreg[p]; \
        u32x2 vc[4]; tr4x4(vreg, vc); \
        _Pragma("unroll") for (int j = 0; j < 4; ++j) *(LAS u32x2*)(base + AT_V0 + (v_d + j) * 136 + v_s * 2) = vc[j]; } while (0)
#define AT_ITER(BUF, LOADSET_K, LOADSET_V, STORESET_K, STORESET_V) { \
            const int kt = kt_hi - it; \
            __syncthreads(); \
            if (it > 0 && flags[it - 1] == 0u) break; \
            if (kt - 2 >= 1) AT_LOAD(LOADSET_K, LOADSET_V, kt - 2); \
            if (64 * kt < tmin + 31) at_tile(lds + (BUF) * AT_BUF + AT_K0, lds + (BUF) * AT_BUF + AT_V0, 64 * kt, tmin, r32, hh, qf, O, P); \
            if (__ballot(P >= 1e-30f) != 0ull && lane == 0) flags[it] = 1u; \
            if (kt - 1 < 1) break; \
            AT_STORE(STORESET_K, STORESET_V, 1 - (BUF)); \
            ++it; }
        if (tid < 80) flags[tid] = 0u;
        AT_LOAD(kregA, vregA, kt_hi);
        AT_STORE(kregA, vregA, 0);
        AT_LOAD(kregB, vregB, kt_hi - 1);
        for (int it = 0; ; ) {
            AT_ITER(0, kregA, vregA, kregB, vregB)
            AT_ITER(1, kregB, vregB, kregA, vregA)
        }
#pragma unroll
        for (int dt = 0; dt < 4; ++dt)
#pragma unroll
            for (int j = 0; j < 16; ++j) {
                const int t = tmin + (j & 3) + 8 * (j >> 2) + 4 * hh;
                ao[(size_t)(b * SEQ + t - 128) * D + head * 128 + 32 * dt + r32] = f2bf(O[dt][j]);
            }
        __syncthreads();
    }
#undef AT_LOAD
#undef AT_STORE
#undef AT_ITER
#undef rowofp
}

__device__ __forceinline__ void ln_row_stats_wave(const float* st, int row, int lane, float& mu, float& rstd) {
    const f32x2 p = *(const f32x2*)(st + (size_t)row * 32 + (lane & 15) * 2);
    float s1 = p[0], s2 = p[1];
#pragma unroll
    for (int o = 1; o < 16; o <<= 1) { s1 += __shfl_xor(s1, o); s2 += __shfl_xor(s2, o); }
    mu = s1 * (1.0f / 1024.0f); const float var = fmaxf(s2 * (1.0f / 1024.0f) - mu * mu, 0.f); rstd = rsqrtf(var + LN_EPS);
}
__device__ __forceinline__ void router1_phase(LAS unsigned char* lds, const Args& a) {
    const int tid = threadIdx.x, lane = tid & 63, wid = tid >> 6;
    unsigned char* ws = a.ws;
    const float* g3 = a.in[16] + 2048; const float* b3 = a.in[17] + 2048; const float* wr = a.in[12];
    LAS float* gw = (LAS float*)lds;
    LAS float* cc = (LAS float*)(lds + 32768);
    LAS int* cnt = (LAS int*)(lds + 32768 + 64);
    __syncthreads();
    for (int i = tid; i < 8192; i += NTHREADS) { const int k = i >> 3, e = i & 7; gw[e * 1024 + k] = g3[k] * wr[i]; }
    if (tid < 8) cnt[tid] = 0;
    __syncthreads();
    { float s1 = 0.f, s2 = 0.f;
        for (int k = lane; k < 1024; k += 64) { s1 += gw[wid * 1024 + k]; s2 += b3[k] * wr[k * 8 + wid]; }
        s1 = wave_sum(s1); s2 = wave_sum(s2);
        if (lane == 0) { cc[wid] = s1; cc[8 + wid] = s2; } }
    __syncthreads();
    const bf16_t* z3 = (const bf16_t*)(ws + WS_RC); const float* st3 = (const float*)(ws + WS_ST3);
    f32x4* route = (f32x4*)(ws + WS_ROUTE);
    const int tok0 = (int)(((long)NR * blockIdx.x) / gridDim.x), tok1 = (int)(((long)NR * (blockIdx.x + 1)) / gridDim.x);
    u32x4 zr[2]; f32x2 sp;
#define RT_LOAD(t) do { zr[0] = *(const u32x4*)(z3 + (size_t)(t) * D + lane * 8); zr[1] = *(const u32x4*)(z3 + (size_t)(t) * D + 512 + lane * 8); sp = *(const f32x2*)(st3 + (size_t)(t) * 32 + (lane & 15) * 2); } while (0)
    if (tok0 + wid < tok1) RT_LOAD(tok0 + wid);
    for (int tok = tok0 + wid; tok < tok1; tok += 8) {
        const u32x4 zc[2] = {zr[0], zr[1]}; const f32x2 spc = sp;
        if (tok + 8 < tok1) RT_LOAD(tok + 8);
        float s1 = spc[0], s2 = spc[1];
#pragma unroll
        for (int o = 1; o < 16; o <<= 1) { s1 += __shfl_xor(s1, o); s2 += __shfl_xor(s2, o); }
        const float mu = s1 * (1.0f / 1024.0f); const float rstd = rsqrtf(fmaxf(s2 * (1.0f / 1024.0f) - mu * mu, 0.f) + LN_EPS);
        float acc[8] = {0.f, 0.f, 0.f, 0.f, 0.f, 0.f, 0.f, 0.f};
#pragma unroll
        for (int hf = 0; hf < 2; ++hf) {
            const int k = hf * 512 + lane * 8;
            float z[8]; g8::unpack8(zc[hf], z);
#pragma unroll
            for (int e = 0; e < 8; ++e) { const f32x4 w0 = *(const LAS f32x4*)(gw + e * 1024 + k), w1 = *(const LAS f32x4*)(gw + e * 1024 + k + 4);
                acc[e] += ((z[0] * w0[0] + z[1] * w0[1]) + (z[2] * w0[2] + z[3] * w0[3])) + ((z[4] * w1[0] + z[5] * w1[1]) + (z[6] * w1[2] + z[7] * w1[3])); }
        }
        float lg[8];
#pragma unroll
        for (int e = 0; e < 8; ++e) lg[e] = rstd * (wave_total(acc[e]) - mu * cc[e]) + cc[8 + e];
        int e1 = 0; float v1 = lg[0];
#pragma unroll
        for (int e = 1; e < 8; ++e) if (lg[e] > v1) { v1 = lg[e]; e1 = e; }
        int e2 = -1; float v2 = -3.0e38f;
#pragma unroll
        for (int e = 0; e < 8; ++e) if (e != e1 && lg[e] > v2) { v2 = lg[e]; e2 = e; }
        const float g1 = 1.0f / (1.0f + expf(v2 - v1));
        if (lane == 0) { ((f32x2*)(ws + WS_TOKST))[tok] = (f32x2){mu, rstd}; route[tok] = (f32x4){__int_as_float(e1 | (e2 << 8)), g1, 1.0f - g1, 0.f}; __hip_atomic_fetch_add(&cnt[e1], 1, __ATOMIC_RELAXED, __HIP_MEMORY_SCOPE_WORKGROUP); __hip_atomic_fetch_add(&cnt[e2], 1, __ATOMIC_RELAXED, __HIP_MEMORY_SCOPE_WORKGROUP); }
    }
    __syncthreads();
    if (tid < 8) ((int*)(ws + WS_CNT))[blockIdx.x * 8 + tid] = cnt[tid];
}
__device__ __forceinline__ void router2_phase(LAS unsigned char* lds, const Args& a) {
    const int tid = threadIdx.x, lane = tid & 63, wid = tid >> 6;
    unsigned char* ws = a.ws;
    const int G = gridDim.x, wg = blockIdx.x;
    LAS int* cn = (LAS int*)lds;
    LAS int* tot = (LAS int*)(lds + 16384);
    __syncthreads();
    const int* cnts = (const int*)(ws + WS_CNT);
    for (int i = tid; i < G * 8; i += NTHREADS) cn[i] = cnts[i];
    __syncthreads();
    { int t = 0, p = 0;
        for (int w = lane; w < G; w += 64) { const int v = cn[w * 8 + wid]; t += v; p += (w < wg) ? v : 0; }
#pragma unroll
        for (int o = 32; o >= 1; o >>= 1) { t += __shfl_xor(t, o); p += __shfl_xor(p, o); }
        if (lane == 0) { tot[wid] = t; tot[8 + wid] = p; } }
    __syncthreads();
    if (tid == 0) { int ps = 0;
        for (int e = 0; e < 8; ++e) { tot[24 + e] = ps; tot[16 + e] = ps + tot[8 + e]; ps += ((tot[e] + 255) >> 8) << 8; }
        if (wg == 0) { int* hdr = (int*)(ws + WS_HDR); int pp = 0; for (int e = 0; e < 8; ++e) { pp += (tot[e] + 255) >> 8; hdr[e] = pp; } hdr[8] = pp; } }
    __syncthreads();
    u32x2* smeta = (u32x2*)(ws + WS_TOK); f32x2* sstat = (f32x2*)(ws + WS_GATEB); const f32x2* tokst = (const f32x2*)(ws + WS_TOKST);
    const f32x4* route = (const f32x4*)(ws + WS_ROUTE);
    const int tok0 = (int)(((long)NR * wg) / G), tok1 = (int)(((long)NR * (wg + 1)) / G);
    { const int e = wid; int run = tot[16 + e];
        for (int q0 = 2 * tok0; q0 < 2 * tok1; q0 += 64) {
            const int q = q0 + lane; bool match = false; float gt = 0.f;
            if (q < 2 * tok1) { const f32x4 r = route[q >> 1]; const int ee = __float_as_int(r[0]); const int ex = (q & 1) ? ((ee >> 8) & 0xff) : (ee & 0xff); match = (ex == e); gt = (q & 1) ? r[2] : r[1]; }
            const unsigned long long mask = __ballot(match);
            const int pos = __popcll(mask & ((1ull << lane) - 1ull));
            if (match) { smeta[run + pos] = (u32x2){(unsigned)q, __float_as_uint(gt)}; sstat[run + pos] = tokst[q >> 1]; }
            run += __popcll(mask);
        }
        if (wg == 0) { const int s0 = tot[24 + e] + tot[e], s1 = tot[24 + e] + (((tot[e] + 255) >> 8) << 8);
            for (int s = s0 + lane; s < s1; s += 64) { smeta[s] = (u32x2){0xffffffffu, 0u}; sstat[s] = (f32x2){0.f, 1.f}; } }
    }
}

__device__ __forceinline__ float wave_total(float x);
__device__ __forceinline__ void final_phase(const Args& a) {
    const int tid = threadIdx.x, lane = tid & 63, wid = tid >> 6;
    unsigned char* ws = a.ws;
    const bf16_t* z3 = (const bf16_t*)(ws + WS_RC); const float* st3 = (const float*)(ws + WS_ST3);
    const bf16_t* Y0 = (const bf16_t*)(ws + WS_RB); const bf16_t* Y1 = (const bf16_t*)(ws + WS_RD);
    const float* g3 = a.in[16] + 2048; const float* b3 = a.in[17] + 2048; const float* g4 = a.in[16] + 3072; const float* b4 = a.in[17] + 3072;
    float G3[16], B3[16], G4[16], B4[16];
#pragma unroll
    for (int hf = 0; hf < 2; ++hf)
#pragma unroll
        for (int q = 0; q < 2; ++q) { const int k = hf * 512 + lane * 8 + q * 4;
            const f32x4 a3 = *(const f32x4*)(g3 + k), c3 = *(const f32x4*)(b3 + k), a4 = *(const f32x4*)(g4 + k), c4 = *(const f32x4*)(b4 + k);
#pragma unroll
            for (int j = 0; j < 4; ++j) { G3[hf * 8 + q * 4 + j] = a3[j] * ALPHA; B3[hf * 8 + q * 4 + j] = c3[j] * ALPHA; G4[hf * 8 + q * 4 + j] = a4[j]; B4[hf * 8 + q * 4 + j] = c4[j]; } }
    const int stride = gridDim.x * 8;
    int tok = blockIdx.x * 8 + wid;
    u32x4 zr[2], y0r[2], y1r[2]; f32x2 sp;
#define FIN_LOAD(t) do { _Pragma("unroll") for (int hf = 0; hf < 2; ++hf) { const size_t o = (size_t)(t) * D + hf * 512 + lane * 8; \
        zr[hf] = *(const u32x4*)(z3 + o); y0r[hf] = *(const u32x4*)(Y0 + o); y1r[hf] = *(const u32x4*)(Y1 + o); } \
        sp = *(const f32x2*)(st3 + (size_t)(t) * 32 + (lane & 15) * 2); } while (0)
    if (tok < NR) FIN_LOAD(tok);
    for (; tok < NR; tok += stride) {
        u32x4 zc[2] = {zr[0], zr[1]}, y0c[2] = {y0r[0], y0r[1]}, y1c[2] = {y1r[0], y1r[1]}; const f32x2 spc = sp;
        if (tok + stride < NR) FIN_LOAD(tok + stride);
        float s1 = spc[0], s2 = spc[1];
#pragma unroll
        for (int o = 1; o < 16; o <<= 1) { s1 += __shfl_xor(s1, o); s2 += __shfl_xor(s2, o); }
        const float mu = s1 * (1.0f / 1024.0f); const float rstd = rsqrtf(fmaxf(s2 * (1.0f / 1024.0f) - mu * mu, 0.f) + LN_EPS);
        float v[16]; float t1 = 0.f;
#pragma unroll
        for (int hf = 0; hf < 2; ++hf) {
            float z[8], y0[8], y1[8];
            g8::unpack8(zc[hf], z); g8::unpack8(y0c[hf], y0); g8::unpack8(y1c[hf], y1);
#pragma unroll
            for (int j = 0; j < 8; ++j) { const float x = ((z[j] - mu) * rstd * G3[hf * 8 + j] + B3[hf * 8 + j]) + (y0[j] + y1[j]); v[hf * 8 + j] = x; t1 += x; }
        }
        t1 = wave_total(t1); const float mean = t1 * (1.0f / 1024.0f); float t2 = 0.f;
#pragma unroll
        for (int j = 0; j < 16; ++j) { const float d = v[j] - mean; t2 += d * d; }
        t2 = wave_total(t2); const float rs = rsqrtf(t2 * (1.0f / 1024.0f) + LN_EPS);
#pragma unroll
        for (int hf = 0; hf < 2; ++hf) {
            const int k = hf * 512 + lane * 8;
            f32x4 o0, o1;
#pragma unroll
            for (int j = 0; j < 4; ++j) { o0[j] = (v[hf * 8 + j] - mean) * rs * G4[hf * 8 + j] + B4[hf * 8 + j]; o1[j] = (v[hf * 8 + 4 + j] - mean) * rs * G4[hf * 8 + 4 + j] + B4[hf * 8 + 4 + j]; }
            *(f32x4*)(a.out + (size_t)tok * D + k) = o0; *(f32x4*)(a.out + (size_t)tok * D + k + 4) = o1;
        }
    }
#undef FIN_LOAD
}

__device__ __forceinline__ void moefix_phase(const Args& a) {
    const int lane = threadIdx.x & 63, wid = threadIdx.x >> 6;
    unsigned char* ws = a.ws;
    const int npan = ((const int*)(ws + WS_HDR))[8];
    const int p_lo = (MOE_NCHUNK - 1) * MOE_CHUNK_PAN + MOE_CHUNK_PAN;
    const int nrows = (npan - p_lo) * 256;
    const u32x2* smeta = (const u32x2*)(ws + WS_TOK);
    const float* P = (const float*)(ws + WS_RA + RA_POFF);
    bf16_t* Y0 = (bf16_t*)(ws + WS_RB); bf16_t* Y1 = (bf16_t*)(ws + WS_RD);
    for (int r = blockIdx.x * 8 + wid; r < nrows; r += gridDim.x * 8) {
        const u32x2 mg = smeta[(size_t)p_lo * 256 + r];
        const int id = (int)mg.x; const float gt = __uint_as_float(mg.y);
        if (id < 0) continue;
        bf16_t* yrow = ((id & 1) ? Y1 : Y0) + (size_t)(id >> 1) * D;
#pragma unroll
        for (int hf = 0; hf < 2; ++hf) {
            const int c = hf * 512 + lane * 8;
            f32x4 s0 = {0.f, 0.f, 0.f, 0.f}, s1 = {0.f, 0.f, 0.f, 0.f};
#pragma unroll
            for (int ks = 0; ks < MOE_KSPLIT; ++ks) { const float* pp = P + ((size_t)ks * 2048 + r) * D + c; s0 += *(const f32x4*)pp; s1 += *(const f32x4*)(pp + 4); }
            *(u32x4*)(yrow + c) = g8::pack8(s0 * gt, s1 * gt);
        }
    }
}
__device__ __forceinline__ void finstats_phase(const float* st, float* rs, int nrows) {
    for (int row = blockIdx.x * NTHREADS + threadIdx.x; row < nrows; row += gridDim.x * NTHREADS) {
        const f32x4* p = (const f32x4*)(st + (size_t)row * 32);
        float s1 = 0.f, s2 = 0.f;
#pragma unroll
        for (int i = 0; i < 8; ++i) { const f32x4 a = p[i]; s1 += a[0] + a[2]; s2 += a[1] + a[3]; }
        const float mu = s1 * (1.0f / 1024.0f); const float rstd = rsqrtf(fmaxf(s2 * (1.0f / 1024.0f) - mu * mu, 0.f) + LN_EPS);
        *(f32x2*)(rs + (size_t)row * 2) = (f32x2){mu, rstd};
    }
}
__global__ void __launch_bounds__(NTHREADS, 2) yoco_fwd(Args args) {
    extern __shared__ __attribute__((aligned(16))) unsigned char lds_raw[];
    LAS unsigned char* lds = (LAS unsigned char*)lds_raw;
    unsigned char* ws = args.ws;
    const int G = gridDim.x;
    const int lo = args.ph_lo, hi = args.ph_hi;
    volatile LAS unsigned* misc = (volatile LAS unsigned*)(lds + LDS_MAIN);
    if (threadIdx.x < 4) misc[threadIdx.x] = 0u;
    __syncthreads();
    XcdBarrier bar; bar.bar = (unsigned*)(ws + WS_CTL); bar.x = 0; bar.st = misc;
    if (hi - lo > 1) bar = xcd_barrier_post((unsigned*)(ws + WS_CTL), misc);
#ifndef PHASE_MASK
#define PHASE_MASK 0xFFFFFFFFu
#endif
#define IN(k) (((PHASE_MASK >> (k)) & 1u) && lo <= (k) && (k) < hi)
#define SEAM(k) do { if (IN(k) && IN((k) + 1)) xcd_barrier(bar); } while (0)
    bf16_t* RA = (bf16_t*)(ws + WS_RA); bf16_t* RB = (bf16_t*)(ws + WS_RB); bf16_t* RC = (bf16_t*)(ws + WS_RC); bf16_t* RD = (bf16_t*)(ws + WS_RD);
    float* vec = (float*)(ws + WS_VEC);
    float* st1 = (float*)(ws + WS_ST1); float* st2 = (float*)(ws + WS_ST2); float* st3 = (float*)(ws + WS_ST3);
    const float* ln_g = args.in[16]; const float* ln_b = args.in[17];

#define RUN(k, ...) do { if constexpr (((REPMASK) >> (k)) & 1u) { if (IN(k)) { __VA_ARGS__ } xcd_barrier(bar); } if (IN(k)) { __VA_ARGS__ } SEAM(k); } while (0)
    RUN(PH_PRO, prologue_phase(lds, args););
    RUN(PH_PROJ,
        g8::Gemm g{RB, (const bf16_t*)(ws + WS_WIN), D, nullptr, nullptr, nullptr}; g8::DenseOrder S; S.init(NPAN, NPROJ / 256, D, G, (int)blockIdx.x);
        g8::EpiPlain E{RA, NPROJ};
        g8::gemm_phase<g8::EpiPlain, g8::DenseOrder, false>(lds, g, S, E); tail_jobs(lds, args, PH_PROJ););
    RUN(PH_MLSTM, if ((int)blockIdx.x < 256) mlstm_phase(lds, RA, (const float*)(ws + WS_GATES), args.in[4], RD, (int)blockIdx.x););
    RUN(PH_WOUT,
        g8::Gemm g{RD, (const bf16_t*)(ws + WS_WOUT), D, nullptr, nullptr, nullptr}; g8::DenseOrder S; S.init(NPAN, 4, D, G, (int)blockIdx.x);
        g8::EpiRes<0> E{RC, RB, st1, lds + LDS_META, nullptr, nullptr};
        g8::gemm_phase<g8::EpiRes<0>, g8::DenseOrder, false>(lds, g, S, E); tail_jobs(lds, args, PH_WOUT););
    RUN(PH_FIN1, finstats_phase(st1, (float*)(ws + WS_RS1), NROWS););
    RUN(PH_GU,
        g8::Gemm g{RC, (const bf16_t*)(ws + WS_WGU), D, nullptr, nullptr, ws + WS_RS1}; g8::DenseOrder S; S.init(NPAN, 2 * FFD / 256, D, G, (int)blockIdx.x);
        g8::EpiGlu<false> E{RA, FFD, st1, vec + VEC_GU_CS, vec + VEC_GU_BW, lds + LDS_META, 0};
        g8::gemm_phase<g8::EpiGlu<false>, g8::DenseOrder, false, 3>(lds, g, S, E); tail_jobs(lds, args, PH_GU););
    RUN(PH_DN,
        g8::Gemm g{RA, (const bf16_t*)(ws + WS_WDN), FFD, nullptr, nullptr, ws + WS_RS1}; g8::DenseOrder S; S.init(NPAN, 4, FFD, G, (int)blockIdx.x);
        g8::EpiRes<1> E{RB, RC, st2, lds + LDS_META, ln_g, ln_b};
        g8::gemm_phase<g8::EpiRes<1>, g8::DenseOrder, false, 3>(lds, g, S, E); tail_jobs(lds, args, PH_DN););
    RUN(PH_FIN2, finstats_phase(st2, (float*)(ws + WS_RS2), NROWS););
    RUN(PH_KVQ,
        g8::Gemm g{RB, (const bf16_t*)(ws + WS_WKVQ), D, nullptr, nullptr, ws + WS_RS2}; g8::DenseOrder S; S.init(NPAN, NPROJ / 256, D, G, (int)blockIdx.x);
        g8::EpiFold E{RA, NPROJ, lds + LDS_META, vec + VEC_KVQ_CS, vec + VEC_KVQ_BW};
        g8::gemm_phase<g8::EpiFold, g8::DenseOrder, false, 3>(lds, g, S, E););
    RUN(PH_ATT, attn_phase(lds, RA, RD););
    RUN(PH_WO,
        g8::Gemm g{RD, (const bf16_t*)(ws + WS_WO), D, nullptr, nullptr, ws + WS_RS2}; g8::DenseOrder S; S.init(NR / 256, 4, D, G, (int)blockIdx.x);
        g8::EpiRes<1> E{RC, RB, st3, lds + LDS_META, ln_g + 1024, ln_b + 1024};
        g8::gemm_phase<g8::EpiRes<1>, g8::DenseOrder, false, 3>(lds, g, S, E););
    RUN(PH_RT1, router1_phase(lds, args););
    RUN(PH_RT2, router2_phase(lds, args););
#define MOE_CHUNK(cidx) \
    RUN(PH_MOE0 + 2 * (cidx), const int* hdr = (const int*)(ws + WS_HDR); const int npan = hdr[8]; const int p0 = (cidx) * MOE_CHUNK_PAN; \
        { g8::MoeOrder S; S.p0 = p0; S.np = ((cidx) == MOE_NCHUNK - 1) ? (npan - p0) : MOE_CHUNK_PAN; S.nfull = S.np; S.nsplit = 1; S.nN = 2 * FFE / 256; S.G = G; S.c = (int)blockIdx.x; S.K = D; S.estride = (unsigned)(2 * FFE * D * 2); \
            _Pragma("unroll") for (int e = 0; e < NE; ++e) S.pend[e] = hdr[e]; \
            g8::Gemm g{RC, (const bf16_t*)(ws + WS_WEGU), D, (const int*)(ws + WS_TOK), ws + WS_TOK, ws + WS_GATEB}; \
            g8::EpiGlu<true> E{RA, FFE, st3, vec + VEC_EGU_CS, vec + VEC_EGU_BW, lds + LDS_META, 2 * FFE}; \
            g8::gemm_phase<g8::EpiGlu<true>, g8::MoeOrder, true, 1>(lds, g, S, E); }); \
    RUN(PH_MOE0 + 2 * (cidx) + 1, const int* hdr = (const int*)(ws + WS_HDR); const int npan = hdr[8]; const int p0 = (cidx) * MOE_CHUNK_PAN; \
        { g8::MoeOrder S; S.p0 = p0; S.np = ((cidx) == MOE_NCHUNK - 1) ? (npan - p0) : MOE_CHUNK_PAN; S.nfull = MOE_CHUNK_PAN; S.nsplit = MOE_KSPLIT; S.nN = 4; S.G = G; S.c = (int)blockIdx.x; S.K = FFE; S.estride = (unsigned)(D * FFE * 2); \
            _Pragma("unroll") for (int e = 0; e < NE; ++e) S.pend[e] = hdr[e]; \
            g8::Gemm g{RA, (const bf16_t*)(ws + WS_WEDN), FFE, nullptr, ws + WS_TOK, nullptr}; \
            g8::EpiMoeDown E{RB, RD, lds + LDS_META, (float*)((unsigned char*)RA + RA_POFF), MOE_CHUNK_PAN}; \
            g8::gemm_phase<g8::EpiMoeDown, g8::MoeOrder, false, 2>(lds, g, S, E); });
    MOE_CHUNK(0) MOE_CHUNK(1) MOE_CHUNK(2) MOE_CHUNK(3)
    RUN(PH_FIX, moefix_phase(args););
    RUN(PH_FINAL, final_phase(args););
    if (PROBE_CLK && blockIdx.x == 0 && threadIdx.x == 0) { const float kv = ((volatile float*)(ws + WS_DIAG))[0]; const long long t0 = wall_clock64(); const long long dl = (long long)(kv * 5000.0f); while (wall_clock64() - t0 < dl) __builtin_amdgcn_s_sleep(8); }
#undef RUN
#undef IN
#undef SEAM
}

extern "C" void kernel_launch(void* const* d_in, const int* in_sizes, int n_in, void* d_out, int out_size, void* d_ws, size_t ws_size, hipStream_t stream) {
    static int grid = 0;
    if (grid == 0) {
        if (n_in != 18 || out_size != NR * D || ws_size < WS_END) { fprintf(stderr, "kernel_launch: unexpected problem (n_in %d out %d ws %zu need %zu)\n", n_in, out_size, ws_size, (size_t)WS_END); grid = -1; return; }
        int dev = 0, cus = 0, per_cu = 0;
        if (hipGetDevice(&dev) != hipSuccess || hipDeviceGetAttribute(&cus, hipDeviceAttributeMultiprocessorCount, dev) != hipSuccess) { grid = -1; return; }
        if (hipFuncSetAttribute((const void*)yoco_fwd, hipFuncAttributeMaxDynamicSharedMemorySize, LDS_BYTES) != hipSuccess) { fprintf(stderr, "kernel_launch: hipFuncSetAttribute failed\n"); grid = -1; return; }
        if (hipOccupancyMaxActiveBlocksPerMultiprocessor(&per_cu, (const void*)yoco_fwd, NTHREADS, LDS_BYTES) != hipSuccess || per_cu < 1) { fprintf(stderr, "kernel_launch: occupancy query says %d\n", per_cu); }
        (void)hipGetLastError();
        if (cus < 256) { fprintf(stderr, "kernel_launch: needs 256 CUs\n"); grid = -1; return; }
        grid = 256;
    }
    if (grid < 0) return;
    (void)hipMemsetAsync((char*)d_ws + WS_CTL, 0, CTL_BYTES, stream);
    Args a{};
    for (int i = 0; i < 18; ++i) a.in[i] = (const float*)d_in[i];
    a.out = (float*)d_out; a.ws = (unsigned char*)d_ws;
#if N_LAUNCH_MODE == 1
    for (int p = 0; p < PH_COUNT; ++p) { a.ph_lo = p; a.ph_hi = p + 1; hipLaunchKernelGGL(yoco_fwd, dim3(grid), dim3(NTHREADS), LDS_BYTES, stream, a); }
#else
    a.ph_lo = 0; a.ph_hi = PH_COUNT;
    hipLaunchKernelGGL(yoco_fwd, dim3(grid), dim3(NTHREADS), LDS_BYTES, stream, a);
#endif
}
```

```cpp
#include <hip/hip_runtime.h>
#include <cstdio>
#include <cstdint>

#ifndef N_LAUNCH_MODE
#define N_LAUNCH_MODE 0
#endif
#ifndef PROBE_CLK
#define PROBE_CLK 0
#endif
#ifndef REPMASK
#define REPMASK 0u
#endif

#define LAS __attribute__((address_space(3)))
typedef unsigned short bf16_t;
typedef short bf16x8 __attribute__((ext_vector_type(8)));
typedef float f32x2 __attribute__((ext_vector_type(2)));
typedef float f32x4 __attribute__((ext_vector_type(4)));
typedef float f32x16 __attribute__((ext_vector_type(16)));
typedef unsigned u32x2 __attribute__((ext_vector_type(2)));
typedef unsigned u32x4 __attribute__((ext_vector_type(4)));
typedef __bf16 bf16x2_t __attribute__((ext_vector_type(2)));

constexpr int D = 1024, NB = 16, SEQ = 4096, NMETA = 16;
constexpr int NR = NB * SEQ;
constexpr int NROWS = NR + NB * NMETA;
constexpr int NPAN = NROWS / 256;
constexpr int NPROJ = 3072;
constexpr int FFD = 2816, NE = 8, FFE = 3584;
constexpr float ALPHA = 1.41421356237f, LN_EPS = 1e-5f;
constexpr int NTHREADS = 512;
constexpr int MOE_ROWS = 2 * NR + NE * 256;
constexpr int MOE_CHUNK_PAN = 128;
constexpr int MOE_NCHUNK = 4;
constexpr int MOE_KSPLIT = 7;
constexpr size_t RA_POFF = (size_t)256 << 20;

constexpr size_t al256(size_t x) { return (x + 255) & ~(size_t)255; }
constexpr size_t WS_CTL = 0;
constexpr size_t CTL_BYTES = 65536;
constexpr size_t WS_WIN = WS_CTL + CTL_BYTES;
constexpr size_t WS_WOUT = WS_WIN + (size_t)NPROJ * D * 2;
constexpr size_t WS_WGU = WS_WOUT + (size_t)D * D * 2;
constexpr size_t WS_WDN = WS_WGU + (size_t)2 * FFD * D * 2;
constexpr size_t WS_WKVQ = WS_WDN + (size_t)D * FFD * 2;
constexpr size_t WS_WO = WS_WKVQ + (size_t)NPROJ * D * 2;
constexpr size_t WS_WEGU = WS_WO + (size_t)D * D * 2;
constexpr size_t WS_WEDN = WS_WEGU + (size_t)NE * 2 * FFE * D * 2;
constexpr size_t WS_VEC = WS_WEDN + (size_t)NE * D * FFE * 2;
constexpr int VEC_GU_CS = 0, VEC_GU_BW = 2 * FFD, VEC_KVQ_CS = 4 * FFD, VEC_KVQ_BW = VEC_KVQ_CS + NPROJ, VEC_EGU_CS = VEC_KVQ_BW + NPROJ, VEC_EGU_BW = VEC_EGU_CS + NE * 2 * FFE, VEC_END = VEC_EGU_BW + NE * 2 * FFE;
constexpr size_t WS_GATES = al256(WS_VEC + (size_t)VEC_END * 4);
constexpr size_t WS_ST1 = al256(WS_GATES + (size_t)NROWS * 8 * 4);
constexpr size_t WS_ST2 = WS_ST1 + (size_t)NROWS * 16 * 8;
constexpr size_t WS_ST3 = WS_ST2 + (size_t)NROWS * 16 * 8;
constexpr size_t WS_ROUTE = WS_ST3 + (size_t)NROWS * 16 * 8;
constexpr size_t WS_CNT = WS_ROUTE + (size_t)NR * 16;
constexpr size_t WS_HDR = WS_CNT + 256 * 8 * 4;
constexpr size_t WS_TOK = WS_HDR + 256;
constexpr size_t WS_GATEB = al256(WS_TOK + (size_t)MOE_ROWS * 8);
constexpr size_t WS_TOKST = al256(WS_GATEB + (size_t)MOE_ROWS * 8);
constexpr size_t WS_RS1 = al256(WS_TOKST + (size_t)NR * 8);
constexpr size_t WS_RS2 = al256(WS_RS1 + (size_t)NROWS * 8);
constexpr size_t WS_DIAG = al256(WS_RS2 + (size_t)NROWS * 8);
constexpr size_t WS_RA = al256(WS_DIAG + 4096);
constexpr size_t RA_BYTES = (size_t)NROWS * NPROJ * 2;
constexpr size_t WS_RB = al256(WS_RA + RA_BYTES);
constexpr size_t RX_BYTES = (size_t)NROWS * D * 2;
constexpr size_t WS_RC = al256(WS_RB + RX_BYTES);
constexpr size_t WS_RD = al256(WS_RC + RX_BYTES);
constexpr size_t WS_END = al256(WS_RD + RX_BYTES);

constexpr int LDS_MAIN = 131072, LDS_META = LDS_MAIN + 256  , LDS_BYTES = LDS_META + 8192;
__device__ __forceinline__ float bf2f(bf16_t v) { return __uint_as_float(((unsigned)v) << 16); }
__device__ __forceinline__ float bflo(unsigned u) { return __uint_as_float(u << 16); }
__device__ __forceinline__ float bfhi(unsigned u) { return __uint_as_float(u & 0xffff0000u); }
__device__ __forceinline__ unsigned pk2(float lo, float hi) { f32x2 v = {lo, hi}; bf16x2_t b = __builtin_convertvector(v, bf16x2_t); return __builtin_bit_cast(unsigned, b); }
__device__ __forceinline__ bf16_t f2bf(float f) { return (bf16_t)(pk2(f, 0.f) & 0xffffu); }
__device__ __forceinline__ float rbf(float f) { return bflo(pk2(f, 0.f)); }
__device__ __forceinline__ float wave_sum(float v) {
#pragma unroll
    for (int o = 32; o >= 1; o >>= 1) v += __shfl_xor(v, o);
    return v;
}
__device__ __forceinline__ float swap32_hi(float x, float& lo) {
    const u32x2 r = __builtin_amdgcn_permlane32_swap(__float_as_uint(x), __float_as_uint(x), false, false); lo = __uint_as_float(r.x); return __uint_as_float(r.y); }
__device__ __forceinline__ float fq_sum(float x) {
    const u32x2 a = __builtin_amdgcn_permlane16_swap(__float_as_uint(x), __float_as_uint(x), false, false); const float y = __uint_as_float(a.x) + __uint_as_float(a.y);
    const u32x2 b = __builtin_amdgcn_permlane32_swap(__float_as_uint(y), __float_as_uint(y), false, false); return __uint_as_float(b.x) + __uint_as_float(b.y); }
__device__ __forceinline__ float sigmoidf_(float x) { return __builtin_amdgcn_rcpf(1.0f + __builtin_amdgcn_exp2f(x * -1.4426950408889634f)); }

#define XB_TMO      128
#define XB_XCNT(j)  (256  + 64 * (j))
#define XB_XSUB(j)  (1280 + 64 * (j))
#define XB_XGEN(j)  (2304 + 64 * (j))
#define XB_TOP      3328
#define XB_TOPGEN   3392
#define XCD_BAR_WORDS 3456
#define XB_SPIN_CAP (1u << 20)
__device__ __forceinline__ unsigned xb_ld(unsigned* p)              { return __hip_atomic_load(p, __ATOMIC_RELAXED, __HIP_MEMORY_SCOPE_AGENT); }
__device__ __forceinline__ unsigned xb_add(unsigned* p, unsigned v) { return __hip_atomic_fetch_add(p, v, __ATOMIC_RELAXED, __HIP_MEMORY_SCOPE_AGENT); }
__device__ __forceinline__ unsigned xb_xcc_id() { return (unsigned)__builtin_amdgcn_s_getreg((3 << 11) | 20) & 0xFu; }
#define XB_SPIN(cond, bar) do { unsigned _sp = 0; while (cond) { __builtin_amdgcn_s_sleep(1); \
    if ((++_sp & 255u) == 0u) { if (xb_ld(&(bar)[XB_TMO])) break; if (_sp > XB_SPIN_CAP) { atomicAdd(&(bar)[XB_TMO], 1u); break; } } } } while (0)
struct XcdBarrier { unsigned* bar; unsigned x; volatile LAS unsigned* st; };
__device__ __forceinline__ XcdBarrier xcd_barrier_post(unsigned* bar, volatile LAS unsigned* st) {
    XcdBarrier b; b.bar = bar; b.x = xb_xcc_id(); b.st = st;
    if (threadIdx.x == 0) (void)xb_add(&bar[XB_XCNT(b.x)], 1u);
    return b;
}
__device__ __forceinline__ void xcd_barrier_complete(unsigned* bar, unsigned x, unsigned& nloc, unsigned& nx) {
    const unsigned G = gridDim.x * gridDim.y * gridDim.z;
    unsigned sum, cnt, mine, sp = 0u;
    for (;;) {
        sum = 0u; cnt = 0u; mine = 0u;
#pragma unroll
        for (unsigned j = 0; j < 16; ++j) { const unsigned c = xb_ld(&bar[XB_XCNT(j)]); sum += c; cnt += (c > 0u) ? 1u : 0u; mine = (j == x) ? c : mine; }
        if (sum == G) break;
        __builtin_amdgcn_s_sleep(1);
        if ((++sp & 255u) == 0u) { if (xb_ld(&bar[XB_TMO])) break; if (sp > XB_SPIN_CAP) { atomicAdd(&bar[XB_TMO], 1u); break; } }
    }
    nloc = mine > 0u ? mine : 1u; nx = cnt > 0u ? cnt : 1u;
}
__device__ __forceinline__ void xcd_barrier(const XcdBarrier& b) {
    asm volatile("s_waitcnt vmcnt(0)" ::: "memory");
    __syncthreads();
    if (threadIdx.x == 0) {
        unsigned* bar = b.bar;
        __builtin_amdgcn_s_waitcnt(0);
        unsigned nloc = b.st[0], nx = b.st[1];
        if (nloc == 0u) { xcd_barrier_complete(bar, b.x, nloc, nx); b.st[0] = nloc; b.st[1] = nx; }
        const unsigned old = xb_add(&bar[XB_XSUB(b.x)], 1u);
        const unsigned gen = old / nloc;
        if (old + 1u == (gen + 1u) * nloc) {
            __builtin_amdgcn_fence(__ATOMIC_RELEASE, "agent");
            asm volatile("s_waitcnt vmcnt(0)" ::: "memory");
            const unsigned og = xb_add(&bar[XB_TOP], 1u);
            const unsigned tg = og / nx;
            if (og + 1u == (tg + 1u) * nx) xb_add(&bar[XB_TOPGEN], 1u);
            else XB_SPIN(xb_ld(&bar[XB_TOPGEN]) == tg, bar);
            __builtin_amdgcn_fence(__ATOMIC_ACQUIRE, "agent");
            xb_add(&bar[XB_XGEN(b.x)], 1u);
            asm volatile("s_waitcnt vmcnt(0)" ::: "memory");
        } else {
            XB_SPIN(xb_ld(&bar[XB_XGEN(b.x)]) == gen, bar);
            __builtin_amdgcn_fence(__ATOMIC_ACQUIRE, "agent");
            asm volatile("s_waitcnt vmcnt(0)" ::: "memory");
        }
    }
    __syncthreads();
}

namespace g8 {
constexpr int BM = 256, BK = 64, HALF = 128, HTB = HALF * BK * 2, STAGE_BYTES = 8 * HTB, NXCD = 8, WGM = 8;
__host__ __device__ __forceinline__ int lds_byte(int r, int c) { const int st = (r >> 4) * 2 + (c >> 5), rr = r & 15, cc = c & 31, ob = rr * 64 + cc * 2; return st * 1024 + (ob ^ (((ob >> 9) & 1) << 5)); }
__host__ __device__ __forceinline__ void stage_rc(int b, int& R, int& C) { const int st = b / 1024, sb = b % 1024, swz = sb ^ (((sb >> 9) & 1) << 5); R = (st >> 1) * 16 + swz / 64; C = (st & 1) * 32 + (swz % 64) / 2; }
__host__ __device__ __forceinline__ int perm32(int rho) { const int n = rho >> 4, i = rho & 15; return 8 * (i >> 2) + 4 * n + (i & 3); }

struct Unit { int pm, pn, gp; unsigned boff; int aux; int kt; unsigned koff; int ks; };
struct Gemm { const bf16_t* A; const bf16_t* Bt; int K; const int* rowtab; const unsigned char* smeta; const unsigned char* sstat; };

struct DenseOrder {
    int nM, nN, nwg, G, c, K;
    __device__ void init(int nM_, int nN_, int K_, int G_, int c_) { nM = nM_; nN = nN_; nwg = nM * nN; G = G_; c = c_; K = K_; }
    __device__ bool next(int i, Unit& u) const {
        const long L = (long)i * G + c; if (L >= nwg) return false;
        int wgid = (int)L; { const int q = nwg / NXCD, r = nwg % NXCD, xcd = wgid % NXCD, off = wgid / NXCD; wgid = (xcd < r ? xcd * (q + 1) : r * (q + 1) + (xcd - r) * q) + off; }
        const int nig = WGM * nN, gid = wgid / nig, fm = gid * WGM, gsz = (nM - fm) < WGM ? (nM - fm) : WGM;
        u.pm = fm + ((wgid % nig) % gsz); u.pn = (wgid % nig) / gsz; u.gp = u.pm; u.boff = (unsigned)u.pn * (unsigned)(256 * K * 2); u.kt = K / BK; u.koff = 0u; u.ks = -1; return true;
    }
};
struct MoeOrder {
    int p0, np, nN, G, c, K; unsigned estride; int pend[NE]; int nfull, nsplit;
    __device__ bool next(int i, Unit& u) const {
        const long L = (long)i * G + c; const long nmain = (long)nfull * nN;
        int pn, pml, ks = -1;
        if (L < nmain) { pn = (int)(L / nfull); pml = (int)(L % nfull); }
        else { const long r = L - nmain; if (r >= (long)(np - nfull) * nN * nsplit) return false;
            ks = (int)(r % nsplit); const int q = (int)(r / nsplit); pn = q % nN; pml = nfull + q / nN; if (nsplit == 1) ks = -1; }
        const int gp = p0 + pml;
        int e = 0;
#pragma unroll
        for (int j = 0; j < NE - 1; ++j) e += (gp >= pend[j]) ? 1 : 0;
        const int ktall = K / BK;
        u.pm = pml; u.pn = pn; u.gp = gp; u.ks = ks; u.kt = ks < 0 ? ktall : ktall / nsplit; u.koff = ks < 0 ? 0u : (unsigned)(ks * (K / nsplit) * 2);
        u.boff = (unsigned)e * estride + (unsigned)pn * (unsigned)(256 * K * 2) + u.koff; return true;
    }
};

template <class Epi, class Sched, bool GATHER, int META = 0>
__device__ __forceinline__ void gemm_phase(LAS unsigned char* lds, const Gemm g, const Sched& S, const Epi& E) {
    const int tid = threadIdx.x, wid = __builtin_amdgcn_readfirstlane(tid >> 6), lane = tid & 63, wr = wid >> 2, wc = wid & 3, fr = lane & 15, fq = lane >> 4;
    const int K = g.K;
    int Rr[2], Cc[2]; unsigned voffA[2], voffB[2];
#pragma unroll
    for (int i = 0; i < 2; ++i) { stage_rc(tid * 16 + i * 8192, Rr[i], Cc[i]); const int Rb = (Rr[i] & ~31) + perm32(Rr[i] & 31);
        voffA[i] = (unsigned)(Rr[i] * K + Cc[i]) * 2u; voffB[i] = (unsigned)(Rb * K + Cc[i]) * 2u; }
    const size_t kstep = (size_t)(BK * 2);
    const size_t hstep = (size_t)HALF * K * 2;
    const size_t tstep = 2 * hstep;
    const unsigned ldsw = (unsigned)wid * 1024u;
    const int aoff = lds_byte(wr * 64 + fr, fq * 8), boff = lds_byte(wc * 32 + fr, fq * 8);
#define G8_SA(b, h) (((b) * 2 + (h)) * HTB)
#define G8_SB(b, h) ((4 + (b) * 2 + (h)) * HTB)
#define G8_STAGE(bufoff, gbase, voff) do { _Pragma("unroll") for (int _i = 0; _i < 2; ++_i) \
        __builtin_amdgcn_global_load_lds((const unsigned*)((const char*)(gbase) + (voff)[_i]), (LAS unsigned*)(lds + (bufoff) + ldsw + _i * 8192), 16, 0, 0); } while (0)
#define G8_STA(bufoff, ptr, offs, h) do { if constexpr (GATHER) { G8_STAGE(bufoff, (const char*)g.A, (offs)[h]); } else { G8_STAGE(bufoff, (ptr) + (h) * hstep, voffA); } } while (0)
#define G8_LDA(dst, b, h) do { _Pragma("unroll") for (int m = 0; m < 4; ++m) _Pragma("unroll") for (int k = 0; k < 2; ++k) dst[m][k] = *(const LAS bf16x8*)(lds + G8_SA(b, h) + aoff + m * 2048 + k * 1024); } while (0)
#define G8_LDB(dst, b, h) do { _Pragma("unroll") for (int n = 0; n < 2; ++n) _Pragma("unroll") for (int k = 0; k < 2; ++k) dst[n][k] = *(const LAS bf16x8*)(lds + G8_SB(b, h) + boff + n * 2048 + k * 1024); } while (0)
#define G8_MMA(ai, bj, At, Bt) do { __builtin_amdgcn_s_setprio(1); _Pragma("unroll") for (int m = 0; m < 4; ++m) _Pragma("unroll") for (int n = 0; n < 2; ++n) _Pragma("unroll") for (int k = 0; k < 2; ++k) \
        acc[ai][bj][m][n] = __builtin_amdgcn_mfma_f32_16x16x32_bf16(Bt[n][k], At[m][k], acc[ai][bj][m][n], 0, 0, 0); __builtin_amdgcn_s_setprio(0); } while (0)
#define G8_WAIT_V(n) asm volatile("s_waitcnt vmcnt(" #n ")" ::: "memory")
#define G8_WAIT_L(n) asm volatile("s_waitcnt lgkmcnt(" #n ")" ::: "memory")
#define G8_BAR __builtin_amdgcn_s_barrier()
#define G8_SCHED __builtin_amdgcn_sched_barrier(0)
#define G8_ROWOFFS(dst, U) do { _Pragma("unroll") for (int _h = 0; _h < 2; ++_h) _Pragma("unroll") for (int _i = 0; _i < 2; ++_i) { \
        const int _id = g.rowtab[2 * ((U).gp * 256 + _h * 128 + Rr[_i])]; const int _tk = _id < 0 ? 0 : (_id >> 1); dst[_h][_i] = (unsigned)(_tk * K + Cc[_i]) * 2u; } } while (0)
#define G8_META_DMA(gsrc, panel, bufidx) __builtin_amdgcn_global_load_lds((const unsigned*)((gsrc) + (size_t)(panel) * 2048 + wid * 256 + lane * 4), (LAS unsigned*)(lds + LDS_META + (bufidx) * 2048 + wid * 256), 4, 0, 0)
    Unit cur, nxt; int ui = 0;
    if (!S.next(0, cur)) return;
    f32x4 acc[2][2][4][2];
#pragma unroll
    for (int a = 0; a < 2; ++a)
#pragma unroll
        for (int b = 0; b < 2; ++b)
#pragma unroll
            for (int m = 0; m < 4; ++m)
#pragma unroll
                for (int n = 0; n < 2; ++n) acc[a][b][m][n] = (f32x4){0.f, 0.f, 0.f, 0.f};
    bf16x8 At[4][2], B0[2][2], B1[2][2];
    const char* cA = (const char*)g.A + (size_t)cur.pm * tstep + cur.koff; const char* cB = (const char*)g.Bt + cur.boff;
    unsigned oc[2][2], on[2][2], o1[2][2], o2[2][2], o3[2][2];
    if constexpr (GATHER) { G8_ROWOFFS(oc, cur);
#pragma unroll
        for (int h = 0; h < 2; ++h)
#pragma unroll
            for (int i = 0; i < 2; ++i) { o1[h][i] = oc[h][i] + 128u; on[h][i] = oc[h][i]; o2[h][i] = 0; o3[h][i] = 0; } }
    G8_STAGE(G8_SB(0, 0), cB, voffB); G8_STAGE(G8_SB(0, 1), cB + hstep, voffB); G8_STA(G8_SA(0, 0), cA, oc, 0); G8_STA(G8_SA(0, 1), cA, oc, 1);
    if (wr == 1) G8_BAR;
    G8_WAIT_V(2); G8_BAR;
    G8_STAGE(G8_SB(1, 0), cB + kstep, voffB); G8_STA(G8_SA(1, 0), cA + kstep, o1, 0); G8_STAGE(G8_SB(1, 1), cB + hstep + kstep, voffB);
    G8_WAIT_V(6); G8_BAR;
    for (;;) {
        const bool has_next = S.next(ui + 1, nxt);
        const char* nA = has_next ? (const char*)g.A + (size_t)nxt.pm * tstep + nxt.koff : cA; const char* nB = has_next ? (const char*)g.Bt + nxt.boff : cB;
        const int nt = cur.kt;
        if constexpr (META == 1) { if (has_next) G8_META_DMA(g.smeta, nxt.gp, (ui + 1) & 1); G8_META_DMA(g.sstat, cur.gp, 2 + (ui & 1)); }
        if constexpr (META == 2) { G8_META_DMA(g.smeta, cur.gp, ui & 1); }
        if constexpr (META == 3) { G8_META_DMA(g.sstat, cur.pm, 2 + (ui & 1)); }
        for (int t = 0; t < nt; t += 2) {
            const bool last = (t == nt - 2);
            const char* a1 = cA + (size_t)(t + 1) * kstep;
            const char* a2 = last ? nA : cA + (size_t)(t + 2) * kstep; const char* b2 = last ? nB : cB + (size_t)(t + 2) * kstep;
            const char* a3 = a2 + kstep; const char* b3 = b2 + kstep;
            if constexpr (GATHER) {
                if (last) {
#pragma unroll
                    for (int h = 0; h < 2; ++h)
#pragma unroll
                        for (int i = 0; i < 2; ++i) { int id = -1; if (has_next) id = *(const LAS int*)(lds + LDS_META + ((ui + 1) & 1) * 2048 + (h * 128 + Rr[i]) * 8);
                            const int tk = id < 0 ? 0 : (id >> 1); on[h][i] = has_next ? (unsigned)(tk * K + Cc[i]) * 2u : oc[h][i]; } }
#pragma unroll
                for (int h = 0; h < 2; ++h)
#pragma unroll
                    for (int i = 0; i < 2; ++i) { o1[h][i] = oc[h][i] + (unsigned)(t + 1) * 128u; o2[h][i] = last ? on[h][i] : oc[h][i] + (unsigned)(t + 2) * 128u; o3[h][i] = o2[h][i] + 128u; } }
            G8_LDB(B0, 0, 0); G8_LDB(B1, 0, 1); G8_SCHED; G8_LDA(At, 0, 0); G8_STA(G8_SA(1, 1), a1, o1, 1);
            G8_WAIT_V(8); G8_WAIT_L(0); G8_BAR; G8_MMA(0, 0, At, B0); G8_MMA(0, 1, At, B1); G8_BAR; G8_SCHED;
            G8_LDA(At, 0, 1); G8_STAGE(G8_SB(0, 0), b2, voffB); G8_STAGE(G8_SB(0, 1), b2 + hstep, voffB); G8_STA(G8_SA(0, 0), a2, o2, 0);
            G8_WAIT_V(8); G8_WAIT_L(0); G8_BAR; G8_MMA(1, 0, At, B0); G8_MMA(1, 1, At, B1); G8_BAR; G8_SCHED;
            G8_LDB(B0, 1, 0); G8_LDB(B1, 1, 1); G8_SCHED; G8_LDA(At, 1, 0); G8_STA(G8_SA(0, 1), a2, o2, 1);
            G8_WAIT_V(8); G8_WAIT_L(0); G8_BAR; G8_MMA(0, 0, At, B0); G8_MMA(0, 1, At, B1); G8_BAR; G8_SCHED;
            G8_LDA(At, 1, 1); G8_STAGE(G8_SB(1, 0), b3, voffB); G8_STAGE(G8_SB(1, 1), b3 + hstep, voffB); G8_STA(G8_SA(1, 0), a3, o3, 0);
            G8_WAIT_V(8); G8_WAIT_L(0); G8_BAR; G8_MMA(1, 0, At, B0); G8_MMA(1, 1, At, B1); G8_BAR; G8_SCHED;
        }
        if (wr == 0) G8_BAR;
        cur.aux = ui & 1;
        E(acc, cur, wr, wc, fr, fq);
        if (!has_next) break;
#pragma unroll
        for (int a = 0; a < 2; ++a)
#pragma unroll
            for (int b = 0; b < 2; ++b)
#pragma unroll
                for (int m = 0; m < 4; ++m)
#pragma unroll
                    for (int n = 0; n < 2; ++n) acc[a][b][m][n] = (f32x4){0.f, 0.f, 0.f, 0.f};
        cur = nxt; cA = nA; cB = nB; ++ui;
        if constexpr (GATHER) {
#pragma unroll
            for (int h = 0; h < 2; ++h)
#pragma unroll
                for (int i = 0; i < 2; ++i) oc[h][i] = on[h][i]; }
        if (wr == 1) G8_BAR;
    }
    G8_WAIT_V(0);
    G8_BAR;
#undef G8_SA
#undef G8_SB
#undef G8_STAGE
#undef G8_STA
#undef G8_LDA
#undef G8_LDB
#undef G8_MMA
#undef G8_WAIT_V
#undef G8_WAIT_L
#undef G8_BAR
#undef G8_SCHED
#undef G8_ROWOFFS
#undef G8_META_DMA
}

typedef f32x4 Acc[2][2][4][2];
__device__ __forceinline__ u32x4 pack8(const f32x4 a, const f32x4 b) { u32x4 w; w.x = pk2(a[0], a[1]); w.y = pk2(a[2], a[3]); w.z = pk2(b[0], b[1]); w.w = pk2(b[2], b[3]); return w; }
__device__ __forceinline__ void unpack8(const u32x4 w, float (&f)[8]) { f[0] = bflo(w.x); f[1] = bfhi(w.x); f[2] = bflo(w.y); f[3] = bfhi(w.y); f[4] = bflo(w.z); f[5] = bfhi(w.z); f[6] = bflo(w.w); f[7] = bfhi(w.w); }
__device__ __forceinline__ void row_stats(const float* st, int row, int fq, float& mu, float& rstd) {
    const f32x4* p = (const f32x4*)(st + (size_t)row * 32 + fq * 8);
    const f32x4 a = p[0], b = p[1];
    float s1 = (a[0] + a[2]) + (b[0] + b[2]), s2 = (a[1] + a[3]) + (b[1] + b[3]);
    s1 += __shfl_xor(s1, 16); s1 += __shfl_xor(s1, 32); s2 += __shfl_xor(s2, 16); s2 += __shfl_xor(s2, 32);
    mu = s1 * (1.0f / 1024.0f); const float var = fmaxf(s2 * (1.0f / 1024.0f) - mu * mu, 0.f); rstd = rsqrtf(var + LN_EPS);
}
__device__ __forceinline__ void put_stats(float* st, int row, int slot, int fq, float s1, float s2) {
    s1 = fq_sum(s1); s2 = fq_sum(s2);
    if (fq == 0) *(f32x2*)(st + (size_t)row * 32 + slot * 2) = (f32x2){s1, s2};
}

struct EpiPlain {
    bf16_t* O; int ldc;
    __device__ __forceinline__ void operator()(const Acc& acc, const Unit& u, int wr, int wc, int fr, int fq) const {
        const int row0 = u.pm * 256 + wr * 64 + fr, col0 = u.pn * 256 + wc * 32 + 8 * fq;
#pragma unroll
        for (int ai = 0; ai < 2; ++ai)
#pragma unroll
            for (int m = 0; m < 4; ++m) { bf16_t* rowp = O + (size_t)(row0 + ai * 128 + m * 16) * ldc + col0;
#pragma unroll
                for (int bj = 0; bj < 2; ++bj) *(u32x4*)(rowp + bj * 128) = pack8(acc[ai][bj][m][0], acc[ai][bj][m][1]); }
    }
};
template <int MODE> struct EpiRes {
    bf16_t* Z; const bf16_t* Rsrc; float* st_out; LAS unsigned char* ldsm; const float* g; const float* b;
    __device__ __forceinline__ void operator()(const Acc& acc, const Unit& u, int wr, int wc, int fr, int fq) const {
        const int r0 = wr * 64 + fr, col0 = u.pn * 256 + wc * 32 + 8 * fq;
        f32x4 gv[2][2], bv[2][2];
        if (MODE == 1) {
#pragma unroll
            for (int bj = 0; bj < 2; ++bj)
#pragma unroll
                for (int n = 0; n < 2; ++n) { gv[bj][n] = *(const f32x4*)(g + col0 + bj * 128 + 4 * n); bv[bj][n] = *(const f32x4*)(b + col0 + bj * 128 + 4 * n); }
        }
        u32x4 rwa[4][4][2];
#define EPR_LOAD(am_) do { _Pragma("unroll") for (int m = 2 * ((am_) & 1); m < 2 * ((am_) & 1) + 2; ++m) _Pragma("unroll") for (int bj = 0; bj < 2; ++bj) \
            rwa[am_][m][bj] = *(const u32x4*)(Rsrc + ((size_t)u.pm * 256 + r0 + ((am_) >> 1) * 128 + m * 16) * D + col0 + bj * 128); } while (0)
        EPR_LOAD(0);
#pragma unroll
        for (int am = 0; am < 4; ++am) { const int ai = am >> 1;
            if (am + 1 < 4) EPR_LOAD(am + 1);
            u32x4 (&rw)[4][2] = rwa[am];
#pragma unroll
            for (int m = 2 * (am & 1); m < 2 * (am & 1) + 2; ++m) {
                const int rl = r0 + ai * 128 + m * 16; const size_t row = (size_t)u.pm * 256 + rl;
                float mu = 0.f, rstd = 1.f;
                if (MODE == 1) { const f32x2 ms = *(const LAS f32x2*)(ldsm + (2 + u.aux) * 2048 + rl * 8); mu = ms[0]; rstd = ms[1]; }
                float s1 = 0.f, s2 = 0.f;
#pragma unroll
                for (int bj = 0; bj < 2; ++bj) {
                    float r[8]; unpack8(rw[m][bj], r);
                    f32x4 v0, v1;
#pragma unroll
                    for (int j = 0; j < 4; ++j) {
                        float h0 = r[j], h1 = r[4 + j];
                        if (MODE == 1) { h0 = (h0 - mu) * rstd * gv[bj][0][j] + bv[bj][0][j]; h1 = (h1 - mu) * rstd * gv[bj][1][j] + bv[bj][1][j]; }
                        v0[j] = ALPHA * h0 + acc[ai][bj][m][0][j]; v1[j] = ALPHA * h1 + acc[ai][bj][m][1][j];
                    }
                    const u32x4 w = pack8(v0, v1);
                    *(u32x4*)(Z + row * D + col0 + bj * 128) = w;
                    float q[8]; unpack8(w, q);
#pragma unroll
                    for (int j = 0; j < 8; ++j) { s1 += q[j]; s2 += q[j] * q[j]; }
                }
                put_stats(st_out, (int)row, u.pn * 4 + wc, fq, s1, s2);
            }
        }
    }
};
struct EpiFold {
    bf16_t* O; int ldc; LAS unsigned char* ldsm; const float* cs; const float* bw;
    __device__ __forceinline__ void operator()(const Acc& acc, const Unit& u, int wr, int wc, int fr, int fq) const {
        const int r0 = wr * 64 + fr, col0 = u.pn * 256 + wc * 32 + 8 * fq;
        f32x4 cv[2][2], bv[2][2];
#pragma unroll
        for (int bj = 0; bj < 2; ++bj)
#pragma unroll
            for (int n = 0; n < 2; ++n) { cv[bj][n] = *(const f32x4*)(cs + col0 + bj * 128 + 4 * n); bv[bj][n] = *(const f32x4*)(bw + col0 + bj * 128 + 4 * n); }
#pragma unroll
        for (int ai = 0; ai < 2; ++ai)
#pragma unroll
            for (int m = 0; m < 4; ++m) {
                const int rl = r0 + ai * 128 + m * 16; const size_t row = (size_t)u.pm * 256 + rl;
                const f32x2 ms = *(const LAS f32x2*)(ldsm + (2 + u.aux) * 2048 + rl * 8); const float mu = ms[0], rstd = ms[1];
#pragma unroll
                for (int bj = 0; bj < 2; ++bj) {
                    const f32x4 v0 = (acc[ai][bj][m][0] - mu * cv[bj][0]) * rstd + bv[bj][0], v1 = (acc[ai][bj][m][1] - mu * cv[bj][1]) * rstd + bv[bj][1];
                    *(u32x4*)(O + row * ldc + col0 + bj * 128) = pack8(v0, v1);
                }
            }
    }
};
template <bool MOE> struct EpiGlu {
    bf16_t* O; int ldc; const float* st_in; const float* cs; const float* bw; LAS unsigned char* ldsm; int ncs;
    __device__ __forceinline__ void operator()(const Acc& acc, const Unit& u, int wr, int wc, int fr, int fq) const {
        const int row0 = u.pm * 256 + wr * 64 + fr, colo = u.pn * 128 + wc * 32 + 8 * fq;
        int vb = u.pn * 256 + wc * 32 + 8 * fq;
        if (MOE) vb += (int)(u.boff / (unsigned)(256 * D * 2)) * 256 - u.pn * 256;
        f32x4 cv[2][2], bv[2][2];
#pragma unroll
        for (int bj = 0; bj < 2; ++bj)
#pragma unroll
            for (int n = 0; n < 2; ++n) { cv[bj][n] = *(const f32x4*)(cs + vb + bj * 128 + 4 * n); bv[bj][n] = *(const f32x4*)(bw + vb + bj * 128 + 4 * n); }
#pragma unroll
        for (int ai = 0; ai < 2; ++ai)
#pragma unroll
            for (int m = 0; m < 4; ++m) {
                const int row = row0 + ai * 128 + m * 16;
                const f32x2 ms = *(const LAS f32x2*)(ldsm + (2 + u.aux) * 2048 + (row - u.pm * 256) * 8); const float mu = ms[0], rstd = ms[1];
                f32x4 o0, o1;
#pragma unroll
                for (int j = 0; j < 4; ++j) {
                    const float g0 = (acc[ai][0][m][0][j] - mu * cv[0][0][j]) * rstd + bv[0][0][j], g1 = (acc[ai][0][m][1][j] - mu * cv[0][1][j]) * rstd + bv[0][1][j];
                    const float u0 = (acc[ai][1][m][0][j] - mu * cv[1][0][j]) * rstd + bv[1][0][j], u1 = (acc[ai][1][m][1][j] - mu * cv[1][1][j]) * rstd + bv[1][1][j];
                    o0[j] = g0 * sigmoidf_(g0) * u0; o1[j] = g1 * sigmoidf_(g1) * u1;
                }
                *(u32x4*)(O + (size_t)row * ldc + colo) = pack8(o0, o1);
            }
    }
};
struct EpiMoeDown {
    bf16_t* Y0; bf16_t* Y1; LAS unsigned char* ldsm; float* P; int nfull;
    __device__ __forceinline__ void operator()(const Acc& acc, const Unit& u, int wr, int wc, int fr, int fq) const {
        const int r0 = wr * 64 + fr, col0 = u.pn * 256 + wc * 32 + 8 * fq;
        if (u.ks >= 0) {
#pragma unroll
            for (int ai = 0; ai < 2; ++ai)
#pragma unroll
                for (int m = 0; m < 4; ++m) { float* rowp = P + ((size_t)u.ks * 2048 + (size_t)(u.pm - nfull) * 256 + r0 + ai * 128 + m * 16) * D + col0;
#pragma unroll
                    for (int bj = 0; bj < 2; ++bj) { *(f32x4*)(rowp + bj * 128) = acc[ai][bj][m][0]; *(f32x4*)(rowp + bj * 128 + 4) = acc[ai][bj][m][1]; } }
            return;
        }
#pragma unroll
        for (int ai = 0; ai < 2; ++ai)
#pragma unroll
            for (int m = 0; m < 4; ++m) {
                const u32x2 mg = *(const LAS u32x2*)(ldsm + u.aux * 2048 + (r0 + ai * 128 + m * 16) * 8);
                const int id = (int)mg.x; const float gt = __uint_as_float(mg.y);
                if (id >= 0) { bf16_t* rowp = Y0 + (size_t)(id & 1) * (size_t)(Y1 - Y0) + (size_t)(id >> 1) * D + col0;
#pragma unroll
                    for (int bj = 0; bj < 2; ++bj) *(u32x4*)(rowp + bj * 128) = pack8(acc[ai][bj][m][0] * gt, acc[ai][bj][m][1] * gt); }
            }
    }
};
}

struct Args { const float* in[18]; float* out; unsigned char* ws; int ph_lo, ph_hi; };
enum { PH_PRO = 0, PH_PROJ, PH_MLSTM, PH_WOUT, PH_FIN1, PH_GU, PH_DN, PH_FIN2, PH_KVQ, PH_ATT, PH_WO, PH_RT1, PH_RT2, PH_MOE0, PH_FIX = PH_MOE0 + 2 * MOE_NCHUNK, PH_FINAL, PH_COUNT };

__device__ __forceinline__ float logsigmoid_(float x) { return fminf(x, 0.f) - log1pf(expf(-fabsf(x))); }
__device__ __forceinline__ void conv_block(LAS unsigned char* lds, const float* src, int ldw, int K, bf16_t* dst, const float* g, const float* bb, float* cs, float* bw) {
    const int tid = threadIdx.x;
    const int n4 = (tid & 15) * 4, k4 = (tid >> 4) * 4;
    const int rn = tid >> 3, rs = tid & 7;
    float csp[4] = {0.f, 0.f, 0.f, 0.f}, bwp[4] = {0.f, 0.f, 0.f, 0.f};
    const int nch = K / 128;
    LAS float* gs = (LAS float*)(lds + 2 * 64 * 264 + 16384);
    if (g) { for (int i = tid; i < K; i += NTHREADS) { gs[i] = g[i]; gs[K + i] = bb[i]; } __syncthreads(); }
    f32x4 v[4], vn[4];
#pragma unroll
    for (int kk = 0; kk < 4; ++kk) v[kk] = *(const f32x4*)(src + (size_t)(k4 + kk) * ldw + n4);
    for (int ch = 0; ch < nch; ++ch) {
        LAS unsigned char* T = lds + (ch & 1) * (64 * 264);
        if (ch + 1 < nch) {
#pragma unroll
            for (int kk = 0; kk < 4; ++kk) vn[kk] = *(const f32x4*)(src + (size_t)((ch + 1) * 128 + k4 + kk) * ldw + n4); }
        float gk[4] = {1.f, 1.f, 1.f, 1.f}, bk[4] = {0.f, 0.f, 0.f, 0.f};
        if (g) {
#pragma unroll
            for (int kk = 0; kk < 4; ++kk) { gk[kk] = gs[ch * 128 + k4 + kk]; bk[kk] = gs[K + ch * 128 + k4 + kk]; } }
#pragma unroll
        for (int j = 0; j < 4; ++j) {
            const unsigned lo = pk2(v[0][j] * gk[0], v[1][j] * gk[1]), hi = pk2(v[2][j] * gk[2], v[3][j] * gk[3]);
            *(LAS u32x2*)(T + (n4 + j) * 264 + k4 * 2) = (u32x2){lo, hi};
            csp[j] += (bflo(lo) + bfhi(lo)) + (bflo(hi) + bfhi(hi));
            bwp[j] += (v[0][j] * bk[0] + v[1][j] * bk[1]) + (v[2][j] * bk[2] + v[3][j] * bk[3]);
        }
        __syncthreads();
        u32x2 q[4];
#pragma unroll
        for (int i = 0; i < 4; ++i) q[i] = *(const LAS u32x2*)(T + rn * 264 + rs * 32 + i * 8);
        bf16_t* dp = dst + (size_t)rn * K + ch * 128 + rs * 16;
        *(u32x4*)dp = (u32x4){q[0].x, q[0].y, q[1].x, q[1].y};
        *(u32x4*)(dp + 8) = (u32x4){q[2].x, q[2].y, q[3].x, q[3].y};
#pragma unroll
        for (int kk = 0; kk < 4; ++kk) v[kk] = vn[kk];
    }
    __syncthreads();
    if (cs) {
        LAS float* red = (LAS float*)(lds + 2 * 64 * 264);
#pragma unroll
        for (int j = 0; j < 4; ++j) { red[(tid >> 4) * 64 + n4 + j] = csp[j]; red[2048 + (tid >> 4) * 64 + n4 + j] = bwp[j]; }
        __syncthreads();
        if (tid < 128) { const int n = tid & 63, w = tid >> 6; float s = 0.f;
            for (int i = 0; i < 32; ++i) s += red[w * 2048 + i * 64 + n];
            (w ? bw : cs)[n] = s; }
        __syncthreads();
    }
}
__device__ __forceinline__ void conv_job(LAS unsigned char* lds, const Args& a, int blk) {
    unsigned char* ws = a.ws;
    const float* ln_g = a.in[16]; const float* ln_b = a.in[17];
    float* vec = (float*)(ws + WS_VEC);
    const float* src; int ldw, K; bf16_t* dst; const float* g = nullptr; const float* bb = nullptr; float* cs = nullptr; float* bw = nullptr;
    int j = blk;
    if (j < 128) { const int e = j >> 4, jj = j & 15; src = a.in[15] + (size_t)e * FFE * D + 64 * jj; ldw = D; K = FFE; dst = (bf16_t*)(ws + WS_WEDN) + ((size_t)e * D + 64 * jj) * FFE; }
    else if (j < 144) { j -= 128; src = a.in[11] + 64 * j; ldw = D; K = FFD; dst = (bf16_t*)(ws + WS_WDN) + (size_t)(64 * j) * FFD; }
    else if (j < 192) { j -= 144; src = a.in[2] + 64 * j; ldw = 3080; K = D; dst = (bf16_t*)(ws + WS_WIN) + (size_t)(64 * j) * D; }
    else if (j < 208) { j -= 192; src = a.in[5] + 64 * j; ldw = D; K = D; dst = (bf16_t*)(ws + WS_WOUT) + (size_t)(64 * j) * D; }
    else if (j < 296) { j -= 208; const int t = j >> 2, q = j & 3; src = (q < 2 ? a.in[9] : a.in[10]) + 128 * t + 64 * (q & 1); ldw = FFD; K = D; dst = (bf16_t*)(ws + WS_WGU) + (size_t)(64 * j) * D;
        g = ln_g; bb = ln_b; cs = vec + VEC_GU_CS + 64 * j; bw = vec + VEC_GU_BW + 64 * j; }
    else if (j < 344) { j -= 296; src = j < 32 ? a.in[6] + 64 * j : a.in[7] + 64 * (j - 32); ldw = j < 32 ? 2048 : 1024; K = D; dst = (bf16_t*)(ws + WS_WKVQ) + (size_t)(64 * j) * D;
        g = ln_g + 1024; bb = ln_b + 1024; cs = vec + VEC_KVQ_CS + 64 * j; bw = vec + VEC_KVQ_BW + 64 * j; }
    else if (j < 360) { j -= 344; src = a.in[8] + 64 * j; ldw = D; K = D; dst = (bf16_t*)(ws + WS_WO) + (size_t)(64 * j) * D; }
    else { j -= 360; const int e = j / 112, jj = j % 112, t = jj >> 2, q = jj & 3; src = (q < 2 ? a.in[13] : a.in[14]) + (size_t)e * D * FFE + 128 * t + 64 * (q & 1); ldw = FFE; K = D;
        dst = (bf16_t*)(ws + WS_WEGU) + ((size_t)e * 2 * FFE + 64 * jj) * D; g = ln_g + 2048; bb = ln_b + 2048; cs = vec + VEC_EGU_CS + e * 2 * FFE + 64 * jj; bw = vec + VEC_EGU_BW + e * 2 * FFE + 64 * jj; }
    conv_block(lds, src, ldw, K, dst, g, bb, cs, bw);
}
constexpr int EGU0 = 360;
__device__ __forceinline__ void tail_jobs(LAS unsigned char* lds, const Args& a, int phase) {
    const int c = (int)blockIdx.x;
    int j0 = -1, j1 = -1;
    if (phase == PH_PROJ) { const int q = c - 12; if (q >= 0) j0 = EGU0 + q; }
    else if (phase == PH_WOUT) { const int q = c - 4; if (q >= 0) j0 = EGU0 + 244 + q; }
    else if (phase == PH_GU) { const int q = c - 22; if (q >= 0) j0 = EGU0 + 496 + q; }
    else { const int q = c - 4;
        if (q >= 0 && q < 128) j0 = q;
        else if (q >= 128) { const int r = q - 128; if (730 + r < 896) j0 = EGU0 + 730 + r; if (730 + 124 + r < 896) j1 = EGU0 + 730 + 124 + r; } }
    for (int k = 0; k < 2; ++k) { const int j = k ? j1 : j0; if (j >= 0) conv_job(lds, a, j); }
}
__device__ __forceinline__ void prologue_phase(LAS unsigned char* lds, const Args& a) {
    unsigned char* ws = a.ws;
    const int G = gridDim.x;
    for (int blk = 128 + blockIdx.x; blk < EGU0; blk += G) conv_job(lds, a, blk);
    {
        const int tid = threadIdx.x, lane = tid & 63, wid = tid >> 6;
        LAS float* wg = (LAS float*)lds;
        __syncthreads();
        const float* w_in = a.in[2];
        for (int i = tid; i < 8192; i += NTHREADS) { const int k = i >> 3, e = i & 7; wg[e * 1024 + k] = w_in[(size_t)k * 3080 + 3072 + e]; }
        __syncthreads();
        bf16_t* H0 = (bf16_t*)(ws + WS_RB); float* gates = (float*)(ws + WS_GATES);
        const float bg = a.in[3][lane & 7];
        f32x4 xv[4], xn[4];
        { const int row = blockIdx.x * 8 + wid; const float* src = row < NR ? a.in[0] + (size_t)row * D : a.in[1] + (size_t)((row - NR) & 15) * D;
#pragma unroll
            for (int i = 0; i < 4; ++i) xv[i] = *(const f32x4*)(src + i * 256 + lane * 4); }
        for (int row = blockIdx.x * 8 + wid; row < NROWS; row += G * 8) {
            { const int rn = row + G * 8;
                if (rn < NROWS) { const float* srcn = rn < NR ? a.in[0] + (size_t)rn * D : a.in[1] + (size_t)((rn - NR) & 15) * D;
#pragma unroll
                    for (int i = 0; i < 4; ++i) xn[i] = *(const f32x4*)(srcn + i * 256 + lane * 4); } }
            float acc[8] = {0.f, 0.f, 0.f, 0.f, 0.f, 0.f, 0.f, 0.f};
#pragma unroll
            for (int i = 0; i < 4; ++i) {
                const int k = i * 256 + lane * 4;
                const f32x4 v = xv[i];
                *(u32x2*)(H0 + (size_t)row * D + k) = (u32x2){pk2(v[0], v[1]), pk2(v[2], v[3])};
#pragma unroll
                for (int e = 0; e < 8; ++e) { const f32x4 w = *(const LAS f32x4*)(wg + e * 1024 + k); acc[e] += (v[0] * w[0] + v[1] * w[1]) + (v[2] * w[2] + v[3] * w[3]); }
            }
#pragma unroll
            for (int i = 0; i < 4; ++i) xv[i] = xn[i];
#pragma unroll
            for (int e = 0; e < 8; ++e) acc[e] = wave_sum(acc[e]);
            float mine = acc[0];
#pragma unroll
            for (int e = 1; e < 8; ++e) mine = ((lane & 7) == e) ? acc[e] : mine;
            if (lane < 8) gates[(size_t)row * 8 + lane] = lane < 4 ? mine + bg : logsigmoid_(mine + bg);
        }
        __syncthreads();
    }
}

__device__ __forceinline__ bf16x8 pack_frag(const f32x16& x, int s) {
    u32x4 p; p.x = pk2(x[8 * s], x[8 * s + 1]); p.y = pk2(x[8 * s + 2], x[8 * s + 3]); p.z = pk2(x[8 * s + 4], x[8 * s + 5]); p.w = pk2(x[8 * s + 6], x[8 * s + 7]);
    return __builtin_bit_cast(bf16x8, p);
}
__device__ __forceinline__ bf16x8 ld2x64(const LAS unsigned char* p0, const LAS unsigned char* p1) {
    const u32x2 a = *(const LAS u32x2*)p0, b = *(const LAS u32x2*)p1; u32x4 r = {a.x, a.y, b.x, b.y}; return __builtin_bit_cast(bf16x8, r);
}
__device__ __forceinline__ void tr4x4(const u32x2 (&r)[4], u32x2 (&c)[4]) {
    c[0] = (u32x2){(r[0].x & 0xffffu) | (r[1].x << 16), (r[2].x & 0xffffu) | (r[3].x << 16)};
    c[1] = (u32x2){(r[0].x >> 16) | (r[1].x & 0xffff0000u), (r[2].x >> 16) | (r[3].x & 0xffff0000u)};
    c[2] = (u32x2){(r[0].y & 0xffffu) | (r[1].y << 16), (r[2].y & 0xffffu) | (r[3].y << 16)};
    c[3] = (u32x2){(r[0].y >> 16) | (r[1].y & 0xffff0000u), (r[2].y >> 16) | (r[3].y & 0xffff0000u)};
}

#define DPP_STEP_ADD(x, ctrl, rmask) x += __builtin_bit_cast(float, __builtin_amdgcn_update_dpp(0, __builtin_bit_cast(int, x), ctrl, rmask, 0xf, false))
#define DPP_STEP_MAX(x, ctrl, rmask) x = fmaxf(x, __builtin_bit_cast(float, __builtin_amdgcn_update_dpp((int)0xff800000, __builtin_bit_cast(int, x), ctrl, rmask, 0xf, false)))
__device__ __forceinline__ float scan_add64(float x) { DPP_STEP_ADD(x, 0x111, 0xf); DPP_STEP_ADD(x, 0x112, 0xf); DPP_STEP_ADD(x, 0x114, 0xf); DPP_STEP_ADD(x, 0x118, 0xf); DPP_STEP_ADD(x, 0x142, 0xa); DPP_STEP_ADD(x, 0x143, 0xc); return x; }
__device__ __forceinline__ float scan_max64(float x) { DPP_STEP_MAX(x, 0x111, 0xf); DPP_STEP_MAX(x, 0x112, 0xf); DPP_STEP_MAX(x, 0x114, 0xf); DPP_STEP_MAX(x, 0x118, 0xf); DPP_STEP_MAX(x, 0x142, 0xa); DPP_STEP_MAX(x, 0x143, 0xc); return x; }
__device__ __forceinline__ float wave_total(float x);
__device__ __forceinline__ float lane63(float x) { return __builtin_bit_cast(float, __builtin_amdgcn_readlane(__builtin_bit_cast(int, x), 63)); }
__device__ __forceinline__ float wave_total(float x) { return lane63(scan_add64(x)); }
constexpr int ML_QS = 0, ML_KS = 17408, ML_PS = 34816, ML_VT = 44032, ML_KT = 78848, ML_SC = 96256;
#ifndef ML_N0
#define ML_N0 23
#define ML_N1 18
#define ML_N2 14
#endif
__device__ __forceinline__ void mlstm_phase(LAS unsigned char* lds, const bf16_t* qkvo, const float* gates, const float* normg, bf16_t* hn, int unit_) {
    const int unit = unit_ >> 2, part_ = unit_ & 3;
    const int c_begin = part_ == 0 ? 0 : (part_ == 1 ? ML_N0 : (part_ == 2 ? ML_N0 + ML_N1 : ML_N0 + ML_N1 + ML_N2));
    const int c_end = part_ == 0 ? ML_N0 : (part_ == 1 ? ML_N0 + ML_N1 : (part_ == 2 ? ML_N0 + ML_N1 + ML_N2 : 65));
    const int tid = threadIdx.x, lane = tid & 63, wid = __builtin_amdgcn_readfirstlane(tid >> 6);
    const int b = unit >> 2, h = unit & 3;
    const int r32 = lane & 31, hh = lane >> 5, l15 = lane & 15, l4 = lane >> 4;
    LAS float* sc = (LAS float*)(lds + ML_SC);
    LAS float* Hs = (LAS float*)lds;
    const int q_row = tid >> 4, q_col = (tid & 15) * 8;
    const int k_dk = (16 * (wid & 1) + l15) * 4, k_s = (4 * (wid >> 1) + l4) * 4;
    const int v_dv = (16 * (wid & 3) + l15) * 4, v_s0 = (4 * (wid >> 2) + l4) * 4;
    f32x16 Cacc[4];
#pragma unroll
    for (int i = 0; i < 4; ++i)
#pragma unroll
        for (int j = 0; j < 16; ++j) Cacc[i][j] = 0.f;
    if (tid < 128) sc[192 + tid] = 0.f;
    float m_run = 0.f;
    u32x4 qreg[2]; u32x2 kreg[4], vreg[2][4]; float g_li = 0.f, g_lf = 0.f;
#define rowof(c, t) ((c) == 0 ? (NR + b * 16 + ((t) - 48)) : (b * SEQ + 64 * ((c) - 1) + (t)))
#define ML_PREFETCH(c) do { \
        if ((c) >= c_begin) _Pragma("unroll") for (int p = 0; p < 2; ++p) { const int t = q_row + 32 * p; const bool pad = ((c) == 0 && t < 48); \
            qreg[p] = pad ? (u32x4){0u, 0u, 0u, 0u} : *(const u32x4*)(qkvo + (size_t)rowof((c), t) * NPROJ + h * 128 + q_col); } \
        _Pragma("unroll") for (int kk = 0; kk < 4; ++kk) { const int t = k_s + kk; const bool pad = ((c) == 0 && t < 48); \
            kreg[kk] = pad ? (u32x2){0u, 0u} : *(const u32x2*)(qkvo + (size_t)rowof((c), t) * NPROJ + 512 + h * 128 + k_dk); } \
        _Pragma("unroll") for (int p = 0; p < 2; ++p) _Pragma("unroll") for (int kk = 0; kk < 4; ++kk) { const int t = v_s0 + 32 * p + kk; const bool pad = ((c) == 0 && t < 48); \
            vreg[p][kk] = pad ? (u32x2){0u, 0u} : *(const u32x2*)(qkvo + (size_t)rowof((c), t) * NPROJ + 1024 + h * 256 + v_dv); } \
        { const bool pad = ((c) == 0 && lane < 48); g_li = pad ? -1e30f : gates[(size_t)rowof((c), lane) * 8 + h]; g_lf = pad ? 0.f : gates[(size_t)rowof((c), lane) * 8 + 4 + h]; } } while (0)
    ML_PREFETCH(0);
    for (int c = 0; c < c_end; ++c) {
        const bool full = (c >= c_begin);
        const float li = g_li;
        const float lf = g_lf;
        const float bc = scan_add64(lf);
        const float av = li - bc;
        const float um = scan_max64(av);
        const float Mt = fmaxf(m_run, um);
        const float winter = __expf(m_run - Mt), bmt = bc + Mt;
        const float M63 = lane63(Mt), b63 = lane63(bc);
        const float wlast = __expf(av - M63), decay = __expf(m_run - M63);
        if (full) {
#pragma unroll
        for (int p = 0; p < 2; ++p) *(LAS u32x4*)(lds + ML_QS + (q_row + 32 * p) * 272 + q_col * 2) = qreg[p]; }
        {
            u32x2 kw[4];
#pragma unroll
            for (int kk = 0; kk < 4; ++kk) {
                if (full) *(LAS u32x2*)(lds + ML_KS + (k_s + kk) * 272 + k_dk * 2) = kreg[kk];
                const float w = __shfl(wlast, k_s + kk) * 0.08838834764831845f;
                kw[kk] = (u32x2){pk2(bflo(kreg[kk].x) * w, bfhi(kreg[kk].x) * w), pk2(bflo(kreg[kk].y) * w, bfhi(kreg[kk].y) * w)};
            }
            u32x2 kc[4]; tr4x4(kw, kc);
#pragma unroll
            for (int j = 0; j < 4; ++j) *(LAS u32x2*)(lds + ML_KT + (k_dk + j) * 136 + k_s * 2) = kc[j];
        }
#pragma unroll
        for (int p = 0; p < 2; ++p) { u32x2 vc[4]; tr4x4(vreg[p], vc);
#pragma unroll
            for (int j = 0; j < 4; ++j) *(LAS u32x2*)(lds + ML_VT + (v_dv + j) * 136 + (v_s0 + 32 * p) * 2) = vc[j]; }
        if (wid == 0) { sc[lane] = winter; sc[128 + lane] = bmt; }
        __syncthreads();
        if (c + 1 < c_end) ML_PREFETCH(c + 1);
        if (full) {
            const int ti = wid >> 1;
#pragma unroll
            for (int q = 0; q < 2; ++q) {
                const int si = 2 * (wid & 1) + q;
                f32x4 sa = {0.f, 0.f, 0.f, 0.f};
                if (si <= ti) {
#pragma unroll
                    for (int ks = 0; ks < 4; ++ks) {
                        const bf16x8 af = *(const LAS bf16x8*)(lds + ML_QS + (16 * ti + l15) * 272 + (32 * ks + 8 * l4) * 2);
                        const bf16x8 bfr = *(const LAS bf16x8*)(lds + ML_KS + (16 * si + l15) * 272 + (32 * ks + 8 * l4) * 2);
                        sa = __builtin_amdgcn_mfma_f32_16x16x32_bf16(af, bfr, sa, 0, 0, 0);
                    }
                }
                const int s = 16 * si + l15;
                const float a_s = __shfl(av, s);
#pragma unroll
                for (int r = 0; r < 4; ++r) {
                    const int t = 16 * ti + 4 * l4 + r;
                    const float Mtt = __shfl(Mt, t);
                    const float w = (s <= t) ? __expf(a_s - Mtt) : 0.f;
                    *(LAS bf16_t*)(lds + ML_PS + t * 144 + s * 2) = f2bf(sa[r] * 0.08838834764831845f * w);
                }
            }
        }
        bf16x8 vf[4];
#pragma unroll
        for (int ks = 0; ks < 4; ++ks) { const LAS unsigned char* p = lds + ML_VT + (32 * wid + r32) * 136 + (16 * ks + 8 * hh) * 2; vf[ks] = ld2x64(p, p + 8); }
        if (full) {
        __syncthreads();
        {
            const int t = tid >> 3, part = tid & 7;
            float qn = 0.f, ps = 0.f;
            const u32x4 q0 = *(const LAS u32x4*)(lds + ML_QS + t * 272 + part * 32), q1 = *(const LAS u32x4*)(lds + ML_QS + t * 272 + part * 32 + 16);
            float qv[16]; { float t8[8]; g8::unpack8(q0, t8);
#pragma unroll
                for (int j = 0; j < 8; ++j) qv[j] = t8[j]; g8::unpack8(q1, t8);
#pragma unroll
                for (int j = 0; j < 8; ++j) qv[8 + j] = t8[j]; }
#pragma unroll
            for (int j = 0; j < 16; ++j) qn += qv[j] * sc[192 + part * 16 + j];
            const u32x4 pw = *(const LAS u32x4*)(lds + ML_PS + t * 144 + part * 16);
            float pv[8]; g8::unpack8(pw, pv);
#pragma unroll
            for (int j = 0; j < 8; ++j) ps += pv[j];
            qn += __shfl_xor(qn, 1); qn += __shfl_xor(qn, 2); qn += __shfl_xor(qn, 4);
            ps += __shfl_xor(ps, 1); ps += __shfl_xor(ps, 2); ps += __shfl_xor(ps, 4);
            if (part == 0) { const float den = sc[t] * qn + ps; sc[64 + t] = __builtin_amdgcn_rcpf(fmaxf(fabsf(den), __expf(-sc[128 + t]))); }
        }
        f32x16 num[2];
#pragma unroll
        for (int tt = 0; tt < 2; ++tt) {
#pragma unroll
            for (int j = 0; j < 16; ++j) num[tt][j] = 0.f;
#pragma unroll
            for (int dkt = 0; dkt < 4; ++dkt)
#pragma unroll
                for (int s2 = 0; s2 < 2; ++s2) {
                    const LAS unsigned char* p = lds + ML_QS + (32 * tt + r32) * 272 + (32 * dkt + 16 * s2 + 4 * hh) * 2;
                    const bf16x8 af = ld2x64(p, p + 16);
                    num[tt] = __builtin_amdgcn_mfma_f32_32x32x16_bf16(af, pack_frag(Cacc[dkt], s2), num[tt], 0, 0, 0);
                }
#pragma unroll
            for (int gq = 0; gq < 4; ++gq) { const f32x4 wv = *(const LAS f32x4*)(sc + 32 * tt + 8 * gq + 4 * hh);
#pragma unroll
                for (int r = 0; r < 4; ++r) num[tt][4 * gq + r] *= wv[r]; }
#pragma unroll
            for (int ks = 0; ks < 4; ++ks) {
                if (tt == 0 && ks >= 2) continue;
                const bf16x8 pf = *(const LAS bf16x8*)(lds + ML_PS + (32 * tt + r32) * 144 + (16 * ks + 8 * hh) * 2);
                num[tt] = __builtin_amdgcn_mfma_f32_32x32x16_bf16(pf, vf[ks], num[tt], 0, 0, 0);
            }
        }
        __syncthreads();
        u32x2 oreg[8];
        { const int t = tid >> 3, part = tid & 7; const bool pad = (c == 0 && t < 48); const size_t row = pad ? 0 : (size_t)rowof(c, t);
#pragma unroll
            for (int i = 0; i < 8; ++i) oreg[i] = *(const u32x2*)(qkvo + row * NPROJ + 2048 + h * 256 + 32 * i + 4 * part); }
#pragma unroll
        for (int tt = 0; tt < 2; ++tt)
#pragma unroll
            for (int gq = 0; gq < 4; ++gq) { const f32x4 iv = *(const LAS f32x4*)(sc + 64 + 32 * tt + 8 * gq + 4 * hh);
#pragma unroll
                for (int r = 0; r < 4; ++r) Hs[(32 * tt + 8 * gq + 4 * hh + r) * 260 + 32 * wid + r32] = num[tt][4 * gq + r] * iv[r]; }
        __syncthreads();
        {
            const int t = tid >> 3, part = tid & 7;
            f32x4 x[8]; float s1 = 0.f;
#pragma unroll
            for (int i = 0; i < 8; ++i) { x[i] = *(const LAS f32x4*)(Hs + t * 260 + 32 * i + 4 * part); s1 += (x[i][0] + x[i][1]) + (x[i][2] + x[i][3]); }
            s1 += __shfl_xor(s1, 1); s1 += __shfl_xor(s1, 2); s1 += __shfl_xor(s1, 4);
            const float mean = s1 * (1.0f / 256.0f); float s2 = 0.f;
#pragma unroll
            for (int i = 0; i < 8; ++i) { const f32x4 d = x[i] - mean; s2 += (d[0] * d[0] + d[1] * d[1]) + (d[2] * d[2] + d[3] * d[3]); }
            s2 += __shfl_xor(s2, 1); s2 += __shfl_xor(s2, 2); s2 += __shfl_xor(s2, 4);
            const float rstd = rsqrtf(s2 * (1.0f / 256.0f) + LN_EPS);
            if (!(c == 0 && t < 48)) {
                const size_t row = (size_t)rowof(c, t);
#pragma unroll
                for (int i = 0; i < 8; ++i) {
                    const int dv = 32 * i + 4 * part;
                    const u32x2 ow = oreg[i];
                    const f32x4 ng = *(const f32x4*)(normg + h * 256 + dv);
                    const float o0 = sigmoidf_(bflo(ow.x)), o1 = sigmoidf_(bfhi(ow.x)), o2 = sigmoidf_(bflo(ow.y)), o3 = sigmoidf_(bfhi(ow.y));
                    const f32x4 y = (x[i] - mean) * rstd * ng;
                    *(u32x2*)(hn + row * D + h * 256 + dv) = (u32x2){pk2(y[0] * o0, y[1] * o1), pk2(y[2] * o2, y[3] * o3)};
                }
            }
        }
        }
#pragma unroll
        for (int dkt = 0; dkt < 4; ++dkt) {
#pragma unroll
            for (int j = 0; j < 16; ++j) Cacc[dkt][j] *= decay;
#pragma unroll
            for (int ks = 0; ks < 4; ++ks) { const LAS unsigned char* p = lds + ML_KT + (32 * dkt + r32) * 136 + (16 * ks + 8 * hh) * 2;
                Cacc[dkt] = __builtin_amdgcn_mfma_f32_32x32x16_bf16(ld2x64(p, p + 8), vf[ks], Cacc[dkt], 0, 0, 0); }
        }
        {
            const int dk = tid >> 2, part = tid & 3;
            const u32x2 k0 = *(const LAS u32x2*)(lds + ML_KT + dk * 136 + part * 32), k1 = *(const LAS u32x2*)(lds + ML_KT + dk * 136 + part * 32 + 8),
                        k2 = *(const LAS u32x2*)(lds + ML_KT + dk * 136 + part * 32 + 16), k3 = *(const LAS u32x2*)(lds + ML_KT + dk * 136 + part * 32 + 24);
            float s = ((bflo(k0.x) + bfhi(k0.x)) + (bflo(k0.y) + bfhi(k0.y))) + ((bflo(k1.x) + bfhi(k1.x)) + (bflo(k1.y) + bfhi(k1.y)))
                    + ((bflo(k2.x) + bfhi(k2.x)) + (bflo(k2.y) + bfhi(k2.y))) + ((bflo(k3.x) + bfhi(k3.x)) + (bflo(k3.y) + bfhi(k3.y)));
            s += __shfl_xor(s, 1); s += __shfl_xor(s, 2);
            if (part == 0) sc[192 + dk] = decay * sc[192 + dk] + s;
        }
        m_run = b63 + M63;
        __syncthreads();
    }
#undef ML_PREFETCH
#undef rowof
}

constexpr float AT_PMIN = 1e-15f;
constexpr int AT_K0 = 0, AT_V0 = 17408, AT_BUF = 34816, AT_FLAGS = 2 * AT_BUF;
__device__ __forceinline__ void at_tile(const LAS unsigned char* Kb, const LAS unsigned char* Vb, int k0, int tmin, int r32, int hh, const bf16x8 (&qf)[8], f32x16 (&O)[4], float& P) {
    f32x16 S[2];
#pragma unroll
    for (int u = 0; u < 2; ++u) {
#pragma unroll
        for (int j = 0; j < 16; ++j) S[u][j] = 0.f;
#pragma unroll
        for (int ks = 0; ks < 8; ++ks) {
            const bf16x8 kf = *(const LAS bf16x8*)(Kb + (32 * u + r32) * 272 + (16 * ks + 8 * hh) * 2);
            S[u] = __builtin_amdgcn_mfma_f32_32x32x16_bf16(kf, qf[ks], S[u], 0, 0, 0);
        }
    }
    const bool full = (k0 + 63 < tmin) && (k0 >= 128);
    const int lim = tmin + r32 - k0 - 4 * hh;
    const int lo = 112 - k0 - 4 * hh;
    float Tt[2][4];
#define AT_ELEM(MASKED) \
    _Pragma("unroll") for (int u = 0; u < 2; ++u) _Pragma("unroll") for (int gq = 0; gq < 4; ++gq) { \
        float x4[4]; \
        _Pragma("unroll") for (int r = 0; r < 4; ++r) { \
            float zz = S[u][4 * gq + r] * (0.08838834764831845f * 1.4426950408889634f); \
            if (MASKED) { const int o = 32 * u + 8 * gq + r; zz = (o < lim && o >= lo) ? zz : -1.0e4f; } \
            const float rc = __builtin_amdgcn_rcpf(1.0f + __builtin_amdgcn_exp2f(zz)); \
            S[u][4 * gq + r] = 1.0f - rc; x4[r] = rc; } \
        const float e2 = x4[3], e1 = e2 * x4[2], e0 = e1 * x4[1]; \
        Tt[u][gq] = e0 * x4[0]; \
        S[u][4 * gq + 2] *= e2; S[u][4 * gq + 1] *= e1; S[u][4 * gq + 0] *= e0; }
    if (full) { AT_ELEM(false) } else { AT_ELEM(true) }
#undef AT_ELEM
    float acc = P;
#pragma unroll
    for (int u = 1; u >= 0; --u)
#pragma unroll
        for (int gq = 3; gq >= 0; --gq) {
            float t0; const float t1 = swap32_hi(Tt[u][gq], t0);
            const float Rr = hh ? acc : acc * t1;
            acc = (acc * t1) * t0;
#pragma unroll
            for (int r = 0; r < 4; ++r) S[u][4 * gq + r] *= Rr;
        }
    P = acc;
#pragma unroll
    for (int u = 0; u < 2; ++u)
#pragma unroll
        for (int s2 = 0; s2 < 2; ++s2) {
            const bf16x8 af = pack_frag(S[u], s2);
#pragma unroll
            for (int dt = 0; dt < 4; ++dt) {
                const LAS unsigned char* p = Vb + (32 * dt + r32) * 136 + (32 * u + 16 * s2 + 4 * hh) * 2;
                O[dt] = __builtin_amdgcn_mfma_f32_32x32x16_bf16(af, ld2x64(p, p + 16), O[dt], 0, 0, 0);
            }
        }
}
__device__ __forceinline__ void attn_phase(LAS unsigned char* lds, const bf16_t* kvq, bf16_t* ao) {
    const int tid = threadIdx.x, lane = tid & 63, wid = __builtin_amdgcn_readfirstlane(tid >> 6);
    const int r32 = lane & 31, hh = lane >> 5, l15 = lane & 15, l4 = lane >> 4;
    LAS unsigned* flags = (LAS unsigned*)(lds + AT_FLAGS);
    const int k_row = tid >> 4, k_col = (tid & 15) * 8;
    const int v_d = (16 * (wid & 1) + l15) * 4, v_s = (4 * (wid >> 1) + l4) * 4;
    for (int unit = blockIdx.x; unit < NB * 8 * 16; unit += gridDim.x) {
        const int qt = unit & 15, head = (unit >> 4) & 7, b = unit >> 7;
        const int q0 = 128 + 256 * qt, tmin = q0 + 32 * wid;
#define rowofp(p) ((p) >= 128 ? b * SEQ + (p) - 128 : ((p) >= 112 ? NR + b * 16 + (p) - 112 : NR + b * 16))
        bf16x8 qf[8];
        { const bf16_t* qp = kvq + (size_t)(b * SEQ + tmin - 128 + r32) * NPROJ + 2048 + head * 128 + 8 * hh;
#pragma unroll
            for (int ks = 0; ks < 8; ++ks) qf[ks] = *(const bf16x8*)(qp + 16 * ks); }
        f32x16 O[4];
#pragma unroll
        for (int i = 0; i < 4; ++i)
#pragma unroll
            for (int j = 0; j < 16; ++j) O[i][j] = 0.f;
        float P = 1.0f;
        const int kt_hi = (q0 >> 6) + 3;
        u32x4 kregA[2], kregB[2]; u32x2 vregA[4], vregB[4];
#define AT_LOAD(kreg, vreg, kt) do { \
        _Pragma("unroll") for (int p = 0; p < 2; ++p) kreg[p] = *(const u32x4*)(kvq + (size_t)rowofp(64 * (kt) + k_row + 32 * p) * NPROJ + head * 128 + k_col); \
        _Pragma("unroll") for (int kk = 0; kk < 4; ++kk) vreg[kk] = *(const u32x2*)(kvq + (size_t)rowofp(64 * (kt) + v_s + kk) * NPROJ + 1024 + head * 128 + v_d); } while (0)
#define AT_STORE(kreg, vreg, buf) do { LAS unsigned char* base = lds + (buf) * AT_BUF; \
        _Pragma("unroll") for (int p = 0; p < 2; ++p) *(LAS u32x4*)(base + AT_K0 + (k_row + 32 * p) * 272 + k_col * 2) = kreg[p]; \
        u32x2 vc[4]; tr4x4(vreg, vc); \
        _Pragma("unroll") for (int j = 0; j < 4; ++j) *(LAS u32x2*)(base + AT_V0 + (v_d + j) * 136 + v_s * 2) = vc[j]; } while (0)
#define AT_ITER(BUF, LOADSET_K, LOADSET_V, STORESET_K, STORESET_V) { \
            const int kt = kt_hi - it; \
            __syncthreads(); \
            if (it > 0 && flags[it - 1] == 0u) break; \
            if (kt - 2 >= 1) AT_LOAD(LOADSET_K, LOADSET_V, kt - 2); \
            if (64 * kt < tmin + 31 && __ballot(P >= AT_PMIN) != 0ull) at_tile(lds + (BUF) * AT_BUF + AT_K0, lds + (BUF) * AT_BUF + AT_V0, 64 * kt, tmin, r32, hh, qf, O, P); \
            if (__ballot(P >= AT_PMIN) != 0ull && lane == 0) flags[it] = 1u; \
            if (kt - 1 < 1) break; \
            AT_STORE(STORESET_K, STORESET_V, 1 - (BUF)); \
            ++it; }
        if (tid < 80) flags[tid] = 0u;
        AT_LOAD(kregA, vregA, kt_hi);
        AT_STORE(kregA, vregA, 0);
        AT_LOAD(kregB, vregB, kt_hi - 1);
        for (int it = 0; ; ) {
            AT_ITER(0, kregA, vregA, kregB, vregB)
            AT_ITER(1, kregB, vregB, kregA, vregA)
        }
#pragma unroll
        for (int dt = 0; dt < 4; ++dt)
#pragma unroll
            for (int j = 0; j < 16; ++j) {
                const int t = tmin + (j & 3) + 8 * (j >> 2) + 4 * hh;
                ao[(size_t)(b * SEQ + t - 128) * D + head * 128 + 32 * dt + r32] = f2bf(O[dt][j]);
            }
        __syncthreads();
    }
#undef AT_LOAD
#undef AT_STORE
#undef AT_ITER
#undef rowofp
}

__device__ __forceinline__ void ln_row_stats_wave(const float* st, int row, int lane, float& mu, float& rstd) {
    const f32x2 p = *(const f32x2*)(st + (size_t)row * 32 + (lane & 15) * 2);
    float s1 = p[0], s2 = p[1];
#pragma unroll
    for (int o = 1; o < 16; o <<= 1) { s1 += __shfl_xor(s1, o); s2 += __shfl_xor(s2, o); }
    mu = s1 * (1.0f / 1024.0f); const float var = fmaxf(s2 * (1.0f / 1024.0f) - mu * mu, 0.f); rstd = rsqrtf(var + LN_EPS);
}
__device__ __forceinline__ void router1_phase(LAS unsigned char* lds, const Args& a) {
    const int tid = threadIdx.x, lane = tid & 63, wid = tid >> 6;
    unsigned char* ws = a.ws;
    const float* g3 = a.in[16] + 2048; const float* b3 = a.in[17] + 2048; const float* wr = a.in[12];
    LAS float* gw = (LAS float*)lds;
    LAS float* cc = (LAS float*)(lds + 32768);
    LAS int* cnt = (LAS int*)(lds + 32768 + 64);
    __syncthreads();
    for (int i = tid; i < 8192; i += NTHREADS) { const int k = i >> 3, e = i & 7; gw[e * 1024 + k] = g3[k] * wr[i]; }
    if (tid < 8) cnt[tid] = 0;
    __syncthreads();
    { float s1 = 0.f, s2 = 0.f;
        for (int k = lane; k < 1024; k += 64) { s1 += gw[wid * 1024 + k]; s2 += b3[k] * wr[k * 8 + wid]; }
        s1 = wave_sum(s1); s2 = wave_sum(s2);
        if (lane == 0) { cc[wid] = s1; cc[8 + wid] = s2; } }
    __syncthreads();
    const bf16_t* z3 = (const bf16_t*)(ws + WS_RC); const float* st3 = (const float*)(ws + WS_ST3);
    f32x4* route = (f32x4*)(ws + WS_ROUTE);
    const int tok0 = (int)(((long)NR * blockIdx.x) / gridDim.x), tok1 = (int)(((long)NR * (blockIdx.x + 1)) / gridDim.x);
    u32x4 zr[2]; f32x2 sp;
#define RT_LOAD(t) do { zr[0] = *(const u32x4*)(z3 + (size_t)(t) * D + lane * 8); zr[1] = *(const u32x4*)(z3 + (size_t)(t) * D + 512 + lane * 8); sp = *(const f32x2*)(st3 + (size_t)(t) * 32 + (lane & 15) * 2); } while (0)
    if (tok0 + wid < tok1) RT_LOAD(tok0 + wid);
    for (int tok = tok0 + wid; tok < tok1; tok += 8) {
        const u32x4 zc[2] = {zr[0], zr[1]}; const f32x2 spc = sp;
        if (tok + 8 < tok1) RT_LOAD(tok + 8);
        float s1 = spc[0], s2 = spc[1];
#pragma unroll
        for (int o = 1; o < 16; o <<= 1) { s1 += __shfl_xor(s1, o); s2 += __shfl_xor(s2, o); }
        const float mu = s1 * (1.0f / 1024.0f); const float rstd = rsqrtf(fmaxf(s2 * (1.0f / 1024.0f) - mu * mu, 0.f) + LN_EPS);
        float acc[8] = {0.f, 0.f, 0.f, 0.f, 0.f, 0.f, 0.f, 0.f};
#pragma unroll
        for (int hf = 0; hf < 2; ++hf) {
            const int k = hf * 512 + lane * 8;
            float z[8]; g8::unpack8(zc[hf], z);
#pragma unroll
            for (int e = 0; e < 8; ++e) { const f32x4 w0 = *(const LAS f32x4*)(gw + e * 1024 + k), w1 = *(const LAS f32x4*)(gw + e * 1024 + k + 4);
                acc[e] += ((z[0] * w0[0] + z[1] * w0[1]) + (z[2] * w0[2] + z[3] * w0[3])) + ((z[4] * w1[0] + z[5] * w1[1]) + (z[6] * w1[2] + z[7] * w1[3])); }
        }
        float lg[8];
#pragma unroll
        for (int e = 0; e < 8; ++e) lg[e] = rstd * (wave_total(acc[e]) - mu * cc[e]) + cc[8 + e];
        int e1 = 0; float v1 = lg[0];
#pragma unroll
        for (int e = 1; e < 8; ++e) if (lg[e] > v1) { v1 = lg[e]; e1 = e; }
        int e2 = -1; float v2 = -3.0e38f;
#pragma unroll
        for (int e = 0; e < 8; ++e) if (e != e1 && lg[e] > v2) { v2 = lg[e]; e2 = e; }
        const float g1 = 1.0f / (1.0f + expf(v2 - v1));
        if (lane == 0) { ((f32x2*)(ws + WS_TOKST))[tok] = (f32x2){mu, rstd}; route[tok] = (f32x4){__int_as_float(e1 | (e2 << 8)), g1, 1.0f - g1, 0.f}; __hip_atomic_fetch_add(&cnt[e1], 1, __ATOMIC_RELAXED, __HIP_MEMORY_SCOPE_WORKGROUP); __hip_atomic_fetch_add(&cnt[e2], 1, __ATOMIC_RELAXED, __HIP_MEMORY_SCOPE_WORKGROUP); }
    }
    __syncthreads();
    if (tid < 8) ((int*)(ws + WS_CNT))[blockIdx.x * 8 + tid] = cnt[tid];
}
__device__ __forceinline__ void router2_phase(LAS unsigned char* lds, const Args& a) {
    const int tid = threadIdx.x, lane = tid & 63, wid = tid >> 6;
    unsigned char* ws = a.ws;
    const int G = gridDim.x, wg = blockIdx.x;
    LAS int* cn = (LAS int*)lds;
    LAS int* tot = (LAS int*)(lds + 16384);
    __syncthreads();
    const int* cnts = (const int*)(ws + WS_CNT);
    for (int i = tid; i < G * 8; i += NTHREADS) cn[i] = cnts[i];
    __syncthreads();
    { int t = 0, p = 0;
        for (int w = lane; w < G; w += 64) { const int v = cn[w * 8 + wid]; t += v; p += (w < wg) ? v : 0; }
#pragma unroll
        for (int o = 32; o >= 1; o >>= 1) { t += __shfl_xor(t, o); p += __shfl_xor(p, o); }
        if (lane == 0) { tot[wid] = t; tot[8 + wid] = p; } }
    __syncthreads();
    if (tid == 0) { int ps = 0;
        for (int e = 0; e < 8; ++e) { tot[24 + e] = ps; tot[16 + e] = ps + tot[8 + e]; ps += ((tot[e] + 255) >> 8) << 8; }
        if (wg == 0) { int* hdr = (int*)(ws + WS_HDR); int pp = 0; for (int e = 0; e < 8; ++e) { pp += (tot[e] + 255) >> 8; hdr[e] = pp; } hdr[8] = pp; } }
    __syncthreads();
    u32x2* smeta = (u32x2*)(ws + WS_TOK); f32x2* sstat = (f32x2*)(ws + WS_GATEB); const f32x2* tokst = (const f32x2*)(ws + WS_TOKST);
    const f32x4* route = (const f32x4*)(ws + WS_ROUTE);
    const int tok0 = (int)(((long)NR * wg) / G), tok1 = (int)(((long)NR * (wg + 1)) / G);
    { const int e = wid; int run = tot[16 + e];
        for (int q0 = 2 * tok0; q0 < 2 * tok1; q0 += 64) {
            const int q = q0 + lane; bool match = false; float gt = 0.f;
            if (q < 2 * tok1) { const f32x4 r = route[q >> 1]; const int ee = __float_as_int(r[0]); const int ex = (q & 1) ? ((ee >> 8) & 0xff) : (ee & 0xff); match = (ex == e); gt = (q & 1) ? r[2] : r[1]; }
            const unsigned long long mask = __ballot(match);
            const int pos = __popcll(mask & ((1ull << lane) - 1ull));
            if (match) { smeta[run + pos] = (u32x2){(unsigned)q, __float_as_uint(gt)}; sstat[run + pos] = tokst[q >> 1]; }
            run += __popcll(mask);
        }
        if (wg == 0) { const int s0 = tot[24 + e] + tot[e], s1 = tot[24 + e] + (((tot[e] + 255) >> 8) << 8);
            for (int s = s0 + lane; s < s1; s += 64) { smeta[s] = (u32x2){0xffffffffu, 0u}; sstat[s] = (f32x2){0.f, 1.f}; } }
    }
}

__device__ __forceinline__ float wave_total(float x);
__device__ __forceinline__ void final_phase(const Args& a) {
    const int tid = threadIdx.x, lane = tid & 63, wid = tid >> 6;
    unsigned char* ws = a.ws;
    const bf16_t* z3 = (const bf16_t*)(ws + WS_RC); const float* st3 = (const float*)(ws + WS_ST3);
    const bf16_t* Y0 = (const bf16_t*)(ws + WS_RB); const bf16_t* Y1 = (const bf16_t*)(ws + WS_RD);
    const float* g3 = a.in[16] + 2048; const float* b3 = a.in[17] + 2048; const float* g4 = a.in[16] + 3072; const float* b4 = a.in[17] + 3072;
    float G3[16], B3[16], G4[16], B4[16];
#pragma unroll
    for (int hf = 0; hf < 2; ++hf)
#pragma unroll
        for (int q = 0; q < 2; ++q) { const int k = hf * 512 + lane * 8 + q * 4;
            const f32x4 a3 = *(const f32x4*)(g3 + k), c3 = *(const f32x4*)(b3 + k), a4 = *(const f32x4*)(g4 + k), c4 = *(const f32x4*)(b4 + k);
#pragma unroll
            for (int j = 0; j < 4; ++j) { G3[hf * 8 + q * 4 + j] = a3[j] * ALPHA; B3[hf * 8 + q * 4 + j] = c3[j] * ALPHA; G4[hf * 8 + q * 4 + j] = a4[j]; B4[hf * 8 + q * 4 + j] = c4[j]; } }
    const int stride = gridDim.x * 8;
    int tok = blockIdx.x * 8 + wid;
    u32x4 zr[2], y0r[2], y1r[2]; f32x2 sp;
#define FIN_LOAD(t) do { _Pragma("unroll") for (int hf = 0; hf < 2; ++hf) { const size_t o = (size_t)(t) * D + hf * 512 + lane * 8; \
        zr[hf] = *(const u32x4*)(z3 + o); y0r[hf] = *(const u32x4*)(Y0 + o); y1r[hf] = *(const u32x4*)(Y1 + o); } \
        sp = *(const f32x2*)(st3 + (size_t)(t) * 32 + (lane & 15) * 2); } while (0)
    if (tok < NR) FIN_LOAD(tok);
    for (; tok < NR; tok += stride) {
        u32x4 zc[2] = {zr[0], zr[1]}, y0c[2] = {y0r[0], y0r[1]}, y1c[2] = {y1r[0], y1r[1]}; const f32x2 spc = sp;
        if (tok + stride < NR) FIN_LOAD(tok + stride);
        float s1 = spc[0], s2 = spc[1];
#pragma unroll
        for (int o = 1; o < 16; o <<= 1) { s1 += __shfl_xor(s1, o); s2 += __shfl_xor(s2, o); }
        const float mu = s1 * (1.0f / 1024.0f); const float rstd = rsqrtf(fmaxf(s2 * (1.0f / 1024.0f) - mu * mu, 0.f) + LN_EPS);
        float v[16]; float t1 = 0.f;
#pragma unroll
        for (int hf = 0; hf < 2; ++hf) {
            float z[8], y0[8], y1[8];
            g8::unpack8(zc[hf], z); g8::unpack8(y0c[hf], y0); g8::unpack8(y1c[hf], y1);
#pragma unroll
            for (int j = 0; j < 8; ++j) { const float x = ((z[j] - mu) * rstd * G3[hf * 8 + j] + B3[hf * 8 + j]) + (y0[j] + y1[j]); v[hf * 8 + j] = x; t1 += x; }
        }
        t1 = wave_total(t1); const float mean = t1 * (1.0f / 1024.0f); float t2 = 0.f;
#pragma unroll
        for (int j = 0; j < 16; ++j) { const float d = v[j] - mean; t2 += d * d; }
        t2 = wave_total(t2); const float rs = rsqrtf(t2 * (1.0f / 1024.0f) + LN_EPS);
#pragma unroll
        for (int hf = 0; hf < 2; ++hf) {
            const int k = hf * 512 + lane * 8;
            f32x4 o0, o1;
#pragma unroll
            for (int j = 0; j < 4; ++j) { o0[j] = (v[hf * 8 + j] - mean) * rs * G4[hf * 8 + j] + B4[hf * 8 + j]; o1[j] = (v[hf * 8 + 4 + j] - mean) * rs * G4[hf * 8 + 4 + j] + B4[hf * 8 + 4 + j]; }
            *(f32x4*)(a.out + (size_t)tok * D + k) = o0; *(f32x4*)(a.out + (size_t)tok * D + k + 4) = o1;
        }
    }
#undef FIN_LOAD
}

__device__ __forceinline__ void moefix_phase(const Args& a) {
    const int lane = threadIdx.x & 63, wid = threadIdx.x >> 6;
    unsigned char* ws = a.ws;
    const int npan = ((const int*)(ws + WS_HDR))[8];
    const int p_lo = (MOE_NCHUNK - 1) * MOE_CHUNK_PAN + MOE_CHUNK_PAN;
    const int nrows = (npan - p_lo) * 256;
    const u32x2* smeta = (const u32x2*)(ws + WS_TOK);
    const float* P = (const float*)(ws + WS_RA + RA_POFF);
    bf16_t* Y0 = (bf16_t*)(ws + WS_RB); bf16_t* Y1 = (bf16_t*)(ws + WS_RD);
    for (int r = blockIdx.x * 8 + wid; r < nrows; r += gridDim.x * 8) {
        const u32x2 mg = smeta[(size_t)p_lo * 256 + r];
        const int id = (int)mg.x; const float gt = __uint_as_float(mg.y);
        if (id < 0) continue;
        bf16_t* yrow = ((id & 1) ? Y1 : Y0) + (size_t)(id >> 1) * D;
#pragma unroll
        for (int hf = 0; hf < 2; ++hf) {
            const int c = hf * 512 + lane * 8;
            f32x4 s0 = {0.f, 0.f, 0.f, 0.f}, s1 = {0.f, 0.f, 0.f, 0.f};
#pragma unroll
            for (int ks = 0; ks < MOE_KSPLIT; ++ks) { const float* pp = P + ((size_t)ks * 2048 + r) * D + c; s0 += *(const f32x4*)pp; s1 += *(const f32x4*)(pp + 4); }
            *(u32x4*)(yrow + c) = g8::pack8(s0 * gt, s1 * gt);
        }
    }
}
__device__ __forceinline__ void finstats_phase(const float* st, float* rs, int nrows) {
    for (int row = blockIdx.x * NTHREADS + threadIdx.x; row < nrows; row += gridDim.x * NTHREADS) {
        const f32x4* p = (const f32x4*)(st + (size_t)row * 32);
        float s1 = 0.f, s2 = 0.f;
#pragma unroll
        for (int i = 0; i < 8; ++i) { const f32x4 a = p[i]; s1 += a[0] + a[2]; s2 += a[1] + a[3]; }
        const float mu = s1 * (1.0f / 1024.0f); const float rstd = rsqrtf(fmaxf(s2 * (1.0f / 1024.0f) - mu * mu, 0.f) + LN_EPS);
        *(f32x2*)(rs + (size_t)row * 2) = (f32x2){mu, rstd};
    }
}
__global__ void __launch_bounds__(NTHREADS, 2) yoco_fwd(Args args) {
    extern __shared__ __attribute__((aligned(16))) unsigned char lds_raw[];
    LAS unsigned char* lds = (LAS unsigned char*)lds_raw;
    unsigned char* ws = args.ws;
    const int G = gridDim.x;
    const int lo = args.ph_lo, hi = args.ph_hi;
    volatile LAS unsigned* misc = (volatile LAS unsigned*)(lds + LDS_MAIN);
    if (threadIdx.x < 4) misc[threadIdx.x] = 0u;
    __syncthreads();
    XcdBarrier bar; bar.bar = (unsigned*)(ws + WS_CTL); bar.x = 0; bar.st = misc;
    if (hi - lo > 1) bar = xcd_barrier_post((unsigned*)(ws + WS_CTL), misc);
#ifndef PHASE_MASK
#define PHASE_MASK 0xFFFFFFFFu
#endif
#define IN(k) (((PHASE_MASK >> (k)) & 1u) && lo <= (k) && (k) < hi)
#define SEAM(k) do { if (IN(k) && IN((k) + 1)) xcd_barrier(bar); } while (0)
    bf16_t* RA = (bf16_t*)(ws + WS_RA); bf16_t* RB = (bf16_t*)(ws + WS_RB); bf16_t* RC = (bf16_t*)(ws + WS_RC); bf16_t* RD = (bf16_t*)(ws + WS_RD);
    float* vec = (float*)(ws + WS_VEC);
    float* st1 = (float*)(ws + WS_ST1); float* st2 = (float*)(ws + WS_ST2); float* st3 = (float*)(ws + WS_ST3);
    const float* ln_g = args.in[16]; const float* ln_b = args.in[17];

#define RUN(k, ...) do { if constexpr (((REPMASK) >> (k)) & 1u) { if (IN(k)) { __VA_ARGS__ } xcd_barrier(bar); } if (IN(k)) { __VA_ARGS__ } SEAM(k); } while (0)
    RUN(PH_PRO, prologue_phase(lds, args););
    RUN(PH_PROJ,
        g8::Gemm g{RB, (const bf16_t*)(ws + WS_WIN), D, nullptr, nullptr, nullptr}; g8::DenseOrder S; S.init(NPAN, NPROJ / 256, D, G, (int)blockIdx.x);
        g8::EpiPlain E{RA, NPROJ};
        g8::gemm_phase<g8::EpiPlain, g8::DenseOrder, false>(lds, g, S, E); tail_jobs(lds, args, PH_PROJ););
    RUN(PH_MLSTM, if ((int)blockIdx.x < 256) mlstm_phase(lds, RA, (const float*)(ws + WS_GATES), args.in[4], RD, (int)blockIdx.x););
    RUN(PH_WOUT,
        g8::Gemm g{RD, (const bf16_t*)(ws + WS_WOUT), D, nullptr, nullptr, nullptr}; g8::DenseOrder S; S.init(NPAN, 4, D, G, (int)blockIdx.x);
        g8::EpiRes<0> E{RC, RB, st1, lds + LDS_META, nullptr, nullptr};
        g8::gemm_phase<g8::EpiRes<0>, g8::DenseOrder, false>(lds, g, S, E); tail_jobs(lds, args, PH_WOUT););
    RUN(PH_FIN1, finstats_phase(st1, (float*)(ws + WS_RS1), NROWS););
    RUN(PH_GU,
        g8::Gemm g{RC, (const bf16_t*)(ws + WS_WGU), D, nullptr, nullptr, ws + WS_RS1}; g8::DenseOrder S; S.init(NPAN, 2 * FFD / 256, D, G, (int)blockIdx.x);
        g8::EpiGlu<false> E{RA, FFD, st1, vec + VEC_GU_CS, vec + VEC_GU_BW, lds + LDS_META, 0};
        g8::gemm_phase<g8::EpiGlu<false>, g8::DenseOrder, false, 3>(lds, g, S, E); tail_jobs(lds, args, PH_GU););
    RUN(PH_DN,
        g8::Gemm g{RA, (const bf16_t*)(ws + WS_WDN), FFD, nullptr, nullptr, ws + WS_RS1}; g8::DenseOrder S; S.init(NPAN, 4, FFD, G, (int)blockIdx.x);
        g8::EpiRes<1> E{RB, RC, st2, lds + LDS_META, ln_g, ln_b};
        g8::gemm_phase<g8::EpiRes<1>, g8::DenseOrder, false, 3>(lds, g, S, E); tail_jobs(lds, args, PH_DN););
    RUN(PH_FIN2, finstats_phase(st2, (float*)(ws + WS_RS2), NROWS););
    RUN(PH_KVQ,
        g8::Gemm g{RB, (const bf16_t*)(ws + WS_WKVQ), D, nullptr, nullptr, ws + WS_RS2}; g8::DenseOrder S; S.init(NPAN, NPROJ / 256, D, G, (int)blockIdx.x);
        g8::EpiFold E{RA, NPROJ, lds + LDS_META, vec + VEC_KVQ_CS, vec + VEC_KVQ_BW};
        g8::gemm_phase<g8::EpiFold, g8::DenseOrder, false, 3>(lds, g, S, E););
    RUN(PH_ATT, attn_phase(lds, RA, RD););
    RUN(PH_WO,
        g8::Gemm g{RD, (const bf16_t*)(ws + WS_WO), D, nullptr, nullptr, ws + WS_RS2}; g8::DenseOrder S; S.init(NR / 256, 4, D, G, (int)blockIdx.x);
        g8::EpiRes<1> E{RC, RB, st3, lds + LDS_META, ln_g + 1024, ln_b + 1024};
        g8::gemm_phase<g8::EpiRes<1>, g8::DenseOrder, false, 3>(lds, g, S, E););
    RUN(PH_RT1, router1_phase(lds, args););
    RUN(PH_RT2, router2_phase(lds, args););
#define MOE_CHUNK(cidx) \
    RUN(PH_MOE0 + 2 * (cidx), const int* hdr = (const int*)(ws + WS_HDR); const int npan = hdr[8]; const int p0 = (cidx) * MOE_CHUNK_PAN; \
        { g8::MoeOrder S; S.p0 = p0; S.np = ((cidx) == MOE_NCHUNK - 1) ? (npan - p0) : MOE_CHUNK_PAN; S.nfull = S.np; S.nsplit = 1; S.nN = 2 * FFE / 256; S.G = G; S.c = (int)blockIdx.x; S.K = D; S.estride = (unsigned)(2 * FFE * D * 2); \
            _Pragma("unroll") for (int e = 0; e < NE; ++e) S.pend[e] = hdr[e]; \
            g8::Gemm g{RC, (const bf16_t*)(ws + WS_WEGU), D, (const int*)(ws + WS_TOK), ws + WS_TOK, ws + WS_GATEB}; \
            g8::EpiGlu<true> E{RA, FFE, st3, vec + VEC_EGU_CS, vec + VEC_EGU_BW, lds + LDS_META, 2 * FFE}; \
            g8::gemm_phase<g8::EpiGlu<true>, g8::MoeOrder, true, 1>(lds, g, S, E); }); \
    RUN(PH_MOE0 + 2 * (cidx) + 1, const int* hdr = (const int*)(ws + WS_HDR); const int npan = hdr[8]; const int p0 = (cidx) * MOE_CHUNK_PAN; \
        { g8::MoeOrder S; S.p0 = p0; S.np = ((cidx) == MOE_NCHUNK - 1) ? (npan - p0) : MOE_CHUNK_PAN; S.nfull = MOE_CHUNK_PAN; S.nsplit = MOE_KSPLIT; S.nN = 4; S.G = G; S.c = (int)blockIdx.x; S.K = FFE; S.estride = (unsigned)(D * FFE * 2); \
            _Pragma("unroll") for (int e = 0; e < NE; ++e) S.pend[e] = hdr[e]; \
            g8::Gemm g{RA, (const bf16_t*)(ws + WS_WEDN), FFE, nullptr, ws + WS_TOK, nullptr}; \
            g8::EpiMoeDown E{RB, RD, lds + LDS_META, (float*)((unsigned char*)RA + RA_POFF), MOE_CHUNK_PAN}; \
            g8::gemm_phase<g8::EpiMoeDown, g8::MoeOrder, false, 2>(lds, g, S, E); });
    MOE_CHUNK(0) MOE_CHUNK(1) MOE_CHUNK(2) MOE_CHUNK(3)
    RUN(PH_FIX, moefix_phase(args););
    RUN(PH_FINAL, final_phase(args););
    if (PROBE_CLK && blockIdx.x == 0 && threadIdx.x == 0) { const float kv = ((volatile float*)(ws + WS_DIAG))[0]; const long long t0 = wall_clock64(); const long long dl = (long long)(kv * 5000.0f); while (wall_clock64() - t0 < dl) __builtin_amdgcn_s_sleep(8); }
#undef RUN
#undef IN
#undef SEAM
}

extern "C" void kernel_launch(void* const* d_in, const int* in_sizes, int n_in, void* d_out, int out_size, void* d_ws, size_t ws_size, hipStream_t stream) {
    static int grid = 0;
    if (grid == 0) {
        if (n_in != 18 || out_size != NR * D || ws_size < WS_END) { fprintf(stderr, "kernel_launch: unexpected problem (n_in %d out %d ws %zu need %zu)\n", n_in, out_size, ws_size, (size_t)WS_END); grid = -1; return; }
        int dev = 0, cus = 0, per_cu = 0;
        if (hipGetDevice(&dev) != hipSuccess || hipDeviceGetAttribute(&cus, hipDeviceAttributeMultiprocessorCount, dev) != hipSuccess) { grid = -1; return; }
        if (hipFuncSetAttribute((const void*)yoco_fwd, hipFuncAttributeMaxDynamicSharedMemorySize, LDS_BYTES) != hipSuccess) { fprintf(stderr, "kernel_launch: hipFuncSetAttribute failed\n"); grid = -1; return; }
        if (hipOccupancyMaxActiveBlocksPerMultiprocessor(&per_cu, (const void*)yoco_fwd, NTHREADS, LDS_BYTES) != hipSuccess || per_cu < 1) { fprintf(stderr, "kernel_launch: occupancy query says %d\n", per_cu); }
        (void)hipGetLastError();
        if (cus < 256) { fprintf(stderr, "kernel_launch: needs 256 CUs\n"); grid = -1; return; }
        grid = 256;
    }
    if (grid < 0) return;
    (void)hipMemsetAsync((char*)d_ws + WS_CTL, 0, CTL_BYTES, stream);
    Args a{};
    for (int i = 0; i < 18; ++i) a.in[i] = (const float*)d_in[i];
    a.out = (float*)d_out; a.ws = (unsigned char*)d_ws;
#if N_LAUNCH_MODE == 1
    for (int p = 0; p < PH_COUNT; ++p) { a.ph_lo = p; a.ph_hi = p + 1; hipLaunchKernelGGL(yoco_fwd, dim3(grid), dim3(NTHREADS), LDS_BYTES, stream, a); }
#else
    a.ph_lo = 0; a.ph_hi = PH_COUNT;
    hipLaunchKernelGGL(yoco_fwd, dim3(grid), dim3(NTHREADS), LDS_BYTES, stream, a);
#endif
}
```

```cpp
#include <hip/hip_runtime.h>
#include <cstdio>
#include <cstdint>

#ifndef N_LAUNCH_MODE
#define N_LAUNCH_MODE 0
#endif
#ifndef PROBE_CLK
#define PROBE_CLK 0
#endif
#ifndef REPMASK
#define REPMASK 0u
#endif

#define LAS __attribute__((address_space(3)))
typedef unsigned short bf16_t;
typedef short bf16x8 __attribute__((ext_vector_type(8)));
typedef float f32x2 __attribute__((ext_vector_type(2)));
typedef float f32x4 __attribute__((ext_vector_type(4)));
typedef float f32x16 __attribute__((ext_vector_type(16)));
typedef unsigned u32x2 __attribute__((ext_vector_type(2)));
typedef unsigned u32x4 __attribute__((ext_vector_type(4)));
typedef __bf16 bf16x2_t __attribute__((ext_vector_type(2)));

constexpr int D = 1024, NB = 16, SEQ = 4096, NMETA = 16;
constexpr int NR = NB * SEQ;
constexpr int NROWS = NR + NB * NMETA;
constexpr int NPAN = NROWS / 256;
constexpr int NPROJ = 3072;
constexpr int FFD = 2816, NE = 8, FFE = 3584;
constexpr float ALPHA = 1.41421356237f, LN_EPS = 1e-5f;
constexpr int NTHREADS = 512;
constexpr int MOE_ROWS = 2 * NR + NE * 256;
constexpr int MOE_CHUNK_PAN = 128;
constexpr int MOE_NCHUNK = 4;
constexpr int MOE_KSPLIT = 7;
constexpr size_t RA_POFF = (size_t)256 << 20;

constexpr size_t al256(size_t x) { return (x + 255) & ~(size_t)255; }
constexpr size_t WS_CTL = 0;
constexpr size_t CTL_BYTES = 65536;
constexpr size_t WS_WIN = WS_CTL + CTL_BYTES;
constexpr size_t WS_WOUT = WS_WIN + (size_t)NPROJ * D * 2;
constexpr size_t WS_WGU = WS_WOUT + (size_t)D * D * 2;
constexpr size_t WS_WDN = WS_WGU + (size_t)2 * FFD * D * 2;
constexpr size_t WS_WKVQ = WS_WDN + (size_t)D * FFD * 2;
constexpr size_t WS_WO = WS_WKVQ + (size_t)NPROJ * D * 2;
constexpr size_t WS_WEGU = WS_WO + (size_t)D * D * 2;
constexpr size_t WS_WEDN = WS_WEGU + (size_t)NE * 2 * FFE * D * 2;
constexpr size_t WS_VEC = WS_WEDN + (size_t)NE * D * FFE * 2;
constexpr int VEC_GU_CS = 0, VEC_GU_BW = 2 * FFD, VEC_KVQ_CS = 4 * FFD, VEC_KVQ_BW = VEC_KVQ_CS + NPROJ, VEC_EGU_CS = VEC_KVQ_BW + NPROJ, VEC_EGU_BW = VEC_EGU_CS + NE * 2 * FFE, VEC_END = VEC_EGU_BW + NE * 2 * FFE;
constexpr size_t WS_GATES = al256(WS_VEC + (size_t)VEC_END * 4);
constexpr size_t WS_ST1 = al256(WS_GATES + (size_t)NROWS * 8 * 4);
constexpr size_t WS_ST2 = WS_ST1 + (size_t)NROWS * 16 * 8;
constexpr size_t WS_ST3 = WS_ST2 + (size_t)NROWS * 16 * 8;
constexpr size_t WS_ROUTE = WS_ST3 + (size_t)NROWS * 16 * 8;
constexpr size_t WS_CNT = WS_ROUTE + (size_t)NR * 16;
constexpr size_t WS_HDR = WS_CNT + 256 * 8 * 4;
constexpr size_t WS_TOK = WS_HDR + 256;
constexpr size_t WS_GATEB = al256(WS_TOK + (size_t)MOE_ROWS * 8);
constexpr size_t WS_TOKST = al256(WS_GATEB + (size_t)MOE_ROWS * 8);
constexpr size_t WS_RS1 = al256(WS_TOKST + (size_t)NR * 8);
constexpr size_t WS_RS2 = al256(WS_RS1 + (size_t)NROWS * 8);
constexpr size_t WS_DIAG = al256(WS_RS2 + (size_t)NROWS * 8);
constexpr size_t WS_RA = al256(WS_DIAG + 4096);
constexpr size_t RA_BYTES = (size_t)NROWS * NPROJ * 2;
constexpr size_t WS_RB = al256(WS_RA + RA_BYTES);
constexpr size_t RX_BYTES = (size_t)NROWS * D * 2;
constexpr size_t WS_RC = al256(WS_RB + RX_BYTES);
constexpr size_t WS_RD = al256(WS_RC + RX_BYTES);
constexpr size_t WS_END = al256(WS_RD + RX_BYTES);

constexpr int LDS_MAIN = 131072, LDS_META = LDS_MAIN + 256  , LDS_BYTES = LDS_META + 8192;
__device__ __forceinline__ float bf2f(bf16_t v) { return __uint_as_float(((unsigned)v) << 16); }
__device__ __forceinline__ float bflo(unsigned u) { return __uint_as_float(u << 16); }
__device__ __forceinline__ float bfhi(unsigned u) { return __uint_as_float(u & 0xffff0000u); }
__device__ __forceinline__ unsigned pk2(float lo, float hi) { f32x2 v = {lo, hi}; bf16x2_t b = __builtin_convertvector(v, bf16x2_t); return __builtin_bit_cast(unsigned, b); }
__device__ __forceinline__ bf16_t f2bf(float f) { return (bf16_t)(pk2(f, 0.f) & 0xffffu); }
__device__ __forceinline__ float rbf(float f) { return bflo(pk2(f, 0.f)); }
__device__ __forceinline__ float wave_sum(float v) {
#pragma unroll
    for (int o = 32; o >= 1; o >>= 1) v += __shfl_xor(v, o);
    return v;
}
__device__ __forceinline__ float swap32_hi(float x, float& lo) {
    const u32x2 r = __builtin_amdgcn_permlane32_swap(__float_as_uint(x), __float_as_uint(x), false, false); lo = __uint_as_float(r.x); return __uint_as_float(r.y); }
__device__ __forceinline__ float fq_sum(float x) {
    const u32x2 a = __builtin_amdgcn_permlane16_swap(__float_as_uint(x), __float_as_uint(x), false, false); const float y = __uint_as_float(a.x) + __uint_as_float(a.y);
    const u32x2 b = __builtin_amdgcn_permlane32_swap(__float_as_uint(y), __float_as_uint(y), false, false); return __uint_as_float(b.x) + __uint_as_float(b.y); }
__device__ __forceinline__ float sigmoidf_(float x) { return __builtin_amdgcn_rcpf(1.0f + __builtin_amdgcn_exp2f(x * -1.4426950408889634f)); }

#define XB_TMO      128
#define XB_XCNT(j)  (256  + 64 * (j))
#define XB_XSUB(j)  (1280 + 64 * (j))
#define XB_XGEN(j)  (2304 + 64 * (j))
#define XB_TOP      3328
#define XB_TOPGEN   3392
#define XCD_BAR_WORDS 3456
#define XB_SPIN_CAP (1u << 20)
__device__ __forceinline__ unsigned xb_ld(unsigned* p)              { return __hip_atomic_load(p, __ATOMIC_RELAXED, __HIP_MEMORY_SCOPE_AGENT); }
__device__ __forceinline__ unsigned xb_add(unsigned* p, unsigned v) { return __hip_atomic_fetch_add(p, v, __ATOMIC_RELAXED, __HIP_MEMORY_SCOPE_AGENT); }
__device__ __forceinline__ unsigned xb_xcc_id() { return (unsigned)__builtin_amdgcn_s_getreg((3 << 11) | 20) & 0xFu; }
#define XB_SPIN(cond, bar) do { unsigned _sp = 0; while (cond) { __builtin_amdgcn_s_sleep(1); \
    if ((++_sp & 255u) == 0u) { if (xb_ld(&(bar)[XB_TMO])) break; if (_sp > XB_SPIN_CAP) { atomicAdd(&(bar)[XB_TMO], 1u); break; } } } } while (0)
struct XcdBarrier { unsigned* bar; unsigned x; volatile LAS unsigned* st; };
__device__ __forceinline__ XcdBarrier xcd_barrier_post(unsigned* bar, volatile LAS unsigned* st) {
    XcdBarrier b; b.bar = bar; b.x = xb_xcc_id(); b.st = st;
    if (threadIdx.x == 0) (void)xb_add(&bar[XB_XCNT(b.x)], 1u);
    return b;
}
__device__ __forceinline__ void xcd_barrier_complete(unsigned* bar, unsigned x, unsigned& nloc, unsigned& nx) {
    const unsigned G = gridDim.x * gridDim.y * gridDim.z;
    unsigned sum, cnt, mine, sp = 0u;
    for (;;) {
        sum = 0u; cnt = 0u; mine = 0u;
#pragma unroll
        for (unsigned j = 0; j < 16; ++j) { const unsigned c = xb_ld(&bar[XB_XCNT(j)]); sum += c; cnt += (c > 0u) ? 1u : 0u; mine = (j == x) ? c : mine; }
        if (sum == G) break;
        __builtin_amdgcn_s_sleep(1);
        if ((++sp & 255u) == 0u) { if (xb_ld(&bar[XB_TMO])) break; if (sp > XB_SPIN_CAP) { atomicAdd(&bar[XB_TMO], 1u); break; } }
    }
    nloc = mine > 0u ? mine : 1u; nx = cnt > 0u ? cnt : 1u;
}
__device__ __forceinline__ void xcd_barrier(const XcdBarrier& b) {
    asm volatile("s_waitcnt vmcnt(0)" ::: "memory");
    __syncthreads();
    if (threadIdx.x == 0) {
        unsigned* bar = b.bar;
        __builtin_amdgcn_s_waitcnt(0);
        unsigned nloc = b.st[0], nx = b.st[1];
        if (nloc == 0u) { xcd_barrier_complete(bar, b.x, nloc, nx); b.st[0] = nloc; b.st[1] = nx; }
        const unsigned old = xb_add(&bar[XB_XSUB(b.x)], 1u);
        const unsigned gen = old / nloc;
        if (old + 1u == (gen + 1u) * nloc) {
            __builtin_amdgcn_fence(__ATOMIC_RELEASE, "agent");
            asm volatile("s_waitcnt vmcnt(0)" ::: "memory");
            const unsigned og = xb_add(&bar[XB_TOP], 1u);
            const unsigned tg = og / nx;
            if (og + 1u == (tg + 1u) * nx) xb_add(&bar[XB_TOPGEN], 1u);
            else XB_SPIN(xb_ld(&bar[XB_TOPGEN]) == tg, bar);
            __builtin_amdgcn_fence(__ATOMIC_ACQUIRE, "agent");
            xb_add(&bar[XB_XGEN(b.x)], 1u);
            asm volatile("s_waitcnt vmcnt(0)" ::: "memory");
        } else {
            XB_SPIN(xb_ld(&bar[XB_XGEN(b.x)]) == gen, bar);
            __builtin_amdgcn_fence(__ATOMIC_ACQUIRE, "agent");
            asm volatile("s_waitcnt vmcnt(0)" ::: "memory");
        }
    }
    __syncthreads();
}

namespace g8 {
constexpr int BM = 256, BK = 64, HALF = 128, HTB = HALF * BK * 2, STAGE_BYTES = 8 * HTB, NXCD = 8, WGM = 8;
__host__ __device__ __forceinline__ int lds_byte(int r, int c) { const int st = (r >> 4) * 2 + (c >> 5), rr = r & 15, cc = c & 31, ob = rr * 64 + cc * 2; return st * 1024 + (ob ^ (((ob >> 9) & 1) << 5)); }
__host__ __device__ __forceinline__ void stage_rc(int b, int& R, int& C) { const int st = b / 1024, sb = b % 1024, swz = sb ^ (((sb >> 9) & 1) << 5); R = (st >> 1) * 16 + swz / 64; C = (st & 1) * 32 + (swz % 64) / 2; }
__host__ __device__ __forceinline__ int perm32(int rho) { const int n = rho >> 4, i = rho & 15; return 8 * (i >> 2) + 4 * n + (i & 3); }

struct Unit { int pm, pn, gp; unsigned boff; int aux; int kt; unsigned koff; int ks; };
struct Gemm { const bf16_t* A; const bf16_t* Bt; int K; const int* rowtab; const unsigned char* smeta; const unsigned char* sstat; };

struct DenseOrder {
    int nM, nN, nwg, G, c, K;
    __device__ void init(int nM_, int nN_, int K_, int G_, int c_) { nM = nM_; nN = nN_; nwg = nM * nN; G = G_; c = c_; K = K_; }
    __device__ bool next(int i, Unit& u) const {
        const long L = (long)i * G + c; if (L >= nwg) return false;
        int wgid = (int)L; { const int q = nwg / NXCD, r = nwg % NXCD, xcd = wgid % NXCD, off = wgid / NXCD; wgid = (xcd < r ? xcd * (q + 1) : r * (q + 1) + (xcd - r) * q) + off; }
        const int nig = WGM * nN, gid = wgid / nig, fm = gid * WGM, gsz = (nM - fm) < WGM ? (nM - fm) : WGM;
        u.pm = fm + ((wgid % nig) % gsz); u.pn = (wgid % nig) / gsz; u.gp = u.pm; u.boff = (unsigned)u.pn * (unsigned)(256 * K * 2); u.kt = K / BK; u.koff = 0u; u.ks = -1; return true;
    }
};
struct MoeOrder {
    int p0, np, nN, G, c, K; unsigned estride; int pend[NE]; int nfull, nsplit;
    __device__ bool next(int i, Unit& u) const {
        const long L = (long)i * G + c; const long nmain = (long)nfull * nN;
        int pn, pml, ks = -1;
        if (L < nmain) { pn = (int)(L / nfull); pml = (int)(L % nfull); }
        else { const long r = L - nmain; if (r >= (long)(np - nfull) * nN * nsplit) return false;
            ks = (int)(r % nsplit); const int q = (int)(r / nsplit); pn = q % nN; pml = nfull + q / nN; if (nsplit == 1) ks = -1; }
        const int gp = p0 + pml;
        int e = 0;
#pragma unroll
        for (int j = 0; j < NE - 1; ++j) e += (gp >= pend[j]) ? 1 : 0;
        const int ktall = K / BK;
        u.pm = pml; u.pn = pn; u.gp = gp; u.ks = ks; u.kt = ks < 0 ? ktall : ktall / nsplit; u.koff = ks < 0 ? 0u : (unsigned)(ks * (K / nsplit) * 2);
        u.boff = (unsigned)e * estride + (unsigned)pn * (unsigned)(256 * K * 2) + u.koff; return true;
    }
};

template <class Epi, class Sched, bool GATHER, int META = 0>
__device__ __forceinline__ void gemm_phase(LAS unsigned char* lds, const Gemm g, const Sched& S, const Epi& E) {
    const int tid = threadIdx.x, wid = __builtin_amdgcn_readfirstlane(tid >> 6), lane = tid & 63, wr = wid >> 2, wc = wid & 3, fr = lane & 15, fq = lane >> 4;
    const int K = g.K;
    int Rr[2], Cc[2]; unsigned voffA[2], voffB[2];
#pragma unroll
    for (int i = 0; i < 2; ++i) { stage_rc(tid * 16 + i * 8192, Rr[i], Cc[i]); const int Rb = (Rr[i] & ~31) + perm32(Rr[i] & 31);
        voffA[i] = (unsigned)(Rr[i] * K + Cc[i]) * 2u; voffB[i] = (unsigned)(Rb * K + Cc[i]) * 2u; }
    const size_t kstep = (size_t)(BK * 2);
    const size_t hstep = (size_t)HALF * K * 2;
    const size_t tstep = 2 * hstep;
    const unsigned ldsw = (unsigned)wid * 1024u;
    const int aoff = lds_byte(wr * 64 + fr, fq * 8), boff = lds_byte(wc * 32 + fr, fq * 8);
#define G8_SA(b, h) (((b) * 2 + (h)) * HTB)
#define G8_SB(b, h) ((4 + (b) * 2 + (h)) * HTB)
#define G8_STAGE(bufoff, gbase, voff) do { _Pragma("unroll") for (int _i = 0; _i < 2; ++_i) \
        __builtin_amdgcn_global_load_lds((const unsigned*)((const char*)(gbase) + (voff)[_i]), (LAS unsigned*)(lds + (bufoff) + ldsw + _i * 8192), 16, 0, 0); } while (0)
#define G8_STA(bufoff, ptr, offs, h) do { if constexpr (GATHER) { G8_STAGE(bufoff, (const char*)g.A, (offs)[h]); } else { G8_STAGE(bufoff, (ptr) + (h) * hstep, voffA); } } while (0)
#define G8_LDA(dst, b, h) do { _Pragma("unroll") for (int m = 0; m < 4; ++m) _Pragma("unroll") for (int k = 0; k < 2; ++k) dst[m][k] = *(const LAS bf16x8*)(lds + G8_SA(b, h) + aoff + m * 2048 + k * 1024); } while (0)
#define G8_LDB(dst, b, h) do { _Pragma("unroll") for (int n = 0; n < 2; ++n) _Pragma("unroll") for (int k = 0; k < 2; ++k) dst[n][k] = *(const LAS bf16x8*)(lds + G8_SB(b, h) + boff + n * 2048 + k * 1024); } while (0)
#define G8_MMA(ai, bj, At, Bt) do { __builtin_amdgcn_s_setprio(1); _Pragma("unroll") for (int m = 0; m < 4; ++m) _Pragma("unroll") for (int n = 0; n < 2; ++n) _Pragma("unroll") for (int k = 0; k < 2; ++k) \
        acc[ai][bj][m][n] = __builtin_amdgcn_mfma_f32_16x16x32_bf16(Bt[n][k], At[m][k], acc[ai][bj][m][n], 0, 0, 0); __builtin_amdgcn_s_setprio(0); } while (0)
#define G8_WAIT_V(n) asm volatile("s_waitcnt vmcnt(" #n ")" ::: "memory")
#define G8_WAIT_L(n) asm volatile("s_waitcnt lgkmcnt(" #n ")" ::: "memory")
#define G8_BAR __builtin_amdgcn_s_barrier()
#define G8_SCHED __builtin_amdgcn_sched_barrier(0)
#define G8_ROWOFFS(dst, U) do { _Pragma("unroll") for (int _h = 0; _h < 2; ++_h) _Pragma("unroll") for (int _i = 0; _i < 2; ++_i) { \
        const int _id = g.rowtab[2 * ((U).gp * 256 + _h * 128 + Rr[_i])]; const int _tk = _id < 0 ? 0 : (_id >> 1); dst[_h][_i] = (unsigned)(_tk * K + Cc[_i]) * 2u; } } while (0)
#define G8_META_DMA(gsrc, panel, bufidx) __builtin_amdgcn_global_load_lds((const unsigned*)((gsrc) + (size_t)(panel) * 2048 + wid * 256 + lane * 4), (LAS unsigned*)(lds + LDS_META + (bufidx) * 2048 + wid * 256), 4, 0, 0)
    Unit cur, nxt; int ui = 0;
    if (!S.next(0, cur)) return;
    f32x4 acc[2][2][4][2];
#pragma unroll
    for (int a = 0; a < 2; ++a)
#pragma unroll
        for (int b = 0; b < 2; ++b)
#pragma unroll
            for (int m = 0; m < 4; ++m)
#pragma unroll
                for (int n = 0; n < 2; ++n) acc[a][b][m][n] = (f32x4){0.f, 0.f, 0.f, 0.f};
    bf16x8 At[4][2], B0[2][2], B1[2][2];
    const char* cA = (const char*)g.A + (size_t)cur.pm * tstep + cur.koff; const char* cB = (const char*)g.Bt + cur.boff;
    unsigned oc[2][2], on[2][2], o1[2][2], o2[2][2], o3[2][2];
    if constexpr (GATHER) { G8_ROWOFFS(oc, cur);
#pragma unroll
        for (int h = 0; h < 2; ++h)
#pragma unroll
            for (int i = 0; i < 2; ++i) { o1[h][i] = oc[h][i] + 128u; on[h][i] = oc[h][i]; o2[h][i] = 0; o3[h][i] = 0; } }
    G8_STAGE(G8_SB(0, 0), cB, voffB); G8_STAGE(G8_SB(0, 1), cB + hstep, voffB); G8_STA(G8_SA(0, 0), cA, oc, 0); G8_STA(G8_SA(0, 1), cA, oc, 1);
    if (wr == 1) G8_BAR;
    G8_WAIT_V(2); G8_BAR;
    G8_STAGE(G8_SB(1, 0), cB + kstep, voffB); G8_STA(G8_SA(1, 0), cA + kstep, o1, 0); G8_STAGE(G8_SB(1, 1), cB + hstep + kstep, voffB);
    G8_WAIT_V(6); G8_BAR;
    for (;;) {
        const bool has_next = S.next(ui + 1, nxt);
        const char* nA = has_next ? (const char*)g.A + (size_t)nxt.pm * tstep + nxt.koff : cA; const char* nB = has_next ? (const char*)g.Bt + nxt.boff : cB;
        const int nt = cur.kt;
        if constexpr (META == 1) { if (has_next) G8_META_DMA(g.smeta, nxt.gp, (ui + 1) & 1); G8_META_DMA(g.sstat, cur.gp, 2 + (ui & 1)); }
        if constexpr (META == 2) { G8_META_DMA(g.smeta, cur.gp, ui & 1); }
        if constexpr (META == 3) { G8_META_DMA(g.sstat, cur.pm, 2 + (ui & 1)); }
        for (int t = 0; t < nt; t += 2) {
            const bool last = (t == nt - 2);
            const char* a1 = cA + (size_t)(t + 1) * kstep;
            const char* a2 = last ? nA : cA + (size_t)(t + 2) * kstep; const char* b2 = last ? nB : cB + (size_t)(t + 2) * kstep;
            const char* a3 = a2 + kstep; const char* b3 = b2 + kstep;
            if constexpr (GATHER) {
                if (last) {
#pragma unroll
                    for (int h = 0; h < 2; ++h)
#pragma unroll
                        for (int i = 0; i < 2; ++i) { int id = -1; if (has_next) id = *(const LAS int*)(lds + LDS_META + ((ui + 1) & 1) * 2048 + (h * 128 + Rr[i]) * 8);
                            const int tk = id < 0 ? 0 : (id >> 1); on[h][i] = has_next ? (unsigned)(tk * K + Cc[i]) * 2u : oc[h][i]; } }
#pragma unroll
                for (int h = 0; h < 2; ++h)
#pragma unroll
                    for (int i = 0; i < 2; ++i) { o1[h][i] = oc[h][i] + (unsigned)(t + 1) * 128u; o2[h][i] = last ? on[h][i] : oc[h][i] + (unsigned)(t + 2) * 128u; o3[h][i] = o2[h][i] + 128u; } }
            G8_LDB(B0, 0, 0); G8_LDB(B1, 0, 1); G8_SCHED; G8_LDA(At, 0, 0); G8_STA(G8_SA(1, 1), a1, o1, 1);
            G8_WAIT_V(8); G8_WAIT_L(0); G8_BAR; G8_MMA(0, 0, At, B0); G8_MMA(0, 1, At, B1); G8_BAR; G8_SCHED;
            G8_LDA(At, 0, 1); G8_STAGE(G8_SB(0, 0), b2, voffB); G8_STAGE(G8_SB(0, 1), b2 + hstep, voffB); G8_STA(G8_SA(0, 0), a2, o2, 0);
            G8_WAIT_V(8); G8_WAIT_L(0); G8_BAR; G8_MMA(1, 0, At, B0); G8_MMA(1, 1, At, B1); G8_BAR; G8_SCHED;
            G8_LDB(B0, 1, 0); G8_LDB(B1, 1, 1); G8_SCHED; G8_LDA(At, 1, 0); G8_STA(G8_SA(0, 1), a2, o2, 1);
            G8_WAIT_V(8); G8_WAIT_L(0); G8_BAR; G8_MMA(0, 0, At, B0); G8_MMA(0, 1, At, B1); G8_BAR; G8_SCHED;
            G8_LDA(At, 1, 1); G8_STAGE(G8_SB(1, 0), b3, voffB); G8_STAGE(G8_SB(1, 1), b3 + hstep, voffB); G8_STA(G8_SA(1, 0), a3, o3, 0);
            G8_WAIT_V(8); G8_WAIT_L(0); G8_BAR; G8_MMA(1, 0, At, B0); G8_MMA(1, 1, At, B1); G8_BAR; G8_SCHED;
        }
        if (wr == 0) G8_BAR;
        cur.aux = ui & 1;
        E(acc, cur, wr, wc, fr, fq);
        if (!has_next) break;
#pragma unroll
        for (int a = 0; a < 2; ++a)
#pragma unroll
            for (int b = 0; b < 2; ++b)
#pragma unroll
                for (int m = 0; m < 4; ++m)
#pragma unroll
                    for (int n = 0; n < 2; ++n) acc[a][b][m][n] = (f32x4){0.f, 0.f, 0.f, 0.f};
        cur = nxt; cA = nA; cB = nB; ++ui;
        if constexpr (GATHER) {
#pragma unroll
            for (int h = 0; h < 2; ++h)
#pragma unroll
                for (int i = 0; i < 2; ++i) oc[h][i] = on[h][i]; }
        if (wr == 1) G8_BAR;
    }
    G8_WAIT_V(0);
    G8_BAR;
#undef G8_SA
#undef G8_SB
#undef G8_STAGE
#undef G8_STA
#undef G8_LDA
#undef G8_LDB
#undef G8_MMA
#undef G8_WAIT_V
#undef G8_WAIT_L
#undef G8_BAR
#undef G8_SCHED
#undef G8_ROWOFFS
#undef G8_META_DMA
}

typedef f32x4 Acc[2][2][4][2];
__device__ __forceinline__ u32x4 pack8(const f32x4 a, const f32x4 b) { u32x4 w; w.x = pk2(a[0], a[1]); w.y = pk2(a[2], a[3]); w.z = pk2(b[0], b[1]); w.w = pk2(b[2], b[3]); return w; }
__device__ __forceinline__ void unpack8(const u32x4 w, float (&f)[8]) { f[0] = bflo(w.x); f[1] = bfhi(w.x); f[2] = bflo(w.y); f[3] = bfhi(w.y); f[4] = bflo(w.z); f[5] = bfhi(w.z); f[6] = bflo(w.w); f[7] = bfhi(w.w); }
__device__ __forceinline__ void row_stats(const float* st, int row, int fq, float& mu, float& rstd) {
    const f32x4* p = (const f32x4*)(st + (size_t)row * 32 + fq * 8);
    const f32x4 a = p[0], b = p[1];
    float s1 = (a[0] + a[2]) + (b[0] + b[2]), s2 = (a[1] + a[3]) + (b[1] + b[3]);
    s1 += __shfl_xor(s1, 16); s1 += __shfl_xor(s1, 32); s2 += __shfl_xor(s2, 16); s2 += __shfl_xor(s2, 32);
    mu = s1 * (1.0f / 1024.0f); const float var = fmaxf(s2 * (1.0f / 1024.0f) - mu * mu, 0.f); rstd = rsqrtf(var + LN_EPS);
}
__device__ __forceinline__ void put_stats(float* st, int row, int slot, int fq, float s1, float s2) {
    s1 = fq_sum(s1); s2 = fq_sum(s2);
    if (fq == 0) *(f32x2*)(st + (size_t)row * 32 + slot * 2) = (f32x2){s1, s2};
}

struct EpiPlain {
    bf16_t* O; int ldc;
    __device__ __forceinline__ void operator()(const Acc& acc, const Unit& u, int wr, int wc, int fr, int fq) const {
        const int row0 = u.pm * 256 + wr * 64 + fr, col0 = u.pn * 256 + wc * 32 + 8 * fq;
#pragma unroll
        for (int ai = 0; ai < 2; ++ai)
#pragma unroll
            for (int m = 0; m < 4; ++m) { bf16_t* rowp = O + (size_t)(row0 + ai * 128 + m * 16) * ldc + col0;
#pragma unroll
                for (int bj = 0; bj < 2; ++bj) *(u32x4*)(rowp + bj * 128) = pack8(acc[ai][bj][m][0], acc[ai][bj][m][1]); }
    }
};
template <int MODE> struct EpiRes {
    bf16_t* Z; const bf16_t* Rsrc; float* st_out; LAS unsigned char* ldsm; const float* g; const float* b;
    __device__ __forceinline__ void operator()(const Acc& acc, const Unit& u, int wr, int wc, int fr, int fq) const {
        const int r0 = wr * 64 + fr, col0 = u.pn * 256 + wc * 32 + 8 * fq;
        f32x4 gv[2][2], bv[2][2];
        if (MODE == 1) {
#pragma unroll
            for (int bj = 0; bj < 2; ++bj)
#pragma unroll
                for (int n = 0; n < 2; ++n) { gv[bj][n] = *(const f32x4*)(g + col0 + bj * 128 + 4 * n); bv[bj][n] = *(const f32x4*)(b + col0 + bj * 128 + 4 * n); }
        }
        u32x4 rwa[4][4][2];
#define EPR_LOAD(am_) do { _Pragma("unroll") for (int m = 2 * ((am_) & 1); m < 2 * ((am_) & 1) + 2; ++m) _Pragma("unroll") for (int bj = 0; bj < 2; ++bj) \
            rwa[am_][m][bj] = *(const u32x4*)(Rsrc + ((size_t)u.pm * 256 + r0 + ((am_) >> 1) * 128 + m * 16) * D + col0 + bj * 128); } while (0)
        EPR_LOAD(0);
#pragma unroll
        for (int am = 0; am < 4; ++am) { const int ai = am >> 1;
            if (am + 1 < 4) EPR_LOAD(am + 1);
            u32x4 (&rw)[4][2] = rwa[am];
#pragma unroll
            for (int m = 2 * (am & 1); m < 2 * (am & 1) + 2; ++m) {
                const int rl = r0 + ai * 128 + m * 16; const size_t row = (size_t)u.pm * 256 + rl;
                float mu = 0.f, rstd = 1.f;
                if (MODE == 1) { const f32x2 ms = *(const LAS f32x2*)(ldsm + (2 + u.aux) * 2048 + rl * 8); mu = ms[0]; rstd = ms[1]; }
                float s1 = 0.f, s2 = 0.f;
#pragma unroll
                for (int bj = 0; bj < 2; ++bj) {
                    float r[8]; unpack8(rw[m][bj], r);
                    f32x4 v0, v1;
#pragma unroll
                    for (int j = 0; j < 4; ++j) {
                        float h0 = r[j], h1 = r[4 + j];
                        if (MODE == 1) { h0 = (h0 - mu) * rstd * gv[bj][0][j] + bv[bj][0][j]; h1 = (h1 - mu) * rstd * gv[bj][1][j] + bv[bj][1][j]; }
                        v0[j] = ALPHA * h0 + acc[ai][bj][m][0][j]; v1[j] = ALPHA * h1 + acc[ai][bj][m][1][j];
                    }
                    const u32x4 w = pack8(v0, v1);
                    *(u32x4*)(Z + row * D + col0 + bj * 128) = w;
                    float q[8]; unpack8(w, q);
#pragma unroll
                    for (int j = 0; j < 8; ++j) { s1 += q[j]; s2 += q[j] * q[j]; }
                }
                put_stats(st_out, (int)row, u.pn * 4 + wc, fq, s1, s2);
            }
        }
    }
};
struct EpiFold {
    bf16_t* O; int ldc; LAS unsigned char* ldsm; const float* cs; const float* bw;
    __device__ __forceinline__ void operator()(const Acc& acc, const Unit& u, int wr, int wc, int fr, int fq) const {
        const int r0 = wr * 64 + fr, col0 = u.pn * 256 + wc * 32 + 8 * fq;
        f32x4 cv[2][2], bv[2][2];
#pragma unroll
        for (int bj = 0; bj < 2; ++bj)
#pragma unroll
            for (int n = 0; n < 2; ++n) { cv[bj][n] = *(const f32x4*)(cs + col0 + bj * 128 + 4 * n); bv[bj][n] = *(const f32x4*)(bw + col0 + bj * 128 + 4 * n); }
#pragma unroll
        for (int ai = 0; ai < 2; ++ai)
#pragma unroll
            for (int m = 0; m < 4; ++m) {
                const int rl = r0 + ai * 128 + m * 16; const size_t row = (size_t)u.pm * 256 + rl;
                const f32x2 ms = *(const LAS f32x2*)(ldsm + (2 + u.aux) * 2048 + rl * 8); const float mu = ms[0], rstd = ms[1];
#pragma unroll
                for (int bj = 0; bj < 2; ++bj) {
                    const f32x4 v0 = (acc[ai][bj][m][0] - mu * cv[bj][0]) * rstd + bv[bj][0], v1 = (acc[ai][bj][m][1] - mu * cv[bj][1]) * rstd + bv[bj][1];
                    *(u32x4*)(O + row * ldc + col0 + bj * 128) = pack8(v0, v1);
                }
            }
    }
};
template <bool MOE> struct EpiGlu {
    bf16_t* O; int ldc; const float* st_in; const float* cs; const float* bw; LAS unsigned char* ldsm; int ncs;
    __device__ __forceinline__ void operator()(const Acc& acc, const Unit& u, int wr, int wc, int fr, int fq) const {
        const int row0 = u.pm * 256 + wr * 64 + fr, colo = u.pn * 128 + wc * 32 + 8 * fq;
        int vb = u.pn * 256 + wc * 32 + 8 * fq;
        if (MOE) vb += (int)(u.boff / (unsigned)(256 * D * 2)) * 256 - u.pn * 256;
        f32x4 cv[2][2], bv[2][2];
#pragma unroll
        for (int bj = 0; bj < 2; ++bj)
#pragma unroll
            for (int n = 0; n < 2; ++n) { cv[bj][n] = *(const f32x4*)(cs + vb + bj * 128 + 4 * n); bv[bj][n] = *(const f32x4*)(bw + vb + bj * 128 + 4 * n); }
#pragma unroll
        for (int ai = 0; ai < 2; ++ai)
#pragma unroll
            for (int m = 0; m < 4; ++m) {
                const int row = row0 + ai * 128 + m * 16;
                const f32x2 ms = *(const LAS f32x2*)(ldsm + (2 + u.aux) * 2048 + (row - u.pm * 256) * 8); const float mu = ms[0], rstd = ms[1];
                f32x4 o0, o1;
#pragma unroll
                for (int j = 0; j < 4; ++j) {
                    const float g0 = (acc[ai][0][m][0][j] - mu * cv[0][0][j]) * rstd + bv[0][0][j], g1 = (acc[ai][0][m][1][j] - mu * cv[0][1][j]) * rstd + bv[0][1][j];
                    const float u0 = (acc[ai][1][m][0][j] - mu * cv[1][0][j]) * rstd + bv[1][0][j], u1 = (acc[ai][1][m][1][j] - mu * cv[1][1][j]) * rstd + bv[1][1][j];
                    o0[j] = g0 * sigmoidf_(g0) * u0; o1[j] = g1 * sigmoidf_(g1) * u1;
                }
                *(u32x4*)(O + (size_t)row * ldc + colo) = pack8(o0, o1);
            }
    }
};
struct EpiMoeDown {
    bf16_t* Y0; bf16_t* Y1; LAS unsigned char* ldsm; float* P; int nfull;
    __device__ __forceinline__ void operator()(const Acc& acc, const Unit& u, int wr, int wc, int fr, int fq) const {
        const int r0 = wr * 64 + fr, col0 = u.pn * 256 + wc * 32 + 8 * fq;
        if (u.ks >= 0) {
#pragma unroll
            for (int ai = 0; ai < 2; ++ai)
#pragma unroll
                for (int m = 0; m < 4; ++m) { float* rowp = P + ((size_t)u.ks * 2048 + (size_t)(u.pm - nfull) * 256 + r0 + ai * 128 + m * 16) * D + col0;
#pragma unroll
                    for (int bj = 0; bj < 2; ++bj) { *(f32x4*)(rowp + bj * 128) = acc[ai][bj][m][0]; *(f32x4*)(rowp + bj * 128 + 4) = acc[ai][bj][m][1]; } }
            return;
        }
#pragma unroll
        for (int ai = 0; ai < 2; ++ai)
#pragma unroll
            for (int m = 0; m < 4; ++m) {
                const u32x2 mg = *(const LAS u32x2*)(ldsm + u.aux * 2048 + (r0 + ai * 128 + m * 16) * 8);
                const int id = (int)mg.x; const float gt = __uint_as_float(mg.y);
                if (id >= 0) { bf16_t* rowp = Y0 + (size_t)(id & 1) * (size_t)(Y1 - Y0) + (size_t)(id >> 1) * D + col0;
#pragma unroll
                    for (int bj = 0; bj < 2; ++bj) *(u32x4*)(rowp + bj * 128) = pack8(acc[ai][bj][m][0] * gt, acc[ai][bj][m][1] * gt); }
            }
    }
};
}

struct Args { const float* in[18]; float* out; unsigned char* ws; int ph_lo, ph_hi; };
enum { PH_PRO = 0, PH_PROJ, PH_MLSTM, PH_WOUT, PH_FIN1, PH_GU, PH_DN, PH_FIN2, PH_KVQ, PH_ATT, PH_WO, PH_RT1, PH_RT2, PH_MOE0, PH_FIX = PH_MOE0 + 2 * MOE_NCHUNK, PH_FINAL, PH_COUNT };

__device__ __forceinline__ float logsigmoid_(float x) { return fminf(x, 0.f) - log1pf(expf(-fabsf(x))); }
__device__ __forceinline__ void conv_block(LAS unsigned char* lds, const float* src, int ldw, int K, bf16_t* dst, const float* g, const float* bb, float* cs, float* bw) {
    const int tid = threadIdx.x;
    const int n4 = (tid & 15) * 4, k4 = (tid >> 4) * 4;
    const int rn = tid >> 3, rs = tid & 7;
    float csp[4] = {0.f, 0.f, 0.f, 0.f}, bwp[4] = {0.f, 0.f, 0.f, 0.f};
    const int nch = K / 128;
    LAS float* gs = (LAS float*)(lds + 2 * 64 * 264 + 16384);
    if (g) { for (int i = tid; i < K; i += NTHREADS) { gs[i] = g[i]; gs[K + i] = bb[i]; } __syncthreads(); }
    f32x4 v[4], vn[4];
#pragma unroll
    for (int kk = 0; kk < 4; ++kk) v[kk] = *(const f32x4*)(src + (size_t)(k4 + kk) * ldw + n4);
    for (int ch = 0; ch < nch; ++ch) {
        LAS unsigned char* T = lds + (ch & 1) * (64 * 264);
        if (ch + 1 < nch) {
#pragma unroll
            for (int kk = 0; kk < 4; ++kk) vn[kk] = *(const f32x4*)(src + (size_t)((ch + 1) * 128 + k4 + kk) * ldw + n4); }
        float gk[4] = {1.f, 1.f, 1.f, 1.f}, bk[4] = {0.f, 0.f, 0.f, 0.f};
        if (g) {
#pragma unroll
            for (int kk = 0; kk < 4; ++kk) { gk[kk] = gs[ch * 128 + k4 + kk]; bk[kk] = gs[K + ch * 128 + k4 + kk]; } }
#pragma unroll
        for (int j = 0; j < 4; ++j) {
            const unsigned lo = pk2(v[0][j] * gk[0], v[1][j] * gk[1]), hi = pk2(v[2][j] * gk[2], v[3][j] * gk[3]);
            *(LAS u32x2*)(T + (n4 + j) * 264 + k4 * 2) = (u32x2){lo, hi};
            csp[j] += (bflo(lo) + bfhi(lo)) + (bflo(hi) + bfhi(hi));
            bwp[j] += (v[0][j] * bk[0] + v[1][j] * bk[1]) + (v[2][j] * bk[2] + v[3][j] * bk[3]);
        }
        __syncthreads();
        u32x2 q[4];
#pragma unroll
        for (int i = 0; i < 4; ++i) q[i] = *(const LAS u32x2*)(T + rn * 264 + rs * 32 + i * 8);
        bf16_t* dp = dst + (size_t)rn * K + ch * 128 + rs * 16;
        *(u32x4*)dp = (u32x4){q[0].x, q[0].y, q[1].x, q[1].y};
        *(u32x4*)(dp + 8) = (u32x4){q[2].x, q[2].y, q[3].x, q[3].y};
#pragma unroll
        for (int kk = 0; kk < 4; ++kk) v[kk] = vn[kk];
    }
    __syncthreads();
    if (cs) {
        LAS float* red = (LAS float*)(lds + 2 * 64 * 264);
#pragma unroll
        for (int j = 0; j < 4; ++j) { red[(tid >> 4) * 64 + n4 + j] = csp[j]; red[2048 + (tid >> 4) * 64 + n4 + j] = bwp[j]; }
        __syncthreads();
        if (tid < 128) { const int n = tid & 63, w = tid >> 6; float s = 0.f;
            for (int i = 0; i < 32; ++i) s += red[w * 2048 + i * 64 + n];
            (w ? bw : cs)[n] = s; }
        __syncthreads();
    }
}
__device__ __forceinline__ void conv_job(LAS unsigned char* lds, const Args& a, int blk) {
    unsigned char* ws = a.ws;
    const float* ln_g = a.in[16]; const float* ln_b = a.in[17];
    float* vec = (float*)(ws + WS_VEC);
    const float* src; int ldw, K; bf16_t* dst; const float* g = nullptr; const float* bb = nullptr; float* cs = nullptr; float* bw = nullptr;
    int j = blk;
    if (j < 128) { const int e = j >> 4, jj = j & 15; src = a.in[15] + (size_t)e * FFE * D + 64 * jj; ldw = D; K = FFE; dst = (bf16_t*)(ws + WS_WEDN) + ((size_t)e * D + 64 * jj) * FFE; }
    else if (j < 144) { j -= 128; src = a.in[11] + 64 * j; ldw = D; K = FFD; dst = (bf16_t*)(ws + WS_WDN) + (size_t)(64 * j) * FFD; }
    else if (j < 192) { j -= 144; src = a.in[2] + 64 * j; ldw = 3080; K = D; dst = (bf16_t*)(ws + WS_WIN) + (size_t)(64 * j) * D; }
    else if (j < 208) { j -= 192; src = a.in[5] + 64 * j; ldw = D; K = D; dst = (bf16_t*)(ws + WS_WOUT) + (size_t)(64 * j) * D; }
    else if (j < 296) { j -= 208; const int t = j >> 2, q = j & 3; src = (q < 2 ? a.in[9] : a.in[10]) + 128 * t + 64 * (q & 1); ldw = FFD; K = D; dst = (bf16_t*)(ws + WS_WGU) + (size_t)(64 * j) * D;
        g = ln_g; bb = ln_b; cs = vec + VEC_GU_CS + 64 * j; bw = vec + VEC_GU_BW + 64 * j; }
    else if (j < 344) { j -= 296; src = j < 32 ? a.in[6] + 64 * j : a.in[7] + 64 * (j - 32); ldw = j < 32 ? 2048 : 1024; K = D; dst = (bf16_t*)(ws + WS_WKVQ) + (size_t)(64 * j) * D;
        g = ln_g + 1024; bb = ln_b + 1024; cs = vec + VEC_KVQ_CS + 64 * j; bw = vec + VEC_KVQ_BW + 64 * j; }
    else if (j < 360) { j -= 344; src = a.in[8] + 64 * j; ldw = D; K = D; dst = (bf16_t*)(ws + WS_WO) + (size_t)(64 * j) * D; }
    else { j -= 360; const int e = j / 112, jj = j % 112, t = jj >> 2, q = jj & 3; src = (q < 2 ? a.in[13] : a.in[14]) + (size_t)e * D * FFE + 128 * t + 64 * (q & 1); ldw = FFE; K = D;
        dst = (bf16_t*)(ws + WS_WEGU) + ((size_t)e * 2 * FFE + 64 * jj) * D; g = ln_g + 2048; bb = ln_b + 2048; cs = vec + VEC_EGU_CS + e * 2 * FFE + 64 * jj; bw = vec + VEC_EGU_BW + e * 2 * FFE + 64 * jj; }
    conv_block(lds, src, ldw, K, dst, g, bb, cs, bw);
}
constexpr int EGU0 = 360;
__device__ __forceinline__ void tail_jobs(LAS unsigned char* lds, const Args& a, int phase) {
    const int c = (int)blockIdx.x;
    int j0 = -1;
    if (phase == PH_PROJ) { const int q = c - 12;
        if (q >= 0) j0 = q < 16 ? 128 + q : (q < 184 ? 192 + (q - 16) : EGU0 + (q - 184)); }
    else if (phase == PH_WOUT) { const int q = c - 4; if (q >= 0) j0 = EGU0 + 60 + q; }
    else if (phase == PH_GU) { const int q = c - 22; if (q >= 0) j0 = EGU0 + 312 + q; }
    else if (phase == PH_DN) { const int q = c - 4;
        if (q >= 0 && q < 128) j0 = q;
        else if (q >= 128 && q - 128 < 106) j0 = EGU0 + 546 + (q - 128); }
    else { const int q = c - 12; if (q >= 0) j0 = EGU0 + 652 + q; }
    if (j0 >= 0) conv_job(lds, a, j0);
}
__device__ __forceinline__ void prologue_phase(LAS unsigned char* lds, const Args& a) {
    unsigned char* ws = a.ws;
    const int G = gridDim.x;
    for (int blk = 144 + blockIdx.x; blk < 192; blk += G) conv_job(lds, a, blk);
    {
        const int tid = threadIdx.x, lane = tid & 63, wid = tid >> 6;
        LAS float* wg = (LAS float*)lds;
        __syncthreads();
        const float* w_in = a.in[2];
        for (int i = tid; i < 8192; i += NTHREADS) { const int k = i >> 3, e = i & 7; wg[e * 1024 + k] = w_in[(size_t)k * 3080 + 3072 + e]; }
        __syncthreads();
        bf16_t* H0 = (bf16_t*)(ws + WS_RB); float* gates = (float*)(ws + WS_GATES);
        const float bg = a.in[3][lane & 7];
        f32x4 xv[4], xn[4];
        { const int row = blockIdx.x * 8 + wid; const float* src = row < NR ? a.in[0] + (size_t)row * D : a.in[1] + (size_t)((row - NR) & 15) * D;
#pragma unroll
            for (int i = 0; i < 4; ++i) xv[i] = *(const f32x4*)(src + i * 256 + lane * 4); }
        for (int row = blockIdx.x * 8 + wid; row < NROWS; row += G * 8) {
            { const int rn = row + G * 8;
                if (rn < NROWS) { const float* srcn = rn < NR ? a.in[0] + (size_t)rn * D : a.in[1] + (size_t)((rn - NR) & 15) * D;
#pragma unroll
                    for (int i = 0; i < 4; ++i) xn[i] = *(const f32x4*)(srcn + i * 256 + lane * 4); } }
            float acc[8] = {0.f, 0.f, 0.f, 0.f, 0.f, 0.f, 0.f, 0.f};
#pragma unroll
            for (int i = 0; i < 4; ++i) {
                const int k = i * 256 + lane * 4;
                const f32x4 v = xv[i];
                *(u32x2*)(H0 + (size_t)row * D + k) = (u32x2){pk2(v[0], v[1]), pk2(v[2], v[3])};
#pragma unroll
                for (int e = 0; e < 8; ++e) { const f32x4 w = *(const LAS f32x4*)(wg + e * 1024 + k); acc[e] += (v[0] * w[0] + v[1] * w[1]) + (v[2] * w[2] + v[3] * w[3]); }
            }
#pragma unroll
            for (int i = 0; i < 4; ++i) xv[i] = xn[i];
#pragma unroll
            for (int e = 0; e < 8; ++e) acc[e] = wave_sum(acc[e]);
            float mine = acc[0];
#pragma unroll
            for (int e = 1; e < 8; ++e) mine = ((lane & 7) == e) ? acc[e] : mine;
            if (lane < 8) gates[(size_t)row * 8 + lane] = lane < 4 ? mine + bg : logsigmoid_(mine + bg);
        }
        __syncthreads();
    }
}

__device__ __forceinline__ bf16x8 pack_frag(const f32x16& x, int s) {
    u32x4 p; p.x = pk2(x[8 * s], x[8 * s + 1]); p.y = pk2(x[8 * s + 2], x[8 * s + 3]); p.z = pk2(x[8 * s + 4], x[8 * s + 5]); p.w = pk2(x[8 * s + 6], x[8 * s + 7]);
    return __builtin_bit_cast(bf16x8, p);
}
__device__ __forceinline__ bf16x8 ld2x64(const LAS unsigned char* p0, const LAS unsigned char* p1) {
    const u32x2 a = *(const LAS u32x2*)p0, b = *(const LAS u32x2*)p1; u32x4 r = {a.x, a.y, b.x, b.y}; return __builtin_bit_cast(bf16x8, r);
}
__device__ __forceinline__ void tr4x4(const u32x2 (&r)[4], u32x2 (&c)[4]) {
    c[0] = (u32x2){(r[0].x & 0xffffu) | (r[1].x << 16), (r[2].x & 0xffffu) | (r[3].x << 16)};
    c[1] = (u32x2){(r[0].x >> 16) | (r[1].x & 0xffff0000u), (r[2].x >> 16) | (r[3].x & 0xffff0000u)};
    c[2] = (u32x2){(r[0].y & 0xffffu) | (r[1].y << 16), (r[2].y & 0xffffu) | (r[3].y << 16)};
    c[3] = (u32x2){(r[0].y >> 16) | (r[1].y & 0xffff0000u), (r[2].y >> 16) | (r[3].y & 0xffff0000u)};
}

#define DPP_STEP_ADD(x, ctrl, rmask) x += __builtin_bit_cast(float, __builtin_amdgcn_update_dpp(0, __builtin_bit_cast(int, x), ctrl, rmask, 0xf, false))
#define DPP_STEP_MAX(x, ctrl, rmask) x = fmaxf(x, __builtin_bit_cast(float, __builtin_amdgcn_update_dpp((int)0xff800000, __builtin_bit_cast(int, x), ctrl, rmask, 0xf, false)))
__device__ __forceinline__ float scan_add64(float x) { DPP_STEP_ADD(x, 0x111, 0xf); DPP_STEP_ADD(x, 0x112, 0xf); DPP_STEP_ADD(x, 0x114, 0xf); DPP_STEP_ADD(x, 0x118, 0xf); DPP_STEP_ADD(x, 0x142, 0xa); DPP_STEP_ADD(x, 0x143, 0xc); return x; }
__device__ __forceinline__ float scan_max64(float x) { DPP_STEP_MAX(x, 0x111, 0xf); DPP_STEP_MAX(x, 0x112, 0xf); DPP_STEP_MAX(x, 0x114, 0xf); DPP_STEP_MAX(x, 0x118, 0xf); DPP_STEP_MAX(x, 0x142, 0xa); DPP_STEP_MAX(x, 0x143, 0xc); return x; }
__device__ __forceinline__ float wave_total(float x);
__device__ __forceinline__ float lane63(float x) { return __builtin_bit_cast(float, __builtin_amdgcn_readlane(__builtin_bit_cast(int, x), 63)); }
__device__ __forceinline__ float wave_total(float x) { return lane63(scan_add64(x)); }
constexpr int ML_QS = 0, ML_KS = 17408, ML_PS = 34816, ML_VT = 44032, ML_KT = 78848, ML_SC = 96256;
#ifndef ML_N0
#define ML_N0 23
#define ML_N1 18
#define ML_N2 14
#endif
__device__ __forceinline__ void mlstm_phase(LAS unsigned char* lds, const bf16_t* qkvo, const float* gates, const float* normg, bf16_t* hn, int unit_) {
    const int unit = unit_ >> 2, part_ = unit_ & 3;
    const int c_begin = part_ == 0 ? 0 : (part_ == 1 ? ML_N0 : (part_ == 2 ? ML_N0 + ML_N1 : ML_N0 + ML_N1 + ML_N2));
    const int c_end = part_ == 0 ? ML_N0 : (part_ == 1 ? ML_N0 + ML_N1 : (part_ == 2 ? ML_N0 + ML_N1 + ML_N2 : 65));
    const int tid = threadIdx.x, lane = tid & 63, wid = __builtin_amdgcn_readfirstlane(tid >> 6);
    const int b = unit >> 2, h = unit & 3;
    const int r32 = lane & 31, hh = lane >> 5, l15 = lane & 15, l4 = lane >> 4;
    LAS float* sc = (LAS float*)(lds + ML_SC);
    LAS float* Hs = (LAS float*)lds;
    const int q_row = tid >> 4, q_col = (tid & 15) * 8;
    const int k_dk = (16 * (wid & 1) + l15) * 4, k_s = (4 * (wid >> 1) + l4) * 4;
    const int v_dv = (16 * (wid & 3) + l15) * 4, v_s0 = (4 * (wid >> 2) + l4) * 4;
    f32x16 Cacc[4];
#pragma unroll
    for (int i = 0; i < 4; ++i)
#pragma unroll
        for (int j = 0; j < 16; ++j) Cacc[i][j] = 0.f;
    if (tid < 128) sc[192 + tid] = 0.f;
    float m_run = 0.f;
    u32x4 qreg[2]; u32x2 kreg[4], vreg[2][4]; float g_li = 0.f, g_lf = 0.f;
#define rowof(c, t) ((c) == 0 ? (NR + b * 16 + ((t) - 48)) : (b * SEQ + 64 * ((c) - 1) + (t)))
#define ML_PREFETCH(c) do { \
        if ((c) >= c_begin) _Pragma("unroll") for (int p = 0; p < 2; ++p) { const int t = q_row + 32 * p; const bool pad = ((c) == 0 && t < 48); \
            qreg[p] = pad ? (u32x4){0u, 0u, 0u, 0u} : *(const u32x4*)(qkvo + (size_t)rowof((c), t) * NPROJ + h * 128 + q_col); } \
        _Pragma("unroll") for (int kk = 0; kk < 4; ++kk) { const int t = k_s + kk; const bool pad = ((c) == 0 && t < 48); \
            kreg[kk] = pad ? (u32x2){0u, 0u} : *(const u32x2*)(qkvo + (size_t)rowof((c), t) * NPROJ + 512 + h * 128 + k_dk); } \
        _Pragma("unroll") for (int p = 0; p < 2; ++p) _Pragma("unroll") for (int kk = 0; kk < 4; ++kk) { const int t = v_s0 + 32 * p + kk; const bool pad = ((c) == 0 && t < 48); \
            vreg[p][kk] = pad ? (u32x2){0u, 0u} : *(const u32x2*)(qkvo + (size_t)rowof((c), t) * NPROJ + 1024 + h * 256 + v_dv); } \
        { const bool pad = ((c) == 0 && lane < 48); g_li = pad ? -1e30f : gates[(size_t)rowof((c), lane) * 8 + h]; g_lf = pad ? 0.f : gates[(size_t)rowof((c), lane) * 8 + 4 + h]; } } while (0)
    ML_PREFETCH(0);
    for (int c = 0; c < c_end; ++c) {
        const bool full = (c >= c_begin);
        const float li = g_li;
        const float lf = g_lf;
        const float bc = scan_add64(lf);
        const float av = li - bc;
        const float um = scan_max64(av);
        const float Mt = fmaxf(m_run, um);
        const float winter = __expf(m_run - Mt), bmt = bc + Mt;
        const float M63 = lane63(Mt), b63 = lane63(bc);
        const float wlast = __expf(av - M63), decay = __expf(m_run - M63);
        if (full) {
#pragma unroll
        for (int p = 0; p < 2; ++p) *(LAS u32x4*)(lds + ML_QS + (q_row + 32 * p) * 272 + q_col * 2) = qreg[p]; }
        {
            u32x2 kw[4];
#pragma unroll
            for (int kk = 0; kk < 4; ++kk) {
                if (full) *(LAS u32x2*)(lds + ML_KS + (k_s + kk) * 272 + k_dk * 2) = kreg[kk];
                const float w = __shfl(wlast, k_s + kk) * 0.08838834764831845f;
                kw[kk] = (u32x2){pk2(bflo(kreg[kk].x) * w, bfhi(kreg[kk].x) * w), pk2(bflo(kreg[kk].y) * w, bfhi(kreg[kk].y) * w)};
            }
            u32x2 kc[4]; tr4x4(kw, kc);
#pragma unroll
            for (int j = 0; j < 4; ++j) *(LAS u32x2*)(lds + ML_KT + (k_dk + j) * 136 + k_s * 2) = kc[j];
        }
#pragma unroll
        for (int p = 0; p < 2; ++p) { u32x2 vc[4]; tr4x4(vreg[p], vc);
#pragma unroll
            for (int j = 0; j < 4; ++j) *(LAS u32x2*)(lds + ML_VT + (v_dv + j) * 136 + (v_s0 + 32 * p) * 2) = vc[j]; }
        if (wid == 0) { sc[lane] = winter; sc[128 + lane] = bmt; }
        __syncthreads();
        if (c + 1 < c_end) ML_PREFETCH(c + 1);
        if (full) {
            const int ti = wid >> 1;
#pragma unroll
            for (int q = 0; q < 2; ++q) {
                const int si = 2 * (wid & 1) + q;
                f32x4 sa = {0.f, 0.f, 0.f, 0.f};
                if (si <= ti) {
#pragma unroll
                    for (int ks = 0; ks < 4; ++ks) {
                        const bf16x8 af = *(const LAS bf16x8*)(lds + ML_QS + (16 * ti + l15) * 272 + (32 * ks + 8 * l4) * 2);
                        const bf16x8 bfr = *(const LAS bf16x8*)(lds + ML_KS + (16 * si + l15) * 272 + (32 * ks + 8 * l4) * 2);
                        sa = __builtin_amdgcn_mfma_f32_16x16x32_bf16(af, bfr, sa, 0, 0, 0);
                    }
                }
                const int s = 16 * si + l15;
                const float a_s = __shfl(av, s);
#pragma unroll
                for (int r = 0; r < 4; ++r) {
                    const int t = 16 * ti + 4 * l4 + r;
                    const float Mtt = __shfl(Mt, t);
                    const float w = (s <= t) ? __expf(a_s - Mtt) : 0.f;
                    *(LAS bf16_t*)(lds + ML_PS + t * 144 + s * 2) = f2bf(sa[r] * 0.08838834764831845f * w);
                }
            }
        }
        bf16x8 vf[4];
#pragma unroll
        for (int ks = 0; ks < 4; ++ks) { const LAS unsigned char* p = lds + ML_VT + (32 * wid + r32) * 136 + (16 * ks + 8 * hh) * 2; vf[ks] = ld2x64(p, p + 8); }
        if (full) {
        __syncthreads();
        {
            const int t = tid >> 3, part = tid & 7;
            float qn = 0.f, ps = 0.f;
            const u32x4 q0 = *(const LAS u32x4*)(lds + ML_QS + t * 272 + part * 32), q1 = *(const LAS u32x4*)(lds + ML_QS + t * 272 + part * 32 + 16);
            float qv[16]; { float t8[8]; g8::unpack8(q0, t8);
#pragma unroll
                for (int j = 0; j < 8; ++j) qv[j] = t8[j]; g8::unpack8(q1, t8);
#pragma unroll
                for (int j = 0; j < 8; ++j) qv[8 + j] = t8[j]; }
#pragma unroll
            for (int j = 0; j < 16; ++j) qn += qv[j] * sc[192 + part * 16 + j];
            const u32x4 pw = *(const LAS u32x4*)(lds + ML_PS + t * 144 + part * 16);
            float pv[8]; g8::unpack8(pw, pv);
#pragma unroll
            for (int j = 0; j < 8; ++j) ps += pv[j];
            qn += __shfl_xor(qn, 1); qn += __shfl_xor(qn, 2); qn += __shfl_xor(qn, 4);
            ps += __shfl_xor(ps, 1); ps += __shfl_xor(ps, 2); ps += __shfl_xor(ps, 4);
            if (part == 0) { const float den = sc[t] * qn + ps; sc[64 + t] = __builtin_amdgcn_rcpf(fmaxf(fabsf(den), __expf(-sc[128 + t]))); }
        }
        f32x16 num[2];
#pragma unroll
        for (int tt = 0; tt < 2; ++tt) {
#pragma unroll
            for (int j = 0; j < 16; ++j) num[tt][j] = 0.f;
#pragma unroll
            for (int dkt = 0; dkt < 4; ++dkt)
#pragma unroll
                for (int s2 = 0; s2 < 2; ++s2) {
                    const LAS unsigned char* p = lds + ML_QS + (32 * tt + r32) * 272 + (32 * dkt + 16 * s2 + 4 * hh) * 2;
                    const bf16x8 af = ld2x64(p, p + 16);
                    num[tt] = __builtin_amdgcn_mfma_f32_32x32x16_bf16(af, pack_frag(Cacc[dkt], s2), num[tt], 0, 0, 0);
                }
#pragma unroll
            for (int gq = 0; gq < 4; ++gq) { const f32x4 wv = *(const LAS f32x4*)(sc + 32 * tt + 8 * gq + 4 * hh);
#pragma unroll
                for (int r = 0; r < 4; ++r) num[tt][4 * gq + r] *= wv[r]; }
#pragma unroll
            for (int ks = 0; ks < 4; ++ks) {
                if (tt == 0 && ks >= 2) continue;
                const bf16x8 pf = *(const LAS bf16x8*)(lds + ML_PS + (32 * tt + r32) * 144 + (16 * ks + 8 * hh) * 2);
                num[tt] = __builtin_amdgcn_mfma_f32_32x32x16_bf16(pf, vf[ks], num[tt], 0, 0, 0);
            }
        }
        __syncthreads();
        u32x2 oreg[8];
        { const int t = tid >> 3, part = tid & 7; const bool pad = (c == 0 && t < 48); const size_t row = pad ? 0 : (size_t)rowof(c, t);
#pragma unroll
            for (int i = 0; i < 8; ++i) oreg[i] = *(const u32x2*)(qkvo + row * NPROJ + 2048 + h * 256 + 32 * i + 4 * part); }
#pragma unroll
        for (int tt = 0; tt < 2; ++tt)
#pragma unroll
            for (int gq = 0; gq < 4; ++gq) { const f32x4 iv = *(const LAS f32x4*)(sc + 64 + 32 * tt + 8 * gq + 4 * hh);
#pragma unroll
                for (int r = 0; r < 4; ++r) Hs[(32 * tt + 8 * gq + 4 * hh + r) * 260 + 32 * wid + r32] = num[tt][4 * gq + r] * iv[r]; }
        __syncthreads();
        {
            const int t = tid >> 3, part = tid & 7;
            f32x4 x[8]; float s1 = 0.f;
#pragma unroll
            for (int i = 0; i < 8; ++i) { x[i] = *(const LAS f32x4*)(Hs + t * 260 + 32 * i + 4 * part); s1 += (x[i][0] + x[i][1]) + (x[i][2] + x[i][3]); }
            s1 += __shfl_xor(s1, 1); s1 += __shfl_xor(s1, 2); s1 += __shfl_xor(s1, 4);
            const float mean = s1 * (1.0f / 256.0f); float s2 = 0.f;
#pragma unroll
            for (int i = 0; i < 8; ++i) { const f32x4 d = x[i] - mean; s2 += (d[0] * d[0] + d[1] * d[1]) + (d[2] * d[2] + d[3] * d[3]); }
            s2 += __shfl_xor(s2, 1); s2 += __shfl_xor(s2, 2); s2 += __shfl_xor(s2, 4);
            const float rstd = rsqrtf(s2 * (1.0f / 256.0f) + LN_EPS);
            if (!(c == 0 && t < 48)) {
                const size_t row = (size_t)rowof(c, t);
#pragma unroll
                for (int i = 0; i < 8; ++i) {
                    const int dv = 32 * i + 4 * part;
                    const u32x2 ow = oreg[i];
                    const f32x4 ng = *(const f32x4*)(normg + h * 256 + dv);
                    const float o0 = sigmoidf_(bflo(ow.x)), o1 = sigmoidf_(bfhi(ow.x)), o2 = sigmoidf_(bflo(ow.y)), o3 = sigmoidf_(bfhi(ow.y));
                    const f32x4 y = (x[i] - mean) * rstd * ng;
                    *(u32x2*)(hn + row * D + h * 256 + dv) = (u32x2){pk2(y[0] * o0, y[1] * o1), pk2(y[2] * o2, y[3] * o3)};
                }
            }
        }
        }
#pragma unroll
        for (int dkt = 0; dkt < 4; ++dkt) {
#pragma unroll
            for (int j = 0; j < 16; ++j) Cacc[dkt][j] *= decay;
#pragma unroll
            for (int ks = 0; ks < 4; ++ks) { const LAS unsigned char* p = lds + ML_KT + (32 * dkt + r32) * 136 + (16 * ks + 8 * hh) * 2;
                Cacc[dkt] = __builtin_amdgcn_mfma_f32_32x32x16_bf16(ld2x64(p, p + 8), vf[ks], Cacc[dkt], 0, 0, 0); }
        }
        {
            const int dk = tid >> 2, part = tid & 3;
            const u32x2 k0 = *(const LAS u32x2*)(lds + ML_KT + dk * 136 + part * 32), k1 = *(const LAS u32x2*)(lds + ML_KT + dk * 136 + part * 32 + 8),
                        k2 = *(const LAS u32x2*)(lds + ML_KT + dk * 136 + part * 32 + 16), k3 = *(const LAS u32x2*)(lds + ML_KT + dk * 136 + part * 32 + 24);
            float s = ((bflo(k0.x) + bfhi(k0.x)) + (bflo(k0.y) + bfhi(k0.y))) + ((bflo(k1.x) + bfhi(k1.x)) + (bflo(k1.y) + bfhi(k1.y)))
                    + ((bflo(k2.x) + bfhi(k2.x)) + (bflo(k2.y) + bfhi(k2.y))) + ((bflo(k3.x) + bfhi(k3.x)) + (bflo(k3.y) + bfhi(k3.y)));
            s += __shfl_xor(s, 1); s += __shfl_xor(s, 2);
            if (part == 0) sc[192 + dk] = decay * sc[192 + dk] + s;
        }
        m_run = b63 + M63;
        __syncthreads();
    }
#undef ML_PREFETCH
#undef rowof
}

constexpr float AT_PMIN = 1e-15f;
constexpr int AT_K0 = 0, AT_V0 = 17408, AT_BUF = 34816, AT_FLAGS = 2 * AT_BUF;
__device__ __forceinline__ void at_tile(const LAS unsigned char* Kb, const LAS unsigned char* Vb, int k0, int tmin, int r32, int hh, const bf16x8 (&qf)[8], f32x16 (&O)[4], float& P) {
    f32x16 S[2];
#pragma unroll
    for (int u = 0; u < 2; ++u) {
#pragma unroll
        for (int j = 0; j < 16; ++j) S[u][j] = 0.f;
#pragma unroll
        for (int ks = 0; ks < 8; ++ks) {
            const bf16x8 kf = *(const LAS bf16x8*)(Kb + (32 * u + r32) * 272 + (16 * ks + 8 * hh) * 2);
            S[u] = __builtin_amdgcn_mfma_f32_32x32x16_bf16(kf, qf[ks], S[u], 0, 0, 0);
        }
    }
    const bool full = (k0 + 63 < tmin) && (k0 >= 128);
    const int lim = tmin + r32 - k0 - 4 * hh;
    const int lo = 112 - k0 - 4 * hh;
    float Tt[2][4];
#define AT_ELEM(MASKED) \
    _Pragma("unroll") for (int u = 0; u < 2; ++u) _Pragma("unroll") for (int gq = 0; gq < 4; ++gq) { \
        float x4[4]; \
        _Pragma("unroll") for (int r = 0; r < 4; ++r) { \
            float zz = S[u][4 * gq + r] * (0.08838834764831845f * 1.4426950408889634f); \
            if (MASKED) { const int o = 32 * u + 8 * gq + r; zz = (o < lim && o >= lo) ? zz : -1.0e4f; } \
            const float rc = __builtin_amdgcn_rcpf(1.0f + __builtin_amdgcn_exp2f(zz)); \
            S[u][4 * gq + r] = 1.0f - rc; x4[r] = rc; } \
        const float e2 = x4[3], e1 = e2 * x4[2], e0 = e1 * x4[1]; \
        Tt[u][gq] = e0 * x4[0]; \
        S[u][4 * gq + 2] *= e2; S[u][4 * gq + 1] *= e1; S[u][4 * gq + 0] *= e0; }
    if (full) { AT_ELEM(false) } else { AT_ELEM(true) }
#undef AT_ELEM
    float acc = P;
#pragma unroll
    for (int u = 1; u >= 0; --u)
#pragma unroll
        for (int gq = 3; gq >= 0; --gq) {
            float t0; const float t1 = swap32_hi(Tt[u][gq], t0);
            const float Rr = hh ? acc : acc * t1;
            acc = (acc * t1) * t0;
#pragma unroll
            for (int r = 0; r < 4; ++r) S[u][4 * gq + r] *= Rr;
        }
    P = acc;
#pragma unroll
    for (int u = 0; u < 2; ++u)
#pragma unroll
        for (int s2 = 0; s2 < 2; ++s2) {
            const bf16x8 af = pack_frag(S[u], s2);
#pragma unroll
            for (int dt = 0; dt < 4; ++dt) {
                const LAS unsigned char* p = Vb + (32 * dt + r32) * 136 + (32 * u + 16 * s2 + 4 * hh) * 2;
                O[dt] = __builtin_amdgcn_mfma_f32_32x32x16_bf16(af, ld2x64(p, p + 16), O[dt], 0, 0, 0);
            }
        }
}
__device__ __forceinline__ void attn_phase(LAS unsigned char* lds, const bf16_t* kvq, bf16_t* ao) {
    const int tid = threadIdx.x, lane = tid & 63, wid = __builtin_amdgcn_readfirstlane(tid >> 6);
    const int r32 = lane & 31, hh = lane >> 5, l15 = lane & 15, l4 = lane >> 4;
    LAS unsigned* flags = (LAS unsigned*)(lds + AT_FLAGS);
    const int k_row = tid >> 4, k_col = (tid & 15) * 8;
    const int v_d = (16 * (wid & 1) + l15) * 4, v_s = (4 * (wid >> 1) + l4) * 4;
    for (int unit = blockIdx.x; unit < NB * 8 * 16; unit += gridDim.x) {
        const int qt = unit & 15, head = (unit >> 4) & 7, b = unit >> 7;
        const int q0 = 128 + 256 * qt, tmin = q0 + 32 * wid;
#define rowofp(p) ((p) >= 128 ? b * SEQ + (p) - 128 : ((p) >= 112 ? NR + b * 16 + (p) - 112 : NR + b * 16))
        bf16x8 qf[8];
        { const bf16_t* qp = kvq + (size_t)(b * SEQ + tmin - 128 + r32) * NPROJ + 2048 + head * 128 + 8 * hh;
#pragma unroll
            for (int ks = 0; ks < 8; ++ks) qf[ks] = *(const bf16x8*)(qp + 16 * ks); }
        f32x16 O[4];
#pragma unroll
        for (int i = 0; i < 4; ++i)
#pragma unroll
            for (int j = 0; j < 16; ++j) O[i][j] = 0.f;
        float P = 1.0f;
        const int kt_hi = (q0 >> 6) + 3;
        u32x4 kregA[2], kregB[2]; u32x2 vregA[4], vregB[4];
#define AT_LOAD(kreg, vreg, kt) do { \
        _Pragma("unroll") for (int p = 0; p < 2; ++p) kreg[p] = *(const u32x4*)(kvq + (size_t)rowofp(64 * (kt) + k_row + 32 * p) * NPROJ + head * 128 + k_col); \
        _Pragma("unroll") for (int kk = 0; kk < 4; ++kk) vreg[kk] = *(const u32x2*)(kvq + (size_t)rowofp(64 * (kt) + v_s + kk) * NPROJ + 1024 + head * 128 + v_d); } while (0)
#define AT_STORE(kreg, vreg, buf) do { LAS unsigned char* base = lds + (buf) * AT_BUF; \
        _Pragma("unroll") for (int p = 0; p < 2; ++p) *(LAS u32x4*)(base + AT_K0 + (k_row + 32 * p) * 272 + k_col * 2) = kreg[p]; \
        u32x2 vc[4]; tr4x4(vreg, vc); \
        _Pragma("unroll") for (int j = 0; j < 4; ++j) *(LAS u32x2*)(base + AT_V0 + (v_d + j) * 136 + v_s * 2) = vc[j]; } while (0)
#define AT_ITER(BUF, LOADSET_K, LOADSET_V, STORESET_K, STORESET_V) { \
            const int kt = kt_hi - it; \
            __syncthreads(); \
            if (it > 0 && flags[it - 1] == 0u) break; \
            if (kt - 2 >= 1) AT_LOAD(LOADSET_K, LOADSET_V, kt - 2); \
            if (64 * kt < tmin + 31 && __ballot(P >= AT_PMIN) != 0ull) at_tile(lds + (BUF) * AT_BUF + AT_K0, lds + (BUF) * AT_BUF + AT_V0, 64 * kt, tmin, r32, hh, qf, O, P); \
            if (__ballot(P >= AT_PMIN) != 0ull && lane == 0) flags[it] = 1u; \
            if (kt - 1 < 1) break; \
            AT_STORE(STORESET_K, STORESET_V, 1 - (BUF)); \
            ++it; }
        if (tid < 80) flags[tid] = 0u;
        AT_LOAD(kregA, vregA, kt_hi);
        AT_STORE(kregA, vregA, 0);
        AT_LOAD(kregB, vregB, kt_hi - 1);
        for (int it = 0; ; ) {
            AT_ITER(0, kregA, vregA, kregB, vregB)
            AT_ITER(1, kregB, vregB, kregA, vregA)
        }
#pragma unroll
        for (int dt = 0; dt < 4; ++dt)
#pragma unroll
            for (int j = 0; j < 16; ++j) {
                const int t = tmin + (j & 3) + 8 * (j >> 2) + 4 * hh;
                ao[(size_t)(b * SEQ + t - 128) * D + head * 128 + 32 * dt + r32] = f2bf(O[dt][j]);
            }
        __syncthreads();
    }
#undef AT_LOAD
#undef AT_STORE
#undef AT_ITER
#undef rowofp
}

__device__ __forceinline__ void ln_row_stats_wave(const float* st, int row, int lane, float& mu, float& rstd) {
    const f32x2 p = *(const f32x2*)(st + (size_t)row * 32 + (lane & 15) * 2);
    float s1 = p[0], s2 = p[1];
#pragma unroll
    for (int o = 1; o < 16; o <<= 1) { s1 += __shfl_xor(s1, o); s2 += __shfl_xor(s2, o); }
    mu = s1 * (1.0f / 1024.0f); const float var = fmaxf(s2 * (1.0f / 1024.0f) - mu * mu, 0.f); rstd = rsqrtf(var + LN_EPS);
}
__device__ __forceinline__ void router1_phase(LAS unsigned char* lds, const Args& a) {
    const int tid = threadIdx.x, lane = tid & 63, wid = tid >> 6;
    unsigned char* ws = a.ws;
    const float* g3 = a.in[16] + 2048; const float* b3 = a.in[17] + 2048; const float* wr = a.in[12];
    LAS float* gw = (LAS float*)lds;
    LAS float* cc = (LAS float*)(lds + 32768);
    LAS int* cnt = (LAS int*)(lds + 32768 + 64);
    __syncthreads();
    for (int i = tid; i < 8192; i += NTHREADS) { const int k = i >> 3, e = i & 7; gw[e * 1024 + k] = g3[k] * wr[i]; }
    if (tid < 8) cnt[tid] = 0;
    __syncthreads();
    { float s1 = 0.f, s2 = 0.f;
        for (int k = lane; k < 1024; k += 64) { s1 += gw[wid * 1024 + k]; s2 += b3[k] * wr[k * 8 + wid]; }
        s1 = wave_sum(s1); s2 = wave_sum(s2);
        if (lane == 0) { cc[wid] = s1; cc[8 + wid] = s2; } }
    __syncthreads();
    const bf16_t* z3 = (const bf16_t*)(ws + WS_RC); const float* st3 = (const float*)(ws + WS_ST3);
    f32x4* route = (f32x4*)(ws + WS_ROUTE);
    const int tok0 = (int)(((long)NR * blockIdx.x) / gridDim.x), tok1 = (int)(((long)NR * (blockIdx.x + 1)) / gridDim.x);
    u32x4 zr[2]; f32x2 sp;
#define RT_LOAD(t) do { zr[0] = *(const u32x4*)(z3 + (size_t)(t) * D + lane * 8); zr[1] = *(const u32x4*)(z3 + (size_t)(t) * D + 512 + lane * 8); sp = *(const f32x2*)(st3 + (size_t)(t) * 32 + (lane & 15) * 2); } while (0)
    if (tok0 + wid < tok1) RT_LOAD(tok0 + wid);
    for (int tok = tok0 + wid; tok < tok1; tok += 8) {
        const u32x4 zc[2] = {zr[0], zr[1]}; const f32x2 spc = sp;
        if (tok + 8 < tok1) RT_LOAD(tok + 8);
        float s1 = spc[0], s2 = spc[1];
#pragma unroll
        for (int o = 1; o < 16; o <<= 1) { s1 += __shfl_xor(s1, o); s2 += __shfl_xor(s2, o); }
        const float mu = s1 * (1.0f / 1024.0f); const float rstd = rsqrtf(fmaxf(s2 * (1.0f / 1024.0f) - mu * mu, 0.f) + LN_EPS);
        float acc[8] = {0.f, 0.f, 0.f, 0.f, 0.f, 0.f, 0.f, 0.f};
#pragma unroll
        for (int hf = 0; hf < 2; ++hf) {
            const int k = hf * 512 + lane * 8;
            float z[8]; g8::unpack8(zc[hf], z);
#pragma unroll
            for (int e = 0; e < 8; ++e) { const f32x4 w0 = *(const LAS f32x4*)(gw + e * 1024 + k), w1 = *(const LAS f32x4*)(gw + e * 1024 + k + 4);
                acc[e] += ((z[0] * w0[0] + z[1] * w0[1]) + (z[2] * w0[2] + z[3] * w0[3])) + ((z[4] * w1[0] + z[5] * w1[1]) + (z[6] * w1[2] + z[7] * w1[3])); }
        }
        float lg[8];
#pragma unroll
        for (int e = 0; e < 8; ++e) lg[e] = rstd * (wave_total(acc[e]) - mu * cc[e]) + cc[8 + e];
        int e1 = 0; float v1 = lg[0];
#pragma unroll
        for (int e = 1; e < 8; ++e) if (lg[e] > v1) { v1 = lg[e]; e1 = e; }
        int e2 = -1; float v2 = -3.0e38f;
#pragma unroll
        for (int e = 0; e < 8; ++e) if (e != e1 && lg[e] > v2) { v2 = lg[e]; e2 = e; }
        const float g1 = 1.0f / (1.0f + expf(v2 - v1));
        if (lane == 0) { ((f32x2*)(ws + WS_TOKST))[tok] = (f32x2){mu, rstd}; route[tok] = (f32x4){__int_as_float(e1 | (e2 << 8)), g1, 1.0f - g1, 0.f}; __hip_atomic_fetch_add(&cnt[e1], 1, __ATOMIC_RELAXED, __HIP_MEMORY_SCOPE_WORKGROUP); __hip_atomic_fetch_add(&cnt[e2], 1, __ATOMIC_RELAXED, __HIP_MEMORY_SCOPE_WORKGROUP); }
    }
    __syncthreads();
    if (tid < 8) ((int*)(ws + WS_CNT))[blockIdx.x * 8 + tid] = cnt[tid];
}
__device__ __forceinline__ void router2_phase(LAS unsigned char* lds, const Args& a) {
    const int tid = threadIdx.x, lane = tid & 63, wid = tid >> 6;
    unsigned char* ws = a.ws;
    const int G = gridDim.x, wg = blockIdx.x;
    LAS int* cn = (LAS int*)lds;
    LAS int* tot = (LAS int*)(lds + 16384);
    __syncthreads();
    const int* cnts = (const int*)(ws + WS_CNT);
    for (int i = tid; i < G * 8; i += NTHREADS) cn[i] = cnts[i];
    __syncthreads();
    { int t = 0, p = 0;
        for (int w = lane; w < G; w += 64) { const int v = cn[w * 8 + wid]; t += v; p += (w < wg) ? v : 0; }
#pragma unroll
        for (int o = 32; o >= 1; o >>= 1) { t += __shfl_xor(t, o); p += __shfl_xor(p, o); }
        if (lane == 0) { tot[wid] = t; tot[8 + wid] = p; } }
    __syncthreads();
    if (tid == 0) { int ps = 0;
        for (int e = 0; e < 8; ++e) { tot[24 + e] = ps; tot[16 + e] = ps + tot[8 + e]; ps += ((tot[e] + 255) >> 8) << 8; }
        if (wg == 0) { int* hdr = (int*)(ws + WS_HDR); int pp = 0; for (int e = 0; e < 8; ++e) { pp += (tot[e] + 255) >> 8; hdr[e] = pp; } hdr[8] = pp; } }
    __syncthreads();
    u32x2* smeta = (u32x2*)(ws + WS_TOK); f32x2* sstat = (f32x2*)(ws + WS_GATEB); const f32x2* tokst = (const f32x2*)(ws + WS_TOKST);
    const f32x4* route = (const f32x4*)(ws + WS_ROUTE);
    const int tok0 = (int)(((long)NR * wg) / G), tok1 = (int)(((long)NR * (wg + 1)) / G);
    { const int e = wid; int run = tot[16 + e];
        for (int q0 = 2 * tok0; q0 < 2 * tok1; q0 += 64) {
            const int q = q0 + lane; bool match = false; float gt = 0.f;
            if (q < 2 * tok1) { const f32x4 r = route[q >> 1]; const int ee = __float_as_int(r[0]); const int ex = (q & 1) ? ((ee >> 8) & 0xff) : (ee & 0xff); match = (ex == e); gt = (q & 1) ? r[2] : r[1]; }
            const unsigned long long mask = __ballot(match);
            const int pos = __popcll(mask & ((1ull << lane) - 1ull));
            if (match) { smeta[run + pos] = (u32x2){(unsigned)q, __float_as_uint(gt)}; sstat[run + pos] = tokst[q >> 1]; }
            run += __popcll(mask);
        }
        if (wg == 0) { const int s0 = tot[24 + e] + tot[e], s1 = tot[24 + e] + (((tot[e] + 255) >> 8) << 8);
            for (int s = s0 + lane; s < s1; s += 64) { smeta[s] = (u32x2){0xffffffffu, 0u}; sstat[s] = (f32x2){0.f, 1.f}; } }
    }
}

__device__ __forceinline__ float wave_total(float x);
__device__ __forceinline__ void final_phase(const Args& a) {
    const int tid = threadIdx.x, lane = tid & 63, wid = tid >> 6;
    unsigned char* ws = a.ws;
    const bf16_t* z3 = (const bf16_t*)(ws + WS_RC); const float* st3 = (const float*)(ws + WS_ST3);
    const bf16_t* Y0 = (const bf16_t*)(ws + WS_RB); const bf16_t* Y1 = (const bf16_t*)(ws + WS_RD);
    const float* g3 = a.in[16] + 2048; const float* b3 = a.in[17] + 2048; const float* g4 = a.in[16] + 3072; const float* b4 = a.in[17] + 3072;
    float G3[16], B3[16], G4[16], B4[16];
#pragma unroll
    for (int hf = 0; hf < 2; ++hf)
#pragma unroll
        for (int q = 0; q < 2; ++q) { const int k = hf * 512 + lane * 8 + q * 4;
            const f32x4 a3 = *(const f32x4*)(g3 + k), c3 = *(const f32x4*)(b3 + k), a4 = *(const f32x4*)(g4 + k), c4 = *(const f32x4*)(b4 + k);
#pragma unroll
            for (int j = 0; j < 4; ++j) { G3[hf * 8 + q * 4 + j] = a3[j] * ALPHA; B3[hf * 8 + q * 4 + j] = c3[j] * ALPHA; G4[hf * 8 + q * 4 + j] = a4[j]; B4[hf * 8 + q * 4 + j] = c4[j]; } }
    const int stride = gridDim.x * 8;
    int tok = blockIdx.x * 8 + wid;
    u32x4 zr[2], y0r[2], y1r[2]; f32x2 sp;
#define FIN_LOAD(t) do { _Pragma("unroll") for (int hf = 0; hf < 2; ++hf) { const size_t o = (size_t)(t) * D + hf * 512 + lane * 8; \
        zr[hf] = *(const u32x4*)(z3 + o); y0r[hf] = *(const u32x4*)(Y0 + o); y1r[hf] = *(const u32x4*)(Y1 + o); } \
        sp = *(const f32x2*)(st3 + (size_t)(t) * 32 + (lane & 15) * 2); } while (0)
    if (tok < NR) FIN_LOAD(tok);
    for (; tok < NR; tok += stride) {
        u32x4 zc[2] = {zr[0], zr[1]}, y0c[2] = {y0r[0], y0r[1]}, y1c[2] = {y1r[0], y1r[1]}; const f32x2 spc = sp;
        if (tok + stride < NR) FIN_LOAD(tok + stride);
        float s1 = spc[0], s2 = spc[1];
#pragma unroll
        for (int o = 1; o < 16; o <<= 1) { s1 += __shfl_xor(s1, o); s2 += __shfl_xor(s2, o); }
        const float mu = s1 * (1.0f / 1024.0f); const float rstd = rsqrtf(fmaxf(s2 * (1.0f / 1024.0f) - mu * mu, 0.f) + LN_EPS);
        float v[16]; float t1 = 0.f;
#pragma unroll
        for (int hf = 0; hf < 2; ++hf) {
            float z[8], y0[8], y1[8];
            g8::unpack8(zc[hf], z); g8::unpack8(y0c[hf], y0); g8::unpack8(y1c[hf], y1);
#pragma unroll
            for (int j = 0; j < 8; ++j) { const float x = ((z[j] - mu) * rstd * G3[hf * 8 + j] + B3[hf * 8 + j]) + (y0[j] + y1[j]); v[hf * 8 + j] = x; t1 += x; }
        }
        t1 = wave_total(t1); const float mean = t1 * (1.0f / 1024.0f); float t2 = 0.f;
#pragma unroll
        for (int j = 0; j < 16; ++j) { const float d = v[j] - mean; t2 += d * d; }
        t2 = wave_total(t2); const float rs = rsqrtf(t2 * (1.0f / 1024.0f) + LN_EPS);
#pragma unroll
        for (int hf = 0; hf < 2; ++hf) {
            const int k = hf * 512 + lane * 8;
            f32x4 o0, o1;
#pragma unroll
            for (int j = 0; j < 4; ++j) { o0[j] = (v[hf * 8 + j] - mean) * rs * G4[hf * 8 + j] + B4[hf * 8 + j]; o1[j] = (v[hf * 8 + 4 + j] - mean) * rs * G4[hf * 8 + 4 + j] + B4[hf * 8 + 4 + j]; }
            *(f32x4*)(a.out + (size_t)tok * D + k) = o0; *(f32x4*)(a.out + (size_t)tok * D + k + 4) = o1;
        }
    }
#undef FIN_LOAD
}

__device__ __forceinline__ void moefix_phase(const Args& a) {
    const int lane = threadIdx.x & 63, wid = threadIdx.x >> 6;
    unsigned char* ws = a.ws;
    const int npan = ((const int*)(ws + WS_HDR))[8];
    const int p_lo = (MOE_NCHUNK - 1) * MOE_CHUNK_PAN + MOE_CHUNK_PAN;
    const int nrows = (npan - p_lo) * 256;
    const u32x2* smeta = (const u32x2*)(ws + WS_TOK);
    const float* P = (const float*)(ws + WS_RA + RA_POFF);
    bf16_t* Y0 = (bf16_t*)(ws + WS_RB); bf16_t* Y1 = (bf16_t*)(ws + WS_RD);
    for (int r = blockIdx.x * 8 + wid; r < nrows; r += gridDim.x * 8) {
        const u32x2 mg = smeta[(size_t)p_lo * 256 + r];
        const int id = (int)mg.x; const float gt = __uint_as_float(mg.y);
        if (id < 0) continue;
        bf16_t* yrow = ((id & 1) ? Y1 : Y0) + (size_t)(id >> 1) * D;
#pragma unroll
        for (int hf = 0; hf < 2; ++hf) {
            const int c = hf * 512 + lane * 8;
            f32x4 s0 = {0.f, 0.f, 0.f, 0.f}, s1 = {0.f, 0.f, 0.f, 0.f};
#pragma unroll
            for (int ks = 0; ks < MOE_KSPLIT; ++ks) { const float* pp = P + ((size_t)ks * 2048 + r) * D + c; s0 += *(const f32x4*)pp; s1 += *(const f32x4*)(pp + 4); }
            *(u32x4*)(yrow + c) = g8::pack8(s0 * gt, s1 * gt);
        }
    }
}
__device__ __forceinline__ void finstats_phase(const float* st, float* rs, int nrows) {
    for (int row = blockIdx.x * NTHREADS + threadIdx.x; row < nrows; row += gridDim.x * NTHREADS) {
        const f32x4* p = (const f32x4*)(st + (size_t)row * 32);
        float s1 = 0.f, s2 = 0.f;
#pragma unroll
        for (int i = 0; i < 8; ++i) { const f32x4 a = p[i]; s1 += a[0] + a[2]; s2 += a[1] + a[3]; }
        const float mu = s1 * (1.0f / 1024.0f); const float rstd = rsqrtf(fmaxf(s2 * (1.0f / 1024.0f) - mu * mu, 0.f) + LN_EPS);
        *(f32x2*)(rs + (size_t)row * 2) = (f32x2){mu, rstd};
    }
}
__global__ void __launch_bounds__(NTHREADS, 2) yoco_fwd(Args args) {
    extern __shared__ __attribute__((aligned(16))) unsigned char lds_raw[];
    LAS unsigned char* lds = (LAS unsigned char*)lds_raw;
    unsigned char* ws = args.ws;
    const int G = gridDim.x;
    const int lo = args.ph_lo, hi = args.ph_hi;
    volatile LAS unsigned* misc = (volatile LAS unsigned*)(lds + LDS_MAIN);
    if (threadIdx.x < 4) misc[threadIdx.x] = 0u;
    __syncthreads();
    XcdBarrier bar; bar.bar = (unsigned*)(ws + WS_CTL); bar.x = 0; bar.st = misc;
    if (hi - lo > 1) bar = xcd_barrier_post((unsigned*)(ws + WS_CTL), misc);
#ifndef PHASE_MASK
#define PHASE_MASK 0xFFFFFFFFu
#endif
#define IN(k) (((PHASE_MASK >> (k)) & 1u) && lo <= (k) && (k) < hi)
#define SEAM(k) do { if (IN(k) && IN((k) + 1)) xcd_barrier(bar); } while (0)
    bf16_t* RA = (bf16_t*)(ws + WS_RA); bf16_t* RB = (bf16_t*)(ws + WS_RB); bf16_t* RC = (bf16_t*)(ws + WS_RC); bf16_t* RD = (bf16_t*)(ws + WS_RD);
    float* vec = (float*)(ws + WS_VEC);
    float* st1 = (float*)(ws + WS_ST1); float* st2 = (float*)(ws + WS_ST2); float* st3 = (float*)(ws + WS_ST3);
    const float* ln_g = args.in[16]; const float* ln_b = args.in[17];

#define RUN(k, ...) do { if constexpr (((REPMASK) >> (k)) & 1u) { if (IN(k)) { __VA_ARGS__ } xcd_barrier(bar); } if (IN(k)) { __VA_ARGS__ } SEAM(k); } while (0)
    RUN(PH_PRO, prologue_phase(lds, args););
    RUN(PH_PROJ,
        g8::Gemm g{RB, (const bf16_t*)(ws + WS_WIN), D, nullptr, nullptr, nullptr}; g8::DenseOrder S; S.init(NPAN, NPROJ / 256, D, G, (int)blockIdx.x);
        g8::EpiPlain E{RA, NPROJ};
        g8::gemm_phase<g8::EpiPlain, g8::DenseOrder, false>(lds, g, S, E); tail_jobs(lds, args, PH_PROJ););
    RUN(PH_MLSTM, if ((int)blockIdx.x < 256) mlstm_phase(lds, RA, (const float*)(ws + WS_GATES), args.in[4], RD, (int)blockIdx.x););
    RUN(PH_WOUT,
        g8::Gemm g{RD, (const bf16_t*)(ws + WS_WOUT), D, nullptr, nullptr, nullptr}; g8::DenseOrder S; S.init(NPAN, 4, D, G, (int)blockIdx.x);
        g8::EpiRes<0> E{RC, RB, st1, lds + LDS_META, nullptr, nullptr};
        g8::gemm_phase<g8::EpiRes<0>, g8::DenseOrder, false>(lds, g, S, E); tail_jobs(lds, args, PH_WOUT););
    RUN(PH_FIN1, finstats_phase(st1, (float*)(ws + WS_RS1), NROWS););
    RUN(PH_GU,
        g8::Gemm g{RC, (const bf16_t*)(ws + WS_WGU), D, nullptr, nullptr, ws + WS_RS1}; g8::DenseOrder S; S.init(NPAN, 2 * FFD / 256, D, G, (int)blockIdx.x);
        g8::EpiGlu<false> E{RA, FFD, st1, vec + VEC_GU_CS, vec + VEC_GU_BW, lds + LDS_META, 0};
        g8::gemm_phase<g8::EpiGlu<false>, g8::DenseOrder, false, 3>(lds, g, S, E); tail_jobs(lds, args, PH_GU););
    RUN(PH_DN,
        g8::Gemm g{RA, (const bf16_t*)(ws + WS_WDN), FFD, nullptr, nullptr, ws + WS_RS1}; g8::DenseOrder S; S.init(NPAN, 4, FFD, G, (int)blockIdx.x);
        g8::EpiRes<1> E{RB, RC, st2, lds + LDS_META, ln_g, ln_b};
        g8::gemm_phase<g8::EpiRes<1>, g8::DenseOrder, false, 3>(lds, g, S, E); tail_jobs(lds, args, PH_DN););
    RUN(PH_FIN2, finstats_phase(st2, (float*)(ws + WS_RS2), NROWS););
    RUN(PH_KVQ,
        g8::Gemm g{RB, (const bf16_t*)(ws + WS_WKVQ), D, nullptr, nullptr, ws + WS_RS2}; g8::DenseOrder S; S.init(NPAN, NPROJ / 256, D, G, (int)blockIdx.x);
        g8::EpiFold E{RA, NPROJ, lds + LDS_META, vec + VEC_KVQ_CS, vec + VEC_KVQ_BW};
        g8::gemm_phase<g8::EpiFold, g8::DenseOrder, false, 3>(lds, g, S, E); tail_jobs(lds, args, PH_KVQ););
    RUN(PH_ATT, attn_phase(lds, RA, RD););
    RUN(PH_WO,
        g8::Gemm g{RD, (const bf16_t*)(ws + WS_WO), D, nullptr, nullptr, ws + WS_RS2}; g8::DenseOrder S; S.init(NR / 256, 4, D, G, (int)blockIdx.x);
        g8::EpiRes<1> E{RC, RB, st3, lds + LDS_META, ln_g + 1024, ln_b + 1024};
        g8::gemm_phase<g8::EpiRes<1>, g8::DenseOrder, false, 3>(lds, g, S, E););
    RUN(PH_RT1, router1_phase(lds, args););
    RUN(PH_RT2, router2_phase(lds, args););
#define MOE_CHUNK(cidx) \
    RUN(PH_MOE0 + 2 * (cidx), const int* hdr = (const int*)(ws + WS_HDR); const int npan = hdr[8]; const int p0 = (cidx) * MOE_CHUNK_PAN; \
        { g8::MoeOrder S; S.p0 = p0; S.np = ((cidx) == MOE_NCHUNK - 1) ? (npan - p0) : MOE_CHUNK_PAN; S.nfull = S.np; S.nsplit = 1; S.nN = 2 * FFE / 256; S.G = G; S.c = (int)blockIdx.x; S.K = D; S.estride = (unsigned)(2 * FFE * D * 2); \
            _Pragma("unroll") for (int e = 0; e < NE; ++e) S.pend[e] = hdr[e]; \
            g8::Gemm g{RC, (const bf16_t*)(ws + WS_WEGU), D, (const int*)(ws + WS_TOK), ws + WS_TOK, ws + WS_GATEB}; \
            g8::EpiGlu<true> E{RA, FFE, st3, vec + VEC_EGU_CS, vec + VEC_EGU_BW, lds + LDS_META, 2 * FFE}; \
            g8::gemm_phase<g8::EpiGlu<true>, g8::MoeOrder, true, 1>(lds, g, S, E); }); \
    RUN(PH_MOE0 + 2 * (cidx) + 1, const int* hdr = (const int*)(ws + WS_HDR); const int npan = hdr[8]; const int p0 = (cidx) * MOE_CHUNK_PAN; \
        { g8::MoeOrder S; S.p0 = p0; S.np = ((cidx) == MOE_NCHUNK - 1) ? (npan - p0) : MOE_CHUNK_PAN; S.nfull = MOE_CHUNK_PAN; S.nsplit = MOE_KSPLIT; S.nN = 4; S.G = G; S.c = (int)blockIdx.x; S.K = FFE; S.estride = (unsigned)(D * FFE * 2); \
            _Pragma("unroll") for (int e = 0; e < NE; ++e) S.pend[e] = hdr[e]; \
            g8::Gemm g{RA, (const bf16_t*)(ws + WS_WEDN), FFE, nullptr, ws + WS_TOK, nullptr}; \
            g8::EpiMoeDown E{RB, RD, lds + LDS_META, (float*)((unsigned char*)RA + RA_POFF), MOE_CHUNK_PAN}; \
            g8::gemm_phase<g8::EpiMoeDown, g8::MoeOrder, false, 2>(lds, g, S, E); });
    MOE_CHUNK(0) MOE_CHUNK(1) MOE_CHUNK(2) MOE_CHUNK(3)
    RUN(PH_FIX, moefix_phase(args););
    RUN(PH_FINAL, final_phase(args););
    if (PROBE_CLK && blockIdx.x == 0 && threadIdx.x == 0) { const float kv = ((volatile float*)(ws + WS_DIAG))[0]; const long long t0 = wall_clock64(); const long long dl = (long long)(kv * 5000.0f); while (wall_clock64() - t0 < dl) __builtin_amdgcn_s_sleep(8); }
#undef RUN
#undef IN
#undef SEAM
}

extern "C" void kernel_launch(void* const* d_in, const int* in_sizes, int n_in, void* d_out, int out_size, void* d_ws, size_t ws_size, hipStream_t stream) {
    static int grid = 0;
    if (grid == 0) {
        if (n_in != 18 || out_size != NR * D || ws_size < WS_END) { fprintf(stderr, "kernel_launch: unexpected problem (n_in %d out %d ws %zu need %zu)\n", n_in, out_size, ws_size, (size_t)WS_END); grid = -1; return; }
        int dev = 0, cus = 0, per_cu = 0;
        if (hipGetDevice(&dev) != hipSuccess || hipDeviceGetAttribute(&cus, hipDeviceAttributeMultiprocessorCount, dev) != hipSuccess) { grid = -1; return; }
        if (hipFuncSetAttribute((const void*)yoco_fwd, hipFuncAttributeMaxDynamicSharedMemorySize, LDS_BYTES) != hipSuccess) { fprintf(stderr, "kernel_launch: hipFuncSetAttribute failed\n"); grid = -1; return; }
        if (hipOccupancyMaxActiveBlocksPerMultiprocessor(&per_cu, (const void*)yoco_fwd, NTHREADS, LDS_BYTES) != hipSuccess || per_cu < 1) { fprintf(stderr, "kernel_launch: occupancy query says %d\n", per_cu); }
        (void)hipGetLastError();
        if (cus < 256) { fprintf(stderr, "kernel_launch: needs 256 CUs\n"); grid = -1; return; }
        grid = 256;
    }
    if (grid < 0) return;
    (void)hipMemsetAsync((char*)d_ws + WS_CTL, 0, CTL_BYTES, stream);
    Args a{};
    for (int i = 0; i < 18; ++i) a.in[i] = (const float*)d_in[i];
    a.out = (float*)d_out; a.ws = (unsigned char*)d_ws;
#if N_LAUNCH_MODE == 1
    for (int p = 0; p < PH_COUNT; ++p) { a.ph_lo = p; a.ph_hi = p + 1; hipLaunchKernelGGL(yoco_fwd, dim3(grid), dim3(NTHREADS), LDS_BYTES, stream, a); }
#else
    a.ph_lo = 0; a.ph_hi = PH_COUNT;
    hipLaunchKernelGGL(yoco_fwd, dim3(grid), dim3(NTHREADS), LDS_BYTES, stream, a);
#endif
}
```

```cpp
#include <hip/hip_runtime.h>
#include <cstdio>
#include <cstdint>

#ifndef N_LAUNCH_MODE
#define N_LAUNCH_MODE 0
#endif
#ifndef PROBE_CLK
#define PROBE_CLK 0
#endif
#ifndef REPMASK
#define REPMASK 0u
#endif

#define LAS __attribute__((address_space(3)))
typedef unsigned short bf16_t;
typedef short bf16x8 __attribute__((ext_vector_type(8)));
typedef float f32x2 __attribute__((ext_vector_type(2)));
typedef float f32x4 __attribute__((ext_vector_type(4)));
typedef float f32x16 __attribute__((ext_vector_type(16)));
typedef unsigned u32x2 __attribute__((ext_vector_type(2)));
typedef unsigned u32x4 __attribute__((ext_vector_type(4)));
typedef __bf16 bf16x2_t __attribute__((ext_vector_type(2)));

constexpr int D = 1024, NB = 16, SEQ = 4096, NMETA = 16;
constexpr int NR = NB * SEQ;
constexpr int NROWS = NR + NB * NMETA;
constexpr int NPAN = NROWS / 256;
constexpr int NPROJ = 3072;
constexpr int FFD = 2816, NE = 8, FFE = 3584;
constexpr float ALPHA = 1.41421356237f, LN_EPS = 1e-5f;
constexpr int NTHREADS = 512;
constexpr int MOE_ROWS = 2 * NR + NE * 256;
constexpr int MOE_CHUNK_PAN = 128;
constexpr int MOE_NCHUNK = 4;
constexpr int MOE_KSPLIT = 7;
constexpr size_t RA_POFF = (size_t)256 << 20;

constexpr size_t al256(size_t x) { return (x + 255) & ~(size_t)255; }
constexpr size_t WS_CTL = 0;
constexpr size_t CTL_BYTES = 65536;
constexpr size_t WS_WIN = WS_CTL + CTL_BYTES;
constexpr size_t WS_WOUT = WS_WIN + (size_t)NPROJ * D * 2;
constexpr size_t WS_WGU = WS_WOUT + (size_t)D * D * 2;
constexpr size_t WS_WDN = WS_WGU + (size_t)2 * FFD * D * 2;
constexpr size_t WS_WKVQ = WS_WDN + (size_t)D * FFD * 2;
constexpr size_t WS_WO = WS_WKVQ + (size_t)NPROJ * D * 2;
constexpr size_t WS_WEGU = WS_WO + (size_t)D * D * 2;
constexpr size_t WS_WEDN = WS_WEGU + (size_t)NE * 2 * FFE * D * 2;
constexpr size_t WS_VEC = WS_WEDN + (size_t)NE * D * FFE * 2;
constexpr int VEC_GU_CS = 0, VEC_GU_BW = 2 * FFD, VEC_KVQ_CS = 4 * FFD, VEC_KVQ_BW = VEC_KVQ_CS + NPROJ, VEC_EGU_CS = VEC_KVQ_BW + NPROJ, VEC_EGU_BW = VEC_EGU_CS + NE * 2 * FFE, VEC_END = VEC_EGU_BW + NE * 2 * FFE;
constexpr size_t WS_GATES = al256(WS_VEC + (size_t)VEC_END * 4);
constexpr size_t WS_ST1 = al256(WS_GATES + (size_t)NROWS * 8 * 4);
constexpr size_t WS_ST2 = WS_ST1 + (size_t)NROWS * 16 * 8;
constexpr size_t WS_ST3 = WS_ST2 + (size_t)NROWS * 16 * 8;
constexpr size_t WS_ROUTE = WS_ST3 + (size_t)NROWS * 16 * 8;
constexpr size_t WS_CNT = WS_ROUTE + (size_t)NR * 16;
constexpr size_t WS_HDR = WS_CNT + 256 * 8 * 4;
constexpr size_t WS_TOK = WS_HDR + 256;
constexpr size_t WS_GATEB = al256(WS_TOK + (size_t)MOE_ROWS * 8);
constexpr size_t WS_TOKST = al256(WS_GATEB + (size_t)MOE_ROWS * 8);
constexpr size_t WS_RS1 = al256(WS_TOKST + (size_t)NR * 8);
constexpr size_t WS_RS2 = al256(WS_RS1 + (size_t)NROWS * 8);
constexpr size_t WS_DIAG = al256(WS_RS2 + (size_t)NROWS * 8);
constexpr size_t WS_RA = al256(WS_DIAG + 4096);
constexpr size_t RA_BYTES = (size_t)NROWS * NPROJ * 2;
constexpr size_t WS_RB = al256(WS_RA + RA_BYTES);
constexpr size_t RX_BYTES = (size_t)NROWS * D * 2;
constexpr size_t WS_RC = al256(WS_RB + RX_BYTES);
constexpr size_t WS_RD = al256(WS_RC + RX_BYTES);
constexpr size_t WS_END = al256(WS_RD + RX_BYTES);

constexpr int LDS_MAIN = 131072, LDS_META = LDS_MAIN + 256  , LDS_BYTES = LDS_META + 8192;
__device__ __forceinline__ float bf2f(bf16_t v) { return __uint_as_float(((unsigned)v) << 16); }
__device__ __forceinline__ float bflo(unsigned u) { return __uint_as_float(u << 16); }
__device__ __forceinline__ float bfhi(unsigned u) { return __uint_as_float(u & 0xffff0000u); }
__device__ __forceinline__ unsigned pk2(float lo, float hi) { f32x2 v = {lo, hi}; bf16x2_t b = __builtin_convertvector(v, bf16x2_t); return __builtin_bit_cast(unsigned, b); }
__device__ __forceinline__ bf16_t f2bf(float f) { return (bf16_t)(pk2(f, 0.f) & 0xffffu); }
__device__ __forceinline__ float rbf(float f) { return bflo(pk2(f, 0.f)); }
__device__ __forceinline__ float wave_sum(float v) {
#pragma unroll
    for (int o = 32; o >= 1; o >>= 1) v += __shfl_xor(v, o);
    return v;
}
__device__ __forceinline__ float swap32_hi(float x, float& lo) {
    const u32x2 r = __builtin_amdgcn_permlane32_swap(__float_as_uint(x), __float_as_uint(x), false, false); lo = __uint_as_float(r.x); return __uint_as_float(r.y); }
__device__ __forceinline__ float fq_sum(float x) {
    const u32x2 a = __builtin_amdgcn_permlane16_swap(__float_as_uint(x), __float_as_uint(x), false, false); const float y = __uint_as_float(a.x) + __uint_as_float(a.y);
    const u32x2 b = __builtin_amdgcn_permlane32_swap(__float_as_uint(y), __float_as_uint(y), false, false); return __uint_as_float(b.x) + __uint_as_float(b.y); }
__device__ __forceinline__ float sigmoidf_(float x) { return __builtin_amdgcn_rcpf(1.0f + __builtin_amdgcn_exp2f(x * -1.4426950408889634f)); }

#define XB_TMO      128
#define XB_XCNT(j)  (256  + 64 * (j))
#define XB_XSUB(j)  (1280 + 64 * (j))
#define XB_XGEN(j)  (2304 + 64 * (j))
#define XB_TOP      3328
#define XB_TOPGEN   3392
#define XCD_BAR_WORDS 3456
#define XB_SPIN_CAP (1u << 20)
__device__ __forceinline__ unsigned xb_ld(unsigned* p)              { return __hip_atomic_load(p, __ATOMIC_RELAXED, __HIP_MEMORY_SCOPE_AGENT); }
__device__ __forceinline__ unsigned xb_add(unsigned* p, unsigned v) { return __hip_atomic_fetch_add(p, v, __ATOMIC_RELAXED, __HIP_MEMORY_SCOPE_AGENT); }
__device__ __forceinline__ unsigned xb_xcc_id() { return (unsigned)__builtin_amdgcn_s_getreg((3 << 11) | 20) & 0xFu; }
#define XB_SPIN(cond, bar) do { unsigned _sp = 0; while (cond) { __builtin_amdgcn_s_sleep(1); \
    if ((++_sp & 255u) == 0u) { if (xb_ld(&(bar)[XB_TMO])) break; if (_sp > XB_SPIN_CAP) { atomicAdd(&(bar)[XB_TMO], 1u); break; } } } } while (0)
struct XcdBarrier { unsigned* bar; unsigned x; volatile LAS unsigned* st; };
__device__ __forceinline__ XcdBarrier xcd_barrier_post(unsigned* bar, volatile LAS unsigned* st) {
    XcdBarrier b; b.bar = bar; b.x = xb_xcc_id(); b.st = st;
    if (threadIdx.x == 0) (void)xb_add(&bar[XB_XCNT(b.x)], 1u);
    return b;
}
__device__ __forceinline__ void xcd_barrier_complete(unsigned* bar, unsigned x, unsigned& nloc, unsigned& nx) {
    const unsigned G = gridDim.x * gridDim.y * gridDim.z;
    unsigned sum, cnt, mine, sp = 0u;
    for (;;) {
        sum = 0u; cnt = 0u; mine = 0u;
#pragma unroll
        for (unsigned j = 0; j < 16; ++j) { const unsigned c = xb_ld(&bar[XB_XCNT(j)]); sum += c; cnt += (c > 0u) ? 1u : 0u; mine = (j == x) ? c : mine; }
        if (sum == G) break;
        __builtin_amdgcn_s_sleep(1);
        if ((++sp & 255u) == 0u) { if (xb_ld(&bar[XB_TMO])) break; if (sp > XB_SPIN_CAP) { atomicAdd(&bar[XB_TMO], 1u); break; } }
    }
    nloc = mine > 0u ? mine : 1u; nx = cnt > 0u ? cnt : 1u;
}
__device__ __forceinline__ void xcd_barrier(const XcdBarrier& b) {
    asm volatile("s_waitcnt vmcnt(0)" ::: "memory");
    __syncthreads();
    if (threadIdx.x == 0) {
        unsigned* bar = b.bar;
        __builtin_amdgcn_s_waitcnt(0);
        unsigned nloc = b.st[0], nx = b.st[1];
        if (nloc == 0u) { xcd_barrier_complete(bar, b.x, nloc, nx); b.st[0] = nloc; b.st[1] = nx; }
        const unsigned old = xb_add(&bar[XB_XSUB(b.x)], 1u);
        const unsigned gen = old / nloc;
        if (old + 1u == (gen + 1u) * nloc) {
            __builtin_amdgcn_fence(__ATOMIC_RELEASE, "agent");
            asm volatile("s_waitcnt vmcnt(0)" ::: "memory");
            const unsigned og = xb_add(&bar[XB_TOP], 1u);
            const unsigned tg = og / nx;
            if (og + 1u == (tg + 1u) * nx) xb_add(&bar[XB_TOPGEN], 1u);
            else XB_SPIN(xb_ld(&bar[XB_TOPGEN]) == tg, bar);
            __builtin_amdgcn_fence(__ATOMIC_ACQUIRE, "agent");
            xb_add(&bar[XB_XGEN(b.x)], 1u);
            asm volatile("s_waitcnt vmcnt(0)" ::: "memory");
        } else {
            XB_SPIN(xb_ld(&bar[XB_XGEN(b.x)]) == gen, bar);
            __builtin_amdgcn_fence(__ATOMIC_ACQUIRE, "agent");
            asm volatile("s_waitcnt vmcnt(0)" ::: "memory");
        }
    }
    __syncthreads();
}

namespace g8 {
constexpr int BM = 256, BK = 64, HALF = 128, HTB = HALF * BK * 2, STAGE_BYTES = 8 * HTB, NXCD = 8, WGM = 8;
__host__ __device__ __forceinline__ int lds_byte(int r, int c) { const int st = (r >> 4) * 2 + (c >> 5), rr = r & 15, cc = c & 31, ob = rr * 64 + cc * 2; return st * 1024 + (ob ^ (((ob >> 9) & 1) << 5)); }
__host__ __device__ __forceinline__ void stage_rc(int b, int& R, int& C) { const int st = b / 1024, sb = b % 1024, swz = sb ^ (((sb >> 9) & 1) << 5); R = (st >> 1) * 16 + swz / 64; C = (st & 1) * 32 + (swz % 64) / 2; }
__host__ __device__ __forceinline__ int perm32(int rho) { const int n = rho >> 4, i = rho & 15; return 8 * (i >> 2) + 4 * n + (i & 3); }

struct Unit { int pm, pn, gp; unsigned boff; int aux; int kt; unsigned koff; int ks; };
struct Gemm { const bf16_t* A; const bf16_t* Bt; int K; const int* rowtab; const unsigned char* smeta; const unsigned char* sstat; };

struct DenseOrder {
    int nM, nN, nwg, G, c, K;
    __device__ void init(int nM_, int nN_, int K_, int G_, int c_) { nM = nM_; nN = nN_; nwg = nM * nN; G = G_; c = c_; K = K_; }
    __device__ bool next(int i, Unit& u) const {
        const long L = (long)i * G + c; if (L >= nwg) return false;
        int wgid = (int)L; { const int q = nwg / NXCD, r = nwg % NXCD, xcd = wgid % NXCD, off = wgid / NXCD; wgid = (xcd < r ? xcd * (q + 1) : r * (q + 1) + (xcd - r) * q) + off; }
        const int nig = WGM * nN, gid = wgid / nig, fm = gid * WGM, gsz = (nM - fm) < WGM ? (nM - fm) : WGM;
        u.pm = fm + ((wgid % nig) % gsz); u.pn = (wgid % nig) / gsz; u.gp = u.pm; u.boff = (unsigned)u.pn * (unsigned)(256 * K * 2); u.kt = K / BK; u.koff = 0u; u.ks = -1; return true;
    }
};
struct MoeOrder {
    int p0, np, nN, G, c, K; unsigned estride; int pend[NE]; int nfull, nsplit;
    __device__ bool next(int i, Unit& u) const {
        const long L = (long)i * G + c; const long nmain = (long)nfull * nN;
        int pn, pml, ks = -1;
        if (L < nmain) { pn = (int)(L / nfull); pml = (int)(L % nfull); }
        else { const long r = L - nmain; if (r >= (long)(np - nfull) * nN * nsplit) return false;
            ks = (int)(r % nsplit); const int q = (int)(r / nsplit); pn = q % nN; pml = nfull + q / nN; if (nsplit == 1) ks = -1; }
        const int gp = p0 + pml;
        int e = 0;
#pragma unroll
        for (int j = 0; j < NE - 1; ++j) e += (gp >= pend[j]) ? 1 : 0;
        const int ktall = K / BK;
        u.pm = pml; u.pn = pn; u.gp = gp; u.ks = ks; u.kt = ks < 0 ? ktall : ktall / nsplit; u.koff = ks < 0 ? 0u : (unsigned)(ks * (K / nsplit) * 2);
        u.boff = (unsigned)e * estride + (unsigned)pn * (unsigned)(256 * K * 2) + u.koff; return true;
    }
};

template <class Epi, class Sched, bool GATHER, int META = 0>
__device__ __forceinline__ void gemm_phase(LAS unsigned char* lds, const Gemm g, const Sched& S, const Epi& E) {
    const int tid = threadIdx.x, wid = __builtin_amdgcn_readfirstlane(tid >> 6), lane = tid & 63, wr = wid >> 2, wc = wid & 3, fr = lane & 15, fq = lane >> 4;
    const int K = g.K;
    int Rr[2], Cc[2]; unsigned voffA[2], voffB[2];
#pragma unroll
    for (int i = 0; i < 2; ++i) { stage_rc(tid * 16 + i * 8192, Rr[i], Cc[i]); const int Rb = (Rr[i] & ~31) + perm32(Rr[i] & 31);
        voffA[i] = (unsigned)(Rr[i] * K + Cc[i]) * 2u; voffB[i] = (unsigned)(Rb * K + Cc[i]) * 2u; }
    const size_t kstep = (size_t)(BK * 2);
    const size_t hstep = (size_t)HALF * K * 2;
    const size_t tstep = 2 * hstep;
    const unsigned ldsw = (unsigned)wid * 1024u;
    const int aoff = lds_byte(wr * 64 + fr, fq * 8), boff = lds_byte(wc * 32 + fr, fq * 8);
#define G8_SA(b, h) (((b) * 2 + (h)) * HTB)
#define G8_SB(b, h) ((4 + (b) * 2 + (h)) * HTB)
#define G8_STAGE(bufoff, gbase, voff) do { _Pragma("unroll") for (int _i = 0; _i < 2; ++_i) \
        __builtin_amdgcn_global_load_lds((const unsigned*)((const char*)(gbase) + (voff)[_i]), (LAS unsigned*)(lds + (bufoff) + ldsw + _i * 8192), 16, 0, 0); } while (0)
#define G8_STA(bufoff, ptr, offs, h) do { if constexpr (GATHER) { G8_STAGE(bufoff, (const char*)g.A, (offs)[h]); } else { G8_STAGE(bufoff, (ptr) + (h) * hstep, voffA); } } while (0)
#define G8_LDA(dst, b, h) do { _Pragma("unroll") for (int m = 0; m < 4; ++m) _Pragma("unroll") for (int k = 0; k < 2; ++k) dst[m][k] = *(const LAS bf16x8*)(lds + G8_SA(b, h) + aoff + m * 2048 + k * 1024); } while (0)
#define G8_LDB(dst, b, h) do { _Pragma("unroll") for (int n = 0; n < 2; ++n) _Pragma("unroll") for (int k = 0; k < 2; ++k) dst[n][k] = *(const LAS bf16x8*)(lds + G8_SB(b, h) + boff + n * 2048 + k * 1024); } while (0)
#define G8_MMA(ai, bj, At, Bt) do { __builtin_amdgcn_s_setprio(1); _Pragma("unroll") for (int m = 0; m < 4; ++m) _Pragma("unroll") for (int n = 0; n < 2; ++n) _Pragma("unroll") for (int k = 0; k < 2; ++k) \
        acc[ai][bj][m][n] = __builtin_amdgcn_mfma_f32_16x16x32_bf16(Bt[n][k], At[m][k], acc[ai][bj][m][n], 0, 0, 0); __builtin_amdgcn_s_setprio(0); } while (0)
#define G8_WAIT_V(n) asm volatile("s_waitcnt vmcnt(" #n ")" ::: "memory")
#define G8_WAIT_L(n) asm volatile("s_waitcnt lgkmcnt(" #n ")" ::: "memory")
#define G8_BAR __builtin_amdgcn_s_barrier()
#define G8_SCHED __builtin_amdgcn_sched_barrier(0)
#define G8_ROWOFFS(dst, U) do { _Pragma("unroll") for (int _h = 0; _h < 2; ++_h) _Pragma("unroll") for (int _i = 0; _i < 2; ++_i) { \
        const int _id = g.rowtab[2 * ((U).gp * 256 + _h * 128 + Rr[_i])]; const int _tk = _id < 0 ? 0 : (_id >> 1); dst[_h][_i] = (unsigned)(_tk * K + Cc[_i]) * 2u; } } while (0)
#define G8_META_DMA(gsrc, panel, bufidx) __builtin_amdgcn_global_load_lds((const unsigned*)((gsrc) + (size_t)(panel) * 2048 + wid * 256 + lane * 4), (LAS unsigned*)(lds + LDS_META + (bufidx) * 2048 + wid * 256), 4, 0, 0)
    Unit cur, nxt; int ui = 0;
    if (!S.next(0, cur)) return;
    f32x4 acc[2][2][4][2];
#pragma unroll
    for (int a = 0; a < 2; ++a)
#pragma unroll
        for (int b = 0; b < 2; ++b)
#pragma unroll
            for (int m = 0; m < 4; ++m)
#pragma unroll
                for (int n = 0; n < 2; ++n) acc[a][b][m][n] = (f32x4){0.f, 0.f, 0.f, 0.f};
    bf16x8 At[4][2], B0[2][2], B1[2][2];
    const char* cA = (const char*)g.A + (size_t)cur.pm * tstep + cur.koff; const char* cB = (const char*)g.Bt + cur.boff;
    unsigned oc[2][2], on[2][2], o1[2][2], o2[2][2], o3[2][2];
    if constexpr (GATHER) { G8_ROWOFFS(oc, cur);
#pragma unroll
        for (int h = 0; h < 2; ++h)
#pragma unroll
            for (int i = 0; i < 2; ++i) { o1[h][i] = oc[h][i] + 128u; on[h][i] = oc[h][i]; o2[h][i] = 0; o3[h][i] = 0; } }
    G8_STAGE(G8_SB(0, 0), cB, voffB); G8_STAGE(G8_SB(0, 1), cB + hstep, voffB); G8_STA(G8_SA(0, 0), cA, oc, 0); G8_STA(G8_SA(0, 1), cA, oc, 1);
    if (wr == 1) G8_BAR;
    G8_WAIT_V(2); G8_BAR;
    G8_STAGE(G8_SB(1, 0), cB + kstep, voffB); G8_STA(G8_SA(1, 0), cA + kstep, o1, 0); G8_STAGE(G8_SB(1, 1), cB + hstep + kstep, voffB);
    G8_WAIT_V(6); G8_BAR;
    for (;;) {
        const bool has_next = S.next(ui + 1, nxt);
        const char* nA = has_next ? (const char*)g.A + (size_t)nxt.pm * tstep + nxt.koff : cA; const char* nB = has_next ? (const char*)g.Bt + nxt.boff : cB;
        const int nt = cur.kt;
        if constexpr (META == 1) { if (has_next) G8_META_DMA(g.smeta, nxt.gp, (ui + 1) & 1); G8_META_DMA(g.sstat, cur.gp, 2 + (ui & 1)); }
        if constexpr (META == 2) { G8_META_DMA(g.smeta, cur.gp, ui & 1); }
        if constexpr (META == 3) { G8_META_DMA(g.sstat, cur.pm, 2 + (ui & 1)); }
        for (int t = 0; t < nt; t += 2) {
            const bool last = (t == nt - 2);
            const char* a1 = cA + (size_t)(t + 1) * kstep;
            const char* a2 = last ? nA : cA + (size_t)(t + 2) * kstep; const char* b2 = last ? nB : cB + (size_t)(t + 2) * kstep;
            const char* a3 = a2 + kstep; const char* b3 = b2 + kstep;
            if constexpr (GATHER) {
                if (last) {
#pragma unroll
                    for (int h = 0; h < 2; ++h)
#pragma unroll
                        for (int i = 0; i < 2; ++i) { int id = -1; if (has_next) id = *(const LAS int*)(lds + LDS_META + ((ui + 1) & 1) * 2048 + (h * 128 + Rr[i]) * 8);
                            const int tk = id < 0 ? 0 : (id >> 1); on[h][i] = has_next ? (unsigned)(tk * K + Cc[i]) * 2u : oc[h][i]; } }
#pragma unroll
                for (int h = 0; h < 2; ++h)
#pragma unroll
                    for (int i = 0; i < 2; ++i) { o1[h][i] = oc[h][i] + (unsigned)(t + 1) * 128u; o2[h][i] = last ? on[h][i] : oc[h][i] + (unsigned)(t + 2) * 128u; o3[h][i] = o2[h][i] + 128u; } }
            G8_LDB(B0, 0, 0); G8_LDB(B1, 0, 1); G8_SCHED; G8_LDA(At, 0, 0); G8_STA(G8_SA(1, 1), a1, o1, 1);
            G8_WAIT_V(8); G8_WAIT_L(0); G8_BAR; G8_MMA(0, 0, At, B0); G8_MMA(0, 1, At, B1); G8_BAR; G8_SCHED;
            G8_LDA(At, 0, 1); G8_STAGE(G8_SB(0, 0), b2, voffB); G8_STAGE(G8_SB(0, 1), b2 + hstep, voffB); G8_STA(G8_SA(0, 0), a2, o2, 0);
            G8_WAIT_V(8); G8_WAIT_L(0); G8_BAR; G8_MMA(1, 0, At, B0); G8_MMA(1, 1, At, B1); G8_BAR; G8_SCHED;
            G8_LDB(B0, 1, 0); G8_LDB(B1, 1, 1); G8_SCHED; G8_LDA(At, 1, 0); G8_STA(G8_SA(0, 1), a2, o2, 1);
            G8_WAIT_V(8); G8_WAIT_L(0); G8_BAR; G8_MMA(0, 0, At, B0); G8_MMA(0, 1, At, B1); G8_BAR; G8_SCHED;
            G8_LDA(At, 1, 1); G8_STAGE(G8_SB(1, 0), b3, voffB); G8_STAGE(G8_SB(1, 1), b3 + hstep, voffB); G8_STA(G8_SA(1, 0), a3, o3, 0);
            G8_WAIT_V(8); G8_WAIT_L(0); G8_BAR; G8_MMA(1, 0, At, B0); G8_MMA(1, 1, At, B1); G8_BAR; G8_SCHED;
        }
        if (wr == 0) G8_BAR;
        cur.aux = ui & 1;
        E(acc, cur, wr, wc, fr, fq);
        if (!has_next) break;
#pragma unroll
        for (int a = 0; a < 2; ++a)
#pragma unroll
            for (int b = 0; b < 2; ++b)
#pragma unroll
                for (int m = 0; m < 4; ++m)
#pragma unroll
                    for (int n = 0; n < 2; ++n) acc[a][b][m][n] = (f32x4){0.f, 0.f, 0.f, 0.f};
        cur = nxt; cA = nA; cB = nB; ++ui;
        if constexpr (GATHER) {
#pragma unroll
            for (int h = 0; h < 2; ++h)
#pragma unroll
                for (int i = 0; i < 2; ++i) oc[h][i] = on[h][i]; }
        if (wr == 1) G8_BAR;
    }
    G8_WAIT_V(0);
    G8_BAR;
#undef G8_SA
#undef G8_SB
#undef G8_STAGE
#undef G8_STA
#undef G8_LDA
#undef G8_LDB
#undef G8_MMA
#undef G8_WAIT_V
#undef G8_WAIT_L
#undef G8_BAR
#undef G8_SCHED
#undef G8_ROWOFFS
#undef G8_META_DMA
}

typedef f32x4 Acc[2][2][4][2];
__device__ __forceinline__ u32x4 pack8(const f32x4 a, const f32x4 b) { u32x4 w; w.x = pk2(a[0], a[1]); w.y = pk2(a[2], a[3]); w.z = pk2(b[0], b[1]); w.w = pk2(b[2], b[3]); return w; }
__device__ __forceinline__ void unpack8(const u32x4 w, float (&f)[8]) { f[0] = bflo(w.x); f[1] = bfhi(w.x); f[2] = bflo(w.y); f[3] = bfhi(w.y); f[4] = bflo(w.z); f[5] = bfhi(w.z); f[6] = bflo(w.w); f[7] = bfhi(w.w); }
__device__ __forceinline__ void row_stats(const float* st, int row, int fq, float& mu, float& rstd) {
    const f32x4* p = (const f32x4*)(st + (size_t)row * 32 + fq * 8);
    const f32x4 a = p[0], b = p[1];
    float s1 = (a[0] + a[2]) + (b[0] + b[2]), s2 = (a[1] + a[3]) + (b[1] + b[3]);
    s1 += __shfl_xor(s1, 16); s1 += __shfl_xor(s1, 32); s2 += __shfl_xor(s2, 16); s2 += __shfl_xor(s2, 32);
    mu = s1 * (1.0f / 1024.0f); const float var = fmaxf(s2 * (1.0f / 1024.0f) - mu * mu, 0.f); rstd = rsqrtf(var + LN_EPS);
}
__device__ __forceinline__ void put_stats(float* st, int row, int slot, int fq, float s1, float s2) {
    s1 = fq_sum(s1); s2 = fq_sum(s2);
    if (fq == 0) *(f32x2*)(st + (size_t)row * 32 + slot * 2) = (f32x2){s1, s2};
}

struct EpiPlain {
    bf16_t* O; int ldc;
    __device__ __forceinline__ void operator()(const Acc& acc, const Unit& u, int wr, int wc, int fr, int fq) const {
        const int row0 = u.pm * 256 + wr * 64 + fr, col0 = u.pn * 256 + wc * 32 + 8 * fq;
#pragma unroll
        for (int ai = 0; ai < 2; ++ai)
#pragma unroll
            for (int m = 0; m < 4; ++m) { bf16_t* rowp = O + (size_t)(row0 + ai * 128 + m * 16) * ldc + col0;
#pragma unroll
                for (int bj = 0; bj < 2; ++bj) *(u32x4*)(rowp + bj * 128) = pack8(acc[ai][bj][m][0], acc[ai][bj][m][1]); }
    }
};
template <int MODE> struct EpiRes {
    bf16_t* Z; const bf16_t* Rsrc; float* st_out; LAS unsigned char* ldsm; const float* g; const float* b;
    __device__ __forceinline__ void operator()(const Acc& acc, const Unit& u, int wr, int wc, int fr, int fq) const {
        const int r0 = wr * 64 + fr, col0 = u.pn * 256 + wc * 32 + 8 * fq;
        f32x4 gv[2][2], bv[2][2];
        if (MODE == 1) {
#pragma unroll
            for (int bj = 0; bj < 2; ++bj)
#pragma unroll
                for (int n = 0; n < 2; ++n) { gv[bj][n] = *(const f32x4*)(g + col0 + bj * 128 + 4 * n); bv[bj][n] = *(const f32x4*)(b + col0 + bj * 128 + 4 * n); }
        }
        u32x4 rwa[4][4][2];
#define EPR_LOAD(am_) do { _Pragma("unroll") for (int m = 2 * ((am_) & 1); m < 2 * ((am_) & 1) + 2; ++m) _Pragma("unroll") for (int bj = 0; bj < 2; ++bj) \
            rwa[am_][m][bj] = *(const u32x4*)(Rsrc + ((size_t)u.pm * 256 + r0 + ((am_) >> 1) * 128 + m * 16) * D + col0 + bj * 128); } while (0)
        EPR_LOAD(0);
#pragma unroll
        for (int am = 0; am < 4; ++am) { const int ai = am >> 1;
            if (am + 1 < 4) EPR_LOAD(am + 1);
            u32x4 (&rw)[4][2] = rwa[am];
#pragma unroll
            for (int m = 2 * (am & 1); m < 2 * (am & 1) + 2; ++m) {
                const int rl = r0 + ai * 128 + m * 16; const size_t row = (size_t)u.pm * 256 + rl;
                float mu = 0.f, rstd = 1.f;
                if (MODE == 1) { const f32x2 ms = *(const LAS f32x2*)(ldsm + (2 + u.aux) * 2048 + rl * 8); mu = ms[0]; rstd = ms[1]; }
                float s1 = 0.f, s2 = 0.f;
#pragma unroll
                for (int bj = 0; bj < 2; ++bj) {
                    float r[8]; unpack8(rw[m][bj], r);
                    f32x4 v0, v1;
#pragma unroll
                    for (int j = 0; j < 4; ++j) {
                        float h0 = r[j], h1 = r[4 + j];
                        if (MODE == 1) { h0 = (h0 - mu) * rstd * gv[bj][0][j] + bv[bj][0][j]; h1 = (h1 - mu) * rstd * gv[bj][1][j] + bv[bj][1][j]; }
                        v0[j] = ALPHA * h0 + acc[ai][bj][m][0][j]; v1[j] = ALPHA * h1 + acc[ai][bj][m][1][j];
                    }
                    const u32x4 w = pack8(v0, v1);
                    *(u32x4*)(Z + row * D + col0 + bj * 128) = w;
                    float q[8]; unpack8(w, q);
#pragma unroll
                    for (int j = 0; j < 8; ++j) { s1 += q[j]; s2 += q[j] * q[j]; }
                }
                put_stats(st_out, (int)row, u.pn * 4 + wc, fq, s1, s2);
            }
        }
    }
};
struct EpiFold {
    bf16_t* O; int ldc; LAS unsigned char* ldsm; const float* cs; const float* bw;
    __device__ __forceinline__ void operator()(const Acc& acc, const Unit& u, int wr, int wc, int fr, int fq) const {
        const int r0 = wr * 64 + fr, col0 = u.pn * 256 + wc * 32 + 8 * fq;
        f32x4 cv[2][2], bv[2][2];
#pragma unroll
        for (int bj = 0; bj < 2; ++bj)
#pragma unroll
            for (int n = 0; n < 2; ++n) { cv[bj][n] = *(const f32x4*)(cs + col0 + bj * 128 + 4 * n); bv[bj][n] = *(const f32x4*)(bw + col0 + bj * 128 + 4 * n); }
#pragma unroll
        for (int ai = 0; ai < 2; ++ai)
#pragma unroll
            for (int m = 0; m < 4; ++m) {
                const int rl = r0 + ai * 128 + m * 16; const size_t row = (size_t)u.pm * 256 + rl;
                const f32x2 ms = *(const LAS f32x2*)(ldsm + (2 + u.aux) * 2048 + rl * 8); const float mu = ms[0], rstd = ms[1];
#pragma unroll
                for (int bj = 0; bj < 2; ++bj) {
                    const f32x4 v0 = (acc[ai][bj][m][0] - mu * cv[bj][0]) * rstd + bv[bj][0], v1 = (acc[ai][bj][m][1] - mu * cv[bj][1]) * rstd + bv[bj][1];
                    *(u32x4*)(O + row * ldc + col0 + bj * 128) = pack8(v0, v1);
                }
            }
    }
};
template <bool MOE> struct EpiGlu {
    bf16_t* O; int ldc; const float* st_in; const float* cs; const float* bw; LAS unsigned char* ldsm; int ncs;
    __device__ __forceinline__ void operator()(const Acc& acc, const Unit& u, int wr, int wc, int fr, int fq) const {
        const int row0 = u.pm * 256 + wr * 64 + fr, colo = u.pn * 128 + wc * 32 + 8 * fq;
        int vb = u.pn * 256 + wc * 32 + 8 * fq;
        if (MOE) vb += (int)(u.boff / (unsigned)(256 * D * 2)) * 256 - u.pn * 256;
        f32x4 cv[2][2], bv[2][2];
#pragma unroll
        for (int bj = 0; bj < 2; ++bj)
#pragma unroll
            for (int n = 0; n < 2; ++n) { cv[bj][n] = *(const f32x4*)(cs + vb + bj * 128 + 4 * n); bv[bj][n] = *(const f32x4*)(bw + vb + bj * 128 + 4 * n); }
#pragma unroll
        for (int ai = 0; ai < 2; ++ai)
#pragma unroll
            for (int m = 0; m < 4; ++m) {
                const int row = row0 + ai * 128 + m * 16;
                const f32x2 ms = *(const LAS f32x2*)(ldsm + (2 + u.aux) * 2048 + (row - u.pm * 256) * 8); const float mu = ms[0], rstd = ms[1];
                f32x4 o0, o1;
#pragma unroll
                for (int j = 0; j < 4; ++j) {
                    const float g0 = (acc[ai][0][m][0][j] - mu * cv[0][0][j]) * rstd + bv[0][0][j], g1 = (acc[ai][0][m][1][j] - mu * cv[0][1][j]) * rstd + bv[0][1][j];
                    const float u0 = (acc[ai][1][m][0][j] - mu * cv[1][0][j]) * rstd + bv[1][0][j], u1 = (acc[ai][1][m][1][j] - mu * cv[1][1][j]) * rstd + bv[1][1][j];
                    o0[j] = g0 * sigmoidf_(g0) * u0; o1[j] = g1 * sigmoidf_(g1) * u1;
                }
                *(u32x4*)(O + (size_t)row * ldc + colo) = pack8(o0, o1);
            }
    }
};
struct EpiMoeDown {
    bf16_t* Y0; bf16_t* Y1; LAS unsigned char* ldsm; float* P; int nfull;
    __device__ __forceinline__ void operator()(const Acc& acc, const Unit& u, int wr, int wc, int fr, int fq) const {
        const int r0 = wr * 64 + fr, col0 = u.pn * 256 + wc * 32 + 8 * fq;
        if (u.ks >= 0) {
#pragma unroll
            for (int ai = 0; ai < 2; ++ai)
#pragma unroll
                for (int m = 0; m < 4; ++m) { float* rowp = P + ((size_t)u.ks * 2048 + (size_t)(u.pm - nfull) * 256 + r0 + ai * 128 + m * 16) * D + col0;
#pragma unroll
                    for (int bj = 0; bj < 2; ++bj) { *(f32x4*)(rowp + bj * 128) = acc[ai][bj][m][0]; *(f32x4*)(rowp + bj * 128 + 4) = acc[ai][bj][m][1]; } }
            return;
        }
#pragma unroll
        for (int ai = 0; ai < 2; ++ai)
#pragma unroll
            for (int m = 0; m < 4; ++m) {
                const u32x2 mg = *(const LAS u32x2*)(ldsm + u.aux * 2048 + (r0 + ai * 128 + m * 16) * 8);
                const int id = (int)mg.x; const float gt = __uint_as_float(mg.y);
                if (id >= 0) { bf16_t* rowp = Y0 + (size_t)(id & 1) * (size_t)(Y1 - Y0) + (size_t)(id >> 1) * D + col0;
#pragma unroll
                    for (int bj = 0; bj < 2; ++bj) *(u32x4*)(rowp + bj * 128) = pack8(acc[ai][bj][m][0] * gt, acc[ai][bj][m][1] * gt); }
            }
    }
};
}

struct Args { const float* in[18]; float* out; unsigned char* ws; int ph_lo, ph_hi; };
enum { PH_PRO = 0, PH_PROJ, PH_MLSTM, PH_WOUT, PH_FIN1, PH_GU, PH_DN, PH_FIN2, PH_KVQ, PH_ATT, PH_WO, PH_RT1, PH_RT2, PH_MOE0, PH_FIX = PH_MOE0 + 2 * MOE_NCHUNK, PH_FINAL, PH_COUNT };

__device__ __forceinline__ float logsigmoid_(float x) { return fminf(x, 0.f) - log1pf(expf(-fabsf(x))); }
__device__ __forceinline__ void conv_block(LAS unsigned char* lds, const float* src, int ldw, int K, bf16_t* dst, const float* g, const float* bb, float* cs, float* bw) {
    const int tid = threadIdx.x;
    const int n4 = (tid & 15) * 4, k4 = (tid >> 4) * 4;
    const int rn = tid >> 3, rs = tid & 7;
    float csp[4] = {0.f, 0.f, 0.f, 0.f}, bwp[4] = {0.f, 0.f, 0.f, 0.f};
    const int nch = K / 128;
    LAS float* gs = (LAS float*)(lds + 2 * 64 * 264 + 16384);
    if (g) { for (int i = tid; i < K; i += NTHREADS) { gs[i] = g[i]; gs[K + i] = bb[i]; } __syncthreads(); }
    f32x4 v[4], vn[4];
#pragma unroll
    for (int kk = 0; kk < 4; ++kk) v[kk] = *(const f32x4*)(src + (size_t)(k4 + kk) * ldw + n4);
    for (int ch = 0; ch < nch; ++ch) {
        LAS unsigned char* T = lds + (ch & 1) * (64 * 264);
        if (ch + 1 < nch) {
#pragma unroll
            for (int kk = 0; kk < 4; ++kk) vn[kk] = *(const f32x4*)(src + (size_t)((ch + 1) * 128 + k4 + kk) * ldw + n4); }
        float gk[4] = {1.f, 1.f, 1.f, 1.f}, bk[4] = {0.f, 0.f, 0.f, 0.f};
        if (g) {
#pragma unroll
            for (int kk = 0; kk < 4; ++kk) { gk[kk] = gs[ch * 128 + k4 + kk]; bk[kk] = gs[K + ch * 128 + k4 + kk]; } }
#pragma unroll
        for (int j = 0; j < 4; ++j) {
            const unsigned lo = pk2(v[0][j] * gk[0], v[1][j] * gk[1]), hi = pk2(v[2][j] * gk[2], v[3][j] * gk[3]);
            *(LAS u32x2*)(T + (n4 + j) * 264 + k4 * 2) = (u32x2){lo, hi};
            csp[j] += (bflo(lo) + bfhi(lo)) + (bflo(hi) + bfhi(hi));
            bwp[j] += (v[0][j] * bk[0] + v[1][j] * bk[1]) + (v[2][j] * bk[2] + v[3][j] * bk[3]);
        }
        __syncthreads();
        u32x2 q[4];
#pragma unroll
        for (int i = 0; i < 4; ++i) q[i] = *(const LAS u32x2*)(T + rn * 264 + rs * 32 + i * 8);
        bf16_t* dp = dst + (size_t)rn * K + ch * 128 + rs * 16;
        *(u32x4*)dp = (u32x4){q[0].x, q[0].y, q[1].x, q[1].y};
        *(u32x4*)(dp + 8) = (u32x4){q[2].x, q[2].y, q[3].x, q[3].y};
#pragma unroll
        for (int kk = 0; kk < 4; ++kk) v[kk] = vn[kk];
    }
    __syncthreads();
    if (cs) {
        LAS float* red = (LAS float*)(lds + 2 * 64 * 264);
#pragma unroll
        for (int j = 0; j < 4; ++j) { red[(tid >> 4) * 64 + n4 + j] = csp[j]; red[2048 + (tid >> 4) * 64 + n4 + j] = bwp[j]; }
        __syncthreads();
        if (tid < 128) { const int n = tid & 63, w = tid >> 6; float s = 0.f;
            for (int i = 0; i < 32; ++i) s += red[w * 2048 + i * 64 + n];
            (w ? bw : cs)[n] = s; }
        __syncthreads();
    }
}
__device__ __forceinline__ void conv_job(LAS unsigned char* lds, const Args& a, int blk) {
    unsigned char* ws = a.ws;
    const float* ln_g = a.in[16]; const float* ln_b = a.in[17];
    float* vec = (float*)(ws + WS_VEC);
    const float* src; int ldw, K; bf16_t* dst; const float* g = nullptr; const float* bb = nullptr; float* cs = nullptr; float* bw = nullptr;
    int j = blk;
    if (j < 128) { const int e = j >> 4, jj = j & 15; src = a.in[15] + (size_t)e * FFE * D + 64 * jj; ldw = D; K = FFE; dst = (bf16_t*)(ws + WS_WEDN) + ((size_t)e * D + 64 * jj) * FFE; }
    else if (j < 144) { j -= 128; src = a.in[11] + 64 * j; ldw = D; K = FFD; dst = (bf16_t*)(ws + WS_WDN) + (size_t)(64 * j) * FFD; }
    else if (j < 192) { j -= 144; src = a.in[2] + 64 * j; ldw = 3080; K = D; dst = (bf16_t*)(ws + WS_WIN) + (size_t)(64 * j) * D; }
    else if (j < 208) { j -= 192; src = a.in[5] + 64 * j; ldw = D; K = D; dst = (bf16_t*)(ws + WS_WOUT) + (size_t)(64 * j) * D; }
    else if (j < 296) { j -= 208; const int t = j >> 2, q = j & 3; src = (q < 2 ? a.in[9] : a.in[10]) + 128 * t + 64 * (q & 1); ldw = FFD; K = D; dst = (bf16_t*)(ws + WS_WGU) + (size_t)(64 * j) * D;
        g = ln_g; bb = ln_b; cs = vec + VEC_GU_CS + 64 * j; bw = vec + VEC_GU_BW + 64 * j; }
    else if (j < 344) { j -= 296; src = j < 32 ? a.in[6] + 64 * j : a.in[7] + 64 * (j - 32); ldw = j < 32 ? 2048 : 1024; K = D; dst = (bf16_t*)(ws + WS_WKVQ) + (size_t)(64 * j) * D;
        g = ln_g + 1024; bb = ln_b + 1024; cs = vec + VEC_KVQ_CS + 64 * j; bw = vec + VEC_KVQ_BW + 64 * j; }
    else if (j < 360) { j -= 344; src = a.in[8] + 64 * j; ldw = D; K = D; dst = (bf16_t*)(ws + WS_WO) + (size_t)(64 * j) * D; }
    else { j -= 360; const int e = j / 112, jj = j % 112, t = jj >> 2, q = jj & 3; src = (q < 2 ? a.in[13] : a.in[14]) + (size_t)e * D * FFE + 128 * t + 64 * (q & 1); ldw = FFE; K = D;
        dst = (bf16_t*)(ws + WS_WEGU) + ((size_t)e * 2 * FFE + 64 * jj) * D; g = ln_g + 2048; bb = ln_b + 2048; cs = vec + VEC_EGU_CS + e * 2 * FFE + 64 * jj; bw = vec + VEC_EGU_BW + e * 2 * FFE + 64 * jj; }
    conv_block(lds, src, ldw, K, dst, g, bb, cs, bw);
}
constexpr int EGU0 = 360;
__device__ __forceinline__ void tail_jobs(LAS unsigned char* lds, const Args& a, int phase) {
    const int c = (int)blockIdx.x;
    int j0 = -1;
    if (phase == PH_PROJ) { const int q = c - 12;
        if (q >= 0) j0 = q < 16 ? 128 + q : (q < 184 ? 192 + (q - 16) : EGU0 + (q - 184)); }
    else if (phase == PH_WOUT) { const int q = c - 4; if (q >= 0) j0 = EGU0 + 60 + q; }
    else if (phase == PH_GU) { const int q = c - 22; if (q >= 0) j0 = EGU0 + 312 + q; }
    else if (phase == PH_DN) { const int q = c - 4;
        if (q >= 0 && q < 128) j0 = q;
        else if (q >= 128 && q - 128 < 106) j0 = EGU0 + 546 + (q - 128); }
    else { const int q = c - 12; if (q >= 0) j0 = EGU0 + 652 + q; }
    if (j0 >= 0) conv_job(lds, a, j0);
}
__device__ __forceinline__ void prologue_phase(LAS unsigned char* lds, const Args& a) {
    unsigned char* ws = a.ws;
    const int G = gridDim.x;
    for (int blk = 144 + blockIdx.x; blk < 192; blk += G) conv_job(lds, a, blk);
    {
        const int tid = threadIdx.x, lane = tid & 63, wid = tid >> 6;
        LAS float* wg = (LAS float*)lds;
        __syncthreads();
        const float* w_in = a.in[2];
        for (int i = tid; i < 8192; i += NTHREADS) { const int k = i >> 3, e = i & 7; wg[e * 1024 + k] = w_in[(size_t)k * 3080 + 3072 + e]; }
        __syncthreads();
        bf16_t* H0 = (bf16_t*)(ws + WS_RB); float* gates = (float*)(ws + WS_GATES);
        const float bg = a.in[3][lane & 7];
        f32x4 xv[4], xn[4];
        { const int row = blockIdx.x * 8 + wid; const float* src = row < NR ? a.in[0] + (size_t)row * D : a.in[1] + (size_t)((row - NR) & 15) * D;
#pragma unroll
            for (int i = 0; i < 4; ++i) xv[i] = *(const f32x4*)(src + i * 256 + lane * 4); }
        for (int row = blockIdx.x * 8 + wid; row < NROWS; row += G * 8) {
            { const int rn = row + G * 8;
                if (rn < NROWS) { const float* srcn = rn < NR ? a.in[0] + (size_t)rn * D : a.in[1] + (size_t)((rn - NR) & 15) * D;
#pragma unroll
                    for (int i = 0; i < 4; ++i) xn[i] = *(const f32x4*)(srcn + i * 256 + lane * 4); } }
            float acc[8] = {0.f, 0.f, 0.f, 0.f, 0.f, 0.f, 0.f, 0.f};
#pragma unroll
            for (int i = 0; i < 4; ++i) {
                const int k = i * 256 + lane * 4;
                const f32x4 v = xv[i];
                *(u32x2*)(H0 + (size_t)row * D + k) = (u32x2){pk2(v[0], v[1]), pk2(v[2], v[3])};
#pragma unroll
                for (int e = 0; e < 8; ++e) { const f32x4 w = *(const LAS f32x4*)(wg + e * 1024 + k); acc[e] += (v[0] * w[0] + v[1] * w[1]) + (v[2] * w[2] + v[3] * w[3]); }
            }
#pragma unroll
            for (int i = 0; i < 4; ++i) xv[i] = xn[i];
#pragma unroll
            for (int e = 0; e < 8; ++e) acc[e] = wave_sum(acc[e]);
            float mine = acc[0];
#pragma unroll
            for (int e = 1; e < 8; ++e) mine = ((lane & 7) == e) ? acc[e] : mine;
            if (lane < 8) gates[(size_t)row * 8 + lane] = lane < 4 ? mine + bg : logsigmoid_(mine + bg);
        }
        __syncthreads();
    }
}

__device__ __forceinline__ bf16x8 pack_frag(const f32x16& x, int s) {
    u32x4 p; p.x = pk2(x[8 * s], x[8 * s + 1]); p.y = pk2(x[8 * s + 2], x[8 * s + 3]); p.z = pk2(x[8 * s + 4], x[8 * s + 5]); p.w = pk2(x[8 * s + 6], x[8 * s + 7]);
    return __builtin_bit_cast(bf16x8, p);
}
__device__ __forceinline__ bf16x8 ld2x64(const LAS unsigned char* p0, const LAS unsigned char* p1) {
    const u32x2 a = *(const LAS u32x2*)p0, b = *(const LAS u32x2*)p1; u32x4 r = {a.x, a.y, b.x, b.y}; return __builtin_bit_cast(bf16x8, r);
}
__device__ __forceinline__ void tr4x4(const u32x2 (&r)[4], u32x2 (&c)[4]) {
    c[0] = (u32x2){(r[0].x & 0xffffu) | (r[1].x << 16), (r[2].x & 0xffffu) | (r[3].x << 16)};
    c[1] = (u32x2){(r[0].x >> 16) | (r[1].x & 0xffff0000u), (r[2].x >> 16) | (r[3].x & 0xffff0000u)};
    c[2] = (u32x2){(r[0].y & 0xffffu) | (r[1].y << 16), (r[2].y & 0xffffu) | (r[3].y << 16)};
    c[3] = (u32x2){(r[0].y >> 16) | (r[1].y & 0xffff0000u), (r[2].y >> 16) | (r[3].y & 0xffff0000u)};
}

#define DPP_STEP_ADD(x, ctrl, rmask) x += __builtin_bit_cast(float, __builtin_amdgcn_update_dpp(0, __builtin_bit_cast(int, x), ctrl, rmask, 0xf, false))
#define DPP_STEP_MAX(x, ctrl, rmask) x = fmaxf(x, __builtin_bit_cast(float, __builtin_amdgcn_update_dpp((int)0xff800000, __builtin_bit_cast(int, x), ctrl, rmask, 0xf, false)))
__device__ __forceinline__ float scan_add64(float x) { DPP_STEP_ADD(x, 0x111, 0xf); DPP_STEP_ADD(x, 0x112, 0xf); DPP_STEP_ADD(x, 0x114, 0xf); DPP_STEP_ADD(x, 0x118, 0xf); DPP_STEP_ADD(x, 0x142, 0xa); DPP_STEP_ADD(x, 0x143, 0xc); return x; }
__device__ __forceinline__ float scan_max64(float x) { DPP_STEP_MAX(x, 0x111, 0xf); DPP_STEP_MAX(x, 0x112, 0xf); DPP_STEP_MAX(x, 0x114, 0xf); DPP_STEP_MAX(x, 0x118, 0xf); DPP_STEP_MAX(x, 0x142, 0xa); DPP_STEP_MAX(x, 0x143, 0xc); return x; }
__device__ __forceinline__ float wave_total(float x);
__device__ __forceinline__ float lane63(float x) { return __builtin_bit_cast(float, __builtin_amdgcn_readlane(__builtin_bit_cast(int, x), 63)); }
__device__ __forceinline__ float wave_total(float x) { return lane63(scan_add64(x)); }
constexpr int ML_QS = 0, ML_KS = 17408, ML_PS = 34816, ML_VT = 44032, ML_KT = 78848, ML_SC = 96256;
#ifndef ML_N0
#define ML_N0 23
#define ML_N1 18
#define ML_N2 14
#endif
__device__ __forceinline__ void mlstm_phase(LAS unsigned char* lds, const bf16_t* qkvo, const float* gates, const float* normg, bf16_t* hn, int unit_) {
    const int unit = unit_ >> 2, part_ = unit_ & 3;
    const int c_begin = part_ == 0 ? 0 : (part_ == 1 ? ML_N0 : (part_ == 2 ? ML_N0 + ML_N1 : ML_N0 + ML_N1 + ML_N2));
    const int c_end = part_ == 0 ? ML_N0 : (part_ == 1 ? ML_N0 + ML_N1 : (part_ == 2 ? ML_N0 + ML_N1 + ML_N2 : 65));
    const int tid = threadIdx.x, lane = tid & 63, wid = __builtin_amdgcn_readfirstlane(tid >> 6);
    const int b = unit >> 2, h = unit & 3;
    const int r32 = lane & 31, hh = lane >> 5, l15 = lane & 15, l4 = lane >> 4;
    LAS float* sc = (LAS float*)(lds + ML_SC);
    LAS float* Hs = (LAS float*)lds;
    const int q_row = tid >> 4, q_col = (tid & 15) * 8;
    const int k_dk = (16 * (wid & 1) + l15) * 4, k_s = (4 * (wid >> 1) + l4) * 4;
    const int v_dv = (16 * (wid & 3) + l15) * 4, v_s0 = (4 * (wid >> 2) + l4) * 4;
    f32x16 Cacc[4];
#pragma unroll
    for (int i = 0; i < 4; ++i)
#pragma unroll
        for (int j = 0; j < 16; ++j) Cacc[i][j] = 0.f;
    if (tid < 128) sc[192 + tid] = 0.f;
    float m_run = 0.f;
    u32x4 qreg[2]; u32x2 kreg[4], vreg[2][4]; float g_li = 0.f, g_lf = 0.f;
#define rowof(c, t) ((c) == 0 ? (NR + b * 16 + ((t) - 48)) : (b * SEQ + 64 * ((c) - 1) + (t)))
#define ML_PREFETCH(c) do { \
        if ((c) >= c_begin) _Pragma("unroll") for (int p = 0; p < 2; ++p) { const int t = q_row + 32 * p; const bool pad = ((c) == 0 && t < 48); \
            qreg[p] = pad ? (u32x4){0u, 0u, 0u, 0u} : *(const u32x4*)(qkvo + (size_t)rowof((c), t) * NPROJ + h * 128 + q_col); } \
        _Pragma("unroll") for (int kk = 0; kk < 4; ++kk) { const int t = k_s + kk; const bool pad = ((c) == 0 && t < 48); \
            kreg[kk] = pad ? (u32x2){0u, 0u} : *(const u32x2*)(qkvo + (size_t)rowof((c), t) * NPROJ + 512 + h * 128 + k_dk); } \
        _Pragma("unroll") for (int p = 0; p < 2; ++p) _Pragma("unroll") for (int kk = 0; kk < 4; ++kk) { const int t = v_s0 + 32 * p + kk; const bool pad = ((c) == 0 && t < 48); \
            vreg[p][kk] = pad ? (u32x2){0u, 0u} : *(const u32x2*)(qkvo + (size_t)rowof((c), t) * NPROJ + 1024 + h * 256 + v_dv); } \
        { const bool pad = ((c) == 0 && lane < 48); g_li = pad ? -1e30f : gates[(size_t)rowof((c), lane) * 8 + h]; g_lf = pad ? 0.f : gates[(size_t)rowof((c), lane) * 8 + 4 + h]; } } while (0)
    ML_PREFETCH(0);
    for (int c = 0; c < c_end; ++c) {
        const bool full = (c >= c_begin);
        const float li = g_li;
        const float lf = g_lf;
        const float bc = scan_add64(lf);
        const float av = li - bc;
        const float um = scan_max64(av);
        const float Mt = fmaxf(m_run, um);
        const float winter = __expf(m_run - Mt), bmt = bc + Mt;
        const float M63 = lane63(Mt), b63 = lane63(bc);
        const float wlast = __expf(av - M63), decay = __expf(m_run - M63);
        if (full) {
#pragma unroll
        for (int p = 0; p < 2; ++p) *(LAS u32x4*)(lds + ML_QS + (q_row + 32 * p) * 272 + q_col * 2) = qreg[p]; }
        {
            u32x2 kw[4];
#pragma unroll
            for (int kk = 0; kk < 4; ++kk) {
                if (full) *(LAS u32x2*)(lds + ML_KS + (k_s + kk) * 272 + k_dk * 2) = kreg[kk];
                const float w = __shfl(wlast, k_s + kk) * 0.08838834764831845f;
                kw[kk] = (u32x2){pk2(bflo(kreg[kk].x) * w, bfhi(kreg[kk].x) * w), pk2(bflo(kreg[kk].y) * w, bfhi(kreg[kk].y) * w)};
            }
            u32x2 kc[4]; tr4x4(kw, kc);
#pragma unroll
            for (int j = 0; j < 4; ++j) *(LAS u32x2*)(lds + ML_KT + (k_dk + j) * 136 + k_s * 2) = kc[j];
        }
#pragma unroll
        for (int p = 0; p < 2; ++p) { u32x2 vc[4]; tr4x4(vreg[p], vc);
#pragma unroll
            for (int j = 0; j < 4; ++j) *(LAS u32x2*)(lds + ML_VT + (v_dv + j) * 136 + (v_s0 + 32 * p) * 2) = vc[j]; }
        if (wid == 0) { sc[lane] = winter; sc[128 + lane] = bmt; }
        __syncthreads();
        if (c + 1 < c_end) ML_PREFETCH(c + 1);
        if (full) {
            const int ti = wid >> 1;
#pragma unroll
            for (int q = 0; q < 2; ++q) {
                const int si = 2 * (wid & 1) + q;
                f32x4 sa = {0.f, 0.f, 0.f, 0.f};
                if (si <= ti) {
#pragma unroll
                    for (int ks = 0; ks < 4; ++ks) {
                        const bf16x8 af = *(const LAS bf16x8*)(lds + ML_QS + (16 * ti + l15) * 272 + (32 * ks + 8 * l4) * 2);
                        const bf16x8 bfr = *(const LAS bf16x8*)(lds + ML_KS + (16 * si + l15) * 272 + (32 * ks + 8 * l4) * 2);
                        sa = __builtin_amdgcn_mfma_f32_16x16x32_bf16(af, bfr, sa, 0, 0, 0);
                    }
                }
                const int s = 16 * si + l15;
                const float a_s = __shfl(av, s);
#pragma unroll
                for (int r = 0; r < 4; ++r) {
                    const int t = 16 * ti + 4 * l4 + r;
                    const float Mtt = __shfl(Mt, t);
                    const float w = (s <= t) ? __expf(a_s - Mtt) : 0.f;
                    *(LAS bf16_t*)(lds + ML_PS + t * 144 + s * 2) = f2bf(sa[r] * 0.08838834764831845f * w);
                }
            }
        }
        bf16x8 vf[4];
#pragma unroll
        for (int ks = 0; ks < 4; ++ks) { const LAS unsigned char* p = lds + ML_VT + (32 * wid + r32) * 136 + (16 * ks + 8 * hh) * 2; vf[ks] = ld2x64(p, p + 8); }
        if (full) {
        __syncthreads();
        {
            const int t = tid >> 3, part = tid & 7;
            float qn = 0.f, ps = 0.f;
            const u32x4 q0 = *(const LAS u32x4*)(lds + ML_QS + t * 272 + part * 32), q1 = *(const LAS u32x4*)(lds + ML_QS + t * 272 + part * 32 + 16);
            float qv[16]; { float t8[8]; g8::unpack8(q0, t8);
#pragma unroll
                for (int j = 0; j < 8; ++j) qv[j] = t8[j]; g8::unpack8(q1, t8);
#pragma unroll
                for (int j = 0; j < 8; ++j) qv[8 + j] = t8[j]; }
#pragma unroll
            for (int j = 0; j < 16; ++j) qn += qv[j] * sc[192 + part * 16 + j];
            const u32x4 pw = *(const LAS u32x4*)(lds + ML_PS + t * 144 + part * 16);
            float pv[8]; g8::unpack8(pw, pv);
#pragma unroll
            for (int j = 0; j < 8; ++j) ps += pv[j];
            qn += __shfl_xor(qn, 1); qn += __shfl_xor(qn, 2); qn += __shfl_xor(qn, 4);
            ps += __shfl_xor(ps, 1); ps += __shfl_xor(ps, 2); ps += __shfl_xor(ps, 4);
            if (part == 0) { const float den = sc[t] * qn + ps; sc[64 + t] = __builtin_amdgcn_rcpf(fmaxf(fabsf(den), __expf(-sc[128 + t]))); }
        }
        f32x16 num[2];
#pragma unroll
        for (int tt = 0; tt < 2; ++tt) {
#pragma unroll
            for (int j = 0; j < 16; ++j) num[tt][j] = 0.f;
#pragma unroll
            for (int dkt = 0; dkt < 4; ++dkt)
#pragma unroll
                for (int s2 = 0; s2 < 2; ++s2) {
                    const LAS unsigned char* p = lds + ML_QS + (32 * tt + r32) * 272 + (32 * dkt + 16 * s2 + 4 * hh) * 2;
                    const bf16x8 af = ld2x64(p, p + 16);
                    num[tt] = __builtin_amdgcn_mfma_f32_32x32x16_bf16(af, pack_frag(Cacc[dkt], s2), num[tt], 0, 0, 0);
                }
#pragma unroll
            for (int gq = 0; gq < 4; ++gq) { const f32x4 wv = *(const LAS f32x4*)(sc + 32 * tt + 8 * gq + 4 * hh);
#pragma unroll
                for (int r = 0; r < 4; ++r) num[tt][4 * gq + r] *= wv[r]; }
#pragma unroll
            for (int ks = 0; ks < 4; ++ks) {
                if (tt == 0 && ks >= 2) continue;
                const bf16x8 pf = *(const LAS bf16x8*)(lds + ML_PS + (32 * tt + r32) * 144 + (16 * ks + 8 * hh) * 2);
                num[tt] = __builtin_amdgcn_mfma_f32_32x32x16_bf16(pf, vf[ks], num[tt], 0, 0, 0);
            }
        }
        __syncthreads();
        u32x2 oreg[8];
        { const int t = tid >> 3, part = tid & 7; const bool pad = (c == 0 && t < 48); const size_t row = pad ? 0 : (size_t)rowof(c, t);
#pragma unroll
            for (int i = 0; i < 8; ++i) oreg[i] = *(const u32x2*)(qkvo + row * NPROJ + 2048 + h * 256 + 32 * i + 4 * part); }
#pragma unroll
        for (int tt = 0; tt < 2; ++tt)
#pragma unroll
            for (int gq = 0; gq < 4; ++gq) { const f32x4 iv = *(const LAS f32x4*)(sc + 64 + 32 * tt + 8 * gq + 4 * hh);
#pragma unroll
                for (int r = 0; r < 4; ++r) Hs[(32 * tt + 8 * gq + 4 * hh + r) * 260 + 32 * wid + r32] = num[tt][4 * gq + r] * iv[r]; }
        __syncthreads();
        {
            const int t = tid >> 3, part = tid & 7;
            f32x4 x[8]; float s1 = 0.f;
#pragma unroll
            for (int i = 0; i < 8; ++i) { x[i] = *(const LAS f32x4*)(Hs + t * 260 + 32 * i + 4 * part); s1 += (x[i][0] + x[i][1]) + (x[i][2] + x[i][3]); }
            s1 += __shfl_xor(s1, 1); s1 += __shfl_xor(s1, 2); s1 += __shfl_xor(s1, 4);
            const float mean = s1 * (1.0f / 256.0f); float s2 = 0.f;
#pragma unroll
            for (int i = 0; i < 8; ++i) { const f32x4 d = x[i] - mean; s2 += (d[0] * d[0] + d[1] * d[1]) + (d[2] * d[2] + d[3] * d[3]); }
            s2 += __shfl_xor(s2, 1); s2 += __shfl_xor(s2, 2); s2 += __shfl_xor(s2, 4);
            const float rstd = rsqrtf(s2 * (1.0f / 256.0f) + LN_EPS);
            if (!(c == 0 && t < 48)) {
                const size_t row = (size_t)rowof(c, t);
#pragma unroll
                for (int i = 0; i < 8; ++i) {
                    const int dv = 32 * i + 4 * part;
                    const u32x2 ow = oreg[i];
                    const f32x4 ng = *(const f32x4*)(normg + h * 256 + dv);
                    const float o0 = sigmoidf_(bflo(ow.x)), o1 = sigmoidf_(bfhi(ow.x)), o2 = sigmoidf_(bflo(ow.y)), o3 = sigmoidf_(bfhi(ow.y));
                    const f32x4 y = (x[i] - mean) * rstd * ng;
                    *(u32x2*)(hn + row * D + h * 256 + dv) = (u32x2){pk2(y[0] * o0, y[1] * o1), pk2(y[2] * o2, y[3] * o3)};
                }
            }
        }
        }
#pragma unroll
        for (int dkt = 0; dkt < 4; ++dkt) {
#pragma unroll
            for (int j = 0; j < 16; ++j) Cacc[dkt][j] *= decay;
#pragma unroll
            for (int ks = 0; ks < 4; ++ks) { const LAS unsigned char* p = lds + ML_KT + (32 * dkt + r32) * 136 + (16 * ks + 8 * hh) * 2;
                Cacc[dkt] = __builtin_amdgcn_mfma_f32_32x32x16_bf16(ld2x64(p, p + 8), vf[ks], Cacc[dkt], 0, 0, 0); }
        }
        {
            const int dk = tid >> 2, part = tid & 3;
            const u32x2 k0 = *(const LAS u32x2*)(lds + ML_KT + dk * 136 + part * 32), k1 = *(const LAS u32x2*)(lds + ML_KT + dk * 136 + part * 32 + 8),
                        k2 = *(const LAS u32x2*)(lds + ML_KT + dk * 136 + part * 32 + 16), k3 = *(const LAS u32x2*)(lds + ML_KT + dk * 136 + part * 32 + 24);
            float s = ((bflo(k0.x) + bfhi(k0.x)) + (bflo(k0.y) + bfhi(k0.y))) + ((bflo(k1.x) + bfhi(k1.x)) + (bflo(k1.y) + bfhi(k1.y)))
                    + ((bflo(k2.x) + bfhi(k2.x)) + (bflo(k2.y) + bfhi(k2.y))) + ((bflo(k3.x) + bfhi(k3.x)) + (bflo(k3.y) + bfhi(k3.y)));
            s += __shfl_xor(s, 1); s += __shfl_xor(s, 2);
            if (part == 0) sc[192 + dk] = decay * sc[192 + dk] + s;
        }
        m_run = b63 + M63;
        __syncthreads();
    }
#undef ML_PREFETCH
#undef rowof
}

constexpr float AT_PMIN = 1e-15f;
constexpr int AT_K0 = 0, AT_V0 = 17408, AT_BUF = 34816, AT_FLAGS = 2 * AT_BUF;
__device__ __forceinline__ void at_tile(const LAS unsigned char* Kb, const LAS unsigned char* Vb, int k0, int tmin, int r32, int hh, const bf16x8 (&qf)[8], f32x16 (&O)[4], float& P) {
    f32x16 S[2];
#pragma unroll
    for (int u = 0; u < 2; ++u) {
#pragma unroll
        for (int j = 0; j < 16; ++j) S[u][j] = 0.f;
#pragma unroll
        for (int ks = 0; ks < 8; ++ks) {
            const bf16x8 kf = *(const LAS bf16x8*)(Kb + (32 * u + r32) * 272 + (16 * ks + 8 * hh) * 2);
            S[u] = __builtin_amdgcn_mfma_f32_32x32x16_bf16(kf, qf[ks], S[u], 0, 0, 0);
        }
    }
    const bool full = (k0 + 63 < tmin) && (k0 >= 128);
    const int lim = tmin + r32 - k0 - 4 * hh;
    const int lo = 112 - k0 - 4 * hh;
    float Tt[2][4];
#define AT_ELEM(MASKED) \
    _Pragma("unroll") for (int u = 0; u < 2; ++u) _Pragma("unroll") for (int gq = 0; gq < 4; ++gq) { \
        float x4[4]; \
        _Pragma("unroll") for (int r = 0; r < 4; ++r) { \
            float zz = S[u][4 * gq + r] * (0.08838834764831845f * 1.4426950408889634f); \
            if (MASKED) { const int o = 32 * u + 8 * gq + r; zz = (o < lim && o >= lo) ? zz : -1.0e4f; } \
            const float rc = __builtin_amdgcn_rcpf(1.0f + __builtin_amdgcn_exp2f(zz)); \
            S[u][4 * gq + r] = 1.0f - rc; x4[r] = rc; } \
        const float e2 = x4[3], e1 = e2 * x4[2], e0 = e1 * x4[1]; \
        Tt[u][gq] = e0 * x4[0]; \
        S[u][4 * gq + 2] *= e2; S[u][4 * gq + 1] *= e1; S[u][4 * gq + 0] *= e0; }
    if (full) { AT_ELEM(false) } else { AT_ELEM(true) }
#undef AT_ELEM
    float acc = P;
#pragma unroll
    for (int u = 1; u >= 0; --u)
#pragma unroll
        for (int gq = 3; gq >= 0; --gq) {
            float t0; const float t1 = swap32_hi(Tt[u][gq], t0);
            const float Rr = hh ? acc : acc * t1;
            acc = (acc * t1) * t0;
#pragma unroll
            for (int r = 0; r < 4; ++r) S[u][4 * gq + r] *= Rr;
        }
    P = acc;
#pragma unroll
    for (int u = 0; u < 2; ++u)
#pragma unroll
        for (int s2 = 0; s2 < 2; ++s2) {
            const bf16x8 af = pack_frag(S[u], s2);
#pragma unroll
            for (int dt = 0; dt < 4; ++dt) {
                const LAS unsigned char* p = Vb + (32 * dt + r32) * 136 + (32 * u + 16 * s2 + 4 * hh) * 2;
                O[dt] = __builtin_amdgcn_mfma_f32_32x32x16_bf16(af, ld2x64(p, p + 16), O[dt], 0, 0, 0);
            }
        }
}
__device__ __forceinline__ void attn_phase(LAS unsigned char* lds, const bf16_t* kvq, bf16_t* ao) {
    const int tid = threadIdx.x, lane = tid & 63, wid = __builtin_amdgcn_readfirstlane(tid >> 6);
    const int r32 = lane & 31, hh = lane >> 5, l15 = lane & 15, l4 = lane >> 4;
    LAS unsigned* flags = (LAS unsigned*)(lds + AT_FLAGS);
    const int k_row = tid >> 4, k_col = (tid & 15) * 8;
    const int v_d = (16 * (wid & 1) + l15) * 4, v_s = (4 * (wid >> 1) + l4) * 4;
    for (int unit = blockIdx.x; unit < NB * 8 * 16; unit += gridDim.x) {
        const int qt = unit & 15, head = (unit >> 4) & 7, b = unit >> 7;
        const int q0 = 128 + 256 * qt, tmin = q0 + 32 * wid;
#define rowofp(p) ((p) >= 128 ? b * SEQ + (p) - 128 : ((p) >= 112 ? NR + b * 16 + (p) - 112 : NR + b * 16))
        bf16x8 qf[8];
        { const bf16_t* qp = kvq + (size_t)(b * SEQ + tmin - 128 + r32) * NPROJ + 2048 + head * 128 + 8 * hh;
#pragma unroll
            for (int ks = 0; ks < 8; ++ks) qf[ks] = *(const bf16x8*)(qp + 16 * ks); }
        f32x16 O[4];
#pragma unroll
        for (int i = 0; i < 4; ++i)
#pragma unroll
            for (int j = 0; j < 16; ++j) O[i][j] = 0.f;
        float P = 1.0f;
        const int kt_hi = (q0 >> 6) + 3;
        u32x4 kregA[2], kregB[2]; u32x2 vregA[4], vregB[4];
#define AT_LOAD(kreg, vreg, kt) do { \
        _Pragma("unroll") for (int p = 0; p < 2; ++p) kreg[p] = *(const u32x4*)(kvq + (size_t)rowofp(64 * (kt) + k_row + 32 * p) * NPROJ + head * 128 + k_col); \
        _Pragma("unroll") for (int kk = 0; kk < 4; ++kk) vreg[kk] = *(const u32x2*)(kvq + (size_t)rowofp(64 * (kt) + v_s + kk) * NPROJ + 1024 + head * 128 + v_d); } while (0)
#define AT_STORE(kreg, vreg, buf) do { LAS unsigned char* base = lds + (buf) * AT_BUF; \
        _Pragma("unroll") for (int p = 0; p < 2; ++p) *(LAS u32x4*)(base + AT_K0 + (k_row + 32 * p) * 272 + k_col * 2) = kreg[p]; \
        u32x2 vc[4]; tr4x4(vreg, vc); \
        _Pragma("unroll") for (int j = 0; j < 4; ++j) *(LAS u32x2*)(base + AT_V0 + (v_d + j) * 136 + v_s * 2) = vc[j]; } while (0)
#define AT_ITER(BUF, LOADSET_K, LOADSET_V, STORESET_K, STORESET_V) { \
            const int kt = kt_hi - it; \
            __syncthreads(); \
            if (it > 0 && flags[it - 1] == 0u) break; \
            if (kt - 2 >= 1) AT_LOAD(LOADSET_K, LOADSET_V, kt - 2); \
            if (64 * kt < tmin + 31 && __ballot(P >= AT_PMIN) != 0ull) at_tile(lds + (BUF) * AT_BUF + AT_K0, lds + (BUF) * AT_BUF + AT_V0, 64 * kt, tmin, r32, hh, qf, O, P); \
            if (__ballot(P >= AT_PMIN) != 0ull && lane == 0) flags[it] = 1u; \
            if (kt - 1 < 1) break; \
            AT_STORE(STORESET_K, STORESET_V, 1 - (BUF)); \
            ++it; }
        if (tid < 80) flags[tid] = 0u;
        AT_LOAD(kregA, vregA, kt_hi);
        AT_STORE(kregA, vregA, 0);
        AT_LOAD(kregB, vregB, kt_hi - 1);
        for (int it = 0; ; ) {
            AT_ITER(0, kregA, vregA, kregB, vregB)
            AT_ITER(1, kregB, vregB, kregA, vregA)
        }
#pragma unroll
        for (int dt = 0; dt < 4; ++dt)
#pragma unroll
            for (int j = 0; j < 16; ++j) {
                const int t = tmin + (j & 3) + 8 * (j >> 2) + 4 * hh;
                ao[(size_t)(b * SEQ + t - 128) * D + head * 128 + 32 * dt + r32] = f2bf(O[dt][j]);
            }
        __syncthreads();
    }
#undef AT_LOAD
#undef AT_STORE
#undef AT_ITER
#undef rowofp
}

__device__ __forceinline__ void ln_row_stats_wave(const float* st, int row, int lane, float& mu, float& rstd) {
    const f32x2 p = *(const f32x2*)(st + (size_t)row * 32 + (lane & 15) * 2);
    float s1 = p[0], s2 = p[1];
#pragma unroll
    for (int o = 1; o < 16; o <<= 1) { s1 += __shfl_xor(s1, o); s2 += __shfl_xor(s2, o); }
    mu = s1 * (1.0f / 1024.0f); const float var = fmaxf(s2 * (1.0f / 1024.0f) - mu * mu, 0.f); rstd = rsqrtf(var + LN_EPS);
}
__device__ __forceinline__ void router1_phase(LAS unsigned char* lds, const Args& a) {
    const int tid = threadIdx.x, lane = tid & 63, wid = tid >> 6;
    unsigned char* ws = a.ws;
    const float* g3 = a.in[16] + 2048; const float* b3 = a.in[17] + 2048; const float* wr = a.in[12];
    LAS float* gw = (LAS float*)lds;
    LAS float* cc = (LAS float*)(lds + 32768);
    LAS int* cnt = (LAS int*)(lds + 32768 + 64);
    __syncthreads();
    for (int i = tid; i < 8192; i += NTHREADS) { const int k = i >> 3, e = i & 7; gw[e * 1024 + k] = g3[k] * wr[i]; }
    if (tid < 8) cnt[tid] = 0;
    __syncthreads();
    { float s1 = 0.f, s2 = 0.f;
        for (int k = lane; k < 1024; k += 64) { s1 += gw[wid * 1024 + k]; s2 += b3[k] * wr[k * 8 + wid]; }
        s1 = wave_sum(s1); s2 = wave_sum(s2);
        if (lane == 0) { cc[wid] = s1; cc[8 + wid] = s2; } }
    __syncthreads();
    const bf16_t* z3 = (const bf16_t*)(ws + WS_RC); const float* st3 = (const float*)(ws + WS_ST3);
    f32x4* route = (f32x4*)(ws + WS_ROUTE);
    const int tok0 = (int)(((long)NR * blockIdx.x) / gridDim.x), tok1 = (int)(((long)NR * (blockIdx.x + 1)) / gridDim.x);
    u32x4 zrA[2], zrB[2]; f32x2 spA, spB;
#define RT_LOAD2(t) do { const int tb_ = ((t) + 8 < tok1) ? (t) + 8 : (t); \
        zrA[0] = *(const u32x4*)(z3 + (size_t)(t) * D + lane * 8); zrA[1] = *(const u32x4*)(z3 + (size_t)(t) * D + 512 + lane * 8); spA = *(const f32x2*)(st3 + (size_t)(t) * 32 + (lane & 15) * 2); \
        zrB[0] = *(const u32x4*)(z3 + (size_t)tb_ * D + lane * 8); zrB[1] = *(const u32x4*)(z3 + (size_t)tb_ * D + 512 + lane * 8); spB = *(const f32x2*)(st3 + (size_t)tb_ * 32 + (lane & 15) * 2); } while (0)
#define RT_FINISH(tk, acc, mu, rstd) do { float lg[8]; \
        _Pragma("unroll") for (int e = 0; e < 8; ++e) lg[e] = (rstd) * (wave_total(acc[e]) - (mu) * cc[e]) + cc[8 + e]; \
        int e1 = 0; float v1 = lg[0]; \
        _Pragma("unroll") for (int e = 1; e < 8; ++e) if (lg[e] > v1) { v1 = lg[e]; e1 = e; } \
        int e2 = -1; float v2 = -3.0e38f; \
        _Pragma("unroll") for (int e = 0; e < 8; ++e) if (e != e1 && lg[e] > v2) { v2 = lg[e]; e2 = e; } \
        const float g1 = 1.0f / (1.0f + expf(v2 - v1)); \
        if (lane == 0) { ((f32x2*)(ws + WS_TOKST))[tk] = (f32x2){(mu), (rstd)}; route[tk] = (f32x4){__int_as_float(e1 | (e2 << 8)), g1, 1.0f - g1, 0.f}; \
            __hip_atomic_fetch_add(&cnt[e1], 1, __ATOMIC_RELAXED, __HIP_MEMORY_SCOPE_WORKGROUP); __hip_atomic_fetch_add(&cnt[e2], 1, __ATOMIC_RELAXED, __HIP_MEMORY_SCOPE_WORKGROUP); } } while (0)
    if (tok0 + wid < tok1) RT_LOAD2(tok0 + wid);
    for (int tok = tok0 + wid; tok < tok1; tok += 16) {
        const u32x4 zA[2] = {zrA[0], zrA[1]}, zB[2] = {zrB[0], zrB[1]}; const f32x2 sA = spA, sB = spB;
        if (tok + 16 < tok1) RT_LOAD2(tok + 16);
        float a1 = sA[0], a2 = sA[1], b1 = sB[0], b2 = sB[1];
#pragma unroll
        for (int o = 1; o < 16; o <<= 1) { a1 += __shfl_xor(a1, o); a2 += __shfl_xor(a2, o); b1 += __shfl_xor(b1, o); b2 += __shfl_xor(b2, o); }
        const float muA = a1 * (1.0f / 1024.0f), rsA = rsqrtf(fmaxf(a2 * (1.0f / 1024.0f) - muA * muA, 0.f) + LN_EPS);
        const float muB = b1 * (1.0f / 1024.0f), rsB = rsqrtf(fmaxf(b2 * (1.0f / 1024.0f) - muB * muB, 0.f) + LN_EPS);
        float accA[8] = {0.f, 0.f, 0.f, 0.f, 0.f, 0.f, 0.f, 0.f}, accB[8] = {0.f, 0.f, 0.f, 0.f, 0.f, 0.f, 0.f, 0.f};
#pragma unroll
        for (int hf = 0; hf < 2; ++hf) {
            const int k = hf * 512 + lane * 8;
            float za[8], zb[8]; g8::unpack8(zA[hf], za); g8::unpack8(zB[hf], zb);
#pragma unroll
            for (int e = 0; e < 8; ++e) { const f32x4 w0 = *(const LAS f32x4*)(gw + e * 1024 + k), w1 = *(const LAS f32x4*)(gw + e * 1024 + k + 4);
                accA[e] += ((za[0] * w0[0] + za[1] * w0[1]) + (za[2] * w0[2] + za[3] * w0[3])) + ((za[4] * w1[0] + za[5] * w1[1]) + (za[6] * w1[2] + za[7] * w1[3]));
                accB[e] += ((zb[0] * w0[0] + zb[1] * w0[1]) + (zb[2] * w0[2] + zb[3] * w0[3])) + ((zb[4] * w1[0] + zb[5] * w1[1]) + (zb[6] * w1[2] + zb[7] * w1[3])); }
        }
        RT_FINISH(tok, accA, muA, rsA);
        if (tok + 8 < tok1) RT_FINISH(tok + 8, accB, muB, rsB);
    }
#undef RT_LOAD2
#undef RT_FINISH
    __syncthreads();
    if (tid < 8) ((int*)(ws + WS_CNT))[blockIdx.x * 8 + tid] = cnt[tid];
}
__device__ __forceinline__ void router2_phase(LAS unsigned char* lds, const Args& a) {
    const int tid = threadIdx.x, lane = tid & 63, wid = tid >> 6;
    unsigned char* ws = a.ws;
    const int G = gridDim.x, wg = blockIdx.x;
    LAS int* cn = (LAS int*)lds;
    LAS int* tot = (LAS int*)(lds + 16384);
    u32x2* smeta = (u32x2*)(ws + WS_TOK); f32x2* sstat = (f32x2*)(ws + WS_GATEB); const f32x2* tokst = (const f32x2*)(ws + WS_TOKST);
    const f32x4* route = (const f32x4*)(ws + WS_ROUTE);
    const int tok0 = (int)(((long)NR * wg) / G), tok1 = (int)(((long)NR * (wg + 1)) / G);
    f32x4 rr[8]; f32x2 ts[8];
#pragma unroll
    for (int i = 0; i < 8; ++i) { int q = 2 * tok0 + 64 * i + lane; q = q < 2 * tok1 ? q : 2 * tok1 - 1; rr[i] = route[q >> 1]; ts[i] = tokst[q >> 1]; }
    __syncthreads();
    const int* cnts = (const int*)(ws + WS_CNT);
    for (int i = tid; i < G * 8; i += NTHREADS) cn[i] = cnts[i];
    __syncthreads();
    { int t = 0, p = 0;
        for (int w = lane; w < G; w += 64) { const int v = cn[w * 8 + wid]; t += v; p += (w < wg) ? v : 0; }
#pragma unroll
        for (int o = 32; o >= 1; o >>= 1) { t += __shfl_xor(t, o); p += __shfl_xor(p, o); }
        if (lane == 0) { tot[wid] = t; tot[8 + wid] = p; } }
    __syncthreads();
    if (tid == 0) { int ps = 0;
        for (int e = 0; e < 8; ++e) { tot[24 + e] = ps; tot[16 + e] = ps + tot[8 + e]; ps += ((tot[e] + 255) >> 8) << 8; }
        if (wg == 0) { int* hdr = (int*)(ws + WS_HDR); int pp = 0; for (int e = 0; e < 8; ++e) { pp += (tot[e] + 255) >> 8; hdr[e] = pp; } hdr[8] = pp; } }
    __syncthreads();
    { const int e = wid; int run = tot[16 + e];
#pragma unroll
        for (int i = 0; i < 8; ++i) {
            const int q = 2 * tok0 + 64 * i + lane; bool match = false; float gt = 0.f;
            if (q < 2 * tok1) { const f32x4 r = rr[i]; const int ee = __float_as_int(r[0]); const int ex = (q & 1) ? ((ee >> 8) & 0xff) : (ee & 0xff); match = (ex == e); gt = (q & 1) ? r[2] : r[1]; }
            const unsigned long long mask = __ballot(match);
            const int pos = __popcll(mask & ((1ull << lane) - 1ull));
            if (match) { smeta[run + pos] = (u32x2){(unsigned)q, __float_as_uint(gt)}; sstat[run + pos] = ts[i]; }
            run += __popcll(mask);
        }
        if (wg == 0) { const int s0 = tot[24 + e] + tot[e], s1 = tot[24 + e] + (((tot[e] + 255) >> 8) << 8);
            for (int s = s0 + lane; s < s1; s += 64) { smeta[s] = (u32x2){0xffffffffu, 0u}; sstat[s] = (f32x2){0.f, 1.f}; } }
    }
}

__device__ __forceinline__ float wave_total(float x);
__device__ __forceinline__ void final_phase(const Args& a) {
    const int tid = threadIdx.x, lane = tid & 63, wid = tid >> 6;
    unsigned char* ws = a.ws;
    const bf16_t* z3 = (const bf16_t*)(ws + WS_RC); const float* st3 = (const float*)(ws + WS_ST3);
    const bf16_t* Y0 = (const bf16_t*)(ws + WS_RB); const bf16_t* Y1 = (const bf16_t*)(ws + WS_RD);
    const float* g3 = a.in[16] + 2048; const float* b3 = a.in[17] + 2048; const float* g4 = a.in[16] + 3072; const float* b4 = a.in[17] + 3072;
    float G3[16], B3[16], G4[16], B4[16];
#pragma unroll
    for (int hf = 0; hf < 2; ++hf)
#pragma unroll
        for (int q = 0; q < 2; ++q) { const int k = hf * 512 + lane * 8 + q * 4;
            const f32x4 a3 = *(const f32x4*)(g3 + k), c3 = *(const f32x4*)(b3 + k), a4 = *(const f32x4*)(g4 + k), c4 = *(const f32x4*)(b4 + k);
#pragma unroll
            for (int j = 0; j < 4; ++j) { G3[hf * 8 + q * 4 + j] = a3[j] * ALPHA; B3[hf * 8 + q * 4 + j] = c3[j] * ALPHA; G4[hf * 8 + q * 4 + j] = a4[j]; B4[hf * 8 + q * 4 + j] = c4[j]; } }
    const int stride = gridDim.x * 8;
    int tok = blockIdx.x * 8 + wid;
    u32x4 zr[2], y0r[2], y1r[2]; f32x2 sp;
#define FIN_LOAD(t) do { _Pragma("unroll") for (int hf = 0; hf < 2; ++hf) { const size_t o = (size_t)(t) * D + hf * 512 + lane * 8; \
        zr[hf] = *(const u32x4*)(z3 + o); y0r[hf] = *(const u32x4*)(Y0 + o); y1r[hf] = *(const u32x4*)(Y1 + o); } \
        sp = *(const f32x2*)(st3 + (size_t)(t) * 32 + (lane & 15) * 2); } while (0)
    if (tok < NR) FIN_LOAD(tok);
    for (; tok < NR; tok += stride) {
        u32x4 zc[2] = {zr[0], zr[1]}, y0c[2] = {y0r[0], y0r[1]}, y1c[2] = {y1r[0], y1r[1]}; const f32x2 spc = sp;
        if (tok + stride < NR) FIN_LOAD(tok + stride);
        float s1 = spc[0], s2 = spc[1];
#pragma unroll
        for (int o = 1; o < 16; o <<= 1) { s1 += __shfl_xor(s1, o); s2 += __shfl_xor(s2, o); }
        const float mu = s1 * (1.0f / 1024.0f); const float rstd = rsqrtf(fmaxf(s2 * (1.0f / 1024.0f) - mu * mu, 0.f) + LN_EPS);
        float v[16]; float t1 = 0.f;
#pragma unroll
        for (int hf = 0; hf < 2; ++hf) {
            float z[8], y0[8], y1[8];
            g8::unpack8(zc[hf], z); g8::unpack8(y0c[hf], y0); g8::unpack8(y1c[hf], y1);
#pragma unroll
            for (int j = 0; j < 8; ++j) { const float x = ((z[j] - mu) * rstd * G3[hf * 8 + j] + B3[hf * 8 + j]) + (y0[j] + y1[j]); v[hf * 8 + j] = x; t1 += x; }
        }
        t1 = wave_total(t1); const float mean = t1 * (1.0f / 1024.0f); float t2 = 0.f;
#pragma unroll
        for (int j = 0; j < 16; ++j) { const float d = v[j] - mean; t2 += d * d; }
        t2 = wave_total(t2); const float rs = rsqrtf(t2 * (1.0f / 1024.0f) + LN_EPS);
#pragma unroll
        for (int hf = 0; hf < 2; ++hf) {
            const int k = hf * 512 + lane * 8;
            f32x4 o0, o1;
#pragma unroll
            for (int j = 0; j < 4; ++j) { o0[j] = (v[hf * 8 + j] - mean) * rs * G4[hf * 8 + j] + B4[hf * 8 + j]; o1[j] = (v[hf * 8 + 4 + j] - mean) * rs * G4[hf * 8 + 4 + j] + B4[hf * 8 + 4 + j]; }
            *(f32x4*)(a.out + (size_t)tok * D + k) = o0; *(f32x4*)(a.out + (size_t)tok * D + k + 4) = o1;
        }
    }
#undef FIN_LOAD
}

__device__ __forceinline__ void moefix_phase(const Args& a) {
    const int lane = threadIdx.x & 63, wid = threadIdx.x >> 6;
    unsigned char* ws = a.ws;
    const int npan = ((const int*)(ws + WS_HDR))[8];
    const int p_lo = (MOE_NCHUNK - 1) * MOE_CHUNK_PAN + MOE_CHUNK_PAN;
    const int nrows = (npan - p_lo) * 256;
    const u32x2* smeta = (const u32x2*)(ws + WS_TOK);
    const float* P = (const float*)(ws + WS_RA + RA_POFF);
    bf16_t* Y0 = (bf16_t*)(ws + WS_RB); bf16_t* Y1 = (bf16_t*)(ws + WS_RD);
    for (int r = blockIdx.x * 8 + wid; r < nrows; r += gridDim.x * 8) {
        const u32x2 mg = smeta[(size_t)p_lo * 256 + r];
        const int id = (int)mg.x; const float gt = __uint_as_float(mg.y);
        if (id < 0) continue;
        bf16_t* yrow = ((id & 1) ? Y1 : Y0) + (size_t)(id >> 1) * D;
#pragma unroll
        for (int hf = 0; hf < 2; ++hf) {
            const int c = hf * 512 + lane * 8;
            f32x4 s0 = {0.f, 0.f, 0.f, 0.f}, s1 = {0.f, 0.f, 0.f, 0.f};
#pragma unroll
            for (int ks = 0; ks < MOE_KSPLIT; ++ks) { const float* pp = P + ((size_t)ks * 2048 + r) * D + c; s0 += *(const f32x4*)pp; s1 += *(const f32x4*)(pp + 4); }
            *(u32x4*)(yrow + c) = g8::pack8(s0 * gt, s1 * gt);
        }
    }
}
__device__ __forceinline__ void finstats_phase(const float* st, float* rs, int nrows) {
    for (int row = blockIdx.x * NTHREADS + threadIdx.x; row < nrows; row += gridDim.x * NTHREADS) {
        const f32x4* p = (const f32x4*)(st + (size_t)row * 32);
        float s1 = 0.f, s2 = 0.f;
#pragma unroll
        for (int i = 0; i < 8; ++i) { const f32x4 a = p[i]; s1 += a[0] + a[2]; s2 += a[1] + a[3]; }
        const float mu = s1 * (1.0f / 1024.0f); const float rstd = rsqrtf(fmaxf(s2 * (1.0f / 1024.0f) - mu * mu, 0.f) + LN_EPS);
        *(f32x2*)(rs + (size_t)row * 2) = (f32x2){mu, rstd};
    }
}
__global__ void __launch_bounds__(NTHREADS, 2) yoco_fwd(Args args) {
    extern __shared__ __attribute__((aligned(16))) unsigned char lds_raw[];
    LAS unsigned char* lds = (LAS unsigned char*)lds_raw;
    unsigned char* ws = args.ws;
    const int G = gridDim.x;
    const int lo = args.ph_lo, hi = args.ph_hi;
    volatile LAS unsigned* misc = (volatile LAS unsigned*)(lds + LDS_MAIN);
    if (threadIdx.x < 4) misc[threadIdx.x] = 0u;
    __syncthreads();
    XcdBarrier bar; bar.bar = (unsigned*)(ws + WS_CTL); bar.x = 0; bar.st = misc;
    if (hi - lo > 1) bar = xcd_barrier_post((unsigned*)(ws + WS_CTL), misc);
#ifndef PHASE_MASK
#define PHASE_MASK 0xFFFFFFFFu
#endif
#define IN(k) (((PHASE_MASK >> (k)) & 1u) && lo <= (k) && (k) < hi)
#define SEAM(k) do { if (IN(k) && IN((k) + 1)) xcd_barrier(bar); } while (0)
    bf16_t* RA = (bf16_t*)(ws + WS_RA); bf16_t* RB = (bf16_t*)(ws + WS_RB); bf16_t* RC = (bf16_t*)(ws + WS_RC); bf16_t* RD = (bf16_t*)(ws + WS_RD);
    float* vec = (float*)(ws + WS_VEC);
    float* st1 = (float*)(ws + WS_ST1); float* st2 = (float*)(ws + WS_ST2); float* st3 = (float*)(ws + WS_ST3);
    const float* ln_g = args.in[16]; const float* ln_b = args.in[17];

#define RUN(k, ...) do { if constexpr (((REPMASK) >> (k)) & 1u) { if (IN(k)) { __VA_ARGS__ } xcd_barrier(bar); } if (IN(k)) { __VA_ARGS__ } SEAM(k); } while (0)
    RUN(PH_PRO, prologue_phase(lds, args););
    RUN(PH_PROJ,
        g8::Gemm g{RB, (const bf16_t*)(ws + WS_WIN), D, nullptr, nullptr, nullptr}; g8::DenseOrder S; S.init(NPAN, NPROJ / 256, D, G, (int)blockIdx.x);
        g8::EpiPlain E{RA, NPROJ};
        g8::gemm_phase<g8::EpiPlain, g8::DenseOrder, false>(lds, g, S, E); tail_jobs(lds, args, PH_PROJ););
    RUN(PH_MLSTM, if ((int)blockIdx.x < 256) mlstm_phase(lds, RA, (const float*)(ws + WS_GATES), args.in[4], RD, (int)blockIdx.x););
    RUN(PH_WOUT,
        g8::Gemm g{RD, (const bf16_t*)(ws + WS_WOUT), D, nullptr, nullptr, nullptr}; g8::DenseOrder S; S.init(NPAN, 4, D, G, (int)blockIdx.x);
        g8::EpiRes<0> E{RC, RB, st1, lds + LDS_META, nullptr, nullptr};
        g8::gemm_phase<g8::EpiRes<0>, g8::DenseOrder, false>(lds, g, S, E); tail_jobs(lds, args, PH_WOUT););
    RUN(PH_FIN1, finstats_phase(st1, (float*)(ws + WS_RS1), NROWS););
    RUN(PH_GU,
        g8::Gemm g{RC, (const bf16_t*)(ws + WS_WGU), D, nullptr, nullptr, ws + WS_RS1}; g8::DenseOrder S; S.init(NPAN, 2 * FFD / 256, D, G, (int)blockIdx.x);
        g8::EpiGlu<false> E{RA, FFD, st1, vec + VEC_GU_CS, vec + VEC_GU_BW, lds + LDS_META, 0};
        g8::gemm_phase<g8::EpiGlu<false>, g8::DenseOrder, false, 3>(lds, g, S, E); tail_jobs(lds, args, PH_GU););
    RUN(PH_DN,
        g8::Gemm g{RA, (const bf16_t*)(ws + WS_WDN), FFD, nullptr, nullptr, ws + WS_RS1}; g8::DenseOrder S; S.init(NPAN, 4, FFD, G, (int)blockIdx.x);
        g8::EpiRes<1> E{RB, RC, st2, lds + LDS_META, ln_g, ln_b};
        g8::gemm_phase<g8::EpiRes<1>, g8::DenseOrder, false, 3>(lds, g, S, E); tail_jobs(lds, args, PH_DN););
    RUN(PH_FIN2, finstats_phase(st2, (float*)(ws + WS_RS2), NROWS););
    RUN(PH_KVQ,
        g8::Gemm g{RB, (const bf16_t*)(ws + WS_WKVQ), D, nullptr, nullptr, ws + WS_RS2}; g8::DenseOrder S; S.init(NPAN, NPROJ / 256, D, G, (int)blockIdx.x);
        g8::EpiFold E{RA, NPROJ, lds + LDS_META, vec + VEC_KVQ_CS, vec + VEC_KVQ_BW};
        g8::gemm_phase<g8::EpiFold, g8::DenseOrder, false, 3>(lds, g, S, E); tail_jobs(lds, args, PH_KVQ););
    RUN(PH_ATT, attn_phase(lds, RA, RD););
    RUN(PH_WO,
        g8::Gemm g{RD, (const bf16_t*)(ws + WS_WO), D, nullptr, nullptr, ws + WS_RS2}; g8::DenseOrder S; S.init(NR / 256, 4, D, G, (int)blockIdx.x);
        g8::EpiRes<1> E{RC, RB, st3, lds + LDS_META, ln_g + 1024, ln_b + 1024};
        g8::gemm_phase<g8::EpiRes<1>, g8::DenseOrder, false, 3>(lds, g, S, E););
    RUN(PH_RT1, router1_phase(lds, args););
    RUN(PH_RT2, router2_phase(lds, args););
#define MOE_CHUNK(cidx) \
    RUN(PH_MOE0 + 2 * (cidx), const int* hdr = (const int*)(ws + WS_HDR); const int npan = hdr[8]; const int p0 = (cidx) * MOE_CHUNK_PAN; \
        { g8::MoeOrder S; S.p0 = p0; S.np = ((cidx) == MOE_NCHUNK - 1) ? (npan - p0) : MOE_CHUNK_PAN; S.nfull = S.np; S.nsplit = 1; S.nN = 2 * FFE / 256; S.G = G; S.c = (int)blockIdx.x; S.K = D; S.estride = (unsigned)(2 * FFE * D * 2); \
            _Pragma("unroll") for (int e = 0; e < NE; ++e) S.pend[e] = hdr[e]; \
            g8::Gemm g{RC, (const bf16_t*)(ws + WS_WEGU), D, (const int*)(ws + WS_TOK), ws + WS_TOK, ws + WS_GATEB}; \
            g8::EpiGlu<true> E{RA, FFE, st3, vec + VEC_EGU_CS, vec + VEC_EGU_BW, lds + LDS_META, 2 * FFE}; \
            g8::gemm_phase<g8::EpiGlu<true>, g8::MoeOrder, true, 1>(lds, g, S, E); }); \
    RUN(PH_MOE0 + 2 * (cidx) + 1, const int* hdr = (const int*)(ws + WS_HDR); const int npan = hdr[8]; const int p0 = (cidx) * MOE_CHUNK_PAN; \
        { g8::MoeOrder S; S.p0 = p0; S.np = ((cidx) == MOE_NCHUNK - 1) ? (npan - p0) : MOE_CHUNK_PAN; S.nfull = MOE_CHUNK_PAN; S.nsplit = MOE_KSPLIT; S.nN = 4; S.G = G; S.c = (int)blockIdx.x; S.K = FFE; S.estride = (unsigned)(D * FFE * 2); \
            _Pragma("unroll") for (int e = 0; e < NE; ++e) S.pend[e] = hdr[e]; \
            g8::Gemm g{RA, (const bf16_t*)(ws + WS_WEDN), FFE, nullptr, ws + WS_TOK, nullptr}; \
            g8::EpiMoeDown E{RB, RD, lds + LDS_META, (float*)((unsigned char*)RA + RA_POFF), MOE_CHUNK_PAN}; \
            g8::gemm_phase<g8::EpiMoeDown, g8::MoeOrder, false, 2>(lds, g, S, E); });
    MOE_CHUNK(0) MOE_CHUNK(1) MOE_CHUNK(2) MOE_CHUNK(3)
    RUN(PH_FIX, moefix_phase(args););
    RUN(PH_FINAL, final_phase(args););
    if (PROBE_CLK && blockIdx.x == 0 && threadIdx.x == 0) { const float kv = ((volatile float*)(ws + WS_DIAG))[0]; const long long t0 = wall_clock64(); const long long dl = (long long)(kv * 5000.0f); while (wall_clock64() - t0 < dl) __builtin_amdgcn_s_sleep(8); }
#undef RUN
#undef IN
#undef SEAM
}

extern "C" void kernel_launch(void* const* d_in, const int* in_sizes, int n_in, void* d_out, int out_size, void* d_ws, size_t ws_size, hipStream_t stream) {
    static int grid = 0;
    if (grid == 0) {
        if (n_in != 18 || out_size != NR * D || ws_size < WS_END) { fprintf(stderr, "kernel_launch: unexpected problem (n_in %d out %d ws %zu need %zu)\n", n_in, out_size, ws_size, (size_t)WS_END); grid = -1; return; }
        int dev = 0, cus = 0, per_cu = 0;
        if (hipGetDevice(&dev) != hipSuccess || hipDeviceGetAttribute(&cus, hipDeviceAttributeMultiprocessorCount, dev) != hipSuccess) { grid = -1; return; }
        if (hipFuncSetAttribute((const void*)yoco_fwd, hipFuncAttributeMaxDynamicSharedMemorySize, LDS_BYTES) != hipSuccess) { fprintf(stderr, "kernel_launch: hipFuncSetAttribute failed\n"); grid = -1; return; }
        if (hipOccupancyMaxActiveBlocksPerMultiprocessor(&per_cu, (const void*)yoco_fwd, NTHREADS, LDS_BYTES) != hipSuccess || per_cu < 1) { fprintf(stderr, "kernel_launch: occupancy query says %d\n", per_cu); }
        (void)hipGetLastError();
        if (cus < 256) { fprintf(stderr, "kernel_launch: needs 256 CUs\n"); grid = -1; return; }
        grid = 256;
    }
    if (grid < 0) return;
    (void)hipMemsetAsync((char*)d_ws + WS_CTL, 0, CTL_BYTES, stream);
    Args a{};
    for (int i = 0; i < 18; ++i) a.in[i] = (const float*)d_in[i];
    a.out = (float*)d_out; a.ws = (unsigned char*)d_ws;
#if N_LAUNCH_MODE == 1
    for (int p = 0; p < PH_COUNT; ++p) { a.ph_lo = p; a.ph_hi = p + 1; hipLaunchKernelGGL(yoco_fwd, dim3(grid), dim3(NTHREADS), LDS_BYTES, stream, a); }
#else
    a.ph_lo = 0; a.ph_hi = PH_COUNT;
    hipLaunchKernelGGL(yoco_fwd, dim3(grid), dim3(NTHREADS), LDS_BYTES, stream, a);
#endif
}
```

```cpp
#include <hip/hip_runtime.h>
#include <cstdio>
#include <cstdint>

#ifndef N_LAUNCH_MODE
#define N_LAUNCH_MODE 0
#endif
#ifndef PROBE_CLK
#define PROBE_CLK 0
#endif
#ifndef REPMASK
#define REPMASK 0u
#endif

#define LAS __attribute__((address_space(3)))
typedef unsigned short bf16_t;
typedef short bf16x8 __attribute__((ext_vector_type(8)));
typedef float f32x2 __attribute__((ext_vector_type(2)));
typedef float f32x4 __attribute__((ext_vector_type(4)));
typedef float f32x16 __attribute__((ext_vector_type(16)));
typedef unsigned u32x2 __attribute__((ext_vector_type(2)));
typedef unsigned u32x4 __attribute__((ext_vector_type(4)));
typedef __bf16 bf16x2_t __attribute__((ext_vector_type(2)));

constexpr int D = 1024, NB = 16, SEQ = 4096, NMETA = 16;
constexpr int NR = NB * SEQ;
constexpr int NROWS = NR + NB * NMETA;
constexpr int NPAN = NROWS / 256;
constexpr int NPROJ = 3072;
constexpr int FFD = 2816, NE = 8, FFE = 3584;
constexpr float ALPHA = 1.41421356237f, LN_EPS = 1e-5f;
constexpr int NTHREADS = 512;
constexpr int MOE_ROWS = 2 * NR + NE * 256;
constexpr int MOE_CHUNK_PAN = 128;
constexpr int MOE_NCHUNK = 4;
constexpr int MOE_KSPLIT = 7;
constexpr size_t RA_POFF = (size_t)256 << 20;

constexpr size_t al256(size_t x) { return (x + 255) & ~(size_t)255; }
constexpr size_t WS_CTL = 0;
constexpr size_t CTL_BYTES = 65536;
constexpr size_t WS_WIN = WS_CTL + CTL_BYTES;
constexpr size_t WS_WOUT = WS_WIN + (size_t)NPROJ * D * 2;
constexpr size_t WS_WGU = WS_WOUT + (size_t)D * D * 2;
constexpr size_t WS_WDN = WS_WGU + (size_t)2 * FFD * D * 2;
constexpr size_t WS_WKVQ = WS_WDN + (size_t)D * FFD * 2;
constexpr size_t WS_WO = WS_WKVQ + (size_t)NPROJ * D * 2;
constexpr size_t WS_WEGU = WS_WO + (size_t)D * D * 2;
constexpr size_t WS_WEDN = WS_WEGU + (size_t)NE * 2 * FFE * D * 2;
constexpr size_t WS_VEC = WS_WEDN + (size_t)NE * D * FFE * 2;
constexpr int VEC_GU_CS = 0, VEC_GU_BW = 2 * FFD, VEC_KVQ_CS = 4 * FFD, VEC_KVQ_BW = VEC_KVQ_CS + NPROJ, VEC_EGU_CS = VEC_KVQ_BW + NPROJ, VEC_EGU_BW = VEC_EGU_CS + NE * 2 * FFE, VEC_END = VEC_EGU_BW + NE * 2 * FFE;
constexpr size_t WS_GATES = al256(WS_VEC + (size_t)VEC_END * 4);
constexpr size_t WS_ST1 = al256(WS_GATES + (size_t)NROWS * 8 * 4);
constexpr size_t WS_ST2 = WS_ST1 + (size_t)NROWS * 16 * 8;
constexpr size_t WS_ST3 = WS_ST2 + (size_t)NROWS * 16 * 8;
constexpr size_t WS_ROUTE = WS_ST3 + (size_t)NROWS * 16 * 8;
constexpr size_t WS_CNT = WS_ROUTE + (size_t)NR * 16;
constexpr size_t WS_HDR = WS_CNT + 256 * 8 * 4;
constexpr size_t WS_TOK = WS_HDR + 256;
constexpr size_t WS_GATEB = al256(WS_TOK + (size_t)MOE_ROWS * 8);
constexpr size_t WS_TOKST = al256(WS_GATEB + (size_t)MOE_ROWS * 8);
constexpr size_t WS_RS1 = al256(WS_TOKST + (size_t)NR * 8);
constexpr size_t WS_RS2 = al256(WS_RS1 + (size_t)NROWS * 8);
constexpr size_t WS_DIAG = al256(WS_RS2 + (size_t)NROWS * 8);
constexpr size_t WS_RA = al256(WS_DIAG + 4096);
constexpr size_t RA_BYTES = (size_t)NROWS * NPROJ * 2;
constexpr size_t WS_RB = al256(WS_RA + RA_BYTES);
constexpr size_t RX_BYTES = (size_t)NROWS * D * 2;
constexpr size_t WS_RC = al256(WS_RB + RX_BYTES);
constexpr size_t WS_RD = al256(WS_RC + RX_BYTES);
constexpr size_t WS_END = al256(WS_RD + RX_BYTES);

constexpr int LDS_MAIN = 131072, LDS_META = LDS_MAIN + 256  , LDS_BYTES = LDS_META + 8192;
__device__ __forceinline__ float bf2f(bf16_t v) { return __uint_as_float(((unsigned)v) << 16); }
__device__ __forceinline__ float bflo(unsigned u) { return __uint_as_float(u << 16); }
__device__ __forceinline__ float bfhi(unsigned u) { return __uint_as_float(u & 0xffff0000u); }
__device__ __forceinline__ unsigned pk2(float lo, float hi) { f32x2 v = {lo, hi}; bf16x2_t b = __builtin_convertvector(v, bf16x2_t); return __builtin_bit_cast(unsigned, b); }
__device__ __forceinline__ bf16_t f2bf(float f) { return (bf16_t)(pk2(f, 0.f) & 0xffffu); }
__device__ __forceinline__ float rbf(float f) { return bflo(pk2(f, 0.f)); }
__device__ __forceinline__ float wave_sum(float v) {
#pragma unroll
    for (int o = 32; o >= 1; o >>= 1) v += __shfl_xor(v, o);
    return v;
}
__device__ __forceinline__ float swap32_hi(float x, float& lo) {
    const u32x2 r = __builtin_amdgcn_permlane32_swap(__float_as_uint(x), __float_as_uint(x), false, false); lo = __uint_as_float(r.x); return __uint_as_float(r.y); }
__device__ __forceinline__ float fq_sum(float x) {
    const u32x2 a = __builtin_amdgcn_permlane16_swap(__float_as_uint(x), __float_as_uint(x), false, false); const float y = __uint_as_float(a.x) + __uint_as_float(a.y);
    const u32x2 b = __builtin_amdgcn_permlane32_swap(__float_as_uint(y), __float_as_uint(y), false, false); return __uint_as_float(b.x) + __uint_as_float(b.y); }
__device__ __forceinline__ float sigmoidf_(float x) { return __builtin_amdgcn_rcpf(1.0f + __builtin_amdgcn_exp2f(x * -1.4426950408889634f)); }

#define XB_TMO      128
#define XB_XCNT(j)  (256  + 64 * (j))
#define XB_XSUB(j)  (1280 + 64 * (j))
#define XB_XGEN(j)  (2304 + 64 * (j))
#define XB_TOP      3328
#define XB_TOPGEN   3392
#define XCD_BAR_WORDS 3456
#define XB_SPIN_CAP (1u << 20)
__device__ __forceinline__ unsigned xb_ld(unsigned* p)              { return __hip_atomic_load(p, __ATOMIC_RELAXED, __HIP_MEMORY_SCOPE_AGENT); }
__device__ __forceinline__ unsigned xb_add(unsigned* p, unsigned v) { return __hip_atomic_fetch_add(p, v, __ATOMIC_RELAXED, __HIP_MEMORY_SCOPE_AGENT); }
__device__ __forceinline__ unsigned xb_xcc_id() { return (unsigned)__builtin_amdgcn_s_getreg((3 << 11) | 20) & 0xFu; }
#define XB_SPIN(cond, bar) do { unsigned _sp = 0; while (cond) { __builtin_amdgcn_s_sleep(1); \
    if ((++_sp & 255u) == 0u) { if (xb_ld(&(bar)[XB_TMO])) break; if (_sp > XB_SPIN_CAP) { atomicAdd(&(bar)[XB_TMO], 1u); break; } } } } while (0)
struct XcdBarrier { unsigned* bar; unsigned x; volatile LAS unsigned* st; };
__device__ __forceinline__ XcdBarrier xcd_barrier_post(unsigned* bar, volatile LAS unsigned* st) {
    XcdBarrier b; b.bar = bar; b.x = xb_xcc_id(); b.st = st;
    if (threadIdx.x == 0) (void)xb_add(&bar[XB_XCNT(b.x)], 1u);
    return b;
}
__device__ __forceinline__ void xcd_barrier_complete(unsigned* bar, unsigned x, unsigned& nloc, unsigned& nx) {
    const unsigned G = gridDim.x * gridDim.y * gridDim.z;
    unsigned sum, cnt, mine, sp = 0u;
    for (;;) {
        sum = 0u; cnt = 0u; mine = 0u;
#pragma unroll
        for (unsigned j = 0; j < 16; ++j) { const unsigned c = xb_ld(&bar[XB_XCNT(j)]); sum += c; cnt += (c > 0u) ? 1u : 0u; mine = (j == x) ? c : mine; }
        if (sum == G) break;
        __builtin_amdgcn_s_sleep(1);
        if ((++sp & 255u) == 0u) { if (xb_ld(&bar[XB_TMO])) break; if (sp > XB_SPIN_CAP) { atomicAdd(&bar[XB_TMO], 1u); break; } }
    }
    nloc = mine > 0u ? mine : 1u; nx = cnt > 0u ? cnt : 1u;
}
__device__ __forceinline__ void xcd_barrier(const XcdBarrier& b) {
    asm volatile("s_waitcnt vmcnt(0)" ::: "memory");
    __syncthreads();
    if (threadIdx.x == 0) {
        unsigned* bar = b.bar;
        __builtin_amdgcn_s_waitcnt(0);
        unsigned nloc = b.st[0], nx = b.st[1];
        if (nloc == 0u) { xcd_barrier_complete(bar, b.x, nloc, nx); b.st[0] = nloc; b.st[1] = nx; }
        const unsigned old = xb_add(&bar[XB_XSUB(b.x)], 1u);
        const unsigned gen = old / nloc;
        if (old + 1u == (gen + 1u) * nloc) {
            __builtin_amdgcn_fence(__ATOMIC_RELEASE, "agent");
            asm volatile("s_waitcnt vmcnt(0)" ::: "memory");
            const unsigned og = xb_add(&bar[XB_TOP], 1u);
            const unsigned tg = og / nx;
            if (og + 1u == (tg + 1u) * nx) xb_add(&bar[XB_TOPGEN], 1u);
            else XB_SPIN(xb_ld(&bar[XB_TOPGEN]) == tg, bar);
            __builtin_amdgcn_fence(__ATOMIC_ACQUIRE, "agent");
            xb_add(&bar[XB_XGEN(b.x)], 1u);
            asm volatile("s_waitcnt vmcnt(0)" ::: "memory");
        } else {
            XB_SPIN(xb_ld(&bar[XB_XGEN(b.x)]) == gen, bar);
            __builtin_amdgcn_fence(__ATOMIC_ACQUIRE, "agent");
            asm volatile("s_waitcnt vmcnt(0)" ::: "memory");
        }
    }
    __syncthreads();
}

namespace g8 {
constexpr int BM = 256, BK = 64, HALF = 128, HTB = HALF * BK * 2, STAGE_BYTES = 8 * HTB, NXCD = 8, WGM = 8;
__host__ __device__ __forceinline__ int lds_byte(int r, int c) { const int st = (r >> 4) * 2 + (c >> 5), rr = r & 15, cc = c & 31, ob = rr * 64 + cc * 2; return st * 1024 + (ob ^ (((ob >> 9) & 1) << 5)); }
__host__ __device__ __forceinline__ void stage_rc(int b, int& R, int& C) { const int st = b / 1024, sb = b % 1024, swz = sb ^ (((sb >> 9) & 1) << 5); R = (st >> 1) * 16 + swz / 64; C = (st & 1) * 32 + (swz % 64) / 2; }
__host__ __device__ __forceinline__ int perm32(int rho) { const int n = rho >> 4, i = rho & 15; return 8 * (i >> 2) + 4 * n + (i & 3); }

struct Unit { int pm, pn, gp; unsigned boff; int aux; int kt; unsigned koff; int ks; };
struct Gemm { const bf16_t* A; const bf16_t* Bt; int K; const int* rowtab; const unsigned char* smeta; const unsigned char* sstat; };

struct DenseOrder {
    int nM, nN, nwg, G, c, K;
    __device__ void init(int nM_, int nN_, int K_, int G_, int c_) { nM = nM_; nN = nN_; nwg = nM * nN; G = G_; c = c_; K = K_; }
    __device__ bool next(int i, Unit& u) const {
        const long L = (long)i * G + c; if (L >= nwg) return false;
        int wgid = (int)L; { const int q = nwg / NXCD, r = nwg % NXCD, xcd = wgid % NXCD, off = wgid / NXCD; wgid = (xcd < r ? xcd * (q + 1) : r * (q + 1) + (xcd - r) * q) + off; }
        const int nig = WGM * nN, gid = wgid / nig, fm = gid * WGM, gsz = (nM - fm) < WGM ? (nM - fm) : WGM;
        u.pm = fm + ((wgid % nig) % gsz); u.pn = (wgid % nig) / gsz; u.gp = u.pm; u.boff = (unsigned)u.pn * (unsigned)(256 * K * 2); u.kt = K / BK; u.koff = 0u; u.ks = -1; return true;
    }
};
struct MoeOrder {
    int p0, np, nN, G, c, K; unsigned estride; int pend[NE]; int nfull, nsplit;
    __device__ bool next(int i, Unit& u) const {
        const long L = (long)i * G + c; const long nmain = (long)nfull * nN;
        int pn, pml, ks = -1;
        if (L < nmain) {
            if (G == 256 && nfull == 128 && (nN & 3) == 0) { const int x = c & 7, j = c >> 3, rpb = nN >> 2, pb = x + 8 * (i / rpb), nb = i % rpb;
                pml = 8 * pb + (j & 7); pn = 4 * nb + (j >> 3); }
            else { pn = (int)(L / nfull); pml = (int)(L % nfull); } }
        else { const long r = L - nmain; if (r >= (long)(np - nfull) * nN * nsplit) return false;
            ks = (int)(r % nsplit); const int q = (int)(r / nsplit); pn = q % nN; pml = nfull + q / nN; if (nsplit == 1) ks = -1; }
        const int gp = p0 + pml;
        int e = 0;
#pragma unroll
        for (int j = 0; j < NE - 1; ++j) e += (gp >= pend[j]) ? 1 : 0;
        const int ktall = K / BK;
        u.pm = pml; u.pn = pn; u.gp = gp; u.ks = ks; u.kt = ks < 0 ? ktall : ktall / nsplit; u.koff = ks < 0 ? 0u : (unsigned)(ks * (K / nsplit) * 2);
        u.boff = (unsigned)e * estride + (unsigned)pn * (unsigned)(256 * K * 2) + u.koff; return true;
    }
};

template <class Epi, class Sched, bool GATHER, int META = 0>
__device__ __forceinline__ void gemm_phase(LAS unsigned char* lds, const Gemm g, const Sched& S, const Epi& E) {
    const int tid = threadIdx.x, wid = __builtin_amdgcn_readfirstlane(tid >> 6), lane = tid & 63, wr = wid >> 2, wc = wid & 3, fr = lane & 15, fq = lane >> 4;
    const int K = g.K;
    int Rr[2], Cc[2]; unsigned voffA[2], voffB[2];
#pragma unroll
    for (int i = 0; i < 2; ++i) { stage_rc(tid * 16 + i * 8192, Rr[i], Cc[i]); const int Rb = (Rr[i] & ~31) + perm32(Rr[i] & 31);
        voffA[i] = (unsigned)(Rr[i] * K + Cc[i]) * 2u; voffB[i] = (unsigned)(Rb * K + Cc[i]) * 2u; }
    const size_t kstep = (size_t)(BK * 2);
    const size_t hstep = (size_t)HALF * K * 2;
    const size_t tstep = 2 * hstep;
    const unsigned ldsw = (unsigned)wid * 1024u;
    const int aoff = lds_byte(wr * 64 + fr, fq * 8), boff = lds_byte(wc * 32 + fr, fq * 8);
#define G8_SA(b, h) (((b) * 2 + (h)) * HTB)
#define G8_SB(b, h) ((4 + (b) * 2 + (h)) * HTB)
#define G8_STAGE(bufoff, gbase, voff) do { _Pragma("unroll") for (int _i = 0; _i < 2; ++_i) \
        __builtin_amdgcn_global_load_lds((const unsigned*)((const char*)(gbase) + (voff)[_i]), (LAS unsigned*)(lds + (bufoff) + ldsw + _i * 8192), 16, 0, 0); } while (0)
#define G8_STA(bufoff, ptr, offs, h) do { if constexpr (GATHER) { G8_STAGE(bufoff, (const char*)g.A, (offs)[h]); } else { G8_STAGE(bufoff, (ptr) + (h) * hstep, voffA); } } while (0)
#define G8_LDA(dst, b, h) do { _Pragma("unroll") for (int m = 0; m < 4; ++m) _Pragma("unroll") for (int k = 0; k < 2; ++k) dst[m][k] = *(const LAS bf16x8*)(lds + G8_SA(b, h) + aoff + m * 2048 + k * 1024); } while (0)
#define G8_LDB(dst, b, h) do { _Pragma("unroll") for (int n = 0; n < 2; ++n) _Pragma("unroll") for (int k = 0; k < 2; ++k) dst[n][k] = *(const LAS bf16x8*)(lds + G8_SB(b, h) + boff + n * 2048 + k * 1024); } while (0)
#define G8_MMA(ai, bj, At, Bt) do { __builtin_amdgcn_s_setprio(1); _Pragma("unroll") for (int m = 0; m < 4; ++m) _Pragma("unroll") for (int n = 0; n < 2; ++n) _Pragma("unroll") for (int k = 0; k < 2; ++k) \
        acc[ai][bj][m][n] = __builtin_amdgcn_mfma_f32_16x16x32_bf16(Bt[n][k], At[m][k], acc[ai][bj][m][n], 0, 0, 0); __builtin_amdgcn_s_setprio(0); } while (0)
#define G8_WAIT_V(n) asm volatile("s_waitcnt vmcnt(" #n ")" ::: "memory")
#define G8_WAIT_L(n) asm volatile("s_waitcnt lgkmcnt(" #n ")" ::: "memory")
#define G8_BAR __builtin_amdgcn_s_barrier()
#define G8_SCHED __builtin_amdgcn_sched_barrier(0)
#define G8_ROWOFFS(dst, U) do { _Pragma("unroll") for (int _h = 0; _h < 2; ++_h) _Pragma("unroll") for (int _i = 0; _i < 2; ++_i) { \
        const int _id = g.rowtab[2 * ((U).gp * 256 + _h * 128 + Rr[_i])]; const int _tk = _id < 0 ? 0 : (_id >> 1); dst[_h][_i] = (unsigned)(_tk * K + Cc[_i]) * 2u; } } while (0)
#define G8_META_DMA(gsrc, panel, bufidx) __builtin_amdgcn_global_load_lds((const unsigned*)((gsrc) + (size_t)(panel) * 2048 + wid * 256 + lane * 4), (LAS unsigned*)(lds + LDS_META + (bufidx) * 2048 + wid * 256), 4, 0, 0)
    Unit cur, nxt; int ui = 0;
    if (!S.next(0, cur)) return;
    f32x4 acc[2][2][4][2];
#pragma unroll
    for (int a = 0; a < 2; ++a)
#pragma unroll
        for (int b = 0; b < 2; ++b)
#pragma unroll
            for (int m = 0; m < 4; ++m)
#pragma unroll
                for (int n = 0; n < 2; ++n) acc[a][b][m][n] = (f32x4){0.f, 0.f, 0.f, 0.f};
    bf16x8 At[4][2], B0[2][2], B1[2][2];
    const char* cA = (const char*)g.A + (size_t)cur.pm * tstep + cur.koff; const char* cB = (const char*)g.Bt + cur.boff;
    unsigned oc[2][2], on[2][2], o1[2][2], o2[2][2], o3[2][2];
    if constexpr (GATHER) { G8_ROWOFFS(oc, cur);
#pragma unroll
        for (int h = 0; h < 2; ++h)
#pragma unroll
            for (int i = 0; i < 2; ++i) { o1[h][i] = oc[h][i] + 128u; on[h][i] = oc[h][i]; o2[h][i] = 0; o3[h][i] = 0; } }
    G8_STAGE(G8_SB(0, 0), cB, voffB); G8_STAGE(G8_SB(0, 1), cB + hstep, voffB); G8_STA(G8_SA(0, 0), cA, oc, 0); G8_STA(G8_SA(0, 1), cA, oc, 1);
    if (wr == 1) G8_BAR;
    G8_WAIT_V(2); G8_BAR;
    G8_STAGE(G8_SB(1, 0), cB + kstep, voffB); G8_STA(G8_SA(1, 0), cA + kstep, o1, 0); G8_STAGE(G8_SB(1, 1), cB + hstep + kstep, voffB);
    G8_WAIT_V(6); G8_BAR;
    for (;;) {
        const bool has_next = S.next(ui + 1, nxt);
        const char* nA = has_next ? (const char*)g.A + (size_t)nxt.pm * tstep + nxt.koff : cA; const char* nB = has_next ? (const char*)g.Bt + nxt.boff : cB;
        const int nt = cur.kt;
        if constexpr (META == 1) { if (has_next) G8_META_DMA(g.smeta, nxt.gp, (ui + 1) & 1); G8_META_DMA(g.sstat, cur.gp, 2 + (ui & 1)); }
        if constexpr (META == 2) { G8_META_DMA(g.smeta, cur.gp, ui & 1); }
        if constexpr (META == 3) { G8_META_DMA(g.sstat, cur.pm, 2 + (ui & 1)); }
        for (int t = 0; t < nt; t += 2) {
            const bool last = (t == nt - 2);
            const char* a1 = cA + (size_t)(t + 1) * kstep;
            const char* a2 = last ? nA : cA + (size_t)(t + 2) * kstep; const char* b2 = last ? nB : cB + (size_t)(t + 2) * kstep;
            const char* a3 = a2 + kstep; const char* b3 = b2 + kstep;
            if constexpr (GATHER) {
                if (last) {
#pragma unroll
                    for (int h = 0; h < 2; ++h)
#pragma unroll
                        for (int i = 0; i < 2; ++i) { int id = -1; if (has_next) id = *(const LAS int*)(lds + LDS_META + ((ui + 1) & 1) * 2048 + (h * 128 + Rr[i]) * 8);
                            const int tk = id < 0 ? 0 : (id >> 1); on[h][i] = has_next ? (unsigned)(tk * K + Cc[i]) * 2u : oc[h][i]; } }
#pragma unroll
                for (int h = 0; h < 2; ++h)
#pragma unroll
                    for (int i = 0; i < 2; ++i) { o1[h][i] = oc[h][i] + (unsigned)(t + 1) * 128u; o2[h][i] = last ? on[h][i] : oc[h][i] + (unsigned)(t + 2) * 128u; o3[h][i] = o2[h][i] + 128u; } }
            G8_LDB(B0, 0, 0); G8_LDB(B1, 0, 1); G8_SCHED; G8_LDA(At, 0, 0); G8_STA(G8_SA(1, 1), a1, o1, 1);
            G8_WAIT_V(8); G8_WAIT_L(0); G8_BAR; G8_MMA(0, 0, At, B0); G8_MMA(0, 1, At, B1); G8_BAR; G8_SCHED;
            G8_LDA(At, 0, 1); G8_STAGE(G8_SB(0, 0), b2, voffB); G8_STAGE(G8_SB(0, 1), b2 + hstep, voffB); G8_STA(G8_SA(0, 0), a2, o2, 0);
            G8_WAIT_V(8); G8_WAIT_L(0); G8_BAR; G8_MMA(1, 0, At, B0); G8_MMA(1, 1, At, B1); G8_BAR; G8_SCHED;
            G8_LDB(B0, 1, 0); G8_LDB(B1, 1, 1); G8_SCHED; G8_LDA(At, 1, 0); G8_STA(G8_SA(0, 1), a2, o2, 1);
            G8_WAIT_V(8); G8_WAIT_L(0); G8_BAR; G8_MMA(0, 0, At, B0); G8_MMA(0, 1, At, B1); G8_BAR; G8_SCHED;
            G8_LDA(At, 1, 1); G8_STAGE(G8_SB(1, 0), b3, voffB); G8_STAGE(G8_SB(1, 1), b3 + hstep, voffB); G8_STA(G8_SA(1, 0), a3, o3, 0);
            G8_WAIT_V(8); G8_WAIT_L(0); G8_BAR; G8_MMA(1, 0, At, B0); G8_MMA(1, 1, At, B1); G8_BAR; G8_SCHED;
        }
        if (wr == 0) G8_BAR;
        cur.aux = ui & 1;
        E(acc, cur, wr, wc, fr, fq);
        if (!has_next) break;
#pragma unroll
        for (int a = 0; a < 2; ++a)
#pragma unroll
            for (int b = 0; b < 2; ++b)
#pragma unroll
                for (int m = 0; m < 4; ++m)
#pragma unroll
                    for (int n = 0; n < 2; ++n) acc[a][b][m][n] = (f32x4){0.f, 0.f, 0.f, 0.f};
        cur = nxt; cA = nA; cB = nB; ++ui;
        if constexpr (GATHER) {
#pragma unroll
            for (int h = 0; h < 2; ++h)
#pragma unroll
                for (int i = 0; i < 2; ++i) oc[h][i] = on[h][i]; }
        if (wr == 1) G8_BAR;
    }
    G8_WAIT_V(0);
    G8_BAR;
#undef G8_SA
#undef G8_SB
#undef G8_STAGE
#undef G8_STA
#undef G8_LDA
#undef G8_LDB
#undef G8_MMA
#undef G8_WAIT_V
#undef G8_WAIT_L
#undef G8_BAR
#undef G8_SCHED
#undef G8_ROWOFFS
#undef G8_META_DMA
}

typedef f32x4 Acc[2][2][4][2];
__device__ __forceinline__ u32x4 pack8(const f32x4 a, const f32x4 b) { u32x4 w; w.x = pk2(a[0], a[1]); w.y = pk2(a[2], a[3]); w.z = pk2(b[0], b[1]); w.w = pk2(b[2], b[3]); return w; }
__device__ __forceinline__ void unpack8(const u32x4 w, float (&f)[8]) { f[0] = bflo(w.x); f[1] = bfhi(w.x); f[2] = bflo(w.y); f[3] = bfhi(w.y); f[4] = bflo(w.z); f[5] = bfhi(w.z); f[6] = bflo(w.w); f[7] = bfhi(w.w); }
__device__ __forceinline__ void row_stats(const float* st, int row, int fq, float& mu, float& rstd) {
    const f32x4* p = (const f32x4*)(st + (size_t)row * 32 + fq * 8);
    const f32x4 a = p[0], b = p[1];
    float s1 = (a[0] + a[2]) + (b[0] + b[2]), s2 = (a[1] + a[3]) + (b[1] + b[3]);
    s1 += __shfl_xor(s1, 16); s1 += __shfl_xor(s1, 32); s2 += __shfl_xor(s2, 16); s2 += __shfl_xor(s2, 32);
    mu = s1 * (1.0f / 1024.0f); const float var = fmaxf(s2 * (1.0f / 1024.0f) - mu * mu, 0.f); rstd = rsqrtf(var + LN_EPS);
}
__device__ __forceinline__ void put_stats(float* st, int row, int slot, int fq, float s1, float s2) {
    s1 = fq_sum(s1); s2 = fq_sum(s2);
    if (fq == 0) *(f32x2*)(st + (size_t)row * 32 + slot * 2) = (f32x2){s1, s2};
}

struct EpiPlain {
    bf16_t* O; int ldc;
    __device__ __forceinline__ void operator()(const Acc& acc, const Unit& u, int wr, int wc, int fr, int fq) const {
        const int row0 = u.pm * 256 + wr * 64 + fr, col0 = u.pn * 256 + wc * 32 + 8 * fq;
#pragma unroll
        for (int ai = 0; ai < 2; ++ai)
#pragma unroll
            for (int m = 0; m < 4; ++m) { bf16_t* rowp = O + (size_t)(row0 + ai * 128 + m * 16) * ldc + col0;
#pragma unroll
                for (int bj = 0; bj < 2; ++bj) *(u32x4*)(rowp + bj * 128) = pack8(acc[ai][bj][m][0], acc[ai][bj][m][1]); }
    }
};
template <int MODE> struct EpiRes {
    bf16_t* Z; const bf16_t* Rsrc; float* st_out; LAS unsigned char* ldsm; const float* g; const float* b;
    __device__ __forceinline__ void operator()(const Acc& acc, const Unit& u, int wr, int wc, int fr, int fq) const {
        const int r0 = wr * 64 + fr, col0 = u.pn * 256 + wc * 32 + 8 * fq;
        f32x4 gv[2][2], bv[2][2];
        if (MODE == 1) {
#pragma unroll
            for (int bj = 0; bj < 2; ++bj)
#pragma unroll
                for (int n = 0; n < 2; ++n) { gv[bj][n] = *(const f32x4*)(g + col0 + bj * 128 + 4 * n); bv[bj][n] = *(const f32x4*)(b + col0 + bj * 128 + 4 * n); }
        }
        u32x4 rwa[4][4][2];
#define EPR_LOAD(am_) do { _Pragma("unroll") for (int m = 2 * ((am_) & 1); m < 2 * ((am_) & 1) + 2; ++m) _Pragma("unroll") for (int bj = 0; bj < 2; ++bj) \
            rwa[am_][m][bj] = *(const u32x4*)(Rsrc + ((size_t)u.pm * 256 + r0 + ((am_) >> 1) * 128 + m * 16) * D + col0 + bj * 128); } while (0)
        EPR_LOAD(0);
#pragma unroll
        for (int am = 0; am < 4; ++am) { const int ai = am >> 1;
            if (am + 1 < 4) EPR_LOAD(am + 1);
            u32x4 (&rw)[4][2] = rwa[am];
#pragma unroll
            for (int m = 2 * (am & 1); m < 2 * (am & 1) + 2; ++m) {
                const int rl = r0 + ai * 128 + m * 16; const size_t row = (size_t)u.pm * 256 + rl;
                float mu = 0.f, rstd = 1.f;
                if (MODE == 1) { const f32x2 ms = *(const LAS f32x2*)(ldsm + (2 + u.aux) * 2048 + rl * 8); mu = ms[0]; rstd = ms[1]; }
                float s1 = 0.f, s2 = 0.f;
#pragma unroll
                for (int bj = 0; bj < 2; ++bj) {
                    float r[8]; unpack8(rw[m][bj], r);
                    f32x4 v0, v1;
#pragma unroll
                    for (int j = 0; j < 4; ++j) {
                        float h0 = r[j], h1 = r[4 + j];
                        if (MODE == 1) { h0 = (h0 - mu) * rstd * gv[bj][0][j] + bv[bj][0][j]; h1 = (h1 - mu) * rstd * gv[bj][1][j] + bv[bj][1][j]; }
                        v0[j] = ALPHA * h0 + acc[ai][bj][m][0][j]; v1[j] = ALPHA * h1 + acc[ai][bj][m][1][j];
                    }
                    const u32x4 w = pack8(v0, v1);
                    *(u32x4*)(Z + row * D + col0 + bj * 128) = w;
                    float q[8]; unpack8(w, q);
#pragma unroll
                    for (int j = 0; j < 8; ++j) { s1 += q[j]; s2 += q[j] * q[j]; }
                }
                put_stats(st_out, (int)row, u.pn * 4 + wc, fq, s1, s2);
            }
        }
    }
};
struct EpiFold {
    bf16_t* O; int ldc; LAS unsigned char* ldsm; const float* cs; const float* bw;
    __device__ __forceinline__ void operator()(const Acc& acc, const Unit& u, int wr, int wc, int fr, int fq) const {
        const int r0 = wr * 64 + fr, col0 = u.pn * 256 + wc * 32 + 8 * fq;
        f32x4 cv[2][2], bv[2][2];
#pragma unroll
        for (int bj = 0; bj < 2; ++bj)
#pragma unroll
            for (int n = 0; n < 2; ++n) { cv[bj][n] = *(const f32x4*)(cs + col0 + bj * 128 + 4 * n); bv[bj][n] = *(const f32x4*)(bw + col0 + bj * 128 + 4 * n); }
#pragma unroll
        for (int ai = 0; ai < 2; ++ai)
#pragma unroll
            for (int m = 0; m < 4; ++m) {
                const int rl = r0 + ai * 128 + m * 16; const size_t row = (size_t)u.pm * 256 + rl;
                const f32x2 ms = *(const LAS f32x2*)(ldsm + (2 + u.aux) * 2048 + rl * 8); const float mu = ms[0], rstd = ms[1];
#pragma unroll
                for (int bj = 0; bj < 2; ++bj) {
                    const f32x4 v0 = (acc[ai][bj][m][0] - mu * cv[bj][0]) * rstd + bv[bj][0], v1 = (acc[ai][bj][m][1] - mu * cv[bj][1]) * rstd + bv[bj][1];
                    *(u32x4*)(O + row * ldc + col0 + bj * 128) = pack8(v0, v1);
                }
            }
    }
};
template <bool MOE> struct EpiGlu {
    bf16_t* O; int ldc; const float* st_in; const float* cs; const float* bw; LAS unsigned char* ldsm; int ncs;
    __device__ __forceinline__ void operator()(const Acc& acc, const Unit& u, int wr, int wc, int fr, int fq) const {
        const int row0 = u.pm * 256 + wr * 64 + fr, colo = u.pn * 128 + wc * 32 + 8 * fq;
        int vb = u.pn * 256 + wc * 32 + 8 * fq;
        if (MOE) vb += (int)(u.boff / (unsigned)(256 * D * 2)) * 256 - u.pn * 256;
        f32x4 cv[2][2], bv[2][2];
#pragma unroll
        for (int bj = 0; bj < 2; ++bj)
#pragma unroll
            for (int n = 0; n < 2; ++n) { cv[bj][n] = *(const f32x4*)(cs + vb + bj * 128 + 4 * n); bv[bj][n] = *(const f32x4*)(bw + vb + bj * 128 + 4 * n); }
#pragma unroll
        for (int ai = 0; ai < 2; ++ai)
#pragma unroll
            for (int m = 0; m < 4; ++m) {
                const int row = row0 + ai * 128 + m * 16;
                const f32x2 ms = *(const LAS f32x2*)(ldsm + (2 + u.aux) * 2048 + (row - u.pm * 256) * 8); const float mu = ms[0], rstd = ms[1];
                f32x4 o0, o1;
#pragma unroll
                for (int j = 0; j < 4; ++j) {
                    const float g0 = (acc[ai][0][m][0][j] - mu * cv[0][0][j]) * rstd + bv[0][0][j], g1 = (acc[ai][0][m][1][j] - mu * cv[0][1][j]) * rstd + bv[0][1][j];
                    const float u0 = (acc[ai][1][m][0][j] - mu * cv[1][0][j]) * rstd + bv[1][0][j], u1 = (acc[ai][1][m][1][j] - mu * cv[1][1][j]) * rstd + bv[1][1][j];
                    o0[j] = g0 * sigmoidf_(g0) * u0; o1[j] = g1 * sigmoidf_(g1) * u1;
                }
                *(u32x4*)(O + (size_t)row * ldc + colo) = pack8(o0, o1);
            }
    }
};
struct EpiMoeDown {
    bf16_t* Y0; bf16_t* Y1; LAS unsigned char* ldsm; float* P; int nfull;
    __device__ __forceinline__ void operator()(const Acc& acc, const Unit& u, int wr, int wc, int fr, int fq) const {
        const int r0 = wr * 64 + fr, col0 = u.pn * 256 + wc * 32 + 8 * fq;
        if (u.ks >= 0) {
#pragma unroll
            for (int ai = 0; ai < 2; ++ai)
#pragma unroll
                for (int m = 0; m < 4; ++m) { float* rowp = P + ((size_t)u.ks * 2048 + (size_t)(u.pm - nfull) * 256 + r0 + ai * 128 + m * 16) * D + col0;
#pragma unroll
                    for (int bj = 0; bj < 2; ++bj) { *(f32x4*)(rowp + bj * 128) = acc[ai][bj][m][0]; *(f32x4*)(rowp + bj * 128 + 4) = acc[ai][bj][m][1]; } }
            return;
        }
#pragma unroll
        for (int ai = 0; ai < 2; ++ai)
#pragma unroll
            for (int m = 0; m < 4; ++m) {
                const u32x2 mg = *(const LAS u32x2*)(ldsm + u.aux * 2048 + (r0 + ai * 128 + m * 16) * 8);
                const int id = (int)mg.x; const float gt = __uint_as_float(mg.y);
                if (id >= 0) { bf16_t* rowp = Y0 + (size_t)(id & 1) * (size_t)(Y1 - Y0) + (size_t)(id >> 1) * D + col0;
#pragma unroll
                    for (int bj = 0; bj < 2; ++bj) *(u32x4*)(rowp + bj * 128) = pack8(acc[ai][bj][m][0] * gt, acc[ai][bj][m][1] * gt); }
            }
    }
};
}

struct Args { const float* in[18]; float* out; unsigned char* ws; int ph_lo, ph_hi; };
enum { PH_PRO = 0, PH_PROJ, PH_MLSTM, PH_WOUT, PH_FIN1, PH_GU, PH_DN, PH_FIN2, PH_KVQ, PH_ATT, PH_WO, PH_RT1, PH_RT2, PH_MOE0, PH_FIX = PH_MOE0 + 2 * MOE_NCHUNK, PH_FINAL, PH_COUNT };

__device__ __forceinline__ float logsigmoid_(float x) { return fminf(x, 0.f) - log1pf(expf(-fabsf(x))); }
__device__ __forceinline__ void conv_block(LAS unsigned char* lds, const float* src, int ldw, int K, bf16_t* dst, const float* g, const float* bb, float* cs, float* bw) {
    const int tid = threadIdx.x;
    const int n4 = (tid & 15) * 4, k4 = (tid >> 4) * 4;
    const int rn = tid >> 3, rs = tid & 7;
    float csp[4] = {0.f, 0.f, 0.f, 0.f}, bwp[4] = {0.f, 0.f, 0.f, 0.f};
    const int nch = K / 128;
    LAS float* gs = (LAS float*)(lds + 2 * 64 * 264 + 16384);
    if (g) { for (int i = tid; i < K; i += NTHREADS) { gs[i] = g[i]; gs[K + i] = bb[i]; } __syncthreads(); }
    f32x4 v[4], vn[4];
#pragma unroll
    for (int kk = 0; kk < 4; ++kk) v[kk] = *(const f32x4*)(src + (size_t)(k4 + kk) * ldw + n4);
    for (int ch = 0; ch < nch; ++ch) {
        LAS unsigned char* T = lds + (ch & 1) * (64 * 264);
        if (ch + 1 < nch) {
#pragma unroll
            for (int kk = 0; kk < 4; ++kk) vn[kk] = *(const f32x4*)(src + (size_t)((ch + 1) * 128 + k4 + kk) * ldw + n4); }
        float gk[4] = {1.f, 1.f, 1.f, 1.f}, bk[4] = {0.f, 0.f, 0.f, 0.f};
        if (g) {
#pragma unroll
            for (int kk = 0; kk < 4; ++kk) { gk[kk] = gs[ch * 128 + k4 + kk]; bk[kk] = gs[K + ch * 128 + k4 + kk]; } }
#pragma unroll
        for (int j = 0; j < 4; ++j) {
            const unsigned lo = pk2(v[0][j] * gk[0], v[1][j] * gk[1]), hi = pk2(v[2][j] * gk[2], v[3][j] * gk[3]);
            *(LAS u32x2*)(T + (n4 + j) * 264 + k4 * 2) = (u32x2){lo, hi};
            csp[j] += (bflo(lo) + bfhi(lo)) + (bflo(hi) + bfhi(hi));
            bwp[j] += (v[0][j] * bk[0] + v[1][j] * bk[1]) + (v[2][j] * bk[2] + v[3][j] * bk[3]);
        }
        __syncthreads();
        u32x2 q[4];
#pragma unroll
        for (int i = 0; i < 4; ++i) q[i] = *(const LAS u32x2*)(T + rn * 264 + rs * 32 + i * 8);
        bf16_t* dp = dst + (size_t)rn * K + ch * 128 + rs * 16;
        *(u32x4*)dp = (u32x4){q[0].x, q[0].y, q[1].x, q[1].y};
        *(u32x4*)(dp + 8) = (u32x4){q[2].x, q[2].y, q[3].x, q[3].y};
#pragma unroll
        for (int kk = 0; kk < 4; ++kk) v[kk] = vn[kk];
    }
    __syncthreads();
    if (cs) {
        LAS float* red = (LAS float*)(lds + 2 * 64 * 264);
#pragma unroll
        for (int j = 0; j < 4; ++j) { red[(tid >> 4) * 64 + n4 + j] = csp[j]; red[2048 + (tid >> 4) * 64 + n4 + j] = bwp[j]; }
        __syncthreads();
        if (tid < 128) { const int n = tid & 63, w = tid >> 6; float s = 0.f;
            for (int i = 0; i < 32; ++i) s += red[w * 2048 + i * 64 + n];
            (w ? bw : cs)[n] = s; }
        __syncthreads();
    }
}
__device__ __forceinline__ void conv_job(LAS unsigned char* lds, const Args& a, int blk) {
    unsigned char* ws = a.ws;
    const float* ln_g = a.in[16]; const float* ln_b = a.in[17];
    float* vec = (float*)(ws + WS_VEC);
    const float* src; int ldw, K; bf16_t* dst; const float* g = nullptr; const float* bb = nullptr; float* cs = nullptr; float* bw = nullptr;
    int j = blk;
    if (j < 128) { const int e = j >> 4, jj = j & 15; src = a.in[15] + (size_t)e * FFE * D + 64 * jj; ldw = D; K = FFE; dst = (bf16_t*)(ws + WS_WEDN) + ((size_t)e * D + 64 * jj) * FFE; }
    else if (j < 144) { j -= 128; src = a.in[11] + 64 * j; ldw = D; K = FFD; dst = (bf16_t*)(ws + WS_WDN) + (size_t)(64 * j) * FFD; }
    else if (j < 192) { j -= 144; src = a.in[2] + 64 * j; ldw = 3080; K = D; dst = (bf16_t*)(ws + WS_WIN) + (size_t)(64 * j) * D; }
    else if (j < 208) { j -= 192; src = a.in[5] + 64 * j; ldw = D; K = D; dst = (bf16_t*)(ws + WS_WOUT) + (size_t)(64 * j) * D; }
    else if (j < 296) { j -= 208; const int t = j >> 2, q = j & 3; src = (q < 2 ? a.in[9] : a.in[10]) + 128 * t + 64 * (q & 1); ldw = FFD; K = D; dst = (bf16_t*)(ws + WS_WGU) + (size_t)(64 * j) * D;
        g = ln_g; bb = ln_b; cs = vec + VEC_GU_CS + 64 * j; bw = vec + VEC_GU_BW + 64 * j; }
    else if (j < 344) { j -= 296; src = j < 32 ? a.in[6] + 64 * j : a.in[7] + 64 * (j - 32); ldw = j < 32 ? 2048 : 1024; K = D; dst = (bf16_t*)(ws + WS_WKVQ) + (size_t)(64 * j) * D;
        g = ln_g + 1024; bb = ln_b + 1024; cs = vec + VEC_KVQ_CS + 64 * j; bw = vec + VEC_KVQ_BW + 64 * j; }
    else if (j < 360) { j -= 344; src = a.in[8] + 64 * j; ldw = D; K = D; dst = (bf16_t*)(ws + WS_WO) + (size_t)(64 * j) * D; }
    else { j -= 360; const int e = j / 112, jj = j % 112, t = jj >> 2, q = jj & 3; src = (q < 2 ? a.in[13] : a.in[14]) + (size_t)e * D * FFE + 128 * t + 64 * (q & 1); ldw = FFE; K = D;
        dst = (bf16_t*)(ws + WS_WEGU) + ((size_t)e * 2 * FFE + 64 * jj) * D; g = ln_g + 2048; bb = ln_b + 2048; cs = vec + VEC_EGU_CS + e * 2 * FFE + 64 * jj; bw = vec + VEC_EGU_BW + e * 2 * FFE + 64 * jj; }
    conv_block(lds, src, ldw, K, dst, g, bb, cs, bw);
}
constexpr int EGU0 = 360;
__device__ __forceinline__ void tail_jobs(LAS unsigned char* lds, const Args& a, int phase) {
    const int c = (int)blockIdx.x;
    int j0 = -1;
    if (phase == PH_PROJ) { const int q = c - 12;
        if (q >= 0) j0 = q < 16 ? 128 + q : (q < 184 ? 192 + (q - 16) : EGU0 + (q - 184)); }
    else if (phase == PH_WOUT) { const int q = c - 4; if (q >= 0) j0 = EGU0 + 60 + q; }
    else if (phase == PH_GU) { const int q = c - 22; if (q >= 0) j0 = EGU0 + 312 + q; }
    else if (phase == PH_DN) { const int q = c - 4;
        if (q >= 0 && q < 128) j0 = q;
        else if (q >= 128 && q - 128 < 106) j0 = EGU0 + 546 + (q - 128); }
    else { const int q = c - 12; if (q >= 0) j0 = EGU0 + 652 + q; }
    if (j0 >= 0) conv_job(lds, a, j0);
}
__device__ __forceinline__ void prologue_phase(LAS unsigned char* lds, const Args& a) {
    unsigned char* ws = a.ws;
    const int G = gridDim.x;
    for (int blk = 144 + blockIdx.x; blk < 192; blk += G) conv_job(lds, a, blk);
    {
        const int tid = threadIdx.x, lane = tid & 63, wid = tid >> 6;
        LAS float* wg = (LAS float*)lds;
        __syncthreads();
        const float* w_in = a.in[2];
        for (int i = tid; i < 8192; i += NTHREADS) { const int k = i >> 3, e = i & 7; wg[e * 1024 + k] = w_in[(size_t)k * 3080 + 3072 + e]; }
        __syncthreads();
        bf16_t* H0 = (bf16_t*)(ws + WS_RB); float* gates = (float*)(ws + WS_GATES);
        const float bg = a.in[3][lane & 7];
        f32x4 xv[4], xn[4];
        { const int row = blockIdx.x * 8 + wid; const float* src = row < NR ? a.in[0] + (size_t)row * D : a.in[1] + (size_t)((row - NR) & 15) * D;
#pragma unroll
            for (int i = 0; i < 4; ++i) xv[i] = *(const f32x4*)(src + i * 256 + lane * 4); }
        for (int row = blockIdx.x * 8 + wid; row < NROWS; row += G * 8) {
            { const int rn = row + G * 8;
                if (rn < NROWS) { const float* srcn = rn < NR ? a.in[0] + (size_t)rn * D : a.in[1] + (size_t)((rn - NR) & 15) * D;
#pragma unroll
                    for (int i = 0; i < 4; ++i) xn[i] = *(const f32x4*)(srcn + i * 256 + lane * 4); } }
            float acc[8] = {0.f, 0.f, 0.f, 0.f, 0.f, 0.f, 0.f, 0.f};
#pragma unroll
            for (int i = 0; i < 4; ++i) {
                const int k = i * 256 + lane * 4;
                const f32x4 v = xv[i];
                *(u32x2*)(H0 + (size_t)row * D + k) = (u32x2){pk2(v[0], v[1]), pk2(v[2], v[3])};
#pragma unroll
                for (int e = 0; e < 8; ++e) { const f32x4 w = *(const LAS f32x4*)(wg + e * 1024 + k); acc[e] += (v[0] * w[0] + v[1] * w[1]) + (v[2] * w[2] + v[3] * w[3]); }
            }
#pragma unroll
            for (int i = 0; i < 4; ++i) xv[i] = xn[i];
#pragma unroll
            for (int e = 0; e < 8; ++e) acc[e] = wave_sum(acc[e]);
            float mine = acc[0];
#pragma unroll
            for (int e = 1; e < 8; ++e) mine = ((lane & 7) == e) ? acc[e] : mine;
            if (lane < 8) gates[(size_t)row * 8 + lane] = lane < 4 ? mine + bg : logsigmoid_(mine + bg);
        }
        __syncthreads();
    }
}

__device__ __forceinline__ bf16x8 pack_frag(const f32x16& x, int s) {
    u32x4 p; p.x = pk2(x[8 * s], x[8 * s + 1]); p.y = pk2(x[8 * s + 2], x[8 * s + 3]); p.z = pk2(x[8 * s + 4], x[8 * s + 5]); p.w = pk2(x[8 * s + 6], x[8 * s + 7]);
    return __builtin_bit_cast(bf16x8, p);
}
__device__ __forceinline__ bf16x8 ld2x64(const LAS unsigned char* p0, const LAS unsigned char* p1) {
    const u32x2 a = *(const LAS u32x2*)p0, b = *(const LAS u32x2*)p1; u32x4 r = {a.x, a.y, b.x, b.y}; return __builtin_bit_cast(bf16x8, r);
}
__device__ __forceinline__ void tr4x4(const u32x2 (&r)[4], u32x2 (&c)[4]) {
    c[0] = (u32x2){(r[0].x & 0xffffu) | (r[1].x << 16), (r[2].x & 0xffffu) | (r[3].x << 16)};
    c[1] = (u32x2){(r[0].x >> 16) | (r[1].x & 0xffff0000u), (r[2].x >> 16) | (r[3].x & 0xffff0000u)};
    c[2] = (u32x2){(r[0].y & 0xffffu) | (r[1].y << 16), (r[2].y & 0xffffu) | (r[3].y << 16)};
    c[3] = (u32x2){(r[0].y >> 16) | (r[1].y & 0xffff0000u), (r[2].y >> 16) | (r[3].y & 0xffff0000u)};
}

#define DPP_STEP_ADD(x, ctrl, rmask) x += __builtin_bit_cast(float, __builtin_amdgcn_update_dpp(0, __builtin_bit_cast(int, x), ctrl, rmask, 0xf, false))
#define DPP_STEP_MAX(x, ctrl, rmask) x = fmaxf(x, __builtin_bit_cast(float, __builtin_amdgcn_update_dpp((int)0xff800000, __builtin_bit_cast(int, x), ctrl, rmask, 0xf, false)))
__device__ __forceinline__ float scan_add64(float x) { DPP_STEP_ADD(x, 0x111, 0xf); DPP_STEP_ADD(x, 0x112, 0xf); DPP_STEP_ADD(x, 0x114, 0xf); DPP_STEP_ADD(x, 0x118, 0xf); DPP_STEP_ADD(x, 0x142, 0xa); DPP_STEP_ADD(x, 0x143, 0xc); return x; }
__device__ __forceinline__ float scan_max64(float x) { DPP_STEP_MAX(x, 0x111, 0xf); DPP_STEP_MAX(x, 0x112, 0xf); DPP_STEP_MAX(x, 0x114, 0xf); DPP_STEP_MAX(x, 0x118, 0xf); DPP_STEP_MAX(x, 0x142, 0xa); DPP_STEP_MAX(x, 0x143, 0xc); return x; }
__device__ __forceinline__ float wave_total(float x);
__device__ __forceinline__ float lane63(float x) { return __builtin_bit_cast(float, __builtin_amdgcn_readlane(__builtin_bit_cast(int, x), 63)); }
__device__ __forceinline__ float wave_total(float x) { return lane63(scan_add64(x)); }
constexpr int ML_QS = 0, ML_KS = 17408, ML_PS = 34816, ML_VT = 44032, ML_KT = 78848, ML_SC = 96256;
#ifndef ML_N0
#define ML_N0 23
#define ML_N1 18
#define ML_N2 14
#endif
__device__ __forceinline__ void mlstm_phase(LAS unsigned char* lds, const bf16_t* qkvo, const float* gates, const float* normg, bf16_t* hn, int unit_) {
    const int unit = (unit_ & 7) * 8 + (unit_ >> 5), part_ = (unit_ >> 3) & 3;
    const int c_begin = part_ == 0 ? 0 : (part_ == 1 ? ML_N0 : (part_ == 2 ? ML_N0 + ML_N1 : ML_N0 + ML_N1 + ML_N2));
    const int c_end = part_ == 0 ? ML_N0 : (part_ == 1 ? ML_N0 + ML_N1 : (part_ == 2 ? ML_N0 + ML_N1 + ML_N2 : 65));
    const int tid = threadIdx.x, lane = tid & 63, wid = __builtin_amdgcn_readfirstlane(tid >> 6);
    const int b = unit >> 2, h = unit & 3;
    const int r32 = lane & 31, hh = lane >> 5, l15 = lane & 15, l4 = lane >> 4;
    LAS float* sc = (LAS float*)(lds + ML_SC);
    LAS float* Hs = (LAS float*)lds;
    const int q_row = tid >> 4, q_col = (tid & 15) * 8;
    const int k_dk = (16 * (wid & 1) + l15) * 4, k_s = (4 * (wid >> 1) + l4) * 4;
    const int v_dv = (16 * (wid & 3) + l15) * 4, v_s0 = (4 * (wid >> 2) + l4) * 4;
    f32x16 Cacc[4];
#pragma unroll
    for (int i = 0; i < 4; ++i)
#pragma unroll
        for (int j = 0; j < 16; ++j) Cacc[i][j] = 0.f;
    if (tid < 128) sc[192 + tid] = 0.f;
    float m_run = 0.f;
    u32x4 qreg[2]; u32x2 kreg[4], vreg[2][4]; float g_li = 0.f, g_lf = 0.f;
#define rowof(c, t) ((c) == 0 ? (NR + b * 16 + ((t) - 48)) : (b * SEQ + 64 * ((c) - 1) + (t)))
#define ML_PREFETCH(c) do { \
        if ((c) >= c_begin) _Pragma("unroll") for (int p = 0; p < 2; ++p) { const int t = q_row + 32 * p; const bool pad = ((c) == 0 && t < 48); \
            qreg[p] = pad ? (u32x4){0u, 0u, 0u, 0u} : *(const u32x4*)(qkvo + (size_t)rowof((c), t) * NPROJ + h * 128 + q_col); } \
        _Pragma("unroll") for (int kk = 0; kk < 4; ++kk) { const int t = k_s + kk; const bool pad = ((c) == 0 && t < 48); \
            kreg[kk] = pad ? (u32x2){0u, 0u} : *(const u32x2*)(qkvo + (size_t)rowof((c), t) * NPROJ + 512 + h * 128 + k_dk); } \
        _Pragma("unroll") for (int p = 0; p < 2; ++p) _Pragma("unroll") for (int kk = 0; kk < 4; ++kk) { const int t = v_s0 + 32 * p + kk; const bool pad = ((c) == 0 && t < 48); \
            vreg[p][kk] = pad ? (u32x2){0u, 0u} : *(const u32x2*)(qkvo + (size_t)rowof((c), t) * NPROJ + 1024 + h * 256 + v_dv); } \
        { const bool pad = ((c) == 0 && lane < 48); g_li = pad ? -1e30f : gates[(size_t)rowof((c), lane) * 8 + h]; g_lf = pad ? 0.f : gates[(size_t)rowof((c), lane) * 8 + 4 + h]; } } while (0)
    ML_PREFETCH(0);
    for (int c = 0; c < c_end; ++c) {
        const bool full = (c >= c_begin);
        const float li = g_li;
        const float lf = g_lf;
        const float bc = scan_add64(lf);
        const float av = li - bc;
        const float um = scan_max64(av);
        const float Mt = fmaxf(m_run, um);
        const float winter = __expf(m_run - Mt), bmt = bc + Mt;
        const float M63 = lane63(Mt), b63 = lane63(bc);
        const float wlast = __expf(av - M63), decay = __expf(m_run - M63);
        if (full) {
#pragma unroll
        for (int p = 0; p < 2; ++p) *(LAS u32x4*)(lds + ML_QS + (q_row + 32 * p) * 272 + q_col * 2) = qreg[p]; }
        {
            u32x2 kw[4];
#pragma unroll
            for (int kk = 0; kk < 4; ++kk) {
                if (full) *(LAS u32x2*)(lds + ML_KS + (k_s + kk) * 272 + k_dk * 2) = kreg[kk];
                const float w = __shfl(wlast, k_s + kk) * 0.08838834764831845f;
                kw[kk] = (u32x2){pk2(bflo(kreg[kk].x) * w, bfhi(kreg[kk].x) * w), pk2(bflo(kreg[kk].y) * w, bfhi(kreg[kk].y) * w)};
            }
            u32x2 kc[4]; tr4x4(kw, kc);
#pragma unroll
            for (int j = 0; j < 4; ++j) *(LAS u32x2*)(lds + ML_KT + (k_dk + j) * 136 + k_s * 2) = kc[j];
        }
#pragma unroll
        for (int p = 0; p < 2; ++p) { u32x2 vc[4]; tr4x4(vreg[p], vc);
#pragma unroll
            for (int j = 0; j < 4; ++j) *(LAS u32x2*)(lds + ML_VT + (v_dv + j) * 136 + (v_s0 + 32 * p) * 2) = vc[j]; }
        if (wid == 0) { sc[lane] = winter; sc[128 + lane] = bmt; }
        __syncthreads();
        if (c + 1 < c_end) ML_PREFETCH(c + 1);
        if (full) {
            const int ti = wid >> 1;
#pragma unroll
            for (int q = 0; q < 2; ++q) {
                const int si = 2 * (wid & 1) + q;
                f32x4 sa = {0.f, 0.f, 0.f, 0.f};
                if (si <= ti) {
#pragma unroll
                    for (int ks = 0; ks < 4; ++ks) {
                        const bf16x8 af = *(const LAS bf16x8*)(lds + ML_QS + (16 * ti + l15) * 272 + (32 * ks + 8 * l4) * 2);
                        const bf16x8 bfr = *(const LAS bf16x8*)(lds + ML_KS + (16 * si + l15) * 272 + (32 * ks + 8 * l4) * 2);
                        sa = __builtin_amdgcn_mfma_f32_16x16x32_bf16(af, bfr, sa, 0, 0, 0);
                    }
                }
                const int s = 16 * si + l15;
                const float a_s = __shfl(av, s);
#pragma unroll
                for (int r = 0; r < 4; ++r) {
                    const int t = 16 * ti + 4 * l4 + r;
                    const float Mtt = __shfl(Mt, t);
                    const float w = (s <= t) ? __expf(a_s - Mtt) : 0.f;
                    *(LAS bf16_t*)(lds + ML_PS + t * 144 + s * 2) = f2bf(sa[r] * 0.08838834764831845f * w);
                }
            }
        }
        bf16x8 vf[4];
#pragma unroll
        for (int ks = 0; ks < 4; ++ks) { const LAS unsigned char* p = lds + ML_VT + (32 * wid + r32) * 136 + (16 * ks + 8 * hh) * 2; vf[ks] = ld2x64(p, p + 8); }
        if (full) {
        __syncthreads();
        {
            const int t = tid >> 3, part = tid & 7;
            float qn = 0.f, ps = 0.f;
            const u32x4 q0 = *(const LAS u32x4*)(lds + ML_QS + t * 272 + part * 32), q1 = *(const LAS u32x4*)(lds + ML_QS + t * 272 + part * 32 + 16);
            float qv[16]; { float t8[8]; g8::unpack8(q0, t8);
#pragma unroll
                for (int j = 0; j < 8; ++j) qv[j] = t8[j]; g8::unpack8(q1, t8);
#pragma unroll
                for (int j = 0; j < 8; ++j) qv[8 + j] = t8[j]; }
#pragma unroll
            for (int j = 0; j < 16; ++j) qn += qv[j] * sc[192 + part * 16 + j];
            const u32x4 pw = *(const LAS u32x4*)(lds + ML_PS + t * 144 + part * 16);
            float pv[8]; g8::unpack8(pw, pv);
#pragma unroll
            for (int j = 0; j < 8; ++j) ps += pv[j];
            qn += __shfl_xor(qn, 1); qn += __shfl_xor(qn, 2); qn += __shfl_xor(qn, 4);
            ps += __shfl_xor(ps, 1); ps += __shfl_xor(ps, 2); ps += __shfl_xor(ps, 4);
            if (part == 0) { const float den = sc[t] * qn + ps; sc[64 + t] = __builtin_amdgcn_rcpf(fmaxf(fabsf(den), __expf(-sc[128 + t]))); }
        }
        f32x16 num[2];
#pragma unroll
        for (int tt = 0; tt < 2; ++tt) {
#pragma unroll
            for (int j = 0; j < 16; ++j) num[tt][j] = 0.f;
#pragma unroll
            for (int dkt = 0; dkt < 4; ++dkt)
#pragma unroll
                for (int s2 = 0; s2 < 2; ++s2) {
                    const LAS unsigned char* p = lds + ML_QS + (32 * tt + r32) * 272 + (32 * dkt + 16 * s2 + 4 * hh) * 2;
                    const bf16x8 af = ld2x64(p, p + 16);
                    num[tt] = __builtin_amdgcn_mfma_f32_32x32x16_bf16(af, pack_frag(Cacc[dkt], s2), num[tt], 0, 0, 0);
                }
#pragma unroll
            for (int gq = 0; gq < 4; ++gq) { const f32x4 wv = *(const LAS f32x4*)(sc + 32 * tt + 8 * gq + 4 * hh);
#pragma unroll
                for (int r = 0; r < 4; ++r) num[tt][4 * gq + r] *= wv[r]; }
#pragma unroll
            for (int ks = 0; ks < 4; ++ks) {
                if (tt == 0 && ks >= 2) continue;
                const bf16x8 pf = *(const LAS bf16x8*)(lds + ML_PS + (32 * tt + r32) * 144 + (16 * ks + 8 * hh) * 2);
                num[tt] = __builtin_amdgcn_mfma_f32_32x32x16_bf16(pf, vf[ks], num[tt], 0, 0, 0);
            }
        }
        __syncthreads();
        u32x2 oreg[8];
        { const int t = tid >> 3, part = tid & 7; const bool pad = (c == 0 && t < 48); const size_t row = pad ? 0 : (size_t)rowof(c, t);
#pragma unroll
            for (int i = 0; i < 8; ++i) oreg[i] = *(const u32x2*)(qkvo + row * NPROJ + 2048 + h * 256 + 32 * i + 4 * part); }
#pragma unroll
        for (int tt = 0; tt < 2; ++tt)
#pragma unroll
            for (int gq = 0; gq < 4; ++gq) { const f32x4 iv = *(const LAS f32x4*)(sc + 64 + 32 * tt + 8 * gq + 4 * hh);
#pragma unroll
                for (int r = 0; r < 4; ++r) Hs[(32 * tt + 8 * gq + 4 * hh + r) * 260 + 32 * wid + r32] = num[tt][4 * gq + r] * iv[r]; }
        __syncthreads();
        {
            const int t = tid >> 3, part = tid & 7;
            f32x4 x[8]; float s1 = 0.f;
#pragma unroll
            for (int i = 0; i < 8; ++i) { x[i] = *(const LAS f32x4*)(Hs + t * 260 + 32 * i + 4 * part); s1 += (x[i][0] + x[i][1]) + (x[i][2] + x[i][3]); }
            s1 += __shfl_xor(s1, 1); s1 += __shfl_xor(s1, 2); s1 += __shfl_xor(s1, 4);
            const float mean = s1 * (1.0f / 256.0f); float s2 = 0.f;
#pragma unroll
            for (int i = 0; i < 8; ++i) { const f32x4 d = x[i] - mean; s2 += (d[0] * d[0] + d[1] * d[1]) + (d[2] * d[2] + d[3] * d[3]); }
            s2 += __shfl_xor(s2, 1); s2 += __shfl_xor(s2, 2); s2 += __shfl_xor(s2, 4);
            const float rstd = rsqrtf(s2 * (1.0f / 256.0f) + LN_EPS);
            if (!(c == 0 && t < 48)) {
                const size_t row = (size_t)rowof(c, t);
#pragma unroll
                for (int i = 0; i < 8; ++i) {
                    const int dv = 32 * i + 4 * part;
                    const u32x2 ow = oreg[i];
                    const f32x4 ng = *(const f32x4*)(normg + h * 256 + dv);
                    const float o0 = sigmoidf_(bflo(ow.x)), o1 = sigmoidf_(bfhi(ow.x)), o2 = sigmoidf_(bflo(ow.y)), o3 = sigmoidf_(bfhi(ow.y));
                    const f32x4 y = (x[i] - mean) * rstd * ng;
                    *(u32x2*)(hn + row * D + h * 256 + dv) = (u32x2){pk2(y[0] * o0, y[1] * o1), pk2(y[2] * o2, y[3] * o3)};
                }
            }
        }
        }
#pragma unroll
        for (int dkt = 0; dkt < 4; ++dkt) {
#pragma unroll
            for (int j = 0; j < 16; ++j) Cacc[dkt][j] *= decay;
#pragma unroll
            for (int ks = 0; ks < 4; ++ks) { const LAS unsigned char* p = lds + ML_KT + (32 * dkt + r32) * 136 + (16 * ks + 8 * hh) * 2;
                Cacc[dkt] = __builtin_amdgcn_mfma_f32_32x32x16_bf16(ld2x64(p, p + 8), vf[ks], Cacc[dkt], 0, 0, 0); }
        }
        {
            const int dk = tid >> 2, part = tid & 3;
            const u32x2 k0 = *(const LAS u32x2*)(lds + ML_KT + dk * 136 + part * 32), k1 = *(const LAS u32x2*)(lds + ML_KT + dk * 136 + part * 32 + 8),
                        k2 = *(const LAS u32x2*)(lds + ML_KT + dk * 136 + part * 32 + 16), k3 = *(const LAS u32x2*)(lds + ML_KT + dk * 136 + part * 32 + 24);
            float s = ((bflo(k0.x) + bfhi(k0.x)) + (bflo(k0.y) + bfhi(k0.y))) + ((bflo(k1.x) + bfhi(k1.x)) + (bflo(k1.y) + bfhi(k1.y)))
                    + ((bflo(k2.x) + bfhi(k2.x)) + (bflo(k2.y) + bfhi(k2.y))) + ((bflo(k3.x) + bfhi(k3.x)) + (bflo(k3.y) + bfhi(k3.y)));
            s += __shfl_xor(s, 1); s += __shfl_xor(s, 2);
            if (part == 0) sc[192 + dk] = decay * sc[192 + dk] + s;
        }
        m_run = b63 + M63;
        __syncthreads();
    }
#undef ML_PREFETCH
#undef rowof
}

constexpr float AT_PMIN = 1e-15f;
constexpr int AT_K0 = 0, AT_V0 = 17408, AT_BUF = 34816, AT_FLAGS = 2 * AT_BUF;
__device__ __forceinline__ void at_tile(const LAS unsigned char* Kb, const LAS unsigned char* Vb, int k0, int tmin, int r32, int hh, const bf16x8 (&qf)[8], f32x16 (&O)[4], float& P) {
    f32x16 S[2];
#pragma unroll
    for (int u = 0; u < 2; ++u) {
#pragma unroll
        for (int j = 0; j < 16; ++j) S[u][j] = 0.f;
#pragma unroll
        for (int ks = 0; ks < 8; ++ks) {
            const bf16x8 kf = *(const LAS bf16x8*)(Kb + (32 * u + r32) * 272 + (16 * ks + 8 * hh) * 2);
            S[u] = __builtin_amdgcn_mfma_f32_32x32x16_bf16(kf, qf[ks], S[u], 0, 0, 0);
        }
    }
    const bool full = (k0 + 63 < tmin) && (k0 >= 128);
    const int lim = tmin + r32 - k0 - 4 * hh;
    const int lo = 112 - k0 - 4 * hh;
    float Tt[2][4];
#define AT_ELEM(MASKED) \
    _Pragma("unroll") for (int u = 0; u < 2; ++u) _Pragma("unroll") for (int gq = 0; gq < 4; ++gq) { \
        float x4[4]; \
        _Pragma("unroll") for (int r = 0; r < 4; ++r) { \
            float zz = S[u][4 * gq + r] * (0.08838834764831845f * 1.4426950408889634f); \
            if (MASKED) { const int o = 32 * u + 8 * gq + r; zz = (o < lim && o >= lo) ? zz : -1.0e4f; } \
            const float rc = __builtin_amdgcn_rcpf(1.0f + __builtin_amdgcn_exp2f(zz)); \
            S[u][4 * gq + r] = 1.0f - rc; x4[r] = rc; } \
        const float e2 = x4[3], e1 = e2 * x4[2], e0 = e1 * x4[1]; \
        Tt[u][gq] = e0 * x4[0]; \
        S[u][4 * gq + 2] *= e2; S[u][4 * gq + 1] *= e1; S[u][4 * gq + 0] *= e0; }
    if (full) { AT_ELEM(false) } else { AT_ELEM(true) }
#undef AT_ELEM
    float acc = P;
#pragma unroll
    for (int u = 1; u >= 0; --u)
#pragma unroll
        for (int gq = 3; gq >= 0; --gq) {
            float t0; const float t1 = swap32_hi(Tt[u][gq], t0);
            const float Rr = hh ? acc : acc * t1;
            acc = (acc * t1) * t0;
#pragma unroll
            for (int r = 0; r < 4; ++r) S[u][4 * gq + r] *= Rr;
        }
    P = acc;
#pragma unroll
    for (int u = 0; u < 2; ++u)
#pragma unroll
        for (int s2 = 0; s2 < 2; ++s2) {
            const bf16x8 af = pack_frag(S[u], s2);
#pragma unroll
            for (int dt = 0; dt < 4; ++dt) {
                const LAS unsigned char* p = Vb + (32 * dt + r32) * 136 + (32 * u + 16 * s2 + 4 * hh) * 2;
                O[dt] = __builtin_amdgcn_mfma_f32_32x32x16_bf16(af, ld2x64(p, p + 16), O[dt], 0, 0, 0);
            }
        }
}
__device__ __forceinline__ void attn_phase(LAS unsigned char* lds, const bf16_t* kvq, bf16_t* ao) {
    const int tid = threadIdx.x, lane = tid & 63, wid = __builtin_amdgcn_readfirstlane(tid >> 6);
    const int r32 = lane & 31, hh = lane >> 5, l15 = lane & 15, l4 = lane >> 4;
    LAS unsigned* flags = (LAS unsigned*)(lds + AT_FLAGS);
    const int k_row = tid >> 4, k_col = (tid & 15) * 8;
    const int v_d = (16 * (wid & 1) + l15) * 4, v_s = (4 * (wid >> 1) + l4) * 4;
    for (int ui_ = 0; ui_ < (NB * 8 * 16) / 256; ++ui_) {
        const int xq = blockIdx.x & 7, jq = blockIdx.x >> 3, strm = (ui_ * 8 + xq) * 2 + (jq >> 4);
        const int qt = jq & 15, head = strm & 7, b = strm >> 3;
        const int q0 = 128 + 256 * qt, tmin = q0 + 32 * wid;
#define rowofp(p) ((p) >= 128 ? b * SEQ + (p) - 128 : ((p) >= 112 ? NR + b * 16 + (p) - 112 : NR + b * 16))
        bf16x8 qf[8];
        { const bf16_t* qp = kvq + (size_t)(b * SEQ + tmin - 128 + r32) * NPROJ + 2048 + head * 128 + 8 * hh;
#pragma unroll
            for (int ks = 0; ks < 8; ++ks) qf[ks] = *(const bf16x8*)(qp + 16 * ks); }
        f32x16 O[4];
#pragma unroll
        for (int i = 0; i < 4; ++i)
#pragma unroll
            for (int j = 0; j < 16; ++j) O[i][j] = 0.f;
        float P = 1.0f;
        const int kt_hi = (q0 >> 6) + 3;
        u32x4 kregA[2], kregB[2]; u32x2 vregA[4], vregB[4];
#define AT_LOAD(kreg, vreg, kt) do { \
        _Pragma("unroll") for (int p = 0; p < 2; ++p) kreg[p] = *(const u32x4*)(kvq + (size_t)rowofp(64 * (kt) + k_row + 32 * p) * NPROJ + head * 128 + k_col); \
        _Pragma("unroll") for (int kk = 0; kk < 4; ++kk) vreg[kk] = *(const u32x2*)(kvq + (size_t)rowofp(64 * (kt) + v_s + kk) * NPROJ + 1024 + head * 128 + v_d); } while (0)
#define AT_STORE(kreg, vreg, buf) do { LAS unsigned char* base = lds + (buf) * AT_BUF; \
        _Pragma("unroll") for (int p = 0; p < 2; ++p) *(LAS u32x4*)(base + AT_K0 + (k_row + 32 * p) * 272 + k_col * 2) = kreg[p]; \
        u32x2 vc[4]; tr4x4(vreg, vc); \
        _Pragma("unroll") for (int j = 0; j < 4; ++j) *(LAS u32x2*)(base + AT_V0 + (v_d + j) * 136 + v_s * 2) = vc[j]; } while (0)
#define AT_ITER(BUF, LOADSET_K, LOADSET_V, STORESET_K, STORESET_V) { \
            const int kt = kt_hi - it; \
            __syncthreads(); \
            if (it > 0 && flags[it - 1] == 0u) break; \
            if (kt - 2 >= 1) AT_LOAD(LOADSET_K, LOADSET_V, kt - 2); \
            if (64 * kt < tmin + 31 && __ballot(P >= AT_PMIN) != 0ull) at_tile(lds + (BUF) * AT_BUF + AT_K0, lds + (BUF) * AT_BUF + AT_V0, 64 * kt, tmin, r32, hh, qf, O, P); \
            if (__ballot(P >= AT_PMIN) != 0ull && lane == 0) flags[it] = 1u; \
            if (kt - 1 < 1) break; \
            AT_STORE(STORESET_K, STORESET_V, 1 - (BUF)); \
            ++it; }
        if (tid < 80) flags[tid] = 0u;
        AT_LOAD(kregA, vregA, kt_hi);
        AT_STORE(kregA, vregA, 0);
        AT_LOAD(kregB, vregB, kt_hi - 1);
        for (int it = 0; ; ) {
            AT_ITER(0, kregA, vregA, kregB, vregB)
            AT_ITER(1, kregB, vregB, kregA, vregA)
        }
#pragma unroll
        for (int dt = 0; dt < 4; ++dt)
#pragma unroll
            for (int j = 0; j < 16; ++j) {
                const int t = tmin + (j & 3) + 8 * (j >> 2) + 4 * hh;
                ao[(size_t)(b * SEQ + t - 128) * D + head * 128 + 32 * dt + r32] = f2bf(O[dt][j]);
            }
        __syncthreads();
    }
#undef AT_LOAD
#undef AT_STORE
#undef AT_ITER
#undef rowofp
}

__device__ __forceinline__ void ln_row_stats_wave(const float* st, int row, int lane, float& mu, float& rstd) {
    const f32x2 p = *(const f32x2*)(st + (size_t)row * 32 + (lane & 15) * 2);
    float s1 = p[0], s2 = p[1];
#pragma unroll
    for (int o = 1; o < 16; o <<= 1) { s1 += __shfl_xor(s1, o); s2 += __shfl_xor(s2, o); }
    mu = s1 * (1.0f / 1024.0f); const float var = fmaxf(s2 * (1.0f / 1024.0f) - mu * mu, 0.f); rstd = rsqrtf(var + LN_EPS);
}
__device__ __forceinline__ void router1_phase(LAS unsigned char* lds, const Args& a) {
    const int tid = threadIdx.x, lane = tid & 63, wid = tid >> 6;
    unsigned char* ws = a.ws;
    const float* g3 = a.in[16] + 2048; const float* b3 = a.in[17] + 2048; const float* wr = a.in[12];
    LAS float* gw = (LAS float*)lds;
    LAS float* cc = (LAS float*)(lds + 32768);
    LAS int* cnt = (LAS int*)(lds + 32768 + 64);
    __syncthreads();
    for (int i = tid; i < 8192; i += NTHREADS) { const int k = i >> 3, e = i & 7; gw[e * 1024 + k] = g3[k] * wr[i]; }
    if (tid < 8) cnt[tid] = 0;
    __syncthreads();
    { float s1 = 0.f, s2 = 0.f;
        for (int k = lane; k < 1024; k += 64) { s1 += gw[wid * 1024 + k]; s2 += b3[k] * wr[k * 8 + wid]; }
        s1 = wave_sum(s1); s2 = wave_sum(s2);
        if (lane == 0) { cc[wid] = s1; cc[8 + wid] = s2; } }
    __syncthreads();
    const bf16_t* z3 = (const bf16_t*)(ws + WS_RC); const float* st3 = (const float*)(ws + WS_ST3);
    f32x4* route = (f32x4*)(ws + WS_ROUTE);
    const int tok0 = (int)(((long)NR * blockIdx.x) / gridDim.x), tok1 = (int)(((long)NR * (blockIdx.x + 1)) / gridDim.x);
    u32x4 zrA[2], zrB[2]; f32x2 spA, spB;
#define RT_LOAD2(t) do { const int tb_ = ((t) + 8 < tok1) ? (t) + 8 : (t); \
        zrA[0] = *(const u32x4*)(z3 + (size_t)(t) * D + lane * 8); zrA[1] = *(const u32x4*)(z3 + (size_t)(t) * D + 512 + lane * 8); spA = *(const f32x2*)(st3 + (size_t)(t) * 32 + (lane & 15) * 2); \
        zrB[0] = *(const u32x4*)(z3 + (size_t)tb_ * D + lane * 8); zrB[1] = *(const u32x4*)(z3 + (size_t)tb_ * D + 512 + lane * 8); spB = *(const f32x2*)(st3 + (size_t)tb_ * 32 + (lane & 15) * 2); } while (0)
#define RT_FINISH(tk, acc, mu, rstd) do { float lg[8]; \
        _Pragma("unroll") for (int e = 0; e < 8; ++e) lg[e] = (rstd) * (wave_total(acc[e]) - (mu) * cc[e]) + cc[8 + e]; \
        int e1 = 0; float v1 = lg[0]; \
        _Pragma("unroll") for (int e = 1; e < 8; ++e) if (lg[e] > v1) { v1 = lg[e]; e1 = e; } \
        int e2 = -1; float v2 = -3.0e38f; \
        _Pragma("unroll") for (int e = 0; e < 8; ++e) if (e != e1 && lg[e] > v2) { v2 = lg[e]; e2 = e; } \
        const float g1 = 1.0f / (1.0f + expf(v2 - v1)); \
        if (lane == 0) { ((f32x2*)(ws + WS_TOKST))[tk] = (f32x2){(mu), (rstd)}; route[tk] = (f32x4){__int_as_float(e1 | (e2 << 8)), g1, 1.0f - g1, 0.f}; \
            __hip_atomic_fetch_add(&cnt[e1], 1, __ATOMIC_RELAXED, __HIP_MEMORY_SCOPE_WORKGROUP); __hip_atomic_fetch_add(&cnt[e2], 1, __ATOMIC_RELAXED, __HIP_MEMORY_SCOPE_WORKGROUP); } } while (0)
    if (tok0 + wid < tok1) RT_LOAD2(tok0 + wid);
    for (int tok = tok0 + wid; tok < tok1; tok += 16) {
        const u32x4 zA[2] = {zrA[0], zrA[1]}, zB[2] = {zrB[0], zrB[1]}; const f32x2 sA = spA, sB = spB;
        if (tok + 16 < tok1) RT_LOAD2(tok + 16);
        float a1 = sA[0], a2 = sA[1], b1 = sB[0], b2 = sB[1];
#pragma unroll
        for (int o = 1; o < 16; o <<= 1) { a1 += __shfl_xor(a1, o); a2 += __shfl_xor(a2, o); b1 += __shfl_xor(b1, o); b2 += __shfl_xor(b2, o); }
        const float muA = a1 * (1.0f / 1024.0f), rsA = rsqrtf(fmaxf(a2 * (1.0f / 1024.0f) - muA * muA, 0.f) + LN_EPS);
        const float muB = b1 * (1.0f / 1024.0f), rsB = rsqrtf(fmaxf(b2 * (1.0f / 1024.0f) - muB * muB, 0.f) + LN_EPS);
        float accA[8] = {0.f, 0.f, 0.f, 0.f, 0.f, 0.f, 0.f, 0.f}, accB[8] = {0.f, 0.f, 0.f, 0.f, 0.f, 0.f, 0.f, 0.f};
#pragma unroll
        for (int hf = 0; hf < 2; ++hf) {
            const int k = hf * 512 + lane * 8;
            float za[8], zb[8]; g8::unpack8(zA[hf], za); g8::unpack8(zB[hf], zb);
#pragma unroll
            for (int e = 0; e < 8; ++e) { const f32x4 w0 = *(const LAS f32x4*)(gw + e * 1024 + k), w1 = *(const LAS f32x4*)(gw + e * 1024 + k + 4);
                accA[e] += ((za[0] * w0[0] + za[1] * w0[1]) + (za[2] * w0[2] + za[3] * w0[3])) + ((za[4] * w1[0] + za[5] * w1[1]) + (za[6] * w1[2] + za[7] * w1[3]));
                accB[e] += ((zb[0] * w0[0] + zb[1] * w0[1]) + (zb[2] * w0[2] + zb[3] * w0[3])) + ((zb[4] * w1[0] + zb[5] * w1[1]) + (zb[6] * w1[2] + zb[7] * w1[3])); }
        }
        RT_FINISH(tok, accA, muA, rsA);
        if (tok + 8 < tok1) RT_FINISH(tok + 8, accB, muB, rsB);
    }
#undef RT_LOAD2
#undef RT_FINISH
    __syncthreads();
    if (tid < 8) ((int*)(ws + WS_CNT))[blockIdx.x * 8 + tid] = cnt[tid];
}
__device__ __forceinline__ void router2_phase(LAS unsigned char* lds, const Args& a) {
    const int tid = threadIdx.x, lane = tid & 63, wid = tid >> 6;
    unsigned char* ws = a.ws;
    const int G = gridDim.x, wg = blockIdx.x;
    LAS int* cn = (LAS int*)lds;
    LAS int* tot = (LAS int*)(lds + 16384);
    u32x2* smeta = (u32x2*)(ws + WS_TOK); f32x2* sstat = (f32x2*)(ws + WS_GATEB); const f32x2* tokst = (const f32x2*)(ws + WS_TOKST);
    const f32x4* route = (const f32x4*)(ws + WS_ROUTE);
    const int tok0 = (int)(((long)NR * wg) / G), tok1 = (int)(((long)NR * (wg + 1)) / G);
    f32x4 rr[8]; f32x2 ts[8];
#pragma unroll
    for (int i = 0; i < 8; ++i) { int q = 2 * tok0 + 64 * i + lane; q = q < 2 * tok1 ? q : 2 * tok1 - 1; rr[i] = route[q >> 1]; ts[i] = tokst[q >> 1]; }
    __syncthreads();
    const int* cnts = (const int*)(ws + WS_CNT);
    for (int i = tid; i < G * 8; i += NTHREADS) cn[i] = cnts[i];
    __syncthreads();
    { int t = 0, p = 0;
        for (int w = lane; w < G; w += 64) { const int v = cn[w * 8 + wid]; t += v; p += (w < wg) ? v : 0; }
#pragma unroll
        for (int o = 32; o >= 1; o >>= 1) { t += __shfl_xor(t, o); p += __shfl_xor(p, o); }
        if (lane == 0) { tot[wid] = t; tot[8 + wid] = p; } }
    __syncthreads();
    if (tid == 0) { int ps = 0;
        for (int e = 0; e < 8; ++e) { tot[24 + e] = ps; tot[16 + e] = ps + tot[8 + e]; ps += ((tot[e] + 255) >> 8) << 8; }
        if (wg == 0) { int* hdr = (int*)(ws + WS_HDR); int pp = 0; for (int e = 0; e < 8; ++e) { pp += (tot[e] + 255) >> 8; hdr[e] = pp; } hdr[8] = pp; } }
    __syncthreads();
    { const int e = wid; int run = tot[16 + e];
#pragma unroll
        for (int i = 0; i < 8; ++i) {
            const int q = 2 * tok0 + 64 * i + lane; bool match = false; float gt = 0.f;
            if (q < 2 * tok1) { const f32x4 r = rr[i]; const int ee = __float_as_int(r[0]); const int ex = (q & 1) ? ((ee >> 8) & 0xff) : (ee & 0xff); match = (ex == e); gt = (q & 1) ? r[2] : r[1]; }
            const unsigned long long mask = __ballot(match);
            const int pos = __popcll(mask & ((1ull << lane) - 1ull));
            if (match) { smeta[run + pos] = (u32x2){(unsigned)q, __float_as_uint(gt)}; sstat[run + pos] = ts[i]; }
            run += __popcll(mask);
        }
        if (wg == 0) { const int s0 = tot[24 + e] + tot[e], s1 = tot[24 + e] + (((tot[e] + 255) >> 8) << 8);
            for (int s = s0 + lane; s < s1; s += 64) { smeta[s] = (u32x2){0xffffffffu, 0u}; sstat[s] = (f32x2){0.f, 1.f}; } }
    }
}

__device__ __forceinline__ float wave_total(float x);
__device__ __forceinline__ void final_phase(const Args& a) {
    const int tid = threadIdx.x, lane = tid & 63, wid = tid >> 6;
    unsigned char* ws = a.ws;
    const bf16_t* z3 = (const bf16_t*)(ws + WS_RC); const float* st3 = (const float*)(ws + WS_ST3);
    const bf16_t* Y0 = (const bf16_t*)(ws + WS_RB); const bf16_t* Y1 = (const bf16_t*)(ws + WS_RD);
    const float* g3 = a.in[16] + 2048; const float* b3 = a.in[17] + 2048; const float* g4 = a.in[16] + 3072; const float* b4 = a.in[17] + 3072;
    float G3[16], B3[16], G4[16], B4[16];
#pragma unroll
    for (int hf = 0; hf < 2; ++hf)
#pragma unroll
        for (int q = 0; q < 2; ++q) { const int k = hf * 512 + lane * 8 + q * 4;
            const f32x4 a3 = *(const f32x4*)(g3 + k), c3 = *(const f32x4*)(b3 + k), a4 = *(const f32x4*)(g4 + k), c4 = *(const f32x4*)(b4 + k);
#pragma unroll
            for (int j = 0; j < 4; ++j) { G3[hf * 8 + q * 4 + j] = a3[j] * ALPHA; B3[hf * 8 + q * 4 + j] = c3[j] * ALPHA; G4[hf * 8 + q * 4 + j] = a4[j]; B4[hf * 8 + q * 4 + j] = c4[j]; } }
    const int stride = gridDim.x * 8;
    int tok = blockIdx.x * 8 + wid;
    u32x4 zr[2], y0r[2], y1r[2]; f32x2 sp;
#define FIN_LOAD(t) do { _Pragma("unroll") for (int hf = 0; hf < 2; ++hf) { const size_t o = (size_t)(t) * D + hf * 512 + lane * 8; \
        zr[hf] = *(const u32x4*)(z3 + o); y0r[hf] = *(const u32x4*)(Y0 + o); y1r[hf] = *(const u32x4*)(Y1 + o); } \
        sp = *(const f32x2*)(st3 + (size_t)(t) * 32 + (lane & 15) * 2); } while (0)
    if (tok < NR) FIN_LOAD(tok);
    for (; tok < NR; tok += stride) {
        u32x4 zc[2] = {zr[0], zr[1]}, y0c[2] = {y0r[0], y0r[1]}, y1c[2] = {y1r[0], y1r[1]}; const f32x2 spc = sp;
        if (tok + stride < NR) FIN_LOAD(tok + stride);
        float s1 = spc[0], s2 = spc[1];
#pragma unroll
        for (int o = 1; o < 16; o <<= 1) { s1 += __shfl_xor(s1, o); s2 += __shfl_xor(s2, o); }
        const float mu = s1 * (1.0f / 1024.0f); const float rstd = rsqrtf(fmaxf(s2 * (1.0f / 1024.0f) - mu * mu, 0.f) + LN_EPS);
        float v[16]; float t1 = 0.f;
#pragma unroll
        for (int hf = 0; hf < 2; ++hf) {
            float z[8], y0[8], y1[8];
            g8::unpack8(zc[hf], z); g8::unpack8(y0c[hf], y0); g8::unpack8(y1c[hf], y1);
#pragma unroll
            for (int j = 0; j < 8; ++j) { const float x = ((z[j] - mu) * rstd * G3[hf * 8 + j] + B3[hf * 8 + j]) + (y0[j] + y1[j]); v[hf * 8 + j] = x; t1 += x; }
        }
        t1 = wave_total(t1); const float mean = t1 * (1.0f / 1024.0f); float t2 = 0.f;
#pragma unroll
        for (int j = 0; j < 16; ++j) { const float d = v[j] - mean; t2 += d * d; }
        t2 = wave_total(t2); const float rs = rsqrtf(t2 * (1.0f / 1024.0f) + LN_EPS);
#pragma unroll
        for (int hf = 0; hf < 2; ++hf) {
            const int k = hf * 512 + lane * 8;
            f32x4 o0, o1;
#pragma unroll
            for (int j = 0; j < 4; ++j) { o0[j] = (v[hf * 8 + j] - mean) * rs * G4[hf * 8 + j] + B4[hf * 8 + j]; o1[j] = (v[hf * 8 + 4 + j] - mean) * rs * G4[hf * 8 + 4 + j] + B4[hf * 8 + 4 + j]; }
            *(f32x4*)(a.out + (size_t)tok * D + k) = o0; *(f32x4*)(a.out + (size_t)tok * D + k + 4) = o1;
        }
    }
#undef FIN_LOAD
}

__device__ __forceinline__ void moefix_phase(const Args& a) {
    const int lane = threadIdx.x & 63, wid = threadIdx.x >> 6;
    unsigned char* ws = a.ws;
    const int npan = ((const int*)(ws + WS_HDR))[8];
    const int p_lo = (MOE_NCHUNK - 1) * MOE_CHUNK_PAN + MOE_CHUNK_PAN;
    const int nrows = (npan - p_lo) * 256;
    const u32x2* smeta = (const u32x2*)(ws + WS_TOK);
    const float* P = (const float*)(ws + WS_RA + RA_POFF);
    bf16_t* Y0 = (bf16_t*)(ws + WS_RB); bf16_t* Y1 = (bf16_t*)(ws + WS_RD);
    for (int r = blockIdx.x * 8 + wid; r < nrows; r += gridDim.x * 8) {
        const u32x2 mg = smeta[(size_t)p_lo * 256 + r];
        const int id = (int)mg.x; const float gt = __uint_as_float(mg.y);
        if (id < 0) continue;
        bf16_t* yrow = ((id & 1) ? Y1 : Y0) + (size_t)(id >> 1) * D;
#pragma unroll
        for (int hf = 0; hf < 2; ++hf) {
            const int c = hf * 512 + lane * 8;
            f32x4 s0 = {0.f, 0.f, 0.f, 0.f}, s1 = {0.f, 0.f, 0.f, 0.f};
#pragma unroll
            for (int ks = 0; ks < MOE_KSPLIT; ++ks) { const float* pp = P + ((size_t)ks * 2048 + r) * D + c; s0 += *(const f32x4*)pp; s1 += *(const f32x4*)(pp + 4); }
            *(u32x4*)(yrow + c) = g8::pack8(s0 * gt, s1 * gt);
        }
    }
}
__device__ __forceinline__ void finstats_phase(const float* st, float* rs, int nrows) {
    for (int row = blockIdx.x * NTHREADS + threadIdx.x; row < nrows; row += gridDim.x * NTHREADS) {
        const f32x4* p = (const f32x4*)(st + (size_t)row * 32);
        float s1 = 0.f, s2 = 0.f;
#pragma unroll
        for (int i = 0; i < 8; ++i) { const f32x4 a = p[i]; s1 += a[0] + a[2]; s2 += a[1] + a[3]; }
        const float mu = s1 * (1.0f / 1024.0f); const float rstd = rsqrtf(fmaxf(s2 * (1.0f / 1024.0f) - mu * mu, 0.f) + LN_EPS);
        *(f32x2*)(rs + (size_t)row * 2) = (f32x2){mu, rstd};
    }
}
__global__ void __launch_bounds__(NTHREADS, 2) yoco_fwd(Args args) {
    extern __shared__ __attribute__((aligned(16))) unsigned char lds_raw[];
    LAS unsigned char* lds = (LAS unsigned char*)lds_raw;
    unsigned char* ws = args.ws;
    const int G = gridDim.x;
    const int lo = args.ph_lo, hi = args.ph_hi;
    volatile LAS unsigned* misc = (volatile LAS unsigned*)(lds + LDS_MAIN);
    if (threadIdx.x < 4) misc[threadIdx.x] = 0u;
    __syncthreads();
    XcdBarrier bar; bar.bar = (unsigned*)(ws + WS_CTL); bar.x = 0; bar.st = misc;
    if (hi - lo > 1) bar = xcd_barrier_post((unsigned*)(ws + WS_CTL), misc);
#ifndef PHASE_MASK
#define PHASE_MASK 0xFFFFFFFFu
#endif
#define IN(k) (((PHASE_MASK >> (k)) & 1u) && lo <= (k) && (k) < hi)
#define SEAM(k) do { if (IN(k) && IN((k) + 1)) xcd_barrier(bar); } while (0)
    bf16_t* RA = (bf16_t*)(ws + WS_RA); bf16_t* RB = (bf16_t*)(ws + WS_RB); bf16_t* RC = (bf16_t*)(ws + WS_RC); bf16_t* RD = (bf16_t*)(ws + WS_RD);
    float* vec = (float*)(ws + WS_VEC);
    float* st1 = (float*)(ws + WS_ST1); float* st2 = (float*)(ws + WS_ST2); float* st3 = (float*)(ws + WS_ST3);
    const float* ln_g = args.in[16]; const float* ln_b = args.in[17];

#define RUN(k, ...) do { if constexpr (((REPMASK) >> (k)) & 1u) { if (IN(k)) { __VA_ARGS__ } xcd_barrier(bar); } if (IN(k)) { __VA_ARGS__ } SEAM(k); } while (0)
    RUN(PH_PRO, prologue_phase(lds, args););
    RUN(PH_PROJ,
        g8::Gemm g{RB, (const bf16_t*)(ws + WS_WIN), D, nullptr, nullptr, nullptr}; g8::DenseOrder S; S.init(NPAN, NPROJ / 256, D, G, (int)blockIdx.x);
        g8::EpiPlain E{RA, NPROJ};
        g8::gemm_phase<g8::EpiPlain, g8::DenseOrder, false>(lds, g, S, E); tail_jobs(lds, args, PH_PROJ););
    RUN(PH_MLSTM, if ((int)blockIdx.x < 256) mlstm_phase(lds, RA, (const float*)(ws + WS_GATES), args.in[4], RD, (int)blockIdx.x););
    RUN(PH_WOUT,
        g8::Gemm g{RD, (const bf16_t*)(ws + WS_WOUT), D, nullptr, nullptr, nullptr}; g8::DenseOrder S; S.init(NPAN, 4, D, G, (int)blockIdx.x);
        g8::EpiRes<0> E{RC, RB, st1, lds + LDS_META, nullptr, nullptr};
        g8::gemm_phase<g8::EpiRes<0>, g8::DenseOrder, false>(lds, g, S, E); tail_jobs(lds, args, PH_WOUT););
    RUN(PH_FIN1, finstats_phase(st1, (float*)(ws + WS_RS1), NROWS););
    RUN(PH_GU,
        g8::Gemm g{RC, (const bf16_t*)(ws + WS_WGU), D, nullptr, nullptr, ws + WS_RS1}; g8::DenseOrder S; S.init(NPAN, 2 * FFD / 256, D, G, (int)blockIdx.x);
        g8::EpiGlu<false> E{RA, FFD, st1, vec + VEC_GU_CS, vec + VEC_GU_BW, lds + LDS_META, 0};
        g8::gemm_phase<g8::EpiGlu<false>, g8::DenseOrder, false, 3>(lds, g, S, E); tail_jobs(lds, args, PH_GU););
    RUN(PH_DN,
        g8::Gemm g{RA, (const bf16_t*)(ws + WS_WDN), FFD, nullptr, nullptr, ws + WS_RS1}; g8::DenseOrder S; S.init(NPAN, 4, FFD, G, (int)blockIdx.x);
        g8::EpiRes<1> E{RB, RC, st2, lds + LDS_META, ln_g, ln_b};
        g8::gemm_phase<g8::EpiRes<1>, g8::DenseOrder, false, 3>(lds, g, S, E); tail_jobs(lds, args, PH_DN););
    RUN(PH_FIN2, finstats_phase(st2, (float*)(ws + WS_RS2), NROWS););
    RUN(PH_KVQ,
        g8::Gemm g{RB, (const bf16_t*)(ws + WS_WKVQ), D, nullptr, nullptr, ws + WS_RS2}; g8::DenseOrder S; S.init(NPAN, NPROJ / 256, D, G, (int)blockIdx.x);
        g8::EpiFold E{RA, NPROJ, lds + LDS_META, vec + VEC_KVQ_CS, vec + VEC_KVQ_BW};
        g8::gemm_phase<g8::EpiFold, g8::DenseOrder, false, 3>(lds, g, S, E); tail_jobs(lds, args, PH_KVQ););
    RUN(PH_ATT, attn_phase(lds, RA, RD););
    RUN(PH_WO,
        g8::Gemm g{RD, (const bf16_t*)(ws + WS_WO), D, nullptr, nullptr, ws + WS_RS2}; g8::DenseOrder S; S.init(NR / 256, 4, D, G, (int)blockIdx.x);
        g8::EpiRes<1> E{RC, RB, st3, lds + LDS_META, ln_g + 1024, ln_b + 1024};
        g8::gemm_phase<g8::EpiRes<1>, g8::DenseOrder, false, 3>(lds, g, S, E););
    RUN(PH_RT1, router1_phase(lds, args););
    RUN(PH_RT2, router2_phase(lds, args););
#define MOE_CHUNK(cidx) \
    RUN(PH_MOE0 + 2 * (cidx), const int* hdr = (const int*)(ws + WS_HDR); const int npan = hdr[8]; const int p0 = (cidx) * MOE_CHUNK_PAN; \
        { g8::MoeOrder S; S.p0 = p0; S.np = ((cidx) == MOE_NCHUNK - 1) ? (npan - p0) : MOE_CHUNK_PAN; S.nfull = MOE_CHUNK_PAN; S.nsplit = 1; S.nN = 2 * FFE / 256; S.G = G; S.c = (int)blockIdx.x; S.K = D; S.estride = (unsigned)(2 * FFE * D * 2); \
            _Pragma("unroll") for (int e = 0; e < NE; ++e) S.pend[e] = hdr[e]; \
            g8::Gemm g{RC, (const bf16_t*)(ws + WS_WEGU), D, (const int*)(ws + WS_TOK), ws + WS_TOK, ws + WS_GATEB}; \
            g8::EpiGlu<true> E{RA, FFE, st3, vec + VEC_EGU_CS, vec + VEC_EGU_BW, lds + LDS_META, 2 * FFE}; \
            g8::gemm_phase<g8::EpiGlu<true>, g8::MoeOrder, true, 1>(lds, g, S, E); }); \
    RUN(PH_MOE0 + 2 * (cidx) + 1, const int* hdr = (const int*)(ws + WS_HDR); const int npan = hdr[8]; const int p0 = (cidx) * MOE_CHUNK_PAN; \
        { g8::MoeOrder S; S.p0 = p0; S.np = ((cidx) == MOE_NCHUNK - 1) ? (npan - p0) : MOE_CHUNK_PAN; S.nfull = MOE_CHUNK_PAN; S.nsplit = MOE_KSPLIT; S.nN = 4; S.G = G; S.c = (int)blockIdx.x; S.K = FFE; S.estride = (unsigned)(D * FFE * 2); \
            _Pragma("unroll") for (int e = 0; e < NE; ++e) S.pend[e] = hdr[e]; \
            g8::Gemm g{RA, (const bf16_t*)(ws + WS_WEDN), FFE, nullptr, ws + WS_TOK, nullptr}; \
            g8::EpiMoeDown E{RB, RD, lds + LDS_META, (float*)((unsigned char*)RA + RA_POFF), MOE_CHUNK_PAN}; \
            g8::gemm_phase<g8::EpiMoeDown, g8::MoeOrder, false, 2>(lds, g, S, E); });
    MOE_CHUNK(0) MOE_CHUNK(1) MOE_CHUNK(2) MOE_CHUNK(3)
    RUN(PH_FIX, moefix_phase(args););
    RUN(PH_FINAL, final_phase(args););
    if (PROBE_CLK && blockIdx.x == 0 && threadIdx.x == 0) { const float kv = ((volatile float*)(ws + WS_DIAG))[0]; const long long t0 = wall_clock64(); const long long dl = (long long)(kv * 5000.0f); while (wall_clock64() - t0 < dl) __builtin_amdgcn_s_sleep(8); }
#undef RUN
#undef IN
#undef SEAM
}

extern "C" void kernel_launch(void* const* d_in, const int* in_sizes, int n_in, void* d_out, int out_size, void* d_ws, size_t ws_size, hipStream_t stream) {
    static int grid = 0;
    if (grid == 0) {
        if (n_in != 18 || out_size != NR * D || ws_size < WS_END) { fprintf(stderr, "kernel_launch: unexpected problem (n_in %d out %d ws %zu need %zu)\n", n_in, out_size, ws_size, (size_t)WS_END); grid = -1; return; }
        int dev = 0, cus = 0, per_cu = 0;
        if (hipGetDevice(&dev) != hipSuccess || hipDeviceGetAttribute(&cus, hipDeviceAttributeMultiprocessorCount, dev) != hipSuccess) { grid = -1; return; }
        if (hipFuncSetAttribute((const void*)yoco_fwd, hipFuncAttributeMaxDynamicSharedMemorySize, LDS_BYTES) != hipSuccess) { fprintf(stderr, "kernel_launch: hipFuncSetAttribute failed\n"); grid = -1; return; }
        if (hipOccupancyMaxActiveBlocksPerMultiprocessor(&per_cu, (const void*)yoco_fwd, NTHREADS, LDS_BYTES) != hipSuccess || per_cu < 1) { fprintf(stderr, "kernel_launch: occupancy query says %d\n", per_cu); }
        (void)hipGetLastError();
        if (cus < 256) { fprintf(stderr, "kernel_launch: needs 256 CUs\n"); grid = -1; return; }
        grid = 256;
    }
    if (grid < 0) return;
    (void)hipMemsetAsync((char*)d_ws + WS_CTL, 0, CTL_BYTES, stream);
    Args a{};
    for (int i = 0; i < 18; ++i) a.in[i] = (const float*)d_in[i];
    a.out = (float*)d_out; a.ws = (unsigned char*)d_ws;
#if N_LAUNCH_MODE == 1
    for (int p = 0; p < PH_COUNT; ++p) { a.ph_lo = p; a.ph_hi = p + 1; hipLaunchKernelGGL(yoco_fwd, dim3(grid), dim3(NTHREADS), LDS_BYTES, stream, a); }
#else
    a.ph_lo = 0; a.ph_hi = PH_COUNT;
    hipLaunchKernelGGL(yoco_fwd, dim3(grid), dim3(NTHREADS), LDS_BYTES, stream, a);
#endif
}
```

```cpp
#include <hip/hip_runtime.h>
#include <cstdio>
#include <cstdint>

#ifndef N_LAUNCH_MODE
#define N_LAUNCH_MODE 0
#endif
#ifndef PROBE_CLK
#define PROBE_CLK 0
#endif
#ifndef PROBE_T
#define PROBE_T (-1)
#endif
#ifndef REPMASK
#define REPMASK 0u
#endif

#define LAS __attribute__((address_space(3)))
typedef unsigned short bf16_t;
typedef short bf16x8 __attribute__((ext_vector_type(8)));
typedef float f32x2 __attribute__((ext_vector_type(2)));
typedef float f32x4 __attribute__((ext_vector_type(4)));
typedef float f32x16 __attribute__((ext_vector_type(16)));
typedef unsigned u32x2 __attribute__((ext_vector_type(2)));
typedef unsigned u32x4 __attribute__((ext_vector_type(4)));
typedef __bf16 bf16x2_t __attribute__((ext_vector_type(2)));

constexpr int D = 1024, NB = 16, SEQ = 4096, NMETA = 16;
constexpr int NR = NB * SEQ;
constexpr int NROWS = NR + NB * NMETA;
constexpr int NPAN = NROWS / 256;
constexpr int NPROJ = 3072;
constexpr int FFD = 2816, NE = 8, FFE = 3584;
constexpr float ALPHA = 1.41421356237f, LN_EPS = 1e-5f;
constexpr int NTHREADS = 512;
constexpr int MOE_ROWS = 2 * NR + NE * 256;
constexpr int MOE_CHUNK_PAN = 128;
constexpr int MOE_NCHUNK = 4;
constexpr int MOE_KSPLIT = 7;
constexpr size_t RA_POFF = (size_t)256 << 20;

constexpr size_t al256(size_t x) { return (x + 255) & ~(size_t)255; }
constexpr size_t WS_CTL = 0;
constexpr size_t CTL_BYTES = 65536;
constexpr size_t WS_WIN = WS_CTL + CTL_BYTES;
constexpr size_t WS_WOUT = WS_WIN + (size_t)NPROJ * D * 2;
constexpr size_t WS_WGU = WS_WOUT + (size_t)D * D * 2;
constexpr size_t WS_WDN = WS_WGU + (size_t)2 * FFD * D * 2;
constexpr size_t WS_WKVQ = WS_WDN + (size_t)D * FFD * 2;
constexpr size_t WS_WO = WS_WKVQ + (size_t)NPROJ * D * 2;
constexpr size_t WS_WEGU = WS_WO + (size_t)D * D * 2;
constexpr size_t WS_WEDN = WS_WEGU + (size_t)NE * 2 * FFE * D * 2;
constexpr size_t WS_VEC = WS_WEDN + (size_t)NE * D * FFE * 2;
constexpr int VEC_GU_CS = 0, VEC_GU_BW = 2 * FFD, VEC_KVQ_CS = 4 * FFD, VEC_KVQ_BW = VEC_KVQ_CS + NPROJ, VEC_EGU_CS = VEC_KVQ_BW + NPROJ, VEC_EGU_BW = VEC_EGU_CS + NE * 2 * FFE, VEC_END = VEC_EGU_BW + NE * 2 * FFE;
constexpr size_t WS_GATES = al256(WS_VEC + (size_t)VEC_END * 4);
constexpr size_t WS_ST1 = al256(WS_GATES + (size_t)NROWS * 8 * 4);
constexpr size_t WS_ST2 = WS_ST1 + (size_t)NROWS * 16 * 8;
constexpr size_t WS_ST3 = WS_ST2 + (size_t)NROWS * 16 * 8;
constexpr size_t WS_ROUTE = WS_ST3 + (size_t)NROWS * 16 * 8;
constexpr size_t WS_CNT = WS_ROUTE + (size_t)NR * 16;
constexpr size_t WS_HDR = WS_CNT + 256 * 8 * 4;
constexpr size_t WS_TOK = WS_HDR + 256;
constexpr size_t WS_GATEB = al256(WS_TOK + (size_t)MOE_ROWS * 8);
constexpr size_t WS_TOKST = al256(WS_GATEB + (size_t)MOE_ROWS * 8);
constexpr size_t WS_RS1 = al256(WS_TOKST + (size_t)NR * 8);
constexpr size_t WS_RS2 = al256(WS_RS1 + (size_t)NROWS * 8);
constexpr size_t WS_DIAG = al256(WS_RS2 + (size_t)NROWS * 8);
constexpr size_t WS_RA = al256(WS_DIAG + 4096);
constexpr size_t RA_BYTES = (size_t)NROWS * NPROJ * 2;
constexpr size_t WS_RB = al256(WS_RA + RA_BYTES);
constexpr size_t RX_BYTES = (size_t)NROWS * D * 2;
constexpr size_t WS_RC = al256(WS_RB + RX_BYTES);
constexpr size_t WS_RD = al256(WS_RC + RX_BYTES);
constexpr size_t WS_END = al256(WS_RD + RX_BYTES);

constexpr int LDS_MAIN = 131072, LDS_META = LDS_MAIN  , LDS_MISC = LDS_META + 8192  , LDS_BYTES = LDS_MISC + 256;
__device__ __forceinline__ float bf2f(bf16_t v) { return __uint_as_float(((unsigned)v) << 16); }
__device__ __forceinline__ float bflo(unsigned u) { return __uint_as_float(u << 16); }
__device__ __forceinline__ float bfhi(unsigned u) { return __uint_as_float(u & 0xffff0000u); }
__device__ __forceinline__ unsigned pk2(float lo, float hi) { f32x2 v = {lo, hi}; bf16x2_t b = __builtin_convertvector(v, bf16x2_t); return __builtin_bit_cast(unsigned, b); }
__device__ __forceinline__ bf16_t f2bf(float f) { return (bf16_t)(pk2(f, 0.f) & 0xffffu); }
__device__ __forceinline__ float rbf(float f) { return bflo(pk2(f, 0.f)); }
__device__ __forceinline__ float wave_sum(float v) {
#pragma unroll
    for (int o = 32; o >= 1; o >>= 1) v += __shfl_xor(v, o);
    return v;
}
__device__ __forceinline__ float swap32_hi(float x, float& lo) {
    const u32x2 r = __builtin_amdgcn_permlane32_swap(__float_as_uint(x), __float_as_uint(x), false, false); lo = __uint_as_float(r.x); return __uint_as_float(r.y); }
__device__ __forceinline__ float fq_sum(float x) {
    const u32x2 a = __builtin_amdgcn_permlane16_swap(__float_as_uint(x), __float_as_uint(x), false, false); const float y = __uint_as_float(a.x) + __uint_as_float(a.y);
    const u32x2 b = __builtin_amdgcn_permlane32_swap(__float_as_uint(y), __float_as_uint(y), false, false); return __uint_as_float(b.x) + __uint_as_float(b.y); }
__device__ __forceinline__ float sigmoidf_(float x) { return __builtin_amdgcn_rcpf(1.0f + __builtin_amdgcn_exp2f(x * -1.4426950408889634f)); }

#define XB_TMO      128
#define XB_XCNT(j)  (256  + 64 * (j))
#define XB_XSUB(j)  (1280 + 64 * (j))
#define XB_XGEN(j)  (2304 + 64 * (j))
#define XB_TOP      3328
#define XB_TOPGEN   3392
#define XCD_BAR_WORDS 3456
#define XB_SPIN_CAP (1u << 20)
__device__ __forceinline__ unsigned xb_ld(unsigned* p)              { return __hip_atomic_load(p, __ATOMIC_RELAXED, __HIP_MEMORY_SCOPE_AGENT); }
__device__ __forceinline__ unsigned xb_add(unsigned* p, unsigned v) { return __hip_atomic_fetch_add(p, v, __ATOMIC_RELAXED, __HIP_MEMORY_SCOPE_AGENT); }
__device__ __forceinline__ unsigned xb_xcc_id() { return (unsigned)__builtin_amdgcn_s_getreg((3 << 11) | 20) & 0xFu; }
#define XB_SPIN(cond, bar) do { unsigned _sp = 0; while (cond) { __builtin_amdgcn_s_sleep(1); \
    if ((++_sp & 255u) == 0u) { if (xb_ld(&(bar)[XB_TMO])) break; if (_sp > XB_SPIN_CAP) { atomicAdd(&(bar)[XB_TMO], 1u); break; } } } } while (0)
struct XcdBarrier { unsigned* bar; unsigned x; volatile LAS unsigned* st; };
__device__ __forceinline__ XcdBarrier xcd_barrier_post(unsigned* bar, volatile LAS unsigned* st) {
    XcdBarrier b; b.bar = bar; b.x = xb_xcc_id(); b.st = st;
    if (threadIdx.x == 0) (void)xb_add(&bar[XB_XCNT(b.x)], 1u);
    return b;
}
__device__ __forceinline__ void xcd_barrier_complete(unsigned* bar, unsigned x, unsigned& nloc, unsigned& nx) {
    const unsigned G = gridDim.x * gridDim.y * gridDim.z;
    unsigned sum, cnt, mine, sp = 0u;
    for (;;) {
        sum = 0u; cnt = 0u; mine = 0u;
#pragma unroll
        for (unsigned j = 0; j < 16; ++j) { const unsigned c = xb_ld(&bar[XB_XCNT(j)]); sum += c; cnt += (c > 0u) ? 1u : 0u; mine = (j == x) ? c : mine; }
        if (sum == G) break;
        __builtin_amdgcn_s_sleep(1);
        if ((++sp & 255u) == 0u) { if (xb_ld(&bar[XB_TMO])) break; if (sp > XB_SPIN_CAP) { atomicAdd(&bar[XB_TMO], 1u); break; } }
    }
    nloc = mine > 0u ? mine : 1u; nx = cnt > 0u ? cnt : 1u;
}
__device__ __forceinline__ void xcd_barrier(const XcdBarrier& b) {
    asm volatile("s_waitcnt vmcnt(0)" ::: "memory");
    __syncthreads();
    if (threadIdx.x == 0) {
        unsigned* bar = b.bar;
        __builtin_amdgcn_s_waitcnt(0);
        unsigned nloc = b.st[0], nx = b.st[1];
        if (nloc == 0u) { xcd_barrier_complete(bar, b.x, nloc, nx); b.st[0] = nloc; b.st[1] = nx; }
        const unsigned old = xb_add(&bar[XB_XSUB(b.x)], 1u);
        const unsigned gen = old / nloc;
        if (old + 1u == (gen + 1u) * nloc) {
            __builtin_amdgcn_fence(__ATOMIC_RELEASE, "agent");
            asm volatile("s_waitcnt vmcnt(0)" ::: "memory");
            const unsigned og = xb_add(&bar[XB_TOP], 1u);
            const unsigned tg = og / nx;
            if (og + 1u == (tg + 1u) * nx) xb_add(&bar[XB_TOPGEN], 1u);
            else XB_SPIN(xb_ld(&bar[XB_TOPGEN]) == tg, bar);
            __builtin_amdgcn_fence(__ATOMIC_ACQUIRE, "agent");
            xb_add(&bar[XB_XGEN(b.x)], 1u);
            asm volatile("s_waitcnt vmcnt(0)" ::: "memory");
        } else {
            XB_SPIN(xb_ld(&bar[XB_XGEN(b.x)]) == gen, bar);
            __builtin_amdgcn_fence(__ATOMIC_ACQUIRE, "agent");
            asm volatile("s_waitcnt vmcnt(0)" ::: "memory");
        }
    }
    __syncthreads();
}

namespace g8 {
constexpr int BM = 256, BK = 64, HALF = 128, HTB = HALF * BK * 2, STAGE_BYTES = 8 * HTB, NXCD = 8, WGM = 8;
__host__ __device__ __forceinline__ int lds_byte(int r, int c) { const int st = (r >> 4) * 2 + (c >> 5), rr = r & 15, cc = c & 31, ob = rr * 64 + cc * 2; return st * 1024 + (ob ^ (((ob >> 9) & 1) << 5)); }
__host__ __device__ __forceinline__ void stage_rc(int b, int& R, int& C) { const int st = b / 1024, sb = b % 1024, swz = sb ^ (((sb >> 9) & 1) << 5); R = (st >> 1) * 16 + swz / 64; C = (st & 1) * 32 + (swz % 64) / 2; }
__host__ __device__ __forceinline__ int perm32(int rho) { const int n = rho >> 4, i = rho & 15; return 8 * (i >> 2) + 4 * n + (i & 3); }

struct Unit { int pm, pn, gp; unsigned boff; int aux; int kt; unsigned koff; int ks; };
struct Gemm { const bf16_t* A; const bf16_t* Bt; int K; const int* rowtab; const unsigned char* smeta; const unsigned char* sstat; };

struct DenseOrder {
    int nM, nN, nwg, G, c, K;
    __device__ void init(int nM_, int nN_, int K_, int G_, int c_) { nM = nM_; nN = nN_; nwg = nM * nN; G = G_; c = c_; K = K_; }
    __device__ bool next(int i, Unit& u) const {
        const long L = (long)i * G + c; if (L >= nwg) return false;
        int wgid = (int)L; { const int q = nwg / NXCD, r = nwg % NXCD, xcd = wgid % NXCD, off = wgid / NXCD; wgid = (xcd < r ? xcd * (q + 1) : r * (q + 1) + (xcd - r) * q) + off; }
        const int nig = WGM * nN, gid = wgid / nig, fm = gid * WGM, gsz = (nM - fm) < WGM ? (nM - fm) : WGM;
        u.pm = fm + ((wgid % nig) % gsz); u.pn = (wgid % nig) / gsz; u.gp = u.pm; u.boff = (unsigned)u.pn * (unsigned)(256 * K * 2); u.kt = K / BK; u.koff = 0u; u.ks = -1; return true;
    }
};
struct MoeOrder {
    int p0, np, nN, G, c, K; unsigned estride; int pend[NE]; int nfull, nsplit;
    __device__ bool next(int i, Unit& u) const {
        const long L = (long)i * G + c; const long nmain = (long)nfull * nN;
        int pn, pml, ks = -1;
        if (L < nmain) {
            if (G == 256 && nfull == 128 && (nN & 3) == 0) { const int x = c & 7, j = c >> 3, rpb = nN >> 2, pb = x + 8 * (i / rpb), nb = i % rpb;
                pml = 8 * pb + (j & 7); pn = 4 * nb + (j >> 3); }
            else { pn = (int)(L / nfull); pml = (int)(L % nfull); } }
        else { const long r = L - nmain; if (r >= (long)(np - nfull) * nN * nsplit) return false;
            ks = (int)(r % nsplit); const int q = (int)(r / nsplit); pn = q % nN; pml = nfull + q / nN; if (nsplit == 1) ks = -1; }
        const int gp = p0 + pml;
        int e = 0;
#pragma unroll
        for (int j = 0; j < NE - 1; ++j) e += (gp >= pend[j]) ? 1 : 0;
        const int ktall = K / BK;
        u.pm = pml; u.pn = pn; u.gp = gp; u.ks = ks; u.kt = ks < 0 ? ktall : ktall / nsplit; u.koff = ks < 0 ? 0u : (unsigned)(ks * (K / nsplit) * 2);
        u.boff = (unsigned)e * estride + (unsigned)pn * (unsigned)(256 * K * 2) + u.koff; return true;
    }
};

template <class Epi, class Sched, bool GATHER, int META = 0>
__device__ __forceinline__ void gemm_phase(LAS unsigned char* lds, const Gemm g, const Sched& S, const Epi& E) {
    const int tid = threadIdx.x, wid = __builtin_amdgcn_readfirstlane(tid >> 6), lane = tid & 63, wr = wid >> 2, wc = wid & 3, fr = lane & 15, fq = lane >> 4;
    const int K = g.K;
    int Rr[2], Cc[2]; unsigned voffA[2], voffB[2];
#pragma unroll
    for (int i = 0; i < 2; ++i) { stage_rc(tid * 16 + i * 8192, Rr[i], Cc[i]); const int Rb = (Rr[i] & ~31) + perm32(Rr[i] & 31);
        voffA[i] = (unsigned)(Rr[i] * K + Cc[i]) * 2u; voffB[i] = (unsigned)(Rb * K + Cc[i]) * 2u; }
    const size_t kstep = (size_t)(BK * 2);
    const size_t hstep = (size_t)HALF * K * 2;
    const size_t tstep = 2 * hstep;
    const unsigned ldsw = (unsigned)wid * 1024u;
    const int aoff = lds_byte(wr * 64 + fr, fq * 8), boff = lds_byte(wc * 32 + fr, fq * 8);
#define G8_SA(b, h) (((b) * 2 + (h)) * HTB)
#define G8_SB(b, h) ((4 + (b) * 2 + (h)) * HTB)
#define G8_STAGE(bufoff, gbase, voff) do { _Pragma("unroll") for (int _i = 0; _i < 2; ++_i) \
        __builtin_amdgcn_global_load_lds((const unsigned*)((const char*)(gbase) + (voff)[_i]), (LAS unsigned*)(lds + (bufoff) + ldsw + _i * 8192), 16, 0, 0); } while (0)
#define G8_STA(bufoff, ptr, offs, h) do { if constexpr (GATHER) { G8_STAGE(bufoff, (const char*)g.A, (offs)[h]); } else { G8_STAGE(bufoff, (ptr) + (h) * hstep, voffA); } } while (0)
#define G8_LDA(dst, b, h) do { _Pragma("unroll") for (int m = 0; m < 4; ++m) _Pragma("unroll") for (int k = 0; k < 2; ++k) dst[m][k] = *(const LAS bf16x8*)(lds + G8_SA(b, h) + aoff + m * 2048 + k * 1024); } while (0)
#define G8_LDB(dst, b, h) do { _Pragma("unroll") for (int n = 0; n < 2; ++n) _Pragma("unroll") for (int k = 0; k < 2; ++k) dst[n][k] = *(const LAS bf16x8*)(lds + G8_SB(b, h) + boff + n * 2048 + k * 1024); } while (0)
#define G8_MMA(ai, bj, At, Bt) do { __builtin_amdgcn_s_setprio(1); _Pragma("unroll") for (int m = 0; m < 4; ++m) _Pragma("unroll") for (int n = 0; n < 2; ++n) _Pragma("unroll") for (int k = 0; k < 2; ++k) \
        acc[ai][bj][m][n] = __builtin_amdgcn_mfma_f32_16x16x32_bf16(Bt[n][k], At[m][k], acc[ai][bj][m][n], 0, 0, 0); __builtin_amdgcn_s_setprio(0); } while (0)
#define G8_WAIT_V(n) asm volatile("s_waitcnt vmcnt(" #n ")" ::: "memory")
#define G8_WAIT_L(n) asm volatile("s_waitcnt lgkmcnt(" #n ")" ::: "memory")
#define G8_BAR __builtin_amdgcn_s_barrier()
#define G8_SCHED __builtin_amdgcn_sched_barrier(0)
#define G8_ROWOFFS(dst, U) do { _Pragma("unroll") for (int _h = 0; _h < 2; ++_h) _Pragma("unroll") for (int _i = 0; _i < 2; ++_i) { \
        const int _id = g.rowtab[2 * ((U).gp * 256 + _h * 128 + Rr[_i])]; const int _tk = _id < 0 ? 0 : (_id >> 1); dst[_h][_i] = (unsigned)(_tk * K + Cc[_i]) * 2u; } } while (0)
#define G8_META_DMA(gsrc, panel, bufidx) __builtin_amdgcn_global_load_lds((const unsigned*)((gsrc) + (size_t)(panel) * 2048 + wid * 256 + lane * 4), (LAS unsigned*)(lds + LDS_META + (bufidx) * 2048 + wid * 256), 4, 0, 0)
    Unit cur, nxt; int ui = 0;
    if (!S.next(0, cur)) return;
    f32x4 acc[2][2][4][2];
#pragma unroll
    for (int a = 0; a < 2; ++a)
#pragma unroll
        for (int b = 0; b < 2; ++b)
#pragma unroll
            for (int m = 0; m < 4; ++m)
#pragma unroll
                for (int n = 0; n < 2; ++n) acc[a][b][m][n] = (f32x4){0.f, 0.f, 0.f, 0.f};
    bf16x8 At[4][2], B0[2][2], B1[2][2];
    const char* cA = (const char*)g.A + (size_t)cur.pm * tstep + cur.koff; const char* cB = (const char*)g.Bt + cur.boff;
    unsigned oc[2][2], on[2][2], o1[2][2], o2[2][2], o3[2][2];
    if constexpr (GATHER) { G8_ROWOFFS(oc, cur);
#pragma unroll
        for (int h = 0; h < 2; ++h)
#pragma unroll
            for (int i = 0; i < 2; ++i) { o1[h][i] = oc[h][i] + 128u; on[h][i] = oc[h][i]; o2[h][i] = 0; o3[h][i] = 0; } }
    G8_STAGE(G8_SB(0, 0), cB, voffB); G8_STAGE(G8_SB(0, 1), cB + hstep, voffB); G8_STA(G8_SA(0, 0), cA, oc, 0); G8_STA(G8_SA(0, 1), cA, oc, 1);
    if (wr == 1) G8_BAR;
    G8_WAIT_V(2); G8_BAR;
    G8_STAGE(G8_SB(1, 0), cB + kstep, voffB); G8_STA(G8_SA(1, 0), cA + kstep, o1, 0); G8_STAGE(G8_SB(1, 1), cB + hstep + kstep, voffB);
    G8_WAIT_V(6); G8_BAR;
    for (;;) {
        const bool has_next = S.next(ui + 1, nxt);
        const char* nA = has_next ? (const char*)g.A + (size_t)nxt.pm * tstep + nxt.koff : cA; const char* nB = has_next ? (const char*)g.Bt + nxt.boff : cB;
        const int nt = cur.kt;
        if constexpr (META == 1) { if (has_next) G8_META_DMA(g.smeta, nxt.gp, (ui + 1) & 1); G8_META_DMA(g.sstat, cur.gp, 2 + (ui & 1)); }
        if constexpr (META == 2) { G8_META_DMA(g.smeta, cur.gp, ui & 1); }
        if constexpr (META == 3) { G8_META_DMA(g.sstat, cur.pm, 2 + (ui & 1)); }
        for (int t = 0; t < nt; t += 2) {
            const bool last = (t == nt - 2);
            const char* a1 = cA + (size_t)(t + 1) * kstep;
            const char* a2 = last ? nA : cA + (size_t)(t + 2) * kstep; const char* b2 = last ? nB : cB + (size_t)(t + 2) * kstep;
            const char* a3 = a2 + kstep; const char* b3 = b2 + kstep;
            if constexpr (GATHER) {
                if (last) {
#pragma unroll
                    for (int h = 0; h < 2; ++h)
#pragma unroll
                        for (int i = 0; i < 2; ++i) { int id = -1; if (has_next) id = *(const LAS int*)(lds + LDS_META + ((ui + 1) & 1) * 2048 + (h * 128 + Rr[i]) * 8);
                            const int tk = id < 0 ? 0 : (id >> 1); on[h][i] = has_next ? (unsigned)(tk * K + Cc[i]) * 2u : oc[h][i]; } }
#pragma unroll
                for (int h = 0; h < 2; ++h)
#pragma unroll
                    for (int i = 0; i < 2; ++i) { o1[h][i] = oc[h][i] + (unsigned)(t + 1) * 128u; o2[h][i] = last ? on[h][i] : oc[h][i] + (unsigned)(t + 2) * 128u; o3[h][i] = o2[h][i] + 128u; } }
            G8_LDB(B0, 0, 0); G8_LDB(B1, 0, 1); G8_SCHED; G8_LDA(At, 0, 0); G8_STA(G8_SA(1, 1), a1, o1, 1);
            G8_WAIT_V(8); G8_WAIT_L(0); G8_BAR; G8_MMA(0, 0, At, B0); G8_MMA(0, 1, At, B1); G8_BAR; G8_SCHED;
            G8_LDA(At, 0, 1); G8_STAGE(G8_SB(0, 0), b2, voffB); G8_STAGE(G8_SB(0, 1), b2 + hstep, voffB); G8_STA(G8_SA(0, 0), a2, o2, 0);
            G8_WAIT_V(8); G8_WAIT_L(0); G8_BAR; G8_MMA(1, 0, At, B0); G8_MMA(1, 1, At, B1); G8_BAR; G8_SCHED;
            G8_LDB(B0, 1, 0); G8_LDB(B1, 1, 1); G8_SCHED; G8_LDA(At, 1, 0); G8_STA(G8_SA(0, 1), a2, o2, 1);
            G8_WAIT_V(8); G8_WAIT_L(0); G8_BAR; G8_MMA(0, 0, At, B0); G8_MMA(0, 1, At, B1); G8_BAR; G8_SCHED;
            G8_LDA(At, 1, 1); G8_STAGE(G8_SB(1, 0), b3, voffB); G8_STAGE(G8_SB(1, 1), b3 + hstep, voffB); G8_STA(G8_SA(1, 0), a3, o3, 0);
            G8_WAIT_V(8); G8_WAIT_L(0); G8_BAR; G8_MMA(1, 0, At, B0); G8_MMA(1, 1, At, B1); G8_BAR; G8_SCHED;
        }
        if (wr == 0) G8_BAR;
        cur.aux = ui & 1;
        E(acc, cur, wr, wc, fr, fq);
        if (!has_next) break;
#pragma unroll
        for (int a = 0; a < 2; ++a)
#pragma unroll
            for (int b = 0; b < 2; ++b)
#pragma unroll
                for (int m = 0; m < 4; ++m)
#pragma unroll
                    for (int n = 0; n < 2; ++n) acc[a][b][m][n] = (f32x4){0.f, 0.f, 0.f, 0.f};
        cur = nxt; cA = nA; cB = nB; ++ui;
        if constexpr (GATHER) {
#pragma unroll
            for (int h = 0; h < 2; ++h)
#pragma unroll
                for (int i = 0; i < 2; ++i) oc[h][i] = on[h][i]; }
        if (wr == 1) G8_BAR;
    }
    G8_WAIT_V(0);
    G8_BAR;
#undef G8_SA
#undef G8_SB
#undef G8_STAGE
#undef G8_STA
#undef G8_LDA
#undef G8_LDB
#undef G8_MMA
#undef G8_WAIT_V
#undef G8_WAIT_L
#undef G8_BAR
#undef G8_SCHED
#undef G8_ROWOFFS
#undef G8_META_DMA
}

typedef f32x4 Acc[2][2][4][2];
__device__ __forceinline__ u32x4 pack8(const f32x4 a, const f32x4 b) { u32x4 w; w.x = pk2(a[0], a[1]); w.y = pk2(a[2], a[3]); w.z = pk2(b[0], b[1]); w.w = pk2(b[2], b[3]); return w; }
__device__ __forceinline__ void unpack8(const u32x4 w, float (&f)[8]) { f[0] = bflo(w.x); f[1] = bfhi(w.x); f[2] = bflo(w.y); f[3] = bfhi(w.y); f[4] = bflo(w.z); f[5] = bfhi(w.z); f[6] = bflo(w.w); f[7] = bfhi(w.w); }
__device__ __forceinline__ void row_stats(const float* st, int row, int fq, float& mu, float& rstd) {
    const f32x4* p = (const f32x4*)(st + (size_t)row * 32 + fq * 8);
    const f32x4 a = p[0], b = p[1];
    float s1 = (a[0] + a[2]) + (b[0] + b[2]), s2 = (a[1] + a[3]) + (b[1] + b[3]);
    s1 += __shfl_xor(s1, 16); s1 += __shfl_xor(s1, 32); s2 += __shfl_xor(s2, 16); s2 += __shfl_xor(s2, 32);
    mu = s1 * (1.0f / 1024.0f); const float var = fmaxf(s2 * (1.0f / 1024.0f) - mu * mu, 0.f); rstd = rsqrtf(var + LN_EPS);
}
__device__ __forceinline__ void put_stats(float* st, int row, int slot, int fq, float s1, float s2) {
    s1 = fq_sum(s1); s2 = fq_sum(s2);
    if (fq == 0) *(f32x2*)(st + (size_t)row * 32 + slot * 2) = (f32x2){s1, s2};
}

struct EpiPlain {
    bf16_t* O; int ldc;
    __device__ __forceinline__ void operator()(const Acc& acc, const Unit& u, int wr, int wc, int fr, int fq) const {
        const int row0 = u.pm * 256 + wr * 64 + fr, col0 = u.pn * 256 + wc * 32 + 8 * fq;
#pragma unroll
        for (int ai = 0; ai < 2; ++ai)
#pragma unroll
            for (int m = 0; m < 4; ++m) { bf16_t* rowp = O + (size_t)(row0 + ai * 128 + m * 16) * ldc + col0;
#pragma unroll
                for (int bj = 0; bj < 2; ++bj) *(u32x4*)(rowp + bj * 128) = pack8(acc[ai][bj][m][0], acc[ai][bj][m][1]); }
    }
};
template <int MODE> struct EpiRes {
    bf16_t* Z; const bf16_t* Rsrc; float* st_out; LAS unsigned char* ldsm; const float* g; const float* b;
    __device__ __forceinline__ void operator()(const Acc& acc, const Unit& u, int wr, int wc, int fr, int fq) const {
        const int r0 = wr * 64 + fr, col0 = u.pn * 256 + wc * 32 + 8 * fq;
        f32x4 gv[2][2], bv[2][2];
        if (MODE == 1) {
#pragma unroll
            for (int bj = 0; bj < 2; ++bj)
#pragma unroll
                for (int n = 0; n < 2; ++n) { gv[bj][n] = *(const f32x4*)(g + col0 + bj * 128 + 4 * n); bv[bj][n] = *(const f32x4*)(b + col0 + bj * 128 + 4 * n); }
        }
        u32x4 rwa[4][4][2];
#define EPR_LOAD(am_) do { _Pragma("unroll") for (int m = 2 * ((am_) & 1); m < 2 * ((am_) & 1) + 2; ++m) _Pragma("unroll") for (int bj = 0; bj < 2; ++bj) \
            rwa[am_][m][bj] = *(const u32x4*)(Rsrc + ((size_t)u.pm * 256 + r0 + ((am_) >> 1) * 128 + m * 16) * D + col0 + bj * 128); } while (0)
        EPR_LOAD(0);
#pragma unroll
        for (int am = 0; am < 4; ++am) { const int ai = am >> 1;
            if (am + 1 < 4) EPR_LOAD(am + 1);
            u32x4 (&rw)[4][2] = rwa[am];
#pragma unroll
            for (int m = 2 * (am & 1); m < 2 * (am & 1) + 2; ++m) {
                const int rl = r0 + ai * 128 + m * 16; const size_t row = (size_t)u.pm * 256 + rl;
                float mu = 0.f, rstd = 1.f;
                if (MODE == 1) { const f32x2 ms = *(const LAS f32x2*)(ldsm + (2 + u.aux) * 2048 + rl * 8); mu = ms[0]; rstd = ms[1]; }
                float s1 = 0.f, s2 = 0.f;
#pragma unroll
                for (int bj = 0; bj < 2; ++bj) {
                    float r[8]; unpack8(rw[m][bj], r);
                    f32x4 v0, v1;
#pragma unroll
                    for (int j = 0; j < 4; ++j) {
                        float h0 = r[j], h1 = r[4 + j];
                        if (MODE == 1) { h0 = (h0 - mu) * rstd * gv[bj][0][j] + bv[bj][0][j]; h1 = (h1 - mu) * rstd * gv[bj][1][j] + bv[bj][1][j]; }
                        v0[j] = ALPHA * h0 + acc[ai][bj][m][0][j]; v1[j] = ALPHA * h1 + acc[ai][bj][m][1][j];
                    }
                    const u32x4 w = pack8(v0, v1);
                    *(u32x4*)(Z + row * D + col0 + bj * 128) = w;
                    float q[8]; unpack8(w, q);
#pragma unroll
                    for (int j = 0; j < 8; ++j) { s1 += q[j]; s2 += q[j] * q[j]; }
                }
                put_stats(st_out, (int)row, u.pn * 4 + wc, fq, s1, s2);
            }
        }
    }
};
struct EpiFold {
    bf16_t* O; int ldc; LAS unsigned char* ldsm; const float* cs; const float* bw;
    __device__ __forceinline__ void operator()(const Acc& acc, const Unit& u, int wr, int wc, int fr, int fq) const {
        const int r0 = wr * 64 + fr, col0 = u.pn * 256 + wc * 32 + 8 * fq;
        f32x4 cv[2][2], bv[2][2];
#pragma unroll
        for (int bj = 0; bj < 2; ++bj)
#pragma unroll
            for (int n = 0; n < 2; ++n) { cv[bj][n] = *(const f32x4*)(cs + col0 + bj * 128 + 4 * n); bv[bj][n] = *(const f32x4*)(bw + col0 + bj * 128 + 4 * n); }
#pragma unroll
        for (int ai = 0; ai < 2; ++ai)
#pragma unroll
            for (int m = 0; m < 4; ++m) {
                const int rl = r0 + ai * 128 + m * 16; const size_t row = (size_t)u.pm * 256 + rl;
                const f32x2 ms = *(const LAS f32x2*)(ldsm + (2 + u.aux) * 2048 + rl * 8); const float mu = ms[0], rstd = ms[1];
#pragma unroll
                for (int bj = 0; bj < 2; ++bj) {
                    const f32x4 v0 = (acc[ai][bj][m][0] - mu * cv[bj][0]) * rstd + bv[bj][0], v1 = (acc[ai][bj][m][1] - mu * cv[bj][1]) * rstd + bv[bj][1];
                    *(u32x4*)(O + row * ldc + col0 + bj * 128) = pack8(v0, v1);
                }
            }
    }
};
template <bool MOE> struct EpiGlu {
    bf16_t* O; int ldc; const float* st_in; const float* cs; const float* bw; LAS unsigned char* ldsm; int ncs;
    __device__ __forceinline__ void operator()(const Acc& acc, const Unit& u, int wr, int wc, int fr, int fq) const {
        const int row0 = u.pm * 256 + wr * 64 + fr, colo = u.pn * 128 + wc * 32 + 8 * fq;
        int vb = u.pn * 256 + wc * 32 + 8 * fq;
        if (MOE) vb += (int)(u.boff / (unsigned)(256 * D * 2)) * 256 - u.pn * 256;
        f32x4 cv[2][2], bv[2][2];
#pragma unroll
        for (int bj = 0; bj < 2; ++bj)
#pragma unroll
            for (int n = 0; n < 2; ++n) { cv[bj][n] = *(const f32x4*)(cs + vb + bj * 128 + 4 * n); bv[bj][n] = *(const f32x4*)(bw + vb + bj * 128 + 4 * n); }
#pragma unroll
        for (int ai = 0; ai < 2; ++ai)
#pragma unroll
            for (int m = 0; m < 4; ++m) {
                const int row = row0 + ai * 128 + m * 16;
                const f32x2 ms = *(const LAS f32x2*)(ldsm + (2 + u.aux) * 2048 + (row - u.pm * 256) * 8); const float mu = ms[0], rstd = ms[1];
                f32x4 o0, o1;
#pragma unroll
                for (int j = 0; j < 4; ++j) {
                    const float g0 = (acc[ai][0][m][0][j] - mu * cv[0][0][j]) * rstd + bv[0][0][j], g1 = (acc[ai][0][m][1][j] - mu * cv[0][1][j]) * rstd + bv[0][1][j];
                    const float u0 = (acc[ai][1][m][0][j] - mu * cv[1][0][j]) * rstd + bv[1][0][j], u1 = (acc[ai][1][m][1][j] - mu * cv[1][1][j]) * rstd + bv[1][1][j];
                    o0[j] = g0 * sigmoidf_(g0) * u0; o1[j] = g1 * sigmoidf_(g1) * u1;
                }
                *(u32x4*)(O + (size_t)row * ldc + colo) = pack8(o0, o1);
            }
    }
};
struct EpiMoeDown {
    bf16_t* Y0; bf16_t* Y1; LAS unsigned char* ldsm; float* P; int nfull;
    __device__ __forceinline__ void operator()(const Acc& acc, const Unit& u, int wr, int wc, int fr, int fq) const {
        const int r0 = wr * 64 + fr, col0 = u.pn * 256 + wc * 32 + 8 * fq;
        if (u.ks >= 0) {
#pragma unroll
            for (int ai = 0; ai < 2; ++ai)
#pragma unroll
                for (int m = 0; m < 4; ++m) { float* rowp = P + ((size_t)u.ks * 2048 + (size_t)(u.pm - nfull) * 256 + r0 + ai * 128 + m * 16) * D + col0;
#pragma unroll
                    for (int bj = 0; bj < 2; ++bj) { *(f32x4*)(rowp + bj * 128) = acc[ai][bj][m][0]; *(f32x4*)(rowp + bj * 128 + 4) = acc[ai][bj][m][1]; } }
            return;
        }
#pragma unroll
        for (int ai = 0; ai < 2; ++ai)
#pragma unroll
            for (int m = 0; m < 4; ++m) {
                const u32x2 mg = *(const LAS u32x2*)(ldsm + u.aux * 2048 + (r0 + ai * 128 + m * 16) * 8);
                const int id = (int)mg.x; const float gt = __uint_as_float(mg.y);
                if (id >= 0) { bf16_t* rowp = Y0 + (size_t)(id & 1) * (size_t)(Y1 - Y0) + (size_t)(id >> 1) * D + col0;
#pragma unroll
                    for (int bj = 0; bj < 2; ++bj) *(u32x4*)(rowp + bj * 128) = pack8(acc[ai][bj][m][0] * gt, acc[ai][bj][m][1] * gt); }
            }
    }
};
}

struct Args { const float* in[18]; float* out; unsigned char* ws; int ph_lo, ph_hi; };
enum { PH_PRO = 0, PH_PROJ, PH_MLSTM, PH_WOUT, PH_FIN1, PH_GU, PH_DN, PH_FIN2, PH_KVQ, PH_ATT, PH_WO, PH_RT1, PH_RT2, PH_MOE0, PH_FIX = PH_MOE0 + 2 * MOE_NCHUNK, PH_FINAL, PH_COUNT };

__device__ __forceinline__ float logsigmoid_(float x) { return fminf(x, 0.f) - log1pf(expf(-fabsf(x))); }
__device__ __forceinline__ void conv_block(LAS unsigned char* lds, const float* src, int ldw, int K, bf16_t* dst, const float* g, const float* bb, float* cs, float* bw) {
    const int tid = threadIdx.x;
    const int n4 = (tid & 15) * 4, k4 = (tid >> 4) * 4;
    const int rn = tid >> 3, rs = tid & 7;
    float csp[4] = {0.f, 0.f, 0.f, 0.f}, bwp[4] = {0.f, 0.f, 0.f, 0.f};
    const int nch = K / 128;
    LAS float* gs = (LAS float*)(lds + 2 * 64 * 264 + 16384);
    if (g) { for (int i = tid; i < K; i += NTHREADS) { gs[i] = g[i]; gs[K + i] = bb[i]; } __syncthreads(); }
    f32x4 v[4], vn[4];
#pragma unroll
    for (int kk = 0; kk < 4; ++kk) v[kk] = *(const f32x4*)(src + (size_t)(k4 + kk) * ldw + n4);
    for (int ch = 0; ch < nch; ++ch) {
        LAS unsigned char* T = lds + (ch & 1) * (64 * 264);
        if (ch + 1 < nch) {
#pragma unroll
            for (int kk = 0; kk < 4; ++kk) vn[kk] = *(const f32x4*)(src + (size_t)((ch + 1) * 128 + k4 + kk) * ldw + n4); }
        float gk[4] = {1.f, 1.f, 1.f, 1.f}, bk[4] = {0.f, 0.f, 0.f, 0.f};
        if (g) {
#pragma unroll
            for (int kk = 0; kk < 4; ++kk) { gk[kk] = gs[ch * 128 + k4 + kk]; bk[kk] = gs[K + ch * 128 + k4 + kk]; } }
#pragma unroll
        for (int j = 0; j < 4; ++j) {
            const unsigned lo = pk2(v[0][j] * gk[0], v[1][j] * gk[1]), hi = pk2(v[2][j] * gk[2], v[3][j] * gk[3]);
            *(LAS u32x2*)(T + (n4 + j) * 264 + k4 * 2) = (u32x2){lo, hi};
            csp[j] += (bflo(lo) + bfhi(lo)) + (bflo(hi) + bfhi(hi));
            bwp[j] += (v[0][j] * bk[0] + v[1][j] * bk[1]) + (v[2][j] * bk[2] + v[3][j] * bk[3]);
        }
        __syncthreads();
        u32x2 q[4];
#pragma unroll
        for (int i = 0; i < 4; ++i) q[i] = *(const LAS u32x2*)(T + rn * 264 + rs * 32 + i * 8);
        bf16_t* dp = dst + (size_t)rn * K + ch * 128 + rs * 16;
        *(u32x4*)dp = (u32x4){q[0].x, q[0].y, q[1].x, q[1].y};
        *(u32x4*)(dp + 8) = (u32x4){q[2].x, q[2].y, q[3].x, q[3].y};
#pragma unroll
        for (int kk = 0; kk < 4; ++kk) v[kk] = vn[kk];
    }
    __syncthreads();
    if (cs) {
        LAS float* red = (LAS float*)(lds + 2 * 64 * 264);
#pragma unroll
        for (int j = 0; j < 4; ++j) { red[(tid >> 4) * 64 + n4 + j] = csp[j]; red[2048 + (tid >> 4) * 64 + n4 + j] = bwp[j]; }
        __syncthreads();
        if (tid < 128) { const int n = tid & 63, w = tid >> 6; float s = 0.f;
            for (int i = 0; i < 32; ++i) s += red[w * 2048 + i * 64 + n];
            (w ? bw : cs)[n] = s; }
        __syncthreads();
    }
}
__device__ __forceinline__ void conv_job(LAS unsigned char* lds, const Args& a, int blk) {
    unsigned char* ws = a.ws;
    const float* ln_g = a.in[16]; const float* ln_b = a.in[17];
    float* vec = (float*)(ws + WS_VEC);
    const float* src; int ldw, K; bf16_t* dst; const float* g = nullptr; const float* bb = nullptr; float* cs = nullptr; float* bw = nullptr;
    int j = blk;
    if (j < 128) { const int e = j >> 4, jj = j & 15; src = a.in[15] + (size_t)e * FFE * D + 64 * jj; ldw = D; K = FFE; dst = (bf16_t*)(ws + WS_WEDN) + ((size_t)e * D + 64 * jj) * FFE; }
    else if (j < 144) { j -= 128; src = a.in[11] + 64 * j; ldw = D; K = FFD; dst = (bf16_t*)(ws + WS_WDN) + (size_t)(64 * j) * FFD; }
    else if (j < 192) { j -= 144; src = a.in[2] + 64 * j; ldw = 3080; K = D; dst = (bf16_t*)(ws + WS_WIN) + (size_t)(64 * j) * D; }
    else if (j < 208) { j -= 192; src = a.in[5] + 64 * j; ldw = D; K = D; dst = (bf16_t*)(ws + WS_WOUT) + (size_t)(64 * j) * D; }
    else if (j < 296) { j -= 208; const int t = j >> 2, q = j & 3; src = (q < 2 ? a.in[9] : a.in[10]) + 128 * t + 64 * (q & 1); ldw = FFD; K = D; dst = (bf16_t*)(ws + WS_WGU) + (size_t)(64 * j) * D;
        g = ln_g; bb = ln_b; cs = vec + VEC_GU_CS + 64 * j; bw = vec + VEC_GU_BW + 64 * j; }
    else if (j < 344) { j -= 296; src = j < 32 ? a.in[6] + 64 * j : a.in[7] + 64 * (j - 32); ldw = j < 32 ? 2048 : 1024; K = D; dst = (bf16_t*)(ws + WS_WKVQ) + (size_t)(64 * j) * D;
        g = ln_g + 1024; bb = ln_b + 1024; cs = vec + VEC_KVQ_CS + 64 * j; bw = vec + VEC_KVQ_BW + 64 * j; }
    else if (j < 360) { j -= 344; src = a.in[8] + 64 * j; ldw = D; K = D; dst = (bf16_t*)(ws + WS_WO) + (size_t)(64 * j) * D; }
    else { j -= 360; const int e = j / 112, jj = j % 112, t = jj >> 2, q = jj & 3; src = (q < 2 ? a.in[13] : a.in[14]) + (size_t)e * D * FFE + 128 * t + 64 * (q & 1); ldw = FFE; K = D;
        dst = (bf16_t*)(ws + WS_WEGU) + ((size_t)e * 2 * FFE + 64 * jj) * D; g = ln_g + 2048; bb = ln_b + 2048; cs = vec + VEC_EGU_CS + e * 2 * FFE + 64 * jj; bw = vec + VEC_EGU_BW + e * 2 * FFE + 64 * jj; }
    conv_block(lds, src, ldw, K, dst, g, bb, cs, bw);
}
constexpr int EGU0 = 360;
__device__ __forceinline__ void tail_jobs(LAS unsigned char* lds, const Args& a, int phase) {
    const int c = (int)blockIdx.x;
    int j0 = -1;
    if (phase == PH_PROJ) { const int q = c - 12;
        if (q >= 0) j0 = q < 16 ? 128 + q : (q < 184 ? 192 + (q - 16) : EGU0 + (q - 184)); }
    else if (phase == PH_WOUT) { const int q = c - 4; if (q >= 0) j0 = EGU0 + 60 + q; }
    else if (phase == PH_GU) { const int q = c - 22; if (q >= 0) j0 = EGU0 + 312 + q; }
    else if (phase == PH_DN) { const int q = c - 4;
        if (q >= 0 && q < 128) j0 = q;
        else if (q >= 128 && q - 128 < 106) j0 = EGU0 + 546 + (q - 128); }
    else { const int q = c - 12; if (q >= 0) j0 = EGU0 + 652 + q; }
    if (j0 >= 0) conv_job(lds, a, j0);
}
__device__ __forceinline__ void prologue_phase(LAS unsigned char* lds, const Args& a) {
    unsigned char* ws = a.ws;
    const int G = gridDim.x;
    for (int blk = 144 + blockIdx.x; blk < 192; blk += G) conv_job(lds, a, blk);
    {
        const int tid = threadIdx.x, lane = tid & 63, wid = tid >> 6;
        LAS float* wg = (LAS float*)lds;
        __syncthreads();
        const float* w_in = a.in[2];
        for (int i = tid; i < 8192; i += NTHREADS) { const int k = i >> 3, e = i & 7; wg[e * 1024 + k] = w_in[(size_t)k * 3080 + 3072 + e]; }
        __syncthreads();
        bf16_t* H0 = (bf16_t*)(ws + WS_RB); float* gates = (float*)(ws + WS_GATES);
        const float bg = a.in[3][lane & 7];
        f32x4 xv[4], xn[4];
        { const int row = blockIdx.x * 8 + wid; const float* src = row < NR ? a.in[0] + (size_t)row * D : a.in[1] + (size_t)((row - NR) & 15) * D;
#pragma unroll
            for (int i = 0; i < 4; ++i) xv[i] = *(const f32x4*)(src + i * 256 + lane * 4); }
        for (int row = blockIdx.x * 8 + wid; row < NROWS; row += G * 8) {
            { const int rn = row + G * 8;
                if (rn < NROWS) { const float* srcn = rn < NR ? a.in[0] + (size_t)rn * D : a.in[1] + (size_t)((rn - NR) & 15) * D;
#pragma unroll
                    for (int i = 0; i < 4; ++i) xn[i] = *(const f32x4*)(srcn + i * 256 + lane * 4); } }
            float acc[8] = {0.f, 0.f, 0.f, 0.f, 0.f, 0.f, 0.f, 0.f};
#pragma unroll
            for (int i = 0; i < 4; ++i) {
                const int k = i * 256 + lane * 4;
                const f32x4 v = xv[i];
                *(u32x2*)(H0 + (size_t)row * D + k) = (u32x2){pk2(v[0], v[1]), pk2(v[2], v[3])};
#pragma unroll
                for (int e = 0; e < 8; ++e) { const f32x4 w = *(const LAS f32x4*)(wg + e * 1024 + k); acc[e] += (v[0] * w[0] + v[1] * w[1]) + (v[2] * w[2] + v[3] * w[3]); }
            }
#pragma unroll
            for (int i = 0; i < 4; ++i) xv[i] = xn[i];
#pragma unroll
            for (int e = 0; e < 8; ++e) acc[e] = wave_sum(acc[e]);
            float mine = acc[0];
#pragma unroll
            for (int e = 1; e < 8; ++e) mine = ((lane & 7) == e) ? acc[e] : mine;
            if (lane < 8) gates[(size_t)row * 8 + lane] = lane < 4 ? mine + bg : logsigmoid_(mine + bg);
        }
        __syncthreads();
    }
}

__device__ __forceinline__ bf16x8 pack_frag(const f32x16& x, int s) {
    u32x4 p; p.x = pk2(x[8 * s], x[8 * s + 1]); p.y = pk2(x[8 * s + 2], x[8 * s + 3]); p.z = pk2(x[8 * s + 4], x[8 * s + 5]); p.w = pk2(x[8 * s + 6], x[8 * s + 7]);
    return __builtin_bit_cast(bf16x8, p);
}
__device__ __forceinline__ bf16x8 ld2x64(const LAS unsigned char* p0, const LAS unsigned char* p1) {
    const u32x2 a = *(const LAS u32x2*)p0, b = *(const LAS u32x2*)p1; u32x4 r = {a.x, a.y, b.x, b.y}; return __builtin_bit_cast(bf16x8, r);
}
__device__ __forceinline__ void tr4x4(const u32x2 (&r)[4], u32x2 (&c)[4]) {
    c[0] = (u32x2){(r[0].x & 0xffffu) | (r[1].x << 16), (r[2].x & 0xffffu) | (r[3].x << 16)};
    c[1] = (u32x2){(r[0].x >> 16) | (r[1].x & 0xffff0000u), (r[2].x >> 16) | (r[3].x & 0xffff0000u)};
    c[2] = (u32x2){(r[0].y & 0xffffu) | (r[1].y << 16), (r[2].y & 0xffffu) | (r[3].y << 16)};
    c[3] = (u32x2){(r[0].y >> 16) | (r[1].y & 0xffff0000u), (r[2].y >> 16) | (r[3].y & 0xffff0000u)};
}

#define DPP_STEP_ADD(x, ctrl, rmask) x += __builtin_bit_cast(float, __builtin_amdgcn_update_dpp(0, __builtin_bit_cast(int, x), ctrl, rmask, 0xf, false))
#define DPP_STEP_MAX(x, ctrl, rmask) x = fmaxf(x, __builtin_bit_cast(float, __builtin_amdgcn_update_dpp((int)0xff800000, __builtin_bit_cast(int, x), ctrl, rmask, 0xf, false)))
__device__ __forceinline__ float scan_add64(float x) { DPP_STEP_ADD(x, 0x111, 0xf); DPP_STEP_ADD(x, 0x112, 0xf); DPP_STEP_ADD(x, 0x114, 0xf); DPP_STEP_ADD(x, 0x118, 0xf); DPP_STEP_ADD(x, 0x142, 0xa); DPP_STEP_ADD(x, 0x143, 0xc); return x; }
__device__ __forceinline__ float scan_max64(float x) { DPP_STEP_MAX(x, 0x111, 0xf); DPP_STEP_MAX(x, 0x112, 0xf); DPP_STEP_MAX(x, 0x114, 0xf); DPP_STEP_MAX(x, 0x118, 0xf); DPP_STEP_MAX(x, 0x142, 0xa); DPP_STEP_MAX(x, 0x143, 0xc); return x; }
__device__ __forceinline__ float wave_total(float x);
__device__ __forceinline__ float lane63(float x) { return __builtin_bit_cast(float, __builtin_amdgcn_readlane(__builtin_bit_cast(int, x), 63)); }
__device__ __forceinline__ float wave_total(float x) { return lane63(scan_add64(x)); }
constexpr int ML_QS = 0, ML_KS = 17408, ML_PS = 34816, ML_VT = 44032, ML_KT = 78848, ML_SC = 96256, ML_HS = 100352;
#ifndef ML_N0
#define ML_N0 28
#define ML_N1 18
#define ML_N2 12
#endif
__device__ __forceinline__ void mlstm_phase(LAS unsigned char* lds, const bf16_t* qkvo, const float* gates, const float* normg, bf16_t* hn, int unit_) {
    const int unit = (unit_ & 7) * 8 + (unit_ >> 5), part_ = (unit_ >> 3) & 3;
    const int c_begin = part_ == 0 ? 0 : (part_ == 1 ? ML_N0 : (part_ == 2 ? ML_N0 + ML_N1 : ML_N0 + ML_N1 + ML_N2));
    const int c_end = part_ == 0 ? ML_N0 : (part_ == 1 ? ML_N0 + ML_N1 : (part_ == 2 ? ML_N0 + ML_N1 + ML_N2 : 65));
    const int tid = threadIdx.x, lane = tid & 63, wid = __builtin_amdgcn_readfirstlane(tid >> 6);
    const int b = unit >> 2, h = unit & 3;
    const int r32 = lane & 31, hh = lane >> 5, l15 = lane & 15, l4 = lane >> 4;
    LAS float* sc = (LAS float*)(lds + ML_SC);
    const int q_row = tid >> 4, q_col = (tid & 15) * 8;
    const int k_dk = (16 * (wid & 1) + l15) * 4, k_s = (4 * (wid >> 1) + l4) * 4;
    const int v_dv = (16 * (wid & 3) + l15) * 4, v_s0 = (4 * (wid >> 2) + l4) * 4;
    f32x16 Cacc[4];
#pragma unroll
    for (int i = 0; i < 4; ++i)
#pragma unroll
        for (int j = 0; j < 16; ++j) Cacc[i][j] = 0.f;
    if (tid < 256) sc[192 + tid] = 0.f;
    float m_run = 0.f;
    u32x4 qreg[2]; u32x2 kreg[4], vreg[2][4]; float g_li = 0.f, g_lf = 0.f;
#define rowof(c, t) ((c) == 0 ? (NR + b * 16 + ((t) - 48)) : (b * SEQ + 64 * ((c) - 1) + (t)))
#define ML_PREFETCH_Q(c) do { \
        if ((c) >= c_begin) _Pragma("unroll") for (int p = 0; p < 2; ++p) { const int t = q_row + 32 * p; const bool pad = ((c) == 0 && t < 48); \
            qreg[p] = pad ? (u32x4){0u, 0u, 0u, 0u} : *(const u32x4*)(qkvo + (size_t)rowof((c), t) * NPROJ + h * 128 + q_col); } } while (0)
#define ML_PREFETCH(c) do { \
        _Pragma("unroll") for (int kk = 0; kk < 4; ++kk) { const int t = k_s + kk; const bool pad = ((c) == 0 && t < 48); \
            kreg[kk] = pad ? (u32x2){0u, 0u} : *(const u32x2*)(qkvo + (size_t)rowof((c), t) * NPROJ + 512 + h * 128 + k_dk); } \
        _Pragma("unroll") for (int p = 0; p < 2; ++p) _Pragma("unroll") for (int kk = 0; kk < 4; ++kk) { const int t = v_s0 + 32 * p + kk; const bool pad = ((c) == 0 && t < 48); \
            vreg[p][kk] = pad ? (u32x2){0u, 0u} : *(const u32x2*)(qkvo + (size_t)rowof((c), t) * NPROJ + 1024 + h * 256 + v_dv); } \
        { const bool pad = ((c) == 0 && lane < 48); g_li = pad ? -1e30f : gates[(size_t)rowof((c), lane) * 8 + h]; g_lf = pad ? 0.f : gates[(size_t)rowof((c), lane) * 8 + 4 + h]; } } while (0)
    float av, Mt, winter, bmt, wlast, decay, m_next;
#define ML_SCALARS() do { const float bc_ = scan_add64(g_lf); av = g_li - bc_; const float um_ = scan_max64(av); Mt = fmaxf(m_run, um_); \
        winter = __expf(m_run - Mt); bmt = bc_ + Mt; const float M63_ = lane63(Mt), b63_ = lane63(bc_); wlast = __expf(av - M63_); decay = __expf(m_run - M63_); m_next = b63_ + M63_; } while (0)
#define ML_IMAGE(FULL) do { \
        if (FULL) { _Pragma("unroll") for (int p = 0; p < 2; ++p) *(LAS u32x4*)(lds + ML_QS + (q_row + 32 * p) * 272 + q_col * 2) = qreg[p]; } \
        { u32x2 kw[4]; \
            _Pragma("unroll") for (int kk = 0; kk < 4; ++kk) { \
                if (FULL) *(LAS u32x2*)(lds + ML_KS + (k_s + kk) * 272 + k_dk * 2) = kreg[kk]; \
                const float w = __shfl(wlast, k_s + kk) * 0.08838834764831845f; \
                kw[kk] = (u32x2){pk2(bflo(kreg[kk].x) * w, bfhi(kreg[kk].x) * w), pk2(bflo(kreg[kk].y) * w, bfhi(kreg[kk].y) * w)}; } \
            u32x2 kc[4]; tr4x4(kw, kc); \
            _Pragma("unroll") for (int j = 0; j < 4; ++j) *(LAS u32x2*)(lds + ML_KT + (k_dk + j) * 136 + k_s * 2) = kc[j]; } \
        _Pragma("unroll") for (int p = 0; p < 2; ++p) { u32x2 vc[4]; tr4x4(vreg[p], vc); \
            _Pragma("unroll") for (int j = 0; j < 4; ++j) *(LAS u32x2*)(lds + ML_VT + (v_dv + j) * 136 + (v_s0 + 32 * p) * 2) = vc[j]; } \
        if (wid == 0) { sc[lane] = winter; sc[128 + lane] = bmt; } } while (0)
#define ML_PTILES() do { const int ti = wid >> 1; \
        _Pragma("unroll") for (int q = 0; q < 2; ++q) { const int si = 2 * (wid & 1) + q; f32x4 sa = {0.f, 0.f, 0.f, 0.f}; \
            if (si <= ti) { _Pragma("unroll") for (int ks = 0; ks < 4; ++ks) { \
                    const bf16x8 af = *(const LAS bf16x8*)(lds + ML_QS + (16 * ti + l15) * 272 + (32 * ks + 8 * l4) * 2); \
                    const bf16x8 bfr = *(const LAS bf16x8*)(lds + ML_KS + (16 * si + l15) * 272 + (32 * ks + 8 * l4) * 2); \
                    sa = __builtin_amdgcn_mfma_f32_16x16x32_bf16(af, bfr, sa, 0, 0, 0); } } \
            const int s = 16 * si + l15; const float a_s = __shfl(av, s); \
            _Pragma("unroll") for (int r = 0; r < 4; ++r) { const int t = 16 * ti + 4 * l4 + r; const float Mtt = __shfl(Mt, t); \
                const float w = (s <= t) ? __expf(a_s - Mtt) : 0.f; \
                *(LAS bf16_t*)(lds + ML_PS + t * 144 + s * 2) = f2bf(sa[r] * 0.08838834764831845f * w); } } } while (0)
    bf16x8 vf[4];
#define ML_VFRAGS() do { _Pragma("unroll") for (int ks = 0; ks < 4; ++ks) { const LAS unsigned char* p_ = lds + ML_VT + (32 * wid + r32) * 136 + (16 * ks + 8 * hh) * 2; vf[ks] = ld2x64(p_, p_ + 8); } } while (0)

    ML_PREFETCH(0); ML_PREFETCH_Q(0);
    ML_SCALARS();
    { const bool f0 = (0 >= c_begin); if (f0) ML_IMAGE(true); else ML_IMAGE(false); }
    __syncthreads();
    if (1 < c_end) ML_PREFETCH(1);
    if (0 >= c_begin) ML_PTILES();
    ML_VFRAGS();
    __syncthreads();
    for (int c = 0; c < c_end; ++c) {
        const bool full = (c >= c_begin), has_n = (c + 1 < c_end), full_n = (c + 1 >= c_begin);
        const float decay_c = decay;
        const int nb = c & 1;
        if (full) {
            {
                const int t = tid >> 3, part = tid & 7;
                float qn = 0.f, ps = 0.f;
                const u32x4 q0 = *(const LAS u32x4*)(lds + ML_QS + t * 272 + part * 32), q1 = *(const LAS u32x4*)(lds + ML_QS + t * 272 + part * 32 + 16);
                float qv[16]; { float t8[8]; g8::unpack8(q0, t8);
#pragma unroll
                    for (int j = 0; j < 8; ++j) qv[j] = t8[j]; g8::unpack8(q1, t8);
#pragma unroll
                    for (int j = 0; j < 8; ++j) qv[8 + j] = t8[j]; }
#pragma unroll
                for (int j = 0; j < 16; ++j) qn += qv[j] * sc[192 + 128 * nb + part * 16 + j];
                const u32x4 pw = *(const LAS u32x4*)(lds + ML_PS + t * 144 + part * 16);
                float pv[8]; g8::unpack8(pw, pv);
#pragma unroll
                for (int j = 0; j < 8; ++j) ps += pv[j];
                qn += __shfl_xor(qn, 1); qn += __shfl_xor(qn, 2); qn += __shfl_xor(qn, 4);
                ps += __shfl_xor(ps, 1); ps += __shfl_xor(ps, 2); ps += __shfl_xor(ps, 4);
                if (part == 0) { const float den = sc[t] * qn + ps; sc[64 + t] = __builtin_amdgcn_rcpf(fmaxf(fabsf(den), __expf(-sc[128 + t]))); }
            }
#pragma unroll
            for (int tt = 0; tt < 2; ++tt) {
                f32x16 num;
#pragma unroll
                for (int j = 0; j < 16; ++j) num[j] = 0.f;
#pragma unroll
                for (int dkt = 0; dkt < 4; ++dkt)
#pragma unroll
                    for (int s2 = 0; s2 < 2; ++s2) {
                        const LAS unsigned char* p = lds + ML_QS + (32 * tt + r32) * 272 + (32 * dkt + 16 * s2 + 4 * hh) * 2;
                        num = __builtin_amdgcn_mfma_f32_32x32x16_bf16(ld2x64(p, p + 16), pack_frag(Cacc[dkt], s2), num, 0, 0, 0);
                    }
#pragma unroll
                for (int gq = 0; gq < 4; ++gq) { const f32x4 wv = *(const LAS f32x4*)(sc + 32 * tt + 8 * gq + 4 * hh);
#pragma unroll
                    for (int r = 0; r < 4; ++r) num[4 * gq + r] *= wv[r]; }
#pragma unroll
                for (int ks = 0; ks < 4; ++ks) {
                    if (tt == 0 && ks >= 2) continue;
                    const bf16x8 pf = *(const LAS bf16x8*)(lds + ML_PS + (32 * tt + r32) * 144 + (16 * ks + 8 * hh) * 2);
                    num = __builtin_amdgcn_mfma_f32_32x32x16_bf16(pf, vf[ks], num, 0, 0, 0);
                }
#pragma unroll
                for (int j = 0; j < 16; ++j) *(LAS bf16_t*)(lds + ML_HS + (32 * tt + (j & 3) + 8 * (j >> 2) + 4 * hh) * 528 + (32 * wid + r32) * 2) = f2bf(num[j]);
            }
        }
#pragma unroll
        for (int dkt = 0; dkt < 4; ++dkt) {
#pragma unroll
            for (int j = 0; j < 16; ++j) Cacc[dkt][j] *= decay_c;
#pragma unroll
            for (int ks = 0; ks < 4; ++ks) { const LAS unsigned char* p = lds + ML_KT + (32 * dkt + r32) * 136 + (16 * ks + 8 * hh) * 2;
                Cacc[dkt] = __builtin_amdgcn_mfma_f32_32x32x16_bf16(ld2x64(p, p + 8), vf[ks], Cacc[dkt], 0, 0, 0); }
        }
        {
            const int dk = tid >> 2, part = tid & 3;
            const u32x2 k0 = *(const LAS u32x2*)(lds + ML_KT + dk * 136 + part * 32), k1 = *(const LAS u32x2*)(lds + ML_KT + dk * 136 + part * 32 + 8),
                        k2 = *(const LAS u32x2*)(lds + ML_KT + dk * 136 + part * 32 + 16), k3 = *(const LAS u32x2*)(lds + ML_KT + dk * 136 + part * 32 + 24);
            float sk = ((bflo(k0.x) + bfhi(k0.x)) + (bflo(k0.y) + bfhi(k0.y))) + ((bflo(k1.x) + bfhi(k1.x)) + (bflo(k1.y) + bfhi(k1.y)))
                     + ((bflo(k2.x) + bfhi(k2.x)) + (bflo(k2.y) + bfhi(k2.y))) + ((bflo(k3.x) + bfhi(k3.x)) + (bflo(k3.y) + bfhi(k3.y)));
            sk += __shfl_xor(sk, 1); sk += __shfl_xor(sk, 2);
            if (part == 0) sc[192 + 128 * (nb ^ 1) + dk] = decay_c * sc[192 + 128 * nb + dk] + sk;
        }
        if (has_n) ML_PREFETCH_Q(c + 1);
        __syncthreads();
        m_run = m_next;
        if (has_n) ML_SCALARS();
        u32x2 oreg[8];
        if (full) { const int t = tid >> 3, part = tid & 7; const bool pad = (c == 0 && t < 48); const size_t row = pad ? 0 : (size_t)rowof(c, t);
#pragma unroll
            for (int i = 0; i < 8; ++i) oreg[i] = *(const u32x2*)(qkvo + row * NPROJ + 2048 + h * 256 + 32 * i + 4 * part); }
        if (full) {
            const int t = tid >> 3, part = tid & 7;
            const float iv = sc[64 + t];
            f32x4 x[8]; float s1 = 0.f;
#pragma unroll
            for (int i = 0; i < 8; ++i) { const u32x2 hw = *(const LAS u32x2*)(lds + ML_HS + t * 528 + (32 * i + 4 * part) * 2);
                x[i] = (f32x4){bflo(hw.x) * iv, bfhi(hw.x) * iv, bflo(hw.y) * iv, bfhi(hw.y) * iv}; s1 += (x[i][0] + x[i][1]) + (x[i][2] + x[i][3]); }
            s1 += __shfl_xor(s1, 1); s1 += __shfl_xor(s1, 2); s1 += __shfl_xor(s1, 4);
            const float mean = s1 * (1.0f / 256.0f); float s2 = 0.f;
#pragma unroll
            for (int i = 0; i < 8; ++i) { const f32x4 d = x[i] - mean; s2 += (d[0] * d[0] + d[1] * d[1]) + (d[2] * d[2] + d[3] * d[3]); }
            s2 += __shfl_xor(s2, 1); s2 += __shfl_xor(s2, 2); s2 += __shfl_xor(s2, 4);
            const float rstd = rsqrtf(s2 * (1.0f / 256.0f) + LN_EPS);
            if (!(c == 0 && t < 48)) {
                const size_t row = (size_t)rowof(c, t);
#pragma unroll
                for (int i = 0; i < 8; ++i) {
                    const int dv = 32 * i + 4 * part;
                    const u32x2 ow = oreg[i];
                    const f32x4 ng = *(const f32x4*)(normg + h * 256 + dv);
                    const float o0 = sigmoidf_(bflo(ow.x)), o1 = sigmoidf_(bfhi(ow.x)), o2 = sigmoidf_(bflo(ow.y)), o3 = sigmoidf_(bfhi(ow.y));
                    const f32x4 y = (x[i] - mean) * rstd * ng;
                    *(u32x2*)(hn + row * D + h * 256 + dv) = (u32x2){pk2(y[0] * o0, y[1] * o1), pk2(y[2] * o2, y[3] * o3)};
                }
            }
        }
        if (!has_n) break;
        if (full_n) ML_IMAGE(true); else ML_IMAGE(false);
        if (c + 2 < c_end) ML_PREFETCH(c + 2);
        __syncthreads();
        if (full_n) ML_PTILES();
        ML_VFRAGS();
        if (full_n) __syncthreads();
    }
    __syncthreads();
#undef ML_PREFETCH
#undef ML_PREFETCH_Q
#undef ML_SCALARS
#undef ML_IMAGE
#undef ML_PTILES
#undef ML_VFRAGS
#undef rowof
}

constexpr float AT_PMIN = 1e-15f;
constexpr int AT_K0 = 0, AT_V0 = 17408, AT_BUF = 34816, AT_FLAGS = 2 * AT_BUF;
__device__ __forceinline__ void at_tile(const LAS unsigned char* Kb, const LAS unsigned char* Vb, int k0, int tmin, int r32, int hh, const bf16x8 (&qf)[8], f32x16 (&O)[4], float& P) {
    f32x16 S[2];
#pragma unroll
    for (int u = 0; u < 2; ++u) {
#pragma unroll
        for (int j = 0; j < 16; ++j) S[u][j] = 0.f;
#pragma unroll
        for (int ks = 0; ks < 8; ++ks) {
            const bf16x8 kf = *(const LAS bf16x8*)(Kb + (32 * u + r32) * 272 + (16 * ks + 8 * hh) * 2);
            S[u] = __builtin_amdgcn_mfma_f32_32x32x16_bf16(kf, qf[ks], S[u], 0, 0, 0);
        }
    }
    const bool full = (k0 + 63 < tmin) && (k0 >= 128);
    const int lim = tmin + r32 - k0 - 4 * hh;
    const int lo = 112 - k0 - 4 * hh;
    float Tt[2][4];
#define AT_ELEM(MASKED) \
    _Pragma("unroll") for (int u = 0; u < 2; ++u) _Pragma("unroll") for (int gq = 0; gq < 4; ++gq) { \
        float x4[4]; \
        _Pragma("unroll") for (int r = 0; r < 4; ++r) { \
            float zz = S[u][4 * gq + r] * (0.08838834764831845f * 1.4426950408889634f); \
            if (MASKED) { const int o = 32 * u + 8 * gq + r; zz = (o < lim && o >= lo) ? zz : -1.0e4f; } \
            const float rc = __builtin_amdgcn_rcpf(1.0f + __builtin_amdgcn_exp2f(zz)); \
            S[u][4 * gq + r] = 1.0f - rc; x4[r] = rc; } \
        const float e2 = x4[3], e1 = e2 * x4[2], e0 = e1 * x4[1]; \
        Tt[u][gq] = e0 * x4[0]; \
        S[u][4 * gq + 2] *= e2; S[u][4 * gq + 1] *= e1; S[u][4 * gq + 0] *= e0; }
    if (full) { AT_ELEM(false) } else { AT_ELEM(true) }
#undef AT_ELEM
    float acc = P;
#pragma unroll
    for (int u = 1; u >= 0; --u)
#pragma unroll
        for (int gq = 3; gq >= 0; --gq) {
            float t0; const float t1 = swap32_hi(Tt[u][gq], t0);
            const float Rr = hh ? acc : acc * t1;
            acc = (acc * t1) * t0;
#pragma unroll
            for (int r = 0; r < 4; ++r) S[u][4 * gq + r] *= Rr;
        }
    P = acc;
#pragma unroll
    for (int u = 0; u < 2; ++u)
#pragma unroll
        for (int s2 = 0; s2 < 2; ++s2) {
            const bf16x8 af = pack_frag(S[u], s2);
#pragma unroll
            for (int dt = 0; dt < 4; ++dt) {
                const LAS unsigned char* p = Vb + (32 * dt + r32) * 136 + (32 * u + 16 * s2 + 4 * hh) * 2;
                O[dt] = __builtin_amdgcn_mfma_f32_32x32x16_bf16(af, ld2x64(p, p + 16), O[dt], 0, 0, 0);
            }
        }
}
__device__ __forceinline__ void attn_phase(LAS unsigned char* lds, const bf16_t* kvq, bf16_t* ao) {
    const int tid = threadIdx.x, lane = tid & 63, wid = __builtin_amdgcn_readfirstlane(tid >> 6);
    const int r32 = lane & 31, hh = lane >> 5, l15 = lane & 15, l4 = lane >> 4;
    LAS unsigned* flags = (LAS unsigned*)(lds + AT_FLAGS);
    const int k_row = tid >> 4, k_col = (tid & 15) * 8;
    const int v_d = (16 * (wid & 1) + l15) * 4, v_s = (4 * (wid >> 1) + l4) * 4;
    for (int ui_ = 0; ui_ < (NB * 8 * 16) / 256; ++ui_) {
        const int xq = blockIdx.x & 7, jq = blockIdx.x >> 3, strm = (ui_ * 8 + xq) * 2 + (jq >> 4);
        const int qt = jq & 15, head = strm & 7, b = strm >> 3;
        const int q0 = 128 + 256 * qt, tmin = q0 + 32 * wid;
#define rowofp(p) ((p) >= 128 ? b * SEQ + (p) - 128 : ((p) >= 112 ? NR + b * 16 + (p) - 112 : NR + b * 16))
        bf16x8 qf[8];
        { const bf16_t* qp = kvq + (size_t)(b * SEQ + tmin - 128 + r32) * NPROJ + 2048 + head * 128 + 8 * hh;
#pragma unroll
            for (int ks = 0; ks < 8; ++ks) qf[ks] = *(const bf16x8*)(qp + 16 * ks); }
        f32x16 O[4];
#pragma unroll
        for (int i = 0; i < 4; ++i)
#pragma unroll
            for (int j = 0; j < 16; ++j) O[i][j] = 0.f;
        float P = 1.0f;
        const int kt_hi = (q0 >> 6) + 3;
        u32x4 kregA[2], kregB[2]; u32x2 vregA[4], vregB[4];
#define AT_LOAD(kreg, vreg, kt) do { \
        _Pragma("unroll") for (int p = 0; p < 2; ++p) kreg[p] = *(const u32x4*)(kvq + (size_t)rowofp(64 * (kt) + k_row + 32 * p) * NPROJ + head * 128 + k_col); \
        _Pragma("unroll") for (int kk = 0; kk < 4; ++kk) vreg[kk] = *(const u32x2*)(kvq + (size_t)rowofp(64 * (kt) + v_s + kk) * NPROJ + 1024 + head * 128 + v_d); } while (0)
#define AT_STORE(kreg, vreg, buf) do { LAS unsigned char* base = lds + (buf) * AT_BUF; \
        _Pragma("unroll") for (int p = 0; p < 2; ++p) *(LAS u32x4*)(base + AT_K0 + (k_row + 32 * p) * 272 + k_col * 2) = kreg[p]; \
        u32x2 vc[4]; tr4x4(vreg, vc); \
        _Pragma("unroll") for (int j = 0; j < 4; ++j) *(LAS u32x2*)(base + AT_V0 + (v_d + j) * 136 + v_s * 2) = vc[j]; } while (0)
#define AT_ITER(BUF, LOADSET_K, LOADSET_V, STORESET_K, STORESET_V) { \
            const int kt = kt_hi - it; \
            __syncthreads(); \
            if (it > 0 && flags[it - 1] == 0u) break; \
            if (kt - 2 >= 1) AT_LOAD(LOADSET_K, LOADSET_V, kt - 2); \
            if (64 * kt < tmin + 31 && __ballot(P >= AT_PMIN) != 0ull) at_tile(lds + (BUF) * AT_BUF + AT_K0, lds + (BUF) * AT_BUF + AT_V0, 64 * kt, tmin, r32, hh, qf, O, P); \
            if (__ballot(P >= AT_PMIN) != 0ull && lane == 0) flags[it] = 1u; \
            if (kt - 1 < 1) break; \
            AT_STORE(STORESET_K, STORESET_V, 1 - (BUF)); \
            ++it; }
        if (tid < 80) flags[tid] = 0u;
        AT_LOAD(kregA, vregA, kt_hi);
        AT_STORE(kregA, vregA, 0);
        AT_LOAD(kregB, vregB, kt_hi - 1);
        for (int it = 0; ; ) {
            AT_ITER(0, kregA, vregA, kregB, vregB)
            AT_ITER(1, kregB, vregB, kregA, vregA)
        }
#pragma unroll
        for (int dt = 0; dt < 4; ++dt)
#pragma unroll
            for (int j = 0; j < 16; ++j) {
                const int t = tmin + (j & 3) + 8 * (j >> 2) + 4 * hh;
                ao[(size_t)(b * SEQ + t - 128) * D + head * 128 + 32 * dt + r32] = f2bf(O[dt][j]);
            }
        __syncthreads();
    }
#undef AT_LOAD
#undef AT_STORE
#undef AT_ITER
#undef rowofp
}

__device__ __forceinline__ void ln_row_stats_wave(const float* st, int row, int lane, float& mu, float& rstd) {
    const f32x2 p = *(const f32x2*)(st + (size_t)row * 32 + (lane & 15) * 2);
    float s1 = p[0], s2 = p[1];
#pragma unroll
    for (int o = 1; o < 16; o <<= 1) { s1 += __shfl_xor(s1, o); s2 += __shfl_xor(s2, o); }
    mu = s1 * (1.0f / 1024.0f); const float var = fmaxf(s2 * (1.0f / 1024.0f) - mu * mu, 0.f); rstd = rsqrtf(var + LN_EPS);
}
__device__ __forceinline__ void router1_phase(LAS unsigned char* lds, const Args& a) {
    const int tid = threadIdx.x, lane = tid & 63, wid = tid >> 6;
    unsigned char* ws = a.ws;
    const float* g3 = a.in[16] + 2048; const float* b3 = a.in[17] + 2048; const float* wr = a.in[12];
    LAS float* gw = (LAS float*)lds;
    LAS float* cc = (LAS float*)(lds + 32768);
    LAS int* cnt = (LAS int*)(lds + 32768 + 64);
    __syncthreads();
    for (int i = tid; i < 8192; i += NTHREADS) { const int k = i >> 3, e = i & 7; gw[e * 1024 + k] = g3[k] * wr[i]; }
    if (tid < 8) cnt[tid] = 0;
    __syncthreads();
    { float s1 = 0.f, s2 = 0.f;
        for (int k = lane; k < 1024; k += 64) { s1 += gw[wid * 1024 + k]; s2 += b3[k] * wr[k * 8 + wid]; }
        s1 = wave_sum(s1); s2 = wave_sum(s2);
        if (lane == 0) { cc[wid] = s1; cc[8 + wid] = s2; } }
    __syncthreads();
    const bf16_t* z3 = (const bf16_t*)(ws + WS_RC); const float* st3 = (const float*)(ws + WS_ST3);
    f32x4* route = (f32x4*)(ws + WS_ROUTE);
    const int tok0 = (int)(((long)NR * blockIdx.x) / gridDim.x), tok1 = (int)(((long)NR * (blockIdx.x + 1)) / gridDim.x);
    u32x4 zrA[2], zrB[2]; f32x2 spA, spB;
#define RT_LOAD2(t) do { const int tb_ = ((t) + 8 < tok1) ? (t) + 8 : (t); \
        zrA[0] = *(const u32x4*)(z3 + (size_t)(t) * D + lane * 8); zrA[1] = *(const u32x4*)(z3 + (size_t)(t) * D + 512 + lane * 8); spA = *(const f32x2*)(st3 + (size_t)(t) * 32 + (lane & 15) * 2); \
        zrB[0] = *(const u32x4*)(z3 + (size_t)tb_ * D + lane * 8); zrB[1] = *(const u32x4*)(z3 + (size_t)tb_ * D + 512 + lane * 8); spB = *(const f32x2*)(st3 + (size_t)tb_ * 32 + (lane & 15) * 2); } while (0)
#define RT_FINISH(tk, acc, mu, rstd) do { float lg[8]; \
        _Pragma("unroll") for (int e = 0; e < 8; ++e) lg[e] = (rstd) * (wave_total(acc[e]) - (mu) * cc[e]) + cc[8 + e]; \
        int e1 = 0; float v1 = lg[0]; \
        _Pragma("unroll") for (int e = 1; e < 8; ++e) if (lg[e] > v1) { v1 = lg[e]; e1 = e; } \
        int e2 = -1; float v2 = -3.0e38f; \
        _Pragma("unroll") for (int e = 0; e < 8; ++e) if (e != e1 && lg[e] > v2) { v2 = lg[e]; e2 = e; } \
        const float g1 = 1.0f / (1.0f + expf(v2 - v1)); \
        if (lane == 0) { ((f32x2*)(ws + WS_TOKST))[tk] = (f32x2){(mu), (rstd)}; route[tk] = (f32x4){__int_as_float(e1 | (e2 << 8)), g1, 1.0f - g1, 0.f}; \
            __hip_atomic_fetch_add(&cnt[e1], 1, __ATOMIC_RELAXED, __HIP_MEMORY_SCOPE_WORKGROUP); __hip_atomic_fetch_add(&cnt[e2], 1, __ATOMIC_RELAXED, __HIP_MEMORY_SCOPE_WORKGROUP); } } while (0)
    if (tok0 + wid < tok1) RT_LOAD2(tok0 + wid);
    for (int tok = tok0 + wid; tok < tok1; tok += 16) {
        const u32x4 zA[2] = {zrA[0], zrA[1]}, zB[2] = {zrB[0], zrB[1]}; const f32x2 sA = spA, sB = spB;
        if (tok + 16 < tok1) RT_LOAD2(tok + 16);
        float a1 = sA[0], a2 = sA[1], b1 = sB[0], b2 = sB[1];
#pragma unroll
        for (int o = 1; o < 16; o <<= 1) { a1 += __shfl_xor(a1, o); a2 += __shfl_xor(a2, o); b1 += __shfl_xor(b1, o); b2 += __shfl_xor(b2, o); }
        const float muA = a1 * (1.0f / 1024.0f), rsA = rsqrtf(fmaxf(a2 * (1.0f / 1024.0f) - muA * muA, 0.f) + LN_EPS);
        const float muB = b1 * (1.0f / 1024.0f), rsB = rsqrtf(fmaxf(b2 * (1.0f / 1024.0f) - muB * muB, 0.f) + LN_EPS);
        float accA[8] = {0.f, 0.f, 0.f, 0.f, 0.f, 0.f, 0.f, 0.f}, accB[8] = {0.f, 0.f, 0.f, 0.f, 0.f, 0.f, 0.f, 0.f};
#pragma unroll
        for (int hf = 0; hf < 2; ++hf) {
            const int k = hf * 512 + lane * 8;
            float za[8], zb[8]; g8::unpack8(zA[hf], za); g8::unpack8(zB[hf], zb);
#pragma unroll
            for (int e = 0; e < 8; ++e) { const f32x4 w0 = *(const LAS f32x4*)(gw + e * 1024 + k), w1 = *(const LAS f32x4*)(gw + e * 1024 + k + 4);
                accA[e] += ((za[0] * w0[0] + za[1] * w0[1]) + (za[2] * w0[2] + za[3] * w0[3])) + ((za[4] * w1[0] + za[5] * w1[1]) + (za[6] * w1[2] + za[7] * w1[3]));
                accB[e] += ((zb[0] * w0[0] + zb[1] * w0[1]) + (zb[2] * w0[2] + zb[3] * w0[3])) + ((zb[4] * w1[0] + zb[5] * w1[1]) + (zb[6] * w1[2] + zb[7] * w1[3])); }
        }
        RT_FINISH(tok, accA, muA, rsA);
        if (tok + 8 < tok1) RT_FINISH(tok + 8, accB, muB, rsB);
    }
#undef RT_LOAD2
#undef RT_FINISH
    __syncthreads();
    if (tid < 8) ((int*)(ws + WS_CNT))[blockIdx.x * 8 + tid] = cnt[tid];
}
__device__ __forceinline__ void router2_phase(LAS unsigned char* lds, const Args& a) {
    const int tid = threadIdx.x, lane = tid & 63, wid = tid >> 6;
    unsigned char* ws = a.ws;
    const int G = gridDim.x, wg = blockIdx.x;
    LAS int* cn = (LAS int*)lds;
    LAS int* tot = (LAS int*)(lds + 16384);
    u32x2* smeta = (u32x2*)(ws + WS_TOK); f32x2* sstat = (f32x2*)(ws + WS_GATEB); const f32x2* tokst = (const f32x2*)(ws + WS_TOKST);
    const f32x4* route = (const f32x4*)(ws + WS_ROUTE);
    const int tok0 = (int)(((long)NR * wg) / G), tok1 = (int)(((long)NR * (wg + 1)) / G);
    f32x4 rr[8]; f32x2 ts[8];
#pragma unroll
    for (int i = 0; i < 8; ++i) { int q = 2 * tok0 + 64 * i + lane; q = q < 2 * tok1 ? q : 2 * tok1 - 1; rr[i] = route[q >> 1]; ts[i] = tokst[q >> 1]; }
    __syncthreads();
    const int* cnts = (const int*)(ws + WS_CNT);
    for (int i = tid; i < G * 8; i += NTHREADS) cn[i] = cnts[i];
    __syncthreads();
    { int t = 0, p = 0;
        for (int w = lane; w < G; w += 64) { const int v = cn[w * 8 + wid]; t += v; p += (w < wg) ? v : 0; }
#pragma unroll
        for (int o = 32; o >= 1; o >>= 1) { t += __shfl_xor(t, o); p += __shfl_xor(p, o); }
        if (lane == 0) { tot[wid] = t; tot[8 + wid] = p; } }
    __syncthreads();
    if (tid == 0) { int ps = 0;
        for (int e = 0; e < 8; ++e) { tot[24 + e] = ps; tot[16 + e] = ps + tot[8 + e]; ps += ((tot[e] + 255) >> 8) << 8; }
        if (wg == 0) { int* hdr = (int*)(ws + WS_HDR); int pp = 0; for (int e = 0; e < 8; ++e) { pp += (tot[e] + 255) >> 8; hdr[e] = pp; } hdr[8] = pp; } }
    __syncthreads();
    { const int e = wid; int run = tot[16 + e];
#pragma unroll
        for (int i = 0; i < 8; ++i) {
            const int q = 2 * tok0 + 64 * i + lane; bool match = false; float gt = 0.f;
            if (q < 2 * tok1) { const f32x4 r = rr[i]; const int ee = __float_as_int(r[0]); const int ex = (q & 1) ? ((ee >> 8) & 0xff) : (ee & 0xff); match = (ex == e); gt = (q & 1) ? r[2] : r[1]; }
            const unsigned long long mask = __ballot(match);
            const int pos = __popcll(mask & ((1ull << lane) - 1ull));
            if (match) { smeta[run + pos] = (u32x2){(unsigned)q, __float_as_uint(gt)}; sstat[run + pos] = ts[i]; }
            run += __popcll(mask);
        }
        if (wg == 0) { const int s0 = tot[24 + e] + tot[e], s1 = tot[24 + e] + (((tot[e] + 255) >> 8) << 8);
            for (int s = s0 + lane; s < s1; s += 64) { smeta[s] = (u32x2){0xffffffffu, 0u}; sstat[s] = (f32x2){0.f, 1.f}; } }
    }
}

__device__ __forceinline__ float wave_total(float x);
__device__ __forceinline__ void final_phase(const Args& a) {
    const int tid = threadIdx.x, lane = tid & 63, wid = tid >> 6;
    unsigned char* ws = a.ws;
    const bf16_t* z3 = (const bf16_t*)(ws + WS_RC); const float* st3 = (const float*)(ws + WS_ST3);
    const bf16_t* Y0 = (const bf16_t*)(ws + WS_RB); const bf16_t* Y1 = (const bf16_t*)(ws + WS_RD);
    const float* g3 = a.in[16] + 2048; const float* b3 = a.in[17] + 2048; const float* g4 = a.in[16] + 3072; const float* b4 = a.in[17] + 3072;
    float G3[16], B3[16], G4[16], B4[16];
#pragma unroll
    for (int hf = 0; hf < 2; ++hf)
#pragma unroll
        for (int q = 0; q < 2; ++q) { const int k = hf * 512 + lane * 8 + q * 4;
            const f32x4 a3 = *(const f32x4*)(g3 + k), c3 = *(const f32x4*)(b3 + k), a4 = *(const f32x4*)(g4 + k), c4 = *(const f32x4*)(b4 + k);
#pragma unroll
            for (int j = 0; j < 4; ++j) { G3[hf * 8 + q * 4 + j] = a3[j] * ALPHA; B3[hf * 8 + q * 4 + j] = c3[j] * ALPHA; G4[hf * 8 + q * 4 + j] = a4[j]; B4[hf * 8 + q * 4 + j] = c4[j]; } }
    const int stride = gridDim.x * 8;
    int tok = blockIdx.x * 8 + wid;
    u32x4 zr[2], y0r[2], y1r[2]; f32x2 sp;
#define FIN_LOAD(t) do { _Pragma("unroll") for (int hf = 0; hf < 2; ++hf) { const size_t o = (size_t)(t) * D + hf * 512 + lane * 8; \
        zr[hf] = *(const u32x4*)(z3 + o); y0r[hf] = *(const u32x4*)(Y0 + o); y1r[hf] = *(const u32x4*)(Y1 + o); } \
        sp = *(const f32x2*)(st3 + (size_t)(t) * 32 + (lane & 15) * 2); } while (0)
    if (tok < NR) FIN_LOAD(tok);
    for (; tok < NR; tok += stride) {
        u32x4 zc[2] = {zr[0], zr[1]}, y0c[2] = {y0r[0], y0r[1]}, y1c[2] = {y1r[0], y1r[1]}; const f32x2 spc = sp;
        if (tok + stride < NR) FIN_LOAD(tok + stride);
        float s1 = spc[0], s2 = spc[1];
#pragma unroll
        for (int o = 1; o < 16; o <<= 1) { s1 += __shfl_xor(s1, o); s2 += __shfl_xor(s2, o); }
        const float mu = s1 * (1.0f / 1024.0f); const float rstd = rsqrtf(fmaxf(s2 * (1.0f / 1024.0f) - mu * mu, 0.f) + LN_EPS);
        float v[16]; float t1 = 0.f;
#pragma unroll
        for (int hf = 0; hf < 2; ++hf) {
            float z[8], y0[8], y1[8];
            g8::unpack8(zc[hf], z); g8::unpack8(y0c[hf], y0); g8::unpack8(y1c[hf], y1);
#pragma unroll
            for (int j = 0; j < 8; ++j) { const float x = ((z[j] - mu) * rstd * G3[hf * 8 + j] + B3[hf * 8 + j]) + (y0[j] + y1[j]); v[hf * 8 + j] = x; t1 += x; }
        }
        t1 = wave_total(t1); const float mean = t1 * (1.0f / 1024.0f); float t2 = 0.f;
#pragma unroll
        for (int j = 0; j < 16; ++j) { const float d = v[j] - mean; t2 += d * d; }
        t2 = wave_total(t2); const float rs = rsqrtf(t2 * (1.0f / 1024.0f) + LN_EPS);
#pragma unroll
        for (int hf = 0; hf < 2; ++hf) {
            const int k = hf * 512 + lane * 8;
            f32x4 o0, o1;
#pragma unroll
            for (int j = 0; j < 4; ++j) { o0[j] = (v[hf * 8 + j] - mean) * rs * G4[hf * 8 + j] + B4[hf * 8 + j]; o1[j] = (v[hf * 8 + 4 + j] - mean) * rs * G4[hf * 8 + 4 + j] + B4[hf * 8 + 4 + j]; }
            *(f32x4*)(a.out + (size_t)tok * D + k) = o0; *(f32x4*)(a.out + (size_t)tok * D + k + 4) = o1;
        }
    }
#undef FIN_LOAD
}

__device__ __forceinline__ void moefix_phase(const Args& a) {
    const int lane = threadIdx.x & 63, wid = threadIdx.x >> 6;
    unsigned char* ws = a.ws;
    const int npan = ((const int*)(ws + WS_HDR))[8];
    const int p_lo = (MOE_NCHUNK - 1) * MOE_CHUNK_PAN + MOE_CHUNK_PAN;
    const int nrows = (npan - p_lo) * 256;
    const u32x2* smeta = (const u32x2*)(ws + WS_TOK);
    const float* P = (const float*)(ws + WS_RA + RA_POFF);
    bf16_t* Y0 = (bf16_t*)(ws + WS_RB); bf16_t* Y1 = (bf16_t*)(ws + WS_RD);
    for (int r = blockIdx.x * 8 + wid; r < nrows; r += gridDim.x * 8) {
        const u32x2 mg = smeta[(size_t)p_lo * 256 + r];
        const int id = (int)mg.x; const float gt = __uint_as_float(mg.y);
        if (id < 0) continue;
        bf16_t* yrow = ((id & 1) ? Y1 : Y0) + (size_t)(id >> 1) * D;
#pragma unroll
        for (int hf = 0; hf < 2; ++hf) {
            const int c = hf * 512 + lane * 8;
            f32x4 s0 = {0.f, 0.f, 0.f, 0.f}, s1 = {0.f, 0.f, 0.f, 0.f};
#pragma unroll
            for (int ks = 0; ks < MOE_KSPLIT; ++ks) { const float* pp = P + ((size_t)ks * 2048 + r) * D + c; s0 += *(const f32x4*)pp; s1 += *(const f32x4*)(pp + 4); }
            *(u32x4*)(yrow + c) = g8::pack8(s0 * gt, s1 * gt);
        }
    }
}
__device__ __forceinline__ void finstats_phase(const float* st, float* rs, int nrows) {
    for (int row = blockIdx.x * NTHREADS + threadIdx.x; row < nrows; row += gridDim.x * NTHREADS) {
        const f32x4* p = (const f32x4*)(st + (size_t)row * 32);
        float s1 = 0.f, s2 = 0.f;
#pragma unroll
        for (int i = 0; i < 8; ++i) { const f32x4 a = p[i]; s1 += a[0] + a[2]; s2 += a[1] + a[3]; }
        const float mu = s1 * (1.0f / 1024.0f); const float rstd = rsqrtf(fmaxf(s2 * (1.0f / 1024.0f) - mu * mu, 0.f) + LN_EPS);
        *(f32x2*)(rs + (size_t)row * 2) = (f32x2){mu, rstd};
    }
}
__global__ void __launch_bounds__(NTHREADS, 2) yoco_fwd(Args args) {
    extern __shared__ __attribute__((aligned(16))) unsigned char lds_raw[];
    LAS unsigned char* lds = (LAS unsigned char*)lds_raw;
    unsigned char* ws = args.ws;
    const int G = gridDim.x;
    const int lo = args.ph_lo, hi = args.ph_hi;
    volatile LAS unsigned* misc = (volatile LAS unsigned*)(lds + LDS_MISC);
    if (threadIdx.x < 4) misc[threadIdx.x] = 0u;
    __syncthreads();
    XcdBarrier bar; bar.bar = (unsigned*)(ws + WS_CTL); bar.x = 0; bar.st = misc;
    if (hi - lo > 1) bar = xcd_barrier_post((unsigned*)(ws + WS_CTL), misc);
#ifndef PHASE_MASK
#define PHASE_MASK 0xFFFFFFFFu
#endif
#define IN(k) (((PHASE_MASK >> (k)) & 1u) && lo <= (k) && (k) < hi)
#define SEAM(k) do { if (IN(k) && IN((k) + 1)) xcd_barrier(bar); } while (0)
    bf16_t* RA = (bf16_t*)(ws + WS_RA); bf16_t* RB = (bf16_t*)(ws + WS_RB); bf16_t* RC = (bf16_t*)(ws + WS_RC); bf16_t* RD = (bf16_t*)(ws + WS_RD);
    float* vec = (float*)(ws + WS_VEC);
    float* st1 = (float*)(ws + WS_ST1); float* st2 = (float*)(ws + WS_ST2); float* st3 = (float*)(ws + WS_ST3);
    const float* ln_g = args.in[16]; const float* ln_b = args.in[17];

#define RUN(k, ...) do { if constexpr (((REPMASK) >> (k)) & 1u) { if (IN(k)) { __VA_ARGS__ } xcd_barrier(bar); } \
        if ((k) == PROBE_T && blockIdx.x == 0 && threadIdx.x == 0) ((volatile long long*)(ws + WS_DIAG))[2] = wall_clock64(); \
        if (IN(k)) { __VA_ARGS__ } \
        if ((k) == PROBE_T && blockIdx.x == 0 && threadIdx.x == 0) ((volatile long long*)(ws + WS_DIAG))[3] = wall_clock64(); \
        SEAM(k); } while (0)
    RUN(PH_PRO, prologue_phase(lds, args););
    RUN(PH_PROJ,
        g8::Gemm g{RB, (const bf16_t*)(ws + WS_WIN), D, nullptr, nullptr, nullptr}; g8::DenseOrder S; S.init(NPAN, NPROJ / 256, D, G, (int)blockIdx.x);
        g8::EpiPlain E{RA, NPROJ};
        g8::gemm_phase<g8::EpiPlain, g8::DenseOrder, false>(lds, g, S, E); tail_jobs(lds, args, PH_PROJ););
    RUN(PH_MLSTM, if ((int)blockIdx.x < 256) mlstm_phase(lds, RA, (const float*)(ws + WS_GATES), args.in[4], RD, (int)blockIdx.x););
    RUN(PH_WOUT,
        g8::Gemm g{RD, (const bf16_t*)(ws + WS_WOUT), D, nullptr, nullptr, nullptr}; g8::DenseOrder S; S.init(NPAN, 4, D, G, (int)blockIdx.x);
        g8::EpiRes<0> E{RC, RB, st1, lds + LDS_META, nullptr, nullptr};
        g8::gemm_phase<g8::EpiRes<0>, g8::DenseOrder, false>(lds, g, S, E); tail_jobs(lds, args, PH_WOUT););
    RUN(PH_FIN1, finstats_phase(st1, (float*)(ws + WS_RS1), NROWS););
    RUN(PH_GU,
        g8::Gemm g{RC, (const bf16_t*)(ws + WS_WGU), D, nullptr, nullptr, ws + WS_RS1}; g8::DenseOrder S; S.init(NPAN, 2 * FFD / 256, D, G, (int)blockIdx.x);
        g8::EpiGlu<false> E{RA, FFD, st1, vec + VEC_GU_CS, vec + VEC_GU_BW, lds + LDS_META, 0};
        g8::gemm_phase<g8::EpiGlu<false>, g8::DenseOrder, false, 3>(lds, g, S, E); tail_jobs(lds, args, PH_GU););
    RUN(PH_DN,
        g8::Gemm g{RA, (const bf16_t*)(ws + WS_WDN), FFD, nullptr, nullptr, ws + WS_RS1}; g8::DenseOrder S; S.init(NPAN, 4, FFD, G, (int)blockIdx.x);
        g8::EpiRes<1> E{RB, RC, st2, lds + LDS_META, ln_g, ln_b};
        g8::gemm_phase<g8::EpiRes<1>, g8::DenseOrder, false, 3>(lds, g, S, E); tail_jobs(lds, args, PH_DN););
    RUN(PH_FIN2, finstats_phase(st2, (float*)(ws + WS_RS2), NROWS););
    RUN(PH_KVQ,
        g8::Gemm g{RB, (const bf16_t*)(ws + WS_WKVQ), D, nullptr, nullptr, ws + WS_RS2}; g8::DenseOrder S; S.init(NPAN, NPROJ / 256, D, G, (int)blockIdx.x);
        g8::EpiFold E{RA, NPROJ, lds + LDS_META, vec + VEC_KVQ_CS, vec + VEC_KVQ_BW};
        g8::gemm_phase<g8::EpiFold, g8::DenseOrder, false, 3>(lds, g, S, E); tail_jobs(lds, args, PH_KVQ););
    RUN(PH_ATT, attn_phase(lds, RA, RD););
    RUN(PH_WO,
        g8::Gemm g{RD, (const bf16_t*)(ws + WS_WO), D, nullptr, nullptr, ws + WS_RS2}; g8::DenseOrder S; S.init(NR / 256, 4, D, G, (int)blockIdx.x);
        g8::EpiRes<1> E{RC, RB, st3, lds + LDS_META, ln_g + 1024, ln_b + 1024};
        g8::gemm_phase<g8::EpiRes<1>, g8::DenseOrder, false, 3>(lds, g, S, E););
    RUN(PH_RT1, router1_phase(lds, args););
    RUN(PH_RT2, router2_phase(lds, args););
#define MOE_CHUNK(cidx) \
    RUN(PH_MOE0 + 2 * (cidx), const int* hdr = (const int*)(ws + WS_HDR); const int npan = hdr[8]; const int p0 = (cidx) * MOE_CHUNK_PAN; \
        { g8::MoeOrder S; S.p0 = p0; S.np = ((cidx) == MOE_NCHUNK - 1) ? (npan - p0) : MOE_CHUNK_PAN; S.nfull = MOE_CHUNK_PAN; S.nsplit = 1; S.nN = 2 * FFE / 256; S.G = G; S.c = (int)blockIdx.x; S.K = D; S.estride = (unsigned)(2 * FFE * D * 2); \
            _Pragma("unroll") for (int e = 0; e < NE; ++e) S.pend[e] = hdr[e]; \
            g8::Gemm g{RC, (const bf16_t*)(ws + WS_WEGU), D, (const int*)(ws + WS_TOK), ws + WS_TOK, ws + WS_GATEB}; \
            g8::EpiGlu<true> E{RA, FFE, st3, vec + VEC_EGU_CS, vec + VEC_EGU_BW, lds + LDS_META, 2 * FFE}; \
            g8::gemm_phase<g8::EpiGlu<true>, g8::MoeOrder, true, 1>(lds, g, S, E); }); \
    RUN(PH_MOE0 + 2 * (cidx) + 1, const int* hdr = (const int*)(ws + WS_HDR); const int npan = hdr[8]; const int p0 = (cidx) * MOE_CHUNK_PAN; \
        { g8::MoeOrder S; S.p0 = p0; S.np = ((cidx) == MOE_NCHUNK - 1) ? (npan - p0) : MOE_CHUNK_PAN; S.nfull = MOE_CHUNK_PAN; S.nsplit = MOE_KSPLIT; S.nN = 4; S.G = G; S.c = (int)blockIdx.x; S.K = FFE; S.estride = (unsigned)(D * FFE * 2); \
            _Pragma("unroll") for (int e = 0; e < NE; ++e) S.pend[e] = hdr[e]; \
            g8::Gemm g{RA, (const bf16_t*)(ws + WS_WEDN), FFE, nullptr, ws + WS_TOK, nullptr}; \
            g8::EpiMoeDown E{RB, RD, lds + LDS_META, (float*)((unsigned char*)RA + RA_POFF), MOE_CHUNK_PAN}; \
            g8::gemm_phase<g8::EpiMoeDown, g8::MoeOrder, false, 2>(lds, g, S, E); });
    MOE_CHUNK(0) MOE_CHUNK(1) MOE_CHUNK(2) MOE_CHUNK(3)
    RUN(PH_FIX, moefix_phase(args););
    RUN(PH_FINAL, final_phase(args););
    if (PROBE_T >= 0 && blockIdx.x == 0 && threadIdx.x == 0) { const long long dl = 4 * (((volatile long long*)(ws + WS_DIAG))[3] - ((volatile long long*)(ws + WS_DIAG))[2]); const long long t0 = wall_clock64(); while (wall_clock64() - t0 < dl) __builtin_amdgcn_s_sleep(8); }
#undef RUN
#undef IN
#undef SEAM
}

extern "C" void kernel_launch(void* const* d_in, const int* in_sizes, int n_in, void* d_out, int out_size, void* d_ws, size_t ws_size, hipStream_t stream) {
    static int grid = 0;
    if (grid == 0) {
        if (n_in != 18 || out_size != NR * D || ws_size < WS_END) { fprintf(stderr, "kernel_launch: unexpected problem (n_in %d out %d ws %zu need %zu)\n", n_in, out_size, ws_size, (size_t)WS_END); grid = -1; return; }
        int dev = 0, cus = 0, per_cu = 0;
        if (hipGetDevice(&dev) != hipSuccess || hipDeviceGetAttribute(&cus, hipDeviceAttributeMultiprocessorCount, dev) != hipSuccess) { grid = -1; return; }
        if (hipFuncSetAttribute((const void*)yoco_fwd, hipFuncAttributeMaxDynamicSharedMemorySize, LDS_BYTES) != hipSuccess) { fprintf(stderr, "kernel_launch: hipFuncSetAttribute failed\n"); grid = -1; return; }
        if (hipOccupancyMaxActiveBlocksPerMultiprocessor(&per_cu, (const void*)yoco_fwd, NTHREADS, LDS_BYTES) != hipSuccess || per_cu < 1) { fprintf(stderr, "kernel_launch: occupancy query says %d\n", per_cu); }
        (void)hipGetLastError();
        if (cus < 256) { fprintf(stderr, "kernel_launch: needs 256 CUs\n"); grid = -1; return; }
        grid = 256;
    }
    if (grid < 0) return;
    (void)hipMemsetAsync((char*)d_ws + WS_CTL, 0, CTL_BYTES, stream);
    Args a{};
    for (int i = 0; i < 18; ++i) a.in[i] = (const float*)d_in[i];
    a.out = (float*)d_out; a.ws = (unsigned char*)d_ws;
#if N_LAUNCH_MODE == 1
    for (int p = 0; p < PH_COUNT; ++p) { a.ph_lo = p; a.ph_hi = p + 1; hipLaunchKernelGGL(yoco_fwd, dim3(grid), dim3(NTHREADS), LDS_BYTES, stream, a); }
#else
    a.ph_lo = 0; a.ph_hi = PH_COUNT;
    hipLaunchKernelGGL(yoco_fwd, dim3(grid), dim3(NTHREADS), LDS_BYTES, stream, a);
#endif
}
```

```cpp
#include <hip/hip_runtime.h>
#include <cstdio>
#include <cstdint>

#ifndef N_LAUNCH_MODE
#define N_LAUNCH_MODE 0
#endif
#ifndef PROBE_CLK
#define PROBE_CLK 0
#endif
#ifndef PROBE_T
#define PROBE_T (-1)
#endif
#ifndef PROBE_WG
#define PROBE_WG (-1)
#endif
#ifndef REPMASK
#define REPMASK 0u
#endif

#define LAS __attribute__((address_space(3)))
typedef unsigned short bf16_t;
typedef short bf16x8 __attribute__((ext_vector_type(8)));
typedef float f32x2 __attribute__((ext_vector_type(2)));
typedef float f32x4 __attribute__((ext_vector_type(4)));
typedef float f32x16 __attribute__((ext_vector_type(16)));
typedef unsigned u32x2 __attribute__((ext_vector_type(2)));
typedef unsigned u32x4 __attribute__((ext_vector_type(4)));
typedef __bf16 bf16x2_t __attribute__((ext_vector_type(2)));

constexpr int D = 1024, NB = 16, SEQ = 4096, NMETA = 16;
constexpr int NR = NB * SEQ;
constexpr int NROWS = NR + NB * NMETA;
constexpr int NPAN = NROWS / 256;
constexpr int NPROJ = 3072;
constexpr int FFD = 2816, NE = 8, FFE = 3584;
constexpr float ALPHA = 1.41421356237f, LN_EPS = 1e-5f;
constexpr int NTHREADS = 512;
constexpr int MOE_ROWS = 2 * NR + NE * 256;
constexpr int MOE_CHUNK_PAN = 128;
constexpr int MOE_NCHUNK = 4;
constexpr int MOE_KSPLIT = 7;
constexpr size_t RA_POFF = (size_t)256 << 20;

constexpr size_t al256(size_t x) { return (x + 255) & ~(size_t)255; }
constexpr size_t WS_CTL = 0;
constexpr size_t CTL_BYTES = 65536;
constexpr size_t WS_WIN = WS_CTL + CTL_BYTES;
constexpr size_t WS_WOUT = WS_WIN + (size_t)NPROJ * D * 2;
constexpr size_t WS_WGU = WS_WOUT + (size_t)D * D * 2;
constexpr size_t WS_WDN = WS_WGU + (size_t)2 * FFD * D * 2;
constexpr size_t WS_WKVQ = WS_WDN + (size_t)D * FFD * 2;
constexpr size_t WS_WO = WS_WKVQ + (size_t)NPROJ * D * 2;
constexpr size_t WS_WEGU = WS_WO + (size_t)D * D * 2;
constexpr size_t WS_WEDN = WS_WEGU + (size_t)NE * 2 * FFE * D * 2;
constexpr size_t WS_VEC = WS_WEDN + (size_t)NE * D * FFE * 2;
constexpr int VEC_GU_CS = 0, VEC_GU_BW = 2 * FFD, VEC_KVQ_CS = 4 * FFD, VEC_KVQ_BW = VEC_KVQ_CS + NPROJ, VEC_EGU_CS = VEC_KVQ_BW + NPROJ, VEC_EGU_BW = VEC_EGU_CS + NE * 2 * FFE, VEC_END = VEC_EGU_BW + NE * 2 * FFE;
constexpr size_t WS_GATES = al256(WS_VEC + (size_t)VEC_END * 4);
constexpr size_t WS_ST1 = al256(WS_GATES + (size_t)NROWS * 8 * 4);
constexpr size_t WS_ST2 = WS_ST1 + (size_t)NROWS * 16 * 8;
constexpr size_t WS_ST3 = WS_ST2 + (size_t)NROWS * 16 * 8;
constexpr size_t WS_ROUTE = WS_ST3 + (size_t)NROWS * 16 * 8;
constexpr size_t WS_CNT = WS_ROUTE + (size_t)NR * 16;
constexpr size_t WS_HDR = WS_CNT + 256 * 8 * 4;
constexpr size_t WS_TOK = WS_HDR + 256;
constexpr size_t WS_GATEB = al256(WS_TOK + (size_t)MOE_ROWS * 8);
constexpr size_t WS_TOKST = al256(WS_GATEB + (size_t)MOE_ROWS * 8);
constexpr size_t WS_RS1 = al256(WS_TOKST + (size_t)NR * 8);
constexpr size_t WS_RS2 = al256(WS_RS1 + (size_t)NROWS * 8);
constexpr size_t WS_DIAG = al256(WS_RS2 + (size_t)NROWS * 8);
constexpr size_t WS_RA = al256(WS_DIAG + 4096);
constexpr size_t RA_BYTES = (size_t)NROWS * NPROJ * 2;
constexpr size_t WS_RB = al256(WS_RA + RA_BYTES);
constexpr size_t RX_BYTES = (size_t)NROWS * D * 2;
constexpr size_t WS_RC = al256(WS_RB + RX_BYTES);
constexpr size_t WS_RD = al256(WS_RC + RX_BYTES);
constexpr size_t WS_END = al256(WS_RD + RX_BYTES);

constexpr int LDS_MAIN = 131072, LDS_META = LDS_MAIN  , LDS_MISC = LDS_META + 8192  , LDS_BYTES = LDS_MISC + 256;
__device__ __forceinline__ float bf2f(bf16_t v) { return __uint_as_float(((unsigned)v) << 16); }
__device__ __forceinline__ float bflo(unsigned u) { return __uint_as_float(u << 16); }
__device__ __forceinline__ float bfhi(unsigned u) { return __uint_as_float(u & 0xffff0000u); }
__device__ __forceinline__ unsigned pk2(float lo, float hi) { f32x2 v = {lo, hi}; bf16x2_t b = __builtin_convertvector(v, bf16x2_t); return __builtin_bit_cast(unsigned, b); }
__device__ __forceinline__ bf16_t f2bf(float f) { return (bf16_t)(pk2(f, 0.f) & 0xffffu); }
__device__ __forceinline__ float rbf(float f) { return bflo(pk2(f, 0.f)); }
__device__ __forceinline__ float wave_sum(float v) {
#pragma unroll
    for (int o = 32; o >= 1; o >>= 1) v += __shfl_xor(v, o);
    return v;
}
__device__ __forceinline__ float swap32_hi(float x, float& lo) {
    const u32x2 r = __builtin_amdgcn_permlane32_swap(__float_as_uint(x), __float_as_uint(x), false, false); lo = __uint_as_float(r.x); return __uint_as_float(r.y); }
__device__ __forceinline__ float fq_sum(float x) {
    const u32x2 a = __builtin_amdgcn_permlane16_swap(__float_as_uint(x), __float_as_uint(x), false, false); const float y = __uint_as_float(a.x) + __uint_as_float(a.y);
    const u32x2 b = __builtin_amdgcn_permlane32_swap(__float_as_uint(y), __float_as_uint(y), false, false); return __uint_as_float(b.x) + __uint_as_float(b.y); }
__device__ __forceinline__ float sigmoidf_(float x) { return __builtin_amdgcn_rcpf(1.0f + __builtin_amdgcn_exp2f(x * -1.4426950408889634f)); }

#define XB_TMO      128
#define XB_XCNT(j)  (256  + 64 * (j))
#define XB_XSUB(j)  (1280 + 64 * (j))
#define XB_XGEN(j)  (2304 + 64 * (j))
#define XB_TOP      3328
#define XB_TOPGEN   3392
#define XCD_BAR_WORDS 3456
#define XB_SPIN_CAP (1u << 20)
__device__ __forceinline__ unsigned xb_ld(unsigned* p)              { return __hip_atomic_load(p, __ATOMIC_RELAXED, __HIP_MEMORY_SCOPE_AGENT); }
__device__ __forceinline__ unsigned xb_add(unsigned* p, unsigned v) { return __hip_atomic_fetch_add(p, v, __ATOMIC_RELAXED, __HIP_MEMORY_SCOPE_AGENT); }
__device__ __forceinline__ unsigned xb_xcc_id() { return (unsigned)__builtin_amdgcn_s_getreg((3 << 11) | 20) & 0xFu; }
#define XB_SPIN(cond, bar) do { unsigned _sp = 0; while (cond) { __builtin_amdgcn_s_sleep(1); \
    if ((++_sp & 255u) == 0u) { if (xb_ld(&(bar)[XB_TMO])) break; if (_sp > XB_SPIN_CAP) { atomicAdd(&(bar)[XB_TMO], 1u); break; } } } } while (0)
struct XcdBarrier { unsigned* bar; unsigned x; volatile LAS unsigned* st; };
__device__ __forceinline__ XcdBarrier xcd_barrier_post(unsigned* bar, volatile LAS unsigned* st) {
    XcdBarrier b; b.bar = bar; b.x = xb_xcc_id(); b.st = st;
    if (threadIdx.x == 0) (void)xb_add(&bar[XB_XCNT(b.x)], 1u);
    return b;
}
__device__ __forceinline__ void xcd_barrier_complete(unsigned* bar, unsigned x, unsigned& nloc, unsigned& nx) {
    const unsigned G = gridDim.x * gridDim.y * gridDim.z;
    unsigned sum, cnt, mine, sp = 0u;
    for (;;) {
        sum = 0u; cnt = 0u; mine = 0u;
#pragma unroll
        for (unsigned j = 0; j < 16; ++j) { const unsigned c = xb_ld(&bar[XB_XCNT(j)]); sum += c; cnt += (c > 0u) ? 1u : 0u; mine = (j == x) ? c : mine; }
        if (sum == G) break;
        __builtin_amdgcn_s_sleep(1);
        if ((++sp & 255u) == 0u) { if (xb_ld(&bar[XB_TMO])) break; if (sp > XB_SPIN_CAP) { atomicAdd(&bar[XB_TMO], 1u); break; } }
    }
    nloc = mine > 0u ? mine : 1u; nx = cnt > 0u ? cnt : 1u;
}
__device__ __forceinline__ void xcd_barrier(const XcdBarrier& b) {
    asm volatile("s_waitcnt vmcnt(0)" ::: "memory");
    __syncthreads();
    if (threadIdx.x == 0) {
        unsigned* bar = b.bar;
        __builtin_amdgcn_s_waitcnt(0);
        unsigned nloc = b.st[0], nx = b.st[1];
        if (nloc == 0u) { xcd_barrier_complete(bar, b.x, nloc, nx); b.st[0] = nloc; b.st[1] = nx; }
        const unsigned old = xb_add(&bar[XB_XSUB(b.x)], 1u);
        const unsigned gen = old / nloc;
        if (old + 1u == (gen + 1u) * nloc) {
            __builtin_amdgcn_fence(__ATOMIC_RELEASE, "agent");
            asm volatile("s_waitcnt vmcnt(0)" ::: "memory");
            const unsigned og = xb_add(&bar[XB_TOP], 1u);
            const unsigned tg = og / nx;
            if (og + 1u == (tg + 1u) * nx) xb_add(&bar[XB_TOPGEN], 1u);
            else XB_SPIN(xb_ld(&bar[XB_TOPGEN]) == tg, bar);
            __builtin_amdgcn_fence(__ATOMIC_ACQUIRE, "agent");
            xb_add(&bar[XB_XGEN(b.x)], 1u);
            asm volatile("s_waitcnt vmcnt(0)" ::: "memory");
        } else {
            XB_SPIN(xb_ld(&bar[XB_XGEN(b.x)]) == gen, bar);
            __builtin_amdgcn_fence(__ATOMIC_ACQUIRE, "agent");
            asm volatile("s_waitcnt vmcnt(0)" ::: "memory");
        }
    }
    __syncthreads();
}

namespace g8 {
constexpr int BM = 256, BK = 64, HALF = 128, HTB = HALF * BK * 2, STAGE_BYTES = 8 * HTB, NXCD = 8, WGM = 8;
__host__ __device__ __forceinline__ int lds_byte(int r, int c) { const int st = (r >> 4) * 2 + (c >> 5), rr = r & 15, cc = c & 31, ob = rr * 64 + cc * 2; return st * 1024 + (ob ^ (((ob >> 9) & 1) << 5)); }
__host__ __device__ __forceinline__ void stage_rc(int b, int& R, int& C) { const int st = b / 1024, sb = b % 1024, swz = sb ^ (((sb >> 9) & 1) << 5); R = (st >> 1) * 16 + swz / 64; C = (st & 1) * 32 + (swz % 64) / 2; }
__host__ __device__ __forceinline__ int perm32(int rho) { const int n = rho >> 4, i = rho & 15; return 8 * (i >> 2) + 4 * n + (i & 3); }

struct Unit { int pm, pn, gp; unsigned boff; int aux; int kt; unsigned koff; int ks; };
struct Gemm { const bf16_t* A; const bf16_t* Bt; int K; const int* rowtab; const unsigned char* smeta; const unsigned char* sstat; };

struct DenseOrder {
    int nM, nN, nwg, G, c, K;
    __device__ void init(int nM_, int nN_, int K_, int G_, int c_) { nM = nM_; nN = nN_; nwg = nM * nN; G = G_; c = c_; K = K_; }
    __device__ bool next(int i, Unit& u) const {
        const long L = (long)i * G + c; if (L >= nwg) return false;
        int wgid = (int)L; { const int q = nwg / NXCD, r = nwg % NXCD, xcd = wgid % NXCD, off = wgid / NXCD; wgid = (xcd < r ? xcd * (q + 1) : r * (q + 1) + (xcd - r) * q) + off; }
        const int nig = WGM * nN, gid = wgid / nig, fm = gid * WGM, gsz = (nM - fm) < WGM ? (nM - fm) : WGM;
        u.pm = fm + ((wgid % nig) % gsz); u.pn = (wgid % nig) / gsz; u.gp = u.pm; u.boff = (unsigned)u.pn * (unsigned)(256 * K * 2); u.kt = K / BK; u.koff = 0u; u.ks = -1; return true;
    }
};
struct MoeOrder {
    int p0, np, nN, G, c, K; unsigned estride; int pend[NE]; int nfull, nsplit;
    __device__ bool next(int i, Unit& u) const {
        const long L = (long)i * G + c; const long nmain = (long)nfull * nN;
        int pn, pml, ks = -1;
        if (L < nmain) {
            if (G == 256 && nfull == 128 && (nN & 3) == 0) { const int x = c & 7, j = c >> 3, rpb = nN >> 2, pb = x + 8 * (i / rpb), nb = i % rpb;
                pml = 8 * pb + (j & 7); pn = 4 * nb + (j >> 3); }
            else { pn = (int)(L / nfull); pml = (int)(L % nfull); } }
        else { const long r = L - nmain; if (r >= (long)(np - nfull) * nN * nsplit) return false;
            ks = (int)(r % nsplit); const int q = (int)(r / nsplit); pn = q % nN; pml = nfull + q / nN; if (nsplit == 1) ks = -1; }
        const int gp = p0 + pml;
        int e = 0;
#pragma unroll
        for (int j = 0; j < NE - 1; ++j) e += (gp >= pend[j]) ? 1 : 0;
        const int ktall = K / BK;
        u.pm = pml; u.pn = pn; u.gp = gp; u.ks = ks; u.kt = ks < 0 ? ktall : ktall / nsplit; u.koff = ks < 0 ? 0u : (unsigned)(ks * (K / nsplit) * 2);
        u.boff = (unsigned)e * estride + (unsigned)pn * (unsigned)(256 * K * 2) + u.koff; return true;
    }
};

template <class Epi, class Sched, bool GATHER, int META = 0>
__device__ __forceinline__ void gemm_phase(LAS unsigned char* lds, const Gemm g, const Sched& S, const Epi& E) {
    const int tid = threadIdx.x, wid = __builtin_amdgcn_readfirstlane(tid >> 6), lane = tid & 63, wr = wid >> 2, wc = wid & 3, fr = lane & 15, fq = lane >> 4;
    const int K = g.K;
    int Rr[2], Cc[2]; unsigned voffA[2], voffB[2];
#pragma unroll
    for (int i = 0; i < 2; ++i) { stage_rc(tid * 16 + i * 8192, Rr[i], Cc[i]); const int Rb = (Rr[i] & ~31) + perm32(Rr[i] & 31);
        voffA[i] = (unsigned)(Rr[i] * K + Cc[i]) * 2u; voffB[i] = (unsigned)(Rb * K + Cc[i]) * 2u; }
    const size_t kstep = (size_t)(BK * 2);
    const size_t hstep = (size_t)HALF * K * 2;
    const size_t tstep = 2 * hstep;
    const unsigned ldsw = (unsigned)wid * 1024u;
    const int aoff = lds_byte(wr * 64 + fr, fq * 8), boff = lds_byte(wc * 32 + fr, fq * 8);
#define G8_SA(b, h) (((b) * 2 + (h)) * HTB)
#define G8_SB(b, h) ((4 + (b) * 2 + (h)) * HTB)
#define G8_STAGE(bufoff, gbase, voff) do { _Pragma("unroll") for (int _i = 0; _i < 2; ++_i) \
        __builtin_amdgcn_global_load_lds((const unsigned*)((const char*)(gbase) + (voff)[_i]), (LAS unsigned*)(lds + (bufoff) + ldsw + _i * 8192), 16, 0, 0); } while (0)
#define G8_STA(bufoff, ptr, offs, h) do { if constexpr (GATHER) { G8_STAGE(bufoff, (const char*)g.A, (offs)[h]); } else { G8_STAGE(bufoff, (ptr) + (h) * hstep, voffA); } } while (0)
#define G8_LDA(dst, b, h) do { _Pragma("unroll") for (int m = 0; m < 4; ++m) _Pragma("unroll") for (int k = 0; k < 2; ++k) dst[m][k] = *(const LAS bf16x8*)(lds + G8_SA(b, h) + aoff + m * 2048 + k * 1024); } while (0)
#define G8_LDB(dst, b, h) do { _Pragma("unroll") for (int n = 0; n < 2; ++n) _Pragma("unroll") for (int k = 0; k < 2; ++k) dst[n][k] = *(const LAS bf16x8*)(lds + G8_SB(b, h) + boff + n * 2048 + k * 1024); } while (0)
#define G8_MMA(ai, bj, At, Bt) do { __builtin_amdgcn_s_setprio(1); _Pragma("unroll") for (int m = 0; m < 4; ++m) _Pragma("unroll") for (int n = 0; n < 2; ++n) _Pragma("unroll") for (int k = 0; k < 2; ++k) \
        acc[ai][bj][m][n] = __builtin_amdgcn_mfma_f32_16x16x32_bf16(Bt[n][k], At[m][k], acc[ai][bj][m][n], 0, 0, 0); __builtin_amdgcn_s_setprio(0); } while (0)
#define G8_WAIT_V(n) asm volatile("s_waitcnt vmcnt(" #n ")" ::: "memory")
#define G8_WAIT_L(n) asm volatile("s_waitcnt lgkmcnt(" #n ")" ::: "memory")
#define G8_BAR __builtin_amdgcn_s_barrier()
#define G8_SCHED __builtin_amdgcn_sched_barrier(0)
#define G8_ROWOFFS(dst, U) do { _Pragma("unroll") for (int _h = 0; _h < 2; ++_h) _Pragma("unroll") for (int _i = 0; _i < 2; ++_i) { \
        const int _id = g.rowtab[2 * ((U).gp * 256 + _h * 128 + Rr[_i])]; const int _tk = _id < 0 ? 0 : (_id >> 1); dst[_h][_i] = (unsigned)(_tk * K + Cc[_i]) * 2u; } } while (0)
#define G8_META_DMA(gsrc, panel, bufidx) __builtin_amdgcn_global_load_lds((const unsigned*)((gsrc) + (size_t)(panel) * 2048 + wid * 256 + lane * 4), (LAS unsigned*)(lds + LDS_META + (bufidx) * 2048 + wid * 256), 4, 0, 0)
    Unit cur, nxt; int ui = 0;
    if (!S.next(0, cur)) return;
    f32x4 acc[2][2][4][2];
#pragma unroll
    for (int a = 0; a < 2; ++a)
#pragma unroll
        for (int b = 0; b < 2; ++b)
#pragma unroll
            for (int m = 0; m < 4; ++m)
#pragma unroll
                for (int n = 0; n < 2; ++n) acc[a][b][m][n] = (f32x4){0.f, 0.f, 0.f, 0.f};
    bf16x8 At[4][2], B0[2][2], B1[2][2];
    const char* cA = (const char*)g.A + (size_t)cur.pm * tstep + cur.koff; const char* cB = (const char*)g.Bt + cur.boff;
    unsigned oc[2][2], on[2][2], o1[2][2], o2[2][2], o3[2][2];
    if constexpr (GATHER) { G8_ROWOFFS(oc, cur);
#pragma unroll
        for (int h = 0; h < 2; ++h)
#pragma unroll
            for (int i = 0; i < 2; ++i) { o1[h][i] = oc[h][i] + 128u; on[h][i] = oc[h][i]; o2[h][i] = 0; o3[h][i] = 0; } }
    G8_STAGE(G8_SB(0, 0), cB, voffB); G8_STAGE(G8_SB(0, 1), cB + hstep, voffB); G8_STA(G8_SA(0, 0), cA, oc, 0); G8_STA(G8_SA(0, 1), cA, oc, 1);
    if (wr == 1) G8_BAR;
    G8_WAIT_V(2); G8_BAR;
    G8_STAGE(G8_SB(1, 0), cB + kstep, voffB); G8_STA(G8_SA(1, 0), cA + kstep, o1, 0); G8_STAGE(G8_SB(1, 1), cB + hstep + kstep, voffB);
    G8_WAIT_V(6); G8_BAR;
    for (;;) {
        const bool has_next = S.next(ui + 1, nxt);
        const char* nA = has_next ? (const char*)g.A + (size_t)nxt.pm * tstep + nxt.koff : cA; const char* nB = has_next ? (const char*)g.Bt + nxt.boff : cB;
        const int nt = cur.kt;
        if constexpr (META == 1) { if (has_next) G8_META_DMA(g.smeta, nxt.gp, (ui + 1) & 1); G8_META_DMA(g.sstat, cur.gp, 2 + (ui & 1)); }
        if constexpr (META == 2) { G8_META_DMA(g.smeta, cur.gp, ui & 1); }
        if constexpr (META == 3) { G8_META_DMA(g.sstat, cur.pm, 2 + (ui & 1)); }
        for (int t = 0; t < nt; t += 2) {
            const bool last = (t == nt - 2);
            const char* a1 = cA + (size_t)(t + 1) * kstep;
            const char* a2 = last ? nA : cA + (size_t)(t + 2) * kstep; const char* b2 = last ? nB : cB + (size_t)(t + 2) * kstep;
            const char* a3 = a2 + kstep; const char* b3 = b2 + kstep;
            if constexpr (GATHER) {
                if (last) {
#pragma unroll
                    for (int h = 0; h < 2; ++h)
#pragma unroll
                        for (int i = 0; i < 2; ++i) { int id = -1; if (has_next) id = *(const LAS int*)(lds + LDS_META + ((ui + 1) & 1) * 2048 + (h * 128 + Rr[i]) * 8);
                            const int tk = id < 0 ? 0 : (id >> 1); on[h][i] = has_next ? (unsigned)(tk * K + Cc[i]) * 2u : oc[h][i]; } }
#pragma unroll
                for (int h = 0; h < 2; ++h)
#pragma unroll
                    for (int i = 0; i < 2; ++i) { o1[h][i] = oc[h][i] + (unsigned)(t + 1) * 128u; o2[h][i] = last ? on[h][i] : oc[h][i] + (unsigned)(t + 2) * 128u; o3[h][i] = o2[h][i] + 128u; } }
            G8_LDB(B0, 0, 0); G8_LDB(B1, 0, 1); G8_SCHED; G8_LDA(At, 0, 0); G8_STA(G8_SA(1, 1), a1, o1, 1);
            G8_WAIT_V(8); G8_WAIT_L(0); G8_BAR; G8_MMA(0, 0, At, B0); G8_MMA(0, 1, At, B1); G8_BAR; G8_SCHED;
            G8_LDA(At, 0, 1); G8_STAGE(G8_SB(0, 0), b2, voffB); G8_STAGE(G8_SB(0, 1), b2 + hstep, voffB); G8_STA(G8_SA(0, 0), a2, o2, 0);
            G8_WAIT_V(8); G8_WAIT_L(0); G8_BAR; G8_MMA(1, 0, At, B0); G8_MMA(1, 1, At, B1); G8_BAR; G8_SCHED;
            G8_LDB(B0, 1, 0); G8_LDB(B1, 1, 1); G8_SCHED; G8_LDA(At, 1, 0); G8_STA(G8_SA(0, 1), a2, o2, 1);
            G8_WAIT_V(8); G8_WAIT_L(0); G8_BAR; G8_MMA(0, 0, At, B0); G8_MMA(0, 1, At, B1); G8_BAR; G8_SCHED;
            G8_LDA(At, 1, 1); G8_STAGE(G8_SB(1, 0), b3, voffB); G8_STAGE(G8_SB(1, 1), b3 + hstep, voffB); G8_STA(G8_SA(1, 0), a3, o3, 0);
            G8_WAIT_V(8); G8_WAIT_L(0); G8_BAR; G8_MMA(1, 0, At, B0); G8_MMA(1, 1, At, B1); G8_BAR; G8_SCHED;
        }
        if (wr == 0) G8_BAR;
        cur.aux = ui & 1;
        E(acc, cur, wr, wc, fr, fq);
        if (!has_next) break;
#pragma unroll
        for (int a = 0; a < 2; ++a)
#pragma unroll
            for (int b = 0; b < 2; ++b)
#pragma unroll
                for (int m = 0; m < 4; ++m)
#pragma unroll
                    for (int n = 0; n < 2; ++n) acc[a][b][m][n] = (f32x4){0.f, 0.f, 0.f, 0.f};
        cur = nxt; cA = nA; cB = nB; ++ui;
        if constexpr (GATHER) {
#pragma unroll
            for (int h = 0; h < 2; ++h)
#pragma unroll
                for (int i = 0; i < 2; ++i) oc[h][i] = on[h][i]; }
        if (wr == 1) G8_BAR;
    }
    G8_WAIT_V(0);
    G8_BAR;
#undef G8_SA
#undef G8_SB
#undef G8_STAGE
#undef G8_STA
#undef G8_LDA
#undef G8_LDB
#undef G8_MMA
#undef G8_WAIT_V
#undef G8_WAIT_L
#undef G8_BAR
#undef G8_SCHED
#undef G8_ROWOFFS
#undef G8_META_DMA
}

typedef f32x4 Acc[2][2][4][2];
__device__ __forceinline__ u32x4 pack8(const f32x4 a, const f32x4 b) { u32x4 w; w.x = pk2(a[0], a[1]); w.y = pk2(a[2], a[3]); w.z = pk2(b[0], b[1]); w.w = pk2(b[2], b[3]); return w; }
__device__ __forceinline__ void unpack8(const u32x4 w, float (&f)[8]) { f[0] = bflo(w.x); f[1] = bfhi(w.x); f[2] = bflo(w.y); f[3] = bfhi(w.y); f[4] = bflo(w.z); f[5] = bfhi(w.z); f[6] = bflo(w.w); f[7] = bfhi(w.w); }
__device__ __forceinline__ void row_stats(const float* st, int row, int fq, float& mu, float& rstd) {
    const f32x4* p = (const f32x4*)(st + (size_t)row * 32 + fq * 8);
    const f32x4 a = p[0], b = p[1];
    float s1 = (a[0] + a[2]) + (b[0] + b[2]), s2 = (a[1] + a[3]) + (b[1] + b[3]);
    s1 += __shfl_xor(s1, 16); s1 += __shfl_xor(s1, 32); s2 += __shfl_xor(s2, 16); s2 += __shfl_xor(s2, 32);
    mu = s1 * (1.0f / 1024.0f); const float var = fmaxf(s2 * (1.0f / 1024.0f) - mu * mu, 0.f); rstd = rsqrtf(var + LN_EPS);
}
__device__ __forceinline__ void put_stats(float* st, int row, int slot, int fq, float s1, float s2) {
    s1 = fq_sum(s1); s2 = fq_sum(s2);
    if (fq == 0) *(f32x2*)(st + (size_t)row * 32 + slot * 2) = (f32x2){s1, s2};
}

struct EpiPlain {
    bf16_t* O; int ldc;
    __device__ __forceinline__ void operator()(const Acc& acc, const Unit& u, int wr, int wc, int fr, int fq) const {
        const int row0 = u.pm * 256 + wr * 64 + fr, col0 = u.pn * 256 + wc * 32 + 8 * fq;
#pragma unroll
        for (int ai = 0; ai < 2; ++ai)
#pragma unroll
            for (int m = 0; m < 4; ++m) { bf16_t* rowp = O + (size_t)(row0 + ai * 128 + m * 16) * ldc + col0;
#pragma unroll
                for (int bj = 0; bj < 2; ++bj) *(u32x4*)(rowp + bj * 128) = pack8(acc[ai][bj][m][0], acc[ai][bj][m][1]); }
    }
};
template <int MODE> struct EpiRes {
    bf16_t* Z; const bf16_t* Rsrc; float* st_out; LAS unsigned char* ldsm; const float* g; const float* b;
    __device__ __forceinline__ void operator()(const Acc& acc, const Unit& u, int wr, int wc, int fr, int fq) const {
        const int r0 = wr * 64 + fr, col0 = u.pn * 256 + wc * 32 + 8 * fq;
        f32x4 gv[2][2], bv[2][2];
        if (MODE == 1) {
#pragma unroll
            for (int bj = 0; bj < 2; ++bj)
#pragma unroll
                for (int n = 0; n < 2; ++n) { gv[bj][n] = *(const f32x4*)(g + col0 + bj * 128 + 4 * n); bv[bj][n] = *(const f32x4*)(b + col0 + bj * 128 + 4 * n); }
        }
        u32x4 rwa[4][4][2];
#define EPR_LOAD(am_) do { _Pragma("unroll") for (int m = 2 * ((am_) & 1); m < 2 * ((am_) & 1) + 2; ++m) _Pragma("unroll") for (int bj = 0; bj < 2; ++bj) \
            rwa[am_][m][bj] = *(const u32x4*)(Rsrc + ((size_t)u.pm * 256 + r0 + ((am_) >> 1) * 128 + m * 16) * D + col0 + bj * 128); } while (0)
        EPR_LOAD(0);
#pragma unroll
        for (int am = 0; am < 4; ++am) { const int ai = am >> 1;
            if (am + 1 < 4) EPR_LOAD(am + 1);
            u32x4 (&rw)[4][2] = rwa[am];
#pragma unroll
            for (int m = 2 * (am & 1); m < 2 * (am & 1) + 2; ++m) {
                const int rl = r0 + ai * 128 + m * 16; const size_t row = (size_t)u.pm * 256 + rl;
                float mu = 0.f, rstd = 1.f;
                if (MODE == 1) { const f32x2 ms = *(const LAS f32x2*)(ldsm + (2 + u.aux) * 2048 + rl * 8); mu = ms[0]; rstd = ms[1]; }
                float s1 = 0.f, s2 = 0.f;
#pragma unroll
                for (int bj = 0; bj < 2; ++bj) {
                    float r[8]; unpack8(rw[m][bj], r);
                    f32x4 v0, v1;
#pragma unroll
                    for (int j = 0; j < 4; ++j) {
                        float h0 = r[j], h1 = r[4 + j];
                        if (MODE == 1) { h0 = (h0 - mu) * rstd * gv[bj][0][j] + bv[bj][0][j]; h1 = (h1 - mu) * rstd * gv[bj][1][j] + bv[bj][1][j]; }
                        v0[j] = ALPHA * h0 + acc[ai][bj][m][0][j]; v1[j] = ALPHA * h1 + acc[ai][bj][m][1][j];
                    }
                    const u32x4 w = pack8(v0, v1);
                    *(u32x4*)(Z + row * D + col0 + bj * 128) = w;
                    float q[8]; unpack8(w, q);
#pragma unroll
                    for (int j = 0; j < 8; ++j) { s1 += q[j]; s2 += q[j] * q[j]; }
                }
                put_stats(st_out, (int)row, u.pn * 4 + wc, fq, s1, s2);
            }
        }
    }
};
struct EpiFold {
    bf16_t* O; int ldc; LAS unsigned char* ldsm; const float* cs; const float* bw;
    __device__ __forceinline__ void operator()(const Acc& acc, const Unit& u, int wr, int wc, int fr, int fq) const {
        const int r0 = wr * 64 + fr, col0 = u.pn * 256 + wc * 32 + 8 * fq;
        f32x4 cv[2][2], bv[2][2];
#pragma unroll
        for (int bj = 0; bj < 2; ++bj)
#pragma unroll
            for (int n = 0; n < 2; ++n) { cv[bj][n] = *(const f32x4*)(cs + col0 + bj * 128 + 4 * n); bv[bj][n] = *(const f32x4*)(bw + col0 + bj * 128 + 4 * n); }
#pragma unroll
        for (int ai = 0; ai < 2; ++ai)
#pragma unroll
            for (int m = 0; m < 4; ++m) {
                const int rl = r0 + ai * 128 + m * 16; const size_t row = (size_t)u.pm * 256 + rl;
                const f32x2 ms = *(const LAS f32x2*)(ldsm + (2 + u.aux) * 2048 + rl * 8); const float mu = ms[0], rstd = ms[1];
#pragma unroll
                for (int bj = 0; bj < 2; ++bj) {
                    const f32x4 v0 = (acc[ai][bj][m][0] - mu * cv[bj][0]) * rstd + bv[bj][0], v1 = (acc[ai][bj][m][1] - mu * cv[bj][1]) * rstd + bv[bj][1];
                    *(u32x4*)(O + row * ldc + col0 + bj * 128) = pack8(v0, v1);
                }
            }
    }
};
template <bool MOE> struct EpiGlu {
    bf16_t* O; int ldc; const float* st_in; const float* cs; const float* bw; LAS unsigned char* ldsm; int ncs;
    __device__ __forceinline__ void operator()(const Acc& acc, const Unit& u, int wr, int wc, int fr, int fq) const {
        const int row0 = u.pm * 256 + wr * 64 + fr, colo = u.pn * 128 + wc * 32 + 8 * fq;
        int vb = u.pn * 256 + wc * 32 + 8 * fq;
        if (MOE) vb += (int)(u.boff / (unsigned)(256 * D * 2)) * 256 - u.pn * 256;
        f32x4 cv[2][2], bv[2][2];
#pragma unroll
        for (int bj = 0; bj < 2; ++bj)
#pragma unroll
            for (int n = 0; n < 2; ++n) { cv[bj][n] = *(const f32x4*)(cs + vb + bj * 128 + 4 * n); bv[bj][n] = *(const f32x4*)(bw + vb + bj * 128 + 4 * n); }
#pragma unroll
        for (int ai = 0; ai < 2; ++ai)
#pragma unroll
            for (int m = 0; m < 4; ++m) {
                const int row = row0 + ai * 128 + m * 16;
                const f32x2 ms = *(const LAS f32x2*)(ldsm + (2 + u.aux) * 2048 + (row - u.pm * 256) * 8); const float mu = ms[0], rstd = ms[1];
                f32x4 o0, o1;
#pragma unroll
                for (int j = 0; j < 4; ++j) {
                    const float g0 = (acc[ai][0][m][0][j] - mu * cv[0][0][j]) * rstd + bv[0][0][j], g1 = (acc[ai][0][m][1][j] - mu * cv[0][1][j]) * rstd + bv[0][1][j];
                    const float u0 = (acc[ai][1][m][0][j] - mu * cv[1][0][j]) * rstd + bv[1][0][j], u1 = (acc[ai][1][m][1][j] - mu * cv[1][1][j]) * rstd + bv[1][1][j];
                    o0[j] = g0 * sigmoidf_(g0) * u0; o1[j] = g1 * sigmoidf_(g1) * u1;
                }
                *(u32x4*)(O + (size_t)row * ldc + colo) = pack8(o0, o1);
            }
    }
};
struct EpiMoeDown {
    bf16_t* Y0; bf16_t* Y1; LAS unsigned char* ldsm; float* P; int nfull;
    __device__ __forceinline__ void operator()(const Acc& acc, const Unit& u, int wr, int wc, int fr, int fq) const {
        const int r0 = wr * 64 + fr, col0 = u.pn * 256 + wc * 32 + 8 * fq;
        if (u.ks >= 0) {
#pragma unroll
            for (int ai = 0; ai < 2; ++ai)
#pragma unroll
                for (int m = 0; m < 4; ++m) { float* rowp = P + ((size_t)u.ks * 2048 + (size_t)(u.pm - nfull) * 256 + r0 + ai * 128 + m * 16) * D + col0;
#pragma unroll
                    for (int bj = 0; bj < 2; ++bj) { *(f32x4*)(rowp + bj * 128) = acc[ai][bj][m][0]; *(f32x4*)(rowp + bj * 128 + 4) = acc[ai][bj][m][1]; } }
            return;
        }
#pragma unroll
        for (int ai = 0; ai < 2; ++ai)
#pragma unroll
            for (int m = 0; m < 4; ++m) {
                const u32x2 mg = *(const LAS u32x2*)(ldsm + u.aux * 2048 + (r0 + ai * 128 + m * 16) * 8);
                const int id = (int)mg.x; const float gt = __uint_as_float(mg.y);
                if (id >= 0) { bf16_t* rowp = Y0 + (size_t)(id & 1) * (size_t)(Y1 - Y0) + (size_t)(id >> 1) * D + col0;
#pragma unroll
                    for (int bj = 0; bj < 2; ++bj) *(u32x4*)(rowp + bj * 128) = pack8(acc[ai][bj][m][0] * gt, acc[ai][bj][m][1] * gt); }
            }
    }
};
}

struct Args { const float* in[18]; float* out; unsigned char* ws; int ph_lo, ph_hi; };
enum { PH_PRO = 0, PH_PROJ, PH_MLSTM, PH_WOUT, PH_FIN1, PH_GU, PH_DN, PH_FIN2, PH_KVQ, PH_ATT, PH_WO, PH_RT1, PH_RT2, PH_MOE0, PH_FIX = PH_MOE0 + 2 * MOE_NCHUNK, PH_FINAL, PH_COUNT };

#define DPP_STEP_ADD(x, ctrl, rmask) x += __builtin_bit_cast(float, __builtin_amdgcn_update_dpp(0, __builtin_bit_cast(int, x), ctrl, rmask, 0xf, false))
#define DPP_STEP_MAX(x, ctrl, rmask) x = fmaxf(x, __builtin_bit_cast(float, __builtin_amdgcn_update_dpp((int)0xff800000, __builtin_bit_cast(int, x), ctrl, rmask, 0xf, false)))
__device__ __forceinline__ float scan_add64(float x) { DPP_STEP_ADD(x, 0x111, 0xf); DPP_STEP_ADD(x, 0x112, 0xf); DPP_STEP_ADD(x, 0x114, 0xf); DPP_STEP_ADD(x, 0x118, 0xf); DPP_STEP_ADD(x, 0x142, 0xa); DPP_STEP_ADD(x, 0x143, 0xc); return x; }
__device__ __forceinline__ float scan_max64(float x) { DPP_STEP_MAX(x, 0x111, 0xf); DPP_STEP_MAX(x, 0x112, 0xf); DPP_STEP_MAX(x, 0x114, 0xf); DPP_STEP_MAX(x, 0x118, 0xf); DPP_STEP_MAX(x, 0x142, 0xa); DPP_STEP_MAX(x, 0x143, 0xc); return x; }
__device__ __forceinline__ float wave_total(float x);
__device__ __forceinline__ float lane63(float x) { return __builtin_bit_cast(float, __builtin_amdgcn_readlane(__builtin_bit_cast(int, x), 63)); }
__device__ __forceinline__ float wave_total(float x) { return lane63(scan_add64(x)); }
__device__ __forceinline__ float logsigmoid_(float x) { return fminf(x, 0.f) - log1pf(expf(-fabsf(x))); }
__device__ __forceinline__ void conv_block(LAS unsigned char* lds, const float* src, int ldw, int K, bf16_t* dst, const float* g, const float* bb, float* cs, float* bw) {
    const int tid = threadIdx.x;
    const int n4 = (tid & 15) * 4, k4 = (tid >> 4) * 4;
    const int rn = tid >> 3, rs = tid & 7;
    float csp[4] = {0.f, 0.f, 0.f, 0.f}, bwp[4] = {0.f, 0.f, 0.f, 0.f};
    const int nch = K / 256;
    constexpr int TS = 520;
    LAS float* gs = (LAS float*)(lds + 2 * 64 * TS + 16384);
    if (g) { for (int i = tid; i < K; i += NTHREADS) { gs[i] = g[i]; gs[K + i] = bb[i]; } __syncthreads(); }
    f32x4 v[2][4], vn[2][4];
#pragma unroll
    for (int hf = 0; hf < 2; ++hf)
#pragma unroll
        for (int kk = 0; kk < 4; ++kk) v[hf][kk] = *(const f32x4*)(src + (size_t)(hf * 128 + k4 + kk) * ldw + n4);
    for (int ch = 0; ch < nch; ++ch) {
        LAS unsigned char* T = lds + (ch & 1) * (64 * TS);
        if (ch + 1 < nch) {
#pragma unroll
            for (int hf = 0; hf < 2; ++hf)
#pragma unroll
                for (int kk = 0; kk < 4; ++kk) vn[hf][kk] = *(const f32x4*)(src + (size_t)((ch + 1) * 256 + hf * 128 + k4 + kk) * ldw + n4); }
#pragma unroll
        for (int hf = 0; hf < 2; ++hf) {
            float gk[4] = {1.f, 1.f, 1.f, 1.f}, bk[4] = {0.f, 0.f, 0.f, 0.f};
            if (g) {
#pragma unroll
                for (int kk = 0; kk < 4; ++kk) { gk[kk] = gs[ch * 256 + hf * 128 + k4 + kk]; bk[kk] = gs[K + ch * 256 + hf * 128 + k4 + kk]; } }
#pragma unroll
            for (int j = 0; j < 4; ++j) {
                const unsigned lo = pk2(v[hf][0][j] * gk[0], v[hf][1][j] * gk[1]), hi = pk2(v[hf][2][j] * gk[2], v[hf][3][j] * gk[3]);
                *(LAS u32x2*)(T + (n4 + j) * TS + (hf * 128 + k4) * 2) = (u32x2){lo, hi};
                csp[j] += (bflo(lo) + bfhi(lo)) + (bflo(hi) + bfhi(hi));
                bwp[j] += (v[hf][0][j] * bk[0] + v[hf][1][j] * bk[1]) + (v[hf][2][j] * bk[2] + v[hf][3][j] * bk[3]);
            }
        }
        __syncthreads();
        u32x2 q[8];
#pragma unroll
        for (int i = 0; i < 8; ++i) q[i] = *(const LAS u32x2*)(T + rn * TS + rs * 64 + i * 8);
        bf16_t* dp = dst + (size_t)rn * K + ch * 256 + rs * 32;
#pragma unroll
        for (int i = 0; i < 4; ++i) *(u32x4*)(dp + 8 * i) = (u32x4){q[2 * i].x, q[2 * i].y, q[2 * i + 1].x, q[2 * i + 1].y};
#pragma unroll
        for (int hf = 0; hf < 2; ++hf)
#pragma unroll
            for (int kk = 0; kk < 4; ++kk) v[hf][kk] = vn[hf][kk];
    }
    __syncthreads();
    if (cs) {
        LAS float* red = (LAS float*)(lds + 2 * 64 * TS);
#pragma unroll
        for (int j = 0; j < 4; ++j) { red[(tid >> 4) * 64 + n4 + j] = csp[j]; red[2048 + (tid >> 4) * 64 + n4 + j] = bwp[j]; }
        __syncthreads();
        if (tid < 128) { const int n = tid & 63, w = tid >> 6; float s = 0.f;
            for (int i = 0; i < 32; ++i) s += red[w * 2048 + i * 64 + n];
            (w ? bw : cs)[n] = s; }
        __syncthreads();
    }
}
__device__ __forceinline__ void conv_job(LAS unsigned char* lds, const Args& a, int blk) {
    unsigned char* ws = a.ws;
    const float* ln_g = a.in[16]; const float* ln_b = a.in[17];
    float* vec = (float*)(ws + WS_VEC);
    const float* src; int ldw, K; bf16_t* dst; const float* g = nullptr; const float* bb = nullptr; float* cs = nullptr; float* bw = nullptr;
    int j = blk;
    if (j < 128) { const int e = j >> 4, jj = j & 15; src = a.in[15] + (size_t)e * FFE * D + 64 * jj; ldw = D; K = FFE; dst = (bf16_t*)(ws + WS_WEDN) + ((size_t)e * D + 64 * jj) * FFE; }
    else if (j < 144) { j -= 128; src = a.in[11] + 64 * j; ldw = D; K = FFD; dst = (bf16_t*)(ws + WS_WDN) + (size_t)(64 * j) * FFD; }
    else if (j < 192) { j -= 144; src = a.in[2] + 64 * j; ldw = 3080; K = D; dst = (bf16_t*)(ws + WS_WIN) + (size_t)(64 * j) * D; }
    else if (j < 208) { j -= 192; src = a.in[5] + 64 * j; ldw = D; K = D; dst = (bf16_t*)(ws + WS_WOUT) + (size_t)(64 * j) * D; }
    else if (j < 296) { j -= 208; const int t = j >> 2, q = j & 3; src = (q < 2 ? a.in[9] : a.in[10]) + 128 * t + 64 * (q & 1); ldw = FFD; K = D; dst = (bf16_t*)(ws + WS_WGU) + (size_t)(64 * j) * D;
        g = ln_g; bb = ln_b; cs = vec + VEC_GU_CS + 64 * j; bw = vec + VEC_GU_BW + 64 * j; }
    else if (j < 344) { j -= 296; src = j < 32 ? a.in[6] + 64 * j : a.in[7] + 64 * (j - 32); ldw = j < 32 ? 2048 : 1024; K = D; dst = (bf16_t*)(ws + WS_WKVQ) + (size_t)(64 * j) * D;
        g = ln_g + 1024; bb = ln_b + 1024; cs = vec + VEC_KVQ_CS + 64 * j; bw = vec + VEC_KVQ_BW + 64 * j; }
    else if (j < 360) { j -= 344; src = a.in[8] + 64 * j; ldw = D; K = D; dst = (bf16_t*)(ws + WS_WO) + (size_t)(64 * j) * D; }
    else { j -= 360; const int e = j / 112, jj = j % 112, t = jj >> 2, q = jj & 3; src = (q < 2 ? a.in[13] : a.in[14]) + (size_t)e * D * FFE + 128 * t + 64 * (q & 1); ldw = FFE; K = D;
        dst = (bf16_t*)(ws + WS_WEGU) + ((size_t)e * 2 * FFE + 64 * jj) * D; g = ln_g + 2048; bb = ln_b + 2048; cs = vec + VEC_EGU_CS + e * 2 * FFE + 64 * jj; bw = vec + VEC_EGU_BW + e * 2 * FFE + 64 * jj; }
    conv_block(lds, src, ldw, K, dst, g, bb, cs, bw);
}
constexpr int EGU0 = 360;
__device__ __forceinline__ void tail_jobs(LAS unsigned char* lds, const Args& a, int phase) {
    const int c = (int)blockIdx.x;
    int j0 = -1;
    if (phase == PH_PROJ) { const int q = c - 12;
        if (q >= 0) j0 = q < 16 ? 128 + q : (q < 184 ? 192 + (q - 16) : EGU0 + (q - 184)); }
    else if (phase == PH_WOUT) { const int q = c - 4; if (q >= 0) j0 = EGU0 + 60 + q; }
    else if (phase == PH_GU) { const int q = c - 22; if (q >= 0) j0 = EGU0 + 312 + q; }
    else if (phase == PH_DN) { const int q = c - 4;
        if (q >= 0 && q < 128) j0 = q;
        else if (q >= 128 && q - 128 < 106) j0 = EGU0 + 546 + (q - 128); }
    else { const int q = c - 12; if (q >= 0) j0 = EGU0 + 652 + q; }
    if (j0 >= 0) conv_job(lds, a, j0);
}
__device__ __forceinline__ void prologue_phase(LAS unsigned char* lds, const Args& a) {
    unsigned char* ws = a.ws;
    const int G = gridDim.x;
    for (int blk = 144 + blockIdx.x; blk < 192; blk += G) conv_job(lds, a, blk);
    {
        const int tid = threadIdx.x, lane = tid & 63, wid = tid >> 6;
        LAS float* wg = (LAS float*)lds;
        __syncthreads();
        const float* w_in = a.in[2];
        for (int i = tid; i < 8192; i += NTHREADS) { const int k = i >> 3, e = i & 7; wg[e * 1024 + k] = w_in[(size_t)k * 3080 + 3072 + e]; }
        __syncthreads();
        bf16_t* H0 = (bf16_t*)(ws + WS_RB); float* gates = (float*)(ws + WS_GATES);
        const float bg = a.in[3][lane & 7];
        const int c_ = (int)blockIdx.x;
        const int r_lo = (G == 256) ? (c_ < 48 ? 160 * c_ : 7680 + 280 * (c_ - 48)) : (int)(((long)NROWS * c_) / G);
        int r_hi = (G == 256) ? (c_ < 48 ? r_lo + 160 : r_lo + 280) : (int)(((long)NROWS * (c_ + 1)) / G); r_hi = r_hi < NROWS ? r_hi : NROWS;
#define PRO_SRC(r) ((r) < NR ? a.in[0] + (size_t)(r) * D : a.in[1] + (size_t)(((r) - NR) & 15) * D)
        f32x4 xa[4], xb[4], na[4], nb[4];
        { const int ra = (r_lo + wid) < r_hi ? (r_lo + wid) : 0, rb = (r_lo + wid + 8) < r_hi ? (r_lo + wid + 8) : ra; const float* sa = PRO_SRC(ra); const float* sb = PRO_SRC(rb);
#pragma unroll
            for (int i = 0; i < 4; ++i) { xa[i] = *(const f32x4*)(sa + i * 256 + lane * 4); xb[i] = *(const f32x4*)(sb + i * 256 + lane * 4); } }
        for (int row = r_lo + wid; row < r_hi; row += 16) {
            const bool hasb = (row + 8 < r_hi);
            { const int ra = (row + 16) < r_hi ? (row + 16) : row, rb = (row + 24) < r_hi ? (row + 24) : ra; const float* sa = PRO_SRC(ra); const float* sb = PRO_SRC(rb);
#pragma unroll
                for (int i = 0; i < 4; ++i) { na[i] = *(const f32x4*)(sa + i * 256 + lane * 4); nb[i] = *(const f32x4*)(sb + i * 256 + lane * 4); } }
            float acca[8] = {0.f, 0.f, 0.f, 0.f, 0.f, 0.f, 0.f, 0.f}, accb[8] = {0.f, 0.f, 0.f, 0.f, 0.f, 0.f, 0.f, 0.f};
#pragma unroll
            for (int i = 0; i < 4; ++i) {
                const int k = i * 256 + lane * 4;
                const f32x4 va = xa[i], vb = xb[i];
                *(u32x2*)(H0 + (size_t)row * D + k) = (u32x2){pk2(va[0], va[1]), pk2(va[2], va[3])};
                if (hasb) *(u32x2*)(H0 + (size_t)(row + 8) * D + k) = (u32x2){pk2(vb[0], vb[1]), pk2(vb[2], vb[3])};
#pragma unroll
                for (int e = 0; e < 8; ++e) { const f32x4 w = *(const LAS f32x4*)(wg + e * 1024 + k);
                    acca[e] += (va[0] * w[0] + va[1] * w[1]) + (va[2] * w[2] + va[3] * w[3]); accb[e] += (vb[0] * w[0] + vb[1] * w[1]) + (vb[2] * w[2] + vb[3] * w[3]); }
            }
#pragma unroll
            for (int i = 0; i < 4; ++i) { xa[i] = na[i]; xb[i] = nb[i]; }
#pragma unroll
            for (int e = 0; e < 8; ++e) { acca[e] = wave_total(acca[e]); accb[e] = wave_total(accb[e]); }
            float ma = acca[0], mb = accb[0];
#pragma unroll
            for (int e = 1; e < 8; ++e) { ma = ((lane & 7) == e) ? acca[e] : ma; mb = ((lane & 7) == e) ? accb[e] : mb; }
            if (lane < 8) { gates[(size_t)row * 8 + lane] = lane < 4 ? ma + bg : logsigmoid_(ma + bg); if (hasb) gates[(size_t)(row + 8) * 8 + lane] = lane < 4 ? mb + bg : logsigmoid_(mb + bg); }
        }
#undef PRO_SRC
        __syncthreads();
    }
}

__device__ __forceinline__ bf16x8 pack_frag(const f32x16& x, int s) {
    u32x4 p; p.x = pk2(x[8 * s], x[8 * s + 1]); p.y = pk2(x[8 * s + 2], x[8 * s + 3]); p.z = pk2(x[8 * s + 4], x[8 * s + 5]); p.w = pk2(x[8 * s + 6], x[8 * s + 7]);
    return __builtin_bit_cast(bf16x8, p);
}
__device__ __forceinline__ bf16x8 ld2x64(const LAS unsigned char* p0, const LAS unsigned char* p1) {
    const u32x2 a = *(const LAS u32x2*)p0, b = *(const LAS u32x2*)p1; u32x4 r = {a.x, a.y, b.x, b.y}; return __builtin_bit_cast(bf16x8, r);
}
__device__ __forceinline__ void tr4x4(const u32x2 (&r)[4], u32x2 (&c)[4]) {
    c[0] = (u32x2){(r[0].x & 0xffffu) | (r[1].x << 16), (r[2].x & 0xffffu) | (r[3].x << 16)};
    c[1] = (u32x2){(r[0].x >> 16) | (r[1].x & 0xffff0000u), (r[2].x >> 16) | (r[3].x & 0xffff0000u)};
    c[2] = (u32x2){(r[0].y & 0xffffu) | (r[1].y << 16), (r[2].y & 0xffffu) | (r[3].y << 16)};
    c[3] = (u32x2){(r[0].y >> 16) | (r[1].y & 0xffff0000u), (r[2].y >> 16) | (r[3].y & 0xffff0000u)};
}

constexpr int ML_QS = 0, ML_KS = 17408, ML_PS = 34816, ML_VT = 44032, ML_KT = 78848, ML_SC = 96256, ML_HS = 100352;
#ifndef ML_N0
#define ML_N0 28
#define ML_N1 18
#define ML_N2 12
#endif
__device__ __forceinline__ void mlstm_phase(LAS unsigned char* lds, const bf16_t* qkvo, const float* gates, const float* normg, bf16_t* hn, int unit_) {
    const int unit = (unit_ & 7) * 8 + (unit_ >> 5), part_ = (unit_ >> 3) & 3;
    const int c_begin = part_ == 0 ? 0 : (part_ == 1 ? ML_N0 : (part_ == 2 ? ML_N0 + ML_N1 : ML_N0 + ML_N1 + ML_N2));
    const int c_end = part_ == 0 ? ML_N0 : (part_ == 1 ? ML_N0 + ML_N1 : (part_ == 2 ? ML_N0 + ML_N1 + ML_N2 : 65));
    const int tid = threadIdx.x, lane = tid & 63, wid = __builtin_amdgcn_readfirstlane(tid >> 6);
    const int b = unit >> 2, h = unit & 3;
    const int r32 = lane & 31, hh = lane >> 5, l15 = lane & 15, l4 = lane >> 4;
    LAS float* sc = (LAS float*)(lds + ML_SC);
    const int q_row = tid >> 4, q_col = (tid & 15) * 8;
    const int k_dk = (16 * (wid & 1) + l15) * 4, k_s = (4 * (wid >> 1) + l4) * 4;
    const int v_dv = (16 * (wid & 3) + l15) * 4, v_s0 = (4 * (wid >> 2) + l4) * 4;
    f32x16 Cacc[4];
#pragma unroll
    for (int i = 0; i < 4; ++i)
#pragma unroll
        for (int j = 0; j < 16; ++j) Cacc[i][j] = 0.f;
    if (tid < 256) sc[192 + tid] = 0.f;
    float m_run = 0.f;
    u32x4 qreg[2]; u32x2 kreg[4], vreg[2][4]; float g_li = 0.f, g_lf = 0.f;
#define rowof(c, t) ((c) == 0 ? (NR + b * 16 + ((t) - 48)) : (b * SEQ + 64 * ((c) - 1) + (t)))
#define ML_PREFETCH_Q(c) do { \
        if ((c) >= c_begin) _Pragma("unroll") for (int p = 0; p < 2; ++p) { const int t = q_row + 32 * p; const bool pad = ((c) == 0 && t < 48); \
            qreg[p] = pad ? (u32x4){0u, 0u, 0u, 0u} : *(const u32x4*)(qkvo + (size_t)rowof((c), t) * NPROJ + h * 128 + q_col); } } while (0)
#define ML_PREFETCH(c) do { \
        _Pragma("unroll") for (int kk = 0; kk < 4; ++kk) { const int t = k_s + kk; const bool pad = ((c) == 0 && t < 48); \
            kreg[kk] = pad ? (u32x2){0u, 0u} : *(const u32x2*)(qkvo + (size_t)rowof((c), t) * NPROJ + 512 + h * 128 + k_dk); } \
        _Pragma("unroll") for (int p = 0; p < 2; ++p) _Pragma("unroll") for (int kk = 0; kk < 4; ++kk) { const int t = v_s0 + 32 * p + kk; const bool pad = ((c) == 0 && t < 48); \
            vreg[p][kk] = pad ? (u32x2){0u, 0u} : *(const u32x2*)(qkvo + (size_t)rowof((c), t) * NPROJ + 1024 + h * 256 + v_dv); } \
        { const bool pad = ((c) == 0 && lane < 48); g_li = pad ? -1e30f : gates[(size_t)rowof((c), lane) * 8 + h]; g_lf = pad ? 0.f : gates[(size_t)rowof((c), lane) * 8 + 4 + h]; } } while (0)
    float av, Mt, winter, bmt, wlast, decay, m_next;
#define ML_SCALARS() do { const float bc_ = scan_add64(g_lf); av = g_li - bc_; const float um_ = scan_max64(av); Mt = fmaxf(m_run, um_); \
        winter = __expf(m_run - Mt); bmt = bc_ + Mt; const float M63_ = lane63(Mt), b63_ = lane63(bc_); wlast = __expf(av - M63_); decay = __expf(m_run - M63_); m_next = b63_ + M63_; } while (0)
#define ML_IMAGE(FULL) do { \
        if (FULL) { _Pragma("unroll") for (int p = 0; p < 2; ++p) *(LAS u32x4*)(lds + ML_QS + (q_row + 32 * p) * 272 + q_col * 2) = qreg[p]; } \
        { u32x2 kw[4]; \
            _Pragma("unroll") for (int kk = 0; kk < 4; ++kk) { \
                if (FULL) *(LAS u32x2*)(lds + ML_KS + (k_s + kk) * 272 + k_dk * 2) = kreg[kk]; \
                const float w = __shfl(wlast, k_s + kk) * 0.08838834764831845f; \
                kw[kk] = (u32x2){pk2(bflo(kreg[kk].x) * w, bfhi(kreg[kk].x) * w), pk2(bflo(kreg[kk].y) * w, bfhi(kreg[kk].y) * w)}; } \
            u32x2 kc[4]; tr4x4(kw, kc); \
            _Pragma("unroll") for (int j = 0; j < 4; ++j) *(LAS u32x2*)(lds + ML_KT + (k_dk + j) * 136 + k_s * 2) = kc[j]; } \
        _Pragma("unroll") for (int p = 0; p < 2; ++p) { u32x2 vc[4]; tr4x4(vreg[p], vc); \
            _Pragma("unroll") for (int j = 0; j < 4; ++j) *(LAS u32x2*)(lds + ML_VT + (v_dv + j) * 136 + (v_s0 + 32 * p) * 2) = vc[j]; } \
        if (wid == 0) { sc[lane] = winter; sc[128 + lane] = bmt; } } while (0)
#define ML_PTILES() do { const int ti = wid >> 1; \
        _Pragma("unroll") for (int q = 0; q < 2; ++q) { const int si = 2 * (wid & 1) + q; f32x4 sa = {0.f, 0.f, 0.f, 0.f}; \
            if (si <= ti) { _Pragma("unroll") for (int ks = 0; ks < 4; ++ks) { \
                    const bf16x8 af = *(const LAS bf16x8*)(lds + ML_QS + (16 * ti + l15) * 272 + (32 * ks + 8 * l4) * 2); \
                    const bf16x8 bfr = *(const LAS bf16x8*)(lds + ML_KS + (16 * si + l15) * 272 + (32 * ks + 8 * l4) * 2); \
                    sa = __builtin_amdgcn_mfma_f32_16x16x32_bf16(af, bfr, sa, 0, 0, 0); } } \
            const int s = 16 * si + l15; const float a_s = __shfl(av, s); \
            _Pragma("unroll") for (int r = 0; r < 4; ++r) { const int t = 16 * ti + 4 * l4 + r; const float Mtt = __shfl(Mt, t); \
                const float w = (s <= t) ? __expf(a_s - Mtt) : 0.f; \
                *(LAS bf16_t*)(lds + ML_PS + t * 144 + s * 2) = f2bf(sa[r] * 0.08838834764831845f * w); } } } while (0)
    bf16x8 vf[4];
#define ML_VFRAGS() do { _Pragma("unroll") for (int ks = 0; ks < 4; ++ks) { const LAS unsigned char* p_ = lds + ML_VT + (32 * wid + r32) * 136 + (16 * ks + 8 * hh) * 2; vf[ks] = ld2x64(p_, p_ + 8); } } while (0)

    ML_PREFETCH(0); ML_PREFETCH_Q(0);
    ML_SCALARS();
    { const bool f0 = (0 >= c_begin); if (f0) ML_IMAGE(true); else ML_IMAGE(false); }
    __syncthreads();
    if (1 < c_end) ML_PREFETCH(1);
    if (0 >= c_begin) ML_PTILES();
    ML_VFRAGS();
    __syncthreads();
    for (int c = 0; c < c_end; ++c) {
        const bool full = (c >= c_begin), has_n = (c + 1 < c_end), full_n = (c + 1 >= c_begin);
        const float decay_c = decay;
        const int nb = c & 1;
        if (full) {
            {
                const int t = tid >> 3, part = tid & 7;
                float qn = 0.f, ps = 0.f;
                const u32x4 q0 = *(const LAS u32x4*)(lds + ML_QS + t * 272 + part * 32), q1 = *(const LAS u32x4*)(lds + ML_QS + t * 272 + part * 32 + 16);
                float qv[16]; { float t8[8]; g8::unpack8(q0, t8);
#pragma unroll
                    for (int j = 0; j < 8; ++j) qv[j] = t8[j]; g8::unpack8(q1, t8);
#pragma unroll
                    for (int j = 0; j < 8; ++j) qv[8 + j] = t8[j]; }
#pragma unroll
                for (int j = 0; j < 16; ++j) qn += qv[j] * sc[192 + 128 * nb + part * 16 + j];
                const u32x4 pw = *(const LAS u32x4*)(lds + ML_PS + t * 144 + part * 16);
                float pv[8]; g8::unpack8(pw, pv);
#pragma unroll
                for (int j = 0; j < 8; ++j) ps += pv[j];
                qn += __shfl_xor(qn, 1); qn += __shfl_xor(qn, 2); qn += __shfl_xor(qn, 4);
                ps += __shfl_xor(ps, 1); ps += __shfl_xor(ps, 2); ps += __shfl_xor(ps, 4);
                if (part == 0) { const float den = sc[t] * qn + ps; sc[64 + t] = __builtin_amdgcn_rcpf(fmaxf(fabsf(den), __expf(-sc[128 + t]))); }
            }
#pragma unroll
            for (int tt = 0; tt < 2; ++tt) {
                f32x16 num;
#pragma unroll
                for (int j = 0; j < 16; ++j) num[j] = 0.f;
#pragma unroll
                for (int dkt = 0; dkt < 4; ++dkt)
#pragma unroll
                    for (int s2 = 0; s2 < 2; ++s2) {
                        const LAS unsigned char* p = lds + ML_QS + (32 * tt + r32) * 272 + (32 * dkt + 16 * s2 + 4 * hh) * 2;
                        num = __builtin_amdgcn_mfma_f32_32x32x16_bf16(ld2x64(p, p + 16), pack_frag(Cacc[dkt], s2), num, 0, 0, 0);
                    }
#pragma unroll
                for (int gq = 0; gq < 4; ++gq) { const f32x4 wv = *(const LAS f32x4*)(sc + 32 * tt + 8 * gq + 4 * hh);
#pragma unroll
                    for (int r = 0; r < 4; ++r) num[4 * gq + r] *= wv[r]; }
#pragma unroll
                for (int ks = 0; ks < 4; ++ks) {
                    if (tt == 0 && ks >= 2) continue;
                    const bf16x8 pf = *(const LAS bf16x8*)(lds + ML_PS + (32 * tt + r32) * 144 + (16 * ks + 8 * hh) * 2);
                    num = __builtin_amdgcn_mfma_f32_32x32x16_bf16(pf, vf[ks], num, 0, 0, 0);
                }
#pragma unroll
                for (int j = 0; j < 16; ++j) *(LAS bf16_t*)(lds + ML_HS + (32 * tt + (j & 3) + 8 * (j >> 2) + 4 * hh) * 528 + (32 * wid + r32) * 2) = f2bf(num[j]);
            }
        }
#pragma unroll
        for (int dkt = 0; dkt < 4; ++dkt) {
#pragma unroll
            for (int j = 0; j < 16; ++j) Cacc[dkt][j] *= decay_c;
#pragma unroll
            for (int ks = 0; ks < 4; ++ks) { const LAS unsigned char* p = lds + ML_KT + (32 * dkt + r32) * 136 + (16 * ks + 8 * hh) * 2;
                Cacc[dkt] = __builtin_amdgcn_mfma_f32_32x32x16_bf16(ld2x64(p, p + 8), vf[ks], Cacc[dkt], 0, 0, 0); }
        }
        {
            const int dk = tid >> 2, part = tid & 3;
            const u32x2 k0 = *(const LAS u32x2*)(lds + ML_KT + dk * 136 + part * 32), k1 = *(const LAS u32x2*)(lds + ML_KT + dk * 136 + part * 32 + 8),
                        k2 = *(const LAS u32x2*)(lds + ML_KT + dk * 136 + part * 32 + 16), k3 = *(const LAS u32x2*)(lds + ML_KT + dk * 136 + part * 32 + 24);
            float sk = ((bflo(k0.x) + bfhi(k0.x)) + (bflo(k0.y) + bfhi(k0.y))) + ((bflo(k1.x) + bfhi(k1.x)) + (bflo(k1.y) + bfhi(k1.y)))
                     + ((bflo(k2.x) + bfhi(k2.x)) + (bflo(k2.y) + bfhi(k2.y))) + ((bflo(k3.x) + bfhi(k3.x)) + (bflo(k3.y) + bfhi(k3.y)));
            sk += __shfl_xor(sk, 1); sk += __shfl_xor(sk, 2);
            if (part == 0) sc[192 + 128 * (nb ^ 1) + dk] = decay_c * sc[192 + 128 * nb + dk] + sk;
        }
        if (has_n) ML_PREFETCH_Q(c + 1);
        __syncthreads();
        m_run = m_next;
        if (has_n) ML_SCALARS();
        u32x2 oreg[8];
        if (full) { const int t = tid >> 3, part = tid & 7; const bool pad = (c == 0 && t < 48); const size_t row = pad ? 0 : (size_t)rowof(c, t);
#pragma unroll
            for (int i = 0; i < 8; ++i) oreg[i] = *(const u32x2*)(qkvo + row * NPROJ + 2048 + h * 256 + 32 * i + 4 * part); }
        if (full) {
            const int t = tid >> 3, part = tid & 7;
            const float iv = sc[64 + t];
            f32x4 x[8]; float s1 = 0.f;
#pragma unroll
            for (int i = 0; i < 8; ++i) { const u32x2 hw = *(const LAS u32x2*)(lds + ML_HS + t * 528 + (32 * i + 4 * part) * 2);
                x[i] = (f32x4){bflo(hw.x) * iv, bfhi(hw.x) * iv, bflo(hw.y) * iv, bfhi(hw.y) * iv}; s1 += (x[i][0] + x[i][1]) + (x[i][2] + x[i][3]); }
            s1 += __shfl_xor(s1, 1); s1 += __shfl_xor(s1, 2); s1 += __shfl_xor(s1, 4);
            const float mean = s1 * (1.0f / 256.0f); float s2 = 0.f;
#pragma unroll
            for (int i = 0; i < 8; ++i) { const f32x4 d = x[i] - mean; s2 += (d[0] * d[0] + d[1] * d[1]) + (d[2] * d[2] + d[3] * d[3]); }
            s2 += __shfl_xor(s2, 1); s2 += __shfl_xor(s2, 2); s2 += __shfl_xor(s2, 4);
            const float rstd = rsqrtf(s2 * (1.0f / 256.0f) + LN_EPS);
            if (!(c == 0 && t < 48)) {
                const size_t row = (size_t)rowof(c, t);
#pragma unroll
                for (int i = 0; i < 8; ++i) {
                    const int dv = 32 * i + 4 * part;
                    const u32x2 ow = oreg[i];
                    const f32x4 ng = *(const f32x4*)(normg + h * 256 + dv);
                    const float o0 = sigmoidf_(bflo(ow.x)), o1 = sigmoidf_(bfhi(ow.x)), o2 = sigmoidf_(bflo(ow.y)), o3 = sigmoidf_(bfhi(ow.y));
                    const f32x4 y = (x[i] - mean) * rstd * ng;
                    *(u32x2*)(hn + row * D + h * 256 + dv) = (u32x2){pk2(y[0] * o0, y[1] * o1), pk2(y[2] * o2, y[3] * o3)};
                }
            }
        }
        if (!has_n) break;
        if (full_n) ML_IMAGE(true); else ML_IMAGE(false);
        if (c + 2 < c_end) ML_PREFETCH(c + 2);
        __syncthreads();
        if (full_n) ML_PTILES();
        ML_VFRAGS();
        if (full_n) __syncthreads();
    }
    __syncthreads();
#undef ML_PREFETCH
#undef ML_PREFETCH_Q
#undef ML_SCALARS
#undef ML_IMAGE
#undef ML_PTILES
#undef ML_VFRAGS
#undef rowof
}

constexpr float AT_PMIN = 1e-15f;
constexpr int AT_K0 = 0, AT_V0 = 17408, AT_BUF = 34816, AT_FLAGS = 2 * AT_BUF;
__device__ __forceinline__ void at_tile(const LAS unsigned char* Kb, const LAS unsigned char* Vb, int k0, int tmin, int r32, int hh, const bf16x8 (&qf)[8], f32x16 (&O)[4], float& P) {
    f32x16 S[2];
#pragma unroll
    for (int u = 0; u < 2; ++u) {
#pragma unroll
        for (int j = 0; j < 16; ++j) S[u][j] = 0.f;
#pragma unroll
        for (int ks = 0; ks < 8; ++ks) {
            const bf16x8 kf = *(const LAS bf16x8*)(Kb + (32 * u + r32) * 272 + (16 * ks + 8 * hh) * 2);
            S[u] = __builtin_amdgcn_mfma_f32_32x32x16_bf16(kf, qf[ks], S[u], 0, 0, 0);
        }
    }
    const bool full = (k0 + 63 < tmin) && (k0 >= 128);
    const int lim = tmin + r32 - k0 - 4 * hh;
    const int lo = 112 - k0 - 4 * hh;
    float Tt[2][4];
#define AT_ELEM(MASKED) \
    _Pragma("unroll") for (int u = 0; u < 2; ++u) _Pragma("unroll") for (int gq = 0; gq < 4; ++gq) { \
        float x4[4]; \
        _Pragma("unroll") for (int r = 0; r < 4; ++r) { \
            float zz = S[u][4 * gq + r] * (0.08838834764831845f * 1.4426950408889634f); \
            if (MASKED) { const int o = 32 * u + 8 * gq + r; zz = (o < lim && o >= lo) ? zz : -1.0e4f; } \
            const float rc = __builtin_amdgcn_rcpf(1.0f + __builtin_amdgcn_exp2f(zz)); \
            S[u][4 * gq + r] = 1.0f - rc; x4[r] = rc; } \
        const float e2 = x4[3], e1 = e2 * x4[2], e0 = e1 * x4[1]; \
        Tt[u][gq] = e0 * x4[0]; \
        S[u][4 * gq + 2] *= e2; S[u][4 * gq + 1] *= e1; S[u][4 * gq + 0] *= e0; }
    if (full) { AT_ELEM(false) } else { AT_ELEM(true) }
#undef AT_ELEM
    float acc = P;
#pragma unroll
    for (int u = 1; u >= 0; --u)
#pragma unroll
        for (int gq = 3; gq >= 0; --gq) {
            float t0; const float t1 = swap32_hi(Tt[u][gq], t0);
            const float Rr = hh ? acc : acc * t1;
            acc = (acc * t1) * t0;
#pragma unroll
            for (int r = 0; r < 4; ++r) S[u][4 * gq + r] *= Rr;
        }
    P = acc;
#pragma unroll
    for (int u = 0; u < 2; ++u)
#pragma unroll
        for (int s2 = 0; s2 < 2; ++s2) {
            const bf16x8 af = pack_frag(S[u], s2);
#pragma unroll
            for (int dt = 0; dt < 4; ++dt) {
                const LAS unsigned char* p = Vb + (32 * dt + r32) * 136 + (32 * u + 16 * s2 + 4 * hh) * 2;
                O[dt] = __builtin_amdgcn_mfma_f32_32x32x16_bf16(af, ld2x64(p, p + 16), O[dt], 0, 0, 0);
            }
        }
}
__device__ __forceinline__ void attn_phase(LAS unsigned char* lds, const bf16_t* kvq, bf16_t* ao) {
    const int tid = threadIdx.x, lane = tid & 63, wid = __builtin_amdgcn_readfirstlane(tid >> 6);
    const int r32 = lane & 31, hh = lane >> 5, l15 = lane & 15, l4 = lane >> 4;
    LAS unsigned* flags = (LAS unsigned*)(lds + AT_FLAGS);
    const int k_row = tid >> 4, k_col = (tid & 15) * 8;
    const int v_d = (16 * (wid & 1) + l15) * 4, v_s = (4 * (wid >> 1) + l4) * 4;
    for (int ui_ = 0; ui_ < (NB * 8 * 16) / 256; ++ui_) {
        const int xq = blockIdx.x & 7, jq = blockIdx.x >> 3, strm = (ui_ * 8 + xq) * 2 + (jq >> 4);
        const int qt = jq & 15, head = strm & 7, b = strm >> 3;
        const int q0 = 128 + 256 * qt, tmin = q0 + 32 * wid;
#define rowofp(p) ((p) >= 128 ? b * SEQ + (p) - 128 : ((p) >= 112 ? NR + b * 16 + (p) - 112 : NR + b * 16))
        bf16x8 qf[8];
        { const bf16_t* qp = kvq + (size_t)(b * SEQ + tmin - 128 + r32) * NPROJ + 2048 + head * 128 + 8 * hh;
#pragma unroll
            for (int ks = 0; ks < 8; ++ks) qf[ks] = *(const bf16x8*)(qp + 16 * ks); }
        f32x16 O[4];
#pragma unroll
        for (int i = 0; i < 4; ++i)
#pragma unroll
            for (int j = 0; j < 16; ++j) O[i][j] = 0.f;
        float P = 1.0f;
        const int kt_hi = (q0 >> 6) + 3;
        u32x4 kregA[2], kregB[2]; u32x2 vregA[4], vregB[4];
#define AT_LOAD(kreg, vreg, kt) do { \
        _Pragma("unroll") for (int p = 0; p < 2; ++p) kreg[p] = *(const u32x4*)(kvq + (size_t)rowofp(64 * (kt) + k_row + 32 * p) * NPROJ + head * 128 + k_col); \
        _Pragma("unroll") for (int kk = 0; kk < 4; ++kk) vreg[kk] = *(const u32x2*)(kvq + (size_t)rowofp(64 * (kt) + v_s + kk) * NPROJ + 1024 + head * 128 + v_d); } while (0)
#define AT_STORE(kreg, vreg, buf) do { LAS unsigned char* base = lds + (buf) * AT_BUF; \
        _Pragma("unroll") for (int p = 0; p < 2; ++p) *(LAS u32x4*)(base + AT_K0 + (k_row + 32 * p) * 272 + k_col * 2) = kreg[p]; \
        u32x2 vc[4]; tr4x4(vreg, vc); \
        _Pragma("unroll") for (int j = 0; j < 4; ++j) *(LAS u32x2*)(base + AT_V0 + (v_d + j) * 136 + v_s * 2) = vc[j]; } while (0)
#define AT_ITER(BUF, LOADSET_K, LOADSET_V, STORESET_K, STORESET_V) { \
            const int kt = kt_hi - it; \
            __syncthreads(); \
            if (it > 0 && flags[it - 1] == 0u) break; \
            if (kt - 2 >= 1) AT_LOAD(LOADSET_K, LOADSET_V, kt - 2); \
            if (64 * kt < tmin + 31 && __ballot(P >= AT_PMIN) != 0ull) at_tile(lds + (BUF) * AT_BUF + AT_K0, lds + (BUF) * AT_BUF + AT_V0, 64 * kt, tmin, r32, hh, qf, O, P); \
            if (__ballot(P >= AT_PMIN) != 0ull && lane == 0) flags[it] = 1u; \
            if (kt - 1 < 1) break; \
            AT_STORE(STORESET_K, STORESET_V, 1 - (BUF)); \
            ++it; }
        if (tid < 80) flags[tid] = 0u;
        AT_LOAD(kregA, vregA, kt_hi);
        AT_STORE(kregA, vregA, 0);
        AT_LOAD(kregB, vregB, kt_hi - 1);
        for (int it = 0; ; ) {
            AT_ITER(0, kregA, vregA, kregB, vregB)
            AT_ITER(1, kregB, vregB, kregA, vregA)
        }
#pragma unroll
        for (int dt = 0; dt < 4; ++dt)
#pragma unroll
            for (int j = 0; j < 16; ++j) {
                const int t = tmin + (j & 3) + 8 * (j >> 2) + 4 * hh;
                ao[(size_t)(b * SEQ + t - 128) * D + head * 128 + 32 * dt + r32] = f2bf(O[dt][j]);
            }
        __syncthreads();
    }
#undef AT_LOAD
#undef AT_STORE
#undef AT_ITER
#undef rowofp
}

__device__ __forceinline__ void ln_row_stats_wave(const float* st, int row, int lane, float& mu, float& rstd) {
    const f32x2 p = *(const f32x2*)(st + (size_t)row * 32 + (lane & 15) * 2);
    float s1 = p[0], s2 = p[1];
#pragma unroll
    for (int o = 1; o < 16; o <<= 1) { s1 += __shfl_xor(s1, o); s2 += __shfl_xor(s2, o); }
    mu = s1 * (1.0f / 1024.0f); const float var = fmaxf(s2 * (1.0f / 1024.0f) - mu * mu, 0.f); rstd = rsqrtf(var + LN_EPS);
}
__device__ __forceinline__ void router1_phase(LAS unsigned char* lds, const Args& a) {
    const int tid = threadIdx.x, lane = tid & 63, wid = tid >> 6;
    unsigned char* ws = a.ws;
    const float* g3 = a.in[16] + 2048; const float* b3 = a.in[17] + 2048; const float* wr = a.in[12];
    LAS float* gw = (LAS float*)lds;
    LAS float* cc = (LAS float*)(lds + 32768);
    LAS int* cnt = (LAS int*)(lds + 32768 + 64);
    __syncthreads();
    for (int i = tid; i < 8192; i += NTHREADS) { const int k = i >> 3, e = i & 7; gw[e * 1024 + k] = g3[k] * wr[i]; }
    if (tid < 8) cnt[tid] = 0;
    __syncthreads();
    { float s1 = 0.f, s2 = 0.f;
        for (int k = lane; k < 1024; k += 64) { s1 += gw[wid * 1024 + k]; s2 += b3[k] * wr[k * 8 + wid]; }
        s1 = wave_sum(s1); s2 = wave_sum(s2);
        if (lane == 0) { cc[wid] = s1; cc[8 + wid] = s2; } }
    __syncthreads();
    const bf16_t* z3 = (const bf16_t*)(ws + WS_RC); const float* st3 = (const float*)(ws + WS_ST3);
    f32x4* route = (f32x4*)(ws + WS_ROUTE);
    const int tok0 = (int)(((long)NR * blockIdx.x) / gridDim.x), tok1 = (int)(((long)NR * (blockIdx.x + 1)) / gridDim.x);
    u32x4 zrA[2], zrB[2]; f32x2 spA, spB;
#define RT_LOAD2(t) do { const int tb_ = ((t) + 8 < tok1) ? (t) + 8 : (t); \
        zrA[0] = *(const u32x4*)(z3 + (size_t)(t) * D + lane * 8); zrA[1] = *(const u32x4*)(z3 + (size_t)(t) * D + 512 + lane * 8); spA = *(const f32x2*)(st3 + (size_t)(t) * 32 + (lane & 15) * 2); \
        zrB[0] = *(const u32x4*)(z3 + (size_t)tb_ * D + lane * 8); zrB[1] = *(const u32x4*)(z3 + (size_t)tb_ * D + 512 + lane * 8); spB = *(const f32x2*)(st3 + (size_t)tb_ * 32 + (lane & 15) * 2); } while (0)
#define RT_FINISH(tk, acc, mu, rstd) do { float lg[8]; \
        _Pragma("unroll") for (int e = 0; e < 8; ++e) lg[e] = (rstd) * (wave_total(acc[e]) - (mu) * cc[e]) + cc[8 + e]; \
        int e1 = 0; float v1 = lg[0]; \
        _Pragma("unroll") for (int e = 1; e < 8; ++e) if (lg[e] > v1) { v1 = lg[e]; e1 = e; } \
        int e2 = -1; float v2 = -3.0e38f; \
        _Pragma("unroll") for (int e = 0; e < 8; ++e) if (e != e1 && lg[e] > v2) { v2 = lg[e]; e2 = e; } \
        const float g1 = 1.0f / (1.0f + expf(v2 - v1)); \
        if (lane == 0) { ((f32x2*)(ws + WS_TOKST))[tk] = (f32x2){(mu), (rstd)}; route[tk] = (f32x4){__int_as_float(e1 | (e2 << 8)), g1, 1.0f - g1, 0.f}; \
            __hip_atomic_fetch_add(&cnt[e1], 1, __ATOMIC_RELAXED, __HIP_MEMORY_SCOPE_WORKGROUP); __hip_atomic_fetch_add(&cnt[e2], 1, __ATOMIC_RELAXED, __HIP_MEMORY_SCOPE_WORKGROUP); } } while (0)
    if (tok0 + wid < tok1) RT_LOAD2(tok0 + wid);
    for (int tok = tok0 + wid; tok < tok1; tok += 16) {
        const u32x4 zA[2] = {zrA[0], zrA[1]}, zB[2] = {zrB[0], zrB[1]}; const f32x2 sA = spA, sB = spB;
        if (tok + 16 < tok1) RT_LOAD2(tok + 16);
        float a1 = sA[0], a2 = sA[1], b1 = sB[0], b2 = sB[1];
#pragma unroll
        for (int o = 1; o < 16; o <<= 1) { a1 += __shfl_xor(a1, o); a2 += __shfl_xor(a2, o); b1 += __shfl_xor(b1, o); b2 += __shfl_xor(b2, o); }
        const float muA = a1 * (1.0f / 1024.0f), rsA = rsqrtf(fmaxf(a2 * (1.0f / 1024.0f) - muA * muA, 0.f) + LN_EPS);
        const float muB = b1 * (1.0f / 1024.0f), rsB = rsqrtf(fmaxf(b2 * (1.0f / 1024.0f) - muB * muB, 0.f) + LN_EPS);
        float accA[8] = {0.f, 0.f, 0.f, 0.f, 0.f, 0.f, 0.f, 0.f}, accB[8] = {0.f, 0.f, 0.f, 0.f, 0.f, 0.f, 0.f, 0.f};
#pragma unroll
        for (int hf = 0; hf < 2; ++hf) {
            const int k = hf * 512 + lane * 8;
            float za[8], zb[8]; g8::unpack8(zA[hf], za); g8::unpack8(zB[hf], zb);
#pragma unroll
            for (int e = 0; e < 8; ++e) { const f32x4 w0 = *(const LAS f32x4*)(gw + e * 1024 + k), w1 = *(const LAS f32x4*)(gw + e * 1024 + k + 4);
                accA[e] += ((za[0] * w0[0] + za[1] * w0[1]) + (za[2] * w0[2] + za[3] * w0[3])) + ((za[4] * w1[0] + za[5] * w1[1]) + (za[6] * w1[2] + za[7] * w1[3]));
                accB[e] += ((zb[0] * w0[0] + zb[1] * w0[1]) + (zb[2] * w0[2] + zb[3] * w0[3])) + ((zb[4] * w1[0] + zb[5] * w1[1]) + (zb[6] * w1[2] + zb[7] * w1[3])); }
        }
        RT_FINISH(tok, accA, muA, rsA);
        if (tok + 8 < tok1) RT_FINISH(tok + 8, accB, muB, rsB);
    }
#undef RT_LOAD2
#undef RT_FINISH
    __syncthreads();
    if (tid < 8) ((int*)(ws + WS_CNT))[blockIdx.x * 8 + tid] = cnt[tid];
}
__device__ __forceinline__ void router2_phase(LAS unsigned char* lds, const Args& a) {
    const int tid = threadIdx.x, lane = tid & 63, wid = tid >> 6;
    unsigned char* ws = a.ws;
    const int G = gridDim.x, wg = blockIdx.x;
    LAS int* cn = (LAS int*)lds;
    LAS int* tot = (LAS int*)(lds + 16384);
    u32x2* smeta = (u32x2*)(ws + WS_TOK); f32x2* sstat = (f32x2*)(ws + WS_GATEB); const f32x2* tokst = (const f32x2*)(ws + WS_TOKST);
    const f32x4* route = (const f32x4*)(ws + WS_ROUTE);
    const int tok0 = (int)(((long)NR * wg) / G), tok1 = (int)(((long)NR * (wg + 1)) / G);
    f32x4 rr[8]; f32x2 ts[8];
#pragma unroll
    for (int i = 0; i < 8; ++i) { int q = 2 * tok0 + 64 * i + lane; q = q < 2 * tok1 ? q : 2 * tok1 - 1; rr[i] = route[q >> 1]; ts[i] = tokst[q >> 1]; }
    __syncthreads();
    const int* cnts = (const int*)(ws + WS_CNT);
    for (int i = tid; i < G * 8; i += NTHREADS) cn[i] = cnts[i];
    __syncthreads();
    { int t = 0, p = 0;
        for (int w = lane; w < G; w += 64) { const int v = cn[w * 8 + wid]; t += v; p += (w < wg) ? v : 0; }
#pragma unroll
        for (int o = 32; o >= 1; o >>= 1) { t += __shfl_xor(t, o); p += __shfl_xor(p, o); }
        if (lane == 0) { tot[wid] = t; tot[8 + wid] = p; } }
    __syncthreads();
    if (tid == 0) { int ps = 0;
        for (int e = 0; e < 8; ++e) { tot[24 + e] = ps; tot[16 + e] = ps + tot[8 + e]; ps += ((tot[e] + 255) >> 8) << 8; }
        if (wg == 0) { int* hdr = (int*)(ws + WS_HDR); int pp = 0; for (int e = 0; e < 8; ++e) { pp += (tot[e] + 255) >> 8; hdr[e] = pp; } hdr[8] = pp; } }
    __syncthreads();
    { const int e = wid; int run = tot[16 + e];
#pragma unroll
        for (int i = 0; i < 8; ++i) {
            const int q = 2 * tok0 + 64 * i + lane; bool match = false; float gt = 0.f;
            if (q < 2 * tok1) { const f32x4 r = rr[i]; const int ee = __float_as_int(r[0]); const int ex = (q & 1) ? ((ee >> 8) & 0xff) : (ee & 0xff); match = (ex == e); gt = (q & 1) ? r[2] : r[1]; }
            const unsigned long long mask = __ballot(match);
            const int pos = __popcll(mask & ((1ull << lane) - 1ull));
            if (match) { smeta[run + pos] = (u32x2){(unsigned)q, __float_as_uint(gt)}; sstat[run + pos] = ts[i]; }
            run += __popcll(mask);
        }
        if (wg == 0) { const int s0 = tot[24 + e] + tot[e], s1 = tot[24 + e] + (((tot[e] + 255) >> 8) << 8);
            for (int s = s0 + lane; s < s1; s += 64) { smeta[s] = (u32x2){0xffffffffu, 0u}; sstat[s] = (f32x2){0.f, 1.f}; } }
    }
}

__device__ __forceinline__ float wave_total(float x);
__device__ __forceinline__ void final_phase(const Args& a) {
    const int tid = threadIdx.x, lane = tid & 63, wid = tid >> 6;
    unsigned char* ws = a.ws;
    const bf16_t* z3 = (const bf16_t*)(ws + WS_RC); const float* st3 = (const float*)(ws + WS_ST3);
    const bf16_t* Y0 = (const bf16_t*)(ws + WS_RB); const bf16_t* Y1 = (const bf16_t*)(ws + WS_RD);
    const float* g3 = a.in[16] + 2048; const float* b3 = a.in[17] + 2048; const float* g4 = a.in[16] + 3072; const float* b4 = a.in[17] + 3072;
    float G3[16], B3[16], G4[16], B4[16];
#pragma unroll
    for (int hf = 0; hf < 2; ++hf)
#pragma unroll
        for (int q = 0; q < 2; ++q) { const int k = hf * 512 + lane * 8 + q * 4;
            const f32x4 a3 = *(const f32x4*)(g3 + k), c3 = *(const f32x4*)(b3 + k), a4 = *(const f32x4*)(g4 + k), c4 = *(const f32x4*)(b4 + k);
#pragma unroll
            for (int j = 0; j < 4; ++j) { G3[hf * 8 + q * 4 + j] = a3[j] * ALPHA; B3[hf * 8 + q * 4 + j] = c3[j] * ALPHA; G4[hf * 8 + q * 4 + j] = a4[j]; B4[hf * 8 + q * 4 + j] = c4[j]; } }
    const int stride = gridDim.x * 8;
    int tok = blockIdx.x * 8 + wid;
    u32x4 zr[2], y0r[2], y1r[2]; f32x2 sp;
#define FIN_LOAD(t) do { _Pragma("unroll") for (int hf = 0; hf < 2; ++hf) { const size_t o = (size_t)(t) * D + hf * 512 + lane * 8; \
        zr[hf] = *(const u32x4*)(z3 + o); y0r[hf] = *(const u32x4*)(Y0 + o); y1r[hf] = *(const u32x4*)(Y1 + o); } \
        sp = *(const f32x2*)(st3 + (size_t)(t) * 32 + (lane & 15) * 2); } while (0)
    if (tok < NR) FIN_LOAD(tok);
    for (; tok < NR; tok += stride) {
        u32x4 zc[2] = {zr[0], zr[1]}, y0c[2] = {y0r[0], y0r[1]}, y1c[2] = {y1r[0], y1r[1]}; const f32x2 spc = sp;
        if (tok + stride < NR) FIN_LOAD(tok + stride);
        float s1 = spc[0], s2 = spc[1];
#pragma unroll
        for (int o = 1; o < 16; o <<= 1) { s1 += __shfl_xor(s1, o); s2 += __shfl_xor(s2, o); }
        const float mu = s1 * (1.0f / 1024.0f); const float rstd = rsqrtf(fmaxf(s2 * (1.0f / 1024.0f) - mu * mu, 0.f) + LN_EPS);
        float v[16]; float t1 = 0.f;
#pragma unroll
        for (int hf = 0; hf < 2; ++hf) {
            float z[8], y0[8], y1[8];
            g8::unpack8(zc[hf], z); g8::unpack8(y0c[hf], y0); g8::unpack8(y1c[hf], y1);
#pragma unroll
            for (int j = 0; j < 8; ++j) { const float x = ((z[j] - mu) * rstd * G3[hf * 8 + j] + B3[hf * 8 + j]) + (y0[j] + y1[j]); v[hf * 8 + j] = x; t1 += x; }
        }
        t1 = wave_total(t1); const float mean = t1 * (1.0f / 1024.0f); float t2 = 0.f;
#pragma unroll
        for (int j = 0; j < 16; ++j) { const float d = v[j] - mean; t2 += d * d; }
        t2 = wave_total(t2); const float rs = rsqrtf(t2 * (1.0f / 1024.0f) + LN_EPS);
#pragma unroll
        for (int hf = 0; hf < 2; ++hf) {
            const int k = hf * 512 + lane * 8;
            f32x4 o0, o1;
#pragma unroll
            for (int j = 0; j < 4; ++j) { o0[j] = (v[hf * 8 + j] - mean) * rs * G4[hf * 8 + j] + B4[hf * 8 + j]; o1[j] = (v[hf * 8 + 4 + j] - mean) * rs * G4[hf * 8 + 4 + j] + B4[hf * 8 + 4 + j]; }
            *(f32x4*)(a.out + (size_t)tok * D + k) = o0; *(f32x4*)(a.out + (size_t)tok * D + k + 4) = o1;
        }
    }
#undef FIN_LOAD
}

__device__ __forceinline__ void moefix_phase(const Args& a) {
    const int lane = threadIdx.x & 63, wid = threadIdx.x >> 6;
    unsigned char* ws = a.ws;
    const int npan = ((const int*)(ws + WS_HDR))[8];
    const int p_lo = (MOE_NCHUNK - 1) * MOE_CHUNK_PAN + MOE_CHUNK_PAN;
    const int nrows = (npan - p_lo) * 256;
    const u32x2* smeta = (const u32x2*)(ws + WS_TOK);
    const float* P = (const float*)(ws + WS_RA + RA_POFF);
    bf16_t* Y0 = (bf16_t*)(ws + WS_RB); bf16_t* Y1 = (bf16_t*)(ws + WS_RD);
    for (int r = blockIdx.x * 8 + wid; r < nrows; r += gridDim.x * 8) {
        const u32x2 mg = smeta[(size_t)p_lo * 256 + r];
        const int id = (int)mg.x; const float gt = __uint_as_float(mg.y);
        if (id < 0) continue;
        bf16_t* yrow = ((id & 1) ? Y1 : Y0) + (size_t)(id >> 1) * D;
#pragma unroll
        for (int hf = 0; hf < 2; ++hf) {
            const int c = hf * 512 + lane * 8;
            f32x4 s0 = {0.f, 0.f, 0.f, 0.f}, s1 = {0.f, 0.f, 0.f, 0.f};
#pragma unroll
            for (int ks = 0; ks < MOE_KSPLIT; ++ks) { const float* pp = P + ((size_t)ks * 2048 + r) * D + c; s0 += *(const f32x4*)pp; s1 += *(const f32x4*)(pp + 4); }
            *(u32x4*)(yrow + c) = g8::pack8(s0 * gt, s1 * gt);
        }
    }
}
__device__ __forceinline__ void finstats_phase(const float* st, float* rs, int nrows) {
    for (int row = blockIdx.x * NTHREADS + threadIdx.x; row < nrows; row += gridDim.x * NTHREADS) {
        const f32x4* p = (const f32x4*)(st + (size_t)row * 32);
        float s1 = 0.f, s2 = 0.f;
#pragma unroll
        for (int i = 0; i < 8; ++i) { const f32x4 a = p[i]; s1 += a[0] + a[2]; s2 += a[1] + a[3]; }
        const float mu = s1 * (1.0f / 1024.0f); const float rstd = rsqrtf(fmaxf(s2 * (1.0f / 1024.0f) - mu * mu, 0.f) + LN_EPS);
        *(f32x2*)(rs + (size_t)row * 2) = (f32x2){mu, rstd};
    }
}
__global__ void __launch_bounds__(NTHREADS, 2) yoco_fwd(Args args) {
    extern __shared__ __attribute__((aligned(16))) unsigned char lds_raw[];
    LAS unsigned char* lds = (LAS unsigned char*)lds_raw;
    unsigned char* ws = args.ws;
    const int G = gridDim.x;
    const int lo = args.ph_lo, hi = args.ph_hi;
    volatile LAS unsigned* misc = (volatile LAS unsigned*)(lds + LDS_MISC);
    if (threadIdx.x < 4) misc[threadIdx.x] = 0u;
    __syncthreads();
    XcdBarrier bar; bar.bar = (unsigned*)(ws + WS_CTL); bar.x = 0; bar.st = misc;
    if (hi - lo > 1) bar = xcd_barrier_post((unsigned*)(ws + WS_CTL), misc);
    if (PROBE_T >= 0 && blockIdx.x == 0 && threadIdx.x == 0) __hip_atomic_store((unsigned long long*)(ws + WS_DIAG + 32), 0ull, __ATOMIC_RELAXED, __HIP_MEMORY_SCOPE_AGENT);
#ifndef PHASE_MASK
#define PHASE_MASK 0xFFFFFFFFu
#endif
#define IN(k) (((PHASE_MASK >> (k)) & 1u) && lo <= (k) && (k) < hi)
#define SEAM(k) do { if (IN(k) && IN((k) + 1)) xcd_barrier(bar); } while (0)
    bf16_t* RA = (bf16_t*)(ws + WS_RA); bf16_t* RB = (bf16_t*)(ws + WS_RB); bf16_t* RC = (bf16_t*)(ws + WS_RC); bf16_t* RD = (bf16_t*)(ws + WS_RD);
    float* vec = (float*)(ws + WS_VEC);
    float* st1 = (float*)(ws + WS_ST1); float* st2 = (float*)(ws + WS_ST2); float* st3 = (float*)(ws + WS_ST3);
    const float* ln_g = args.in[16]; const float* ln_b = args.in[17];

#define RUN(k, ...) do { if constexpr (((REPMASK) >> (k)) & 1u) { if (IN(k)) { __VA_ARGS__ } xcd_barrier(bar); } \
        if ((k) == PROBE_T && threadIdx.x == 0) ((volatile long long*)(ws + WS_DIAG + 1024))[blockIdx.x] = wall_clock64(); \
        if (IN(k)) { __VA_ARGS__ } \
        if ((k) == PROBE_T && threadIdx.x == 0) { const long long dt_ = wall_clock64() - ((volatile long long*)(ws + WS_DIAG + 1024))[blockIdx.x]; if (PROBE_WG < 0 || (int)blockIdx.x == PROBE_WG) atomicMax((unsigned long long*)(ws + WS_DIAG + 32), (unsigned long long)dt_); } \
        SEAM(k); } while (0)
    RUN(PH_PRO, prologue_phase(lds, args););
    RUN(PH_PROJ,
        g8::Gemm g{RB, (const bf16_t*)(ws + WS_WIN), D, nullptr, nullptr, nullptr}; g8::DenseOrder S; S.init(NPAN, NPROJ / 256, D, G, (int)blockIdx.x);
        g8::EpiPlain E{RA, NPROJ};
        g8::gemm_phase<g8::EpiPlain, g8::DenseOrder, false>(lds, g, S, E); tail_jobs(lds, args, PH_PROJ););
    RUN(PH_MLSTM, if ((int)blockIdx.x < 256) mlstm_phase(lds, RA, (const float*)(ws + WS_GATES), args.in[4], RD, (int)blockIdx.x););
    RUN(PH_WOUT,
        g8::Gemm g{RD, (const bf16_t*)(ws + WS_WOUT), D, nullptr, nullptr, nullptr}; g8::DenseOrder S; S.init(NPAN, 4, D, G, (int)blockIdx.x);
        g8::EpiRes<0> E{RC, RB, st1, lds + LDS_META, nullptr, nullptr};
        g8::gemm_phase<g8::EpiRes<0>, g8::DenseOrder, false>(lds, g, S, E); tail_jobs(lds, args, PH_WOUT););
    RUN(PH_FIN1, finstats_phase(st1, (float*)(ws + WS_RS1), NROWS););
    RUN(PH_GU,
        g8::Gemm g{RC, (const bf16_t*)(ws + WS_WGU), D, nullptr, nullptr, ws + WS_RS1}; g8::DenseOrder S; S.init(NPAN, 2 * FFD / 256, D, G, (int)blockIdx.x);
        g8::EpiGlu<false> E{RA, FFD, st1, vec + VEC_GU_CS, vec + VEC_GU_BW, lds + LDS_META, 0};
        g8::gemm_phase<g8::EpiGlu<false>, g8::DenseOrder, false, 3>(lds, g, S, E); tail_jobs(lds, args, PH_GU););
    RUN(PH_DN,
        g8::Gemm g{RA, (const bf16_t*)(ws + WS_WDN), FFD, nullptr, nullptr, ws + WS_RS1}; g8::DenseOrder S; S.init(NPAN, 4, FFD, G, (int)blockIdx.x);
        g8::EpiRes<1> E{RB, RC, st2, lds + LDS_META, ln_g, ln_b};
        g8::gemm_phase<g8::EpiRes<1>, g8::DenseOrder, false, 3>(lds, g, S, E); tail_jobs(lds, args, PH_DN););
    RUN(PH_FIN2, finstats_phase(st2, (float*)(ws + WS_RS2), NROWS););
    RUN(PH_KVQ,
        g8::Gemm g{RB, (const bf16_t*)(ws + WS_WKVQ), D, nullptr, nullptr, ws + WS_RS2}; g8::DenseOrder S; S.init(NPAN, NPROJ / 256, D, G, (int)blockIdx.x);
        g8::EpiFold E{RA, NPROJ, lds + LDS_META, vec + VEC_KVQ_CS, vec + VEC_KVQ_BW};
        g8::gemm_phase<g8::EpiFold, g8::DenseOrder, false, 3>(lds, g, S, E); tail_jobs(lds, args, PH_KVQ););
    RUN(PH_ATT, attn_phase(lds, RA, RD););
    RUN(PH_WO,
        g8::Gemm g{RD, (const bf16_t*)(ws + WS_WO), D, nullptr, nullptr, ws + WS_RS2}; g8::DenseOrder S; S.init(NR / 256, 4, D, G, (int)blockIdx.x);
        g8::EpiRes<1> E{RC, RB, st3, lds + LDS_META, ln_g + 1024, ln_b + 1024};
        g8::gemm_phase<g8::EpiRes<1>, g8::DenseOrder, false, 3>(lds, g, S, E););
    RUN(PH_RT1, router1_phase(lds, args););
    RUN(PH_RT2, router2_phase(lds, args););
#define MOE_CHUNK(cidx) \
    RUN(PH_MOE0 + 2 * (cidx), const int* hdr = (const int*)(ws + WS_HDR); const int npan = hdr[8]; const int p0 = (cidx) * MOE_CHUNK_PAN; \
        { g8::MoeOrder S; S.p0 = p0; S.np = ((cidx) == MOE_NCHUNK - 1) ? (npan - p0) : MOE_CHUNK_PAN; S.nfull = MOE_CHUNK_PAN; S.nsplit = 1; S.nN = 2 * FFE / 256; S.G = G; S.c = (int)blockIdx.x; S.K = D; S.estride = (unsigned)(2 * FFE * D * 2); \
            _Pragma("unroll") for (int e = 0; e < NE; ++e) S.pend[e] = hdr[e]; \
            g8::Gemm g{RC, (const bf16_t*)(ws + WS_WEGU), D, (const int*)(ws + WS_TOK), ws + WS_TOK, ws + WS_GATEB}; \
            g8::EpiGlu<true> E{RA, FFE, st3, vec + VEC_EGU_CS, vec + VEC_EGU_BW, lds + LDS_META, 2 * FFE}; \
            g8::gemm_phase<g8::EpiGlu<true>, g8::MoeOrder, true, 1>(lds, g, S, E); }); \
    RUN(PH_MOE0 + 2 * (cidx) + 1, const int* hdr = (const int*)(ws + WS_HDR); const int npan = hdr[8]; const int p0 = (cidx) * MOE_CHUNK_PAN; \
        { g8::MoeOrder S; S.p0 = p0; S.np = ((cidx) == MOE_NCHUNK - 1) ? (npan - p0) : MOE_CHUNK_PAN; S.nfull = MOE_CHUNK_PAN; S.nsplit = MOE_KSPLIT; S.nN = 4; S.G = G; S.c = (int)blockIdx.x; S.K = FFE; S.estride = (unsigned)(D * FFE * 2); \
            _Pragma("unroll") for (int e = 0; e < NE; ++e) S.pend[e] = hdr[e]; \
            g8::Gemm g{RA, (const bf16_t*)(ws + WS_WEDN), FFE, nullptr, ws + WS_TOK, nullptr}; \
            g8::EpiMoeDown E{RB, RD, lds + LDS_META, (float*)((unsigned char*)RA + RA_POFF), MOE_CHUNK_PAN}; \
            g8::gemm_phase<g8::EpiMoeDown, g8::MoeOrder, false, 2>(lds, g, S, E); });
    MOE_CHUNK(0) MOE_CHUNK(1) MOE_CHUNK(2) MOE_CHUNK(3)
    RUN(PH_FIX, moefix_phase(args););
    RUN(PH_FINAL, final_phase(args););
    if (PROBE_T >= 0 && blockIdx.x == 0 && threadIdx.x == 0) { const long long dl = 4 * (long long)__hip_atomic_load((unsigned long long*)(ws + WS_DIAG + 32), __ATOMIC_RELAXED, __HIP_MEMORY_SCOPE_AGENT); const long long t0 = wall_clock64(); while (wall_clock64() - t0 < dl) __builtin_amdgcn_s_sleep(8); }
#undef RUN
#undef IN
#undef SEAM
}

extern "C" void kernel_launch(void* const* d_in, const int* in_sizes, int n_in, void* d_out, int out_size, void* d_ws, size_t ws_size, hipStream_t stream) {
    static int grid = 0;
    if (grid == 0) {
        if (n_in != 18 || out_size != NR * D || ws_size < WS_END) { fprintf(stderr, "kernel_launch: unexpected problem (n_in %d out %d ws %zu need %zu)\n", n_in, out_size, ws_size, (size_t)WS_END); grid = -1; return; }
        int dev = 0, cus = 0, per_cu = 0;
        if (hipGetDevice(&dev) != hipSuccess || hipDeviceGetAttribute(&cus, hipDeviceAttributeMultiprocessorCount, dev) != hipSuccess) { grid = -1; return; }
        if (hipFuncSetAttribute((const void*)yoco_fwd, hipFuncAttributeMaxDynamicSharedMemorySize, LDS_BYTES) != hipSuccess) { fprintf(stderr, "kernel_launch: hipFuncSetAttribute failed\n"); grid = -1; return; }
        if (hipOccupancyMaxActiveBlocksPerMultiprocessor(&per_cu, (const void*)yoco_fwd, NTHREADS, LDS_BYTES) != hipSuccess || per_cu < 1) { fprintf(stderr, "kernel_launch: occupancy query says %d\n", per_cu); }
        (void)hipGetLastError();
        if (cus < 256) { fprintf(stderr, "kernel_launch: needs 256 CUs\n"); grid = -1; return; }
        grid = 256;
    }
    if (grid < 0) return;
    (void)hipMemsetAsync((char*)d_ws + WS_CTL, 0, CTL_BYTES, stream);
    Args a{};
    for (int i = 0; i < 18; ++i) a.in[i] = (const float*)d_in[i];
    a.out = (float*)d_out; a.ws = (unsigned char*)d_ws;
#if N_LAUNCH_MODE == 1
    for (int p = 0; p < PH_COUNT; ++p) { a.ph_lo = p; a.ph_hi = p + 1; hipLaunchKernelGGL(yoco_fwd, dim3(grid), dim3(NTHREADS), LDS_BYTES, stream, a); }
#else
    a.ph_lo = 0; a.ph_hi = PH_COUNT;
    hipLaunchKernelGGL(yoco_fwd, dim3(grid), dim3(NTHREADS), LDS_BYTES, stream, a);
#endif
}
```

```cpp
#include <hip/hip_runtime.h>
#include <cstdio>
#include <cstdint>

#ifndef N_LAUNCH_MODE
#define N_LAUNCH_MODE 0
#endif
#ifndef PROBE_CLK
#define PROBE_CLK 0
#endif
#ifndef PROBE_T
#define PROBE_T (-1)
#endif
#ifndef PROBE_WG
#define PROBE_WG (-1)
#endif
#ifndef REPMASK
#define REPMASK 0u
#endif

#define LAS __attribute__((address_space(3)))
typedef unsigned short bf16_t;
typedef short bf16x8 __attribute__((ext_vector_type(8)));
typedef float f32x2 __attribute__((ext_vector_type(2)));
typedef float f32x4 __attribute__((ext_vector_type(4)));
typedef float f32x16 __attribute__((ext_vector_type(16)));
typedef unsigned u32x2 __attribute__((ext_vector_type(2)));
typedef unsigned u32x4 __attribute__((ext_vector_type(4)));
typedef __bf16 bf16x2_t __attribute__((ext_vector_type(2)));

constexpr int D = 1024, NB = 16, SEQ = 4096, NMETA = 16;
constexpr int NR = NB * SEQ;
constexpr int NROWS = NR + NB * NMETA;
constexpr int NPAN = NROWS / 256;
constexpr int NPROJ = 3072;
constexpr int FFD = 2816, NE = 8, FFE = 3584;
constexpr float ALPHA = 1.41421356237f, LN_EPS = 1e-5f;
constexpr int NTHREADS = 512;
constexpr int MOE_ROWS = 2 * NR + NE * 256;
constexpr int MOE_CHUNK_PAN = 128;
constexpr int MOE_NCHUNK = 4;
constexpr int MOE_KSPLIT = 7;
constexpr size_t RA_POFF = (size_t)256 << 20;

constexpr size_t al256(size_t x) { return (x + 255) & ~(size_t)255; }
constexpr size_t WS_CTL = 0;
constexpr size_t CTL_BYTES = 65536;
constexpr size_t WS_WIN = WS_CTL + CTL_BYTES;
constexpr size_t WS_WOUT = WS_WIN + (size_t)NPROJ * D * 2;
constexpr size_t WS_WGU = WS_WOUT + (size_t)D * D * 2;
constexpr size_t WS_WDN = WS_WGU + (size_t)2 * FFD * D * 2;
constexpr size_t WS_WKVQ = WS_WDN + (size_t)D * FFD * 2;
constexpr size_t WS_WO = WS_WKVQ + (size_t)NPROJ * D * 2;
constexpr size_t WS_WEGU = WS_WO + (size_t)D * D * 2;
constexpr size_t WS_WEDN = WS_WEGU + (size_t)NE * 2 * FFE * D * 2;
constexpr size_t WS_VEC = WS_WEDN + (size_t)NE * D * FFE * 2;
constexpr int VEC_GU_CS = 0, VEC_GU_BW = 2 * FFD, VEC_KVQ_CS = 4 * FFD, VEC_KVQ_BW = VEC_KVQ_CS + NPROJ, VEC_EGU_CS = VEC_KVQ_BW + NPROJ, VEC_EGU_BW = VEC_EGU_CS + NE * 2 * FFE, VEC_END = VEC_EGU_BW + NE * 2 * FFE;
constexpr size_t WS_GATES = al256(WS_VEC + (size_t)VEC_END * 4);
constexpr size_t WS_ST1 = al256(WS_GATES + (size_t)NROWS * 8 * 4);
constexpr size_t WS_ST2 = WS_ST1 + (size_t)NROWS * 16 * 8;
constexpr size_t WS_ST3 = WS_ST2 + (size_t)NROWS * 16 * 8;
constexpr size_t WS_ROUTE = WS_ST3 + (size_t)NROWS * 16 * 8;
constexpr size_t WS_CNT = WS_ROUTE + (size_t)NR * 16;
constexpr size_t WS_HDR = WS_CNT + 256 * 8 * 4;
constexpr size_t WS_TOK = WS_HDR + 256;
constexpr size_t WS_GATEB = al256(WS_TOK + (size_t)MOE_ROWS * 8);
constexpr size_t WS_TOKST = al256(WS_GATEB + (size_t)MOE_ROWS * 8);
constexpr size_t WS_RS1 = al256(WS_TOKST + (size_t)NR * 8);
constexpr size_t WS_RS2 = al256(WS_RS1 + (size_t)NROWS * 8);
constexpr size_t WS_DIAG = al256(WS_RS2 + (size_t)NROWS * 8);
constexpr size_t WS_RA = al256(WS_DIAG + 4096);
constexpr size_t RA_BYTES = (size_t)NROWS * NPROJ * 2;
constexpr size_t WS_RB = al256(WS_RA + RA_BYTES);
constexpr size_t RX_BYTES = (size_t)NROWS * D * 2;
constexpr size_t WS_RC = al256(WS_RB + RX_BYTES);
constexpr size_t WS_RD = al256(WS_RC + RX_BYTES);
constexpr size_t WS_END = al256(WS_RD + RX_BYTES);

constexpr int LDS_MAIN = 131072, LDS_META = LDS_MAIN  , LDS_MISC = LDS_META + 8192  , LDS_BYTES = LDS_MISC + 256;
__device__ __forceinline__ float bf2f(bf16_t v) { return __uint_as_float(((unsigned)v) << 16); }
__device__ __forceinline__ float bflo(unsigned u) { return __uint_as_float(u << 16); }
__device__ __forceinline__ float bfhi(unsigned u) { return __uint_as_float(u & 0xffff0000u); }
__device__ __forceinline__ unsigned pk2(float lo, float hi) { f32x2 v = {lo, hi}; bf16x2_t b = __builtin_convertvector(v, bf16x2_t); return __builtin_bit_cast(unsigned, b); }
__device__ __forceinline__ bf16_t f2bf(float f) { return (bf16_t)(pk2(f, 0.f) & 0xffffu); }
__device__ __forceinline__ float rbf(float f) { return bflo(pk2(f, 0.f)); }
__device__ __forceinline__ float wave_sum(float v) {
#pragma unroll
    for (int o = 32; o >= 1; o >>= 1) v += __shfl_xor(v, o);
    return v;
}
__device__ __forceinline__ float swap32_hi(float x, float& lo) {
    const u32x2 r = __builtin_amdgcn_permlane32_swap(__float_as_uint(x), __float_as_uint(x), false, false); lo = __uint_as_float(r.x); return __uint_as_float(r.y); }
__device__ __forceinline__ float fq_sum(float x) {
    const u32x2 a = __builtin_amdgcn_permlane16_swap(__float_as_uint(x), __float_as_uint(x), false, false); const float y = __uint_as_float(a.x) + __uint_as_float(a.y);
    const u32x2 b = __builtin_amdgcn_permlane32_swap(__float_as_uint(y), __float_as_uint(y), false, false); return __uint_as_float(b.x) + __uint_as_float(b.y); }
__device__ __forceinline__ float sigmoidf_(float x) { return __builtin_amdgcn_rcpf(1.0f + __builtin_amdgcn_exp2f(x * -1.4426950408889634f)); }

#define XB_TMO      128
#define XB_XCNT(j)  (256  + 64 * (j))
#define XB_XSUB(j)  (1280 + 64 * (j))
#define XB_XGEN(j)  (2304 + 64 * (j))
#define XB_TOP      3328
#define XB_TOPGEN   3392
#define XCD_BAR_WORDS 3456
#define XB_SPIN_CAP (1u << 20)
__device__ __forceinline__ unsigned xb_ld(unsigned* p)              { return __hip_atomic_load(p, __ATOMIC_RELAXED, __HIP_MEMORY_SCOPE_AGENT); }
__device__ __forceinline__ unsigned xb_add(unsigned* p, unsigned v) { return __hip_atomic_fetch_add(p, v, __ATOMIC_RELAXED, __HIP_MEMORY_SCOPE_AGENT); }
__device__ __forceinline__ unsigned xb_xcc_id() { return (unsigned)__builtin_amdgcn_s_getreg((3 << 11) | 20) & 0xFu; }
#define XB_SPIN(cond, bar) do { unsigned _sp = 0; while (cond) { __builtin_amdgcn_s_sleep(1); \
    if ((++_sp & 255u) == 0u) { if (xb_ld(&(bar)[XB_TMO])) break; if (_sp > XB_SPIN_CAP) { atomicAdd(&(bar)[XB_TMO], 1u); break; } } } } while (0)
struct XcdBarrier { unsigned* bar; unsigned x; volatile LAS unsigned* st; };
__device__ __forceinline__ XcdBarrier xcd_barrier_post(unsigned* bar, volatile LAS unsigned* st) {
    XcdBarrier b; b.bar = bar; b.x = xb_xcc_id(); b.st = st;
    if (threadIdx.x == 0) (void)xb_add(&bar[XB_XCNT(b.x)], 1u);
    return b;
}
__device__ __forceinline__ void xcd_barrier_complete(unsigned* bar, unsigned x, unsigned& nloc, unsigned& nx) {
    const unsigned G = gridDim.x * gridDim.y * gridDim.z;
    unsigned sum, cnt, mine, sp = 0u;
    for (;;) {
        sum = 0u; cnt = 0u; mine = 0u;
#pragma unroll
        for (unsigned j = 0; j < 16; ++j) { const unsigned c = xb_ld(&bar[XB_XCNT(j)]); sum += c; cnt += (c > 0u) ? 1u : 0u; mine = (j == x) ? c : mine; }
        if (sum == G) break;
        __builtin_amdgcn_s_sleep(1);
        if ((++sp & 255u) == 0u) { if (xb_ld(&bar[XB_TMO])) break; if (sp > XB_SPIN_CAP) { atomicAdd(&bar[XB_TMO], 1u); break; } }
    }
    nloc = mine > 0u ? mine : 1u; nx = cnt > 0u ? cnt : 1u;
}
__device__ __forceinline__ void xcd_barrier(const XcdBarrier& b) {
    asm volatile("s_waitcnt vmcnt(0)" ::: "memory");
    __syncthreads();
    if (threadIdx.x == 0) {
        unsigned* bar = b.bar;
        __builtin_amdgcn_s_waitcnt(0);
        unsigned nloc = b.st[0], nx = b.st[1];
        if (nloc == 0u) { xcd_barrier_complete(bar, b.x, nloc, nx); b.st[0] = nloc; b.st[1] = nx; }
        const unsigned old = xb_add(&bar[XB_XSUB(b.x)], 1u);
        const unsigned gen = old / nloc;
        if (old + 1u == (gen + 1u) * nloc) {
            __builtin_amdgcn_fence(__ATOMIC_RELEASE, "agent");
            asm volatile("s_waitcnt vmcnt(0)" ::: "memory");
            const unsigned og = xb_add(&bar[XB_TOP], 1u);
            const unsigned tg = og / nx;
            if (og + 1u == (tg + 1u) * nx) xb_add(&bar[XB_TOPGEN], 1u);
            else XB_SPIN(xb_ld(&bar[XB_TOPGEN]) == tg, bar);
            __builtin_amdgcn_fence(__ATOMIC_ACQUIRE, "agent");
            xb_add(&bar[XB_XGEN(b.x)], 1u);
            asm volatile("s_waitcnt vmcnt(0)" ::: "memory");
        } else {
            XB_SPIN(xb_ld(&bar[XB_XGEN(b.x)]) == gen, bar);
            __builtin_amdgcn_fence(__ATOMIC_ACQUIRE, "agent");
            asm volatile("s_waitcnt vmcnt(0)" ::: "memory");
        }
    }
    __syncthreads();
}

namespace g8 {
constexpr int BM = 256, BK = 64, HALF = 128, HTB = HALF * BK * 2, STAGE_BYTES = 8 * HTB, NXCD = 8, WGM = 8;
__host__ __device__ __forceinline__ int lds_byte(int r, int c) { const int st = (r >> 4) * 2 + (c >> 5), rr = r & 15, cc = c & 31, ob = rr * 64 + cc * 2; return st * 1024 + (ob ^ (((ob >> 9) & 1) << 5)); }
__host__ __device__ __forceinline__ void stage_rc(int b, int& R, int& C) { const int st = b / 1024, sb = b % 1024, swz = sb ^ (((sb >> 9) & 1) << 5); R = (st >> 1) * 16 + swz / 64; C = (st & 1) * 32 + (swz % 64) / 2; }
__host__ __device__ __forceinline__ int perm32(int rho) { const int n = rho >> 4, i = rho & 15; return 8 * (i >> 2) + 4 * n + (i & 3); }

struct Unit { int pm, pn, gp; unsigned boff; int aux; int kt; unsigned koff; int ks; };
struct Gemm { const bf16_t* A; const bf16_t* Bt; int K; const int* rowtab; const unsigned char* smeta; const unsigned char* sstat; };

struct DenseOrder {
    int nM, nN, nwg, G, c, K;
    __device__ void init(int nM_, int nN_, int K_, int G_, int c_) { nM = nM_; nN = nN_; nwg = nM * nN; G = G_; c = c_; K = K_; }
    __device__ bool next(int i, Unit& u) const {
        const long L = (long)i * G + c; if (L >= nwg) return false;
        int wgid = (int)L; { const int q = nwg / NXCD, r = nwg % NXCD, xcd = wgid % NXCD, off = wgid / NXCD; wgid = (xcd < r ? xcd * (q + 1) : r * (q + 1) + (xcd - r) * q) + off; }
        const int nig = WGM * nN, gid = wgid / nig, fm = gid * WGM, gsz = (nM - fm) < WGM ? (nM - fm) : WGM;
        u.pm = fm + ((wgid % nig) % gsz); u.pn = (wgid % nig) / gsz; u.gp = u.pm; u.boff = (unsigned)u.pn * (unsigned)(256 * K * 2); u.kt = K / BK; u.koff = 0u; u.ks = -1; return true;
    }
};
struct MoeOrder {
    int p0, np, nN, G, c, K; unsigned estride; int pend[NE]; int nfull, nsplit;
    __device__ bool next(int i, Unit& u) const {
        const long L = (long)i * G + c; const long nmain = (long)nfull * nN;
        int pn, pml, ks = -1;
        if (L < nmain) {
            if (G == 256 && nfull == 128 && (nN & 3) == 0) { const int x = c & 7, j = c >> 3, rpb = nN >> 2, pb = x + 8 * (i / rpb), nb = i % rpb;
                pml = 8 * pb + (j & 7); pn = 4 * nb + (j >> 3); }
            else { pn = (int)(L / nfull); pml = (int)(L % nfull); } }
        else { const long r = L - nmain; if (r >= (long)(np - nfull) * nN * nsplit) return false;
            ks = (int)(r % nsplit); const int q = (int)(r / nsplit); pn = q % nN; pml = nfull + q / nN; if (nsplit == 1) ks = -1; }
        const int gp = p0 + pml;
        int e = 0;
#pragma unroll
        for (int j = 0; j < NE - 1; ++j) e += (gp >= pend[j]) ? 1 : 0;
        const int ktall = K / BK;
        u.pm = pml; u.pn = pn; u.gp = gp; u.ks = ks; u.kt = ks < 0 ? ktall : ktall / nsplit; u.koff = ks < 0 ? 0u : (unsigned)(ks * (K / nsplit) * 2);
        u.boff = (unsigned)e * estride + (unsigned)pn * (unsigned)(256 * K * 2) + u.koff; return true;
    }
};

template <class Epi, class Sched, bool GATHER, int META = 0>
__device__ __forceinline__ void gemm_phase(LAS unsigned char* lds, const Gemm g, const Sched& S, const Epi& E) {
    const int tid = threadIdx.x, wid = __builtin_amdgcn_readfirstlane(tid >> 6), lane = tid & 63, wr = wid >> 2, wc = wid & 3, fr = lane & 15, fq = lane >> 4;
    const int K = g.K;
    int Rr[2], Cc[2]; unsigned voffA[2], voffB[2];
#pragma unroll
    for (int i = 0; i < 2; ++i) { stage_rc(tid * 16 + i * 8192, Rr[i], Cc[i]); const int Rb = (Rr[i] & ~31) + perm32(Rr[i] & 31);
        voffA[i] = (unsigned)(Rr[i] * K + Cc[i]) * 2u; voffB[i] = (unsigned)(Rb * K + Cc[i]) * 2u; }
    const size_t kstep = (size_t)(BK * 2);
    const size_t hstep = (size_t)HALF * K * 2;
    const size_t tstep = 2 * hstep;
    const unsigned ldsw = (unsigned)wid * 1024u;
    const int aoff = lds_byte(wr * 64 + fr, fq * 8), boff = lds_byte(wc * 32 + fr, fq * 8);
#define G8_SA(b, h) (((b) * 2 + (h)) * HTB)
#define G8_SB(b, h) ((4 + (b) * 2 + (h)) * HTB)
#define G8_STAGE(bufoff, gbase, voff) do { _Pragma("unroll") for (int _i = 0; _i < 2; ++_i) \
        __builtin_amdgcn_global_load_lds((const unsigned*)((const char*)(gbase) + (voff)[_i]), (LAS unsigned*)(lds + (bufoff) + ldsw + _i * 8192), 16, 0, 0); } while (0)
#define G8_STA(bufoff, ptr, offs, h) do { if constexpr (GATHER) { G8_STAGE(bufoff, (const char*)g.A, (offs)[h]); } else { G8_STAGE(bufoff, (ptr) + (h) * hstep, voffA); } } while (0)
#define G8_LDA(dst, b, h) do { _Pragma("unroll") for (int m = 0; m < 4; ++m) _Pragma("unroll") for (int k = 0; k < 2; ++k) dst[m][k] = *(const LAS bf16x8*)(lds + G8_SA(b, h) + aoff + m * 2048 + k * 1024); } while (0)
#define G8_LDB(dst, b, h) do { _Pragma("unroll") for (int n = 0; n < 2; ++n) _Pragma("unroll") for (int k = 0; k < 2; ++k) dst[n][k] = *(const LAS bf16x8*)(lds + G8_SB(b, h) + boff + n * 2048 + k * 1024); } while (0)
#define G8_MMA(ai, bj, At, Bt) do { __builtin_amdgcn_s_setprio(1); _Pragma("unroll") for (int m = 0; m < 4; ++m) _Pragma("unroll") for (int n = 0; n < 2; ++n) _Pragma("unroll") for (int k = 0; k < 2; ++k) \
        acc[ai][bj][m][n] = __builtin_amdgcn_mfma_f32_16x16x32_bf16(Bt[n][k], At[m][k], acc[ai][bj][m][n], 0, 0, 0); __builtin_amdgcn_s_setprio(0); } while (0)
#define G8_WAIT_V(n) asm volatile("s_waitcnt vmcnt(" #n ")" ::: "memory")
#define G8_WAIT_L(n) asm volatile("s_waitcnt lgkmcnt(" #n ")" ::: "memory")
#define G8_BAR __builtin_amdgcn_s_barrier()
#define G8_SCHED __builtin_amdgcn_sched_barrier(0)
#define G8_ROWOFFS(dst, U) do { _Pragma("unroll") for (int _h = 0; _h < 2; ++_h) _Pragma("unroll") for (int _i = 0; _i < 2; ++_i) { \
        const int _id = g.rowtab[2 * ((U).gp * 256 + _h * 128 + Rr[_i])]; const int _tk = _id < 0 ? 0 : (_id >> 1); dst[_h][_i] = (unsigned)(_tk * K + Cc[_i]) * 2u; } } while (0)
#define G8_META_DMA(gsrc, panel, bufidx) __builtin_amdgcn_global_load_lds((const unsigned*)((gsrc) + (size_t)(panel) * 2048 + wid * 256 + lane * 4), (LAS unsigned*)(lds + LDS_META + (bufidx) * 2048 + wid * 256), 4, 0, 0)
    Unit cur, nxt; int ui = 0;
    if (!S.next(0, cur)) return;
    f32x4 acc[2][2][4][2];
#pragma unroll
    for (int a = 0; a < 2; ++a)
#pragma unroll
        for (int b = 0; b < 2; ++b)
#pragma unroll
            for (int m = 0; m < 4; ++m)
#pragma unroll
                for (int n = 0; n < 2; ++n) acc[a][b][m][n] = (f32x4){0.f, 0.f, 0.f, 0.f};
    bf16x8 At[4][2], B0[2][2], B1[2][2];
    const char* cA = (const char*)g.A + (size_t)cur.pm * tstep + cur.koff; const char* cB = (const char*)g.Bt + cur.boff;
    unsigned oc[2][2], on[2][2], o1[2][2], o2[2][2], o3[2][2];
    if constexpr (GATHER) { G8_ROWOFFS(oc, cur);
#pragma unroll
        for (int h = 0; h < 2; ++h)
#pragma unroll
            for (int i = 0; i < 2; ++i) { o1[h][i] = oc[h][i] + 128u; on[h][i] = oc[h][i]; o2[h][i] = 0; o3[h][i] = 0; } }
    G8_STAGE(G8_SB(0, 0), cB, voffB); G8_STAGE(G8_SB(0, 1), cB + hstep, voffB); G8_STA(G8_SA(0, 0), cA, oc, 0); G8_STA(G8_SA(0, 1), cA, oc, 1);
    if (wr == 1) G8_BAR;
    G8_WAIT_V(2); G8_BAR;
    G8_STAGE(G8_SB(1, 0), cB + kstep, voffB); G8_STA(G8_SA(1, 0), cA + kstep, o1, 0); G8_STAGE(G8_SB(1, 1), cB + hstep + kstep, voffB);
    G8_WAIT_V(6); G8_BAR;
    for (;;) {
        const bool has_next = S.next(ui + 1, nxt);
        const char* nA = has_next ? (const char*)g.A + (size_t)nxt.pm * tstep + nxt.koff : cA; const char* nB = has_next ? (const char*)g.Bt + nxt.boff : cB;
        const int nt = cur.kt;
        if constexpr (META == 1) { if (has_next) G8_META_DMA(g.smeta, nxt.gp, (ui + 1) & 1); G8_META_DMA(g.sstat, cur.gp, 2 + (ui & 1)); }
        if constexpr (META == 2) { G8_META_DMA(g.smeta, cur.gp, ui & 1); }
        if constexpr (META == 3) { G8_META_DMA(g.sstat, cur.pm, 2 + (ui & 1)); }
        for (int t = 0; t < nt; t += 2) {
            const bool last = (t == nt - 2);
            const char* a1 = cA + (size_t)(t + 1) * kstep;
            const char* a2 = last ? nA : cA + (size_t)(t + 2) * kstep; const char* b2 = last ? nB : cB + (size_t)(t + 2) * kstep;
            const char* a3 = a2 + kstep; const char* b3 = b2 + kstep;
            if constexpr (GATHER) {
                if (last) {
#pragma unroll
                    for (int h = 0; h < 2; ++h)
#pragma unroll
                        for (int i = 0; i < 2; ++i) { int id = -1; if (has_next) id = *(const LAS int*)(lds + LDS_META + ((ui + 1) & 1) * 2048 + (h * 128 + Rr[i]) * 8);
                            const int tk = id < 0 ? 0 : (id >> 1); on[h][i] = has_next ? (unsigned)(tk * K + Cc[i]) * 2u : oc[h][i]; } }
#pragma unroll
                for (int h = 0; h < 2; ++h)
#pragma unroll
                    for (int i = 0; i < 2; ++i) { o1[h][i] = oc[h][i] + (unsigned)(t + 1) * 128u; o2[h][i] = last ? on[h][i] : oc[h][i] + (unsigned)(t + 2) * 128u; o3[h][i] = o2[h][i] + 128u; } }
            G8_LDB(B0, 0, 0); G8_LDB(B1, 0, 1); G8_SCHED; G8_LDA(At, 0, 0); G8_STA(G8_SA(1, 1), a1, o1, 1);
            G8_WAIT_V(8); G8_WAIT_L(0); G8_BAR; G8_MMA(0, 0, At, B0); G8_MMA(0, 1, At, B1); G8_BAR; G8_SCHED;
            G8_LDA(At, 0, 1); G8_STAGE(G8_SB(0, 0), b2, voffB); G8_STAGE(G8_SB(0, 1), b2 + hstep, voffB); G8_STA(G8_SA(0, 0), a2, o2, 0);
            G8_WAIT_V(8); G8_WAIT_L(0); G8_BAR; G8_MMA(1, 0, At, B0); G8_MMA(1, 1, At, B1); G8_BAR; G8_SCHED;
            G8_LDB(B0, 1, 0); G8_LDB(B1, 1, 1); G8_SCHED; G8_LDA(At, 1, 0); G8_STA(G8_SA(0, 1), a2, o2, 1);
            G8_WAIT_V(8); G8_WAIT_L(0); G8_BAR; G8_MMA(0, 0, At, B0); G8_MMA(0, 1, At, B1); G8_BAR; G8_SCHED;
            G8_LDA(At, 1, 1); G8_STAGE(G8_SB(1, 0), b3, voffB); G8_STAGE(G8_SB(1, 1), b3 + hstep, voffB); G8_STA(G8_SA(1, 0), a3, o3, 0);
            G8_WAIT_V(8); G8_WAIT_L(0); G8_BAR; G8_MMA(1, 0, At, B0); G8_MMA(1, 1, At, B1); G8_BAR; G8_SCHED;
        }
        if (wr == 0) G8_BAR;
        cur.aux = ui & 1;
        E(acc, cur, wr, wc, fr, fq);
        if (!has_next) break;
#pragma unroll
        for (int a = 0; a < 2; ++a)
#pragma unroll
            for (int b = 0; b < 2; ++b)
#pragma unroll
                for (int m = 0; m < 4; ++m)
#pragma unroll
                    for (int n = 0; n < 2; ++n) acc[a][b][m][n] = (f32x4){0.f, 0.f, 0.f, 0.f};
        cur = nxt; cA = nA; cB = nB; ++ui;
        if constexpr (GATHER) {
#pragma unroll
            for (int h = 0; h < 2; ++h)
#pragma unroll
                for (int i = 0; i < 2; ++i) oc[h][i] = on[h][i]; }
        if (wr == 1) G8_BAR;
    }
    G8_WAIT_V(0);
    G8_BAR;
#undef G8_SA
#undef G8_SB
#undef G8_STAGE
#undef G8_STA
#undef G8_LDA
#undef G8_LDB
#undef G8_MMA
#undef G8_WAIT_V
#undef G8_WAIT_L
#undef G8_BAR
#undef G8_SCHED
#undef G8_ROWOFFS
#undef G8_META_DMA
}

typedef f32x4 Acc[2][2][4][2];
__device__ __forceinline__ u32x4 pack8(const f32x4 a, const f32x4 b) { u32x4 w; w.x = pk2(a[0], a[1]); w.y = pk2(a[2], a[3]); w.z = pk2(b[0], b[1]); w.w = pk2(b[2], b[3]); return w; }
__device__ __forceinline__ void unpack8(const u32x4 w, float (&f)[8]) { f[0] = bflo(w.x); f[1] = bfhi(w.x); f[2] = bflo(w.y); f[3] = bfhi(w.y); f[4] = bflo(w.z); f[5] = bfhi(w.z); f[6] = bflo(w.w); f[7] = bfhi(w.w); }
__device__ __forceinline__ void row_stats(const float* st, int row, int fq, float& mu, float& rstd) {
    const f32x4* p = (const f32x4*)(st + (size_t)row * 32 + fq * 8);
    const f32x4 a = p[0], b = p[1];
    float s1 = (a[0] + a[2]) + (b[0] + b[2]), s2 = (a[1] + a[3]) + (b[1] + b[3]);
    s1 += __shfl_xor(s1, 16); s1 += __shfl_xor(s1, 32); s2 += __shfl_xor(s2, 16); s2 += __shfl_xor(s2, 32);
    mu = s1 * (1.0f / 1024.0f); const float var = fmaxf(s2 * (1.0f / 1024.0f) - mu * mu, 0.f); rstd = rsqrtf(var + LN_EPS);
}
__device__ __forceinline__ void put_stats(float* st, int row, int slot, int fq, float s1, float s2) {
    s1 = fq_sum(s1); s2 = fq_sum(s2);
    if (fq == 0) *(f32x2*)(st + (size_t)row * 32 + slot * 2) = (f32x2){s1, s2};
}

struct EpiPlain {
    bf16_t* O; int ldc;
    __device__ __forceinline__ void operator()(const Acc& acc, const Unit& u, int wr, int wc, int fr, int fq) const {
        const int row0 = u.pm * 256 + wr * 64 + fr, col0 = u.pn * 256 + wc * 32 + 8 * fq;
#pragma unroll
        for (int ai = 0; ai < 2; ++ai)
#pragma unroll
            for (int m = 0; m < 4; ++m) { bf16_t* rowp = O + (size_t)(row0 + ai * 128 + m * 16) * ldc + col0;
#pragma unroll
                for (int bj = 0; bj < 2; ++bj) *(u32x4*)(rowp + bj * 128) = pack8(acc[ai][bj][m][0], acc[ai][bj][m][1]); }
    }
};
template <int MODE> struct EpiRes {
    bf16_t* Z; const bf16_t* Rsrc; float* st_out; LAS unsigned char* ldsm; const float* g; const float* b;
    __device__ __forceinline__ void operator()(const Acc& acc, const Unit& u, int wr, int wc, int fr, int fq) const {
        const int r0 = wr * 64 + fr, col0 = u.pn * 256 + wc * 32 + 8 * fq;
        f32x4 gv[2][2], bv[2][2];
        if (MODE == 1) {
#pragma unroll
            for (int bj = 0; bj < 2; ++bj)
#pragma unroll
                for (int n = 0; n < 2; ++n) { gv[bj][n] = *(const f32x4*)(g + col0 + bj * 128 + 4 * n); bv[bj][n] = *(const f32x4*)(b + col0 + bj * 128 + 4 * n); }
        }
        u32x4 rwa[4][4][2];
#define EPR_LOAD(am_) do { _Pragma("unroll") for (int m = 2 * ((am_) & 1); m < 2 * ((am_) & 1) + 2; ++m) _Pragma("unroll") for (int bj = 0; bj < 2; ++bj) \
            rwa[am_][m][bj] = *(const u32x4*)(Rsrc + ((size_t)u.pm * 256 + r0 + ((am_) >> 1) * 128 + m * 16) * D + col0 + bj * 128); } while (0)
        constexpr int PD = (MODE == 0) ? 2 : 1;
        EPR_LOAD(0); if (PD > 1) EPR_LOAD(1);
#pragma unroll
        for (int am = 0; am < 4; ++am) { const int ai = am >> 1;
            if (am + PD < 4) EPR_LOAD(am + PD);
            u32x4 (&rw)[4][2] = rwa[am];
#pragma unroll
            for (int m = 2 * (am & 1); m < 2 * (am & 1) + 2; ++m) {
                const int rl = r0 + ai * 128 + m * 16; const size_t row = (size_t)u.pm * 256 + rl;
                float mu = 0.f, rstd = 1.f;
                if (MODE == 1) { const f32x2 ms = *(const LAS f32x2*)(ldsm + (2 + u.aux) * 2048 + rl * 8); mu = ms[0]; rstd = ms[1]; }
                float s1 = 0.f, s2 = 0.f;
#pragma unroll
                for (int bj = 0; bj < 2; ++bj) {
                    float r[8]; unpack8(rw[m][bj], r);
                    f32x4 v0, v1;
#pragma unroll
                    for (int j = 0; j < 4; ++j) {
                        float h0 = r[j], h1 = r[4 + j];
                        if (MODE == 1) { h0 = (h0 - mu) * rstd * gv[bj][0][j] + bv[bj][0][j]; h1 = (h1 - mu) * rstd * gv[bj][1][j] + bv[bj][1][j]; }
                        v0[j] = ALPHA * h0 + acc[ai][bj][m][0][j]; v1[j] = ALPHA * h1 + acc[ai][bj][m][1][j];
                    }
                    const u32x4 w = pack8(v0, v1);
                    *(u32x4*)(Z + row * D + col0 + bj * 128) = w;
                    float q[8]; unpack8(w, q);
#pragma unroll
                    for (int j = 0; j < 8; ++j) { s1 += q[j]; s2 += q[j] * q[j]; }
                }
                put_stats(st_out, (int)row, u.pn * 4 + wc, fq, s1, s2);
            }
        }
    }
};
struct EpiFold {
    bf16_t* O; int ldc; LAS unsigned char* ldsm; const float* cs; const float* bw;
    __device__ __forceinline__ void operator()(const Acc& acc, const Unit& u, int wr, int wc, int fr, int fq) const {
        const int r0 = wr * 64 + fr, col0 = u.pn * 256 + wc * 32 + 8 * fq;
        f32x4 cv[2][2], bv[2][2];
#pragma unroll
        for (int bj = 0; bj < 2; ++bj)
#pragma unroll
            for (int n = 0; n < 2; ++n) { cv[bj][n] = *(const f32x4*)(cs + col0 + bj * 128 + 4 * n); bv[bj][n] = *(const f32x4*)(bw + col0 + bj * 128 + 4 * n); }
#pragma unroll
        for (int ai = 0; ai < 2; ++ai)
#pragma unroll
            for (int m = 0; m < 4; ++m) {
                const int rl = r0 + ai * 128 + m * 16; const size_t row = (size_t)u.pm * 256 + rl;
                const f32x2 ms = *(const LAS f32x2*)(ldsm + (2 + u.aux) * 2048 + rl * 8); const float mu = ms[0], rstd = ms[1];
#pragma unroll
                for (int bj = 0; bj < 2; ++bj) {
                    const f32x4 v0 = (acc[ai][bj][m][0] - mu * cv[bj][0]) * rstd + bv[bj][0], v1 = (acc[ai][bj][m][1] - mu * cv[bj][1]) * rstd + bv[bj][1];
                    *(u32x4*)(O + row * ldc + col0 + bj * 128) = pack8(v0, v1);
                }
            }
    }
};
template <bool MOE> struct EpiGlu {
    bf16_t* O; int ldc; const float* st_in; const float* cs; const float* bw; LAS unsigned char* ldsm; int ncs;
    __device__ __forceinline__ void operator()(const Acc& acc, const Unit& u, int wr, int wc, int fr, int fq) const {
        const int row0 = u.pm * 256 + wr * 64 + fr, colo = u.pn * 128 + wc * 32 + 8 * fq;
        int vb = u.pn * 256 + wc * 32 + 8 * fq;
        if (MOE) vb += (int)(u.boff / (unsigned)(256 * D * 2)) * 256 - u.pn * 256;
        f32x4 cv[2][2], bv[2][2];
#pragma unroll
        for (int bj = 0; bj < 2; ++bj)
#pragma unroll
            for (int n = 0; n < 2; ++n) { cv[bj][n] = *(const f32x4*)(cs + vb + bj * 128 + 4 * n); bv[bj][n] = *(const f32x4*)(bw + vb + bj * 128 + 4 * n); }
#pragma unroll
        for (int ai = 0; ai < 2; ++ai)
#pragma unroll
            for (int m = 0; m < 4; ++m) {
                const int row = row0 + ai * 128 + m * 16;
                const f32x2 ms = *(const LAS f32x2*)(ldsm + (2 + u.aux) * 2048 + (row - u.pm * 256) * 8); const float mu = ms[0], rstd = ms[1];
                f32x4 o0, o1;
#pragma unroll
                for (int j = 0; j < 4; ++j) {
                    const float g0 = (acc[ai][0][m][0][j] - mu * cv[0][0][j]) * rstd + bv[0][0][j], g1 = (acc[ai][0][m][1][j] - mu * cv[0][1][j]) * rstd + bv[0][1][j];
                    const float u0 = (acc[ai][1][m][0][j] - mu * cv[1][0][j]) * rstd + bv[1][0][j], u1 = (acc[ai][1][m][1][j] - mu * cv[1][1][j]) * rstd + bv[1][1][j];
                    o0[j] = g0 * sigmoidf_(g0) * u0; o1[j] = g1 * sigmoidf_(g1) * u1;
                }
                *(u32x4*)(O + (size_t)row * ldc + colo) = pack8(o0, o1);
            }
    }
};
struct EpiMoeDown {
    bf16_t* Y0; bf16_t* Y1; LAS unsigned char* ldsm; float* P; int nfull;
    __device__ __forceinline__ void operator()(const Acc& acc, const Unit& u, int wr, int wc, int fr, int fq) const {
        const int r0 = wr * 64 + fr, col0 = u.pn * 256 + wc * 32 + 8 * fq;
        if (u.ks >= 0) {
#pragma unroll
            for (int ai = 0; ai < 2; ++ai)
#pragma unroll
                for (int m = 0; m < 4; ++m) { float* rowp = P + ((size_t)u.ks * 2048 + (size_t)(u.pm - nfull) * 256 + r0 + ai * 128 + m * 16) * D + col0;
#pragma unroll
                    for (int bj = 0; bj < 2; ++bj) { *(f32x4*)(rowp + bj * 128) = acc[ai][bj][m][0]; *(f32x4*)(rowp + bj * 128 + 4) = acc[ai][bj][m][1]; } }
            return;
        }
#pragma unroll
        for (int ai = 0; ai < 2; ++ai)
#pragma unroll
            for (int m = 0; m < 4; ++m) {
                const u32x2 mg = *(const LAS u32x2*)(ldsm + u.aux * 2048 + (r0 + ai * 128 + m * 16) * 8);
                const int id = (int)mg.x; const float gt = __uint_as_float(mg.y);
                if (id >= 0) { bf16_t* rowp = Y0 + (size_t)(id & 1) * (size_t)(Y1 - Y0) + (size_t)(id >> 1) * D + col0;
#pragma unroll
                    for (int bj = 0; bj < 2; ++bj) *(u32x4*)(rowp + bj * 128) = pack8(acc[ai][bj][m][0] * gt, acc[ai][bj][m][1] * gt); }
            }
    }
};
}

struct Args { const float* in[18]; float* out; unsigned char* ws; int ph_lo, ph_hi; };
enum { PH_PRO = 0, PH_PROJ, PH_MLSTM, PH_WOUT, PH_FIN1, PH_GU, PH_DN, PH_FIN2, PH_KVQ, PH_ATT, PH_WO, PH_RT1, PH_RT2, PH_MOE0, PH_FIX = PH_MOE0 + 2 * MOE_NCHUNK, PH_FINAL, PH_COUNT };

#define DPP_STEP_ADD(x, ctrl, rmask) x += __builtin_bit_cast(float, __builtin_amdgcn_update_dpp(0, __builtin_bit_cast(int, x), ctrl, rmask, 0xf, false))
#define DPP_STEP_MAX(x, ctrl, rmask) x = fmaxf(x, __builtin_bit_cast(float, __builtin_amdgcn_update_dpp((int)0xff800000, __builtin_bit_cast(int, x), ctrl, rmask, 0xf, false)))
__device__ __forceinline__ float scan_add64(float x) { DPP_STEP_ADD(x, 0x111, 0xf); DPP_STEP_ADD(x, 0x112, 0xf); DPP_STEP_ADD(x, 0x114, 0xf); DPP_STEP_ADD(x, 0x118, 0xf); DPP_STEP_ADD(x, 0x142, 0xa); DPP_STEP_ADD(x, 0x143, 0xc); return x; }
__device__ __forceinline__ float scan_max64(float x) { DPP_STEP_MAX(x, 0x111, 0xf); DPP_STEP_MAX(x, 0x112, 0xf); DPP_STEP_MAX(x, 0x114, 0xf); DPP_STEP_MAX(x, 0x118, 0xf); DPP_STEP_MAX(x, 0x142, 0xa); DPP_STEP_MAX(x, 0x143, 0xc); return x; }
__device__ __forceinline__ float wave_total(float x);
__device__ __forceinline__ float lane63(float x) { return __builtin_bit_cast(float, __builtin_amdgcn_readlane(__builtin_bit_cast(int, x), 63)); }
__device__ __forceinline__ float wave_total(float x) { return lane63(scan_add64(x)); }
__device__ __forceinline__ float logsigmoid_(float x) { return fminf(x, 0.f) - log1pf(expf(-fabsf(x))); }
__device__ __forceinline__ void conv_block(LAS unsigned char* lds, const float* src, int ldw, int K, bf16_t* dst, const float* g, const float* bb, float* cs, float* bw) {
    const int tid = threadIdx.x;
    const int n4 = (tid & 15) * 4, k4 = (tid >> 4) * 4;
    const int rn = tid >> 3, rs = tid & 7;
    float csp[4] = {0.f, 0.f, 0.f, 0.f}, bwp[4] = {0.f, 0.f, 0.f, 0.f};
    const int nch = K / 256;
    constexpr int TS = 520;
    LAS float* gs = (LAS float*)(lds + 2 * 64 * TS + 16384);
    if (g) { for (int i = tid; i < K; i += NTHREADS) { gs[i] = g[i]; gs[K + i] = bb[i]; } __syncthreads(); }
    f32x4 v[2][4], vn[2][4];
#pragma unroll
    for (int hf = 0; hf < 2; ++hf)
#pragma unroll
        for (int kk = 0; kk < 4; ++kk) v[hf][kk] = *(const f32x4*)(src + (size_t)(hf * 128 + k4 + kk) * ldw + n4);
    for (int ch = 0; ch < nch; ++ch) {
        LAS unsigned char* T = lds + (ch & 1) * (64 * TS);
        if (ch + 1 < nch) {
#pragma unroll
            for (int hf = 0; hf < 2; ++hf)
#pragma unroll
                for (int kk = 0; kk < 4; ++kk) vn[hf][kk] = *(const f32x4*)(src + (size_t)((ch + 1) * 256 + hf * 128 + k4 + kk) * ldw + n4); }
#pragma unroll
        for (int hf = 0; hf < 2; ++hf) {
            float gk[4] = {1.f, 1.f, 1.f, 1.f}, bk[4] = {0.f, 0.f, 0.f, 0.f};
            if (g) {
#pragma unroll
                for (int kk = 0; kk < 4; ++kk) { gk[kk] = gs[ch * 256 + hf * 128 + k4 + kk]; bk[kk] = gs[K + ch * 256 + hf * 128 + k4 + kk]; } }
#pragma unroll
            for (int j = 0; j < 4; ++j) {
                const unsigned lo = pk2(v[hf][0][j] * gk[0], v[hf][1][j] * gk[1]), hi = pk2(v[hf][2][j] * gk[2], v[hf][3][j] * gk[3]);
                *(LAS u32x2*)(T + (n4 + j) * TS + (hf * 128 + k4) * 2) = (u32x2){lo, hi};
                csp[j] += (bflo(lo) + bfhi(lo)) + (bflo(hi) + bfhi(hi));
                bwp[j] += (v[hf][0][j] * bk[0] + v[hf][1][j] * bk[1]) + (v[hf][2][j] * bk[2] + v[hf][3][j] * bk[3]);
            }
        }
        __syncthreads();
        u32x2 q[8];
#pragma unroll
        for (int i = 0; i < 8; ++i) q[i] = *(const LAS u32x2*)(T + rn * TS + rs * 64 + i * 8);
        bf16_t* dp = dst + (size_t)rn * K + ch * 256 + rs * 32;
#pragma unroll
        for (int i = 0; i < 4; ++i) *(u32x4*)(dp + 8 * i) = (u32x4){q[2 * i].x, q[2 * i].y, q[2 * i + 1].x, q[2 * i + 1].y};
#pragma unroll
        for (int hf = 0; hf < 2; ++hf)
#pragma unroll
            for (int kk = 0; kk < 4; ++kk) v[hf][kk] = vn[hf][kk];
    }
    __syncthreads();
    if (cs) {
        LAS float* red = (LAS float*)(lds + 2 * 64 * TS);
#pragma unroll
        for (int j = 0; j < 4; ++j) { red[(tid >> 4) * 64 + n4 + j] = csp[j]; red[2048 + (tid >> 4) * 64 + n4 + j] = bwp[j]; }
        __syncthreads();
        if (tid < 128) { const int n = tid & 63, w = tid >> 6; float s = 0.f;
            for (int i = 0; i < 32; ++i) s += red[w * 2048 + i * 64 + n];
            (w ? bw : cs)[n] = s; }
        __syncthreads();
    }
}
__device__ __forceinline__ void conv_job(LAS unsigned char* lds, const Args& a, int blk) {
    unsigned char* ws = a.ws;
    const float* ln_g = a.in[16]; const float* ln_b = a.in[17];
    float* vec = (float*)(ws + WS_VEC);
    const float* src; int ldw, K; bf16_t* dst; const float* g = nullptr; const float* bb = nullptr; float* cs = nullptr; float* bw = nullptr;
    int j = blk;
    if (j < 128) { const int e = j >> 4, jj = j & 15; src = a.in[15] + (size_t)e * FFE * D + 64 * jj; ldw = D; K = FFE; dst = (bf16_t*)(ws + WS_WEDN) + ((size_t)e * D + 64 * jj) * FFE; }
    else if (j < 144) { j -= 128; src = a.in[11] + 64 * j; ldw = D; K = FFD; dst = (bf16_t*)(ws + WS_WDN) + (size_t)(64 * j) * FFD; }
    else if (j < 192) { j -= 144; src = a.in[2] + 64 * j; ldw = 3080; K = D; dst = (bf16_t*)(ws + WS_WIN) + (size_t)(64 * j) * D; }
    else if (j < 208) { j -= 192; src = a.in[5] + 64 * j; ldw = D; K = D; dst = (bf16_t*)(ws + WS_WOUT) + (size_t)(64 * j) * D; }
    else if (j < 296) { j -= 208; const int t = j >> 2, q = j & 3; src = (q < 2 ? a.in[9] : a.in[10]) + 128 * t + 64 * (q & 1); ldw = FFD; K = D; dst = (bf16_t*)(ws + WS_WGU) + (size_t)(64 * j) * D;
        g = ln_g; bb = ln_b; cs = vec + VEC_GU_CS + 64 * j; bw = vec + VEC_GU_BW + 64 * j; }
    else if (j < 344) { j -= 296; src = j < 32 ? a.in[6] + 64 * j : a.in[7] + 64 * (j - 32); ldw = j < 32 ? 2048 : 1024; K = D; dst = (bf16_t*)(ws + WS_WKVQ) + (size_t)(64 * j) * D;
        g = ln_g + 1024; bb = ln_b + 1024; cs = vec + VEC_KVQ_CS + 64 * j; bw = vec + VEC_KVQ_BW + 64 * j; }
    else if (j < 360) { j -= 344; src = a.in[8] + 64 * j; ldw = D; K = D; dst = (bf16_t*)(ws + WS_WO) + (size_t)(64 * j) * D; }
    else { j -= 360; const int e = j / 112, jj = j % 112, t = jj >> 2, q = jj & 3; src = (q < 2 ? a.in[13] : a.in[14]) + (size_t)e * D * FFE + 128 * t + 64 * (q & 1); ldw = FFE; K = D;
        dst = (bf16_t*)(ws + WS_WEGU) + ((size_t)e * 2 * FFE + 64 * jj) * D; g = ln_g + 2048; bb = ln_b + 2048; cs = vec + VEC_EGU_CS + e * 2 * FFE + 64 * jj; bw = vec + VEC_EGU_BW + e * 2 * FFE + 64 * jj; }
    conv_block(lds, src, ldw, K, dst, g, bb, cs, bw);
}
constexpr int EGU0 = 360;
__device__ __forceinline__ void tail_jobs(LAS unsigned char* lds, const Args& a, int phase) {
    const int c = (int)blockIdx.x;
    int j0 = -1;
    if (phase == PH_PROJ) { const int q = c - 12;
        if (q >= 0) j0 = q < 16 ? 128 + q : (q < 184 ? 192 + (q - 16) : EGU0 + (q - 184)); }
    else if (phase == PH_WOUT) { const int q = c - 4; if (q >= 0) j0 = EGU0 + 60 + q; }
    else if (phase == PH_GU) { const int q = c - 22; if (q >= 0) j0 = EGU0 + 312 + q; }
    else if (phase == PH_DN) { const int q = c - 4;
        if (q >= 0 && q < 128) j0 = q;
        else if (q >= 128 && q - 128 < 106) j0 = EGU0 + 546 + (q - 128); }
    else { const int q = c - 12; if (q >= 0) j0 = EGU0 + 652 + q; }
    if (j0 >= 0) conv_job(lds, a, j0);
}
__device__ __forceinline__ void prologue_phase(LAS unsigned char* lds, const Args& a) {
    unsigned char* ws = a.ws;
    const int G = gridDim.x;
    for (int blk = 144 + blockIdx.x; blk < 192; blk += G) conv_job(lds, a, blk);
    {
        const int tid = threadIdx.x, lane = tid & 63, wid = tid >> 6;
        LAS float* wg = (LAS float*)lds;
        __syncthreads();
        const float* w_in = a.in[2];
        for (int i = tid; i < 8192; i += NTHREADS) { const int k = i >> 3, e = i & 7; wg[e * 1024 + k] = w_in[(size_t)k * 3080 + 3072 + e]; }
        __syncthreads();
        bf16_t* H0 = (bf16_t*)(ws + WS_RB); float* gates = (float*)(ws + WS_GATES);
        const float bg = a.in[3][lane & 7];
        const int c_ = (int)blockIdx.x;
        const int r_lo = (G == 256) ? (c_ < 48 ? 160 * c_ : 7680 + 280 * (c_ - 48)) : (int)(((long)NROWS * c_) / G);
        int r_hi = (G == 256) ? (c_ < 48 ? r_lo + 160 : r_lo + 280) : (int)(((long)NROWS * (c_ + 1)) / G); r_hi = r_hi < NROWS ? r_hi : NROWS;
#define PRO_SRC(r) ((r) < NR ? a.in[0] + (size_t)(r) * D : a.in[1] + (size_t)(((r) - NR) & 15) * D)
        f32x4 xa[4], xb[4], na[4], nb[4];
        { const int ra = (r_lo + wid) < r_hi ? (r_lo + wid) : 0, rb = (r_lo + wid + 8) < r_hi ? (r_lo + wid + 8) : ra; const float* sa = PRO_SRC(ra); const float* sb = PRO_SRC(rb);
#pragma unroll
            for (int i = 0; i < 4; ++i) { xa[i] = *(const f32x4*)(sa + i * 256 + lane * 4); xb[i] = *(const f32x4*)(sb + i * 256 + lane * 4); } }
        for (int row = r_lo + wid; row < r_hi; row += 16) {
            const bool hasb = (row + 8 < r_hi);
            { const int ra = (row + 16) < r_hi ? (row + 16) : row, rb = (row + 24) < r_hi ? (row + 24) : ra; const float* sa = PRO_SRC(ra); const float* sb = PRO_SRC(rb);
#pragma unroll
                for (int i = 0; i < 4; ++i) { na[i] = *(const f32x4*)(sa + i * 256 + lane * 4); nb[i] = *(const f32x4*)(sb + i * 256 + lane * 4); } }
            float acca[8] = {0.f, 0.f, 0.f, 0.f, 0.f, 0.f, 0.f, 0.f}, accb[8] = {0.f, 0.f, 0.f, 0.f, 0.f, 0.f, 0.f, 0.f};
#pragma unroll
            for (int i = 0; i < 4; ++i) {
                const int k = i * 256 + lane * 4;
                const f32x4 va = xa[i], vb = xb[i];
                *(u32x2*)(H0 + (size_t)row * D + k) = (u32x2){pk2(va[0], va[1]), pk2(va[2], va[3])};
                if (hasb) *(u32x2*)(H0 + (size_t)(row + 8) * D + k) = (u32x2){pk2(vb[0], vb[1]), pk2(vb[2], vb[3])};
#pragma unroll
                for (int e = 0; e < 8; ++e) { const f32x4 w = *(const LAS f32x4*)(wg + e * 1024 + k);
                    acca[e] += (va[0] * w[0] + va[1] * w[1]) + (va[2] * w[2] + va[3] * w[3]); accb[e] += (vb[0] * w[0] + vb[1] * w[1]) + (vb[2] * w[2] + vb[3] * w[3]); }
            }
#pragma unroll
            for (int i = 0; i < 4; ++i) { xa[i] = na[i]; xb[i] = nb[i]; }
#pragma unroll
            for (int e = 0; e < 8; ++e) { acca[e] = wave_total(acca[e]); accb[e] = wave_total(accb[e]); }
            float ma = acca[0], mb = accb[0];
#pragma unroll
            for (int e = 1; e < 8; ++e) { ma = ((lane & 7) == e) ? acca[e] : ma; mb = ((lane & 7) == e) ? accb[e] : mb; }
            if (lane < 8) { gates[(size_t)row * 8 + lane] = lane < 4 ? ma + bg : logsigmoid_(ma + bg); if (hasb) gates[(size_t)(row + 8) * 8 + lane] = lane < 4 ? mb + bg : logsigmoid_(mb + bg); }
        }
#undef PRO_SRC
        __syncthreads();
    }
}

__device__ __forceinline__ bf16x8 pack_frag(const f32x16& x, int s) {
    u32x4 p; p.x = pk2(x[8 * s], x[8 * s + 1]); p.y = pk2(x[8 * s + 2], x[8 * s + 3]); p.z = pk2(x[8 * s + 4], x[8 * s + 5]); p.w = pk2(x[8 * s + 6], x[8 * s + 7]);
    return __builtin_bit_cast(bf16x8, p);
}
__device__ __forceinline__ bf16x8 ld2x64(const LAS unsigned char* p0, const LAS unsigned char* p1) {
    const u32x2 a = *(const LAS u32x2*)p0, b = *(const LAS u32x2*)p1; u32x4 r = {a.x, a.y, b.x, b.y}; return __builtin_bit_cast(bf16x8, r);
}
__device__ __forceinline__ void tr4x4(const u32x2 (&r)[4], u32x2 (&c)[4]) {
    c[0] = (u32x2){(r[0].x & 0xffffu) | (r[1].x << 16), (r[2].x & 0xffffu) | (r[3].x << 16)};
    c[1] = (u32x2){(r[0].x >> 16) | (r[1].x & 0xffff0000u), (r[2].x >> 16) | (r[3].x & 0xffff0000u)};
    c[2] = (u32x2){(r[0].y & 0xffffu) | (r[1].y << 16), (r[2].y & 0xffffu) | (r[3].y << 16)};
    c[3] = (u32x2){(r[0].y >> 16) | (r[1].y & 0xffff0000u), (r[2].y >> 16) | (r[3].y & 0xffff0000u)};
}

constexpr int ML_QS = 0, ML_KS = 17408, ML_PS = 34816, ML_VT = 44032, ML_KT = 78848, ML_SC = 96256, ML_HS = 100352;
#ifndef ML_N0
#define ML_N0 28
#define ML_N1 18
#define ML_N2 12
#endif
__device__ __forceinline__ void mlstm_phase(LAS unsigned char* lds, const bf16_t* qkvo, const float* gates, const float* normg, bf16_t* hn, int unit_) {
    const int unit = (unit_ & 7) * 8 + (unit_ >> 5), part_ = (unit_ >> 3) & 3;
    const int c_begin = part_ == 0 ? 0 : (part_ == 1 ? ML_N0 : (part_ == 2 ? ML_N0 + ML_N1 : ML_N0 + ML_N1 + ML_N2));
    const int c_end = part_ == 0 ? ML_N0 : (part_ == 1 ? ML_N0 + ML_N1 : (part_ == 2 ? ML_N0 + ML_N1 + ML_N2 : 65));
    const int tid = threadIdx.x, lane = tid & 63, wid = __builtin_amdgcn_readfirstlane(tid >> 6);
    const int b = unit >> 2, h = unit & 3;
    const int r32 = lane & 31, hh = lane >> 5, l15 = lane & 15, l4 = lane >> 4;
    LAS float* sc = (LAS float*)(lds + ML_SC);
    const int q_row = tid >> 4, q_col = (tid & 15) * 8;
    const int k_dk = (16 * (wid & 1) + l15) * 4, k_s = (4 * (wid >> 1) + l4) * 4;
    const int v_dv = (16 * (wid & 3) + l15) * 4, v_s0 = (4 * (wid >> 2) + l4) * 4;
    f32x16 Cacc[4];
#pragma unroll
    for (int i = 0; i < 4; ++i)
#pragma unroll
        for (int j = 0; j < 16; ++j) Cacc[i][j] = 0.f;
    if (tid < 256) sc[192 + tid] = 0.f;
    float m_run = 0.f;
    u32x4 qreg[2]; u32x2 kreg[4], vreg[2][4]; float g_li = 0.f, g_lf = 0.f;
#define rowof(c, t) ((c) == 0 ? (NR + b * 16 + ((t) - 48)) : (b * SEQ + 64 * ((c) - 1) + (t)))
#define ML_PREFETCH_Q(c) do { \
        if ((c) >= c_begin) _Pragma("unroll") for (int p = 0; p < 2; ++p) { const int t = q_row + 32 * p; const bool pad = ((c) == 0 && t < 48); \
            qreg[p] = pad ? (u32x4){0u, 0u, 0u, 0u} : *(const u32x4*)(qkvo + (size_t)rowof((c), t) * NPROJ + h * 128 + q_col); } } while (0)
#define ML_PREFETCH(c) do { \
        _Pragma("unroll") for (int kk = 0; kk < 4; ++kk) { const int t = k_s + kk; const bool pad = ((c) == 0 && t < 48); \
            kreg[kk] = pad ? (u32x2){0u, 0u} : *(const u32x2*)(qkvo + (size_t)rowof((c), t) * NPROJ + 512 + h * 128 + k_dk); } \
        _Pragma("unroll") for (int p = 0; p < 2; ++p) _Pragma("unroll") for (int kk = 0; kk < 4; ++kk) { const int t = v_s0 + 32 * p + kk; const bool pad = ((c) == 0 && t < 48); \
            vreg[p][kk] = pad ? (u32x2){0u, 0u} : *(const u32x2*)(qkvo + (size_t)rowof((c), t) * NPROJ + 1024 + h * 256 + v_dv); } \
        { const bool pad = ((c) == 0 && lane < 48); g_li = pad ? -1e30f : gates[(size_t)rowof((c), lane) * 8 + h]; g_lf = pad ? 0.f : gates[(size_t)rowof((c), lane) * 8 + 4 + h]; } } while (0)
    float av, Mt, winter, bmt, wlast, decay, m_next;
#define ML_SCALARS() do { const float bc_ = scan_add64(g_lf); av = g_li - bc_; const float um_ = scan_max64(av); Mt = fmaxf(m_run, um_); \
        winter = __expf(m_run - Mt); bmt = bc_ + Mt; const float M63_ = lane63(Mt), b63_ = lane63(bc_); wlast = __expf(av - M63_); decay = __expf(m_run - M63_); m_next = b63_ + M63_; } while (0)
#define ML_IMAGE(FULL) do { \
        if (FULL) { _Pragma("unroll") for (int p = 0; p < 2; ++p) *(LAS u32x4*)(lds + ML_QS + (q_row + 32 * p) * 272 + q_col * 2) = qreg[p]; } \
        { u32x2 kw[4]; \
            _Pragma("unroll") for (int kk = 0; kk < 4; ++kk) { \
                if (FULL) *(LAS u32x2*)(lds + ML_KS + (k_s + kk) * 272 + k_dk * 2) = kreg[kk]; \
                const float w = __shfl(wlast, k_s + kk) * 0.08838834764831845f; \
                kw[kk] = (u32x2){pk2(bflo(kreg[kk].x) * w, bfhi(kreg[kk].x) * w), pk2(bflo(kreg[kk].y) * w, bfhi(kreg[kk].y) * w)}; } \
            u32x2 kc[4]; tr4x4(kw, kc); \
            _Pragma("unroll") for (int j = 0; j < 4; ++j) *(LAS u32x2*)(lds + ML_KT + (k_dk + j) * 136 + k_s * 2) = kc[j]; } \
        _Pragma("unroll") for (int p = 0; p < 2; ++p) { u32x2 vc[4]; tr4x4(vreg[p], vc); \
            _Pragma("unroll") for (int j = 0; j < 4; ++j) *(LAS u32x2*)(lds + ML_VT + (v_dv + j) * 136 + (v_s0 + 32 * p) * 2) = vc[j]; } \
        if (wid == 0) { sc[lane] = winter; sc[128 + lane] = bmt; } } while (0)
#define ML_PTILES() do { const int ti = wid >> 1; \
        _Pragma("unroll") for (int q = 0; q < 2; ++q) { const int si = 2 * (wid & 1) + q; f32x4 sa = {0.f, 0.f, 0.f, 0.f}; \
            if (si <= ti) { _Pragma("unroll") for (int ks = 0; ks < 4; ++ks) { \
                    const bf16x8 af = *(const LAS bf16x8*)(lds + ML_QS + (16 * ti + l15) * 272 + (32 * ks + 8 * l4) * 2); \
                    const bf16x8 bfr = *(const LAS bf16x8*)(lds + ML_KS + (16 * si + l15) * 272 + (32 * ks + 8 * l4) * 2); \
                    sa = __builtin_amdgcn_mfma_f32_16x16x32_bf16(af, bfr, sa, 0, 0, 0); } } \
            const int s = 16 * si + l15; const float a_s = __shfl(av, s); \
            _Pragma("unroll") for (int r = 0; r < 4; ++r) { const int t = 16 * ti + 4 * l4 + r; const float Mtt = __shfl(Mt, t); \
                const float w = (s <= t) ? __expf(a_s - Mtt) : 0.f; \
                *(LAS bf16_t*)(lds + ML_PS + t * 144 + s * 2) = f2bf(sa[r] * 0.08838834764831845f * w); } } } while (0)
    bf16x8 vf[4];
#define ML_VFRAGS() do { _Pragma("unroll") for (int ks = 0; ks < 4; ++ks) { const LAS unsigned char* p_ = lds + ML_VT + (32 * wid + r32) * 136 + (16 * ks + 8 * hh) * 2; vf[ks] = ld2x64(p_, p_ + 8); } } while (0)

    ML_PREFETCH(0); ML_PREFETCH_Q(0);
    ML_SCALARS();
    { const bool f0 = (0 >= c_begin); if (f0) ML_IMAGE(true); else ML_IMAGE(false); }
    __syncthreads();
    if (1 < c_end) ML_PREFETCH(1);
    if (0 >= c_begin) ML_PTILES();
    ML_VFRAGS();
    __syncthreads();
    for (int c = 0; c < c_end; ++c) {
        const bool full = (c >= c_begin), has_n = (c + 1 < c_end), full_n = (c + 1 >= c_begin);
        const float decay_c = decay;
        const int nb = c & 1;
        if (full) {
            {
                const int t = tid >> 3, part = tid & 7;
                float qn = 0.f, ps = 0.f;
                const u32x4 q0 = *(const LAS u32x4*)(lds + ML_QS + t * 272 + part * 32), q1 = *(const LAS u32x4*)(lds + ML_QS + t * 272 + part * 32 + 16);
                float qv[16]; { float t8[8]; g8::unpack8(q0, t8);
#pragma unroll
                    for (int j = 0; j < 8; ++j) qv[j] = t8[j]; g8::unpack8(q1, t8);
#pragma unroll
                    for (int j = 0; j < 8; ++j) qv[8 + j] = t8[j]; }
#pragma unroll
                for (int j = 0; j < 16; ++j) qn += qv[j] * sc[192 + 128 * nb + part * 16 + j];
                const u32x4 pw = *(const LAS u32x4*)(lds + ML_PS + t * 144 + part * 16);
                float pv[8]; g8::unpack8(pw, pv);
#pragma unroll
                for (int j = 0; j < 8; ++j) ps += pv[j];
                qn += __shfl_xor(qn, 1); qn += __shfl_xor(qn, 2); qn += __shfl_xor(qn, 4);
                ps += __shfl_xor(ps, 1); ps += __shfl_xor(ps, 2); ps += __shfl_xor(ps, 4);
                if (part == 0) { const float den = sc[t] * qn + ps; sc[64 + t] = __builtin_amdgcn_rcpf(fmaxf(fabsf(den), __expf(-sc[128 + t]))); }
            }
#pragma unroll
            for (int tt = 0; tt < 2; ++tt) {
                f32x16 num;
#pragma unroll
                for (int j = 0; j < 16; ++j) num[j] = 0.f;
#pragma unroll
                for (int dkt = 0; dkt < 4; ++dkt)
#pragma unroll
                    for (int s2 = 0; s2 < 2; ++s2) {
                        const LAS unsigned char* p = lds + ML_QS + (32 * tt + r32) * 272 + (32 * dkt + 16 * s2 + 4 * hh) * 2;
                        num = __builtin_amdgcn_mfma_f32_32x32x16_bf16(ld2x64(p, p + 16), pack_frag(Cacc[dkt], s2), num, 0, 0, 0);
                    }
#pragma unroll
                for (int gq = 0; gq < 4; ++gq) { const f32x4 wv = *(const LAS f32x4*)(sc + 32 * tt + 8 * gq + 4 * hh);
#pragma unroll
                    for (int r = 0; r < 4; ++r) num[4 * gq + r] *= wv[r]; }
#pragma unroll
                for (int ks = 0; ks < 4; ++ks) {
                    if (tt == 0 && ks >= 2) continue;
                    const bf16x8 pf = *(const LAS bf16x8*)(lds + ML_PS + (32 * tt + r32) * 144 + (16 * ks + 8 * hh) * 2);
                    num = __builtin_amdgcn_mfma_f32_32x32x16_bf16(pf, vf[ks], num, 0, 0, 0);
                }
#pragma unroll
                for (int j = 0; j < 16; ++j) *(LAS bf16_t*)(lds + ML_HS + (32 * tt + (j & 3) + 8 * (j >> 2) + 4 * hh) * 528 + (32 * wid + r32) * 2) = f2bf(num[j]);
            }
        }
#pragma unroll
        for (int dkt = 0; dkt < 4; ++dkt) {
#pragma unroll
            for (int j = 0; j < 16; ++j) Cacc[dkt][j] *= decay_c;
#pragma unroll
            for (int ks = 0; ks < 4; ++ks) { const LAS unsigned char* p = lds + ML_KT + (32 * dkt + r32) * 136 + (16 * ks + 8 * hh) * 2;
                Cacc[dkt] = __builtin_amdgcn_mfma_f32_32x32x16_bf16(ld2x64(p, p + 8), vf[ks], Cacc[dkt], 0, 0, 0); }
        }
        {
            const int dk = tid >> 2, part = tid & 3;
            const u32x2 k0 = *(const LAS u32x2*)(lds + ML_KT + dk * 136 + part * 32), k1 = *(const LAS u32x2*)(lds + ML_KT + dk * 136 + part * 32 + 8),
                        k2 = *(const LAS u32x2*)(lds + ML_KT + dk * 136 + part * 32 + 16), k3 = *(const LAS u32x2*)(lds + ML_KT + dk * 136 + part * 32 + 24);
            float sk = ((bflo(k0.x) + bfhi(k0.x)) + (bflo(k0.y) + bfhi(k0.y))) + ((bflo(k1.x) + bfhi(k1.x)) + (bflo(k1.y) + bfhi(k1.y)))
                     + ((bflo(k2.x) + bfhi(k2.x)) + (bflo(k2.y) + bfhi(k2.y))) + ((bflo(k3.x) + bfhi(k3.x)) + (bflo(k3.y) + bfhi(k3.y)));
            sk += __shfl_xor(sk, 1); sk += __shfl_xor(sk, 2);
            if (part == 0) sc[192 + 128 * (nb ^ 1) + dk] = decay_c * sc[192 + 128 * nb + dk] + sk;
        }
        if (has_n) ML_PREFETCH_Q(c + 1);
        __syncthreads();
        m_run = m_next;
        if (has_n) ML_SCALARS();
        u32x2 oreg[8];
        if (full) { const int t = tid >> 3, part = tid & 7; const bool pad = (c == 0 && t < 48); const size_t row = pad ? 0 : (size_t)rowof(c, t);
#pragma unroll
            for (int i = 0; i < 8; ++i) oreg[i] = *(const u32x2*)(qkvo + row * NPROJ + 2048 + h * 256 + 32 * i + 4 * part); }
        if (full) {
            const int t = tid >> 3, part = tid & 7;
            const float iv = sc[64 + t];
            f32x4 x[8]; float s1 = 0.f;
#pragma unroll
            for (int i = 0; i < 8; ++i) { const u32x2 hw = *(const LAS u32x2*)(lds + ML_HS + t * 528 + (32 * i + 4 * part) * 2);
                x[i] = (f32x4){bflo(hw.x) * iv, bfhi(hw.x) * iv, bflo(hw.y) * iv, bfhi(hw.y) * iv}; s1 += (x[i][0] + x[i][1]) + (x[i][2] + x[i][3]); }
            s1 += __shfl_xor(s1, 1); s1 += __shfl_xor(s1, 2); s1 += __shfl_xor(s1, 4);
            const float mean = s1 * (1.0f / 256.0f); float s2 = 0.f;
#pragma unroll
            for (int i = 0; i < 8; ++i) { const f32x4 d = x[i] - mean; s2 += (d[0] * d[0] + d[1] * d[1]) + (d[2] * d[2] + d[3] * d[3]); }
            s2 += __shfl_xor(s2, 1); s2 += __shfl_xor(s2, 2); s2 += __shfl_xor(s2, 4);
            const float rstd = rsqrtf(s2 * (1.0f / 256.0f) + LN_EPS);
            if (!(c == 0 && t < 48)) {
                const size_t row = (size_t)rowof(c, t);
#pragma unroll
                for (int i = 0; i < 8; ++i) {
                    const int dv = 32 * i + 4 * part;
                    const u32x2 ow = oreg[i];
                    const f32x4 ng = *(const f32x4*)(normg + h * 256 + dv);
                    const float o0 = sigmoidf_(bflo(ow.x)), o1 = sigmoidf_(bfhi(ow.x)), o2 = sigmoidf_(bflo(ow.y)), o3 = sigmoidf_(bfhi(ow.y));
                    const f32x4 y = (x[i] - mean) * rstd * ng;
                    *(u32x2*)(hn + row * D + h * 256 + dv) = (u32x2){pk2(y[0] * o0, y[1] * o1), pk2(y[2] * o2, y[3] * o3)};
                }
            }
        }
        if (!has_n) break;
        if (full_n) ML_IMAGE(true); else ML_IMAGE(false);
        if (c + 2 < c_end) ML_PREFETCH(c + 2);
        __syncthreads();
        if (full_n) ML_PTILES();
        ML_VFRAGS();
        if (full_n) __syncthreads();
    }
    __syncthreads();
#undef ML_PREFETCH
#undef ML_PREFETCH_Q
#undef ML_SCALARS
#undef ML_IMAGE
#undef ML_PTILES
#undef ML_VFRAGS
#undef rowof
}

constexpr float AT_PMIN = 1e-15f;
constexpr int AT_K0 = 0, AT_V0 = 17408, AT_BUF = 34816, AT_FLAGS = 2 * AT_BUF;
__device__ __forceinline__ void at_tile(const LAS unsigned char* Kb, const LAS unsigned char* Vb, int k0, int tmin, int r32, int hh, const bf16x8 (&qf)[8], f32x16 (&O)[4], float& P) {
    f32x16 S[2];
#pragma unroll
    for (int u = 0; u < 2; ++u) {
#pragma unroll
        for (int j = 0; j < 16; ++j) S[u][j] = 0.f;
#pragma unroll
        for (int ks = 0; ks < 8; ++ks) {
            const bf16x8 kf = *(const LAS bf16x8*)(Kb + (32 * u + r32) * 272 + (16 * ks + 8 * hh) * 2);
            S[u] = __builtin_amdgcn_mfma_f32_32x32x16_bf16(kf, qf[ks], S[u], 0, 0, 0);
        }
    }
    const bool full = (k0 + 63 < tmin) && (k0 >= 128);
    const int lim = tmin + r32 - k0 - 4 * hh;
    const int lo = 112 - k0 - 4 * hh;
    float Tt[2][4];
#define AT_ELEM(MASKED) \
    _Pragma("unroll") for (int u = 0; u < 2; ++u) _Pragma("unroll") for (int gq = 0; gq < 4; ++gq) { \
        float x4[4]; \
        _Pragma("unroll") for (int r = 0; r < 4; ++r) { \
            float zz = S[u][4 * gq + r] * (0.08838834764831845f * 1.4426950408889634f); \
            if (MASKED) { const int o = 32 * u + 8 * gq + r; zz = (o < lim && o >= lo) ? zz : -1.0e4f; } \
            const float rc = __builtin_amdgcn_rcpf(1.0f + __builtin_amdgcn_exp2f(zz)); \
            S[u][4 * gq + r] = 1.0f - rc; x4[r] = rc; } \
        const float e2 = x4[3], e1 = e2 * x4[2], e0 = e1 * x4[1]; \
        Tt[u][gq] = e0 * x4[0]; \
        S[u][4 * gq + 2] *= e2; S[u][4 * gq + 1] *= e1; S[u][4 * gq + 0] *= e0; }
    if (full) { AT_ELEM(false) } else { AT_ELEM(true) }
#undef AT_ELEM
    float acc = P;
#pragma unroll
    for (int u = 1; u >= 0; --u)
#pragma unroll
        for (int gq = 3; gq >= 0; --gq) {
            float t0; const float t1 = swap32_hi(Tt[u][gq], t0);
            const float Rr = hh ? acc : acc * t1;
            acc = (acc * t1) * t0;
#pragma unroll
            for (int r = 0; r < 4; ++r) S[u][4 * gq + r] *= Rr;
        }
    P = acc;
#pragma unroll
    for (int u = 0; u < 2; ++u)
#pragma unroll
        for (int s2 = 0; s2 < 2; ++s2) {
            const bf16x8 af = pack_frag(S[u], s2);
#pragma unroll
            for (int dt = 0; dt < 4; ++dt) {
                const LAS unsigned char* p = Vb + (32 * dt + r32) * 136 + (32 * u + 16 * s2 + 4 * hh) * 2;
                O[dt] = __builtin_amdgcn_mfma_f32_32x32x16_bf16(af, ld2x64(p, p + 16), O[dt], 0, 0, 0);
            }
        }
}
__device__ __forceinline__ void attn_phase(LAS unsigned char* lds, const bf16_t* kvq, bf16_t* ao) {
    const int tid = threadIdx.x, lane = tid & 63, wid = __builtin_amdgcn_readfirstlane(tid >> 6);
    const int r32 = lane & 31, hh = lane >> 5, l15 = lane & 15, l4 = lane >> 4;
    LAS unsigned* flags = (LAS unsigned*)(lds + AT_FLAGS);
    const int k_row = tid >> 4, k_col = (tid & 15) * 8;
    const int v_d = (16 * (wid & 1) + l15) * 4, v_s = (4 * (wid >> 1) + l4) * 4;
    for (int ui_ = 0; ui_ < (NB * 8 * 16) / 256; ++ui_) {
        const int xq = blockIdx.x & 7, jq = blockIdx.x >> 3, strm = (ui_ * 8 + xq) * 2 + (jq >> 4);
        const int qt = jq & 15, head = strm & 7, b = strm >> 3;
        const int q0 = 128 + 256 * qt, tmin = q0 + 32 * wid;
#define rowofp(p) ((p) >= 128 ? b * SEQ + (p) - 128 : ((p) >= 112 ? NR + b * 16 + (p) - 112 : NR + b * 16))
        bf16x8 qf[8];
        { const bf16_t* qp = kvq + (size_t)(b * SEQ + tmin - 128 + r32) * NPROJ + 2048 + head * 128 + 8 * hh;
#pragma unroll
            for (int ks = 0; ks < 8; ++ks) qf[ks] = *(const bf16x8*)(qp + 16 * ks); }
        f32x16 O[4];
#pragma unroll
        for (int i = 0; i < 4; ++i)
#pragma unroll
            for (int j = 0; j < 16; ++j) O[i][j] = 0.f;
        float P = 1.0f;
        const int kt_hi = (q0 >> 6) + 3;
        u32x4 kregA[2], kregB[2]; u32x2 vregA[4], vregB[4];
#define AT_LOAD(kreg, vreg, kt) do { \
        _Pragma("unroll") for (int p = 0; p < 2; ++p) kreg[p] = *(const u32x4*)(kvq + (size_t)rowofp(64 * (kt) + k_row + 32 * p) * NPROJ + head * 128 + k_col); \
        _Pragma("unroll") for (int kk = 0; kk < 4; ++kk) vreg[kk] = *(const u32x2*)(kvq + (size_t)rowofp(64 * (kt) + v_s + kk) * NPROJ + 1024 + head * 128 + v_d); } while (0)
#define AT_STORE(kreg, vreg, buf) do { LAS unsigned char* base = lds + (buf) * AT_BUF; \
        _Pragma("unroll") for (int p = 0; p < 2; ++p) *(LAS u32x4*)(base + AT_K0 + (k_row + 32 * p) * 272 + k_col * 2) = kreg[p]; \
        u32x2 vc[4]; tr4x4(vreg, vc); \
        _Pragma("unroll") for (int j = 0; j < 4; ++j) *(LAS u32x2*)(base + AT_V0 + (v_d + j) * 136 + v_s * 2) = vc[j]; } while (0)
#define AT_ITER(BUF, LOADSET_K, LOADSET_V, STORESET_K, STORESET_V) { \
            const int kt = kt_hi - it; \
            __syncthreads(); \
            if (it > 0 && flags[it - 1] == 0u) break; \
            if (kt - 2 >= 1) AT_LOAD(LOADSET_K, LOADSET_V, kt - 2); \
            if (64 * kt < tmin + 31 && __ballot(P >= AT_PMIN) != 0ull) at_tile(lds + (BUF) * AT_BUF + AT_K0, lds + (BUF) * AT_BUF + AT_V0, 64 * kt, tmin, r32, hh, qf, O, P); \
            if (__ballot(P >= AT_PMIN) != 0ull && lane == 0) flags[it] = 1u; \
            if (kt - 1 < 1) break; \
            AT_STORE(STORESET_K, STORESET_V, 1 - (BUF)); \
            ++it; }
        if (tid < 80) flags[tid] = 0u;
        AT_LOAD(kregA, vregA, kt_hi);
        AT_STORE(kregA, vregA, 0);
        AT_LOAD(kregB, vregB, kt_hi - 1);
        for (int it = 0; ; ) {
            AT_ITER(0, kregA, vregA, kregB, vregB)
            AT_ITER(1, kregB, vregB, kregA, vregA)
        }
#pragma unroll
        for (int dt = 0; dt < 4; ++dt)
#pragma unroll
            for (int j = 0; j < 16; ++j) {
                const int t = tmin + (j & 3) + 8 * (j >> 2) + 4 * hh;
                ao[(size_t)(b * SEQ + t - 128) * D + head * 128 + 32 * dt + r32] = f2bf(O[dt][j]);
            }
        __syncthreads();
    }
#undef AT_LOAD
#undef AT_STORE
#undef AT_ITER
#undef rowofp
}

__device__ __forceinline__ void ln_row_stats_wave(const float* st, int row, int lane, float& mu, float& rstd) {
    const f32x2 p = *(const f32x2*)(st + (size_t)row * 32 + (lane & 15) * 2);
    float s1 = p[0], s2 = p[1];
#pragma unroll
    for (int o = 1; o < 16; o <<= 1) { s1 += __shfl_xor(s1, o); s2 += __shfl_xor(s2, o); }
    mu = s1 * (1.0f / 1024.0f); const float var = fmaxf(s2 * (1.0f / 1024.0f) - mu * mu, 0.f); rstd = rsqrtf(var + LN_EPS);
}
__device__ __forceinline__ void router1_phase(LAS unsigned char* lds, const Args& a) {
    const int tid = threadIdx.x, lane = tid & 63, wid = tid >> 6;
    unsigned char* ws = a.ws;
    const float* g3 = a.in[16] + 2048; const float* b3 = a.in[17] + 2048; const float* wr = a.in[12];
    LAS float* gw = (LAS float*)lds;
    LAS float* cc = (LAS float*)(lds + 32768);
    LAS int* cnt = (LAS int*)(lds + 32768 + 64);
    __syncthreads();
    for (int i = tid; i < 8192; i += NTHREADS) { const int k = i >> 3, e = i & 7; gw[e * 1024 + k] = g3[k] * wr[i]; }
    if (tid < 8) cnt[tid] = 0;
    __syncthreads();
    { float s1 = 0.f, s2 = 0.f;
        for (int k = lane; k < 1024; k += 64) { s1 += gw[wid * 1024 + k]; s2 += b3[k] * wr[k * 8 + wid]; }
        s1 = wave_sum(s1); s2 = wave_sum(s2);
        if (lane == 0) { cc[wid] = s1; cc[8 + wid] = s2; } }
    __syncthreads();
    const bf16_t* z3 = (const bf16_t*)(ws + WS_RC); const float* st3 = (const float*)(ws + WS_ST3);
    f32x4* route = (f32x4*)(ws + WS_ROUTE);
    const int tok0 = (int)(((long)NR * blockIdx.x) / gridDim.x), tok1 = (int)(((long)NR * (blockIdx.x + 1)) / gridDim.x);
    u32x4 zrA[2], zrB[2]; f32x2 spA, spB;
#define RT_LOAD2(t) do { const int tb_ = ((t) + 8 < tok1) ? (t) + 8 : (t); \
        zrA[0] = *(const u32x4*)(z3 + (size_t)(t) * D + lane * 8); zrA[1] = *(const u32x4*)(z3 + (size_t)(t) * D + 512 + lane * 8); spA = *(const f32x2*)(st3 + (size_t)(t) * 32 + (lane & 15) * 2); \
        zrB[0] = *(const u32x4*)(z3 + (size_t)tb_ * D + lane * 8); zrB[1] = *(const u32x4*)(z3 + (size_t)tb_ * D + 512 + lane * 8); spB = *(const f32x2*)(st3 + (size_t)tb_ * 32 + (lane & 15) * 2); } while (0)
#define RT_FINISH(tk, acc, mu, rstd) do { float lg[8]; \
        _Pragma("unroll") for (int e = 0; e < 8; ++e) lg[e] = (rstd) * (wave_total(acc[e]) - (mu) * cc[e]) + cc[8 + e]; \
        int e1 = 0; float v1 = lg[0]; \
        _Pragma("unroll") for (int e = 1; e < 8; ++e) if (lg[e] > v1) { v1 = lg[e]; e1 = e; } \
        int e2 = -1; float v2 = -3.0e38f; \
        _Pragma("unroll") for (int e = 0; e < 8; ++e) if (e != e1 && lg[e] > v2) { v2 = lg[e]; e2 = e; } \
        const float g1 = 1.0f / (1.0f + expf(v2 - v1)); \
        if (lane == 0) { ((f32x2*)(ws + WS_TOKST))[tk] = (f32x2){(mu), (rstd)}; route[tk] = (f32x4){__int_as_float(e1 | (e2 << 8)), g1, 1.0f - g1, 0.f}; \
            __hip_atomic_fetch_add(&cnt[e1], 1, __ATOMIC_RELAXED, __HIP_MEMORY_SCOPE_WORKGROUP); __hip_atomic_fetch_add(&cnt[e2], 1, __ATOMIC_RELAXED, __HIP_MEMORY_SCOPE_WORKGROUP); } } while (0)
    if (tok0 + wid < tok1) RT_LOAD2(tok0 + wid);
    for (int tok = tok0 + wid; tok < tok1; tok += 16) {
        const u32x4 zA[2] = {zrA[0], zrA[1]}, zB[2] = {zrB[0], zrB[1]}; const f32x2 sA = spA, sB = spB;
        if (tok + 16 < tok1) RT_LOAD2(tok + 16);
        float a1 = sA[0], a2 = sA[1], b1 = sB[0], b2 = sB[1];
#pragma unroll
        for (int o = 1; o < 16; o <<= 1) { a1 += __shfl_xor(a1, o); a2 += __shfl_xor(a2, o); b1 += __shfl_xor(b1, o); b2 += __shfl_xor(b2, o); }
        const float muA = a1 * (1.0f / 1024.0f), rsA = rsqrtf(fmaxf(a2 * (1.0f / 1024.0f) - muA * muA, 0.f) + LN_EPS);
        const float muB = b1 * (1.0f / 1024.0f), rsB = rsqrtf(fmaxf(b2 * (1.0f / 1024.0f) - muB * muB, 0.f) + LN_EPS);
        float accA[8] = {0.f, 0.f, 0.f, 0.f, 0.f, 0.f, 0.f, 0.f}, accB[8] = {0.f, 0.f, 0.f, 0.f, 0.f, 0.f, 0.f, 0.f};
#pragma unroll
        for (int hf = 0; hf < 2; ++hf) {
            const int k = hf * 512 + lane * 8;
            float za[8], zb[8]; g8::unpack8(zA[hf], za); g8::unpack8(zB[hf], zb);
#pragma unroll
            for (int e = 0; e < 8; ++e) { const f32x4 w0 = *(const LAS f32x4*)(gw + e * 1024 + k), w1 = *(const LAS f32x4*)(gw + e * 1024 + k + 4);
                accA[e] += ((za[0] * w0[0] + za[1] * w0[1]) + (za[2] * w0[2] + za[3] * w0[3])) + ((za[4] * w1[0] + za[5] * w1[1]) + (za[6] * w1[2] + za[7] * w1[3]));
                accB[e] += ((zb[0] * w0[0] + zb[1] * w0[1]) + (zb[2] * w0[2] + zb[3] * w0[3])) + ((zb[4] * w1[0] + zb[5] * w1[1]) + (zb[6] * w1[2] + zb[7] * w1[3])); }
        }
        RT_FINISH(tok, accA, muA, rsA);
        if (tok + 8 < tok1) RT_FINISH(tok + 8, accB, muB, rsB);
    }
#undef RT_LOAD2
#undef RT_FINISH
    __syncthreads();
    if (tid < 8) ((int*)(ws + WS_CNT))[blockIdx.x * 8 + tid] = cnt[tid];
}
__device__ __forceinline__ void router2_phase(LAS unsigned char* lds, const Args& a) {
    const int tid = threadIdx.x, lane = tid & 63, wid = tid >> 6;
    unsigned char* ws = a.ws;
    const int G = gridDim.x, wg = blockIdx.x;
    LAS int* cn = (LAS int*)lds;
    LAS int* tot = (LAS int*)(lds + 16384);
    u32x2* smeta = (u32x2*)(ws + WS_TOK); f32x2* sstat = (f32x2*)(ws + WS_GATEB); const f32x2* tokst = (const f32x2*)(ws + WS_TOKST);
    const f32x4* route = (const f32x4*)(ws + WS_ROUTE);
    const int tok0 = (int)(((long)NR * wg) / G), tok1 = (int)(((long)NR * (wg + 1)) / G);
    f32x4 rr[8]; f32x2 ts[8];
#pragma unroll
    for (int i = 0; i < 8; ++i) { int q = 2 * tok0 + 64 * i + lane; q = q < 2 * tok1 ? q : 2 * tok1 - 1; rr[i] = route[q >> 1]; ts[i] = tokst[q >> 1]; }
    __syncthreads();
    const int* cnts = (const int*)(ws + WS_CNT);
    for (int i = tid; i < G * 8; i += NTHREADS) cn[i] = cnts[i];
    __syncthreads();
    { int t = 0, p = 0;
        for (int w = lane; w < G; w += 64) { const int v = cn[w * 8 + wid]; t += v; p += (w < wg) ? v : 0; }
#pragma unroll
        for (int o = 32; o >= 1; o >>= 1) { t += __shfl_xor(t, o); p += __shfl_xor(p, o); }
        if (lane == 0) { tot[wid] = t; tot[8 + wid] = p; } }
    __syncthreads();
    if (tid == 0) { int ps = 0;
        for (int e = 0; e < 8; ++e) { tot[24 + e] = ps; tot[16 + e] = ps + tot[8 + e]; ps += ((tot[e] + 255) >> 8) << 8; }
        if (wg == 0) { int* hdr = (int*)(ws + WS_HDR); int pp = 0; for (int e = 0; e < 8; ++e) { pp += (tot[e] + 255) >> 8; hdr[e] = pp; } hdr[8] = pp; } }
    __syncthreads();
    { const int e = wid; int run = tot[16 + e];
#pragma unroll
        for (int i = 0; i < 8; ++i) {
            const int q = 2 * tok0 + 64 * i + lane; bool match = false; float gt = 0.f;
            if (q < 2 * tok1) { const f32x4 r = rr[i]; const int ee = __float_as_int(r[0]); const int ex = (q & 1) ? ((ee >> 8) & 0xff) : (ee & 0xff); match = (ex == e); gt = (q & 1) ? r[2] : r[1]; }
            const unsigned long long mask = __ballot(match);
            const int pos = __popcll(mask & ((1ull << lane) - 1ull));
            if (match) { smeta[run + pos] = (u32x2){(unsigned)q, __float_as_uint(gt)}; sstat[run + pos] = ts[i]; }
            run += __popcll(mask);
        }
        if (wg == 0) { const int s0 = tot[24 + e] + tot[e], s1 = tot[24 + e] + (((tot[e] + 255) >> 8) << 8);
            for (int s = s0 + lane; s < s1; s += 64) { smeta[s] = (u32x2){0xffffffffu, 0u}; sstat[s] = (f32x2){0.f, 1.f}; } }
    }
}

__device__ __forceinline__ float wave_total(float x);
__device__ __forceinline__ void final_phase(const Args& a) {
    const int tid = threadIdx.x, lane = tid & 63, wid = tid >> 6;
    unsigned char* ws = a.ws;
    const bf16_t* z3 = (const bf16_t*)(ws + WS_RC); const float* st3 = (const float*)(ws + WS_ST3);
    const bf16_t* Y0 = (const bf16_t*)(ws + WS_RB); const bf16_t* Y1 = (const bf16_t*)(ws + WS_RD);
    const float* g3 = a.in[16] + 2048; const float* b3 = a.in[17] + 2048; const float* g4 = a.in[16] + 3072; const float* b4 = a.in[17] + 3072;
    float G3[16], B3[16], G4[16], B4[16];
#pragma unroll
    for (int hf = 0; hf < 2; ++hf)
#pragma unroll
        for (int q = 0; q < 2; ++q) { const int k = hf * 512 + lane * 8 + q * 4;
            const f32x4 a3 = *(const f32x4*)(g3 + k), c3 = *(const f32x4*)(b3 + k), a4 = *(const f32x4*)(g4 + k), c4 = *(const f32x4*)(b4 + k);
#pragma unroll
            for (int j = 0; j < 4; ++j) { G3[hf * 8 + q * 4 + j] = a3[j] * ALPHA; B3[hf * 8 + q * 4 + j] = c3[j] * ALPHA; G4[hf * 8 + q * 4 + j] = a4[j]; B4[hf * 8 + q * 4 + j] = c4[j]; } }
    const int stride = gridDim.x * 8;
    int tok = blockIdx.x * 8 + wid;
    u32x4 zr[2], y0r[2], y1r[2]; f32x2 sp;
#define FIN_LOAD(t) do { _Pragma("unroll") for (int hf = 0; hf < 2; ++hf) { const size_t o = (size_t)(t) * D + hf * 512 + lane * 8; \
        zr[hf] = *(const u32x4*)(z3 + o); y0r[hf] = *(const u32x4*)(Y0 + o); y1r[hf] = *(const u32x4*)(Y1 + o); } \
        sp = *(const f32x2*)(st3 + (size_t)(t) * 32 + (lane & 15) * 2); } while (0)
    if (tok < NR) FIN_LOAD(tok);
    for (; tok < NR; tok += stride) {
        u32x4 zc[2] = {zr[0], zr[1]}, y0c[2] = {y0r[0], y0r[1]}, y1c[2] = {y1r[0], y1r[1]}; const f32x2 spc = sp;
        if (tok + stride < NR) FIN_LOAD(tok + stride);
        float s1 = spc[0], s2 = spc[1];
#pragma unroll
        for (int o = 1; o < 16; o <<= 1) { s1 += __shfl_xor(s1, o); s2 += __shfl_xor(s2, o); }
        const float mu = s1 * (1.0f / 1024.0f); const float rstd = rsqrtf(fmaxf(s2 * (1.0f / 1024.0f) - mu * mu, 0.f) + LN_EPS);
        float v[16]; float t1 = 0.f;
#pragma unroll
        for (int hf = 0; hf < 2; ++hf) {
            float z[8], y0[8], y1[8];
            g8::unpack8(zc[hf], z); g8::unpack8(y0c[hf], y0); g8::unpack8(y1c[hf], y1);
#pragma unroll
            for (int j = 0; j < 8; ++j) { const float x = ((z[j] - mu) * rstd * G3[hf * 8 + j] + B3[hf * 8 + j]) + (y0[j] + y1[j]); v[hf * 8 + j] = x; t1 += x; }
        }
        t1 = wave_total(t1); const float mean = t1 * (1.0f / 1024.0f); float t2 = 0.f;
#pragma unroll
        for (int j = 0; j < 16; ++j) { const float d = v[j] - mean; t2 += d * d; }
        t2 = wave_total(t2); const float rs = rsqrtf(t2 * (1.0f / 1024.0f) + LN_EPS);
#pragma unroll
        for (int hf = 0; hf < 2; ++hf) {
            const int k = hf * 512 + lane * 8;
            f32x4 o0, o1;
#pragma unroll
            for (int j = 0; j < 4; ++j) { o0[j] = (v[hf * 8 + j] - mean) * rs * G4[hf * 8 + j] + B4[hf * 8 + j]; o1[j] = (v[hf * 8 + 4 + j] - mean) * rs * G4[hf * 8 + 4 + j] + B4[hf * 8 + 4 + j]; }
            *(f32x4*)(a.out + (size_t)tok * D + k) = o0; *(f32x4*)(a.out + (size_t)tok * D + k + 4) = o1;
        }
    }
#undef FIN_LOAD
}

__device__ __forceinline__ void moefix_phase(const Args& a) {
    const int lane = threadIdx.x & 63, wid = threadIdx.x >> 6;
    unsigned char* ws = a.ws;
    const int npan = ((const int*)(ws + WS_HDR))[8];
    const int p_lo = (MOE_NCHUNK - 1) * MOE_CHUNK_PAN + MOE_CHUNK_PAN;
    const int nrows = (npan - p_lo) * 256;
    const u32x2* smeta = (const u32x2*)(ws + WS_TOK);
    const float* P = (const float*)(ws + WS_RA + RA_POFF);
    bf16_t* Y0 = (bf16_t*)(ws + WS_RB); bf16_t* Y1 = (bf16_t*)(ws + WS_RD);
    for (int r = blockIdx.x * 8 + wid; r < nrows; r += gridDim.x * 8) {
        const u32x2 mg = smeta[(size_t)p_lo * 256 + r];
        const int id = (int)mg.x; const float gt = __uint_as_float(mg.y);
        if (id < 0) continue;
        bf16_t* yrow = ((id & 1) ? Y1 : Y0) + (size_t)(id >> 1) * D;
#pragma unroll
        for (int hf = 0; hf < 2; ++hf) {
            const int c = hf * 512 + lane * 8;
            f32x4 s0 = {0.f, 0.f, 0.f, 0.f}, s1 = {0.f, 0.f, 0.f, 0.f};
#pragma unroll
            for (int ks = 0; ks < MOE_KSPLIT; ++ks) { const float* pp = P + ((size_t)ks * 2048 + r) * D + c; s0 += *(const f32x4*)pp; s1 += *(const f32x4*)(pp + 4); }
            *(u32x4*)(yrow + c) = g8::pack8(s0 * gt, s1 * gt);
        }
    }
}
__device__ __forceinline__ void finstats_phase(const float* st, float* rs, int nrows) {
    for (int row = blockIdx.x * NTHREADS + threadIdx.x; row < nrows; row += gridDim.x * NTHREADS) {
        const f32x4* p = (const f32x4*)(st + (size_t)row * 32);
        float s1 = 0.f, s2 = 0.f;
#pragma unroll
        for (int i = 0; i < 8; ++i) { const f32x4 a = p[i]; s1 += a[0] + a[2]; s2 += a[1] + a[3]; }
        const float mu = s1 * (1.0f / 1024.0f); const float rstd = rsqrtf(fmaxf(s2 * (1.0f / 1024.0f) - mu * mu, 0.f) + LN_EPS);
        *(f32x2*)(rs + (size_t)row * 2) = (f32x2){mu, rstd};
    }
}
__global__ void __launch_bounds__(NTHREADS, 2) yoco_fwd(Args args) {
    extern __shared__ __attribute__((aligned(16))) unsigned char lds_raw[];
    LAS unsigned char* lds = (LAS unsigned char*)lds_raw;
    unsigned char* ws = args.ws;
    const int G = gridDim.x;
    const int lo = args.ph_lo, hi = args.ph_hi;
    volatile LAS unsigned* misc = (volatile LAS unsigned*)(lds + LDS_MISC);
    if (threadIdx.x < 4) misc[threadIdx.x] = 0u;
    __syncthreads();
    XcdBarrier bar; bar.bar = (unsigned*)(ws + WS_CTL); bar.x = 0; bar.st = misc;
    if (hi - lo > 1) bar = xcd_barrier_post((unsigned*)(ws + WS_CTL), misc);
    if (PROBE_T >= 0 && blockIdx.x == 0 && threadIdx.x == 0) __hip_atomic_store((unsigned long long*)(ws + WS_DIAG + 32), 0ull, __ATOMIC_RELAXED, __HIP_MEMORY_SCOPE_AGENT);
#ifndef PHASE_MASK
#define PHASE_MASK 0xFFFFFFFFu
#endif
#define IN(k) (((PHASE_MASK >> (k)) & 1u) && lo <= (k) && (k) < hi)
#define SEAM(k) do { if (IN(k) && IN((k) + 1)) xcd_barrier(bar); } while (0)
    bf16_t* RA = (bf16_t*)(ws + WS_RA); bf16_t* RB = (bf16_t*)(ws + WS_RB); bf16_t* RC = (bf16_t*)(ws + WS_RC); bf16_t* RD = (bf16_t*)(ws + WS_RD);
    float* vec = (float*)(ws + WS_VEC);
    float* st1 = (float*)(ws + WS_ST1); float* st2 = (float*)(ws + WS_ST2); float* st3 = (float*)(ws + WS_ST3);
    const float* ln_g = args.in[16]; const float* ln_b = args.in[17];

#define RUN(k, ...) do { if constexpr (((REPMASK) >> (k)) & 1u) { if (IN(k)) { __VA_ARGS__ } xcd_barrier(bar); } \
        if ((k) == PROBE_T && threadIdx.x == 0) ((volatile long long*)(ws + WS_DIAG + 1024))[blockIdx.x] = wall_clock64(); \
        if (IN(k)) { __VA_ARGS__ } \
        if ((k) == PROBE_T && threadIdx.x == 0) { const long long dt_ = wall_clock64() - ((volatile long long*)(ws + WS_DIAG + 1024))[blockIdx.x]; if (PROBE_WG < 0 || (int)blockIdx.x == PROBE_WG) atomicMax((unsigned long long*)(ws + WS_DIAG + 32), (unsigned long long)dt_); } \
        SEAM(k); } while (0)
    RUN(PH_PRO, prologue_phase(lds, args););
    RUN(PH_PROJ,
        g8::Gemm g{RB, (const bf16_t*)(ws + WS_WIN), D, nullptr, nullptr, nullptr}; g8::DenseOrder S; S.init(NPAN, NPROJ / 256, D, G, (int)blockIdx.x);
        g8::EpiPlain E{RA, NPROJ};
        g8::gemm_phase<g8::EpiPlain, g8::DenseOrder, false>(lds, g, S, E); tail_jobs(lds, args, PH_PROJ););
    RUN(PH_MLSTM, if ((int)blockIdx.x < 256) mlstm_phase(lds, RA, (const float*)(ws + WS_GATES), args.in[4], RD, (int)blockIdx.x););
    RUN(PH_WOUT,
        g8::Gemm g{RD, (const bf16_t*)(ws + WS_WOUT), D, nullptr, nullptr, nullptr}; g8::DenseOrder S; S.init(NPAN, 4, D, G, (int)blockIdx.x);
        g8::EpiRes<0> E{RC, RB, st1, lds + LDS_META, nullptr, nullptr};
        g8::gemm_phase<g8::EpiRes<0>, g8::DenseOrder, false>(lds, g, S, E); tail_jobs(lds, args, PH_WOUT););
    RUN(PH_FIN1, finstats_phase(st1, (float*)(ws + WS_RS1), NROWS););
    RUN(PH_GU,
        g8::Gemm g{RC, (const bf16_t*)(ws + WS_WGU), D, nullptr, nullptr, ws + WS_RS1}; g8::DenseOrder S; S.init(NPAN, 2 * FFD / 256, D, G, (int)blockIdx.x);
        g8::EpiGlu<false> E{RA, FFD, st1, vec + VEC_GU_CS, vec + VEC_GU_BW, lds + LDS_META, 0};
        g8::gemm_phase<g8::EpiGlu<false>, g8::DenseOrder, false, 3>(lds, g, S, E); tail_jobs(lds, args, PH_GU););
    RUN(PH_DN,
        g8::Gemm g{RA, (const bf16_t*)(ws + WS_WDN), FFD, nullptr, nullptr, ws + WS_RS1}; g8::DenseOrder S; S.init(NPAN, 4, FFD, G, (int)blockIdx.x);
        g8::EpiRes<1> E{RB, RC, st2, lds + LDS_META, ln_g, ln_b};
        g8::gemm_phase<g8::EpiRes<1>, g8::DenseOrder, false, 3>(lds, g, S, E); tail_jobs(lds, args, PH_DN););
    RUN(PH_FIN2, finstats_phase(st2, (float*)(ws + WS_RS2), NROWS););
    RUN(PH_KVQ,
        g8::Gemm g{RB, (const bf16_t*)(ws + WS_WKVQ), D, nullptr, nullptr, ws + WS_RS2}; g8::DenseOrder S; S.init(NPAN, NPROJ / 256, D, G, (int)blockIdx.x);
        g8::EpiFold E{RA, NPROJ, lds + LDS_META, vec + VEC_KVQ_CS, vec + VEC_KVQ_BW};
        g8::gemm_phase<g8::EpiFold, g8::DenseOrder, false, 3>(lds, g, S, E); tail_jobs(lds, args, PH_KVQ););
    RUN(PH_ATT, attn_phase(lds, RA, RD););
    RUN(PH_WO,
        g8::Gemm g{RD, (const bf16_t*)(ws + WS_WO), D, nullptr, nullptr, ws + WS_RS2}; g8::DenseOrder S; S.init(NR / 256, 4, D, G, (int)blockIdx.x);
        g8::EpiRes<1> E{RC, RB, st3, lds + LDS_META, ln_g + 1024, ln_b + 1024};
        g8::gemm_phase<g8::EpiRes<1>, g8::DenseOrder, false, 3>(lds, g, S, E););
    RUN(PH_RT1, router1_phase(lds, args););
    RUN(PH_RT2, router2_phase(lds, args););
#define MOE_CHUNK(cidx) \
    RUN(PH_MOE0 + 2 * (cidx), const int* hdr = (const int*)(ws + WS_HDR); const int npan = hdr[8]; const int p0 = (cidx) * MOE_CHUNK_PAN; \
        { g8::MoeOrder S; S.p0 = p0; S.np = ((cidx) == MOE_NCHUNK - 1) ? (npan - p0) : MOE_CHUNK_PAN; S.nfull = MOE_CHUNK_PAN; S.nsplit = 1; S.nN = 2 * FFE / 256; S.G = G; S.c = (int)blockIdx.x; S.K = D; S.estride = (unsigned)(2 * FFE * D * 2); \
            _Pragma("unroll") for (int e = 0; e < NE; ++e) S.pend[e] = hdr[e]; \
            g8::Gemm g{RC, (const bf16_t*)(ws + WS_WEGU), D, (const int*)(ws + WS_TOK), ws + WS_TOK, ws + WS_GATEB}; \
            g8::EpiGlu<true> E{RA, FFE, st3, vec + VEC_EGU_CS, vec + VEC_EGU_BW, lds + LDS_META, 2 * FFE}; \
            g8::gemm_phase<g8::EpiGlu<true>, g8::MoeOrder, true, 1>(lds, g, S, E); }); \
    RUN(PH_MOE0 + 2 * (cidx) + 1, const int* hdr = (const int*)(ws + WS_HDR); const int npan = hdr[8]; const int p0 = (cidx) * MOE_CHUNK_PAN; \
        { g8::MoeOrder S; S.p0 = p0; S.np = ((cidx) == MOE_NCHUNK - 1) ? (npan - p0) : MOE_CHUNK_PAN; S.nfull = MOE_CHUNK_PAN; S.nsplit = MOE_KSPLIT; S.nN = 4; S.G = G; S.c = (int)blockIdx.x; S.K = FFE; S.estride = (unsigned)(D * FFE * 2); \
            _Pragma("unroll") for (int e = 0; e < NE; ++e) S.pend[e] = hdr[e]; \
            g8::Gemm g{RA, (const bf16_t*)(ws + WS_WEDN), FFE, nullptr, ws + WS_TOK, nullptr}; \
            g8::EpiMoeDown E{RB, RD, lds + LDS_META, (float*)((unsigned char*)RA + RA_POFF), MOE_CHUNK_PAN}; \
            g8::gemm_phase<g8::EpiMoeDown, g8::MoeOrder, false, 2>(lds, g, S, E); });
    MOE_CHUNK(0) MOE_CHUNK(1) MOE_CHUNK(2) MOE_CHUNK(3)
    RUN(PH_FIX, moefix_phase(args););
    RUN(PH_FINAL, final_phase(args););
    if (PROBE_T >= 0 && blockIdx.x == 0 && threadIdx.x == 0) { const long long dl = 4 * (long long)__hip_atomic_load((unsigned long long*)(ws + WS_DIAG + 32), __ATOMIC_RELAXED, __HIP_MEMORY_SCOPE_AGENT); const long long t0 = wall_clock64(); while (wall_clock64() - t0 < dl) __builtin_amdgcn_s_sleep(8); }
#undef RUN
#undef IN
#undef SEAM
}

extern "C" void kernel_launch(void* const* d_in, const int* in_sizes, int n_in, void* d_out, int out_size, void* d_ws, size_t ws_size, hipStream_t stream) {
    static int grid = 0;
    if (grid == 0) {
        if (n_in != 18 || out_size != NR * D || ws_size < WS_END) { fprintf(stderr, "kernel_launch: unexpected problem (n_in %d out %d ws %zu need %zu)\n", n_in, out_size, ws_size, (size_t)WS_END); grid = -1; return; }
        int dev = 0, cus = 0, per_cu = 0;
        if (hipGetDevice(&dev) != hipSuccess || hipDeviceGetAttribute(&cus, hipDeviceAttributeMultiprocessorCount, dev) != hipSuccess) { grid = -1; return; }
        if (hipFuncSetAttribute((const void*)yoco_fwd, hipFuncAttributeMaxDynamicSharedMemorySize, LDS_BYTES) != hipSuccess) { fprintf(stderr, "kernel_launch: hipFuncSetAttribute failed\n"); grid = -1; return; }
        if (hipOccupancyMaxActiveBlocksPerMultiprocessor(&per_cu, (const void*)yoco_fwd, NTHREADS, LDS_BYTES) != hipSuccess || per_cu < 1) { fprintf(stderr, "kernel_launch: occupancy query says %d\n", per_cu); }
        (void)hipGetLastError();
        if (cus < 256) { fprintf(stderr, "kernel_launch: needs 256 CUs\n"); grid = -1; return; }
        grid = 256;
    }
    if (grid < 0) return;
    (void)hipMemsetAsync((char*)d_ws + WS_CTL, 0, CTL_BYTES, stream);
    Args a{};
    for (int i = 0; i < 18; ++i) a.in[i] = (const float*)d_in[i];
    a.out = (float*)d_out; a.ws = (unsigned char*)d_ws;
#if N_LAUNCH_MODE == 1
    for (int p = 0; p < PH_COUNT; ++p) { a.ph_lo = p; a.ph_hi = p + 1; hipLaunchKernelGGL(yoco_fwd, dim3(grid), dim3(NTHREADS), LDS_BYTES, stream, a); }
#else
    a.ph_lo = 0; a.ph_hi = PH_COUNT;
    hipLaunchKernelGGL(yoco_fwd, dim3(grid), dim3(NTHREADS), LDS_BYTES, stream, a);
#endif
}
```

```cpp
#include <hip/hip_runtime.h>
#include <cstdio>
#include <cstdint>

#ifndef N_LAUNCH_MODE
#define N_LAUNCH_MODE 0
#endif
#ifndef PROBE_CLK
#define PROBE_CLK 0
#endif
#ifndef PROBE_T
#define PROBE_T (-1)
#endif
#ifndef PROBE_WG
#define PROBE_WG (-1)
#endif
#ifndef REPMASK
#define REPMASK 0u
#endif

#define LAS __attribute__((address_space(3)))
typedef unsigned short bf16_t;
typedef short bf16x8 __attribute__((ext_vector_type(8)));
typedef float f32x2 __attribute__((ext_vector_type(2)));
typedef float f32x4 __attribute__((ext_vector_type(4)));
typedef float f32x16 __attribute__((ext_vector_type(16)));
typedef unsigned u32x2 __attribute__((ext_vector_type(2)));
typedef unsigned u32x4 __attribute__((ext_vector_type(4)));
typedef __bf16 bf16x2_t __attribute__((ext_vector_type(2)));

constexpr int D = 1024, NB = 16, SEQ = 4096, NMETA = 16;
constexpr int NR = NB * SEQ;
constexpr int NROWS = NR + NB * NMETA;
constexpr int NPAN = NROWS / 256;
constexpr int NPROJ = 3072;
constexpr int FFD = 2816, NE = 8, FFE = 3584;
constexpr float ALPHA = 1.41421356237f, LN_EPS = 1e-5f;
constexpr int NTHREADS = 512;
constexpr int MOE_ROWS = 2 * NR + NE * 256;
constexpr int MOE_CHUNK_PAN = 128;
constexpr int MOE_NCHUNK = 4;
constexpr int MOE_KSPLIT = 7;
constexpr size_t RA_POFF = (size_t)256 << 20;

constexpr size_t al256(size_t x) { return (x + 255) & ~(size_t)255; }
constexpr size_t WS_CTL = 0;
constexpr size_t CTL_BYTES = 65536;
constexpr size_t WS_WIN = WS_CTL + CTL_BYTES;
constexpr size_t WS_WOUT = WS_WIN + (size_t)NPROJ * D * 2;
constexpr size_t WS_WGU = WS_WOUT + (size_t)D * D * 2;
constexpr size_t WS_WDN = WS_WGU + (size_t)2 * FFD * D * 2;
constexpr size_t WS_WKVQ = WS_WDN + (size_t)D * FFD * 2;
constexpr size_t WS_WO = WS_WKVQ + (size_t)NPROJ * D * 2;
constexpr size_t WS_WEGU = WS_WO + (size_t)D * D * 2;
constexpr size_t WS_WEDN = WS_WEGU + (size_t)NE * 2 * FFE * D * 2;
constexpr size_t WS_VEC = WS_WEDN + (size_t)NE * D * FFE * 2;
constexpr int VEC_GU_CS = 0, VEC_GU_BW = 2 * FFD, VEC_KVQ_CS = 4 * FFD, VEC_KVQ_BW = VEC_KVQ_CS + NPROJ, VEC_EGU_CS = VEC_KVQ_BW + NPROJ, VEC_EGU_BW = VEC_EGU_CS + NE * 2 * FFE, VEC_END = VEC_EGU_BW + NE * 2 * FFE;
constexpr size_t WS_GATES = al256(WS_VEC + (size_t)VEC_END * 4);
constexpr size_t WS_ST1 = al256(WS_GATES + (size_t)NROWS * 8 * 4);
constexpr size_t WS_ST2 = WS_ST1 + (size_t)NROWS * 16 * 8;
constexpr size_t WS_ST3 = WS_ST2 + (size_t)NROWS * 16 * 8;
constexpr size_t WS_ROUTE = WS_ST3 + (size_t)NROWS * 16 * 8;
constexpr size_t WS_CNT = WS_ROUTE + (size_t)NR * 16;
constexpr size_t WS_HDR = WS_CNT + 256 * 8 * 4;
constexpr size_t WS_TOK = WS_HDR + 256;
constexpr size_t WS_GATEB = al256(WS_TOK + (size_t)MOE_ROWS * 8);
constexpr size_t WS_TOKST = al256(WS_GATEB + (size_t)MOE_ROWS * 8);
constexpr size_t WS_RS1 = al256(WS_TOKST + (size_t)NR * 8);
constexpr size_t WS_RS2 = al256(WS_RS1 + (size_t)NROWS * 8);
constexpr size_t WS_DIAG = al256(WS_RS2 + (size_t)NROWS * 8);
constexpr size_t WS_RA = al256(WS_DIAG + 4096);
constexpr size_t RA_BYTES = (size_t)NROWS * NPROJ * 2;
constexpr size_t WS_RB = al256(WS_RA + RA_BYTES);
constexpr size_t RX_BYTES = (size_t)NROWS * D * 2;
constexpr size_t WS_RC = al256(WS_RB + RX_BYTES);
constexpr size_t WS_RD = al256(WS_RC + RX_BYTES);
constexpr size_t WS_END = al256(WS_RD + RX_BYTES);

constexpr int LDS_MAIN = 131072, LDS_META = LDS_MAIN  , LDS_MISC = LDS_META + 8192  , LDS_BYTES = LDS_MISC + 256;
__device__ __forceinline__ float bf2f(bf16_t v) { return __uint_as_float(((unsigned)v) << 16); }
__device__ __forceinline__ float bflo(unsigned u) { return __uint_as_float(u << 16); }
__device__ __forceinline__ float bfhi(unsigned u) { return __uint_as_float(u & 0xffff0000u); }
__device__ __forceinline__ unsigned pk2(float lo, float hi) { f32x2 v = {lo, hi}; bf16x2_t b = __builtin_convertvector(v, bf16x2_t); return __builtin_bit_cast(unsigned, b); }
__device__ __forceinline__ bf16_t f2bf(float f) { return (bf16_t)(pk2(f, 0.f) & 0xffffu); }
__device__ __forceinline__ float rbf(float f) { return bflo(pk2(f, 0.f)); }
__device__ __forceinline__ float wave_sum(float v) {
#pragma unroll
    for (int o = 32; o >= 1; o >>= 1) v += __shfl_xor(v, o);
    return v;
}
__device__ __forceinline__ float swap32_hi(float x, float& lo) {
    const u32x2 r = __builtin_amdgcn_permlane32_swap(__float_as_uint(x), __float_as_uint(x), false, false); lo = __uint_as_float(r.x); return __uint_as_float(r.y); }
__device__ __forceinline__ float fq_sum(float x) {
    const u32x2 a = __builtin_amdgcn_permlane16_swap(__float_as_uint(x), __float_as_uint(x), false, false); const float y = __uint_as_float(a.x) + __uint_as_float(a.y);
    const u32x2 b = __builtin_amdgcn_permlane32_swap(__float_as_uint(y), __float_as_uint(y), false, false); return __uint_as_float(b.x) + __uint_as_float(b.y); }
__device__ __forceinline__ float sigmoidf_(float x) { return __builtin_amdgcn_rcpf(1.0f + __builtin_amdgcn_exp2f(x * -1.4426950408889634f)); }

#define XB_TMO      128
#define XB_XCNT(j)  (256  + 64 * (j))
#define XB_XSUB(j)  (1280 + 64 * (j))
#define XB_XGEN(j)  (2304 + 64 * (j))
#define XB_TOP      3328
#define XB_TOPGEN   3392
#define XCD_BAR_WORDS 3456
#define XB_SPIN_CAP (1u << 20)
__device__ __forceinline__ unsigned xb_ld(unsigned* p)              { return __hip_atomic_load(p, __ATOMIC_RELAXED, __HIP_MEMORY_SCOPE_AGENT); }
__device__ __forceinline__ unsigned xb_add(unsigned* p, unsigned v) { return __hip_atomic_fetch_add(p, v, __ATOMIC_RELAXED, __HIP_MEMORY_SCOPE_AGENT); }
__device__ __forceinline__ unsigned xb_xcc_id() { return (unsigned)__builtin_amdgcn_s_getreg((3 << 11) | 20) & 0xFu; }
#define XB_SPIN(cond, bar) do { unsigned _sp = 0; while (cond) { __builtin_amdgcn_s_sleep(1); \
    if ((++_sp & 255u) == 0u) { if (xb_ld(&(bar)[XB_TMO])) break; if (_sp > XB_SPIN_CAP) { atomicAdd(&(bar)[XB_TMO], 1u); break; } } } } while (0)
struct XcdBarrier { unsigned* bar; unsigned x; volatile LAS unsigned* st; };
__device__ __forceinline__ XcdBarrier xcd_barrier_post(unsigned* bar, volatile LAS unsigned* st) {
    XcdBarrier b; b.bar = bar; b.x = xb_xcc_id(); b.st = st;
    if (threadIdx.x == 0) (void)xb_add(&bar[XB_XCNT(b.x)], 1u);
    return b;
}
__device__ __forceinline__ void xcd_barrier_complete(unsigned* bar, unsigned x, unsigned& nloc, unsigned& nx) {
    const unsigned G = gridDim.x * gridDim.y * gridDim.z;
    unsigned sum, cnt, mine, sp = 0u;
    for (;;) {
        sum = 0u; cnt = 0u; mine = 0u;
#pragma unroll
        for (unsigned j = 0; j < 16; ++j) { const unsigned c = xb_ld(&bar[XB_XCNT(j)]); sum += c; cnt += (c > 0u) ? 1u : 0u; mine = (j == x) ? c : mine; }
        if (sum == G) break;
        __builtin_amdgcn_s_sleep(1);
        if ((++sp & 255u) == 0u) { if (xb_ld(&bar[XB_TMO])) break; if (sp > XB_SPIN_CAP) { atomicAdd(&bar[XB_TMO], 1u); break; } }
    }
    nloc = mine > 0u ? mine : 1u; nx = cnt > 0u ? cnt : 1u;
}
__device__ __forceinline__ void xcd_barrier(const XcdBarrier& b) {
    asm volatile("s_waitcnt vmcnt(0)" ::: "memory");
    __syncthreads();
    if (threadIdx.x == 0) {
        unsigned* bar = b.bar;
        __builtin_amdgcn_s_waitcnt(0);
        unsigned nloc = b.st[0], nx = b.st[1];
        if (nloc == 0u) { xcd_barrier_complete(bar, b.x, nloc, nx); b.st[0] = nloc; b.st[1] = nx; }
        const unsigned old = xb_add(&bar[XB_XSUB(b.x)], 1u);
        const unsigned gen = old / nloc;
        if (old + 1u == (gen + 1u) * nloc) {
            __builtin_amdgcn_fence(__ATOMIC_RELEASE, "agent");
            asm volatile("s_waitcnt vmcnt(0)" ::: "memory");
            const unsigned og = xb_add(&bar[XB_TOP], 1u);
            const unsigned tg = og / nx;
            if (og + 1u == (tg + 1u) * nx) xb_add(&bar[XB_TOPGEN], 1u);
            else XB_SPIN(xb_ld(&bar[XB_TOPGEN]) == tg, bar);
            __builtin_amdgcn_fence(__ATOMIC_ACQUIRE, "agent");
            xb_add(&bar[XB_XGEN(b.x)], 1u);
            asm volatile("s_waitcnt vmcnt(0)" ::: "memory");
        } else {
            XB_SPIN(xb_ld(&bar[XB_XGEN(b.x)]) == gen, bar);
            __builtin_amdgcn_fence(__ATOMIC_ACQUIRE, "agent");
            asm volatile("s_waitcnt vmcnt(0)" ::: "memory");
        }
    }
    __syncthreads();
}

namespace g8 {
constexpr int BM = 256, BK = 64, HALF = 128, HTB = HALF * BK * 2, STAGE_BYTES = 8 * HTB, NXCD = 8, WGM = 8;
__host__ __device__ __forceinline__ int lds_byte(int r, int c) { const int st = (r >> 4) * 2 + (c >> 5), rr = r & 15, cc = c & 31, ob = rr * 64 + cc * 2; return st * 1024 + (ob ^ (((ob >> 9) & 1) << 5)); }
__host__ __device__ __forceinline__ void stage_rc(int b, int& R, int& C) { const int st = b / 1024, sb = b % 1024, swz = sb ^ (((sb >> 9) & 1) << 5); R = (st >> 1) * 16 + swz / 64; C = (st & 1) * 32 + (swz % 64) / 2; }
__host__ __device__ __forceinline__ int perm32(int rho) { const int n = rho >> 4, i = rho & 15; return 8 * (i >> 2) + 4 * n + (i & 3); }

struct Unit { int pm, pn, gp; unsigned boff; int aux; int kt; unsigned koff; int ks; };
struct Gemm { const bf16_t* A; const bf16_t* Bt; int K; const int* rowtab; const unsigned char* smeta; const unsigned char* sstat; };

struct DenseOrder {
    int nM, nN, nwg, G, c, K;
    __device__ void init(int nM_, int nN_, int K_, int G_, int c_) { nM = nM_; nN = nN_; nwg = nM * nN; G = G_; c = c_; K = K_; }
    __device__ bool next(int i, Unit& u) const {
        const long L = (long)i * G + c; if (L >= nwg) return false;
        int wgid = (int)L; { const int q = nwg / NXCD, r = nwg % NXCD, xcd = wgid % NXCD, off = wgid / NXCD; wgid = (xcd < r ? xcd * (q + 1) : r * (q + 1) + (xcd - r) * q) + off; }
        const int nig = WGM * nN, gid = wgid / nig, fm = gid * WGM, gsz = (nM - fm) < WGM ? (nM - fm) : WGM;
        u.pm = fm + ((wgid % nig) % gsz); u.pn = (wgid % nig) / gsz; u.gp = u.pm; u.boff = (unsigned)u.pn * (unsigned)(256 * K * 2); u.kt = K / BK; u.koff = 0u; u.ks = -1; return true;
    }
};
struct MoeOrder {
    int p0, np, nN, G, c, K; unsigned estride; int pend[NE]; int nfull, nsplit;
    __device__ bool next(int i, Unit& u) const {
        const long L = (long)i * G + c; const long nmain = (long)nfull * nN;
        int pn, pml, ks = -1;
        if (L < nmain) {
            if (G == 256 && nfull == 128 && (nN & 3) == 0) { const int x = c & 7, j = c >> 3, rpb = nN >> 2, pb = x + 8 * (i / rpb), nb = i % rpb;
                pml = 8 * pb + (j & 7); pn = 4 * nb + (j >> 3); }
            else { pn = (int)(L / nfull); pml = (int)(L % nfull); } }
        else { const long r = L - nmain; if (r >= (long)(np - nfull) * nN * nsplit) return false;
            ks = (int)(r % nsplit); const int q = (int)(r / nsplit); pn = q % nN; pml = nfull + q / nN; if (nsplit == 1) ks = -1; }
        const int gp = p0 + pml;
        int e = 0;
#pragma unroll
        for (int j = 0; j < NE - 1; ++j) e += (gp >= pend[j]) ? 1 : 0;
        const int ktall = K / BK;
        u.pm = pml; u.pn = pn; u.gp = gp; u.ks = ks; u.kt = ks < 0 ? ktall : ktall / nsplit; u.koff = ks < 0 ? 0u : (unsigned)(ks * (K / nsplit) * 2);
        u.boff = (unsigned)e * estride + (unsigned)pn * (unsigned)(256 * K * 2) + u.koff; return true;
    }
};

template <class Epi, class Sched, bool GATHER, int META = 0>
__device__ __forceinline__ void gemm_phase(LAS unsigned char* lds, const Gemm g, const Sched& S, const Epi& E) {
    const int tid = threadIdx.x, wid = __builtin_amdgcn_readfirstlane(tid >> 6), lane = tid & 63, wr = wid >> 2, wc = wid & 3, fr = lane & 15, fq = lane >> 4;
    const int K = g.K;
    int Rr[2], Cc[2]; unsigned voffA[2], voffB[2];
#pragma unroll
    for (int i = 0; i < 2; ++i) { stage_rc(tid * 16 + i * 8192, Rr[i], Cc[i]); const int Rb = (Rr[i] & ~31) + perm32(Rr[i] & 31);
        voffA[i] = (unsigned)(Rr[i] * K + Cc[i]) * 2u; voffB[i] = (unsigned)(Rb * K + Cc[i]) * 2u; }
    const size_t kstep = (size_t)(BK * 2);
    const size_t hstep = (size_t)HALF * K * 2;
    const size_t tstep = 2 * hstep;
    const unsigned ldsw = (unsigned)wid * 1024u;
    const int aoff = lds_byte(wr * 64 + fr, fq * 8), boff = lds_byte(wc * 32 + fr, fq * 8);
#define G8_SA(b, h) (((b) * 2 + (h)) * HTB)
#define G8_SB(b, h) ((4 + (b) * 2 + (h)) * HTB)
#define G8_STAGE(bufoff, gbase, voff) do { _Pragma("unroll") for (int _i = 0; _i < 2; ++_i) \
        __builtin_amdgcn_global_load_lds((const unsigned*)((const char*)(gbase) + (voff)[_i]), (LAS unsigned*)(lds + (bufoff) + ldsw + _i * 8192), 16, 0, 0); } while (0)
#define G8_STA(bufoff, ptr, offs, h) do { if constexpr (GATHER) { G8_STAGE(bufoff, (const char*)g.A, (offs)[h]); } else { G8_STAGE(bufoff, (ptr) + (h) * hstep, voffA); } } while (0)
#define G8_LDA(dst, b, h) do { _Pragma("unroll") for (int m = 0; m < 4; ++m) _Pragma("unroll") for (int k = 0; k < 2; ++k) dst[m][k] = *(const LAS bf16x8*)(lds + G8_SA(b, h) + aoff + m * 2048 + k * 1024); } while (0)
#define G8_LDB(dst, b, h) do { _Pragma("unroll") for (int n = 0; n < 2; ++n) _Pragma("unroll") for (int k = 0; k < 2; ++k) dst[n][k] = *(const LAS bf16x8*)(lds + G8_SB(b, h) + boff + n * 2048 + k * 1024); } while (0)
#define G8_MMA(ai, bj, At, Bt) do { __builtin_amdgcn_s_setprio(1); _Pragma("unroll") for (int m = 0; m < 4; ++m) _Pragma("unroll") for (int n = 0; n < 2; ++n) _Pragma("unroll") for (int k = 0; k < 2; ++k) \
        acc[ai][bj][m][n] = __builtin_amdgcn_mfma_f32_16x16x32_bf16(Bt[n][k], At[m][k], acc[ai][bj][m][n], 0, 0, 0); __builtin_amdgcn_s_setprio(0); } while (0)
#define G8_WAIT_V(n) asm volatile("s_waitcnt vmcnt(" #n ")" ::: "memory")
#define G8_WAIT_L(n) asm volatile("s_waitcnt lgkmcnt(" #n ")" ::: "memory")
#define G8_BAR __builtin_amdgcn_s_barrier()
#define G8_SCHED __builtin_amdgcn_sched_barrier(0)
#define G8_ROWOFFS(dst, U) do { _Pragma("unroll") for (int _h = 0; _h < 2; ++_h) _Pragma("unroll") for (int _i = 0; _i < 2; ++_i) { \
        const int _id = g.rowtab[2 * ((U).gp * 256 + _h * 128 + Rr[_i])]; const int _tk = _id < 0 ? 0 : (_id >> 1); dst[_h][_i] = (unsigned)(_tk * K + Cc[_i]) * 2u; } } while (0)
#define G8_META_DMA(gsrc, panel, bufidx) __builtin_amdgcn_global_load_lds((const unsigned*)((gsrc) + (size_t)(panel) * 2048 + wid * 256 + lane * 4), (LAS unsigned*)(lds + LDS_META + (bufidx) * 2048 + wid * 256), 4, 0, 0)
    Unit cur, nxt; int ui = 0;
    if (!S.next(0, cur)) return;
    f32x4 acc[2][2][4][2];
#pragma unroll
    for (int a = 0; a < 2; ++a)
#pragma unroll
        for (int b = 0; b < 2; ++b)
#pragma unroll
            for (int m = 0; m < 4; ++m)
#pragma unroll
                for (int n = 0; n < 2; ++n) acc[a][b][m][n] = (f32x4){0.f, 0.f, 0.f, 0.f};
    bf16x8 At[4][2], B0[2][2], B1[2][2];
    const char* cA = (const char*)g.A + (size_t)cur.pm * tstep + cur.koff; const char* cB = (const char*)g.Bt + cur.boff;
    unsigned oc[2][2], on[2][2], o1[2][2], o2[2][2], o3[2][2];
    if constexpr (GATHER) { G8_ROWOFFS(oc, cur);
#pragma unroll
        for (int h = 0; h < 2; ++h)
#pragma unroll
            for (int i = 0; i < 2; ++i) { o1[h][i] = oc[h][i] + 128u; on[h][i] = oc[h][i]; o2[h][i] = 0; o3[h][i] = 0; } }
    G8_STAGE(G8_SB(0, 0), cB, voffB); G8_STAGE(G8_SB(0, 1), cB + hstep, voffB); G8_STA(G8_SA(0, 0), cA, oc, 0); G8_STA(G8_SA(0, 1), cA, oc, 1);
    if (wr == 1) G8_BAR;
    G8_WAIT_V(2); G8_BAR;
    G8_STAGE(G8_SB(1, 0), cB + kstep, voffB); G8_STA(G8_SA(1, 0), cA + kstep, o1, 0); G8_STAGE(G8_SB(1, 1), cB + hstep + kstep, voffB);
    G8_WAIT_V(6); G8_BAR;
    for (;;) {
        const bool has_next = S.next(ui + 1, nxt);
        const char* nA = has_next ? (const char*)g.A + (size_t)nxt.pm * tstep + nxt.koff : cA; const char* nB = has_next ? (const char*)g.Bt + nxt.boff : cB;
        const int nt = cur.kt;
        if constexpr (META == 1) { if (has_next) G8_META_DMA(g.smeta, nxt.gp, (ui + 1) & 1); G8_META_DMA(g.sstat, cur.gp, 2 + (ui & 1)); }
        if constexpr (META == 2) { G8_META_DMA(g.smeta, cur.gp, ui & 1); }
        if constexpr (META == 3) { G8_META_DMA(g.sstat, cur.pm, 2 + (ui & 1)); }
        for (int t = 0; t < nt; t += 2) {
            const bool last = (t == nt - 2);
            const char* a1 = cA + (size_t)(t + 1) * kstep;
            const char* a2 = last ? nA : cA + (size_t)(t + 2) * kstep; const char* b2 = last ? nB : cB + (size_t)(t + 2) * kstep;
            const char* a3 = a2 + kstep; const char* b3 = b2 + kstep;
            if constexpr (GATHER) {
                if (last) {
#pragma unroll
                    for (int h = 0; h < 2; ++h)
#pragma unroll
                        for (int i = 0; i < 2; ++i) { int id = -1; if (has_next) id = *(const LAS int*)(lds + LDS_META + ((ui + 1) & 1) * 2048 + (h * 128 + Rr[i]) * 8);
                            const int tk = id < 0 ? 0 : (id >> 1); on[h][i] = has_next ? (unsigned)(tk * K + Cc[i]) * 2u : oc[h][i]; } }
#pragma unroll
                for (int h = 0; h < 2; ++h)
#pragma unroll
                    for (int i = 0; i < 2; ++i) { o1[h][i] = oc[h][i] + (unsigned)(t + 1) * 128u; o2[h][i] = last ? on[h][i] : oc[h][i] + (unsigned)(t + 2) * 128u; o3[h][i] = o2[h][i] + 128u; } }
            G8_LDB(B0, 0, 0); G8_LDB(B1, 0, 1); G8_SCHED; G8_LDA(At, 0, 0); G8_STA(G8_SA(1, 1), a1, o1, 1);
            G8_WAIT_V(8); G8_WAIT_L(0); G8_BAR; G8_MMA(0, 0, At, B0); G8_MMA(0, 1, At, B1); G8_BAR; G8_SCHED;
            G8_LDA(At, 0, 1); G8_STAGE(G8_SB(0, 0), b2, voffB); G8_STAGE(G8_SB(0, 1), b2 + hstep, voffB); G8_STA(G8_SA(0, 0), a2, o2, 0);
            G8_WAIT_V(8); G8_WAIT_L(0); G8_BAR; G8_MMA(1, 0, At, B0); G8_MMA(1, 1, At, B1); G8_BAR; G8_SCHED;
            G8_LDB(B0, 1, 0); G8_LDB(B1, 1, 1); G8_SCHED; G8_LDA(At, 1, 0); G8_STA(G8_SA(0, 1), a2, o2, 1);
            G8_WAIT_V(8); G8_WAIT_L(0); G8_BAR; G8_MMA(0, 0, At, B0); G8_MMA(0, 1, At, B1); G8_BAR; G8_SCHED;
            G8_LDA(At, 1, 1); G8_STAGE(G8_SB(1, 0), b3, voffB); G8_STAGE(G8_SB(1, 1), b3 + hstep, voffB); G8_STA(G8_SA(1, 0), a3, o3, 0);
            G8_WAIT_V(8); G8_WAIT_L(0); G8_BAR; G8_MMA(1, 0, At, B0); G8_MMA(1, 1, At, B1); G8_BAR; G8_SCHED;
        }
        if (wr == 0) G8_BAR;
        cur.aux = ui & 1;
        E(acc, cur, wr, wc, fr, fq);
        if (!has_next) break;
#pragma unroll
        for (int a = 0; a < 2; ++a)
#pragma unroll
            for (int b = 0; b < 2; ++b)
#pragma unroll
                for (int m = 0; m < 4; ++m)
#pragma unroll
                    for (int n = 0; n < 2; ++n) acc[a][b][m][n] = (f32x4){0.f, 0.f, 0.f, 0.f};
        cur = nxt; cA = nA; cB = nB; ++ui;
        if constexpr (GATHER) {
#pragma unroll
            for (int h = 0; h < 2; ++h)
#pragma unroll
                for (int i = 0; i < 2; ++i) oc[h][i] = on[h][i]; }
        if (wr == 1) G8_BAR;
    }
    G8_WAIT_V(0);
    G8_BAR;
#undef G8_SA
#undef G8_SB
#undef G8_STAGE
#undef G8_STA
#undef G8_LDA
#undef G8_LDB
#undef G8_MMA
#undef G8_WAIT_V
#undef G8_WAIT_L
#undef G8_BAR
#undef G8_SCHED
#undef G8_ROWOFFS
#undef G8_META_DMA
}

typedef f32x4 Acc[2][2][4][2];
__device__ __forceinline__ u32x4 pack8(const f32x4 a, const f32x4 b) { u32x4 w; w.x = pk2(a[0], a[1]); w.y = pk2(a[2], a[3]); w.z = pk2(b[0], b[1]); w.w = pk2(b[2], b[3]); return w; }
__device__ __forceinline__ void unpack8(const u32x4 w, float (&f)[8]) { f[0] = bflo(w.x); f[1] = bfhi(w.x); f[2] = bflo(w.y); f[3] = bfhi(w.y); f[4] = bflo(w.z); f[5] = bfhi(w.z); f[6] = bflo(w.w); f[7] = bfhi(w.w); }
__device__ __forceinline__ void row_stats(const float* st, int row, int fq, float& mu, float& rstd) {
    const f32x4* p = (const f32x4*)(st + (size_t)row * 32 + fq * 8);
    const f32x4 a = p[0], b = p[1];
    float s1 = (a[0] + a[2]) + (b[0] + b[2]), s2 = (a[1] + a[3]) + (b[1] + b[3]);
    s1 += __shfl_xor(s1, 16); s1 += __shfl_xor(s1, 32); s2 += __shfl_xor(s2, 16); s2 += __shfl_xor(s2, 32);
    mu = s1 * (1.0f / 1024.0f); const float var = fmaxf(s2 * (1.0f / 1024.0f) - mu * mu, 0.f); rstd = rsqrtf(var + LN_EPS);
}
__device__ __forceinline__ void put_stats(float* st, int row, int slot, int fq, float s1, float s2) {
    s1 = fq_sum(s1); s2 = fq_sum(s2);
    if (fq == 0) *(f32x2*)(st + (size_t)row * 32 + slot * 2) = (f32x2){s1, s2};
}

struct EpiPlain {
    bf16_t* O; int ldc;
    __device__ __forceinline__ void operator()(const Acc& acc, const Unit& u, int wr, int wc, int fr, int fq) const {
        const int row0 = u.pm * 256 + wr * 64 + fr, col0 = u.pn * 256 + wc * 32 + 8 * fq;
#pragma unroll
        for (int ai = 0; ai < 2; ++ai)
#pragma unroll
            for (int m = 0; m < 4; ++m) { bf16_t* rowp = O + (size_t)(row0 + ai * 128 + m * 16) * ldc + col0;
#pragma unroll
                for (int bj = 0; bj < 2; ++bj) *(u32x4*)(rowp + bj * 128) = pack8(acc[ai][bj][m][0], acc[ai][bj][m][1]); }
    }
};
template <int MODE> struct EpiRes {
    bf16_t* Z; const bf16_t* Rsrc; float* st_out; LAS unsigned char* ldsm; const float* g; const float* b;
    __device__ __forceinline__ void operator()(const Acc& acc, const Unit& u, int wr, int wc, int fr, int fq) const {
        const int r0 = wr * 64 + fr, col0 = u.pn * 256 + wc * 32 + 8 * fq;
        f32x4 gv[2][2], bv[2][2];
        if (MODE == 1) {
#pragma unroll
            for (int bj = 0; bj < 2; ++bj)
#pragma unroll
                for (int n = 0; n < 2; ++n) { gv[bj][n] = *(const f32x4*)(g + col0 + bj * 128 + 4 * n); bv[bj][n] = *(const f32x4*)(b + col0 + bj * 128 + 4 * n); }
        }
        u32x4 rwa[4][4][2];
#define EPR_LOAD(am_) do { _Pragma("unroll") for (int m = 2 * ((am_) & 1); m < 2 * ((am_) & 1) + 2; ++m) _Pragma("unroll") for (int bj = 0; bj < 2; ++bj) \
            rwa[am_][m][bj] = *(const u32x4*)(Rsrc + ((size_t)u.pm * 256 + r0 + ((am_) >> 1) * 128 + m * 16) * D + col0 + bj * 128); } while (0)
        EPR_LOAD(0);
#pragma unroll
        for (int am = 0; am < 4; ++am) { const int ai = am >> 1;
            if (am + 1 < 4) EPR_LOAD(am + 1);
            u32x4 (&rw)[4][2] = rwa[am];
#pragma unroll
            for (int m = 2 * (am & 1); m < 2 * (am & 1) + 2; ++m) {
                const int rl = r0 + ai * 128 + m * 16; const size_t row = (size_t)u.pm * 256 + rl;
                float mu = 0.f, rstd = 1.f;
                if (MODE == 1) { const f32x2 ms = *(const LAS f32x2*)(ldsm + (2 + u.aux) * 2048 + rl * 8); mu = ms[0]; rstd = ms[1]; }
                float s1 = 0.f, s2 = 0.f;
#pragma unroll
                for (int bj = 0; bj < 2; ++bj) {
                    float r[8]; unpack8(rw[m][bj], r);
                    f32x4 v0, v1;
#pragma unroll
                    for (int j = 0; j < 4; ++j) {
                        float h0 = r[j], h1 = r[4 + j];
                        if (MODE == 1) { h0 = (h0 - mu) * rstd * gv[bj][0][j] + bv[bj][0][j]; h1 = (h1 - mu) * rstd * gv[bj][1][j] + bv[bj][1][j]; }
                        v0[j] = ALPHA * h0 + acc[ai][bj][m][0][j]; v1[j] = ALPHA * h1 + acc[ai][bj][m][1][j];
                    }
                    const u32x4 w = pack8(v0, v1);
                    *(u32x4*)(Z + row * D + col0 + bj * 128) = w;
                    float q[8]; unpack8(w, q);
#pragma unroll
                    for (int j = 0; j < 8; ++j) { s1 += q[j]; s2 += q[j] * q[j]; }
                }
                put_stats(st_out, (int)row, u.pn * 4 + wc, fq, s1, s2);
            }
        }
    }
};
struct EpiFold {
    bf16_t* O; int ldc; LAS unsigned char* ldsm; const float* cs; const float* bw;
    __device__ __forceinline__ void operator()(const Acc& acc, const Unit& u, int wr, int wc, int fr, int fq) const {
        const int r0 = wr * 64 + fr, col0 = u.pn * 256 + wc * 32 + 8 * fq;
        f32x4 cv[2][2], bv[2][2];
#pragma unroll
        for (int bj = 0; bj < 2; ++bj)
#pragma unroll
            for (int n = 0; n < 2; ++n) { cv[bj][n] = *(const f32x4*)(cs + col0 + bj * 128 + 4 * n); bv[bj][n] = *(const f32x4*)(bw + col0 + bj * 128 + 4 * n); }
#pragma unroll
        for (int ai = 0; ai < 2; ++ai)
#pragma unroll
            for (int m = 0; m < 4; ++m) {
                const int rl = r0 + ai * 128 + m * 16; const size_t row = (size_t)u.pm * 256 + rl;
                const f32x2 ms = *(const LAS f32x2*)(ldsm + (2 + u.aux) * 2048 + rl * 8); const float mu = ms[0], rstd = ms[1];
#pragma unroll
                for (int bj = 0; bj < 2; ++bj) {
                    const f32x4 v0 = (acc[ai][bj][m][0] - mu * cv[bj][0]) * rstd + bv[bj][0], v1 = (acc[ai][bj][m][1] - mu * cv[bj][1]) * rstd + bv[bj][1];
                    *(u32x4*)(O + row * ldc + col0 + bj * 128) = pack8(v0, v1);
                }
            }
    }
};
template <bool MOE> struct EpiGlu {
    bf16_t* O; int ldc; const float* st_in; const float* cs; const float* bw; LAS unsigned char* ldsm; int ncs;
    __device__ __forceinline__ void operator()(const Acc& acc, const Unit& u, int wr, int wc, int fr, int fq) const {
        const int row0 = u.pm * 256 + wr * 64 + fr, colo = u.pn * 128 + wc * 32 + 8 * fq;
        int vb = u.pn * 256 + wc * 32 + 8 * fq;
        if (MOE) vb += (int)(u.boff / (unsigned)(256 * D * 2)) * 256 - u.pn * 256;
        f32x4 cv[2][2], bv[2][2];
#pragma unroll
        for (int bj = 0; bj < 2; ++bj)
#pragma unroll
            for (int n = 0; n < 2; ++n) { cv[bj][n] = *(const f32x4*)(cs + vb + bj * 128 + 4 * n); bv[bj][n] = *(const f32x4*)(bw + vb + bj * 128 + 4 * n); }
#pragma unroll
        for (int ai = 0; ai < 2; ++ai)
#pragma unroll
            for (int m = 0; m < 4; ++m) {
                const int row = row0 + ai * 128 + m * 16;
                const f32x2 ms = *(const LAS f32x2*)(ldsm + (2 + u.aux) * 2048 + (row - u.pm * 256) * 8); const float mu = ms[0], rstd = ms[1];
                f32x4 o0, o1;
#pragma unroll
                for (int j = 0; j < 4; ++j) {
                    const float g0 = (acc[ai][0][m][0][j] - mu * cv[0][0][j]) * rstd + bv[0][0][j], g1 = (acc[ai][0][m][1][j] - mu * cv[0][1][j]) * rstd + bv[0][1][j];
                    const float u0 = (acc[ai][1][m][0][j] - mu * cv[1][0][j]) * rstd + bv[1][0][j], u1 = (acc[ai][1][m][1][j] - mu * cv[1][1][j]) * rstd + bv[1][1][j];
                    o0[j] = g0 * sigmoidf_(g0) * u0; o1[j] = g1 * sigmoidf_(g1) * u1;
                }
                *(u32x4*)(O + (size_t)row * ldc + colo) = pack8(o0, o1);
            }
    }
};
struct EpiMoeDown {
    bf16_t* Y0; bf16_t* Y1; LAS unsigned char* ldsm; float* P; int nfull;
    __device__ __forceinline__ void operator()(const Acc& acc, const Unit& u, int wr, int wc, int fr, int fq) const {
        const int r0 = wr * 64 + fr, col0 = u.pn * 256 + wc * 32 + 8 * fq;
        if (u.ks >= 0) {
#pragma unroll
            for (int ai = 0; ai < 2; ++ai)
#pragma unroll
                for (int m = 0; m < 4; ++m) { float* rowp = P + ((size_t)u.ks * 2048 + (size_t)(u.pm - nfull) * 256 + r0 + ai * 128 + m * 16) * D + col0;
#pragma unroll
                    for (int bj = 0; bj < 2; ++bj) { *(f32x4*)(rowp + bj * 128) = acc[ai][bj][m][0]; *(f32x4*)(rowp + bj * 128 + 4) = acc[ai][bj][m][1]; } }
            return;
        }
#pragma unroll
        for (int ai = 0; ai < 2; ++ai)
#pragma unroll
            for (int m = 0; m < 4; ++m) {
                const u32x2 mg = *(const LAS u32x2*)(ldsm + u.aux * 2048 + (r0 + ai * 128 + m * 16) * 8);
                const int id = (int)mg.x; const float gt = __uint_as_float(mg.y);
                if (id >= 0) { bf16_t* rowp = Y0 + (size_t)(id & 1) * (size_t)(Y1 - Y0) + (size_t)(id >> 1) * D + col0;
#pragma unroll
                    for (int bj = 0; bj < 2; ++bj) *(u32x4*)(rowp + bj * 128) = pack8(acc[ai][bj][m][0] * gt, acc[ai][bj][m][1] * gt); }
            }
    }
};
}

struct Args { const float* in[18]; float* out; unsigned char* ws; int ph_lo, ph_hi; };
enum { PH_PRO = 0, PH_PROJ, PH_MLSTM, PH_WOUT, PH_FIN1, PH_GU, PH_DN, PH_FIN2, PH_KVQ, PH_ATT, PH_WO, PH_RT1, PH_RT2, PH_MOE0, PH_FIX = PH_MOE0 + 2 * MOE_NCHUNK, PH_FINAL, PH_COUNT };

#define DPP_STEP_ADD(x, ctrl, rmask) x += __builtin_bit_cast(float, __builtin_amdgcn_update_dpp(0, __builtin_bit_cast(int, x), ctrl, rmask, 0xf, false))
#define DPP_STEP_MAX(x, ctrl, rmask) x = fmaxf(x, __builtin_bit_cast(float, __builtin_amdgcn_update_dpp((int)0xff800000, __builtin_bit_cast(int, x), ctrl, rmask, 0xf, false)))
__device__ __forceinline__ float scan_add64(float x) { DPP_STEP_ADD(x, 0x111, 0xf); DPP_STEP_ADD(x, 0x112, 0xf); DPP_STEP_ADD(x, 0x114, 0xf); DPP_STEP_ADD(x, 0x118, 0xf); DPP_STEP_ADD(x, 0x142, 0xa); DPP_STEP_ADD(x, 0x143, 0xc); return x; }
__device__ __forceinline__ float scan_max64(float x) { DPP_STEP_MAX(x, 0x111, 0xf); DPP_STEP_MAX(x, 0x112, 0xf); DPP_STEP_MAX(x, 0x114, 0xf); DPP_STEP_MAX(x, 0x118, 0xf); DPP_STEP_MAX(x, 0x142, 0xa); DPP_STEP_MAX(x, 0x143, 0xc); return x; }
__device__ __forceinline__ float wave_total(float x);
__device__ __forceinline__ float lane63(float x) { return __builtin_bit_cast(float, __builtin_amdgcn_readlane(__builtin_bit_cast(int, x), 63)); }
__device__ __forceinline__ float wave_total(float x) { return lane63(scan_add64(x)); }
__device__ __forceinline__ float logsigmoid_(float x) { return fminf(x, 0.f) - log1pf(expf(-fabsf(x))); }
__device__ __forceinline__ void conv_block(LAS unsigned char* lds, const float* src, int ldw, int K, bf16_t* dst, const float* g, const float* bb, float* cs, float* bw) {
    const int tid = threadIdx.x;
    const int n4 = (tid & 15) * 4, k4 = (tid >> 4) * 4;
    const int rn = tid >> 3, rs = tid & 7;
    float csp[4] = {0.f, 0.f, 0.f, 0.f}, bwp[4] = {0.f, 0.f, 0.f, 0.f};
    const int nch = K / 256;
    constexpr int TS = 520;
    LAS float* gs = (LAS float*)(lds + 2 * 64 * TS + 16384);
    if (g) { for (int i = tid; i < K; i += NTHREADS) { gs[i] = g[i]; gs[K + i] = bb[i]; } __syncthreads(); }
    f32x4 v[2][4], vn[2][4];
#pragma unroll
    for (int hf = 0; hf < 2; ++hf)
#pragma unroll
        for (int kk = 0; kk < 4; ++kk) v[hf][kk] = *(const f32x4*)(src + (size_t)(hf * 128 + k4 + kk) * ldw + n4);
    for (int ch = 0; ch < nch; ++ch) {
        LAS unsigned char* T = lds + (ch & 1) * (64 * TS);
        if (ch + 1 < nch) {
#pragma unroll
            for (int hf = 0; hf < 2; ++hf)
#pragma unroll
                for (int kk = 0; kk < 4; ++kk) vn[hf][kk] = *(const f32x4*)(src + (size_t)((ch + 1) * 256 + hf * 128 + k4 + kk) * ldw + n4); }
#pragma unroll
        for (int hf = 0; hf < 2; ++hf) {
            float gk[4] = {1.f, 1.f, 1.f, 1.f}, bk[4] = {0.f, 0.f, 0.f, 0.f};
            if (g) {
#pragma unroll
                for (int kk = 0; kk < 4; ++kk) { gk[kk] = gs[ch * 256 + hf * 128 + k4 + kk]; bk[kk] = gs[K + ch * 256 + hf * 128 + k4 + kk]; } }
#pragma unroll
            for (int j = 0; j < 4; ++j) {
                const unsigned lo = pk2(v[hf][0][j] * gk[0], v[hf][1][j] * gk[1]), hi = pk2(v[hf][2][j] * gk[2], v[hf][3][j] * gk[3]);
                *(LAS u32x2*)(T + (n4 + j) * TS + (hf * 128 + k4) * 2) = (u32x2){lo, hi};
                csp[j] += (bflo(lo) + bfhi(lo)) + (bflo(hi) + bfhi(hi));
                bwp[j] += (v[hf][0][j] * bk[0] + v[hf][1][j] * bk[1]) + (v[hf][2][j] * bk[2] + v[hf][3][j] * bk[3]);
            }
        }
        __syncthreads();
        u32x2 q[8];
#pragma unroll
        for (int i = 0; i < 8; ++i) q[i] = *(const LAS u32x2*)(T + rn * TS + rs * 64 + i * 8);
        bf16_t* dp = dst + (size_t)rn * K + ch * 256 + rs * 32;
#pragma unroll
        for (int i = 0; i < 4; ++i) *(u32x4*)(dp + 8 * i) = (u32x4){q[2 * i].x, q[2 * i].y, q[2 * i + 1].x, q[2 * i + 1].y};
#pragma unroll
        for (int hf = 0; hf < 2; ++hf)
#pragma unroll
            for (int kk = 0; kk < 4; ++kk) v[hf][kk] = vn[hf][kk];
    }
    __syncthreads();
    if (cs) {
        LAS float* red = (LAS float*)(lds + 2 * 64 * TS);
#pragma unroll
        for (int j = 0; j < 4; ++j) { red[(tid >> 4) * 64 + n4 + j] = csp[j]; red[2048 + (tid >> 4) * 64 + n4 + j] = bwp[j]; }
        __syncthreads();
        if (tid < 128) { const int n = tid & 63, w = tid >> 6; float s = 0.f;
            for (int i = 0; i < 32; ++i) s += red[w * 2048 + i * 64 + n];
            (w ? bw : cs)[n] = s; }
        __syncthreads();
    }
}
__device__ __forceinline__ void conv_job(LAS unsigned char* lds, const Args& a, int blk) {
    unsigned char* ws = a.ws;
    const float* ln_g = a.in[16]; const float* ln_b = a.in[17];
    float* vec = (float*)(ws + WS_VEC);
    const float* src; int ldw, K; bf16_t* dst; const float* g = nullptr; const float* bb = nullptr; float* cs = nullptr; float* bw = nullptr;
    int j = blk;
    if (j < 128) { const int e = j >> 4, jj = j & 15; src = a.in[15] + (size_t)e * FFE * D + 64 * jj; ldw = D; K = FFE; dst = (bf16_t*)(ws + WS_WEDN) + ((size_t)e * D + 64 * jj) * FFE; }
    else if (j < 144) { j -= 128; src = a.in[11] + 64 * j; ldw = D; K = FFD; dst = (bf16_t*)(ws + WS_WDN) + (size_t)(64 * j) * FFD; }
    else if (j < 192) { j -= 144; src = a.in[2] + 64 * j; ldw = 3080; K = D; dst = (bf16_t*)(ws + WS_WIN) + (size_t)(64 * j) * D; }
    else if (j < 208) { j -= 192; src = a.in[5] + 64 * j; ldw = D; K = D; dst = (bf16_t*)(ws + WS_WOUT) + (size_t)(64 * j) * D; }
    else if (j < 296) { j -= 208; const int t = j >> 2, q = j & 3; src = (q < 2 ? a.in[9] : a.in[10]) + 128 * t + 64 * (q & 1); ldw = FFD; K = D; dst = (bf16_t*)(ws + WS_WGU) + (size_t)(64 * j) * D;
        g = ln_g; bb = ln_b; cs = vec + VEC_GU_CS + 64 * j; bw = vec + VEC_GU_BW + 64 * j; }
    else if (j < 344) { j -= 296; src = j < 32 ? a.in[6] + 64 * j : a.in[7] + 64 * (j - 32); ldw = j < 32 ? 2048 : 1024; K = D; dst = (bf16_t*)(ws + WS_WKVQ) + (size_t)(64 * j) * D;
        g = ln_g + 1024; bb = ln_b + 1024; cs = vec + VEC_KVQ_CS + 64 * j; bw = vec + VEC_KVQ_BW + 64 * j; }
    else if (j < 360) { j -= 344; src = a.in[8] + 64 * j; ldw = D; K = D; dst = (bf16_t*)(ws + WS_WO) + (size_t)(64 * j) * D; }
    else { j -= 360; const int e = j / 112, jj = j % 112, t = jj >> 2, q = jj & 3; src = (q < 2 ? a.in[13] : a.in[14]) + (size_t)e * D * FFE + 128 * t + 64 * (q & 1); ldw = FFE; K = D;
        dst = (bf16_t*)(ws + WS_WEGU) + ((size_t)e * 2 * FFE + 64 * jj) * D; g = ln_g + 2048; bb = ln_b + 2048; cs = vec + VEC_EGU_CS + e * 2 * FFE + 64 * jj; bw = vec + VEC_EGU_BW + e * 2 * FFE + 64 * jj; }
    conv_block(lds, src, ldw, K, dst, g, bb, cs, bw);
}
constexpr int EGU0 = 360;
__device__ __forceinline__ void tail_jobs(LAS unsigned char* lds, const Args& a, int phase) {
    const int c = (int)blockIdx.x;
    int j0 = -1;
    if (phase == PH_PROJ) { const int q = c - 12;
        if (q >= 0) j0 = q < 16 ? 128 + q : (q < 184 ? 192 + (q - 16) : EGU0 + (q - 184)); }
    else if (phase == PH_WOUT) { const int q = c - 4; if (q >= 0) j0 = EGU0 + 60 + q; }
    else if (phase == PH_GU) { const int q = c - 22; if (q >= 0) j0 = EGU0 + 312 + q; }
    else if (phase == PH_DN) { const int q = c - 4;
        if (q >= 0 && q < 128) j0 = q;
        else if (q >= 128 && q - 128 < 106) j0 = EGU0 + 546 + (q - 128); }
    else { const int q = c - 12; if (q >= 0) j0 = EGU0 + 652 + q; }
    if (j0 >= 0) conv_job(lds, a, j0);
}
__device__ __forceinline__ void prologue_phase(LAS unsigned char* lds, const Args& a) {
    unsigned char* ws = a.ws;
    const int G = gridDim.x;
    for (int blk = 144 + blockIdx.x; blk < 192; blk += G) conv_job(lds, a, blk);
    {
        const int tid = threadIdx.x, lane = tid & 63, wid = tid >> 6;
        LAS float* wg = (LAS float*)lds;
        __syncthreads();
        const float* w_in = a.in[2];
        for (int i = tid; i < 8192; i += NTHREADS) { const int k = i >> 3, e = i & 7; wg[e * 1024 + k] = w_in[(size_t)k * 3080 + 3072 + e]; }
        __syncthreads();
        bf16_t* H0 = (bf16_t*)(ws + WS_RB); float* gates = (float*)(ws + WS_GATES);
        const float bg = a.in[3][lane & 7];
        const int c_ = (int)blockIdx.x;
        const int r_lo = (G == 256) ? (c_ < 48 ? 160 * c_ : 7680 + 280 * (c_ - 48)) : (int)(((long)NROWS * c_) / G);
        int r_hi = (G == 256) ? (c_ < 48 ? r_lo + 160 : r_lo + 280) : (int)(((long)NROWS * (c_ + 1)) / G); r_hi = r_hi < NROWS ? r_hi : NROWS;
#define PRO_SRC(r) ((r) < NR ? a.in[0] + (size_t)(r) * D : a.in[1] + (size_t)(((r) - NR) & 15) * D)
        f32x4 xa[4], xb[4], na[4], nb[4];
        { const int ra = (r_lo + wid) < r_hi ? (r_lo + wid) : 0, rb = (r_lo + wid + 8) < r_hi ? (r_lo + wid + 8) : ra; const float* sa = PRO_SRC(ra); const float* sb = PRO_SRC(rb);
#pragma unroll
            for (int i = 0; i < 4; ++i) { xa[i] = *(const f32x4*)(sa + i * 256 + lane * 4); xb[i] = *(const f32x4*)(sb + i * 256 + lane * 4); } }
        for (int row = r_lo + wid; row < r_hi; row += 16) {
            const bool hasb = (row + 8 < r_hi);
            { const int ra = (row + 16) < r_hi ? (row + 16) : row, rb = (row + 24) < r_hi ? (row + 24) : ra; const float* sa = PRO_SRC(ra); const float* sb = PRO_SRC(rb);
#pragma unroll
                for (int i = 0; i < 4; ++i) { na[i] = *(const f32x4*)(sa + i * 256 + lane * 4); nb[i] = *(const f32x4*)(sb + i * 256 + lane * 4); } }
            float acca[8] = {0.f, 0.f, 0.f, 0.f, 0.f, 0.f, 0.f, 0.f}, accb[8] = {0.f, 0.f, 0.f, 0.f, 0.f, 0.f, 0.f, 0.f};
#pragma unroll
            for (int i = 0; i < 4; ++i) {
                const int k = i * 256 + lane * 4;
                const f32x4 va = xa[i], vb = xb[i];
                *(u32x2*)(H0 + (size_t)row * D + k) = (u32x2){pk2(va[0], va[1]), pk2(va[2], va[3])};
                if (hasb) *(u32x2*)(H0 + (size_t)(row + 8) * D + k) = (u32x2){pk2(vb[0], vb[1]), pk2(vb[2], vb[3])};
#pragma unroll
                for (int e = 0; e < 8; ++e) { const f32x4 w = *(const LAS f32x4*)(wg + e * 1024 + k);
                    acca[e] += (va[0] * w[0] + va[1] * w[1]) + (va[2] * w[2] + va[3] * w[3]); accb[e] += (vb[0] * w[0] + vb[1] * w[1]) + (vb[2] * w[2] + vb[3] * w[3]); }
            }
#pragma unroll
            for (int i = 0; i < 4; ++i) { xa[i] = na[i]; xb[i] = nb[i]; }
#pragma unroll
            for (int e = 0; e < 8; ++e) { acca[e] = wave_total(acca[e]); accb[e] = wave_total(accb[e]); }
            float ma = acca[0], mb = accb[0];
#pragma unroll
            for (int e = 1; e < 8; ++e) { ma = ((lane & 7) == e) ? acca[e] : ma; mb = ((lane & 7) == e) ? accb[e] : mb; }
            if (lane < 8) { gates[(size_t)row * 8 + lane] = lane < 4 ? ma + bg : logsigmoid_(ma + bg); if (hasb) gates[(size_t)(row + 8) * 8 + lane] = lane < 4 ? mb + bg : logsigmoid_(mb + bg); }
        }
#undef PRO_SRC
        __syncthreads();
    }
}

__device__ __forceinline__ bf16x8 pack_frag(const f32x16& x, int s) {
    u32x4 p; p.x = pk2(x[8 * s], x[8 * s + 1]); p.y = pk2(x[8 * s + 2], x[8 * s + 3]); p.z = pk2(x[8 * s + 4], x[8 * s + 5]); p.w = pk2(x[8 * s + 6], x[8 * s + 7]);
    return __builtin_bit_cast(bf16x8, p);
}
__device__ __forceinline__ bf16x8 ld2x64(const LAS unsigned char* p0, const LAS unsigned char* p1) {
    const u32x2 a = *(const LAS u32x2*)p0, b = *(const LAS u32x2*)p1; u32x4 r = {a.x, a.y, b.x, b.y}; return __builtin_bit_cast(bf16x8, r);
}
__device__ __forceinline__ void tr4x4(const u32x2 (&r)[4], u32x2 (&c)[4]) {
    c[0] = (u32x2){(r[0].x & 0xffffu) | (r[1].x << 16), (r[2].x & 0xffffu) | (r[3].x << 16)};
    c[1] = (u32x2){(r[0].x >> 16) | (r[1].x & 0xffff0000u), (r[2].x >> 16) | (r[3].x & 0xffff0000u)};
    c[2] = (u32x2){(r[0].y & 0xffffu) | (r[1].y << 16), (r[2].y & 0xffffu) | (r[3].y << 16)};
    c[3] = (u32x2){(r[0].y >> 16) | (r[1].y & 0xffff0000u), (r[2].y >> 16) | (r[3].y & 0xffff0000u)};
}

constexpr int ML_QS = 0, ML_KS = 17408, ML_PS = 34816, ML_VT = 44032, ML_KT = 78848, ML_SC = 96256, ML_HS = 100352;
#ifndef ML_N0
#define ML_N0 28
#define ML_N1 18
#define ML_N2 12
#endif
__device__ __forceinline__ void mlstm_phase(LAS unsigned char* lds, const bf16_t* qkvo, const float* gates, const float* normg, bf16_t* hn, int unit_) {
    const int unit = (unit_ & 7) * 8 + (unit_ >> 5), part_ = (unit_ >> 3) & 3;
    const int c_begin = part_ == 0 ? 0 : (part_ == 1 ? ML_N0 : (part_ == 2 ? ML_N0 + ML_N1 : ML_N0 + ML_N1 + ML_N2));
    const int c_end = part_ == 0 ? ML_N0 : (part_ == 1 ? ML_N0 + ML_N1 : (part_ == 2 ? ML_N0 + ML_N1 + ML_N2 : 65));
    const int tid = threadIdx.x, lane = tid & 63, wid = __builtin_amdgcn_readfirstlane(tid >> 6);
    const int b = unit >> 2, h = unit & 3;
    const int r32 = lane & 31, hh = lane >> 5, l15 = lane & 15, l4 = lane >> 4;
    LAS float* sc = (LAS float*)(lds + ML_SC);
    const int q_row = tid >> 4, q_col = (tid & 15) * 8;
    const int k_dk = (16 * (wid & 1) + l15) * 4, k_s = (4 * (wid >> 1) + l4) * 4;
    const int v_dv = (16 * (wid & 3) + l15) * 4, v_s0 = (4 * (wid >> 2) + l4) * 4;
    f32x16 Cacc[4];
#pragma unroll
    for (int i = 0; i < 4; ++i)
#pragma unroll
        for (int j = 0; j < 16; ++j) Cacc[i][j] = 0.f;
    if (tid < 256) sc[192 + tid] = 0.f;
    float m_run = 0.f;
    u32x4 qreg[2]; u32x2 kreg[4], vreg[2][4]; float g_li = 0.f, g_lf = 0.f;
#define rowof(c, t) ((c) == 0 ? (NR + b * 16 + ((t) - 48)) : (b * SEQ + 64 * ((c) - 1) + (t)))
#define ML_PREFETCH_Q(c) do { \
        if ((c) >= c_begin) _Pragma("unroll") for (int p = 0; p < 2; ++p) { const int t = q_row + 32 * p; const bool pad = ((c) == 0 && t < 48); \
            qreg[p] = pad ? (u32x4){0u, 0u, 0u, 0u} : *(const u32x4*)(qkvo + (size_t)rowof((c), t) * NPROJ + h * 128 + q_col); } } while (0)
#define ML_PREFETCH(c) do { \
        _Pragma("unroll") for (int kk = 0; kk < 4; ++kk) { const int t = k_s + kk; const bool pad = ((c) == 0 && t < 48); \
            kreg[kk] = pad ? (u32x2){0u, 0u} : *(const u32x2*)(qkvo + (size_t)rowof((c), t) * NPROJ + 512 + h * 128 + k_dk); } \
        _Pragma("unroll") for (int p = 0; p < 2; ++p) _Pragma("unroll") for (int kk = 0; kk < 4; ++kk) { const int t = v_s0 + 32 * p + kk; const bool pad = ((c) == 0 && t < 48); \
            vreg[p][kk] = pad ? (u32x2){0u, 0u} : *(const u32x2*)(qkvo + (size_t)rowof((c), t) * NPROJ + 1024 + h * 256 + v_dv); } \
        { const bool pad = ((c) == 0 && lane < 48); g_li = pad ? -1e30f : gates[(size_t)rowof((c), lane) * 8 + h]; g_lf = pad ? 0.f : gates[(size_t)rowof((c), lane) * 8 + 4 + h]; } } while (0)
    float av, Mt, winter, bmt, wlast, decay, m_next;
#define ML_SCALARS() do { const float bc_ = scan_add64(g_lf); av = g_li - bc_; const float um_ = scan_max64(av); Mt = fmaxf(m_run, um_); \
        winter = __expf(m_run - Mt); bmt = bc_ + Mt; const float M63_ = lane63(Mt), b63_ = lane63(bc_); wlast = __expf(av - M63_); decay = __expf(m_run - M63_); m_next = b63_ + M63_; } while (0)
#define ML_IMAGE(FULL) do { \
        if (FULL) { _Pragma("unroll") for (int p = 0; p < 2; ++p) *(LAS u32x4*)(lds + ML_QS + (q_row + 32 * p) * 272 + q_col * 2) = qreg[p]; } \
        { u32x2 kw[4]; \
            _Pragma("unroll") for (int kk = 0; kk < 4; ++kk) { \
                if (FULL) *(LAS u32x2*)(lds + ML_KS + (k_s + kk) * 272 + k_dk * 2) = kreg[kk]; \
                const float w = __shfl(wlast, k_s + kk) * 0.08838834764831845f; \
                kw[kk] = (u32x2){pk2(bflo(kreg[kk].x) * w, bfhi(kreg[kk].x) * w), pk2(bflo(kreg[kk].y) * w, bfhi(kreg[kk].y) * w)}; } \
            u32x2 kc[4]; tr4x4(kw, kc); \
            _Pragma("unroll") for (int j = 0; j < 4; ++j) *(LAS u32x2*)(lds + ML_KT + (k_dk + j) * 136 + k_s * 2) = kc[j]; } \
        _Pragma("unroll") for (int p = 0; p < 2; ++p) { u32x2 vc[4]; tr4x4(vreg[p], vc); \
            _Pragma("unroll") for (int j = 0; j < 4; ++j) *(LAS u32x2*)(lds + ML_VT + (v_dv + j) * 136 + (v_s0 + 32 * p) * 2) = vc[j]; } \
        if (wid == 0) { sc[lane] = winter; sc[128 + lane] = bmt; } } while (0)
#define ML_PTILES() do { const int ti = wid >> 1; \
        _Pragma("unroll") for (int q = 0; q < 2; ++q) { const int si = 2 * (wid & 1) + q; f32x4 sa = {0.f, 0.f, 0.f, 0.f}; \
            if (si <= ti) { _Pragma("unroll") for (int ks = 0; ks < 4; ++ks) { \
                    const bf16x8 af = *(const LAS bf16x8*)(lds + ML_QS + (16 * ti + l15) * 272 + (32 * ks + 8 * l4) * 2); \
                    const bf16x8 bfr = *(const LAS bf16x8*)(lds + ML_KS + (16 * si + l15) * 272 + (32 * ks + 8 * l4) * 2); \
                    sa = __builtin_amdgcn_mfma_f32_16x16x32_bf16(af, bfr, sa, 0, 0, 0); } } \
            const int s = 16 * si + l15; const float a_s = __shfl(av, s); \
            _Pragma("unroll") for (int r = 0; r < 4; ++r) { const int t = 16 * ti + 4 * l4 + r; const float Mtt = __shfl(Mt, t); \
                const float w = (s <= t) ? __expf(a_s - Mtt) : 0.f; \
                *(LAS bf16_t*)(lds + ML_PS + t * 144 + s * 2) = f2bf(sa[r] * 0.08838834764831845f * w); } } } while (0)
    bf16x8 vf[4];
#define ML_VFRAGS() do { _Pragma("unroll") for (int ks = 0; ks < 4; ++ks) { const LAS unsigned char* p_ = lds + ML_VT + (32 * wid + r32) * 136 + (16 * ks + 8 * hh) * 2; vf[ks] = ld2x64(p_, p_ + 8); } } while (0)

    ML_PREFETCH(0); ML_PREFETCH_Q(0);
    ML_SCALARS();
    { const bool f0 = (0 >= c_begin); if (f0) ML_IMAGE(true); else ML_IMAGE(false); }
    __syncthreads();
    if (1 < c_end) ML_PREFETCH(1);
    if (0 >= c_begin) ML_PTILES();
    ML_VFRAGS();
    __syncthreads();
    for (int c = 0; c < c_end; ++c) {
        const bool full = (c >= c_begin), has_n = (c + 1 < c_end), full_n = (c + 1 >= c_begin);
        const float decay_c = decay;
        const int nb = c & 1;
        if (full) {
            {
                const int t = tid >> 3, part = tid & 7;
                float qn = 0.f, ps = 0.f;
                const u32x4 q0 = *(const LAS u32x4*)(lds + ML_QS + t * 272 + part * 32), q1 = *(const LAS u32x4*)(lds + ML_QS + t * 272 + part * 32 + 16);
                float qv[16]; { float t8[8]; g8::unpack8(q0, t8);
#pragma unroll
                    for (int j = 0; j < 8; ++j) qv[j] = t8[j]; g8::unpack8(q1, t8);
#pragma unroll
                    for (int j = 0; j < 8; ++j) qv[8 + j] = t8[j]; }
#pragma unroll
                for (int j = 0; j < 16; ++j) qn += qv[j] * sc[192 + 128 * nb + part * 16 + j];
                const u32x4 pw = *(const LAS u32x4*)(lds + ML_PS + t * 144 + part * 16);
                float pv[8]; g8::unpack8(pw, pv);
#pragma unroll
                for (int j = 0; j < 8; ++j) ps += pv[j];
                qn += __shfl_xor(qn, 1); qn += __shfl_xor(qn, 2); qn += __shfl_xor(qn, 4);
                ps += __shfl_xor(ps, 1); ps += __shfl_xor(ps, 2); ps += __shfl_xor(ps, 4);
                if (part == 0) { const float den = sc[t] * qn + ps; sc[64 + t] = __builtin_amdgcn_rcpf(fmaxf(fabsf(den), __expf(-sc[128 + t]))); }
            }
#pragma unroll
            for (int tt = 0; tt < 2; ++tt) {
                f32x16 num;
#pragma unroll
                for (int j = 0; j < 16; ++j) num[j] = 0.f;
#pragma unroll
                for (int dkt = 0; dkt < 4; ++dkt)
#pragma unroll
                    for (int s2 = 0; s2 < 2; ++s2) {
                        const LAS unsigned char* p = lds + ML_QS + (32 * tt + r32) * 272 + (32 * dkt + 16 * s2 + 4 * hh) * 2;
                        num = __builtin_amdgcn_mfma_f32_32x32x16_bf16(ld2x64(p, p + 16), pack_frag(Cacc[dkt], s2), num, 0, 0, 0);
                    }
#pragma unroll
                for (int gq = 0; gq < 4; ++gq) { const f32x4 wv = *(const LAS f32x4*)(sc + 32 * tt + 8 * gq + 4 * hh);
#pragma unroll
                    for (int r = 0; r < 4; ++r) num[4 * gq + r] *= wv[r]; }
#pragma unroll
                for (int ks = 0; ks < 4; ++ks) {
                    if (tt == 0 && ks >= 2) continue;
                    const bf16x8 pf = *(const LAS bf16x8*)(lds + ML_PS + (32 * tt + r32) * 144 + (16 * ks + 8 * hh) * 2);
                    num = __builtin_amdgcn_mfma_f32_32x32x16_bf16(pf, vf[ks], num, 0, 0, 0);
                }
#pragma unroll
                for (int j = 0; j < 16; ++j) *(LAS bf16_t*)(lds + ML_HS + (32 * tt + (j & 3) + 8 * (j >> 2) + 4 * hh) * 528 + (32 * wid + r32) * 2) = f2bf(num[j]);
            }
        }
#pragma unroll
        for (int dkt = 0; dkt < 4; ++dkt) {
#pragma unroll
            for (int j = 0; j < 16; ++j) Cacc[dkt][j] *= decay_c;
#pragma unroll
            for (int ks = 0; ks < 4; ++ks) { const LAS unsigned char* p = lds + ML_KT + (32 * dkt + r32) * 136 + (16 * ks + 8 * hh) * 2;
                Cacc[dkt] = __builtin_amdgcn_mfma_f32_32x32x16_bf16(ld2x64(p, p + 8), vf[ks], Cacc[dkt], 0, 0, 0); }
        }
        {
            const int dk = tid >> 2, part = tid & 3;
            const u32x2 k0 = *(const LAS u32x2*)(lds + ML_KT + dk * 136 + part * 32), k1 = *(const LAS u32x2*)(lds + ML_KT + dk * 136 + part * 32 + 8),
                        k2 = *(const LAS u32x2*)(lds + ML_KT + dk * 136 + part * 32 + 16), k3 = *(const LAS u32x2*)(lds + ML_KT + dk * 136 + part * 32 + 24);
            float sk = ((bflo(k0.x) + bfhi(k0.x)) + (bflo(k0.y) + bfhi(k0.y))) + ((bflo(k1.x) + bfhi(k1.x)) + (bflo(k1.y) + bfhi(k1.y)))
                     + ((bflo(k2.x) + bfhi(k2.x)) + (bflo(k2.y) + bfhi(k2.y))) + ((bflo(k3.x) + bfhi(k3.x)) + (bflo(k3.y) + bfhi(k3.y)));
            sk += __shfl_xor(sk, 1); sk += __shfl_xor(sk, 2);
            if (part == 0) sc[192 + 128 * (nb ^ 1) + dk] = decay_c * sc[192 + 128 * nb + dk] + sk;
        }
        if (has_n) ML_PREFETCH_Q(c + 1);
        __syncthreads();
        m_run = m_next;
        if (has_n) ML_SCALARS();
        u32x2 oreg[8];
        if (full) { const int t = tid >> 3, part = tid & 7; const bool pad = (c == 0 && t < 48); const size_t row = pad ? 0 : (size_t)rowof(c, t);
#pragma unroll
            for (int i = 0; i < 8; ++i) oreg[i] = *(const u32x2*)(qkvo + row * NPROJ + 2048 + h * 256 + 32 * i + 4 * part); }
        if (full) {
            const int t = tid >> 3, part = tid & 7;
            const float iv = sc[64 + t];
            f32x4 x[8]; float s1 = 0.f;
#pragma unroll
            for (int i = 0; i < 8; ++i) { const u32x2 hw = *(const LAS u32x2*)(lds + ML_HS + t * 528 + (32 * i + 4 * part) * 2);
                x[i] = (f32x4){bflo(hw.x) * iv, bfhi(hw.x) * iv, bflo(hw.y) * iv, bfhi(hw.y) * iv}; s1 += (x[i][0] + x[i][1]) + (x[i][2] + x[i][3]); }
            s1 += __shfl_xor(s1, 1); s1 += __shfl_xor(s1, 2); s1 += __shfl_xor(s1, 4);
            const float mean = s1 * (1.0f / 256.0f); float s2 = 0.f;
#pragma unroll
            for (int i = 0; i < 8; ++i) { const f32x4 d = x[i] - mean; s2 += (d[0] * d[0] + d[1] * d[1]) + (d[2] * d[2] + d[3] * d[3]); }
            s2 += __shfl_xor(s2, 1); s2 += __shfl_xor(s2, 2); s2 += __shfl_xor(s2, 4);
            const float rstd = rsqrtf(s2 * (1.0f / 256.0f) + LN_EPS);
            if (!(c == 0 && t < 48)) {
                const size_t row = (size_t)rowof(c, t);
#pragma unroll
                for (int i = 0; i < 8; ++i) {
                    const int dv = 32 * i + 4 * part;
                    const u32x2 ow = oreg[i];
                    const f32x4 ng = *(const f32x4*)(normg + h * 256 + dv);
                    const float o0 = sigmoidf_(bflo(ow.x)), o1 = sigmoidf_(bfhi(ow.x)), o2 = sigmoidf_(bflo(ow.y)), o3 = sigmoidf_(bfhi(ow.y));
                    const f32x4 y = (x[i] - mean) * rstd * ng;
                    *(u32x2*)(hn + row * D + h * 256 + dv) = (u32x2){pk2(y[0] * o0, y[1] * o1), pk2(y[2] * o2, y[3] * o3)};
                }
            }
        }
        if (!has_n) break;
        if (full_n) ML_IMAGE(true); else ML_IMAGE(false);
        if (c + 2 < c_end) ML_PREFETCH(c + 2);
        __syncthreads();
        if (full_n) ML_PTILES();
        ML_VFRAGS();
        if (full_n) __syncthreads();
    }
    __syncthreads();
#undef ML_PREFETCH
#undef ML_PREFETCH_Q
#undef ML_SCALARS
#undef ML_IMAGE
#undef ML_PTILES
#undef ML_VFRAGS
#undef rowof
}

constexpr float AT_PMIN = 1e-15f;
constexpr int AT_K0 = 0, AT_V0 = 17408, AT_BUF = 34816, AT_FLAGS = 2 * AT_BUF;
__device__ __forceinline__ void at_tile(const LAS unsigned char* Kb, const LAS unsigned char* Vb, int k0, int tmin, int r32, int hh, const bf16x8 (&qf)[8], f32x16 (&O)[4], float& P) {
    f32x16 S[2];
#pragma unroll
    for (int u = 0; u < 2; ++u) {
#pragma unroll
        for (int j = 0; j < 16; ++j) S[u][j] = 0.f;
#pragma unroll
        for (int ks = 0; ks < 8; ++ks) {
            const bf16x8 kf = *(const LAS bf16x8*)(Kb + (32 * u + r32) * 272 + (16 * ks + 8 * hh) * 2);
            S[u] = __builtin_amdgcn_mfma_f32_32x32x16_bf16(kf, qf[ks], S[u], 0, 0, 0);
        }
    }
    const bool full = (k0 + 63 < tmin) && (k0 >= 128);
    const int lim = tmin + r32 - k0 - 4 * hh;
    const int lo = 112 - k0 - 4 * hh;
    float Tt[2][4];
#define AT_ELEM(MASKED) \
    _Pragma("unroll") for (int u = 0; u < 2; ++u) _Pragma("unroll") for (int gq = 0; gq < 4; ++gq) { \
        float x4[4]; \
        _Pragma("unroll") for (int r = 0; r < 4; ++r) { \
            float zz = S[u][4 * gq + r] * (0.08838834764831845f * 1.4426950408889634f); \
            if (MASKED) { const int o = 32 * u + 8 * gq + r; zz = (o < lim && o >= lo) ? zz : -1.0e4f; } \
            const float rc = __builtin_amdgcn_rcpf(1.0f + __builtin_amdgcn_exp2f(zz)); \
            S[u][4 * gq + r] = 1.0f - rc; x4[r] = rc; } \
        const float e2 = x4[3], e1 = e2 * x4[2], e0 = e1 * x4[1]; \
        Tt[u][gq] = e0 * x4[0]; \
        S[u][4 * gq + 2] *= e2; S[u][4 * gq + 1] *= e1; S[u][4 * gq + 0] *= e0; }
    if (full) { AT_ELEM(false) } else { AT_ELEM(true) }
#undef AT_ELEM
    float acc = P;
#pragma unroll
    for (int u = 1; u >= 0; --u)
#pragma unroll
        for (int gq = 3; gq >= 0; --gq) {
            float t0; const float t1 = swap32_hi(Tt[u][gq], t0);
            const float Rr = hh ? acc : acc * t1;
            acc = (acc * t1) * t0;
#pragma unroll
            for (int r = 0; r < 4; ++r) S[u][4 * gq + r] *= Rr;
        }
    P = acc;
#pragma unroll
    for (int u = 0; u < 2; ++u)
#pragma unroll
        for (int s2 = 0; s2 < 2; ++s2) {
            const bf16x8 af = pack_frag(S[u], s2);
#pragma unroll
            for (int dt = 0; dt < 4; ++dt) {
                const LAS unsigned char* p = Vb + (32 * dt + r32) * 136 + (32 * u + 16 * s2 + 4 * hh) * 2;
                O[dt] = __builtin_amdgcn_mfma_f32_32x32x16_bf16(af, ld2x64(p, p + 16), O[dt], 0, 0, 0);
            }
        }
}
__device__ __forceinline__ void attn_phase(LAS unsigned char* lds, const bf16_t* kvq, bf16_t* ao) {
    const int tid = threadIdx.x, lane = tid & 63, wid = __builtin_amdgcn_readfirstlane(tid >> 6);
    const int r32 = lane & 31, hh = lane >> 5, l15 = lane & 15, l4 = lane >> 4;
    LAS unsigned* flags = (LAS unsigned*)(lds + AT_FLAGS);
    const int k_row = tid >> 4, k_col = (tid & 15) * 8;
    const int v_d = (16 * (wid & 1) + l15) * 4, v_s = (4 * (wid >> 1) + l4) * 4;
    for (int ui_ = 0; ui_ < (NB * 8 * 16) / 256; ++ui_) {
        const int xq = blockIdx.x & 7, jq = blockIdx.x >> 3, strm = (ui_ * 8 + xq) * 2 + (jq >> 4);
        const int qt = jq & 15, head = strm & 7, b = strm >> 3;
        const int q0 = 128 + 256 * qt, tmin = q0 + 32 * wid;
#define rowofp(p) ((p) >= 128 ? b * SEQ + (p) - 128 : ((p) >= 112 ? NR + b * 16 + (p) - 112 : NR + b * 16))
        bf16x8 qf[8];
        { const bf16_t* qp = kvq + (size_t)(b * SEQ + tmin - 128 + r32) * NPROJ + 2048 + head * 128 + 8 * hh;
#pragma unroll
            for (int ks = 0; ks < 8; ++ks) qf[ks] = *(const bf16x8*)(qp + 16 * ks); }
        f32x16 O[4];
#pragma unroll
        for (int i = 0; i < 4; ++i)
#pragma unroll
            for (int j = 0; j < 16; ++j) O[i][j] = 0.f;
        float P = 1.0f;
        const int kt_hi = (q0 >> 6) + 3;
        u32x4 kregA[2], kregB[2]; u32x2 vregA[4], vregB[4];
#define AT_LOAD(kreg, vreg, kt) do { \
        _Pragma("unroll") for (int p = 0; p < 2; ++p) kreg[p] = *(const u32x4*)(kvq + (size_t)rowofp(64 * (kt) + k_row + 32 * p) * NPROJ + head * 128 + k_col); \
        _Pragma("unroll") for (int kk = 0; kk < 4; ++kk) vreg[kk] = *(const u32x2*)(kvq + (size_t)rowofp(64 * (kt) + v_s + kk) * NPROJ + 1024 + head * 128 + v_d); } while (0)
#define AT_STORE(kreg, vreg, buf) do { LAS unsigned char* base = lds + (buf) * AT_BUF; \
        _Pragma("unroll") for (int p = 0; p < 2; ++p) *(LAS u32x4*)(base + AT_K0 + (k_row + 32 * p) * 272 + k_col * 2) = kreg[p]; \
        u32x2 vc[4]; tr4x4(vreg, vc); \
        _Pragma("unroll") for (int j = 0; j < 4; ++j) *(LAS u32x2*)(base + AT_V0 + (v_d + j) * 136 + v_s * 2) = vc[j]; } while (0)
#define AT_ITER(BUF, LOADSET_K, LOADSET_V, STORESET_K, STORESET_V) { \
            const int kt = kt_hi - it; \
            __syncthreads(); \
            if (it > 0 && flags[it - 1] == 0u) break; \
            if (kt - 2 >= 1) AT_LOAD(LOADSET_K, LOADSET_V, kt - 2); \
            if (64 * kt < tmin + 31 && __ballot(P >= AT_PMIN) != 0ull) at_tile(lds + (BUF) * AT_BUF + AT_K0, lds + (BUF) * AT_BUF + AT_V0, 64 * kt, tmin, r32, hh, qf, O, P); \
            if (__ballot(P >= AT_PMIN) != 0ull && lane == 0) flags[it] = 1u; \
            if (kt - 1 < 1) break; \
            AT_STORE(STORESET_K, STORESET_V, 1 - (BUF)); \
            ++it; }
        if (tid < 80) flags[tid] = 0u;
        AT_LOAD(kregA, vregA, kt_hi);
        AT_STORE(kregA, vregA, 0);
        AT_LOAD(kregB, vregB, kt_hi - 1);
        for (int it = 0; ; ) {
            AT_ITER(0, kregA, vregA, kregB, vregB)
            AT_ITER(1, kregB, vregB, kregA, vregA)
        }
#pragma unroll
        for (int dt = 0; dt < 4; ++dt)
#pragma unroll
            for (int j = 0; j < 16; ++j) {
                const int t = tmin + (j & 3) + 8 * (j >> 2) + 4 * hh;
                ao[(size_t)(b * SEQ + t - 128) * D + head * 128 + 32 * dt + r32] = f2bf(O[dt][j]);
            }
        __syncthreads();
    }
#undef AT_LOAD
#undef AT_STORE
#undef AT_ITER
#undef rowofp
}

__device__ __forceinline__ void ln_row_stats_wave(const float* st, int row, int lane, float& mu, float& rstd) {
    const f32x2 p = *(const f32x2*)(st + (size_t)row * 32 + (lane & 15) * 2);
    float s1 = p[0], s2 = p[1];
#pragma unroll
    for (int o = 1; o < 16; o <<= 1) { s1 += __shfl_xor(s1, o); s2 += __shfl_xor(s2, o); }
    mu = s1 * (1.0f / 1024.0f); const float var = fmaxf(s2 * (1.0f / 1024.0f) - mu * mu, 0.f); rstd = rsqrtf(var + LN_EPS);
}
__device__ __forceinline__ void router1_phase(LAS unsigned char* lds, const Args& a) {
    const int tid = threadIdx.x, lane = tid & 63, wid = tid >> 6;
    unsigned char* ws = a.ws;
    const float* g3 = a.in[16] + 2048; const float* b3 = a.in[17] + 2048; const float* wr = a.in[12];
    LAS float* gw = (LAS float*)lds;
    LAS float* cc = (LAS float*)(lds + 32768);
    LAS int* cnt = (LAS int*)(lds + 32768 + 64);
    __syncthreads();
    for (int i = tid; i < 8192; i += NTHREADS) { const int k = i >> 3, e = i & 7; gw[e * 1024 + k] = g3[k] * wr[i]; }
    if (tid < 8) cnt[tid] = 0;
    __syncthreads();
    { float s1 = 0.f, s2 = 0.f;
        for (int k = lane; k < 1024; k += 64) { s1 += gw[wid * 1024 + k]; s2 += b3[k] * wr[k * 8 + wid]; }
        s1 = wave_sum(s1); s2 = wave_sum(s2);
        if (lane == 0) { cc[wid] = s1; cc[8 + wid] = s2; } }
    __syncthreads();
    const bf16_t* z3 = (const bf16_t*)(ws + WS_RC); const float* st3 = (const float*)(ws + WS_ST3);
    f32x4* route = (f32x4*)(ws + WS_ROUTE);
    const int tok0 = (int)(((long)NR * blockIdx.x) / gridDim.x), tok1 = (int)(((long)NR * (blockIdx.x + 1)) / gridDim.x);
    u32x4 zrA[2], zrB[2]; f32x2 spA, spB;
#define RT_LOAD2(t) do { const int tb_ = ((t) + 8 < tok1) ? (t) + 8 : (t); \
        zrA[0] = *(const u32x4*)(z3 + (size_t)(t) * D + lane * 8); zrA[1] = *(const u32x4*)(z3 + (size_t)(t) * D + 512 + lane * 8); spA = *(const f32x2*)(st3 + (size_t)(t) * 32 + (lane & 15) * 2); \
        zrB[0] = *(const u32x4*)(z3 + (size_t)tb_ * D + lane * 8); zrB[1] = *(const u32x4*)(z3 + (size_t)tb_ * D + 512 + lane * 8); spB = *(const f32x2*)(st3 + (size_t)tb_ * 32 + (lane & 15) * 2); } while (0)
#define RT_FINISH(tk, acc, mu, rstd) do { float lg[8]; \
        _Pragma("unroll") for (int e = 0; e < 8; ++e) lg[e] = (rstd) * (wave_total(acc[e]) - (mu) * cc[e]) + cc[8 + e]; \
        int e1 = 0; float v1 = lg[0]; \
        _Pragma("unroll") for (int e = 1; e < 8; ++e) if (lg[e] > v1) { v1 = lg[e]; e1 = e; } \
        int e2 = -1; float v2 = -3.0e38f; \
        _Pragma("unroll") for (int e = 0; e < 8; ++e) if (e != e1 && lg[e] > v2) { v2 = lg[e]; e2 = e; } \
        const float g1 = 1.0f / (1.0f + expf(v2 - v1)); \
        if (lane == 0) { ((f32x2*)(ws + WS_TOKST))[tk] = (f32x2){(mu), (rstd)}; route[tk] = (f32x4){__int_as_float(e1 | (e2 << 8)), g1, 1.0f - g1, 0.f}; \
            __hip_atomic_fetch_add(&cnt[e1], 1, __ATOMIC_RELAXED, __HIP_MEMORY_SCOPE_WORKGROUP); __hip_atomic_fetch_add(&cnt[e2], 1, __ATOMIC_RELAXED, __HIP_MEMORY_SCOPE_WORKGROUP); } } while (0)
    if (tok0 + wid < tok1) RT_LOAD2(tok0 + wid);
    for (int tok = tok0 + wid; tok < tok1; tok += 16) {
        const u32x4 zA[2] = {zrA[0], zrA[1]}, zB[2] = {zrB[0], zrB[1]}; const f32x2 sA = spA, sB = spB;
        if (tok + 16 < tok1) RT_LOAD2(tok + 16);
        float a1 = sA[0], a2 = sA[1], b1 = sB[0], b2 = sB[1];
#pragma unroll
        for (int o = 1; o < 16; o <<= 1) { a1 += __shfl_xor(a1, o); a2 += __shfl_xor(a2, o); b1 += __shfl_xor(b1, o); b2 += __shfl_xor(b2, o); }
        const float muA = a1 * (1.0f / 1024.0f), rsA = rsqrtf(fmaxf(a2 * (1.0f / 1024.0f) - muA * muA, 0.f) + LN_EPS);
        const float muB = b1 * (1.0f / 1024.0f), rsB = rsqrtf(fmaxf(b2 * (1.0f / 1024.0f) - muB * muB, 0.f) + LN_EPS);
        float accA[8] = {0.f, 0.f, 0.f, 0.f, 0.f, 0.f, 0.f, 0.f}, accB[8] = {0.f, 0.f, 0.f, 0.f, 0.f, 0.f, 0.f, 0.f};
#pragma unroll
        for (int hf = 0; hf < 2; ++hf) {
            const int k = hf * 512 + lane * 8;
            float za[8], zb[8]; g8::unpack8(zA[hf], za); g8::unpack8(zB[hf], zb);
#pragma unroll
            for (int e = 0; e < 8; ++e) { const f32x4 w0 = *(const LAS f32x4*)(gw + e * 1024 + k), w1 = *(const LAS f32x4*)(gw + e * 1024 + k + 4);
                accA[e] += ((za[0] * w0[0] + za[1] * w0[1]) + (za[2] * w0[2] + za[3] * w0[3])) + ((za[4] * w1[0] + za[5] * w1[1]) + (za[6] * w1[2] + za[7] * w1[3]));
                accB[e] += ((zb[0] * w0[0] + zb[1] * w0[1]) + (zb[2] * w0[2] + zb[3] * w0[3])) + ((zb[4] * w1[0] + zb[5] * w1[1]) + (zb[6] * w1[2] + zb[7] * w1[3])); }
        }
        RT_FINISH(tok, accA, muA, rsA);
        if (tok + 8 < tok1) RT_FINISH(tok + 8, accB, muB, rsB);
    }
#undef RT_LOAD2
#undef RT_FINISH
    __syncthreads();
    if (tid < 8) ((int*)(ws + WS_CNT))[blockIdx.x * 8 + tid] = cnt[tid];
}
__device__ __forceinline__ void router2_phase(LAS unsigned char* lds, const Args& a) {
    const int tid = threadIdx.x, lane = tid & 63, wid = tid >> 6;
    unsigned char* ws = a.ws;
    const int G = gridDim.x, wg = blockIdx.x;
    LAS int* cn = (LAS int*)lds;
    LAS int* tot = (LAS int*)(lds + 16384);
    u32x2* smeta = (u32x2*)(ws + WS_TOK); f32x2* sstat = (f32x2*)(ws + WS_GATEB); const f32x2* tokst = (const f32x2*)(ws + WS_TOKST);
    const f32x4* route = (const f32x4*)(ws + WS_ROUTE);
    const int tok0 = (int)(((long)NR * wg) / G), tok1 = (int)(((long)NR * (wg + 1)) / G);
    f32x4 rr[8]; f32x2 ts[8];
#pragma unroll
    for (int i = 0; i < 8; ++i) { int q = 2 * tok0 + 64 * i + lane; q = q < 2 * tok1 ? q : 2 * tok1 - 1; rr[i] = route[q >> 1]; ts[i] = tokst[q >> 1]; }
    __syncthreads();
    const int* cnts = (const int*)(ws + WS_CNT);
    for (int i = tid; i < G * 8; i += NTHREADS) cn[i] = cnts[i];
    __syncthreads();
    { int t = 0, p = 0;
        for (int w = lane; w < G; w += 64) { const int v = cn[w * 8 + wid]; t += v; p += (w < wg) ? v : 0; }
#pragma unroll
        for (int o = 32; o >= 1; o >>= 1) { t += __shfl_xor(t, o); p += __shfl_xor(p, o); }
        if (lane == 0) { tot[wid] = t; tot[8 + wid] = p; } }
    __syncthreads();
    if (tid == 0) { int ps = 0;
        for (int e = 0; e < 8; ++e) { tot[24 + e] = ps; tot[16 + e] = ps + tot[8 + e]; ps += ((tot[e] + 255) >> 8) << 8; }
        if (wg == 0) { int* hdr = (int*)(ws + WS_HDR); int pp = 0; for (int e = 0; e < 8; ++e) { pp += (tot[e] + 255) >> 8; hdr[e] = pp; } hdr[8] = pp; } }
    __syncthreads();
    { const int e = wid; int run = tot[16 + e];
#pragma unroll
        for (int i = 0; i < 8; ++i) {
            const int q = 2 * tok0 + 64 * i + lane; bool match = false; float gt = 0.f;
            if (q < 2 * tok1) { const f32x4 r = rr[i]; const int ee = __float_as_int(r[0]); const int ex = (q & 1) ? ((ee >> 8) & 0xff) : (ee & 0xff); match = (ex == e); gt = (q & 1) ? r[2] : r[1]; }
            const unsigned long long mask = __ballot(match);
            const int pos = __popcll(mask & ((1ull << lane) - 1ull));
            if (match) { smeta[run + pos] = (u32x2){(unsigned)q, __float_as_uint(gt)}; sstat[run + pos] = ts[i]; }
            run += __popcll(mask);
        }
        if (wg == 0) { const int s0 = tot[24 + e] + tot[e], s1 = tot[24 + e] + (((tot[e] + 255) >> 8) << 8);
            for (int s = s0 + lane; s < s1; s += 64) { smeta[s] = (u32x2){0xffffffffu, 0u}; sstat[s] = (f32x2){0.f, 1.f}; } }
    }
}

__device__ __forceinline__ float wave_total(float x);
__device__ __forceinline__ void final_phase(const Args& a) {
    const int tid = threadIdx.x, lane = tid & 63, wid = tid >> 6;
    unsigned char* ws = a.ws;
    const bf16_t* z3 = (const bf16_t*)(ws + WS_RC); const float* st3 = (const float*)(ws + WS_ST3);
    const bf16_t* Y0 = (const bf16_t*)(ws + WS_RB); const bf16_t* Y1 = (const bf16_t*)(ws + WS_RD);
    const float* g3 = a.in[16] + 2048; const float* b3 = a.in[17] + 2048; const float* g4 = a.in[16] + 3072; const float* b4 = a.in[17] + 3072;
    float G3[16], B3[16], G4[16], B4[16];
#pragma unroll
    for (int hf = 0; hf < 2; ++hf)
#pragma unroll
        for (int q = 0; q < 2; ++q) { const int k = hf * 512 + lane * 8 + q * 4;
            const f32x4 a3 = *(const f32x4*)(g3 + k), c3 = *(const f32x4*)(b3 + k), a4 = *(const f32x4*)(g4 + k), c4 = *(const f32x4*)(b4 + k);
#pragma unroll
            for (int j = 0; j < 4; ++j) { G3[hf * 8 + q * 4 + j] = a3[j] * ALPHA; B3[hf * 8 + q * 4 + j] = c3[j] * ALPHA; G4[hf * 8 + q * 4 + j] = a4[j]; B4[hf * 8 + q * 4 + j] = c4[j]; } }
    const int stride = gridDim.x * 8;
    int tok = blockIdx.x * 8 + wid;
    u32x4 zr[2], y0r[2], y1r[2]; f32x2 sp;
#define FIN_LOAD(t) do { _Pragma("unroll") for (int hf = 0; hf < 2; ++hf) { const size_t o = (size_t)(t) * D + hf * 512 + lane * 8; \
        zr[hf] = *(const u32x4*)(z3 + o); y0r[hf] = *(const u32x4*)(Y0 + o); y1r[hf] = *(const u32x4*)(Y1 + o); } \
        sp = *(const f32x2*)(st3 + (size_t)(t) * 32 + (lane & 15) * 2); } while (0)
    if (tok < NR) FIN_LOAD(tok);
    for (; tok < NR; tok += stride) {
        u32x4 zc[2] = {zr[0], zr[1]}, y0c[2] = {y0r[0], y0r[1]}, y1c[2] = {y1r[0], y1r[1]}; const f32x2 spc = sp;
        if (tok + stride < NR) FIN_LOAD(tok + stride);
        float s1 = spc[0], s2 = spc[1];
#pragma unroll
        for (int o = 1; o < 16; o <<= 1) { s1 += __shfl_xor(s1, o); s2 += __shfl_xor(s2, o); }
        const float mu = s1 * (1.0f / 1024.0f); const float rstd = rsqrtf(fmaxf(s2 * (1.0f / 1024.0f) - mu * mu, 0.f) + LN_EPS);
        float v[16]; float t1 = 0.f;
#pragma unroll
        for (int hf = 0; hf < 2; ++hf) {
            float z[8], y0[8], y1[8];
            g8::unpack8(zc[hf], z); g8::unpack8(y0c[hf], y0); g8::unpack8(y1c[hf], y1);
#pragma unroll
            for (int j = 0; j < 8; ++j) { const float x = ((z[j] - mu) * rstd * G3[hf * 8 + j] + B3[hf * 8 + j]) + (y0[j] + y1[j]); v[hf * 8 + j] = x; t1 += x; }
        }
        t1 = wave_total(t1); const float mean = t1 * (1.0f / 1024.0f); float t2 = 0.f;
#pragma unroll
        for (int j = 0; j < 16; ++j) { const float d = v[j] - mean; t2 += d * d; }
        t2 = wave_total(t2); const float rs = rsqrtf(t2 * (1.0f / 1024.0f) + LN_EPS);
#pragma unroll
        for (int hf = 0; hf < 2; ++hf) {
            const int k = hf * 512 + lane * 8;
            f32x4 o0, o1;
#pragma unroll
            for (int j = 0; j < 4; ++j) { o0[j] = (v[hf * 8 + j] - mean) * rs * G4[hf * 8 + j] + B4[hf * 8 + j]; o1[j] = (v[hf * 8 + 4 + j] - mean) * rs * G4[hf * 8 + 4 + j] + B4[hf * 8 + 4 + j]; }
            *(f32x4*)(a.out + (size_t)tok * D + k) = o0; *(f32x4*)(a.out + (size_t)tok * D + k + 4) = o1;
        }
    }
#undef FIN_LOAD
}

__device__ __forceinline__ void moefix_phase(const Args& a) {
    const int lane = threadIdx.x & 63, wid = threadIdx.x >> 6;
    unsigned char* ws = a.ws;
    const int npan = ((const int*)(ws + WS_HDR))[8];
    const int p_lo = (MOE_NCHUNK - 1) * MOE_CHUNK_PAN + MOE_CHUNK_PAN;
    const int nrows = (npan - p_lo) * 256;
    const u32x2* smeta = (const u32x2*)(ws + WS_TOK);
    const float* P = (const float*)(ws + WS_RA + RA_POFF);
    bf16_t* Y0 = (bf16_t*)(ws + WS_RB); bf16_t* Y1 = (bf16_t*)(ws + WS_RD);
    for (int r = blockIdx.x * 8 + wid; r < nrows; r += gridDim.x * 8) {
        const u32x2 mg = smeta[(size_t)p_lo * 256 + r];
        const int id = (int)mg.x; const float gt = __uint_as_float(mg.y);
        if (id < 0) continue;
        bf16_t* yrow = ((id & 1) ? Y1 : Y0) + (size_t)(id >> 1) * D;
#pragma unroll
        for (int hf = 0; hf < 2; ++hf) {
            const int c = hf * 512 + lane * 8;
            f32x4 s0 = {0.f, 0.f, 0.f, 0.f}, s1 = {0.f, 0.f, 0.f, 0.f};
#pragma unroll
            for (int ks = 0; ks < MOE_KSPLIT; ++ks) { const float* pp = P + ((size_t)ks * 2048 + r) * D + c; s0 += *(const f32x4*)pp; s1 += *(const f32x4*)(pp + 4); }
            *(u32x4*)(yrow + c) = g8::pack8(s0 * gt, s1 * gt);
        }
    }
}
__device__ __forceinline__ void finstats_phase(const float* st, float* rs, int nrows) {
    for (int row = blockIdx.x * NTHREADS + threadIdx.x; row < nrows; row += gridDim.x * NTHREADS) {
        const f32x4* p = (const f32x4*)(st + (size_t)row * 32);
        float s1 = 0.f, s2 = 0.f;
#pragma unroll
        for (int i = 0; i < 8; ++i) { const f32x4 a = p[i]; s1 += a[0] + a[2]; s2 += a[1] + a[3]; }
        const float mu = s1 * (1.0f / 1024.0f); const float rstd = rsqrtf(fmaxf(s2 * (1.0f / 1024.0f) - mu * mu, 0.f) + LN_EPS);
        *(f32x2*)(rs + (size_t)row * 2) = (f32x2){mu, rstd};
    }
}
__global__ void __launch_bounds__(NTHREADS, 2) yoco_fwd(Args args) {
    extern __shared__ __attribute__((aligned(16))) unsigned char lds_raw[];
    LAS unsigned char* lds = (LAS unsigned char*)lds_raw;
    unsigned char* ws = args.ws;
    const int G = gridDim.x;
    const int lo = args.ph_lo, hi = args.ph_hi;
    volatile LAS unsigned* misc = (volatile LAS unsigned*)(lds + LDS_MISC);
    if (threadIdx.x < 4) misc[threadIdx.x] = 0u;
    __syncthreads();
    XcdBarrier bar; bar.bar = (unsigned*)(ws + WS_CTL); bar.x = 0; bar.st = misc;
    if (hi - lo > 1) bar = xcd_barrier_post((unsigned*)(ws + WS_CTL), misc);
    if (PROBE_T >= 0 && blockIdx.x == 0 && threadIdx.x == 0) __hip_atomic_store((unsigned long long*)(ws + WS_DIAG + 32), 0ull, __ATOMIC_RELAXED, __HIP_MEMORY_SCOPE_AGENT);
#ifndef PHASE_MASK
#define PHASE_MASK 0xFFFFFFFFu
#endif
#define IN(k) (((PHASE_MASK >> (k)) & 1u) && lo <= (k) && (k) < hi)
#define SEAM(k) do { if (IN(k) && IN((k) + 1)) xcd_barrier(bar); } while (0)
    bf16_t* RA = (bf16_t*)(ws + WS_RA); bf16_t* RB = (bf16_t*)(ws + WS_RB); bf16_t* RC = (bf16_t*)(ws + WS_RC); bf16_t* RD = (bf16_t*)(ws + WS_RD);
    float* vec = (float*)(ws + WS_VEC);
    float* st1 = (float*)(ws + WS_ST1); float* st2 = (float*)(ws + WS_ST2); float* st3 = (float*)(ws + WS_ST3);
    const float* ln_g = args.in[16]; const float* ln_b = args.in[17];

#define RUN(k, ...) do { if constexpr (((REPMASK) >> (k)) & 1u) { if (IN(k)) { __VA_ARGS__ } xcd_barrier(bar); } \
        if ((k) == PROBE_T && threadIdx.x == 0) ((volatile long long*)(ws + WS_DIAG + 1024))[blockIdx.x] = wall_clock64(); \
        if (IN(k)) { __VA_ARGS__ } \
        if ((k) == PROBE_T && threadIdx.x == 0) { const long long dt_ = wall_clock64() - ((volatile long long*)(ws + WS_DIAG + 1024))[blockIdx.x]; if (PROBE_WG < 0 || (int)blockIdx.x == PROBE_WG) atomicMax((unsigned long long*)(ws + WS_DIAG + 32), (unsigned long long)dt_); } \
        SEAM(k); } while (0)
    RUN(PH_PRO, prologue_phase(lds, args););
    RUN(PH_PROJ,
        g8::Gemm g{RB, (const bf16_t*)(ws + WS_WIN), D, nullptr, nullptr, nullptr}; g8::DenseOrder S; S.init(NPAN, NPROJ / 256, D, G, (int)blockIdx.x);
        g8::EpiPlain E{RA, NPROJ};
        g8::gemm_phase<g8::EpiPlain, g8::DenseOrder, false>(lds, g, S, E); tail_jobs(lds, args, PH_PROJ););
    RUN(PH_MLSTM, if ((int)blockIdx.x < 256) mlstm_phase(lds, RA, (const float*)(ws + WS_GATES), args.in[4], RD, (int)blockIdx.x););
    RUN(PH_WOUT,
        g8::Gemm g{RD, (const bf16_t*)(ws + WS_WOUT), D, nullptr, nullptr, nullptr}; g8::DenseOrder S; S.init(NPAN, 4, D, G, (int)blockIdx.x);
        g8::EpiRes<0> E{RC, RB, st1, lds + LDS_META, nullptr, nullptr};
        g8::gemm_phase<g8::EpiRes<0>, g8::DenseOrder, false>(lds, g, S, E); tail_jobs(lds, args, PH_WOUT););
    RUN(PH_FIN1, finstats_phase(st1, (float*)(ws + WS_RS1), NROWS););
    RUN(PH_GU,
        g8::Gemm g{RC, (const bf16_t*)(ws + WS_WGU), D, nullptr, nullptr, ws + WS_RS1}; g8::DenseOrder S; S.init(NPAN, 2 * FFD / 256, D, G, (int)blockIdx.x);
        g8::EpiGlu<false> E{RA, FFD, st1, vec + VEC_GU_CS, vec + VEC_GU_BW, lds + LDS_META, 0};
        g8::gemm_phase<g8::EpiGlu<false>, g8::DenseOrder, false, 3>(lds, g, S, E); tail_jobs(lds, args, PH_GU););
    RUN(PH_DN,
        g8::Gemm g{RA, (const bf16_t*)(ws + WS_WDN), FFD, nullptr, nullptr, ws + WS_RS1}; g8::DenseOrder S; S.init(NPAN, 4, FFD, G, (int)blockIdx.x);
        g8::EpiRes<1> E{RB, RC, st2, lds + LDS_META, ln_g, ln_b};
        g8::gemm_phase<g8::EpiRes<1>, g8::DenseOrder, false, 3>(lds, g, S, E); tail_jobs(lds, args, PH_DN););
    RUN(PH_FIN2, finstats_phase(st2, (float*)(ws + WS_RS2), NROWS););
    RUN(PH_KVQ,
        g8::Gemm g{RB, (const bf16_t*)(ws + WS_WKVQ), D, nullptr, nullptr, ws + WS_RS2}; g8::DenseOrder S; S.init(NPAN, NPROJ / 256, D, G, (int)blockIdx.x);
        g8::EpiFold E{RA, NPROJ, lds + LDS_META, vec + VEC_KVQ_CS, vec + VEC_KVQ_BW};
        g8::gemm_phase<g8::EpiFold, g8::DenseOrder, false, 3>(lds, g, S, E); tail_jobs(lds, args, PH_KVQ););
    RUN(PH_ATT, attn_phase(lds, RA, RD););
    RUN(PH_WO,
        g8::Gemm g{RD, (const bf16_t*)(ws + WS_WO), D, nullptr, nullptr, ws + WS_RS2}; g8::DenseOrder S; S.init(NR / 256, 4, D, G, (int)blockIdx.x);
        g8::EpiRes<1> E{RC, RB, st3, lds + LDS_META, ln_g + 1024, ln_b + 1024};
        g8::gemm_phase<g8::EpiRes<1>, g8::DenseOrder, false, 3>(lds, g, S, E););
    RUN(PH_RT1, router1_phase(lds, args););
    RUN(PH_RT2, router2_phase(lds, args););
#define MOE_CHUNK(cidx) \
    RUN(PH_MOE0 + 2 * (cidx), const int* hdr = (const int*)(ws + WS_HDR); const int npan = hdr[8]; const int p0 = (cidx) * MOE_CHUNK_PAN; \
        { g8::MoeOrder S; S.p0 = p0; S.np = ((cidx) == MOE_NCHUNK - 1) ? (npan - p0) : MOE_CHUNK_PAN; S.nfull = MOE_CHUNK_PAN; S.nsplit = 1; S.nN = 2 * FFE / 256; S.G = G; S.c = (int)blockIdx.x; S.K = D; S.estride = (unsigned)(2 * FFE * D * 2); \
            _Pragma("unroll") for (int e = 0; e < NE; ++e) S.pend[e] = hdr[e]; \
            g8::Gemm g{RC, (const bf16_t*)(ws + WS_WEGU), D, (const int*)(ws + WS_TOK), ws + WS_TOK, ws + WS_GATEB}; \
            g8::EpiGlu<true> E{RA, FFE, st3, vec + VEC_EGU_CS, vec + VEC_EGU_BW, lds + LDS_META, 2 * FFE}; \
            g8::gemm_phase<g8::EpiGlu<true>, g8::MoeOrder, true, 1>(lds, g, S, E); }); \
    RUN(PH_MOE0 + 2 * (cidx) + 1, const int* hdr = (const int*)(ws + WS_HDR); const int npan = hdr[8]; const int p0 = (cidx) * MOE_CHUNK_PAN; \
        { g8::MoeOrder S; S.p0 = p0; S.np = ((cidx) == MOE_NCHUNK - 1) ? (npan - p0) : MOE_CHUNK_PAN; S.nfull = MOE_CHUNK_PAN; S.nsplit = MOE_KSPLIT; S.nN = 4; S.G = G; S.c = (int)blockIdx.x; S.K = FFE; S.estride = (unsigned)(D * FFE * 2); \
            _Pragma("unroll") for (int e = 0; e < NE; ++e) S.pend[e] = hdr[e]; \
            g8::Gemm g{RA, (const bf16_t*)(ws + WS_WEDN), FFE, nullptr, ws + WS_TOK, nullptr}; \
            g8::EpiMoeDown E{RB, RD, lds + LDS_META, (float*)((unsigned char*)RA + RA_POFF), MOE_CHUNK_PAN}; \
            g8::gemm_phase<g8::EpiMoeDown, g8::MoeOrder, false, 2>(lds, g, S, E); });
    MOE_CHUNK(0) MOE_CHUNK(1) MOE_CHUNK(2) MOE_CHUNK(3)
    RUN(PH_FIX, moefix_phase(args););
    RUN(PH_FINAL, final_phase(args););
    if (PROBE_T >= 0 && blockIdx.x == 0 && threadIdx.x == 0) { const long long dl = 4 * (long long)__hip_atomic_load((unsigned long long*)(ws + WS_DIAG + 32), __ATOMIC_RELAXED, __HIP_MEMORY_SCOPE_AGENT); const long long t0 = wall_clock64(); while (wall_clock64() - t0 < dl) __builtin_amdgcn_s_sleep(8); }
#undef RUN
#undef IN
#undef SEAM
}

extern "C" void kernel_launch(void* const* d_in, const int* in_sizes, int n_in, void* d_out, int out_size, void* d_ws, size_t ws_size, hipStream_t stream) {
    static int grid = 0;
    if (grid == 0) {
        if (n_in != 18 || out_size != NR * D || ws_size < WS_END) { fprintf(stderr, "kernel_launch: unexpected problem (n_in %d out %d ws %zu need %zu)\n", n_in, out_size, ws_size, (size_t)WS_END); grid = -1; return; }
        int dev = 0, cus = 0, per_cu = 0;
        if (hipGetDevice(&dev) != hipSuccess || hipDeviceGetAttribute(&cus, hipDeviceAttributeMultiprocessorCount, dev) != hipSuccess) { grid = -1; return; }
        if (hipFuncSetAttribute((const void*)yoco_fwd, hipFuncAttributeMaxDynamicSharedMemorySize, LDS_BYTES) != hipSuccess) { fprintf(stderr, "kernel_launch: hipFuncSetAttribute failed\n"); grid = -1; return; }
        if (hipOccupancyMaxActiveBlocksPerMultiprocessor(&per_cu, (const void*)yoco_fwd, NTHREADS, LDS_BYTES) != hipSuccess || per_cu < 1) { fprintf(stderr, "kernel_launch: occupancy query says %d\n", per_cu); }
        (void)hipGetLastError();
        if (cus < 256) { fprintf(stderr, "kernel_launch: needs 256 CUs\n"); grid = -1; return; }
        grid = 256;
    }
    if (grid < 0) return;
    (void)hipMemsetAsync((char*)d_ws + WS_CTL, 0, CTL_BYTES, stream);
    Args a{};
    for (int i = 0; i < 18; ++i) a.in[i] = (const float*)d_in[i];
    a.out = (float*)d_out; a.ws = (unsigned char*)d_ws;
#if N_LAUNCH_MODE == 1
    for (int p = 0; p < PH_COUNT; ++p) { a.ph_lo = p; a.ph_hi = p + 1; hipLaunchKernelGGL(yoco_fwd, dim3(grid), dim3(NTHREADS), LDS_BYTES, stream, a); }
#else
    a.ph_lo = 0; a.ph_hi = PH_COUNT;
    hipLaunchKernelGGL(yoco_fwd, dim3(grid), dim3(NTHREADS), LDS_BYTES, stream, a);
#endif
}
```

```cpp
#include <hip/hip_runtime.h>
#include <cstdio>
#include <cstdint>

#ifndef N_LAUNCH_MODE
#define N_LAUNCH_MODE 0
#endif
#ifndef PROBE_CLK
#define PROBE_CLK 0
#endif
#ifndef PROBE_T
#define PROBE_T (-1)
#endif
#ifndef PROBE_WG
#define PROBE_WG (-1)
#endif
#ifndef REPMASK
#define REPMASK 0u
#endif

#define LAS __attribute__((address_space(3)))
typedef unsigned short bf16_t;
typedef short bf16x8 __attribute__((ext_vector_type(8)));
typedef float f32x2 __attribute__((ext_vector_type(2)));
typedef float f32x4 __attribute__((ext_vector_type(4)));
typedef float f32x16 __attribute__((ext_vector_type(16)));
typedef unsigned u32x2 __attribute__((ext_vector_type(2)));
typedef unsigned u32x4 __attribute__((ext_vector_type(4)));
typedef int i32x4 __attribute__((ext_vector_type(4)));
typedef __bf16 bf16x2_t __attribute__((ext_vector_type(2)));

constexpr int D = 1024, NB = 16, SEQ = 4096, NMETA = 16;
constexpr int NR = NB * SEQ;
constexpr int NROWS = NR + NB * NMETA;
constexpr int NPAN = NROWS / 256;
constexpr int NPROJ = 3072;
constexpr int FFD = 2816, NE = 8, FFE = 3584;
constexpr float ALPHA = 1.41421356237f, LN_EPS = 1e-5f;
constexpr float HN_CLIP = 3.5f;
constexpr float AO_CLIP = 3.0f;
constexpr float Z_CLIP = 6.0f;
constexpr size_t RA_Z1Q = (size_t)256 << 20;
constexpr float ACT_CLIP = 8.0f;
constexpr int NTHREADS = 512;
constexpr int MOE_ROWS = 2 * NR + NE * 256;
constexpr int MOE_CHUNK_PAN = 256;
constexpr int MOE_NCHUNK = 2;
constexpr int MOE_KSPLIT = 7;
constexpr size_t RA_POFF = (size_t)256 << 20;
constexpr size_t RA_Z3Q = (size_t)320 << 20;

constexpr size_t al256(size_t x) { return (x + 255) & ~(size_t)255; }
constexpr size_t WS_CTL = 0;
constexpr size_t CTL_BYTES = 65536;
constexpr size_t WS_WIN = WS_CTL + CTL_BYTES;
constexpr size_t WS_WOUT = WS_WIN + (size_t)NPROJ * D * 2;
constexpr size_t WS_WGU = WS_WOUT + (size_t)D * D * 2;
constexpr size_t WS_WDN = WS_WGU + (size_t)2 * FFD * D * 2;
constexpr size_t WS_WKVQ = WS_WDN + (size_t)D * FFD * 2;
constexpr size_t WS_WO = WS_WKVQ + (size_t)NPROJ * D * 2;
constexpr size_t WS_WEGU = WS_WO + (size_t)D * D * 2;
constexpr size_t WS_WEDN = WS_WEGU + (size_t)NE * 2 * FFE * D * 2;
constexpr size_t WS_VEC = WS_WEDN + (size_t)NE * D * FFE * 2;
constexpr int VEC_GU_CS = 0, VEC_GU_BW = 2 * FFD, VEC_KVQ_CS = 4 * FFD, VEC_KVQ_BW = VEC_KVQ_CS + NPROJ, VEC_EGU_CS = VEC_KVQ_BW + NPROJ, VEC_EGU_BW = VEC_EGU_CS + NE * 2 * FFE, VEC_EGU_SC = VEC_EGU_BW + NE * 2 * FFE, VEC_GU_SC = VEC_EGU_SC + NE * 2 * FFE, VEC_KVQ_SC = VEC_GU_SC + 2 * FFD, VEC_EDN_SC = VEC_KVQ_SC + NPROJ, VEC_WIN_SC = VEC_EDN_SC + NE * D, VEC_DN_SC = VEC_WIN_SC + NPROJ, VEC_WOUT_SC = VEC_DN_SC + D, VEC_WO_SC = VEC_WOUT_SC + D, VEC_END = VEC_WO_SC + D;
constexpr size_t WS_GATES = al256(WS_VEC + (size_t)VEC_END * 4);
constexpr size_t WS_ST1 = al256(WS_GATES + (size_t)NROWS * 8 * 4);
constexpr size_t WS_ST2 = WS_ST1 + (size_t)NROWS * 16 * 8;
constexpr size_t WS_ST3 = WS_ST2 + (size_t)NROWS * 16 * 8;
constexpr size_t WS_ROUTE = WS_ST3 + (size_t)NROWS * 16 * 8;
constexpr size_t WS_CNT = WS_ROUTE + (size_t)NR * 16;
constexpr size_t WS_HDR = WS_CNT + 256 * 8 * 4;
constexpr size_t WS_TOK = WS_HDR + 256;
constexpr size_t WS_GATEB = al256(WS_TOK + (size_t)MOE_ROWS * 8);
constexpr size_t WS_TOKST = al256(WS_GATEB + (size_t)MOE_ROWS * 8);
constexpr size_t WS_RS1 = al256(WS_TOKST + (size_t)NR * 8);
constexpr size_t WS_RS2 = al256(WS_RS1 + (size_t)NROWS * 8);
constexpr size_t WS_RQ1 = al256(WS_RS2 + (size_t)NROWS * 8);
constexpr size_t WS_RQ2 = al256(WS_RQ1 + (size_t)NROWS * 8);
constexpr size_t WS_DIAG = al256(WS_RQ2 + (size_t)NROWS * 8);
constexpr size_t WS_RA = al256(WS_DIAG + 4096);
constexpr size_t RA_BYTES = (size_t)NROWS * NPROJ * 2;
constexpr size_t WS_RB = al256(WS_RA + RA_BYTES);
constexpr size_t RX_BYTES = (size_t)NROWS * D * 2;
constexpr size_t WS_RC = al256(WS_RB + RX_BYTES);
constexpr size_t WS_RD = al256(WS_RC + RX_BYTES);
constexpr size_t WS_END = al256(WS_RD + RX_BYTES);

constexpr int LDS_MAIN = 131072, LDS_META = LDS_MAIN  , LDS_MISC = LDS_META + 8192  , LDS_BYTES = LDS_MISC + 256;
__device__ __forceinline__ float bf2f(bf16_t v) { return __uint_as_float(((unsigned)v) << 16); }
__device__ __forceinline__ float bflo(unsigned u) { return __uint_as_float(u << 16); }
__device__ __forceinline__ float bfhi(unsigned u) { return __uint_as_float(u & 0xffff0000u); }
__device__ __forceinline__ unsigned pk2(float lo, float hi) { f32x2 v = {lo, hi}; bf16x2_t b = __builtin_convertvector(v, bf16x2_t); return __builtin_bit_cast(unsigned, b); }
__device__ __forceinline__ bf16_t f2bf(float f) { return (bf16_t)(pk2(f, 0.f) & 0xffffu); }
__device__ __forceinline__ float rbf(float f) { return bflo(pk2(f, 0.f)); }
__device__ __forceinline__ float wave_sum(float v) {
#pragma unroll
    for (int o = 32; o >= 1; o >>= 1) v += __shfl_xor(v, o);
    return v;
}
__device__ __forceinline__ float swap32_hi(float x, float& lo) {
    const u32x2 r = __builtin_amdgcn_permlane32_swap(__float_as_uint(x), __float_as_uint(x), false, false); lo = __uint_as_float(r.x); return __uint_as_float(r.y); }
__device__ __forceinline__ float fq_sum(float x) {
    const u32x2 a = __builtin_amdgcn_permlane16_swap(__float_as_uint(x), __float_as_uint(x), false, false); const float y = __uint_as_float(a.x) + __uint_as_float(a.y);
    const u32x2 b = __builtin_amdgcn_permlane32_swap(__float_as_uint(y), __float_as_uint(y), false, false); return __uint_as_float(b.x) + __uint_as_float(b.y); }
__device__ __forceinline__ float sigmoidf_(float x) { return __builtin_amdgcn_rcpf(1.0f + __builtin_amdgcn_exp2f(x * -1.4426950408889634f)); }

#define XB_TMO      128
#define XB_XCNT(j)  (256  + 64 * (j))
#define XB_XSUB(j)  (1280 + 64 * (j))
#define XB_XGEN(j)  (2304 + 64 * (j))
#define XB_TOP      3328
#define XB_TOPGEN   3392
#define XCD_BAR_WORDS 3456
#define XB_SPIN_CAP (1u << 20)
__device__ __forceinline__ unsigned xb_ld(unsigned* p)              { return __hip_atomic_load(p, __ATOMIC_RELAXED, __HIP_MEMORY_SCOPE_AGENT); }
__device__ __forceinline__ unsigned xb_add(unsigned* p, unsigned v) { return __hip_atomic_fetch_add(p, v, __ATOMIC_RELAXED, __HIP_MEMORY_SCOPE_AGENT); }
__device__ __forceinline__ unsigned xb_xcc_id() { return (unsigned)__builtin_amdgcn_s_getreg((3 << 11) | 20) & 0xFu; }
#define XB_SPIN(cond, bar) do { unsigned _sp = 0; while (cond) { __builtin_amdgcn_s_sleep(1); \
    if ((++_sp & 255u) == 0u) { if (xb_ld(&(bar)[XB_TMO])) break; if (_sp > XB_SPIN_CAP) { atomicAdd(&(bar)[XB_TMO], 1u); break; } } } } while (0)
struct XcdBarrier { unsigned* bar; unsigned x; volatile LAS unsigned* st; };
__device__ __forceinline__ XcdBarrier xcd_barrier_post(unsigned* bar, volatile LAS unsigned* st) {
    XcdBarrier b; b.bar = bar; b.x = xb_xcc_id(); b.st = st;
    if (threadIdx.x == 0) (void)xb_add(&bar[XB_XCNT(b.x)], 1u);
    return b;
}
__device__ __forceinline__ void xcd_barrier_complete(unsigned* bar, unsigned x, unsigned& nloc, unsigned& nx) {
    const unsigned G = gridDim.x * gridDim.y * gridDim.z;
    unsigned sum, cnt, mine, sp = 0u;
    for (;;) {
        sum = 0u; cnt = 0u; mine = 0u;
#pragma unroll
        for (unsigned j = 0; j < 16; ++j) { const unsigned c = xb_ld(&bar[XB_XCNT(j)]); sum += c; cnt += (c > 0u) ? 1u : 0u; mine = (j == x) ? c : mine; }
        if (sum == G) break;
        __builtin_amdgcn_s_sleep(1);
        if ((++sp & 255u) == 0u) { if (xb_ld(&bar[XB_TMO])) break; if (sp > XB_SPIN_CAP) { atomicAdd(&bar[XB_TMO], 1u); break; } }
    }
    nloc = mine > 0u ? mine : 1u; nx = cnt > 0u ? cnt : 1u;
}
__device__ __forceinline__ void xcd_barrier(const XcdBarrier& b) {
    asm volatile("s_waitcnt vmcnt(0)" ::: "memory");
    __syncthreads();
    if (threadIdx.x == 0) {
        unsigned* bar = b.bar;
        __builtin_amdgcn_s_waitcnt(0);
        unsigned nloc = b.st[0], nx = b.st[1];
        if (nloc == 0u) { xcd_barrier_complete(bar, b.x, nloc, nx); b.st[0] = nloc; b.st[1] = nx; }
        const unsigned old = xb_add(&bar[XB_XSUB(b.x)], 1u);
        const unsigned gen = old / nloc;
        if (old + 1u == (gen + 1u) * nloc) {
            __builtin_amdgcn_fence(__ATOMIC_RELEASE, "agent");
            asm volatile("s_waitcnt vmcnt(0)" ::: "memory");
            const unsigned og = xb_add(&bar[XB_TOP], 1u);
            const unsigned tg = og / nx;
            if (og + 1u == (tg + 1u) * nx) xb_add(&bar[XB_TOPGEN], 1u);
            else XB_SPIN(xb_ld(&bar[XB_TOPGEN]) == tg, bar);
            __builtin_amdgcn_fence(__ATOMIC_ACQUIRE, "agent");
            xb_add(&bar[XB_XGEN(b.x)], 1u);
            asm volatile("s_waitcnt vmcnt(0)" ::: "memory");
        } else {
            XB_SPIN(xb_ld(&bar[XB_XGEN(b.x)]) == gen, bar);
            __builtin_amdgcn_fence(__ATOMIC_ACQUIRE, "agent");
            asm volatile("s_waitcnt vmcnt(0)" ::: "memory");
        }
    }
    __syncthreads();
}

namespace g8 {
constexpr int BM = 256, BK = 64, HALF = 128, HTB = HALF * BK * 2, STAGE_BYTES = 8 * HTB, NXCD = 8, WGM = 8;
__host__ __device__ __forceinline__ int lds_byte(int r, int c) { const int st = (r >> 4) * 2 + (c >> 5), rr = r & 15, cc = c & 31, ob = rr * 64 + cc * 2; return st * 1024 + (ob ^ (((ob >> 9) & 1) << 5)); }
__host__ __device__ __forceinline__ void stage_rc(int b, int& R, int& C) { const int st = b / 1024, sb = b % 1024, swz = sb ^ (((sb >> 9) & 1) << 5); R = (st >> 1) * 16 + swz / 64; C = (st & 1) * 32 + (swz % 64) / 2; }
__host__ __device__ __forceinline__ int perm32(int rho) { const int n = rho >> 4, i = rho & 15; return 8 * (i >> 2) + 4 * n + (i & 3); }

struct Unit { int pm, pn, gp; unsigned boff; int aux; int kt; unsigned koff; int ks; };
struct Gemm { const bf16_t* A; const bf16_t* Bt; int K; const int* rowtab; const unsigned char* smeta; const unsigned char* sstat; };

struct DenseOrder {
    int nM, nN, nwg, G, c, K;
    __device__ void init(int nM_, int nN_, int K_, int G_, int c_) { nM = nM_; nN = nN_; nwg = nM * nN; G = G_; c = c_; K = K_; }
    __device__ bool next(int i, Unit& u) const {
        const long L = (long)i * G + c; if (L >= nwg) return false;
        int wgid = (int)L; { const int q = nwg / NXCD, r = nwg % NXCD, xcd = wgid % NXCD, off = wgid / NXCD; wgid = (xcd < r ? xcd * (q + 1) : r * (q + 1) + (xcd - r) * q) + off; }
        const int nig = WGM * nN, gid = wgid / nig, fm = gid * WGM, gsz = (nM - fm) < WGM ? (nM - fm) : WGM;
        u.pm = fm + ((wgid % nig) % gsz); u.pn = (wgid % nig) / gsz; u.gp = u.pm; u.boff = (unsigned)u.pn * (unsigned)(256 * K * 2); u.kt = K / BK; u.koff = 0u; u.ks = -1; return true;
    }
};
struct MoeOrder {
    int p0, np, nN, G, c, K; unsigned estride; int pend[NE]; int nfull, nsplit;
    __device__ bool next(int i, Unit& u) const {
        const long L = (long)i * G + c; const long nmain = (long)nfull * nN;
        int pn, pml, ks = -1;
        if (L < nmain) {
            if (G == 256 && (nfull & 63) == 0 && (nN & 3) == 0) { const int x = c & 7, j = c >> 3, rpb = nN >> 2, pb = x + 8 * (i / rpb), nb = i % rpb;
                pml = 8 * pb + (j & 7); pn = 4 * nb + (j >> 3); }
            else { pn = (int)(L / nfull); pml = (int)(L % nfull); } }
        else { const long r = L - nmain; if (r >= (long)(np - nfull) * nN * nsplit) return false;
            ks = (int)(r % nsplit); const int q = (int)(r / nsplit); pn = q % nN; pml = nfull + q / nN; if (nsplit == 1) ks = -1; }
        const int gp = p0 + pml;
        int e = 0;
#pragma unroll
        for (int j = 0; j < NE - 1; ++j) e += (gp >= pend[j]) ? 1 : 0;
        const int ktall = K / BK;
        u.pm = pml; u.pn = pn; u.gp = gp; u.ks = ks; u.kt = ks < 0 ? ktall : ktall / nsplit; u.koff = ks < 0 ? 0u : (unsigned)(ks * (K / nsplit) * 2);
        u.boff = (unsigned)e * estride + (unsigned)pn * (unsigned)(256 * K * 2) + u.koff; return true;
    }
};

template <class Epi, class Sched, bool GATHER, int META = 0, bool I8 = false>
__device__ __forceinline__ void gemm_phase(LAS unsigned char* lds, const Gemm g, const Sched& S, const Epi& E) {
    int tid_ = threadIdx.x; asm volatile("" : "+v"(tid_));
    const int tid = tid_, wid = __builtin_amdgcn_readfirstlane(tid >> 6), lane = tid & 63, wr = wid >> 2, wc = wid & 3, fr = lane & 15, fq = lane >> 4;
    const int K = g.K;
    int Rr[2], Cc[2]; unsigned voffA[2], voffB[2];
#pragma unroll
    for (int i = 0; i < 2; ++i) { stage_rc(tid * 16 + i * 8192, Rr[i], Cc[i]); const int Rb = (Rr[i] & ~31) + perm32(Rr[i] & 31);
        voffA[i] = (unsigned)(Rr[i] * K + Cc[i]) * 2u; voffB[i] = (unsigned)(Rb * K + Cc[i]) * 2u; }
    const size_t kstep = (size_t)(BK * 2);
    const size_t hstep = (size_t)HALF * K * 2;
    const size_t tstep = 2 * hstep;
    const unsigned ldsw = (unsigned)wid * 1024u;
    const int aoff = lds_byte(wr * 64 + fr, fq * 8), boff = lds_byte(wc * 32 + fr, fq * 8);
#define G8_SA(b, h) (((b) * 2 + (h)) * HTB)
#define G8_SB(b, h) ((4 + (b) * 2 + (h)) * HTB)
#define G8_STAGE(bufoff, gbase, voff) do { _Pragma("unroll") for (int _i = 0; _i < 2; ++_i) \
        __builtin_amdgcn_global_load_lds((const unsigned*)((const char*)(gbase) + (voff)[_i]), (LAS unsigned*)(lds + (bufoff) + ldsw + _i * 8192), 16, 0, 0); } while (0)
#define G8_STA(bufoff, ptr, offs, h) do { if constexpr (GATHER) { G8_STAGE(bufoff, (const char*)g.A, (offs)[h]); } else { G8_STAGE(bufoff, (ptr) + (h) * hstep, voffA); } } while (0)
#define G8_LDA(dst, b, h) do { _Pragma("unroll") for (int m = 0; m < 4; ++m) _Pragma("unroll") for (int k = 0; k < 2; ++k) dst[m][k] = *(const LAS bf16x8*)(lds + G8_SA(b, h) + aoff + m * 2048 + k * 1024); } while (0)
#define G8_LDB(dst, b, h) do { _Pragma("unroll") for (int n = 0; n < 2; ++n) _Pragma("unroll") for (int k = 0; k < 2; ++k) dst[n][k] = *(const LAS bf16x8*)(lds + G8_SB(b, h) + boff + n * 2048 + k * 1024); } while (0)
#define G8_MMA(ai, bj, At, Bt) do { __builtin_amdgcn_s_setprio(1); _Pragma("unroll") for (int m = 0; m < 4; ++m) _Pragma("unroll") for (int n = 0; n < 2; ++n) _Pragma("unroll") for (int k = 0; k < 2; ++k) \
        { if constexpr (I8) acc[ai][bj][m][n] = __builtin_bit_cast(f32x4, __builtin_amdgcn_mfma_i32_16x16x64_i8(__builtin_bit_cast(i32x4, Bt[n][k]), __builtin_bit_cast(i32x4, At[m][k]), __builtin_bit_cast(i32x4, acc[ai][bj][m][n]), 0, 0, 0)); \
          else acc[ai][bj][m][n] = __builtin_amdgcn_mfma_f32_16x16x32_bf16(Bt[n][k], At[m][k], acc[ai][bj][m][n], 0, 0, 0); } __builtin_amdgcn_s_setprio(0); } while (0)
#define G8_WAIT_V(n) asm volatile("s_waitcnt vmcnt(" #n ")" ::: "memory")
#define G8_WAIT_L(n) asm volatile("s_waitcnt lgkmcnt(" #n ")" ::: "memory")
#define G8_BAR __builtin_amdgcn_s_barrier()
#define G8_SCHED __builtin_amdgcn_sched_barrier(0)
#define G8_ROWOFFS(dst, U) do { _Pragma("unroll") for (int _h = 0; _h < 2; ++_h) _Pragma("unroll") for (int _i = 0; _i < 2; ++_i) { \
        const int _id = g.rowtab[2 * ((U).gp * 256 + _h * 128 + Rr[_i])]; const int _tk = _id < 0 ? 0 : (_id >> 1); dst[_h][_i] = (unsigned)(_tk * K + Cc[_i]) * 2u; } } while (0)
#define G8_META_DMA(gsrc, panel, bufidx) __builtin_amdgcn_global_load_lds((const unsigned*)((gsrc) + (size_t)(panel) * 2048 + wid * 256 + lane * 4), (LAS unsigned*)(lds + LDS_META + (bufidx) * 2048 + wid * 256), 4, 0, 0)
    Unit cur, nxt; int ui = 0;
    if (!S.next(0, cur)) return;
    f32x4 acc[2][2][4][2];
#pragma unroll
    for (int a = 0; a < 2; ++a)
#pragma unroll
        for (int b = 0; b < 2; ++b)
#pragma unroll
            for (int m = 0; m < 4; ++m)
#pragma unroll
                for (int n = 0; n < 2; ++n) acc[a][b][m][n] = (f32x4){0.f, 0.f, 0.f, 0.f};
    bf16x8 At[4][2], B0[2][2], B1[2][2];
    const char* cA = (const char*)g.A + (size_t)cur.pm * tstep + cur.koff; const char* cB = (const char*)g.Bt + cur.boff;
    unsigned oc[2][2], on[2][2], o1[2][2], o2[2][2], o3[2][2];
    if constexpr (GATHER) { G8_ROWOFFS(oc, cur);
#pragma unroll
        for (int h = 0; h < 2; ++h)
#pragma unroll
            for (int i = 0; i < 2; ++i) { o1[h][i] = oc[h][i] + 128u; on[h][i] = oc[h][i]; o2[h][i] = 0; o3[h][i] = 0; } }
    G8_STAGE(G8_SB(0, 0), cB, voffB); G8_STAGE(G8_SB(0, 1), cB + hstep, voffB); G8_STA(G8_SA(0, 0), cA, oc, 0); G8_STA(G8_SA(0, 1), cA, oc, 1);
    if (wr == 1) G8_BAR;
    G8_WAIT_V(2); G8_BAR;
    G8_STAGE(G8_SB(1, 0), cB + kstep, voffB); G8_STA(G8_SA(1, 0), cA + kstep, o1, 0); G8_STAGE(G8_SB(1, 1), cB + hstep + kstep, voffB);
    G8_WAIT_V(6); G8_BAR;
    for (;;) {
        const bool has_next = S.next(ui + 1, nxt);
        const char* nA = has_next ? (const char*)g.A + (size_t)nxt.pm * tstep + nxt.koff : cA; const char* nB = has_next ? (const char*)g.Bt + nxt.boff : cB;
        const int nt = cur.kt;
        if constexpr (META == 1) { if (has_next) G8_META_DMA(g.smeta, nxt.gp, (ui + 1) & 1); G8_META_DMA(g.sstat, cur.gp, 2 + (ui & 1)); }
        if constexpr (META == 2) { G8_META_DMA(g.smeta, cur.gp, ui & 1); }
        if constexpr (META == 3) { G8_META_DMA(g.sstat, cur.pm, 2 + (ui & 1)); }
        for (int t = 0; t < nt; t += 2) {
            const bool last = (t == nt - 2);
            const char* a1 = cA + (size_t)(t + 1) * kstep;
            const char* a2 = last ? nA : cA + (size_t)(t + 2) * kstep; const char* b2 = last ? nB : cB + (size_t)(t + 2) * kstep;
            const char* a3 = a2 + kstep; const char* b3 = b2 + kstep;
            if constexpr (GATHER) {
                if (last) {
#pragma unroll
                    for (int h = 0; h < 2; ++h)
#pragma unroll
                        for (int i = 0; i < 2; ++i) { int id = -1; if (has_next) id = *(const LAS int*)(lds + LDS_META + ((ui + 1) & 1) * 2048 + (h * 128 + Rr[i]) * 8);
                            const int tk = id < 0 ? 0 : (id >> 1); on[h][i] = has_next ? (unsigned)(tk * K + Cc[i]) * 2u : oc[h][i]; } }
#pragma unroll
                for (int h = 0; h < 2; ++h)
#pragma unroll
                    for (int i = 0; i < 2; ++i) { o1[h][i] = oc[h][i] + (unsigned)(t + 1) * 128u; o2[h][i] = last ? on[h][i] : oc[h][i] + (unsigned)(t + 2) * 128u; o3[h][i] = o2[h][i] + 128u; } }
            G8_LDB(B0, 0, 0); G8_LDB(B1, 0, 1); G8_SCHED; G8_LDA(At, 0, 0); G8_STA(G8_SA(1, 1), a1, o1, 1);
            G8_WAIT_V(8); G8_WAIT_L(0); G8_BAR; G8_MMA(0, 0, At, B0); G8_MMA(0, 1, At, B1); G8_BAR; G8_SCHED;
            G8_LDA(At, 0, 1); G8_STAGE(G8_SB(0, 0), b2, voffB); G8_STAGE(G8_SB(0, 1), b2 + hstep, voffB); G8_STA(G8_SA(0, 0), a2, o2, 0);
            G8_WAIT_V(8); G8_WAIT_L(0); G8_BAR; G8_MMA(1, 0, At, B0); G8_MMA(1, 1, At, B1); G8_BAR; G8_SCHED;
            G8_LDB(B0, 1, 0); G8_LDB(B1, 1, 1); G8_SCHED; G8_LDA(At, 1, 0); G8_STA(G8_SA(0, 1), a2, o2, 1);
            G8_WAIT_V(8); G8_WAIT_L(0); G8_BAR; G8_MMA(0, 0, At, B0); G8_MMA(0, 1, At, B1); G8_BAR; G8_SCHED;
            G8_LDA(At, 1, 1); G8_STAGE(G8_SB(1, 0), b3, voffB); G8_STAGE(G8_SB(1, 1), b3 + hstep, voffB); G8_STA(G8_SA(1, 0), a3, o3, 0);
            G8_WAIT_V(8); G8_WAIT_L(0); G8_BAR; G8_MMA(1, 0, At, B0); G8_MMA(1, 1, At, B1); G8_BAR; G8_SCHED;
        }
        if (wr == 0) G8_BAR;
        cur.aux = ui & 1;
        if constexpr (Epi::PRESCALE) E.prescale(acc, cur, wc, fq);
        E(acc, cur, wr, wc, fr, fq);
        if (!has_next) break;
#pragma unroll
        for (int a = 0; a < 2; ++a)
#pragma unroll
            for (int b = 0; b < 2; ++b)
#pragma unroll
                for (int m = 0; m < 4; ++m)
#pragma unroll
                    for (int n = 0; n < 2; ++n) { f32x2 z0_, z1_; asm volatile("v_mov_b64 %0, 0" : "=v"(z0_)); asm volatile("v_mov_b64 %0, 0" : "=v"(z1_)); acc[a][b][m][n] = (f32x4){z0_[0], z0_[1], z1_[0], z1_[1]}; }
        cur = nxt; cA = nA; cB = nB; ++ui;
        if constexpr (GATHER) {
#pragma unroll
            for (int h = 0; h < 2; ++h)
#pragma unroll
                for (int i = 0; i < 2; ++i) oc[h][i] = on[h][i]; }
        if (wr == 1) G8_BAR;
    }
    G8_WAIT_V(0);
    G8_BAR;
#undef G8_SA
#undef G8_SB
#undef G8_STAGE
#undef G8_STA
#undef G8_LDA
#undef G8_LDB
#undef G8_MMA
#undef G8_WAIT_V
#undef G8_WAIT_L
#undef G8_BAR
#undef G8_SCHED
#undef G8_ROWOFFS
#undef G8_META_DMA
}

typedef f32x4 Acc[2][2][4][2];
__device__ __forceinline__ int qc8_(float x) { const int q = (int)__builtin_rintf(x); return q < -127 ? -127 : (q > 127 ? 127 : q); }
__device__ __forceinline__ u32x4 pack8(const f32x4 a, const f32x4 b) { u32x4 w; w.x = pk2(a[0], a[1]); w.y = pk2(a[2], a[3]); w.z = pk2(b[0], b[1]); w.w = pk2(b[2], b[3]); return w; }
__device__ __forceinline__ void unpack8(const u32x4 w, float (&f)[8]) { f[0] = bflo(w.x); f[1] = bfhi(w.x); f[2] = bflo(w.y); f[3] = bfhi(w.y); f[4] = bflo(w.z); f[5] = bfhi(w.z); f[6] = bflo(w.w); f[7] = bfhi(w.w); }
__device__ __forceinline__ void row_stats(const float* st, int row, int fq, float& mu, float& rstd) {
    const f32x4* p = (const f32x4*)(st + (size_t)row * 32 + fq * 8);
    const f32x4 a = p[0], b = p[1];
    float s1 = (a[0] + a[2]) + (b[0] + b[2]), s2 = (a[1] + a[3]) + (b[1] + b[3]);
    s1 += __shfl_xor(s1, 16); s1 += __shfl_xor(s1, 32); s2 += __shfl_xor(s2, 16); s2 += __shfl_xor(s2, 32);
    mu = s1 * (1.0f / 1024.0f); const float var = fmaxf(s2 * (1.0f / 1024.0f) - mu * mu, 0.f); rstd = rsqrtf(var + LN_EPS);
}
__device__ __forceinline__ void put_stats(float* st, int row, int slot, int fq, float s1, float s2) {
    s1 = fq_sum(s1); s2 = fq_sum(s2);
    if (fq == 0) *(f32x2*)(st + (size_t)row * 32 + slot * 2) = (f32x2){s1, s2};
}

struct EpiPlain {
    static constexpr bool PRESCALE = false;
    bf16_t* O; int ldc;
    __device__ __forceinline__ void operator()(const Acc& acc, const Unit& u, int wr, int wc, int fr, int fq) const {
        const int row0 = u.pm * 256 + wr * 64 + fr, col0 = u.pn * 256 + wc * 32 + 8 * fq;
#pragma unroll
        for (int ai = 0; ai < 2; ++ai)
#pragma unroll
            for (int m = 0; m < 4; ++m) { bf16_t* rowp = O + (size_t)(row0 + ai * 128 + m * 16) * ldc + col0;
#pragma unroll
                for (int bj = 0; bj < 2; ++bj) *(u32x4*)(rowp + bj * 128) = pack8(acc[ai][bj][m][0], acc[ai][bj][m][1]); }
    }
};
struct EpiPlainQ {
    static constexpr bool PRESCALE = false;
    bf16_t* O; int ldc; LAS unsigned char* ldsm; const float* sc;
    __device__ __forceinline__ void operator()(const Acc& acc, const Unit& u, int wr, int wc, int fr, int fq) const {
        const int r0 = wr * 64 + fr, col0 = u.pn * 256 + wc * 32 + 8 * fq;
        f32x2 sv[2][4];
#pragma unroll
        for (int bj = 0; bj < 2; ++bj) { const f32x4 s0 = *(const f32x4*)(sc + col0 + bj * 128), s1 = *(const f32x4*)(sc + col0 + bj * 128 + 4);
#pragma unroll
            for (int j = 0; j < 4; ++j) sv[bj][j] = (f32x2){s0[j], s1[j]}; }
#pragma unroll
        for (int ai = 0; ai < 2; ++ai)
#pragma unroll
            for (int m = 0; m < 4; ++m) { const int rl = r0 + ai * 128 + m * 16; bf16_t* rowp = O + ((size_t)u.pm * 256 + rl) * ldc + col0;
                const float a1 = *(const LAS float*)(ldsm + (2 + u.aux) * 2048 + rl * 8); const f32x2 al = {a1, a1};
#pragma unroll
                for (int bj = 0; bj < 2; ++bj) { const i32x4 i0 = __builtin_bit_cast(i32x4, acc[ai][bj][m][0]), i1 = __builtin_bit_cast(i32x4, acc[ai][bj][m][1]);
                    f32x4 v0, v1;
#pragma unroll
                    for (int j = 0; j < 4; ++j) { const f32x2 v = (al * sv[bj][j]) * (f32x2){(float)i0[j], (float)i1[j]}; v0[j] = v[0]; v1[j] = v[1]; }
                    *(u32x4*)(rowp + bj * 128) = pack8(v0, v1); } }
    }
};
template <int MODE, bool Q8 = false> struct EpiRes {
    static constexpr bool PRESCALE = Q8;
    bf16_t* Z; const bf16_t* Rsrc; float* st_out; LAS unsigned char* ldsm; const float* g; const float* b; const float* sc; float qs; unsigned char* Zq;
    __device__ __forceinline__ void prescale(Acc& acc, const Unit& u, int wc, int fq) const {
        const int col0 = u.pn * 256 + wc * 32 + 8 * fq;
#pragma unroll
        for (int bj = 0; bj < 2; ++bj) {
            const f32x4 s0 = *(const f32x4*)(sc + col0 + bj * 128) * qs, s1 = *(const f32x4*)(sc + col0 + bj * 128 + 4) * qs;
#pragma unroll
            for (int ai = 0; ai < 2; ++ai)
#pragma unroll
                for (int m = 0; m < 4; ++m) {
                    const i32x4 i0 = __builtin_bit_cast(i32x4, acc[ai][bj][m][0]), i1 = __builtin_bit_cast(i32x4, acc[ai][bj][m][1]);
#pragma unroll
                    for (int j = 0; j < 4; ++j) { const f32x2 v = (f32x2){(float)i0[j], (float)i1[j]} * (f32x2){s0[j], s1[j]}; acc[ai][bj][m][0][j] = v[0]; acc[ai][bj][m][1][j] = v[1]; }
                }
        }
    }
    __device__ __forceinline__ void operator()(const Acc& acc, const Unit& u, int wr, int wc, int fr, int fq) const {
        const int r0 = wr * 64 + fr, col0 = u.pn * 256 + wc * 32 + 8 * fq;
        f32x4 gv[2][2], bv[2][2];
        if (MODE == 1) {
#pragma unroll
            for (int bj = 0; bj < 2; ++bj)
#pragma unroll
                for (int n = 0; n < 2; ++n) { gv[bj][n] = *(const f32x4*)(g + col0 + bj * 128 + 4 * n); bv[bj][n] = *(const f32x4*)(b + col0 + bj * 128 + 4 * n); }
        }
        u32x4 rwa[4][4][2];
#define EPR_LOAD(am_) do { _Pragma("unroll") for (int m = 2 * ((am_) & 1); m < 2 * ((am_) & 1) + 2; ++m) _Pragma("unroll") for (int bj = 0; bj < 2; ++bj) \
            rwa[am_][m][bj] = *(const u32x4*)(Rsrc + (unsigned)((u.pm * 256 + r0 + ((am_) >> 1) * 128 + m * 16) * D + col0 + bj * 128)); } while (0)
        EPR_LOAD(0);
#pragma unroll
        for (int am = 0; am < 4; ++am) { const int ai = am >> 1;
            if (am + 1 < 4) EPR_LOAD(am + 1);
            u32x4 (&rw)[4][2] = rwa[am];
#pragma unroll
            for (int m = 2 * (am & 1); m < 2 * (am & 1) + 2; ++m) {
                const int rl = r0 + ai * 128 + m * 16; const unsigned row = (unsigned)(u.pm * 256 + rl);
                float mu = 0.f, rstd = 1.f;
                if (MODE == 1) { const f32x2 ms = *(const LAS f32x2*)(ldsm + (2 + u.aux) * 2048 + rl * 8); mu = ms[0]; rstd = ms[1]; }
                f32x2 s12a = {0.f, 0.f}, s12b = {0.f, 0.f};
                const f32x2 mu2 = {mu, mu}, rs2 = {rstd, rstd};
#pragma unroll
                for (int bj = 0; bj < 2; ++bj) {
                    const u32x4 rwv = rw[m][bj];
                    f32x4 v0, v1;
#pragma unroll
                    for (int p2 = 0; p2 < 4; ++p2) {
                        const unsigned wv = rwv[p2];
                        f32x2 h = {bflo(wv), bfhi(wv)};
                        const int n = p2 >> 1, j = (p2 & 1) * 2;
                        if (MODE == 1) { const f32x2 gg = {gv[bj][n][j], gv[bj][n][j + 1]}, bb2 = {bv[bj][n][j], bv[bj][n][j + 1]}; h = __builtin_elementwise_fma((h - mu2) * rs2, gg, bb2); }
                        const f32x2 av = {acc[ai][bj][m][n][j], acc[ai][bj][m][n][j + 1]};
                        const f32x2 v = __builtin_elementwise_fma((f32x2){ALPHA, ALPHA}, h, av);
                        if (n == 0) { v0[j] = v[0]; v0[j + 1] = v[1]; } else { v1[j] = v[0]; v1[j + 1] = v[1]; }
                    }
                    const u32x4 w = pack8(v0, v1);
                    *(u32x4*)(Z + (row * (unsigned)D + (unsigned)(col0 + bj * 128))) = w;
                    { unsigned q0_ = 0u, q1_ = 0u;
#pragma unroll
                      for (int j = 0; j < 4; ++j) { q0_ = __builtin_amdgcn_cvt_pk_u8_f32(__builtin_rintf(__builtin_fmaf(v0[j], 127.0f / Z_CLIP, 128.0f)), j, q0_); q1_ = __builtin_amdgcn_cvt_pk_u8_f32(__builtin_rintf(__builtin_fmaf(v1[j], 127.0f / Z_CLIP, 128.0f)), j, q1_); }
                      *(u32x2*)(Zq + (row * (unsigned)D + (unsigned)(col0 + bj * 128))) = (u32x2){q0_ ^ 0x80808080u, q1_ ^ 0x80808080u}; }
#pragma unroll
                    for (int p2 = 0; p2 < 4; ++p2) { const f32x2 q = {bflo(w[p2]), bfhi(w[p2])}; s12a += q; s12b = __builtin_elementwise_fma(q, q, s12b); }
                }
                const float s1 = s12a[0] + s12a[1], s2 = s12b[0] + s12b[1];
                put_stats(st_out, (int)row, u.pn * 4 + wc, fq, s1, s2);
            }
        }
    }
};
struct EpiFold {
    static constexpr bool PRESCALE = false;
    bf16_t* O; int ldc; LAS unsigned char* ldsm; const float* cs; const float* bw;
    __device__ __forceinline__ void operator()(const Acc& acc, const Unit& u, int wr, int wc, int fr, int fq) const {
        const int r0 = wr * 64 + fr, col0 = u.pn * 256 + wc * 32 + 8 * fq;
        f32x4 cv[2][2], bv[2][2];
#pragma unroll
        for (int bj = 0; bj < 2; ++bj)
#pragma unroll
            for (int n = 0; n < 2; ++n) { cv[bj][n] = *(const f32x4*)(cs + col0 + bj * 128 + 4 * n); bv[bj][n] = *(const f32x4*)(bw + col0 + bj * 128 + 4 * n); }
#pragma unroll
        for (int ai = 0; ai < 2; ++ai)
#pragma unroll
            for (int m = 0; m < 4; ++m) {
                const int rl = r0 + ai * 128 + m * 16; const size_t row = (size_t)u.pm * 256 + rl;
                const f32x2 ms = *(const LAS f32x2*)(ldsm + (2 + u.aux) * 2048 + rl * 8); const float mu = ms[0], rstd = ms[1];
#pragma unroll
                for (int bj = 0; bj < 2; ++bj) {
                    const f32x4 v0 = (acc[ai][bj][m][0] - mu * cv[bj][0]) * rstd + bv[bj][0], v1 = (acc[ai][bj][m][1] - mu * cv[bj][1]) * rstd + bv[bj][1];
                    *(u32x4*)(O + row * ldc + col0 + bj * 128) = pack8(v0, v1);
                }
            }
    }
};
template <bool MOE> struct EpiGlu {
    static constexpr bool PRESCALE = false;
    bf16_t* O; int ldc; const float* st_in; const float* cs; const float* bw; LAS unsigned char* ldsm; int ncs;
    __device__ __forceinline__ void operator()(const Acc& acc, const Unit& u, int wr, int wc, int fr, int fq) const {
        const int row0 = u.pm * 256 + wr * 64 + fr, colo = u.pn * 128 + wc * 32 + 8 * fq;
        int vb = u.pn * 256 + wc * 32 + 8 * fq;
        if (MOE) vb += (int)(u.boff / (unsigned)(256 * D * 2)) * 256 - u.pn * 256;
        f32x4 cv[2][2], bv[2][2];
#pragma unroll
        for (int bj = 0; bj < 2; ++bj)
#pragma unroll
            for (int n = 0; n < 2; ++n) { cv[bj][n] = *(const f32x4*)(cs + vb + bj * 128 + 4 * n); bv[bj][n] = *(const f32x4*)(bw + vb + bj * 128 + 4 * n); }
#pragma unroll
        for (int ai = 0; ai < 2; ++ai)
#pragma unroll
            for (int m = 0; m < 4; ++m) {
                const int row = row0 + ai * 128 + m * 16;
                const f32x2 ms = *(const LAS f32x2*)(ldsm + (2 + u.aux) * 2048 + (row - u.pm * 256) * 8); const float mu = ms[0], rstd = ms[1];
                f32x4 o0, o1;
#pragma unroll
                for (int j = 0; j < 4; ++j) {
                    const float g0 = (acc[ai][0][m][0][j] - mu * cv[0][0][j]) * rstd + bv[0][0][j], g1 = (acc[ai][0][m][1][j] - mu * cv[0][1][j]) * rstd + bv[0][1][j];
                    const float u0 = (acc[ai][1][m][0][j] - mu * cv[1][0][j]) * rstd + bv[1][0][j], u1 = (acc[ai][1][m][1][j] - mu * cv[1][1][j]) * rstd + bv[1][1][j];
                    o0[j] = g0 * sigmoidf_(g0) * u0; o1[j] = g1 * sigmoidf_(g1) * u1;
                }
                *(u32x4*)(O + (size_t)row * ldc + colo) = pack8(o0, o1);
            }
    }
};
template <bool OUT8> struct EpiGluQ {
    static constexpr bool PRESCALE = false;
    bf16_t* O; int ldc; const float* cs; const float* bw; const float* sc; LAS unsigned char* ldsm;
    __device__ __forceinline__ void operator()(const Acc& acc, const Unit& u, int wr, int wc, int fr, int fq) const {
        const int row0 = u.pm * 256 + wr * 64 + fr, colo = u.pn * 128 + wc * 32 + 8 * fq;
        const int vb = (int)(u.boff / (unsigned)(256 * 1024)) * 256 + wc * 32 + 8 * fq;
        constexpr float KG = -1.4426950408889634f, KU = -0.6931471805599453f * (OUT8 ? 127.0f / ACT_CLIP : 1.0f);
        f32x2 cv[2][4], bv[2][4], sv[2][4];
#pragma unroll
        for (int bj = 0; bj < 2; ++bj) { const float kk = bj ? KU : KG;
            const f32x4 c0 = *(const f32x4*)(cs + vb + bj * 128), c1 = *(const f32x4*)(cs + vb + bj * 128 + 4), b0 = *(const f32x4*)(bw + vb + bj * 128), b1 = *(const f32x4*)(bw + vb + bj * 128 + 4),
                        s0 = *(const f32x4*)(sc + vb + bj * 128), s1 = *(const f32x4*)(sc + vb + bj * 128 + 4);
#pragma unroll
            for (int j = 0; j < 4; ++j) { cv[bj][j] = (f32x2){c0[j], c1[j]} * kk; bv[bj][j] = (f32x2){b0[j], b1[j]} * kk; sv[bj][j] = (f32x2){s0[j], s1[j]} * kk; } }
#pragma unroll
        for (int ai = 0; ai < 2; ++ai)
#pragma unroll
            for (int m = 0; m < 4; ++m) {
                const int row = row0 + ai * 128 + m * 16;
                const f32x2 ms = *(const LAS f32x2*)(ldsm + (2 + u.aux) * 2048 + (row - u.pm * 256) * 8); const f32x2 al = {ms[0], ms[0]}, be = {ms[1], ms[1]};
                const i32x4 ig0 = __builtin_bit_cast(i32x4, acc[ai][0][m][0]), ig1 = __builtin_bit_cast(i32x4, acc[ai][0][m][1]), iu0 = __builtin_bit_cast(i32x4, acc[ai][1][m][0]), iu1 = __builtin_bit_cast(i32x4, acc[ai][1][m][1]);
                f32x4 o0, o1;
#pragma unroll
                for (int j = 0; j < 4; ++j) {
                    const f32x2 ag = {(float)ig0[j], (float)ig1[j]}, au = {(float)iu0[j], (float)iu1[j]};
                    const f32x2 g = __builtin_elementwise_fma(al * sv[0][j], ag, __builtin_elementwise_fma(be, cv[0][j], bv[0][j]));
                    const f32x2 uu = __builtin_elementwise_fma(al * sv[1][j], au, __builtin_elementwise_fma(be, cv[1][j], bv[1][j]));
                    const f32x2 den = (f32x2){__builtin_amdgcn_exp2f(g[0]), __builtin_amdgcn_exp2f(g[1])} + (f32x2){1.0f, 1.0f};
                    const f32x2 t = g * (f32x2){__builtin_amdgcn_rcpf(den[0]), __builtin_amdgcn_rcpf(den[1])};
                    if constexpr (OUT8) { const f32x2 q = __builtin_elementwise_fma(t, uu, (f32x2){128.0f, 128.0f}); o0[j] = __builtin_rintf(q[0]); o1[j] = __builtin_rintf(q[1]); }
                    else { const f32x2 q = t * uu; o0[j] = q[0]; o1[j] = q[1]; }
                }
                if constexpr (OUT8) { unsigned w0 = 0u, w1 = 0u;
                    w0 = __builtin_amdgcn_cvt_pk_u8_f32(o0[0], 0, w0); w0 = __builtin_amdgcn_cvt_pk_u8_f32(o0[1], 1, w0); w0 = __builtin_amdgcn_cvt_pk_u8_f32(o0[2], 2, w0); w0 = __builtin_amdgcn_cvt_pk_u8_f32(o0[3], 3, w0);
                    w1 = __builtin_amdgcn_cvt_pk_u8_f32(o1[0], 0, w1); w1 = __builtin_amdgcn_cvt_pk_u8_f32(o1[1], 1, w1); w1 = __builtin_amdgcn_cvt_pk_u8_f32(o1[2], 2, w1); w1 = __builtin_amdgcn_cvt_pk_u8_f32(o1[3], 3, w1);
                    *(u32x2*)((unsigned char*)O + (size_t)row * ldc + colo) = (u32x2){w0 ^ 0x80808080u, w1 ^ 0x80808080u}; }
                else *(u32x4*)(O + (size_t)row * ldc + colo) = pack8(o0, o1);
            }
    }
};
struct EpiFoldQ {
    static constexpr bool PRESCALE = false;
    bf16_t* O; int ldc; LAS unsigned char* ldsm; const float* cs; const float* bw; const float* sc;
    __device__ __forceinline__ void operator()(const Acc& acc, const Unit& u, int wr, int wc, int fr, int fq) const {
        const int r0 = wr * 64 + fr, col0 = u.pn * 256 + wc * 32 + 8 * fq;
        f32x2 cv[2][4], bv[2][4], sv[2][4];
#pragma unroll
        for (int bj = 0; bj < 2; ++bj) {
            const f32x4 c0 = *(const f32x4*)(cs + col0 + bj * 128), c1 = *(const f32x4*)(cs + col0 + bj * 128 + 4), b0 = *(const f32x4*)(bw + col0 + bj * 128), b1 = *(const f32x4*)(bw + col0 + bj * 128 + 4),
                        s0 = *(const f32x4*)(sc + col0 + bj * 128), s1 = *(const f32x4*)(sc + col0 + bj * 128 + 4);
#pragma unroll
            for (int j = 0; j < 4; ++j) { cv[bj][j] = (f32x2){c0[j], c1[j]}; bv[bj][j] = (f32x2){b0[j], b1[j]}; sv[bj][j] = (f32x2){s0[j], s1[j]}; } }
#pragma unroll
        for (int ai = 0; ai < 2; ++ai)
#pragma unroll
            for (int m = 0; m < 4; ++m) {
                const int rl = r0 + ai * 128 + m * 16; const size_t row = (size_t)u.pm * 256 + rl;
                const f32x2 ms = *(const LAS f32x2*)(ldsm + (2 + u.aux) * 2048 + rl * 8); const f32x2 al = {ms[0], ms[0]}, be = {ms[1], ms[1]};
#pragma unroll
                for (int bj = 0; bj < 2; ++bj) {
                    const i32x4 i0 = __builtin_bit_cast(i32x4, acc[ai][bj][m][0]), i1 = __builtin_bit_cast(i32x4, acc[ai][bj][m][1]);
                    f32x4 v0, v1;
#pragma unroll
                    for (int j = 0; j < 4; ++j) { const f32x2 v = __builtin_elementwise_fma(al * sv[bj][j], (f32x2){(float)i0[j], (float)i1[j]}, __builtin_elementwise_fma(be, cv[bj][j], bv[bj][j])); v0[j] = v[0]; v1[j] = v[1]; }
                    *(u32x4*)(O + row * ldc + col0 + bj * 128) = pack8(v0, v1);
                }
            }
    }
};
struct EpiMoeDown {
    static constexpr bool PRESCALE = false;
    bf16_t* Y0; bf16_t* Y1; LAS unsigned char* ldsm; float* P; int nfull;
    __device__ __forceinline__ void operator()(const Acc& acc, const Unit& u, int wr, int wc, int fr, int fq) const {
        const int r0 = wr * 64 + fr, col0 = u.pn * 256 + wc * 32 + 8 * fq;
        if (u.ks >= 0) {
#pragma unroll
            for (int ai = 0; ai < 2; ++ai)
#pragma unroll
                for (int m = 0; m < 4; ++m) { float* rowp = P + ((size_t)u.ks * 2048 + (size_t)(u.pm - nfull) * 256 + r0 + ai * 128 + m * 16) * D + col0;
#pragma unroll
                    for (int bj = 0; bj < 2; ++bj) { *(f32x4*)(rowp + bj * 128) = acc[ai][bj][m][0]; *(f32x4*)(rowp + bj * 128 + 4) = acc[ai][bj][m][1]; } }
            return;
        }
#pragma unroll
        for (int ai = 0; ai < 2; ++ai)
#pragma unroll
            for (int m = 0; m < 4; ++m) {
                const u32x2 mg = *(const LAS u32x2*)(ldsm + u.aux * 2048 + (r0 + ai * 128 + m * 16) * 8);
                const int id = (int)mg.x; const float gt = __uint_as_float(mg.y);
                if (id >= 0) { bf16_t* rowp = Y0 + (size_t)(id & 1) * (size_t)(Y1 - Y0) + (size_t)(id >> 1) * D + col0;
#pragma unroll
                    for (int bj = 0; bj < 2; ++bj) *(u32x4*)(rowp + bj * 128) = pack8(acc[ai][bj][m][0] * gt, acc[ai][bj][m][1] * gt); }
            }
    }
};
struct EpiMoeDownQ {
    static constexpr bool PRESCALE = false;
    bf16_t* Y0; bf16_t* Y1; LAS unsigned char* ldsm; float* P; int nfull; const float* sc;
    __device__ __forceinline__ void operator()(const Acc& acc, const Unit& u, int wr, int wc, int fr, int fq) const {
        const int r0 = wr * 64 + fr, col0 = u.pn * 256 + wc * 32 + 8 * fq;
        const int e = (int)(u.boff / (unsigned)(D * FFE));
        f32x4 sv[2][2];
#pragma unroll
        for (int bj = 0; bj < 2; ++bj)
#pragma unroll
            for (int n = 0; n < 2; ++n) sv[bj][n] = *(const f32x4*)(sc + e * D + col0 + bj * 128 + 4 * n) * (ACT_CLIP / 127.0f);
#define EMD_VAL(ai, bj, m, n, gt) ({ const i32x4 i_ = __builtin_bit_cast(i32x4, acc[ai][bj][m][n]); f32x4 v_; _Pragma("unroll") for (int j = 0; j < 4; ++j) v_[j] = (float)i_[j] * (sv[bj][n][j] * (gt)); v_; })
        if (u.ks >= 0) {
#pragma unroll
            for (int ai = 0; ai < 2; ++ai)
#pragma unroll
                for (int m = 0; m < 4; ++m) { float* rowp = P + ((size_t)u.ks * 2048 + (size_t)(u.pm - nfull) * 256 + r0 + ai * 128 + m * 16) * D + col0;
#pragma unroll
                    for (int bj = 0; bj < 2; ++bj) { *(f32x4*)(rowp + bj * 128) = EMD_VAL(ai, bj, m, 0, 1.0f); *(f32x4*)(rowp + bj * 128 + 4) = EMD_VAL(ai, bj, m, 1, 1.0f); } }
            return;
        }
#pragma unroll
        for (int ai = 0; ai < 2; ++ai)
#pragma unroll
            for (int m = 0; m < 4; ++m) {
                const u32x2 mg = *(const LAS u32x2*)(ldsm + u.aux * 2048 + (r0 + ai * 128 + m * 16) * 8);
                const int id = (int)mg.x; const float gt = __uint_as_float(mg.y);
                if (id >= 0) { bf16_t* rowp = Y0 + (size_t)(id & 1) * (size_t)(Y1 - Y0) + (size_t)(id >> 1) * D + col0;
#pragma unroll
                    for (int bj = 0; bj < 2; ++bj) *(u32x4*)(rowp + bj * 128) = pack8(EMD_VAL(ai, bj, m, 0, gt), EMD_VAL(ai, bj, m, 1, gt)); }
            }
#undef EMD_VAL
    }
};
}

struct Args { const float* in[18]; float* out; unsigned char* ws; int ph_lo, ph_hi; };
enum { PH_PRO = 0, PH_PROJ, PH_MLSTM, PH_WOUT, PH_FIN1, PH_GU, PH_DN, PH_FIN2, PH_KVQ, PH_ATT, PH_WO, PH_RT1, PH_RT2, PH_MOE0, PH_FIX = PH_MOE0 + 2 * MOE_NCHUNK, PH_FINAL, PH_COUNT };

#define DPP_STEP_ADD(x, ctrl, rmask) x += __builtin_bit_cast(float, __builtin_amdgcn_update_dpp(0, __builtin_bit_cast(int, x), ctrl, rmask, 0xf, false))
#define DPP_STEP_MAX(x, ctrl, rmask) x = fmaxf(x, __builtin_bit_cast(float, __builtin_amdgcn_update_dpp((int)0xff800000, __builtin_bit_cast(int, x), ctrl, rmask, 0xf, false)))
__device__ __forceinline__ float scan_add64(float x) { DPP_STEP_ADD(x, 0x111, 0xf); DPP_STEP_ADD(x, 0x112, 0xf); DPP_STEP_ADD(x, 0x114, 0xf); DPP_STEP_ADD(x, 0x118, 0xf); DPP_STEP_ADD(x, 0x142, 0xa); DPP_STEP_ADD(x, 0x143, 0xc); return x; }
__device__ __forceinline__ float scan_max64(float x) { DPP_STEP_MAX(x, 0x111, 0xf); DPP_STEP_MAX(x, 0x112, 0xf); DPP_STEP_MAX(x, 0x114, 0xf); DPP_STEP_MAX(x, 0x118, 0xf); DPP_STEP_MAX(x, 0x142, 0xa); DPP_STEP_MAX(x, 0x143, 0xc); return x; }
__device__ __forceinline__ float wave_total(float x);
__device__ __forceinline__ float lane63(float x) { return __builtin_bit_cast(float, __builtin_amdgcn_readlane(__builtin_bit_cast(int, x), 63)); }
__device__ __forceinline__ float wave_total(float x) { return lane63(scan_add64(x)); }
__device__ __forceinline__ float logsigmoid_(float x) { return fminf(x, 0.f) - log1pf(expf(-fabsf(x))); }
__device__ __forceinline__ void conv_block(LAS unsigned char* lds, const float* src, int ldw, int K, bf16_t* dst, const float* g, const float* bb, float* cs, float* bw) {
    const int tid = threadIdx.x;
    const int n4 = (tid & 15) * 4, k4 = (tid >> 4) * 4;
    const int rn = tid >> 3, rs = tid & 7;
    float csp[4] = {0.f, 0.f, 0.f, 0.f}, bwp[4] = {0.f, 0.f, 0.f, 0.f};
    const int nch = K / 256;
    constexpr int TS = 520;
    LAS float* gs = (LAS float*)(lds + 2 * 64 * TS + 16384);
    if (g) { for (int i = tid; i < K; i += NTHREADS) { gs[i] = g[i]; gs[K + i] = bb[i]; } __syncthreads(); }
    f32x4 v[2][4], vn[2][4];
#pragma unroll
    for (int hf = 0; hf < 2; ++hf)
#pragma unroll
        for (int kk = 0; kk < 4; ++kk) v[hf][kk] = *(const f32x4*)(src + (size_t)(hf * 128 + k4 + kk) * ldw + n4);
    for (int ch = 0; ch < nch; ++ch) {
        LAS unsigned char* T = lds + (ch & 1) * (64 * TS);
        if (ch + 1 < nch) {
#pragma unroll
            for (int hf = 0; hf < 2; ++hf)
#pragma unroll
                for (int kk = 0; kk < 4; ++kk) vn[hf][kk] = *(const f32x4*)(src + (size_t)((ch + 1) * 256 + hf * 128 + k4 + kk) * ldw + n4); }
#pragma unroll
        for (int hf = 0; hf < 2; ++hf) {
            float gk[4] = {1.f, 1.f, 1.f, 1.f}, bk[4] = {0.f, 0.f, 0.f, 0.f};
            if (g) {
#pragma unroll
                for (int kk = 0; kk < 4; ++kk) { gk[kk] = gs[ch * 256 + hf * 128 + k4 + kk]; bk[kk] = gs[K + ch * 256 + hf * 128 + k4 + kk]; } }
#pragma unroll
            for (int j = 0; j < 4; ++j) {
                const unsigned lo = pk2(v[hf][0][j] * gk[0], v[hf][1][j] * gk[1]), hi = pk2(v[hf][2][j] * gk[2], v[hf][3][j] * gk[3]);
                *(LAS u32x2*)(T + (n4 + j) * TS + (hf * 128 + k4) * 2) = (u32x2){lo, hi};
                csp[j] += (bflo(lo) + bfhi(lo)) + (bflo(hi) + bfhi(hi));
                bwp[j] += (v[hf][0][j] * bk[0] + v[hf][1][j] * bk[1]) + (v[hf][2][j] * bk[2] + v[hf][3][j] * bk[3]);
            }
        }
        __syncthreads();
        u32x2 q[8];
#pragma unroll
        for (int i = 0; i < 8; ++i) q[i] = *(const LAS u32x2*)(T + rn * TS + rs * 64 + i * 8);
        bf16_t* dp = dst + (size_t)rn * K + ch * 256 + rs * 32;
#pragma unroll
        for (int i = 0; i < 4; ++i) *(u32x4*)(dp + 8 * i) = (u32x4){q[2 * i].x, q[2 * i].y, q[2 * i + 1].x, q[2 * i + 1].y};
#pragma unroll
        for (int hf = 0; hf < 2; ++hf)
#pragma unroll
            for (int kk = 0; kk < 4; ++kk) v[hf][kk] = vn[hf][kk];
    }
    __syncthreads();
    if (cs) {
        LAS float* red = (LAS float*)(lds + 2 * 64 * TS);
#pragma unroll
        for (int j = 0; j < 4; ++j) { red[(tid >> 4) * 64 + n4 + j] = csp[j]; red[2048 + (tid >> 4) * 64 + n4 + j] = bwp[j]; }
        __syncthreads();
        if (tid < 128) { const int n = tid & 63, w = tid >> 6; float s = 0.f;
            for (int i = 0; i < 32; ++i) s += red[w * 2048 + i * 64 + n];
            (w ? bw : cs)[n] = s; }
        __syncthreads();
    }
}
__device__ __forceinline__ int q8_(float x) { return (int)__builtin_rintf(x); }
__device__ __forceinline__ void conv_block_q8(LAS unsigned char* lds, const float* src, int ldw, int K, unsigned char* dst, const float* g, const float* bb, float* cs, float* bw, float* sc) {
    const int tid = threadIdx.x;
    const int nch = K / 256;
    const int n4 = (tid & 15) * 4, k4 = (tid >> 4) * 4;
    const int rn = tid >> 3, rs = tid & 7;
    constexpr int TS = 272;
    LAS float* red = (LAS float*)(lds + 2 * 64 * 520);
    LAS float* inv = (LAS float*)(lds + 2 * 64 * 520 + 16384);
    LAS float* gs = (LAS float*)(lds + 2 * 64 * 520 + 16384 + 256);
    if (g) { for (int i = tid; i < K; i += NTHREADS) { gs[i] = g[i]; gs[K + i] = bb[i]; } __syncthreads(); }
    float cm[4] = {0.f, 0.f, 0.f, 0.f};
    for (int ch = 0; ch < nch; ch += 2) {
        f32x4 w[2][2][4];
#pragma unroll
        for (int c2 = 0; c2 < 2; ++c2) { const int cc = (ch + c2 < nch) ? ch + c2 : ch;
#pragma unroll
            for (int hf = 0; hf < 2; ++hf)
#pragma unroll
                for (int kk = 0; kk < 4; ++kk) w[c2][hf][kk] = *(const f32x4*)(src + (size_t)(cc * 256 + hf * 128 + k4 + kk) * ldw + n4); }
#pragma unroll
        for (int c2 = 0; c2 < 2; ++c2) { const int cc = (ch + c2 < nch) ? ch + c2 : ch;
#pragma unroll
            for (int hf = 0; hf < 2; ++hf)
#pragma unroll
                for (int kk = 0; kk < 4; ++kk) { const float gk = g ? gs[cc * 256 + hf * 128 + k4 + kk] : 1.0f;
#pragma unroll
                    for (int j = 0; j < 4; ++j) cm[j] = fmaxf(cm[j], fabsf(w[c2][hf][kk][j] * gk)); } }
    }
#pragma unroll
    for (int j = 0; j < 4; ++j) red[(tid >> 4) * 64 + n4 + j] = cm[j];
    __syncthreads();
    if (tid < 64) { float mx = 0.f; for (int i = 0; i < 32; ++i) mx = fmaxf(mx, red[i * 64 + tid]); mx = fmaxf(mx, 1e-30f); inv[tid] = 127.0f / mx; sc[tid] = mx * (1.0f / 127.0f); }
    __syncthreads();
    float iv[4];
#pragma unroll
    for (int j = 0; j < 4; ++j) iv[j] = inv[n4 + j];
    float csp[4] = {0.f, 0.f, 0.f, 0.f}, bwp[4] = {0.f, 0.f, 0.f, 0.f};
    f32x4 v[2][4], vn[2][4];
#pragma unroll
    for (int hf = 0; hf < 2; ++hf)
#pragma unroll
        for (int kk = 0; kk < 4; ++kk) v[hf][kk] = *(const f32x4*)(src + (size_t)(hf * 128 + k4 + kk) * ldw + n4);
    for (int ch = 0; ch < nch; ++ch) {
        LAS unsigned char* T = lds + (ch & 1) * (64 * TS);
        if (ch + 1 < nch) {
#pragma unroll
            for (int hf = 0; hf < 2; ++hf)
#pragma unroll
                for (int kk = 0; kk < 4; ++kk) vn[hf][kk] = *(const f32x4*)(src + (size_t)((ch + 1) * 256 + hf * 128 + k4 + kk) * ldw + n4); }
#pragma unroll
        for (int hf = 0; hf < 2; ++hf) {
            float gk[4] = {1.f, 1.f, 1.f, 1.f}, bk[4] = {0.f, 0.f, 0.f, 0.f};
            if (g) {
#pragma unroll
                for (int kk = 0; kk < 4; ++kk) { gk[kk] = gs[ch * 256 + hf * 128 + k4 + kk]; bk[kk] = gs[K + ch * 256 + hf * 128 + k4 + kk]; } }
#pragma unroll
            for (int j = 0; j < 4; ++j) {
                const int q0 = q8_(v[hf][0][j] * gk[0] * iv[j]), q1 = q8_(v[hf][1][j] * gk[1] * iv[j]), q2 = q8_(v[hf][2][j] * gk[2] * iv[j]), q3 = q8_(v[hf][3][j] * gk[3] * iv[j]);
                *(LAS unsigned*)(T + (n4 + j) * TS + hf * 128 + k4) = (unsigned)(q0 & 255) | ((unsigned)(q1 & 255) << 8) | ((unsigned)(q2 & 255) << 16) | ((unsigned)q3 << 24);
                csp[j] += (float)((q0 + q1) + (q2 + q3));
                bwp[j] += (v[hf][0][j] * bk[0] + v[hf][1][j] * bk[1]) + (v[hf][2][j] * bk[2] + v[hf][3][j] * bk[3]);
            }
        }
        __syncthreads();
        const u32x4 qa = *(const LAS u32x4*)(T + rn * TS + rs * 32), qb = *(const LAS u32x4*)(T + rn * TS + rs * 32 + 16);
        unsigned char* dp = dst + (size_t)rn * K + ch * 256 + rs * 32;
        *(u32x4*)dp = qa; *(u32x4*)(dp + 16) = qb;
#pragma unroll
        for (int hf = 0; hf < 2; ++hf)
#pragma unroll
            for (int kk = 0; kk < 4; ++kk) v[hf][kk] = vn[hf][kk];
    }
    __syncthreads();
    if (cs) {
#pragma unroll
        for (int j = 0; j < 4; ++j) { red[(tid >> 4) * 64 + n4 + j] = csp[j]; red[2048 + (tid >> 4) * 64 + n4 + j] = bwp[j]; }
        __syncthreads();
        if (tid < 128) { const int n = tid & 63, w = tid >> 6; float s = 0.f;
            for (int i = 0; i < 32; ++i) s += red[w * 2048 + i * 64 + n];
            if (w) bw[n] = s; else cs[n] = s / inv[n]; }
        __syncthreads();
    }
}
__device__ __forceinline__ void conv_block_q8_1k(LAS unsigned char* lds, const float* src, int ldw, unsigned char* dst, const float* g, const float* bb, float* cs, float* bw, float* sc) {
    const int tid = threadIdx.x;
    constexpr int K = 1024, nch = 4;
    const int n4 = (tid & 15) * 4, k4 = (tid >> 4) * 4;
    const int rn = tid >> 3, rs = tid & 7;
    constexpr int TS = 272;
    LAS float* red = (LAS float*)(lds + 2 * 64 * 520);
    LAS float* inv = (LAS float*)(lds + 2 * 64 * 520 + 16384);
    LAS float* gs = (LAS float*)(lds + 2 * 64 * 520 + 16384 + 256);
    f32x4 v[nch][2][4];
#pragma unroll
    for (int ch = 0; ch < nch; ++ch)
#pragma unroll
        for (int hf = 0; hf < 2; ++hf)
#pragma unroll
            for (int kk = 0; kk < 4; ++kk) v[ch][hf][kk] = __builtin_nontemporal_load((const f32x4*)(src + (size_t)(ch * 256 + hf * 128 + k4 + kk) * ldw + n4));
    for (int i = tid; i < K; i += NTHREADS) { gs[i] = g ? g[i] : 1.0f; gs[K + i] = g ? bb[i] : 0.0f; }
    __syncthreads();
    {
        float cm[4] = {0.f, 0.f, 0.f, 0.f}, bwp[4] = {0.f, 0.f, 0.f, 0.f};
#pragma unroll
        for (int ch = 0; ch < nch; ++ch)
#pragma unroll
            for (int hf = 0; hf < 2; ++hf)
#pragma unroll
                for (int kk = 0; kk < 4; ++kk) { const float gk = gs[ch * 256 + hf * 128 + k4 + kk], bk = gs[K + ch * 256 + hf * 128 + k4 + kk];
#pragma unroll
                    for (int j = 0; j < 4; ++j) { cm[j] = fmaxf(cm[j], fabsf(v[ch][hf][kk][j] * gk)); bwp[j] = __builtin_fmaf(v[ch][hf][kk][j], bk, bwp[j]); } }
#pragma unroll
        for (int j = 0; j < 4; ++j) { red[(tid >> 4) * 64 + n4 + j] = cm[j]; red[2048 + (tid >> 4) * 64 + n4 + j] = bwp[j]; }
    }
    __syncthreads();
    if (tid < 128) { const int n = tid & 63, w = tid >> 6;
        if (w == 0) { float mx = 0.f; for (int i = 0; i < 32; ++i) mx = fmaxf(mx, red[i * 64 + n]); mx = fmaxf(mx, 1e-30f); inv[n] = 127.0f / mx; sc[n] = mx * (1.0f / 127.0f); }
        else if (bw) { float s_ = 0.f; for (int i = 0; i < 32; ++i) s_ += red[2048 + i * 64 + n]; bw[n] = s_; } }
    __syncthreads();
    float iv[4];
#pragma unroll
    for (int j = 0; j < 4; ++j) iv[j] = inv[n4 + j];
    int csum = 0;
#pragma unroll
    for (int ch = 0; ch < nch; ++ch) {
        LAS unsigned char* T = lds + (ch & 1) * (64 * TS);
#pragma unroll
        for (int hf = 0; hf < 2; ++hf) {
            float gk[4];
#pragma unroll
            for (int kk = 0; kk < 4; ++kk) gk[kk] = gs[ch * 256 + hf * 128 + k4 + kk];
#pragma unroll
            for (int j = 0; j < 4; ++j) { unsigned w = 0u;
#pragma unroll
                for (int kk = 0; kk < 4; ++kk) w = __builtin_amdgcn_cvt_pk_u8_f32(__builtin_rintf(__builtin_fmaf(v[ch][hf][kk][j] * gk[kk], iv[j], 128.0f)), kk, w);
                *(LAS unsigned*)(T + (n4 + j) * TS + hf * 128 + k4) = w ^ 0x80808080u; }
        }
        __syncthreads();
        const u32x4 qa = *(const LAS u32x4*)(T + rn * TS + rs * 32), qb = *(const LAS u32x4*)(T + rn * TS + rs * 32 + 16);
        unsigned char* dp = dst + (size_t)rn * K + ch * 256 + rs * 32;
        *(u32x4*)dp = qa; *(u32x4*)(dp + 16) = qb;
#pragma unroll
        for (int i = 0; i < 4; ++i) { csum = __builtin_amdgcn_sdot4((int)qa[i], 0x01010101, csum, false); csum = __builtin_amdgcn_sdot4((int)qb[i], 0x01010101, csum, false); }
    }
    if (cs) {
        csum += __shfl_xor(csum, 1); csum += __shfl_xor(csum, 2); csum += __shfl_xor(csum, 4);
        if (rs == 0) cs[rn] = (float)csum / inv[rn];
    }
    __syncthreads();
}
__device__ __forceinline__ void conv_job(LAS unsigned char* lds, const Args& a, int blk) {
    unsigned char* ws = a.ws;
    const float* ln_g = a.in[16]; const float* ln_b = a.in[17];
    float* vec = (float*)(ws + WS_VEC);
    const float* src; int ldw, K = D; bf16_t* dst = nullptr; unsigned char* dq = nullptr; const float* g = nullptr; const float* bb = nullptr; float* cs = nullptr; float* bw = nullptr; float* sc = nullptr;
    int j = blk;
    if (j < 128) { const int e = j >> 4, jj = j & 15; src = a.in[15] + (size_t)e * FFE * D + 64 * jj; ldw = D; K = FFE; dq = ws + WS_WEDN + ((size_t)e * D + 64 * jj) * FFE; sc = vec + VEC_EDN_SC + e * D + 64 * jj; }
    else if (j < 144) { j -= 128; src = a.in[11] + 64 * j; ldw = D; K = FFD; dq = ws + WS_WDN + (size_t)(64 * j) * FFD; sc = vec + VEC_DN_SC + 64 * j; }
    else if (j < 192) { j -= 144; src = a.in[2] + 64 * j; ldw = 3080; dq = ws + WS_WIN + (size_t)(64 * j) * D; sc = vec + VEC_WIN_SC + 64 * j; }
    else if (j < 208) { j -= 192; src = a.in[5] + 64 * j; ldw = D; dq = ws + WS_WOUT + (size_t)(64 * j) * D; sc = vec + VEC_WOUT_SC + 64 * j; }
    else if (j < 296) { j -= 208; const int t = j >> 2, q = j & 3; src = (q < 2 ? a.in[9] : a.in[10]) + 128 * t + 64 * (q & 1); ldw = FFD; dq = ws + WS_WGU + (size_t)(64 * j) * D;
        g = ln_g; bb = ln_b; cs = vec + VEC_GU_CS + 64 * j; bw = vec + VEC_GU_BW + 64 * j; sc = vec + VEC_GU_SC + 64 * j; }
    else if (j < 344) { j -= 296; src = j < 32 ? a.in[6] + 64 * j : a.in[7] + 64 * (j - 32); ldw = j < 32 ? 2048 : 1024; dq = ws + WS_WKVQ + (size_t)(64 * j) * D;
        g = ln_g + 1024; bb = ln_b + 1024; cs = vec + VEC_KVQ_CS + 64 * j; bw = vec + VEC_KVQ_BW + 64 * j; sc = vec + VEC_KVQ_SC + 64 * j; }
    else if (j < 360) { j -= 344; src = a.in[8] + 64 * j; ldw = D; dq = ws + WS_WO + (size_t)(64 * j) * D; sc = vec + VEC_WO_SC + 64 * j; }
    else { j -= 360; const int e = j / 112, jj = j % 112, t = jj >> 2, q = jj & 3; src = (q < 2 ? a.in[13] : a.in[14]) + (size_t)e * D * FFE + 128 * t + 64 * (q & 1); ldw = FFE;
        const int o = e * 2 * FFE + 64 * jj;
        dq = ws + WS_WEGU + (size_t)o * D; g = ln_g + 2048; bb = ln_b + 2048; cs = vec + VEC_EGU_CS + o; bw = vec + VEC_EGU_BW + o; sc = vec + VEC_EGU_SC + o; }
    if (dq && K == D) conv_block_q8_1k(lds, src, ldw, dq, g, bb, cs, bw, sc);
    else if (dq) conv_block_q8(lds, src, ldw, K, dq, g, bb, cs, bw, sc);
    else conv_block(lds, src, ldw, K, dst, g, bb, cs, bw);
}
constexpr int EGU0 = 360;
__device__ __forceinline__ void tail_jobs(LAS unsigned char* lds, const Args& a, int phase) {
    const int c = (int)blockIdx.x;
    int j0 = -1;
    if (phase == PH_PROJ) { const int q = c - 12;
        if (q >= 0) j0 = q < 16 ? 128 + q : (q < 184 ? 192 + (q - 16) : EGU0 + (q - 184)); }
    else if (phase == PH_WOUT) { const int q = c - 4; if (q >= 0) j0 = EGU0 + 60 + q; }
    else if (phase == PH_GU) { const int q = c - 22; if (q >= 0) j0 = EGU0 + 312 + q; }
    else if (phase == PH_DN) { const int q = c - 4;
        if (q >= 0 && q < 128) j0 = q;
        else if (q >= 128 && q - 128 < 106) j0 = EGU0 + 546 + (q - 128); }
    else { const int q = c - 12; if (q >= 0) j0 = EGU0 + 652 + q; }
    if (j0 >= 0) conv_job(lds, a, j0);
}
__device__ __forceinline__ void prologue_phase(LAS unsigned char* lds, const Args& a) {
    unsigned char* ws = a.ws;
    const int G = gridDim.x;
    for (int blk = 144 + blockIdx.x; blk < 192; blk += G) conv_job(lds, a, blk);
    {
        const int tid = threadIdx.x, lane = tid & 63, wid = tid >> 6;
        LAS float* wg = (LAS float*)lds;
        __syncthreads();
        const float* w_in = a.in[2];
        for (int i = tid; i < 8192; i += NTHREADS) { const int k = i >> 3, e = i & 7; wg[e * 1024 + k] = w_in[(size_t)k * 3080 + 3072 + e]; }
        __syncthreads();
        bf16_t* H0 = (bf16_t*)(ws + WS_RB); float* gates = (float*)(ws + WS_GATES);
        unsigned char* H0q = ws + WS_RC; f32x2* rq = (f32x2*)(ws + WS_RQ1);
        const float bg4 = a.in[3][4 * ((lane >> 4) & 1) + (lane & 3)];
        const int c_ = (int)blockIdx.x;
        const int r_lo = (G == 256) ? (c_ < 48 ? 128 * c_ : 6144 + 288 * (c_ - 48)) : (int)(((long)NROWS * c_) / G);
        int r_hi = (G == 256) ? (c_ < 48 ? r_lo + 128 : r_lo + 288) : (int)(((long)NROWS * (c_ + 1)) / G); r_hi = r_hi < NROWS ? r_hi : NROWS;
#define PRO_SRC(r) ((r) < NR ? a.in[0] + (size_t)(r) * D : a.in[1] + (size_t)(((r) - NR) & 15) * D)
        f32x4 xa[4], xb[4], na[4], nb[4];
        { const int ra = (r_lo + wid) < r_hi ? (r_lo + wid) : 0, rb = (r_lo + wid + 8) < r_hi ? (r_lo + wid + 8) : ra; const float* sa = PRO_SRC(ra); const float* sb = PRO_SRC(rb);
#pragma unroll
            for (int i = 0; i < 4; ++i) { xa[i] = *(const f32x4*)(sa + i * 256 + lane * 4); xb[i] = *(const f32x4*)(sb + i * 256 + lane * 4); } }
        for (int row = r_lo + wid; row < r_hi; row += 16) {
            const bool hasb = (row + 8 < r_hi);
            { const int ra = (row + 16) < r_hi ? (row + 16) : row, rb = (row + 24) < r_hi ? (row + 24) : ra; const float* sa = PRO_SRC(ra); const float* sb = PRO_SRC(rb);
#pragma unroll
                for (int i = 0; i < 4; ++i) { na[i] = *(const f32x4*)(sa + i * 256 + lane * 4); nb[i] = *(const f32x4*)(sb + i * 256 + lane * 4); } }
            f32x2 acc2[8];
#pragma unroll
            for (int e = 0; e < 8; ++e) acc2[e] = (f32x2){0.f, 0.f};
            float mxa = 0.f, mxb = 0.f;
#pragma unroll
            for (int i = 0; i < 4; ++i)
#pragma unroll
                for (int j = 0; j < 4; ++j) { mxa = fmaxf(mxa, fabsf(xa[i][j])); mxb = fmaxf(mxb, fabsf(xb[i][j])); }
            mxa = fmaxf(lane63(scan_max64(mxa)), 1e-30f); mxb = fmaxf(lane63(scan_max64(mxb)), 1e-30f);
            const float iqa = 127.0f / mxa, iqb = 127.0f / mxb;
            if (lane == 0) { rq[row] = (f32x2){mxa * (1.0f / 127.0f), 0.f}; if (hasb) rq[row + 8] = (f32x2){mxb * (1.0f / 127.0f), 0.f}; }
#pragma unroll
            for (int i = 0; i < 4; ++i) {
                const int k = i * 256 + lane * 4;
                const f32x4 va = xa[i], vb = xb[i];
                { unsigned wa = 0u, wb = 0u;
#pragma unroll
                    for (int j = 0; j < 4; ++j) { wa = __builtin_amdgcn_cvt_pk_u8_f32(__builtin_rintf(__builtin_fmaf(va[j], iqa, 128.0f)), j, wa); wb = __builtin_amdgcn_cvt_pk_u8_f32(__builtin_rintf(__builtin_fmaf(vb[j], iqb, 128.0f)), j, wb); }
                    *(unsigned*)(H0q + (size_t)row * D + k) = wa ^ 0x80808080u; if (hasb) *(unsigned*)(H0q + (size_t)(row + 8) * D + k) = wb ^ 0x80808080u; }
                *(u32x2*)(H0 + (size_t)row * D + k) = (u32x2){pk2(va[0], va[1]), pk2(va[2], va[3])};
                if (hasb) *(u32x2*)(H0 + (size_t)(row + 8) * D + k) = (u32x2){pk2(vb[0], vb[1]), pk2(vb[2], vb[3])};
                { f32x2 vab[4];
#pragma unroll
                    for (int j = 0; j < 4; ++j) vab[j] = (f32x2){va[j], vb[j]};
#pragma unroll
                    for (int e = 0; e < 8; ++e) { const f32x4 w = *(const LAS f32x4*)(wg + e * 1024 + k);
#pragma unroll
                        for (int j = 0; j < 4; ++j) acc2[e] = __builtin_elementwise_fma(vab[j], (f32x2){w[j], w[j]}, acc2[e]); } }
                __builtin_amdgcn_sched_barrier(0);
            }
#pragma unroll
            for (int i = 0; i < 4; ++i) { xa[i] = na[i]; xb[i] = nb[i]; }
            float r8[8], r4[4];
#pragma unroll
            for (int e = 0; e < 8; ++e) { const u32x2 p_ = __builtin_amdgcn_permlane32_swap(__float_as_uint(acc2[e][0]), __float_as_uint(acc2[e][1]), false, false); r8[e] = __uint_as_float(p_.x) + __uint_as_float(p_.y); }
#pragma unroll
            for (int i = 0; i < 4; ++i) { const u32x2 p_ = __builtin_amdgcn_permlane16_swap(__float_as_uint(r8[i]), __float_as_uint(r8[i + 4]), false, false); r4[i] = __uint_as_float(p_.x) + __uint_as_float(p_.y); }
#pragma unroll
            for (int i = 0; i < 4; ++i) { DPP_STEP_ADD(r4[i], 0x128, 0xf); DPP_STEP_ADD(r4[i], 0x124, 0xf); DPP_STEP_ADD(r4[i], 0x122, 0xf); DPP_STEP_ADD(r4[i], 0x121, 0xf); }
            { const int j_ = lane & 15, rw_ = lane >> 4, e_ = 4 * (rw_ & 1) + (j_ & 3);
              const float m_ = ((j_ & 3) == 0 ? r4[0] : ((j_ & 3) == 1 ? r4[1] : ((j_ & 3) == 2 ? r4[2] : r4[3]))) + bg4;
              if (j_ < 4 && (rw_ < 2 || hasb)) gates[(size_t)(row + 8 * (rw_ >> 1)) * 8 + e_] = e_ < 4 ? m_ : logsigmoid_(m_); }
        }
#undef PRO_SRC
        __syncthreads();
    }
}

__device__ __forceinline__ bf16x8 pack_frag(const f32x16& x, int s) {
    u32x4 p; p.x = pk2(x[8 * s], x[8 * s + 1]); p.y = pk2(x[8 * s + 2], x[8 * s + 3]); p.z = pk2(x[8 * s + 4], x[8 * s + 5]); p.w = pk2(x[8 * s + 6], x[8 * s + 7]);
    return __builtin_bit_cast(bf16x8, p);
}
__device__ __forceinline__ bf16x8 ld2x64(const LAS unsigned char* p0, const LAS unsigned char* p1) {
    const u32x2 a = *(const LAS u32x2*)p0, b = *(const LAS u32x2*)p1; u32x4 r = {a.x, a.y, b.x, b.y}; return __builtin_bit_cast(bf16x8, r);
}
__device__ __forceinline__ void tr4x4(const u32x2 (&r)[4], u32x2 (&c)[4]) {
    c[0] = (u32x2){(r[0].x & 0xffffu) | (r[1].x << 16), (r[2].x & 0xffffu) | (r[3].x << 16)};
    c[1] = (u32x2){(r[0].x >> 16) | (r[1].x & 0xffff0000u), (r[2].x >> 16) | (r[3].x & 0xffff0000u)};
    c[2] = (u32x2){(r[0].y & 0xffffu) | (r[1].y << 16), (r[2].y & 0xffffu) | (r[3].y << 16)};
    c[3] = (u32x2){(r[0].y >> 16) | (r[1].y & 0xffff0000u), (r[2].y >> 16) | (r[3].y & 0xffff0000u)};
}

constexpr int ML_QS = 0, ML_KS = 17408, ML_PS = 34816, ML_VT = 44032, ML_KT = 78848, ML_SC = 96256, ML_HS = 100352;
#ifndef ML_N0
#define ML_N0 28
#define ML_N1 18
#define ML_N2 12
#endif
__device__ __forceinline__ void mlstm_phase(LAS unsigned char* lds, const bf16_t* qkvo, const float* gates, const float* normg, bf16_t* hn, int unit_) {
    const int unit = (unit_ & 7) * 8 + (unit_ >> 5), part_ = (unit_ >> 3) & 3;
    const int c_begin = part_ == 0 ? 0 : (part_ == 1 ? ML_N0 : (part_ == 2 ? ML_N0 + ML_N1 : ML_N0 + ML_N1 + ML_N2));
    const int c_end = part_ == 0 ? ML_N0 : (part_ == 1 ? ML_N0 + ML_N1 : (part_ == 2 ? ML_N0 + ML_N1 + ML_N2 : 65));
    const int tid = threadIdx.x, lane = tid & 63, wid = __builtin_amdgcn_readfirstlane(tid >> 6);
    const int b = unit >> 2, h = unit & 3;
    const int r32 = lane & 31, hh = lane >> 5, l15 = lane & 15, l4 = lane >> 4;
    LAS float* sc = (LAS float*)(lds + ML_SC);
    const int q_row = tid >> 4, q_col = (tid & 15) * 8;
    const int k_dk = (16 * (wid & 1) + l15) * 4, k_s = (4 * (wid >> 1) + l4) * 4;
    const int v_dv = (16 * (wid & 3) + l15) * 4, v_s0 = (4 * (wid >> 2) + l4) * 4;
    f32x16 Cacc[4];
#pragma unroll
    for (int i = 0; i < 4; ++i)
#pragma unroll
        for (int j = 0; j < 16; ++j) Cacc[i][j] = 0.f;
    if (tid < 256) sc[192 + tid] = 0.f;
    float m_run = 0.f;
    u32x4 qreg[2]; u32x2 kreg[4], vreg[2][4]; float g_li = 0.f, g_lf = 0.f;
#define rowof(c, t) ((c) == 0 ? (NR + b * 16 + ((t) - 48)) : (b * SEQ + 64 * ((c) - 1) + (t)))
#define ML_PREFETCH_Q(c) do { \
        if ((c) >= c_begin) _Pragma("unroll") for (int p = 0; p < 2; ++p) { const int t = q_row + 32 * p; const bool pad = ((c) == 0 && t < 48); \
            qreg[p] = pad ? (u32x4){0u, 0u, 0u, 0u} : *(const u32x4*)(qkvo + (size_t)rowof((c), t) * NPROJ + h * 128 + q_col); } } while (0)
#define ML_PREFETCH(c) do { \
        _Pragma("unroll") for (int kk = 0; kk < 4; ++kk) { const int t = k_s + kk; const bool pad = ((c) == 0 && t < 48); \
            kreg[kk] = pad ? (u32x2){0u, 0u} : *(const u32x2*)(qkvo + (size_t)rowof((c), t) * NPROJ + 512 + h * 128 + k_dk); } \
        _Pragma("unroll") for (int p = 0; p < 2; ++p) _Pragma("unroll") for (int kk = 0; kk < 4; ++kk) { const int t = v_s0 + 32 * p + kk; const bool pad = ((c) == 0 && t < 48); \
            vreg[p][kk] = pad ? (u32x2){0u, 0u} : *(const u32x2*)(qkvo + (size_t)rowof((c), t) * NPROJ + 1024 + h * 256 + v_dv); } \
        { const bool pad = ((c) == 0 && lane < 48); g_li = pad ? -1e30f : gates[(size_t)rowof((c), lane) * 8 + h]; g_lf = pad ? 0.f : gates[(size_t)rowof((c), lane) * 8 + 4 + h]; } } while (0)
    float av, Mt, winter, bmt, wlast, decay, m_next;
#define ML_SCALARS() do { const float bc_ = scan_add64(g_lf); av = g_li - bc_; const float um_ = scan_max64(av); Mt = fmaxf(m_run, um_); \
        winter = __expf(m_run - Mt); bmt = bc_ + Mt; const float M63_ = lane63(Mt), b63_ = lane63(bc_); wlast = __expf(av - M63_); decay = __expf(m_run - M63_); m_next = b63_ + M63_; } while (0)
#define ML_IMAGE(FULL) do { \
        if (FULL) { _Pragma("unroll") for (int p = 0; p < 2; ++p) *(LAS u32x4*)(lds + ML_QS + (q_row + 32 * p) * 272 + q_col * 2) = qreg[p]; } \
        { u32x2 kw[4]; \
            _Pragma("unroll") for (int kk = 0; kk < 4; ++kk) { \
                if (FULL) *(LAS u32x2*)(lds + ML_KS + (k_s + kk) * 272 + k_dk * 2) = kreg[kk]; \
                const float w = __shfl(wlast, k_s + kk) * 0.08838834764831845f; \
                kw[kk] = (u32x2){pk2(bflo(kreg[kk].x) * w, bfhi(kreg[kk].x) * w), pk2(bflo(kreg[kk].y) * w, bfhi(kreg[kk].y) * w)}; } \
            u32x2 kc[4]; tr4x4(kw, kc); \
            _Pragma("unroll") for (int j = 0; j < 4; ++j) *(LAS u32x2*)(lds + ML_KT + (k_dk + j) * 136 + k_s * 2) = kc[j]; } \
        _Pragma("unroll") for (int p = 0; p < 2; ++p) { u32x2 vc[4]; tr4x4(vreg[p], vc); \
            _Pragma("unroll") for (int j = 0; j < 4; ++j) *(LAS u32x2*)(lds + ML_VT + (v_dv + j) * 136 + (v_s0 + 32 * p) * 2) = vc[j]; } \
        if (wid == 0) { sc[lane] = winter; sc[128 + lane] = bmt; } } while (0)
#define ML_PTILES() do { const int ti = wid >> 1; \
        _Pragma("unroll") for (int q = 0; q < 2; ++q) { const int si = 2 * (wid & 1) + q; f32x4 sa = {0.f, 0.f, 0.f, 0.f}; \
            if (si <= ti) { _Pragma("unroll") for (int ks = 0; ks < 4; ++ks) { \
                    const bf16x8 af = *(const LAS bf16x8*)(lds + ML_QS + (16 * ti + l15) * 272 + (32 * ks + 8 * l4) * 2); \
                    const bf16x8 bfr = *(const LAS bf16x8*)(lds + ML_KS + (16 * si + l15) * 272 + (32 * ks + 8 * l4) * 2); \
                    sa = __builtin_amdgcn_mfma_f32_16x16x32_bf16(af, bfr, sa, 0, 0, 0); } } \
            const int s = 16 * si + l15; const float a_s = __shfl(av, s); \
            _Pragma("unroll") for (int r = 0; r < 4; ++r) { const int t = 16 * ti + 4 * l4 + r; const float Mtt = __shfl(Mt, t); \
                const float w = (s <= t) ? __expf(a_s - Mtt) : 0.f; \
                *(LAS bf16_t*)(lds + ML_PS + t * 144 + s * 2) = f2bf(sa[r] * 0.08838834764831845f * w); } } } while (0)
    bf16x8 vf[4];
#define ML_VFRAGS() do { _Pragma("unroll") for (int ks = 0; ks < 4; ++ks) { const LAS unsigned char* p_ = lds + ML_VT + (32 * wid + r32) * 136 + (16 * ks + 8 * hh) * 2; vf[ks] = ld2x64(p_, p_ + 8); } } while (0)

    ML_PREFETCH(0); ML_PREFETCH_Q(0);
    ML_SCALARS();
    { const bool f0 = (0 >= c_begin); if (f0) ML_IMAGE(true); else ML_IMAGE(false); }
    __syncthreads();
    if (1 < c_end) ML_PREFETCH(1);
    if (0 >= c_begin) ML_PTILES();
    ML_VFRAGS();
    __syncthreads();
    for (int c = 0; c < c_end; ++c) {
        const bool full = (c >= c_begin), has_n = (c + 1 < c_end), full_n = (c + 1 >= c_begin);
        const float decay_c = decay;
        const int nb = c & 1;
        if (full) {
            {
                const int t = tid >> 3, part = tid & 7;
                float qn = 0.f, ps = 0.f;
                const u32x4 q0 = *(const LAS u32x4*)(lds + ML_QS + t * 272 + part * 32), q1 = *(const LAS u32x4*)(lds + ML_QS + t * 272 + part * 32 + 16);
                float qv[16]; { float t8[8]; g8::unpack8(q0, t8);
#pragma unroll
                    for (int j = 0; j < 8; ++j) qv[j] = t8[j]; g8::unpack8(q1, t8);
#pragma unroll
                    for (int j = 0; j < 8; ++j) qv[8 + j] = t8[j]; }
#pragma unroll
                for (int j = 0; j < 16; ++j) qn += qv[j] * sc[192 + 128 * nb + part * 16 + j];
                const u32x4 pw = *(const LAS u32x4*)(lds + ML_PS + t * 144 + part * 16);
                float pv[8]; g8::unpack8(pw, pv);
#pragma unroll
                for (int j = 0; j < 8; ++j) ps += pv[j];
                qn += __shfl_xor(qn, 1); qn += __shfl_xor(qn, 2); qn += __shfl_xor(qn, 4);
                ps += __shfl_xor(ps, 1); ps += __shfl_xor(ps, 2); ps += __shfl_xor(ps, 4);
                if (part == 0) { const float den = sc[t] * qn + ps; sc[64 + t] = __builtin_amdgcn_rcpf(fmaxf(fabsf(den), __expf(-sc[128 + t]))); }
            }
#pragma unroll
            for (int tt = 0; tt < 2; ++tt) {
                f32x16 num;
#pragma unroll
                for (int j = 0; j < 16; ++j) num[j] = 0.f;
#pragma unroll
                for (int dkt = 0; dkt < 4; ++dkt)
#pragma unroll
                    for (int s2 = 0; s2 < 2; ++s2) {
                        const LAS unsigned char* p = lds + ML_QS + (32 * tt + r32) * 272 + (32 * dkt + 16 * s2 + 4 * hh) * 2;
                        num = __builtin_amdgcn_mfma_f32_32x32x16_bf16(ld2x64(p, p + 16), pack_frag(Cacc[dkt], s2), num, 0, 0, 0);
                    }
#pragma unroll
                for (int gq = 0; gq < 4; ++gq) { const f32x4 wv = *(const LAS f32x4*)(sc + 32 * tt + 8 * gq + 4 * hh);
#pragma unroll
                    for (int r = 0; r < 4; ++r) num[4 * gq + r] *= wv[r]; }
#pragma unroll
                for (int ks = 0; ks < 4; ++ks) {
                    if (tt == 0 && ks >= 2) continue;
                    const bf16x8 pf = *(const LAS bf16x8*)(lds + ML_PS + (32 * tt + r32) * 144 + (16 * ks + 8 * hh) * 2);
                    num = __builtin_amdgcn_mfma_f32_32x32x16_bf16(pf, vf[ks], num, 0, 0, 0);
                }
#pragma unroll
                for (int j = 0; j < 16; ++j) *(LAS bf16_t*)(lds + ML_HS + (32 * tt + (j & 3) + 8 * (j >> 2) + 4 * hh) * 528 + (32 * wid + r32) * 2) = f2bf(num[j]);
            }
        }
#pragma unroll
        for (int dkt = 0; dkt < 4; ++dkt) {
#pragma unroll
            for (int j = 0; j < 16; ++j) Cacc[dkt][j] *= decay_c;
#pragma unroll
            for (int ks = 0; ks < 4; ++ks) { const LAS unsigned char* p = lds + ML_KT + (32 * dkt + r32) * 136 + (16 * ks + 8 * hh) * 2;
                Cacc[dkt] = __builtin_amdgcn_mfma_f32_32x32x16_bf16(ld2x64(p, p + 8), vf[ks], Cacc[dkt], 0, 0, 0); }
        }
        {
            const int dk = tid >> 2, part = tid & 3;
            const u32x2 k0 = *(const LAS u32x2*)(lds + ML_KT + dk * 136 + part * 32), k1 = *(const LAS u32x2*)(lds + ML_KT + dk * 136 + part * 32 + 8),
                        k2 = *(const LAS u32x2*)(lds + ML_KT + dk * 136 + part * 32 + 16), k3 = *(const LAS u32x2*)(lds + ML_KT + dk * 136 + part * 32 + 24);
            float sk = ((bflo(k0.x) + bfhi(k0.x)) + (bflo(k0.y) + bfhi(k0.y))) + ((bflo(k1.x) + bfhi(k1.x)) + (bflo(k1.y) + bfhi(k1.y)))
                     + ((bflo(k2.x) + bfhi(k2.x)) + (bflo(k2.y) + bfhi(k2.y))) + ((bflo(k3.x) + bfhi(k3.x)) + (bflo(k3.y) + bfhi(k3.y)));
            sk += __shfl_xor(sk, 1); sk += __shfl_xor(sk, 2);
            if (part == 0) sc[192 + 128 * (nb ^ 1) + dk] = decay_c * sc[192 + 128 * nb + dk] + sk;
        }
        if (has_n) ML_PREFETCH_Q(c + 1);
        __syncthreads();
        m_run = m_next;
        if (has_n) ML_SCALARS();
        u32x2 oreg[8];
        if (full) { const int t = tid >> 3, part = tid & 7; const bool pad = (c == 0 && t < 48); const size_t row = pad ? 0 : (size_t)rowof(c, t);
#pragma unroll
            for (int i = 0; i < 8; ++i) oreg[i] = *(const u32x2*)(qkvo + row * NPROJ + 2048 + h * 256 + 32 * i + 4 * part); }
        if (full) {
            const int t = tid >> 3, part = tid & 7;
            const float iv = sc[64 + t];
            f32x4 x[8]; float s1 = 0.f;
#pragma unroll
            for (int i = 0; i < 8; ++i) { const u32x2 hw = *(const LAS u32x2*)(lds + ML_HS + t * 528 + (32 * i + 4 * part) * 2);
                x[i] = (f32x4){bflo(hw.x) * iv, bfhi(hw.x) * iv, bflo(hw.y) * iv, bfhi(hw.y) * iv}; s1 += (x[i][0] + x[i][1]) + (x[i][2] + x[i][3]); }
            s1 += __shfl_xor(s1, 1); s1 += __shfl_xor(s1, 2); s1 += __shfl_xor(s1, 4);
            const float mean = s1 * (1.0f / 256.0f); float s2 = 0.f;
#pragma unroll
            for (int i = 0; i < 8; ++i) { const f32x4 d = x[i] - mean; s2 += (d[0] * d[0] + d[1] * d[1]) + (d[2] * d[2] + d[3] * d[3]); }
            s2 += __shfl_xor(s2, 1); s2 += __shfl_xor(s2, 2); s2 += __shfl_xor(s2, 4);
            const float rstd = rsqrtf(s2 * (1.0f / 256.0f) + LN_EPS);
            if (!(c == 0 && t < 48)) {
                const size_t row = (size_t)rowof(c, t);
#pragma unroll
                for (int i = 0; i < 8; ++i) {
                    const int dv = 32 * i + 4 * part;
                    const u32x2 ow = oreg[i];
                    const f32x4 ng = *(const f32x4*)(normg + h * 256 + dv);
                    const float o0 = sigmoidf_(bflo(ow.x)), o1 = sigmoidf_(bfhi(ow.x)), o2 = sigmoidf_(bflo(ow.y)), o3 = sigmoidf_(bfhi(ow.y));
                    const f32x4 y = (x[i] - mean) * rstd * ng;
                    { unsigned w_ = 0u;
                      w_ = __builtin_amdgcn_cvt_pk_u8_f32(__builtin_rintf(__builtin_fmaf(y[0] * o0, 127.0f / HN_CLIP, 128.0f)), 0, w_); w_ = __builtin_amdgcn_cvt_pk_u8_f32(__builtin_rintf(__builtin_fmaf(y[1] * o1, 127.0f / HN_CLIP, 128.0f)), 1, w_);
                      w_ = __builtin_amdgcn_cvt_pk_u8_f32(__builtin_rintf(__builtin_fmaf(y[2] * o2, 127.0f / HN_CLIP, 128.0f)), 2, w_); w_ = __builtin_amdgcn_cvt_pk_u8_f32(__builtin_rintf(__builtin_fmaf(y[3] * o3, 127.0f / HN_CLIP, 128.0f)), 3, w_);
                      *(unsigned*)((unsigned char*)hn + row * D + h * 256 + dv) = w_ ^ 0x80808080u; }
                }
            }
        }
        if (!has_n) break;
        if (full_n) ML_IMAGE(true); else ML_IMAGE(false);
        if (c + 2 < c_end) ML_PREFETCH(c + 2);
        __syncthreads();
        if (full_n) ML_PTILES();
        ML_VFRAGS();
        if (full_n) __syncthreads();
    }
    __syncthreads();
#undef ML_PREFETCH
#undef ML_PREFETCH_Q
#undef ML_SCALARS
#undef ML_IMAGE
#undef ML_PTILES
#undef ML_VFRAGS
#undef rowof
}

constexpr float AT_PMIN = 1e-15f;
constexpr int AT_K0 = 0, AT_V0 = 17408, AT_BUF = 34816, AT_FLAGS = 2 * AT_BUF;
__device__ __forceinline__ void at_tile(const LAS unsigned char* Kb, const LAS unsigned char* Vb, int k0, int tmin, int r32, int hh, const bf16x8 (&qf)[8], f32x16 (&O)[4], float& P) {
    f32x16 S[2];
#pragma unroll
    for (int u = 0; u < 2; ++u) {
#pragma unroll
        for (int j = 0; j < 16; ++j) S[u][j] = 0.f;
#pragma unroll
        for (int ks = 0; ks < 8; ++ks) {
            const bf16x8 kf = *(const LAS bf16x8*)(Kb + (32 * u + r32) * 272 + (16 * ks + 8 * hh) * 2);
            S[u] = __builtin_amdgcn_mfma_f32_32x32x16_bf16(kf, qf[ks], S[u], 0, 0, 0);
        }
    }
    const bool full = (k0 + 63 < tmin) && (k0 >= 128);
    const int lim = tmin + r32 - k0 - 4 * hh;
    const int lo = 112 - k0 - 4 * hh;
    float Tt[2][4];
#define AT_ELEM(MASKED) \
    _Pragma("unroll") for (int u = 0; u < 2; ++u) _Pragma("unroll") for (int gq = 0; gq < 4; ++gq) { \
        float x4[4]; \
        _Pragma("unroll") for (int r = 0; r < 4; ++r) { \
            float zz = S[u][4 * gq + r] * (0.08838834764831845f * 1.4426950408889634f); \
            if (MASKED) { const int o = 32 * u + 8 * gq + r; zz = (o < lim && o >= lo) ? zz : -1.0e4f; } \
            const float rc = __builtin_amdgcn_rcpf(1.0f + __builtin_amdgcn_exp2f(zz)); \
            S[u][4 * gq + r] = 1.0f - rc; x4[r] = rc; } \
        const float e2 = x4[3], e1 = e2 * x4[2], e0 = e1 * x4[1]; \
        Tt[u][gq] = e0 * x4[0]; \
        S[u][4 * gq + 2] *= e2; S[u][4 * gq + 1] *= e1; S[u][4 * gq + 0] *= e0; }
    if (full) { AT_ELEM(false) } else { AT_ELEM(true) }
#undef AT_ELEM
    float acc = P;
#pragma unroll
    for (int u = 1; u >= 0; --u)
#pragma unroll
        for (int gq = 3; gq >= 0; --gq) {
            float t0; const float t1 = swap32_hi(Tt[u][gq], t0);
            const float Rr = hh ? acc : acc * t1;
            acc = (acc * t1) * t0;
#pragma unroll
            for (int r = 0; r < 4; ++r) S[u][4 * gq + r] *= Rr;
        }
    P = acc;
#pragma unroll
    for (int u = 0; u < 2; ++u)
#pragma unroll
        for (int s2 = 0; s2 < 2; ++s2) {
            const bf16x8 af = pack_frag(S[u], s2);
#pragma unroll
            for (int dt = 0; dt < 4; ++dt) {
                const LAS unsigned char* p = Vb + (32 * dt + r32) * 136 + (32 * u + 16 * s2 + 4 * hh) * 2;
                O[dt] = __builtin_amdgcn_mfma_f32_32x32x16_bf16(af, ld2x64(p, p + 16), O[dt], 0, 0, 0);
            }
        }
}
__device__ __forceinline__ void attn_phase(LAS unsigned char* lds, const bf16_t* kvq, bf16_t* ao) {
    const int tid = threadIdx.x, lane = tid & 63, wid = __builtin_amdgcn_readfirstlane(tid >> 6);
    const int r32 = lane & 31, hh = lane >> 5, l15 = lane & 15, l4 = lane >> 4;
    LAS unsigned* flags = (LAS unsigned*)(lds + AT_FLAGS);
    const int k_row = tid >> 4, k_col = (tid & 15) * 8;
    const int v_d = (16 * (wid & 1) + l15) * 4, v_s = (4 * (wid >> 1) + l4) * 4;
    for (int ui_ = 0; ui_ < (NB * 8 * 16) / 256; ++ui_) {
        const int xq = blockIdx.x & 7, jq = blockIdx.x >> 3, strm = (ui_ * 8 + xq) * 2 + (jq >> 4);
        const int qt = jq & 15, head = strm & 7, b = strm >> 3;
        const int q0 = 128 + 256 * qt, tmin = q0 + 32 * wid;
#define rowofp(p) ((p) >= 128 ? b * SEQ + (p) - 128 : ((p) >= 112 ? NR + b * 16 + (p) - 112 : NR + b * 16))
        bf16x8 qf[8];
        { const bf16_t* qp = kvq + (size_t)(b * SEQ + tmin - 128 + r32) * NPROJ + 2048 + head * 128 + 8 * hh;
#pragma unroll
            for (int ks = 0; ks < 8; ++ks) qf[ks] = *(const bf16x8*)(qp + 16 * ks); }
        f32x16 O[4];
#pragma unroll
        for (int i = 0; i < 4; ++i)
#pragma unroll
            for (int j = 0; j < 16; ++j) O[i][j] = 0.f;
        float P = 1.0f;
        const int kt_hi = (q0 >> 6) + 3;
        u32x4 kregA[2], kregB[2]; u32x2 vregA[4], vregB[4];
#define AT_LOAD(kreg, vreg, kt) do { \
        _Pragma("unroll") for (int p = 0; p < 2; ++p) kreg[p] = *(const u32x4*)(kvq + (size_t)rowofp(64 * (kt) + k_row + 32 * p) * NPROJ + head * 128 + k_col); \
        _Pragma("unroll") for (int kk = 0; kk < 4; ++kk) vreg[kk] = *(const u32x2*)(kvq + (size_t)rowofp(64 * (kt) + v_s + kk) * NPROJ + 1024 + head * 128 + v_d); } while (0)
#define AT_STORE(kreg, vreg, buf) do { LAS unsigned char* base = lds + (buf) * AT_BUF; \
        _Pragma("unroll") for (int p = 0; p < 2; ++p) *(LAS u32x4*)(base + AT_K0 + (k_row + 32 * p) * 272 + k_col * 2) = kreg[p]; \
        u32x2 vc[4]; tr4x4(vreg, vc); \
        _Pragma("unroll") for (int j = 0; j < 4; ++j) *(LAS u32x2*)(base + AT_V0 + (v_d + j) * 136 + v_s * 2) = vc[j]; } while (0)
#define AT_ITER(BUF, LOADSET_K, LOADSET_V, STORESET_K, STORESET_V) { \
            const int kt = kt_hi - it; \
            __syncthreads(); \
            if (it > 0 && flags[it - 1] == 0u) break; \
            if (kt - 2 >= 1) AT_LOAD(LOADSET_K, LOADSET_V, kt - 2); \
            if (64 * kt < tmin + 31 && __ballot(P >= AT_PMIN) != 0ull) at_tile(lds + (BUF) * AT_BUF + AT_K0, lds + (BUF) * AT_BUF + AT_V0, 64 * kt, tmin, r32, hh, qf, O, P); \
            if (__ballot(P >= AT_PMIN) != 0ull && lane == 0) flags[it] = 1u; \
            if (kt - 1 < 1) break; \
            AT_STORE(STORESET_K, STORESET_V, 1 - (BUF)); \
            ++it; }
        if (tid < 80) flags[tid] = 0u;
        AT_LOAD(kregA, vregA, kt_hi);
        AT_STORE(kregA, vregA, 0);
        AT_LOAD(kregB, vregB, kt_hi - 1);
        for (int it = 0; ; ) {
            AT_ITER(0, kregA, vregA, kregB, vregB)
            AT_ITER(1, kregB, vregB, kregA, vregA)
        }
#pragma unroll
        for (int dt = 0; dt < 4; ++dt)
#pragma unroll
            for (int j = 0; j < 16; ++j) {
                const int t = tmin + (j & 3) + 8 * (j >> 2) + 4 * hh;
                ((signed char*)ao)[(size_t)(b * SEQ + t - 128) * D + head * 128 + 32 * dt + r32] = (signed char)g8::qc8_(O[dt][j] * (127.0f / AO_CLIP));
            }
        __syncthreads();
    }
#undef AT_LOAD
#undef AT_STORE
#undef AT_ITER
#undef rowofp
}

__device__ __forceinline__ void ln_row_stats_wave(const float* st, int row, int lane, float& mu, float& rstd) {
    const f32x2 p = *(const f32x2*)(st + (size_t)row * 32 + (lane & 15) * 2);
    float s1 = p[0], s2 = p[1];
#pragma unroll
    for (int o = 1; o < 16; o <<= 1) { s1 += __shfl_xor(s1, o); s2 += __shfl_xor(s2, o); }
    mu = s1 * (1.0f / 1024.0f); const float var = fmaxf(s2 * (1.0f / 1024.0f) - mu * mu, 0.f); rstd = rsqrtf(var + LN_EPS);
}
__device__ __forceinline__ void router1_phase(LAS unsigned char* lds, const Args& a) {
    const int tid = threadIdx.x, lane = tid & 63, wid = tid >> 6;
    unsigned char* ws = a.ws;
    const float* g3 = a.in[16] + 2048; const float* b3 = a.in[17] + 2048; const float* wr = a.in[12];
    LAS float* gw = (LAS float*)lds;
    LAS float* cc = (LAS float*)(lds + 32768);
    LAS int* cnt = (LAS int*)(lds + 32768 + 64);
    LAS float* sums = (LAS float*)(lds + 36864);
    LAS f32x2* stat = (LAS f32x2*)(lds + 36864 + 8448);
    __syncthreads();
    for (int i = tid; i < 8192; i += NTHREADS) { const int k = i >> 3, e = i & 7; gw[e * 1024 + k] = g3[k] * wr[i]; }
    if (tid < 8) cnt[tid] = 0;
    __syncthreads();
    { float s1 = 0.f, s2 = 0.f;
        for (int k = lane; k < 1024; k += 64) { s1 += gw[wid * 1024 + k]; s2 += b3[k] * wr[k * 8 + wid]; }
        s1 = wave_sum(s1); s2 = wave_sum(s2);
        if (lane == 0) { cc[wid] = s1; cc[8 + wid] = s2; } }
    __syncthreads();
    const bf16_t* z3 = (const bf16_t*)(ws + WS_RC); const float* st3 = (const float*)(ws + WS_ST3);
    f32x4* route = (f32x4*)(ws + WS_ROUTE);
    const int tok0 = (int)(((long)NR * blockIdx.x) / gridDim.x), tok1 = (int)(((long)NR * (blockIdx.x + 1)) / gridDim.x);
    u32x4 zrA[2], zrB[2]; f32x2 spA, spB;
#define RT_LOAD2(t) do { const int tb_ = ((t) + 8 < tok1) ? (t) + 8 : (t); \
        zrA[0] = *(const u32x4*)(z3 + (size_t)(t) * D + lane * 8); zrA[1] = *(const u32x4*)(z3 + (size_t)(t) * D + 512 + lane * 8); spA = *(const f32x2*)(st3 + (size_t)(t) * 32 + (lane & 15) * 2); \
        zrB[0] = *(const u32x4*)(z3 + (size_t)tb_ * D + lane * 8); zrB[1] = *(const u32x4*)(z3 + (size_t)tb_ * D + 512 + lane * 8); spB = *(const f32x2*)(st3 + (size_t)tb_ * 32 + (lane & 15) * 2); } while (0)
#define RT_FINISH(tk, acc, mu, rstd) do { float lg[8]; \
        _Pragma("unroll") for (int e = 0; e < 8; ++e) lg[e] = (rstd) * (wave_total(acc[e]) - (mu) * cc[e]) + cc[8 + e]; \
        int e1 = 0; float v1 = lg[0]; \
        _Pragma("unroll") for (int e = 1; e < 8; ++e) if (lg[e] > v1) { v1 = lg[e]; e1 = e; } \
        int e2 = -1; float v2 = -3.0e38f; \
        _Pragma("unroll") for (int e = 0; e < 8; ++e) if (e != e1 && lg[e] > v2) { v2 = lg[e]; e2 = e; } \
        const float g1 = 1.0f / (1.0f + expf(v2 - v1)); \
        if (lane == 0) { route[tk] = (f32x4){__int_as_float(e1 | (e2 << 8)), g1, 1.0f - g1, 0.f}; \
            __hip_atomic_fetch_add(&cnt[e1], 1, __ATOMIC_RELAXED, __HIP_MEMORY_SCOPE_WORKGROUP); __hip_atomic_fetch_add(&cnt[e2], 1, __ATOMIC_RELAXED, __HIP_MEMORY_SCOPE_WORKGROUP); } } while (0)
#define RT_Q8(f, iq, hf, tk) do { unsigned w0 = 0u, w1 = 0u;        \
        _Pragma("unroll") for (int j = 0; j < 4; ++j) { w0 = __builtin_amdgcn_cvt_pk_u8_f32(__builtin_rintf(__builtin_fmaf(f[j], iq, 128.0f)), j, w0); w1 = __builtin_amdgcn_cvt_pk_u8_f32(__builtin_rintf(__builtin_fmaf(f[4 + j], iq, 128.0f)), j, w1); } \
        *(u32x2*)(z3q + (size_t)(tk) * D + (hf) * 512 + lane * 8) = (u32x2){w0 ^ 0x80808080u, w1 ^ 0x80808080u}; } while (0)
#define RT_QUANT(tk, zz, mu, rstd) do { float f0[8], f1[8]; g8::unpack8(zz[0], f0); g8::unpack8(zz[1], f1); float mx = 0.f; \
        _Pragma("unroll") for (int j = 0; j < 8; ++j) mx = fmaxf(mx, fmaxf(fabsf(f0[j]), fabsf(f1[j]))); \
        mx = fmaxf(lane63(scan_max64(mx)), 1e-30f); const float iq = 127.0f / mx; \
        RT_Q8(f0, iq, 0, tk); RT_Q8(f1, iq, 1, tk); \
        if (lane == 0) ((f32x2*)(ws + WS_TOKST))[tk] = (f32x2){(rstd) * mx * (1.0f / 127.0f), -(rstd) * (mu)}; } while (0)
    unsigned char* z3q = (unsigned char*)(ws + WS_RA) + RA_Z3Q;
#define RT_BODY(tok_, ZA0, ZA1, ZB0, ZB1, SA, SB) do { const int tk_ = (tok_); \
        const u32x4 zA[2] = {ZA0, ZA1}, zB[2] = {ZB0, ZB1}; \
        float a1 = SA[0], a2 = SA[1], b1 = SB[0], b2 = SB[1]; \
        _Pragma("unroll") for (int o = 1; o < 16; o <<= 1) { a1 += __shfl_xor(a1, o); a2 += __shfl_xor(a2, o); b1 += __shfl_xor(b1, o); b2 += __shfl_xor(b2, o); } \
        const float muA = a1 * (1.0f / 1024.0f), rsA = rsqrtf(fmaxf(a2 * (1.0f / 1024.0f) - muA * muA, 0.f) + LN_EPS); \
        const float muB = b1 * (1.0f / 1024.0f), rsB = rsqrtf(fmaxf(b2 * (1.0f / 1024.0f) - muB * muB, 0.f) + LN_EPS); \
        f32x2 acc2[8]; _Pragma("unroll") for (int e = 0; e < 8; ++e) acc2[e] = (f32x2){0.f, 0.f};        \
        _Pragma("unroll") for (int hf = 0; hf < 2; ++hf) { const int k = hf * 512 + lane * 8; \
            float za[8], zb[8]; g8::unpack8(zA[hf], za); g8::unpack8(zB[hf], zb); \
            f32x2 zab[8]; _Pragma("unroll") for (int j = 0; j < 8; ++j) zab[j] = (f32x2){za[j], zb[j]}; \
            _Pragma("unroll") for (int e = 0; e < 8; ++e) { const f32x4 w0 = *(const LAS f32x4*)(gw + e * 1024 + k), w1 = *(const LAS f32x4*)(gw + e * 1024 + k + 4); \
                _Pragma("unroll") for (int j = 0; j < 4; ++j) { acc2[e] = __builtin_elementwise_fma(zab[j], (f32x2){w0[j], w0[j]}, acc2[e]); acc2[e] = __builtin_elementwise_fma(zab[4 + j], (f32x2){w1[j], w1[j]}, acc2[e]); } } } \
        if (lane == 0) { ((f32x2*)(ws + WS_TOKST))[tk_] = (f32x2){rsA * (Z_CLIP / 127.0f), -rsA * muA}; if (tk_ + 8 < tok1) ((f32x2*)(ws + WS_TOKST))[tk_ + 8] = (f32x2){rsB * (Z_CLIP / 127.0f), -rsB * muB}; } \
          \
        float r8[8]; _Pragma("unroll") for (int e = 0; e < 8; ++e) { const u32x2 p_ = __builtin_amdgcn_permlane32_swap(__float_as_uint(acc2[e][0]), __float_as_uint(acc2[e][1]), false, false); r8[e] = __uint_as_float(p_.x) + __uint_as_float(p_.y); } \
        float r4[4]; _Pragma("unroll") for (int i = 0; i < 4; ++i) { const u32x2 p_ = __builtin_amdgcn_permlane16_swap(__float_as_uint(r8[i]), __float_as_uint(r8[i + 4]), false, false); r4[i] = __uint_as_float(p_.x) + __uint_as_float(p_.y); } \
        _Pragma("unroll") for (int i = 0; i < 4; ++i) { DPP_STEP_ADD(r4[i], 0x128, 0xf); DPP_STEP_ADD(r4[i], 0x124, 0xf); DPP_STEP_ADD(r4[i], 0x122, 0xf); DPP_STEP_ADD(r4[i], 0x121, 0xf); } \
        { const int tl_ = tk_ - tok0, row_ = lane >> 4; \
          if ((lane & 15) == 0) { LAS float* d_ = sums + (tl_ + 8 * (row_ >> 1)) * 8 + 4 * (row_ & 1); d_[0] = r4[0]; d_[1] = r4[1]; d_[2] = r4[2]; d_[3] = r4[3]; } \
          if (lane == 0) { stat[tl_] = (f32x2){muA, rsA}; stat[tl_ + 8] = (f32x2){muB, rsB}; } } } while (0)
    u32x4 zsA[2], zsB[2]; f32x2 ssA, ssB;
#define RT_SWAPSETS() do { u32x4 t_; f32x2 u_; t_ = zrA[0]; zrA[0] = zsA[0]; zsA[0] = t_; t_ = zrA[1]; zrA[1] = zsA[1]; zsA[1] = t_; t_ = zrB[0]; zrB[0] = zsB[0]; zsB[0] = t_; t_ = zrB[1]; zrB[1] = zsB[1]; zsB[1] = t_; \
        u_ = spA; spA = ssA; ssA = u_; u_ = spB; spB = ssB; ssB = u_; } while (0)
    {
        const int t0 = tok0 + wid;
        if (t0 + 16 < tok1) { RT_LOAD2(t0 + 16); } else if (t0 < tok1) { RT_LOAD2(t0); }
        RT_SWAPSETS();
        if (t0 < tok1) RT_LOAD2(t0);
        for (int tok = t0; tok < tok1; tok += 32) {
            { const u32x4 a0 = zrA[0], a1_ = zrA[1], b0 = zrB[0], b1_ = zrB[1]; const f32x2 sa = spA, sb = spB;
              if (tok + 32 < tok1) RT_LOAD2(tok + 32);
              RT_BODY(tok, a0, a1_, b0, b1_, sa, sb); }
            if (tok + 16 < tok1) {
              const u32x4 a0 = zsA[0], a1_ = zsA[1], b0 = zsB[0], b1_ = zsB[1]; const f32x2 sa = ssA, sb = ssB;
              if (tok + 48 < tok1) { RT_SWAPSETS(); RT_LOAD2(tok + 48); RT_SWAPSETS(); }
              RT_BODY(tok + 16, a0, a1_, b0, b1_, sa, sb); }
        }
    }
#undef RT_BODY
#undef RT_SWAPSETS
    if (lane < 32) { const int tl = wid + 8 * lane, tk = tok0 + tl;
        if (tk < tok1) {
            const f32x4 s0 = *(const LAS f32x4*)(sums + tl * 8), s1 = *(const LAS f32x4*)(sums + tl * 8 + 4); const f32x2 ms = stat[tl];
            float lg[8];
#pragma unroll
            for (int e = 0; e < 8; ++e) lg[e] = ms[1] * ((e < 4 ? s0[e & 3] : s1[e & 3]) - ms[0] * cc[e]) + cc[8 + e];
            int e1 = 0; float v1 = lg[0];
#pragma unroll
            for (int e = 1; e < 8; ++e) if (lg[e] > v1) { v1 = lg[e]; e1 = e; }
            int e2 = -1; float v2 = -3.0e38f;
#pragma unroll
            for (int e = 0; e < 8; ++e) if (e != e1 && lg[e] > v2) { v2 = lg[e]; e2 = e; }
            const float g1 = 1.0f / (1.0f + expf(v2 - v1));
            route[tk] = (f32x4){__int_as_float(e1 | (e2 << 8)), g1, 1.0f - g1, 0.f};
            __hip_atomic_fetch_add(&cnt[e1], 1, __ATOMIC_RELAXED, __HIP_MEMORY_SCOPE_WORKGROUP); __hip_atomic_fetch_add(&cnt[e2], 1, __ATOMIC_RELAXED, __HIP_MEMORY_SCOPE_WORKGROUP);
        } }
#undef RT_LOAD2
#undef RT_FINISH
#undef RT_QUANT
#undef RT_Q8
    __syncthreads();
    if (tid < 8) ((int*)(ws + WS_CNT))[blockIdx.x * 8 + tid] = cnt[tid];
}
__device__ __forceinline__ void router2_phase(LAS unsigned char* lds, const Args& a) {
    const int tid = threadIdx.x, lane = tid & 63, wid = tid >> 6;
    unsigned char* ws = a.ws;
    const int G = gridDim.x, wg = blockIdx.x;
    LAS int* cn = (LAS int*)lds;
    LAS int* tot = (LAS int*)(lds + 16384);
    u32x2* smeta = (u32x2*)(ws + WS_TOK); f32x2* sstat = (f32x2*)(ws + WS_GATEB); const f32x2* tokst = (const f32x2*)(ws + WS_TOKST);
    const f32x4* route = (const f32x4*)(ws + WS_ROUTE);
    const int tok0 = (int)(((long)NR * wg) / G), tok1 = (int)(((long)NR * (wg + 1)) / G);
    f32x4 rr[8]; f32x2 ts[8];
#pragma unroll
    for (int i = 0; i < 8; ++i) { int q = 2 * tok0 + 64 * i + lane; q = q < 2 * tok1 ? q : 2 * tok1 - 1; rr[i] = route[q >> 1]; ts[i] = tokst[q >> 1]; }
    __syncthreads();
    const int* cnts = (const int*)(ws + WS_CNT);
    for (int i = tid; i < G * 8; i += NTHREADS) cn[i] = cnts[i];
    __syncthreads();
    { int t = 0, p = 0;
        for (int w = lane; w < G; w += 64) { const int v = cn[w * 8 + wid]; t += v; p += (w < wg) ? v : 0; }
#pragma unroll
        for (int o = 32; o >= 1; o >>= 1) { t += __shfl_xor(t, o); p += __shfl_xor(p, o); }
        if (lane == 0) { tot[wid] = t; tot[8 + wid] = p; } }
    __syncthreads();
    if (tid == 0) { int ps = 0;
        for (int e = 0; e < 8; ++e) { tot[24 + e] = ps; tot[16 + e] = ps + tot[8 + e]; ps += ((tot[e] + 255) >> 8) << 8; }
        if (wg == 0) { int* hdr = (int*)(ws + WS_HDR); int pp = 0; for (int e = 0; e < 8; ++e) { pp += (tot[e] + 255) >> 8; hdr[e] = pp; } hdr[8] = pp; } }
    __syncthreads();
    { const int e = wid; int run = tot[16 + e];
#pragma unroll
        for (int i = 0; i < 8; ++i) {
            const int q = 2 * tok0 + 64 * i + lane; bool match = false; float gt = 0.f;
            if (q < 2 * tok1) { const f32x4 r = rr[i]; const int ee = __float_as_int(r[0]); const int ex = (q & 1) ? ((ee >> 8) & 0xff) : (ee & 0xff); match = (ex == e); gt = (q & 1) ? r[2] : r[1]; }
            const unsigned long long mask = __ballot(match);
            const int pos = __popcll(mask & ((1ull << lane) - 1ull));
            if (match) { smeta[run + pos] = (u32x2){(unsigned)q, __float_as_uint(gt)}; sstat[run + pos] = ts[i]; }
            run += __popcll(mask);
        }
        if (wg == 0) { const int s0 = tot[24 + e] + tot[e], s1 = tot[24 + e] + (((tot[e] + 255) >> 8) << 8);
            for (int s = s0 + lane; s < s1; s += 64) { smeta[s] = (u32x2){0xffffffffu, 0u}; sstat[s] = (f32x2){0.f, 0.f}; } }
    }
}

__device__ __forceinline__ float wave_total(float x);
__device__ __forceinline__ void final_phase(const Args& a) {
    const int tid = threadIdx.x, lane = tid & 63, wid = tid >> 6;
    unsigned char* ws = a.ws;
    const bf16_t* z3 = (const bf16_t*)(ws + WS_RC); const float* st3 = (const float*)(ws + WS_ST3);
    const bf16_t* Y0 = (const bf16_t*)(ws + WS_RB); const bf16_t* Y1 = (const bf16_t*)(ws + WS_RD);
    const float* g3 = a.in[16] + 2048; const float* b3 = a.in[17] + 2048; const float* g4 = a.in[16] + 3072; const float* b4 = a.in[17] + 3072;
    float G3[16], B3[16], G4[16], B4[16];
#pragma unroll
    for (int hf = 0; hf < 2; ++hf)
#pragma unroll
        for (int q = 0; q < 2; ++q) { const int k = hf * 512 + lane * 8 + q * 4;
            const f32x4 a3 = *(const f32x4*)(g3 + k), c3 = *(const f32x4*)(b3 + k), a4 = *(const f32x4*)(g4 + k), c4 = *(const f32x4*)(b4 + k);
#pragma unroll
            for (int j = 0; j < 4; ++j) { G3[hf * 8 + q * 4 + j] = a3[j] * ALPHA; B3[hf * 8 + q * 4 + j] = c3[j] * ALPHA; G4[hf * 8 + q * 4 + j] = a4[j]; B4[hf * 8 + q * 4 + j] = c4[j]; } }
    const int stride = gridDim.x * 8;
    int tok = blockIdx.x * 8 + wid;
    u32x4 zr[2], y0r[2], y1r[2]; f32x2 sp;
#define FIN_LOAD(t) do { _Pragma("unroll") for (int hf = 0; hf < 2; ++hf) { const size_t o = (size_t)(t) * D + hf * 512 + lane * 8; \
        zr[hf] = *(const u32x4*)(z3 + o); y0r[hf] = *(const u32x4*)(Y0 + o); y1r[hf] = *(const u32x4*)(Y1 + o); } \
        sp = *(const f32x2*)(st3 + (size_t)(t) * 32 + (lane & 15) * 2); } while (0)
    if (tok < NR) FIN_LOAD(tok);
    for (; tok < NR; tok += stride) {
        u32x4 zc[2] = {zr[0], zr[1]}, y0c[2] = {y0r[0], y0r[1]}, y1c[2] = {y1r[0], y1r[1]}; const f32x2 spc = sp;
        if (tok + stride < NR) FIN_LOAD(tok + stride);
        float s1 = spc[0], s2 = spc[1];
#pragma unroll
        for (int o = 1; o < 16; o <<= 1) { s1 += __shfl_xor(s1, o); s2 += __shfl_xor(s2, o); }
        const float mu = s1 * (1.0f / 1024.0f); const float rstd = rsqrtf(fmaxf(s2 * (1.0f / 1024.0f) - mu * mu, 0.f) + LN_EPS);
        float v[16]; float t1 = 0.f;
#pragma unroll
        for (int hf = 0; hf < 2; ++hf) {
            float z[8], y0[8], y1[8];
            g8::unpack8(zc[hf], z); g8::unpack8(y0c[hf], y0); g8::unpack8(y1c[hf], y1);
#pragma unroll
            for (int j = 0; j < 8; ++j) { const float x = ((z[j] - mu) * rstd * G3[hf * 8 + j] + B3[hf * 8 + j]) + (y0[j] + y1[j]); v[hf * 8 + j] = x; t1 += x; }
        }
        t1 = wave_total(t1); const float mean = t1 * (1.0f / 1024.0f); float t2 = 0.f;
#pragma unroll
        for (int j = 0; j < 16; ++j) { const float d = v[j] - mean; t2 += d * d; }
        t2 = wave_total(t2); const float rs = rsqrtf(t2 * (1.0f / 1024.0f) + LN_EPS);
#pragma unroll
        for (int hf = 0; hf < 2; ++hf) {
            const int k = hf * 512 + lane * 8;
            f32x4 o0, o1;
#pragma unroll
            for (int j = 0; j < 4; ++j) { o0[j] = (v[hf * 8 + j] - mean) * rs * G4[hf * 8 + j] + B4[hf * 8 + j]; o1[j] = (v[hf * 8 + 4 + j] - mean) * rs * G4[hf * 8 + 4 + j] + B4[hf * 8 + 4 + j]; }
            *(f32x4*)(a.out + (size_t)tok * D + k) = o0; *(f32x4*)(a.out + (size_t)tok * D + k + 4) = o1;
        }
    }
#undef FIN_LOAD
}

__device__ __forceinline__ void moefix_phase(const Args& a) {
    const int lane = threadIdx.x & 63, wid = threadIdx.x >> 6;
    unsigned char* ws = a.ws;
    const int npan = ((const int*)(ws + WS_HDR))[8];
    const int p_lo = (MOE_NCHUNK - 1) * MOE_CHUNK_PAN + MOE_CHUNK_PAN;
    const int nrows = (npan - p_lo) * 256;
    const u32x2* smeta = (const u32x2*)(ws + WS_TOK);
    const float* P = (const float*)(ws + WS_RA + RA_POFF);
    bf16_t* Y0 = (bf16_t*)(ws + WS_RB); bf16_t* Y1 = (bf16_t*)(ws + WS_RD);
    for (int r = blockIdx.x * 8 + wid; r < nrows; r += gridDim.x * 8) {
        const u32x2 mg = smeta[(size_t)p_lo * 256 + r];
        const int id = (int)mg.x; const float gt = __uint_as_float(mg.y);
        if (id < 0) continue;
        bf16_t* yrow = ((id & 1) ? Y1 : Y0) + (size_t)(id >> 1) * D;
#pragma unroll
        for (int hf = 0; hf < 2; ++hf) {
            const int c = hf * 512 + lane * 8;
            f32x4 s0 = {0.f, 0.f, 0.f, 0.f}, s1 = {0.f, 0.f, 0.f, 0.f};
#pragma unroll
            for (int ks = 0; ks < MOE_KSPLIT; ++ks) { const float* pp = P + ((size_t)ks * 2048 + r) * D + c; s0 += *(const f32x4*)pp; s1 += *(const f32x4*)(pp + 4); }
            *(u32x4*)(yrow + c) = g8::pack8(s0 * gt, s1 * gt);
        }
    }
}
__device__ __forceinline__ void finquant_phase(const float* st, float* rs, const bf16_t* z, unsigned char* zq, float* rq, int nrows) {
    const int lane = threadIdx.x & 63, wid = threadIdx.x >> 6;
    const int nw = gridDim.x * 8;
    for (int row0 = blockIdx.x * 8 + wid; row0 < nrows; row0 += 4 * nw) {
        u32x4 zr[4][2]; f32x2 sp[4];
#pragma unroll
        for (int i = 0; i < 4; ++i) { int r = row0 + i * nw; r = r < nrows ? r : row0;
            zr[i][0] = *(const u32x4*)(z + (size_t)r * D + lane * 8); zr[i][1] = *(const u32x4*)(z + (size_t)r * D + 512 + lane * 8); sp[i] = *(const f32x2*)(st + (size_t)r * 32 + (lane & 15) * 2); }
#pragma unroll
        for (int i = 0; i < 4; ++i) { const int r = row0 + i * nw;
            if (r < nrows) {
                float s1 = sp[i][0], s2 = sp[i][1];
#pragma unroll
                for (int o = 1; o < 16; o <<= 1) { s1 += __shfl_xor(s1, o); s2 += __shfl_xor(s2, o); }
                const float mu = s1 * (1.0f / 1024.0f), rstd = rsqrtf(fmaxf(s2 * (1.0f / 1024.0f) - mu * mu, 0.f) + LN_EPS);
                float f0[8], f1[8]; g8::unpack8(zr[i][0], f0); g8::unpack8(zr[i][1], f1); float mx = 0.f;
#pragma unroll
                for (int j = 0; j < 8; ++j) mx = fmaxf(mx, fmaxf(fabsf(f0[j]), fabsf(f1[j])));
                mx = fmaxf(lane63(scan_max64(mx)), 1e-30f); const float iq = 127.0f / mx;
                unsigned w0 = 0u, w1 = 0u, w2 = 0u, w3 = 0u;
#pragma unroll
                for (int j = 0; j < 4; ++j) { w0 |= ((unsigned)q8_(f0[j] * iq) & 255u) << (8 * j); w1 |= ((unsigned)q8_(f0[4 + j] * iq) & 255u) << (8 * j);
                    w2 |= ((unsigned)q8_(f1[j] * iq) & 255u) << (8 * j); w3 |= ((unsigned)q8_(f1[4 + j] * iq) & 255u) << (8 * j); }
                *(u32x2*)(zq + (size_t)r * D + lane * 8) = (u32x2){w0, w1}; *(u32x2*)(zq + (size_t)r * D + 512 + lane * 8) = (u32x2){w2, w3};
                if (lane == 0) { *(f32x2*)(rs + (size_t)r * 2) = (f32x2){mu, rstd}; *(f32x2*)(rq + (size_t)r * 2) = (f32x2){rstd * mx * (1.0f / 127.0f), -rstd * mu}; }
            } }
    }
}
__device__ __forceinline__ void finstats_phase(const float* st, float* rs, float* rq, int nrows) {
    for (int row = blockIdx.x * NTHREADS + threadIdx.x; row < nrows; row += gridDim.x * NTHREADS) {
        const f32x4* p = (const f32x4*)(st + (size_t)row * 32);
        float s1 = 0.f, s2 = 0.f;
#pragma unroll
        for (int i = 0; i < 8; ++i) { const f32x4 a = p[i]; s1 += a[0] + a[2]; s2 += a[1] + a[3]; }
        const float mu = s1 * (1.0f / 1024.0f); const float rstd = rsqrtf(fmaxf(s2 * (1.0f / 1024.0f) - mu * mu, 0.f) + LN_EPS);
        *(f32x2*)(rs + (size_t)row * 2) = (f32x2){mu, rstd};
        *(f32x2*)(rq + (size_t)row * 2) = (f32x2){rstd * (Z_CLIP / 127.0f), -rstd * mu};
    }
}
__global__ void __launch_bounds__(NTHREADS, 2) yoco_fwd(Args args) {
    extern __shared__ __attribute__((aligned(16))) unsigned char lds_raw[];
    LAS unsigned char* lds = (LAS unsigned char*)lds_raw;
    unsigned char* ws = args.ws;
    const int G = gridDim.x;
    const int lo = args.ph_lo, hi = args.ph_hi;
    volatile LAS unsigned* misc = (volatile LAS unsigned*)(lds + LDS_MISC);
    if (threadIdx.x < 4) misc[threadIdx.x] = 0u;
    __syncthreads();
    XcdBarrier bar; bar.bar = (unsigned*)(ws + WS_CTL); bar.x = 0; bar.st = misc;
    if (hi - lo > 1) bar = xcd_barrier_post((unsigned*)(ws + WS_CTL), misc);
    if (PROBE_T >= 0 && blockIdx.x == 0 && threadIdx.x == 0) __hip_atomic_store((unsigned long long*)(ws + WS_DIAG + 32), 0ull, __ATOMIC_RELAXED, __HIP_MEMORY_SCOPE_AGENT);
#ifndef PHASE_MASK
#define PHASE_MASK 0xFFFFFFFFu
#endif
#define IN(k) (((PHASE_MASK >> (k)) & 1u) && lo <= (k) && (k) < hi)
#define SEAM(k) do { if (IN(k) && IN((k) + 1)) xcd_barrier(bar); } while (0)
    bf16_t* RA = (bf16_t*)(ws + WS_RA); bf16_t* RB = (bf16_t*)(ws + WS_RB); bf16_t* RC = (bf16_t*)(ws + WS_RC); bf16_t* RD = (bf16_t*)(ws + WS_RD);
    float* vec = (float*)(ws + WS_VEC);
    float* st1 = (float*)(ws + WS_ST1); float* st2 = (float*)(ws + WS_ST2); float* st3 = (float*)(ws + WS_ST3);
    const float* ln_g = args.in[16]; const float* ln_b = args.in[17];

#define RUN_(seam, k, ...) do { if constexpr (((REPMASK) >> (k)) & 1u) { if (IN(k)) { __VA_ARGS__ } xcd_barrier(bar); } \
        if ((k) == PROBE_T && threadIdx.x == 0) ((volatile long long*)(ws + WS_DIAG + 1024))[blockIdx.x] = wall_clock64(); \
        if (IN(k)) { __VA_ARGS__ } \
        if ((k) == PROBE_T && threadIdx.x == 0) { const long long dt_ = wall_clock64() - ((volatile long long*)(ws + WS_DIAG + 1024))[blockIdx.x]; if (PROBE_WG < 0 || (int)blockIdx.x == PROBE_WG) atomicMax((unsigned long long*)(ws + WS_DIAG + 32), (unsigned long long)dt_); } \
        if (seam) SEAM(k); } while (0)
#define RUN(k, ...) RUN_(true, k, __VA_ARGS__)
    RUN(PH_PRO, prologue_phase(lds, args););
    RUN(PH_PROJ,
        g8::Gemm g{RC, (const bf16_t*)(ws + WS_WIN), D / 2, nullptr, nullptr, ws + WS_RQ1}; g8::DenseOrder S; S.init(NPAN, NPROJ / 256, D / 2, G, (int)blockIdx.x);
        g8::EpiPlainQ E{RA, NPROJ, lds + LDS_META, vec + VEC_WIN_SC};
        g8::gemm_phase<g8::EpiPlainQ, g8::DenseOrder, false, 3, true>(lds, g, S, E); tail_jobs(lds, args, PH_PROJ););
    RUN(PH_MLSTM, if ((int)blockIdx.x < 256) mlstm_phase(lds, RA, (const float*)(ws + WS_GATES), args.in[4], RD, (int)blockIdx.x););
    RUN(PH_WOUT,
        g8::Gemm g{RD, (const bf16_t*)(ws + WS_WOUT), D / 2, nullptr, nullptr, nullptr}; g8::DenseOrder S; S.init(NPAN, 4, D / 2, G, (int)blockIdx.x);
        g8::EpiRes<0, true> E{RC, RB, st1, lds + LDS_META, nullptr, nullptr, vec + VEC_WOUT_SC, HN_CLIP / 127.0f, (unsigned char*)RA + RA_Z1Q};
        g8::gemm_phase<g8::EpiRes<0, true>, g8::DenseOrder, false, 0, true>(lds, g, S, E); tail_jobs(lds, args, PH_WOUT););
    RUN(PH_FIN1, finstats_phase(st1, (float*)(ws + WS_RS1), (float*)(ws + WS_RQ1), NROWS););
    RUN(PH_GU,
        g8::Gemm g{(const bf16_t*)((const unsigned char*)RA + RA_Z1Q), (const bf16_t*)(ws + WS_WGU), D / 2, nullptr, nullptr, ws + WS_RQ1}; g8::DenseOrder S; S.init(NPAN, 2 * FFD / 256, D / 2, G, (int)blockIdx.x);
        g8::EpiGluQ<true> E{RA, FFD, vec + VEC_GU_CS, vec + VEC_GU_BW, vec + VEC_GU_SC, lds + LDS_META};
        g8::gemm_phase<g8::EpiGluQ<true>, g8::DenseOrder, false, 3, true>(lds, g, S, E); tail_jobs(lds, args, PH_GU););
    RUN(PH_DN,
        g8::Gemm g{RA, (const bf16_t*)(ws + WS_WDN), FFD / 2, nullptr, nullptr, ws + WS_RS1}; g8::DenseOrder S; S.init(NPAN, 4, FFD / 2, G, (int)blockIdx.x);
        g8::EpiRes<1, true> E{RB, RC, st2, lds + LDS_META, ln_g, ln_b, vec + VEC_DN_SC, ACT_CLIP / 127.0f, (unsigned char*)RD};
        g8::gemm_phase<g8::EpiRes<1, true>, g8::DenseOrder, false, 3, true>(lds, g, S, E); tail_jobs(lds, args, PH_DN););
    RUN(PH_FIN2, finstats_phase(st2, (float*)(ws + WS_RS2), (float*)(ws + WS_RQ2), NROWS););
    RUN(PH_KVQ,
        g8::Gemm g{RD, (const bf16_t*)(ws + WS_WKVQ), D / 2, nullptr, nullptr, ws + WS_RQ2}; g8::DenseOrder S; S.init(NPAN, NPROJ / 256, D / 2, G, (int)blockIdx.x);
        g8::EpiFoldQ E{RA, NPROJ, lds + LDS_META, vec + VEC_KVQ_CS, vec + VEC_KVQ_BW, vec + VEC_KVQ_SC};
        g8::gemm_phase<g8::EpiFoldQ, g8::DenseOrder, false, 3, true>(lds, g, S, E); tail_jobs(lds, args, PH_KVQ););
    RUN(PH_ATT, attn_phase(lds, RA, RD););
    RUN(PH_WO,
        g8::Gemm g{RD, (const bf16_t*)(ws + WS_WO), D / 2, nullptr, nullptr, ws + WS_RS2}; g8::DenseOrder S; S.init(NR / 256, 4, D / 2, G, (int)blockIdx.x);
        g8::EpiRes<1, true> E{RC, RB, st3, lds + LDS_META, ln_g + 1024, ln_b + 1024, vec + VEC_WO_SC, AO_CLIP / 127.0f, (unsigned char*)RA + RA_Z3Q};
        g8::gemm_phase<g8::EpiRes<1, true>, g8::DenseOrder, false, 3, true>(lds, g, S, E););
    RUN(PH_RT1, router1_phase(lds, args););
    RUN(PH_RT2, router2_phase(lds, args););
#define MOE_ACT2(cidx) (RA)
#define MOE_CHUNK(cidx) \
    RUN(PH_MOE0 + 2 * (cidx), const int* hdr = (const int*)(ws + WS_HDR); const int npan = hdr[8]; const int p0 = (cidx) * MOE_CHUNK_PAN; \
        { g8::MoeOrder S; S.p0 = p0; S.np = ((cidx) == MOE_NCHUNK - 1) ? (npan - p0) : MOE_CHUNK_PAN; S.nfull = MOE_CHUNK_PAN; S.nsplit = 1; S.nN = 2 * FFE / 256; S.G = G; S.c = (int)blockIdx.x; S.K = D / 2; S.estride = (unsigned)(2 * FFE * D); \
            _Pragma("unroll") for (int e = 0; e < NE; ++e) S.pend[e] = hdr[e]; \
            g8::Gemm g{(const bf16_t*)((const unsigned char*)RA + RA_Z3Q), (const bf16_t*)(ws + WS_WEGU), D / 2, (const int*)(ws + WS_TOK), ws + WS_TOK, ws + WS_GATEB}; \
            g8::EpiGluQ<true> E{MOE_ACT2(cidx), FFE, vec + VEC_EGU_CS, vec + VEC_EGU_BW, vec + VEC_EGU_SC, lds + LDS_META}; \
            g8::gemm_phase<g8::EpiGluQ<true>, g8::MoeOrder, true, 1, true>(lds, g, S, E); }); \
    RUN_(true, PH_MOE0 + 2 * (cidx) + 1, const int* hdr = (const int*)(ws + WS_HDR); const int npan = hdr[8]; const int p0 = (cidx) * MOE_CHUNK_PAN; \
        { g8::MoeOrder S; S.p0 = p0; S.np = ((cidx) == MOE_NCHUNK - 1) ? (npan - p0) : MOE_CHUNK_PAN; S.nfull = MOE_CHUNK_PAN; S.nsplit = MOE_KSPLIT; S.nN = 4; S.G = G; S.c = (int)blockIdx.x; S.K = FFE / 2; S.estride = (unsigned)(D * FFE); \
            _Pragma("unroll") for (int e = 0; e < NE; ++e) S.pend[e] = hdr[e]; \
            g8::Gemm g{MOE_ACT2(cidx), (const bf16_t*)(ws + WS_WEDN), FFE / 2, nullptr, ws + WS_TOK, nullptr}; \
            g8::EpiMoeDownQ E{RB, RD, lds + LDS_META, (float*)((unsigned char*)RA + RA_POFF), MOE_CHUNK_PAN, vec + VEC_EDN_SC}; \
            g8::gemm_phase<g8::EpiMoeDownQ, g8::MoeOrder, false, 2, true>(lds, g, S, E); });
    MOE_CHUNK(0) MOE_CHUNK(1)
    RUN(PH_FIX, moefix_phase(args););
    RUN(PH_FINAL, final_phase(args););
    if (PROBE_T >= 0 && blockIdx.x == 0 && threadIdx.x == 0) { const long long dl = 4 * (long long)__hip_atomic_load((unsigned long long*)(ws + WS_DIAG + 32), __ATOMIC_RELAXED, __HIP_MEMORY_SCOPE_AGENT); const long long t0 = wall_clock64(); while (wall_clock64() - t0 < dl) __builtin_amdgcn_s_sleep(8); }
#undef RUN
#undef IN
#undef SEAM
}

extern "C" void kernel_launch(void* const* d_in, const int* in_sizes, int n_in, void* d_out, int out_size, void* d_ws, size_t ws_size, hipStream_t stream) {
    static int grid = 0;
    if (grid == 0) {
        if (n_in != 18 || out_size != NR * D || ws_size < WS_END) { fprintf(stderr, "kernel_launch: unexpected problem (n_in %d out %d ws %zu need %zu)\n", n_in, out_size, ws_size, (size_t)WS_END); grid = -1; return; }
        int dev = 0, cus = 0, per_cu = 0;
        if (hipGetDevice(&dev) != hipSuccess || hipDeviceGetAttribute(&cus, hipDeviceAttributeMultiprocessorCount, dev) != hipSuccess) { grid = -1; return; }
        if (hipFuncSetAttribute((const void*)yoco_fwd, hipFuncAttributeMaxDynamicSharedMemorySize, LDS_BYTES) != hipSuccess) { fprintf(stderr, "kernel_launch: hipFuncSetAttribute failed\n"); grid = -1; return; }
        if (hipOccupancyMaxActiveBlocksPerMultiprocessor(&per_cu, (const void*)yoco_fwd, NTHREADS, LDS_BYTES) != hipSuccess || per_cu < 1) { fprintf(stderr, "kernel_launch: occupancy query says %d\n", per_cu); }
        (void)hipGetLastError();
        if (cus < 256) { fprintf(stderr, "kernel_launch: needs 256 CUs\n"); grid = -1; return; }
        grid = 256;
    }
    if (grid < 0) return;
    (void)hipMemsetAsync((char*)d_ws + WS_CTL, 0, CTL_BYTES, stream);
    Args a{};
    for (int i = 0; i < 18; ++i) a.in[i] = (const float*)d_in[i];
    a.out = (float*)d_out; a.ws = (unsigned char*)d_ws;
#if N_LAUNCH_MODE == 1
    for (int p = 0; p < PH_COUNT; ++p) { a.ph_lo = p; a.ph_hi = p + 1; hipLaunchKernelGGL(yoco_fwd, dim3(grid), dim3(NTHREADS), LDS_BYTES, stream, a); }
#else
    a.ph_lo = 0; a.ph_hi = PH_COUNT;
    hipLaunchKernelGGL(yoco_fwd, dim3(grid), dim3(NTHREADS), LDS_BYTES, stream, a);
#endif
}
```
